# Optimizing an MI355X kernel written in HIP

```python
import jax, jax.numpy as jnp
from jax import lax
import numpy as np

D_MODEL = 1024
BATCH = 8
SEQ = 2048
DEPTH = 1
DEC_BATCH = 128
DEC_SEQ = 1
PAST_LEN = 2048
PAGE_SIZE = 128

HEAD_DIM = 64
N_HEADS = 8
N_KV = 2
GQA = N_HEADS // N_KV
WIDTH_A = N_HEADS * HEAD_DIM
KV_WIDTH = N_KV * HEAD_DIM
L_CMP = 32
L_SLC = 64
N_SEL = 8
WINDOW = 512
Q_BLOCK = 128
FORCE_BONUS = 1.0e4
ROPE_THETA = 10000.0
CHUNK = 128
N_GROUPS_B = 4
WIDTH_B = 512
GROUP_W_B = WIDTH_B // N_GROUPS_B
D_IN = WIDTH_A + 6 * KV_WIDTH + 3 * N_HEADS + WIDTH_A + 3 * WIDTH_B + 2 * D_MODEL
EPS = 1e-6
NEG = -1e30

kernel_name = 'nsa_gmlp_hybrid_step'


def rms_norm(x, g):
    xf = x.astype(jnp.float32)
    y = xf * lax.rsqrt(jnp.mean(xf * xf, axis=-1, keepdims=True) + EPS)
    return (y * g.astype(jnp.float32)).astype(x.dtype)


def layer_norm(x, g, b):
    xf = x.astype(jnp.float32)
    mu = jnp.mean(xf, axis=-1, keepdims=True)
    var = jnp.mean(jnp.square(xf - mu), axis=-1, keepdims=True)
    y = (xf - mu) * lax.rsqrt(var + EPS) * g.astype(jnp.float32) + b.astype(jnp.float32)
    return y.astype(x.dtype)


def rope(x, pos):
    half = HEAD_DIM // 2
    inv = ROPE_THETA ** (-jnp.arange(half, dtype=jnp.float32) * 2.0 / HEAD_DIM)
    ang = pos.astype(jnp.float32)[:, None] * inv[None, :]
    shape = (pos.shape[0],) + (1,) * (x.ndim - 3) + (half,)
    cos, sin = jnp.cos(ang).reshape(shape), jnp.sin(ang).reshape(shape)
    xf = x.astype(jnp.float32)
    x1, x2 = xf[..., :half], xf[..., half:]
    return jnp.concatenate([x1 * cos - x2 * sin, x2 * cos + x1 * sin], axis=-1).astype(x.dtype)


def compress(rows, pos_emb, w):
    B, T = rows.shape[:2]
    blocks = rows.reshape(B, T // L_CMP, L_CMP, N_KV, HEAD_DIM)
    pooled = jnp.mean(blocks + pos_emb[:, None, :], axis=2)
    return pooled @ w


def nsa_core(q, qpos, kc, vc, ks, vs, kw, vw, kwpos):
    B, Tq = q.shape[:2]
    dt = q.dtype
    scale = HEAD_DIM ** -0.5
    qg = q.reshape(B, Tq, N_KV, GQA, HEAD_DIM)
    NC = kc.shape[1]
    cend = (jnp.arange(NC, dtype=jnp.int32) + 1) * L_CMP - 1
    mc = (cend[None, :] <= qpos[:, None])[None, :, None, None, :]
    s_c = jnp.einsum('bqgrd,bcgd->bqgrc', qg, kc).astype(jnp.float32) * scale
    p_c = jax.nn.softmax(jnp.where(mc, s_c, NEG), axis=-1) * mc
    o_c = jnp.einsum('bqgrc,bcgd->bqgrd', p_c.astype(dt), vc)
    NS = ks.shape[1] // L_SLC
    ratio = L_SLC // L_CMP
    imp = p_c.sum(axis=3).reshape(B, Tq, N_KV, NS, ratio).sum(axis=-1)
    blk = jnp.arange(NS, dtype=jnp.int32)
    qblk = qpos // L_SLC
    forced = ((blk[None, :] == 0) | (blk[None, :] == qblk[:, None])).astype(jnp.float32)
    causal_blk = blk[None, :] <= qblk[:, None]
    imp = jnp.where(causal_blk[None, :, None, :], imp + FORCE_BONUS * forced[None, :, None, :], NEG)
    n_sel = min(N_SEL, NS)
    _, idx = lax.top_k(imp, n_sel)
    ksb = ks.reshape(B, NS, L_SLC, N_KV, HEAD_DIM).transpose(0, 3, 1, 2, 4)
    vsb = vs.reshape(B, NS, L_SLC, N_KV, HEAD_DIM).transpose(0, 3, 1, 2, 4)
    idx_t = idx.transpose(0, 2, 1, 3)
    gather = jax.vmap(jax.vmap(lambda blocks, ids: blocks[ids]))
    k_sel = gather(ksb, idx_t)
    v_sel = gather(vsb, idx_t)
    s_s = jnp.einsum('bqgrd,bgqnld->bqgrnl', qg, k_sel).astype(jnp.float32) * scale
    kpos_s = idx_t[..., None] * L_SLC + jnp.arange(L_SLC, dtype=jnp.int32)
    m_s = (kpos_s <= qpos[None, None, :, None, None]).transpose(0, 2, 1, 3, 4)[:, :, :, None]
    s_s = jnp.where(m_s, s_s, NEG).reshape(B, Tq, N_KV, GQA, n_sel * L_SLC)
    p_s = jax.nn.softmax(s_s, axis=-1).reshape(B, Tq, N_KV, GQA, n_sel, L_SLC)
    o_s = jnp.einsum('bqgrnl,bgqnld->bqgrd', p_s.astype(dt), v_sel)
    m_w = ((kwpos[None, :] <= qpos[:, None]) & (kwpos[None, :] > qpos[:, None] - WINDOW)
           & (kwpos[None, :] >= 0))[None, :, None, None, :]
    s_w = jnp.einsum('bqgrd,bkgd->bqgrk', qg, kw).astype(jnp.float32) * scale
    p_w = jax.nn.softmax(jnp.where(m_w, s_w, NEG), axis=-1)
    o_w = jnp.einsum('bqgrk,bkgd->bqgrd', p_w.astype(dt), vw)
    shp = (B, Tq, N_HEADS, HEAD_DIM)
    return (o_c.reshape(shp), o_s.reshape(shp), o_w.reshape(shp))


def spatial_mix(vn, w_s, b_s):
    B, T, _ = vn.shape
    Lc = min(CHUNK, T)
    vc = vn.reshape(B, T // Lc, Lc, N_GROUPS_B, GROUP_W_B)
    ws = jnp.tril(w_s[:, :Lc, :Lc])
    s = jnp.einsum('gij,bcjgd->bcigd', ws, vc) + b_s[:, :Lc].T[None, None, :, :, None]
    return s.reshape(B, T, WIDTH_B)


def mixer_inputs(x, c, pos, w_ada, b_ada, norm_g, w_in, q_norm_g, k_norm_g, vnorm_g, vnorm_b):
    B, T, _ = x.shape
    mod = c @ w_ada + b_ada
    shift, scale, gate = jnp.split(mod, 3, axis=-1)
    h = rms_norm(x, norm_g) * (1.0 + scale[:, None]) + shift[:, None]
    proj = h @ w_in
    sizes = (WIDTH_A, 6 * KV_WIDTH, 3 * N_HEADS, WIDTH_A, WIDTH_B, WIDTH_B, WIDTH_B, D_MODEL, D_MODEL)
    cuts = [int(v) for v in np.cumsum(sizes)[:-1]]
    q, kv, nsa_g, z_a, u, v, z_b, g_a, g_b = jnp.split(proj, cuts, axis=-1)
    q = rope(rms_norm(q.reshape(B, T, N_HEADS, HEAD_DIM), q_norm_g), pos)
    kv = kv.reshape(B, T, 2, 3, N_KV, HEAD_DIM)
    keys = rope(rms_norm(kv[:, :, 0], k_norm_g), pos)
    vals = kv[:, :, 1]
    vn = layer_norm(v, vnorm_g, vnorm_b)
    return gate, q, keys, vals, nsa_g, z_a, u, vn, z_b, g_a, g_b


def mixer_output(x, gate, o_c, o_s, o_w, nsa_g, z_a, u, s_b, z_b, g_a, g_b, w_br_a, w_br_b, w_out):
    B, T, _ = x.shape
    gw = jax.nn.sigmoid(nsa_g).reshape(B, T, N_HEADS, 3, 1)
    o_a = gw[:, :, :, 0] * o_c + gw[:, :, :, 1] * o_s + gw[:, :, :, 2] * o_w
    a = (o_a.reshape(B, T, WIDTH_A) * jax.nn.silu(z_a)) @ w_br_a
    b = (u * s_b * jax.nn.silu(z_b)) @ w_br_b
    m = jax.nn.sigmoid(g_a) * a + jax.nn.sigmoid(g_b) * b
    return x + gate[:, None] * (m @ w_out)


def prompt_layer(x, c, lw):
    (w_ada, b_ada, norm_g, w_in, q_norm_g, k_norm_g, pe_k, pe_v, w_ck, w_cv,
     vnorm_g, vnorm_b, w_s, b_s, w_br_a, w_br_b, w_out) = lw
    B, S, _ = x.shape
    pos = jnp.arange(S, dtype=jnp.int32)
    gate, q, keys, vals, nsa_g, z_a, u, vn, z_b, g_a, g_b = mixer_inputs(
        x, c, pos, w_ada, b_ada, norm_g, w_in, q_norm_g, k_norm_g, vnorm_g, vnorm_b)
    k_cmp, k_slc, k_win = keys[:, :, 0], keys[:, :, 1], keys[:, :, 2]
    v_cmp, v_slc, v_win = vals[:, :, 0], vals[:, :, 1], vals[:, :, 2]
    kc = compress(k_cmp, pe_k, w_ck)
    vc = compress(v_cmp, pe_v, w_cv)
    pad = ((0, 0), (WINDOW, 0), (0, 0), (0, 0))
    kw_pad, vw_pad = jnp.pad(k_win, pad), jnp.pad(v_win, pad)
    band = WINDOW + Q_BLOCK

    def block(i):
        start = i * Q_BLOCK
        qb = lax.dynamic_slice_in_dim(q, start, Q_BLOCK, axis=1)
        qpos = start + jnp.arange(Q_BLOCK, dtype=jnp.int32)
        kwb = lax.dynamic_slice_in_dim(kw_pad, start, band, axis=1)
        vwb = lax.dynamic_slice_in_dim(vw_pad, start, band, axis=1)
        kwpos = start - WINDOW + jnp.arange(band, dtype=jnp.int32)
        return nsa_core(qb, qpos, kc, vc, k_slc, v_slc, kwb, vwb, kwpos)

    outs = lax.map(block, jnp.arange(S // Q_BLOCK, dtype=jnp.int32))
    o_c, o_s, o_w = [o.transpose(1, 0, 2, 3, 4).reshape(B, S, N_HEADS, HEAD_DIM) for o in outs]
    s_b = spatial_mix(vn, w_s, b_s)
    y = mixer_output(x, gate, o_c, o_s, o_w, nsa_g, z_a, u, s_b, z_b, g_a, g_b, w_br_a, w_br_b, w_out)
    wb = min(WINDOW, S)
    return y, (k_cmp, v_cmp, k_slc, v_slc, k_win[:, S - wb:], v_win[:, S - wb:])


def sample_layer(x, c, caches, page_table, lw):
    (w_ada, b_ada, norm_g, w_in, q_norm_g, k_norm_g, pe_k, pe_v, w_ck, w_cv,
     vnorm_g, vnorm_b, w_s, b_s, w_br_a, w_br_b, w_out) = lw
    cache_k_cmp, cache_v_cmp, cache_k_slc, cache_v_slc, cache_k_win, cache_v_win = caches
    B, T_new, _ = x.shape
    past = page_table.shape[1] * PAGE_SIZE
    pos = past + jnp.arange(T_new, dtype=jnp.int32)
    gate, q, keys, vals, nsa_g, z_a, u, vn, z_b, g_a, g_b = mixer_inputs(
        x, c, pos, w_ada, b_ada, norm_g, w_in, q_norm_g, k_norm_g, vnorm_g, vnorm_b)
    k_cmp, k_slc, k_win = keys[:, :, 0], keys[:, :, 1], keys[:, :, 2]
    v_cmp, v_slc, v_win = vals[:, :, 0], vals[:, :, 1], vals[:, :, 2]
    total = past + T_new
    t_pad = -(-total // L_SLC) * L_SLC

    def full_rows(pool, new):
        rows = pool[page_table].reshape(B, past, N_KV, HEAD_DIM).astype(new.dtype)
        tail = jnp.zeros((B, t_pad - total, N_KV, HEAD_DIM), new.dtype)
        return jnp.concatenate([rows, new, tail], axis=1)

    kc = compress(full_rows(cache_k_cmp, k_cmp), pe_k, w_ck)
    vc = compress(full_rows(cache_v_cmp, v_cmp), pe_v, w_cv)
    ks_full = full_rows(cache_k_slc, k_slc)
    vs_full = full_rows(cache_v_slc, v_slc)
    wb = cache_k_win.shape[1]
    kw = jnp.concatenate([cache_k_win.astype(k_win.dtype), k_win], axis=1)
    vw = jnp.concatenate([cache_v_win.astype(v_win.dtype), v_win], axis=1)
    kwpos = past - wb + jnp.arange(wb + T_new, dtype=jnp.int32)
    o_c, o_s, o_w = nsa_core(q, pos, kc, vc, ks_full, vs_full, kw, vw, kwpos)
    s_b = spatial_mix(vn, w_s, b_s)
    y = mixer_output(x, gate, o_c, o_s, o_w, nsa_g, z_a, u, s_b, z_b, g_a, g_b, w_br_a, w_br_b, w_out)
    return y, (k_cmp, v_cmp, k_slc, v_slc, kw[:, T_new:], vw[:, T_new:], vn)


def setup_inputs(seed: int = 0) -> dict:
    key = jax.random.key(seed)
    ks = jax.random.split(key, 28)
    n_pages = PAST_LEN // PAGE_SIZE
    n_pool = (DEC_BATCH * n_pages * 5) // 4
    wb = min(WINDOW, PAST_LEN)

    def nrm(k, shape, s=1.0):
        return jax.random.normal(k, shape, jnp.float32) * s

    page_table = jax.random.permutation(ks[0], n_pool)[: DEC_BATCH * n_pages]
    page_table = page_table.reshape(DEC_BATCH, n_pages).astype(jnp.int32)
    paged = (DEPTH, n_pool, PAGE_SIZE, N_KV, HEAD_DIM)
    win = (DEPTH, DEC_BATCH, wb, N_KV, HEAD_DIM)
    return {
        'x_prompt': nrm(ks[1], (BATCH, SEQ, D_MODEL)),
        'x_sample': nrm(ks[2], (DEC_BATCH, DEC_SEQ, D_MODEL)),
        'cache_k_cmp': nrm(ks[3], paged),
        'cache_v_cmp': nrm(ks[4], paged),
        'cache_k_slc': nrm(ks[5], paged),
        'cache_v_slc': nrm(ks[6], paged),
        'cache_k_win': nrm(ks[7], win),
        'cache_v_win': nrm(ks[8], win),
        'page_table': page_table,
        'c_prompt': nrm(ks[9], (BATCH, D_MODEL)),
        'c_sample': nrm(ks[10], (DEC_BATCH, D_MODEL)),
        'w_ada': nrm(ks[11], (DEPTH, D_MODEL, 3 * D_MODEL), 0.5 * D_MODEL ** -0.5),
        'b_ada': nrm(ks[12], (DEPTH, 3 * D_MODEL), 0.02),
        'norm_g': 1.0 + nrm(ks[13], (DEPTH, D_MODEL), 0.02),
        'w_in': nrm(ks[14], (DEPTH, D_MODEL, D_IN), D_MODEL ** -0.5),
        'q_norm_g': 1.0 + nrm(ks[15], (DEPTH, HEAD_DIM), 0.02),
        'k_norm_g': 1.0 + nrm(ks[16], (DEPTH, HEAD_DIM), 0.02),
        'cmp_pos_k': nrm(ks[17], (DEPTH, L_CMP, HEAD_DIM), 0.1),
        'cmp_pos_v': nrm(ks[18], (DEPTH, L_CMP, HEAD_DIM), 0.1),
        'w_cmp_k': nrm(ks[19], (DEPTH, HEAD_DIM, HEAD_DIM), HEAD_DIM ** -0.5),
        'w_cmp_v': nrm(ks[20], (DEPTH, HEAD_DIM, HEAD_DIM), HEAD_DIM ** -0.5),
        'vnorm_g': 1.0 + nrm(ks[21], (DEPTH, WIDTH_B), 0.02),
        'vnorm_b': nrm(ks[22], (DEPTH, WIDTH_B), 0.02),
        'w_s': nrm(ks[23], (DEPTH, N_GROUPS_B, CHUNK, CHUNK), CHUNK ** -0.5),
        'b_s': 1.0 + nrm(ks[24], (DEPTH, N_GROUPS_B, CHUNK), 0.02),
        'w_br_a': nrm(ks[25], (DEPTH, WIDTH_A, D_MODEL), WIDTH_A ** -0.5),
        'w_br_b': nrm(ks[26], (DEPTH, WIDTH_B, D_MODEL), WIDTH_B ** -0.5),
        'w_out': nrm(ks[27], (DEPTH, D_MODEL, D_MODEL), D_MODEL ** -0.5),
    }


def reference(x_prompt, x_sample, cache_k_cmp, cache_v_cmp, cache_k_slc, cache_v_slc,
              cache_k_win, cache_v_win, page_table, c_prompt, c_sample,
              w_ada, b_ada, norm_g, w_in, q_norm_g, k_norm_g, cmp_pos_k, cmp_pos_v,
              w_cmp_k, w_cmp_v, vnorm_g, vnorm_b, w_s, b_s, w_br_a, w_br_b, w_out):
    xp, xs = x_prompt, x_sample
    p_states, s_states = [], []
    for l in range(DEPTH):
        lw = (w_ada[l], b_ada[l], norm_g[l], w_in[l], q_norm_g[l], k_norm_g[l], cmp_pos_k[l],
              cmp_pos_v[l], w_cmp_k[l], w_cmp_v[l], vnorm_g[l], vnorm_b[l], w_s[l], b_s[l],
              w_br_a[l], w_br_b[l], w_out[l])
        xp, st_p = prompt_layer(xp, c_prompt, lw)
        caches = (cache_k_cmp[l], cache_v_cmp[l], cache_k_slc[l], cache_v_slc[l],
                  cache_k_win[l], cache_v_win[l])
        xs, st_s = sample_layer(xs, c_sample, caches, page_table, lw)
        p_states.append(st_p)
        s_states.append(st_s)
    p_k_cmp, p_v_cmp, p_k_slc, p_v_slc, p_k_win, p_v_win = [jnp.stack(z) for z in zip(*p_states)]
    s_k_cmp, s_v_cmp, s_k_slc, s_v_slc, s_k_win, s_v_win, s_v_chunk = [jnp.stack(z) for z in zip(*s_states)]
    return (xp, xs, p_k_cmp, p_v_cmp, p_k_slc, p_v_slc, p_k_win, p_v_win,
            s_k_cmp, s_v_cmp, s_k_slc, s_v_slc, s_k_win, s_v_win, s_v_chunk)
```

```cpp
#include <hip/hip_runtime.h>
#include <hip/hip_cooperative_groups.h>
#include <cstdio>
#include <cstdint>
namespace cg = cooperative_groups;

#ifndef MK_N_LAUNCHES
#define MK_N_LAUNCHES 1
#endif

#define LAS __attribute__((address_space(3)))
typedef unsigned short bf16_t;
typedef short bf16x8 __attribute__((ext_vector_type(8)));
typedef short bf16x4 __attribute__((ext_vector_type(4)));
typedef float f32x4 __attribute__((ext_vector_type(4)));
typedef float f32x2 __attribute__((ext_vector_type(2)));
typedef unsigned u32x4 __attribute__((ext_vector_type(4)));
typedef unsigned u32x2 __attribute__((ext_vector_type(2)));

constexpr int DM = 1024, SEQ = 2048, NBATCH = 8, MP = NBATCH * SEQ, NSB = 128, MTOT = MP + NSB, MPAD = 16640;
constexpr int NIN = 5632;
constexpr int LQ = 0, LK = 512, LV = 896, LZA = 1280, LU = 1792, LVB = 2304, LZB = 2816, LGA = 3328, LGB = 4352, LNSA = 5376;
constexpr float C2Q = 0.125f * 1.4426950408889634f;
constexpr float NEGBIG = -1e30f, MINIT = -1e29f;
constexpr size_t O_YP = 0, O_YS = 16777216, O_PKC = 16908288, O_PVC = 19005440, O_PKS = 21102592, O_PVS = 23199744, O_PKW = 25296896, O_PVW = 25821184,
                 O_SKC = 26345472, O_SVC = 26361856, O_SKS = 26378240, O_SVS = 26394624, O_SKW = 26411008, O_SVW = 34799616, O_SVCH = 43188224, O_END = 43253760;
constexpr size_t MiB = 1u << 20;
constexpr size_t WS_ROPE = 0, WS_MOD = 1 * MiB, WS_WTIN = 3 * MiB, WS_WTBR = 14 * MiB, WS_WTOUT = 16 * MiB, WS_TRIL = 18 * MiB, WS_KC = 18 * MiB + 512 * 1024, WS_VCT = WS_KC + 128 * 1024,
                 WS_KCS = 19 * MiB, WS_VCS = 23 * MiB, WS_VT = 27 * MiB, WS_H = 40 * MiB, WS_AB = 73 * MiB, WS_ACT = 106 * MiB, WS_END = 285 * MiB;
constexpr int LDS_BYTES = 147456;

struct Params { const float* in[28]; float* out; unsigned char* ws; int ph_lo, ph_hi; };

__device__ __forceinline__ unsigned f2bf(float f) { unsigned u = __builtin_bit_cast(unsigned, f); return (u + 0x7fffu + ((u >> 16) & 1u)) >> 16; }
__device__ __forceinline__ unsigned pk2(float lo, float hi) { return f2bf(lo) | (f2bf(hi) << 16); }
__device__ __forceinline__ float bf2f(unsigned b) { return __builtin_bit_cast(float, (b & 0xffffu) << 16); }
__device__ __forceinline__ unsigned cvt_pk_bf16(float lo, float hi) { unsigned r; asm volatile("v_cvt_pk_bf16_f32 %0, %1, %2" : "=v"(r) : "v"(lo), "v"(hi)); return r; }
__device__ __forceinline__ float sigmoidf_(float x) { return 1.0f / (1.0f + __expf(-x)); }
__device__ __forceinline__ float wave_sum(float v) {
#pragma unroll
    for (int o = 1; o < 64; o <<= 1) v += __shfl_xor(v, o);
    return v;
}
__device__ __forceinline__ float wave_max(float v) {
#pragma unroll
    for (int o = 1; o < 64; o <<= 1) v = fmaxf(v, __shfl_xor(v, o));
    return v;
}
__device__ __forceinline__ void unpack4(u32x2 w, float (&f)[4]) { f[0] = bf2f(w.x); f[1] = bf2f(w.x >> 16); f[2] = bf2f(w.y); f[3] = bf2f(w.y >> 16); }

namespace pg8 {
constexpr int BM = 256, BK = 64, HALF = 128, HTB = HALF * BK * 2, STAGE_BYTES = 8 * HTB, NXCD = 8, WGM = 8;
__host__ __device__ __forceinline__ int lds_byte(int r, int c) { const int st = (r >> 4) * 2 + (c >> 5), rr = r & 15, cc = c & 31, ob = rr * 64 + cc * 2; return st * 1024 + (ob ^ (((ob >> 9) & 1) << 5)); }
__host__ __device__ __forceinline__ void stage_rc(int b, int& R, int& C) { const int st = b / 1024, sb = b % 1024, swz = sb ^ (((sb >> 9) & 1) << 5); R = (st >> 1) * 16 + swz / 64; C = (st & 1) * 32 + (swz % 64) / 2; }

struct Unit { int pm, pn, kofs, keep; };
struct Gemm { const bf16_t* A; const bf16_t* Bt; int lda, ldb, K; };

struct StaticOrder {
    int nM, nN, nwg, G, c;
    __device__ void init(int nM_, int nN_, int G_, int c_) { nM = nM_; nN = nN_; nwg = nM * nN; G = G_; c = c_; }
    __device__ bool tile(int i, int& pm, int& pn) const {
        const long L = (long)i * G + c; if (L >= nwg) return false;
        int wgid = (int)L; { const int q = nwg / NXCD, r = nwg % NXCD, xcd = wgid % NXCD, off = wgid / NXCD; wgid = (xcd < r ? xcd * (q + 1) : r * (q + 1) + (xcd - r) * q) + off; }
        const int nig = WGM * nN, gid = wgid / nig, fm = gid * WGM, gsz = (nM - fm) < WGM ? (nM - fm) : WGM;
        pm = fm + ((wgid % nig) % gsz); pn = (wgid % nig) / gsz; return true;
    }
    __device__ bool next(int i, Unit& u) const { u.kofs = 0; u.keep = 0; return tile(i, u.pm, u.pn); }
};
struct PairOrder {
    StaticOrder S;
    __device__ bool next(int i, Unit& u) const { u.kofs = (i & 1) * 512; u.keep = (i & 1) ? 0 : 1; return S.tile(i >> 1, u.pm, u.pn); }
};

template <class Epi, class Sched>
__device__ __forceinline__ void gemm_phase(LAS unsigned char* lds, const Gemm g, const Sched& S, const Epi& E) {
    const int tid = threadIdx.x, wid = __builtin_amdgcn_readfirstlane(tid >> 6), lane = tid & 63, wr = wid >> 2, wc = wid & 3, fr = lane & 15, fq = lane >> 4;
    const int nt = g.K / BK;
    unsigned voffA[2], voffB[2];
#pragma unroll
    for (int i = 0; i < 2; ++i) { int R, C; stage_rc(tid * 16 + i * 8192, R, C); voffA[i] = (unsigned)(R * g.lda + C) * 2u; voffB[i] = (unsigned)(R * g.ldb + C) * 2u; }
    const size_t kstep = (size_t)(BK * 2);
    const size_t hstepA = (size_t)HALF * g.lda * 2, hstepB = (size_t)HALF * g.ldb * 2, tstepA = 2 * hstepA, tstepB = 2 * hstepB;
    const unsigned ldsw = (unsigned)wid * 1024u;
    const int aoff = lds_byte(wr * 64 + fr, fq * 8), boff = lds_byte(wc * 32 + fr, fq * 8);
#define PG8_SA(b, h) (((b) * 2 + (h)) * HTB)
#define PG8_SB(b, h) ((4 + (b) * 2 + (h)) * HTB)
#define PG8_STAGE(bufoff, gbase, voff) do { _Pragma("unroll") for (int _i = 0; _i < 2; ++_i) \
        __builtin_amdgcn_global_load_lds((const unsigned*)((const char*)(gbase) + (voff)[_i]), (LAS unsigned*)(lds + (bufoff) + ldsw + _i * 8192), 16, 0, 0); } while (0)
#define PG8_LDA(dst, b, h) do { _Pragma("unroll") for (int m = 0; m < 4; ++m) _Pragma("unroll") for (int k = 0; k < 2; ++k) dst[m][k] = *(const LAS bf16x8*)(lds + PG8_SA(b, h) + aoff + m * 2048 + k * 1024); } while (0)
#define PG8_LDB(dst, b, h) do { _Pragma("unroll") for (int n = 0; n < 2; ++n) _Pragma("unroll") for (int k = 0; k < 2; ++k) dst[n][k] = *(const LAS bf16x8*)(lds + PG8_SB(b, h) + boff + n * 2048 + k * 1024); } while (0)
#define PG8_MMA(ai, bj, At, Bt) do { __builtin_amdgcn_s_setprio(1); _Pragma("unroll") for (int m = 0; m < 4; ++m) _Pragma("unroll") for (int n = 0; n < 2; ++n) _Pragma("unroll") for (int k = 0; k < 2; ++k) \
        acc[ai][bj][m][n] = __builtin_amdgcn_mfma_f32_16x16x32_bf16(Bt[n][k], At[m][k], acc[ai][bj][m][n], 0, 0, 0); __builtin_amdgcn_s_setprio(0); } while (0)
#define PG8_WAIT_V(n) asm volatile("s_waitcnt vmcnt(" #n ")" ::: "memory")
#define PG8_WAIT_L(n) asm volatile("s_waitcnt lgkmcnt(" #n ")" ::: "memory")
#define PG8_BAR __builtin_amdgcn_s_barrier()
#define PG8_SCHED __builtin_amdgcn_sched_barrier(0)
    Unit cur, nxt; int ui = 0;
    if (!S.next(0, cur)) return;
    f32x4 acc[2][2][4][2];
#pragma unroll
    for (int a = 0; a < 2; ++a)
#pragma unroll
        for (int b = 0; b < 2; ++b)
#pragma unroll
            for (int m = 0; m < 4; ++m)
#pragma unroll
                for (int n = 0; n < 2; ++n) acc[a][b][m][n] = (f32x4){0.f, 0.f, 0.f, 0.f};
    bf16x8 At[4][2], B0[2][2], B1[2][2];
    const char* cA = (const char*)g.A + (size_t)cur.pm * tstepA + (size_t)cur.kofs * 2; const char* cB = (const char*)g.Bt + (size_t)cur.pn * tstepB + (size_t)cur.kofs * 2;
    PG8_STAGE(PG8_SB(0, 0), cB, voffB); PG8_STAGE(PG8_SB(0, 1), cB + hstepB, voffB); PG8_STAGE(PG8_SA(0, 0), cA, voffA); PG8_STAGE(PG8_SA(0, 1), cA + hstepA, voffA);
    if (wr == 1) PG8_BAR;
    PG8_WAIT_V(2); PG8_BAR;
    PG8_STAGE(PG8_SB(1, 0), cB + kstep, voffB); PG8_STAGE(PG8_SA(1, 0), cA + kstep, voffA); PG8_STAGE(PG8_SB(1, 1), cB + hstepB + kstep, voffB);
    PG8_WAIT_V(6); PG8_BAR;
    for (;;) {
        const bool has_next = S.next(ui + 1, nxt);
        const char* nA = has_next ? (const char*)g.A + (size_t)nxt.pm * tstepA + (size_t)nxt.kofs * 2 : cA; const char* nB = has_next ? (const char*)g.Bt + (size_t)nxt.pn * tstepB + (size_t)nxt.kofs * 2 : cB;
        for (int t = 0; t < nt; t += 2) {
            const bool last = (t == nt - 2);
            const char* a1 = cA + (size_t)(t + 1) * kstep;
            const char* a2 = last ? nA : cA + (size_t)(t + 2) * kstep; const char* b2 = last ? nB : cB + (size_t)(t + 2) * kstep;
            const char* a3 = a2 + kstep; const char* b3 = b2 + kstep;
            PG8_LDB(B0, 0, 0); PG8_LDB(B1, 0, 1); PG8_SCHED; PG8_LDA(At, 0, 0); PG8_STAGE(PG8_SA(1, 1), a1 + hstepA, voffA);
            PG8_WAIT_V(8); PG8_WAIT_L(0); PG8_BAR; PG8_MMA(0, 0, At, B0); PG8_MMA(0, 1, At, B1); PG8_BAR; PG8_SCHED;
            PG8_LDA(At, 0, 1); PG8_STAGE(PG8_SB(0, 0), b2, voffB); PG8_STAGE(PG8_SB(0, 1), b2 + hstepB, voffB); PG8_STAGE(PG8_SA(0, 0), a2, voffA);
            PG8_WAIT_V(8); PG8_WAIT_L(0); PG8_BAR; PG8_MMA(1, 0, At, B0); PG8_MMA(1, 1, At, B1); PG8_BAR; PG8_SCHED;
            PG8_LDB(B0, 1, 0); PG8_LDB(B1, 1, 1); PG8_SCHED; PG8_LDA(At, 1, 0); PG8_STAGE(PG8_SA(0, 1), a2 + hstepA, voffA);
            PG8_WAIT_V(8); PG8_WAIT_L(0); PG8_BAR; PG8_MMA(0, 0, At, B0); PG8_MMA(0, 1, At, B1); PG8_BAR; PG8_SCHED;
            PG8_LDA(At, 1, 1); PG8_STAGE(PG8_SB(1, 0), b3, voffB); PG8_STAGE(PG8_SB(1, 1), b3 + hstepB, voffB); PG8_STAGE(PG8_SA(1, 0), a3, voffA);
            PG8_WAIT_V(8); PG8_WAIT_L(0); PG8_BAR; PG8_MMA(1, 0, At, B0); PG8_MMA(1, 1, At, B1); PG8_BAR; PG8_SCHED;
        }
        if (wr == 0) PG8_BAR;
        E(acc, cur, wr, wc, fr, fq);
        if (!has_next) break;
        if (!cur.keep) {
#pragma unroll
            for (int a = 0; a < 2; ++a)
#pragma unroll
                for (int b = 0; b < 2; ++b)
#pragma unroll
                    for (int m = 0; m < 4; ++m)
#pragma unroll
                        for (int n = 0; n < 2; ++n) acc[a][b][m][n] = (f32x4){0.f, 0.f, 0.f, 0.f};
        }
        cur = nxt; cA = nA; cB = nB; ++ui;
        if (wr == 1) PG8_BAR;
    }
    PG8_WAIT_V(0);
    PG8_BAR;
#undef PG8_SA
#undef PG8_SB
#undef PG8_STAGE
#undef PG8_LDA
#undef PG8_LDB
#undef PG8_MMA
#undef PG8_WAIT_V
#undef PG8_WAIT_L
#undef PG8_BAR
#undef PG8_SCHED
}
}

struct EpiInProj {
    bf16_t* ACT; bf16_t* VT; float* out; const float* qng; const float* kng; const float* rope;
    __device__ __forceinline__ void operator()(f32x4 (&acc)[2][2][4][2], const pg8::Unit& u, int wr, int wc, int fr, int fq) const {
        const int pn = u.pn;
        int type = 0, slot = 0;
        if (pn < 2) { type = 1; slot = 4 * pn + wc; }
        else if (pn == 2 || (pn == 3 && wc < 2)) { type = 2; slot = 4 * (pn - 2) + wc; }
        else if (pn == 3 || pn == 4) { type = 3; slot = 4 * (pn - 3) + wc - 2; }
        const int rbase = u.pm * 256 + wr * 64 + fr;
        if (type == 1 || type == 2) {
            const float* gn = (type == 1) ? qng : kng;
            f32x4 g4[2][2];
#pragma unroll
            for (int bj = 0; bj < 2; ++bj)
#pragma unroll
                for (int n = 0; n < 2; ++n) g4[bj][n] = *(const f32x4*)(gn + 32 * bj + 16 * n + 4 * fq);
            const int br = slot >> 1, kvh = slot & 1;
#pragma unroll
            for (int ai = 0; ai < 2; ++ai)
#pragma unroll
                for (int m = 0; m < 4; ++m) {
                    const int row = rbase + ai * 128 + m * 16;
                    float ss = 0.f;
#pragma unroll
                    for (int bj = 0; bj < 2; ++bj)
#pragma unroll
                        for (int n = 0; n < 2; ++n) { const f32x4 v = acc[ai][bj][m][n]; ss += (v[0] * v[0] + v[1] * v[1]) + (v[2] * v[2] + v[3] * v[3]); }
                    ss += __shfl_xor(ss, 16); ss += __shfl_xor(ss, 32);
                    const float rinv = rsqrtf(ss * (1.0f / 64.0f) + 1e-6f);
                    const int pos = (row < MP) ? (row & (SEQ - 1)) : SEQ;
                    const bool live = row < MTOT;
                    long obase = -1;
                    if (type == 2 && live) {
                        if (row < MP) {
                            const int t = row & (SEQ - 1), b = row >> 11;
                            if (br == 0) obase = (long)O_PKC + (long)row * 128 + kvh * 64;
                            else if (br == 1) obase = (long)O_PKS + (long)row * 128 + kvh * 64;
                            else if (t >= 1536) obase = (long)O_PKW + ((long)(b * 512 + t - 1536) * 2 + kvh) * 64;
                        } else {
                            const int sb = row - MP;
                            if (br == 0) obase = (long)O_SKC + sb * 128 + kvh * 64;
                            else if (br == 1) obase = (long)O_SKS + sb * 128 + kvh * 64;
                            else obase = (long)O_SKW + ((long)(sb * 512 + 511) * 2 + kvh) * 64;
                        }
                    }
#pragma unroll
                    for (int n = 0; n < 2; ++n) {
                        const f32x4 cs0 = *(const f32x4*)(rope + ((size_t)pos * 32 + 16 * n + 4 * fq) * 2);
                        const f32x4 cs1 = *(const f32x4*)(rope + ((size_t)pos * 32 + 16 * n + 4 * fq) * 2 + 4);
                        const float cc[4] = {cs0[0], cs0[2], cs1[0], cs1[2]}, sn[4] = {cs0[1], cs0[3], cs1[1], cs1[3]};
                        f32x4 o0, o1;
#pragma unroll
                        for (int j = 0; j < 4; ++j) {
                            const float y0 = acc[ai][0][m][n][j] * rinv * g4[0][n][j], y1 = acc[ai][1][m][n][j] * rinv * g4[1][n][j];
                            o0[j] = y0 * cc[j] - y1 * sn[j]; o1[j] = y1 * cc[j] + y0 * sn[j];
                        }
                        if (live) {
                            const int dcol = 16 * n + 4 * fq;
                            if (type == 1) {
                                bf16_t* p = ACT + (size_t)row * NIN + LQ + 64 * slot + dcol;
                                u32x2 w0, w1; w0.x = cvt_pk_bf16(o0[0] * C2Q, o0[1] * C2Q); w0.y = cvt_pk_bf16(o0[2] * C2Q, o0[3] * C2Q); w1.x = cvt_pk_bf16(o1[0] * C2Q, o1[1] * C2Q); w1.y = cvt_pk_bf16(o1[2] * C2Q, o1[3] * C2Q);
                                *(u32x2*)p = w0; *(u32x2*)(p + 32) = w1;
                            } else {
                                bf16_t* p = ACT + (size_t)row * NIN + LK + 64 * slot + dcol;
                                u32x2 w0, w1; w0.x = cvt_pk_bf16(o0[0], o0[1]); w0.y = cvt_pk_bf16(o0[2], o0[3]); w1.x = cvt_pk_bf16(o1[0], o1[1]); w1.y = cvt_pk_bf16(o1[2], o1[3]);
                                *(u32x2*)p = w0; *(u32x2*)(p + 32) = w1;
                                if (obase >= 0) { *(f32x4*)(out + obase + dcol) = o0; *(f32x4*)(out + obase + 32 + dcol) = o1; }
                            }
                        }
                    }
                }
        } else if (type == 3) {
            const int br = slot >> 1, kvh = slot & 1;
#pragma unroll
            for (int ai = 0; ai < 2; ++ai)
#pragma unroll
                for (int m = 0; m < 4; ++m) {
                    const int row = rbase + ai * 128 + m * 16;
                    if (row < MTOT) {
                        long obase = -1;
                        if (row < MP) {
                            const int t = row & (SEQ - 1), b = row >> 11;
                            if (br == 0) obase = (long)O_PVC + (long)row * 128 + kvh * 64;
                            else if (br == 1) obase = (long)O_PVS + (long)row * 128 + kvh * 64;
                            else if (t >= 1536) obase = (long)O_PVW + ((long)(b * 512 + t - 1536) * 2 + kvh) * 64;
                            bf16_t* vt = VT + ((size_t)(b * 6 + slot) * 64) * SEQ + t;
#pragma unroll
                            for (int bj = 0; bj < 2; ++bj)
#pragma unroll
                                for (int n = 0; n < 2; ++n)
#pragma unroll
                                    for (int j = 0; j < 4; ++j) vt[(size_t)(32 * bj + 16 * n + 4 * fq + j) * SEQ] = (bf16_t)f2bf(acc[ai][bj][m][n][j]);
                        } else {
                            const int sb = row - MP;
                            if (br == 0) obase = (long)O_SVC + sb * 128 + kvh * 64;
                            else if (br == 1) obase = (long)O_SVS + sb * 128 + kvh * 64;
                            else obase = (long)O_SVW + ((long)(sb * 512 + 511) * 2 + kvh) * 64;
                        }
                        if (obase >= 0) {
#pragma unroll
                            for (int bj = 0; bj < 2; ++bj)
#pragma unroll
                                for (int n = 0; n < 2; ++n) *(f32x4*)(out + obase + 32 * bj + 16 * n + 4 * fq) = acc[ai][bj][m][n];
                        }
                    }
                }
        } else {
            const int mode = (pn <= 6) ? 1 : (pn <= 10) ? 0 : (pn <= 12) ? 1 : 2;
#pragma unroll
            for (int ai = 0; ai < 2; ++ai)
#pragma unroll
                for (int m = 0; m < 4; ++m) {
                    const int row = rbase + ai * 128 + m * 16;
                    if (row < MTOT) {
                        bf16_t* p = ACT + (size_t)row * NIN + 256 * pn + 64 * wc + 4 * fq;
#pragma unroll
                        for (int bj = 0; bj < 2; ++bj)
#pragma unroll
                            for (int n = 0; n < 2; ++n) {
                                f32x4 v = acc[ai][bj][m][n];
#pragma unroll
                                for (int j = 0; j < 4; ++j) { const float sg = sigmoidf_(v[j]); v[j] = (mode == 0) ? v[j] : (mode == 1) ? v[j] * sg : sg; }
                                u32x2 w; w.x = cvt_pk_bf16(v[0], v[1]); w.y = cvt_pk_bf16(v[2], v[3]);
                                *(u32x2*)(p + 32 * bj + 16 * n) = w;
                            }
                    }
                }
        }
    }
};

struct EpiMix {
    const bf16_t* ACT; bf16_t* M;
    __device__ __forceinline__ void operator()(f32x4 (&acc)[2][2][4][2], const pg8::Unit& u, int wr, int wc, int fr, int fq) const {
        const int rbase = u.pm * 256 + wr * 64 + fr, cbase = u.pn * 256 + wc * 32 + 4 * fq;
#pragma unroll
        for (int ai = 0; ai < 2; ++ai)
#pragma unroll
            for (int m = 0; m < 4; ++m) {
                const int row = rbase + ai * 128 + m * 16;
                const bool live = row < MTOT;
                const int rr = live ? row : 0;
#pragma unroll
                for (int bj = 0; bj < 2; ++bj)
#pragma unroll
                    for (int n = 0; n < 2; ++n) {
                        const int col = cbase + 128 * bj + 16 * n;
                        float sb[4]; unpack4(*(const u32x2*)(ACT + (size_t)rr * NIN + LGB + col), sb);
                        if (u.keep) {
                            float sa[4]; unpack4(*(const u32x2*)(ACT + (size_t)rr * NIN + LGA + col), sa);
#pragma unroll
                            for (int j = 0; j < 4; ++j) acc[ai][bj][m][n][j] *= sa[j] * __builtin_amdgcn_rcpf(sb[j]);
                        } else if (live) {
                            const f32x4 v = acc[ai][bj][m][n];
                            u32x2 w; w.x = cvt_pk_bf16(v[0] * sb[0], v[1] * sb[1]); w.y = cvt_pk_bf16(v[2] * sb[2], v[3] * sb[3]);
                            *(u32x2*)(M + (size_t)row * DM + col) = w;
                        }
                    }
            }
    }
};

struct EpiOut {
    const float* xp; const float* xs; const float* MOD; float* out;
    __device__ __forceinline__ void operator()(f32x4 (&acc)[2][2][4][2], const pg8::Unit& u, int wr, int wc, int fr, int fq) const {
        const int rbase = u.pm * 256 + wr * 64 + fr, cbase = u.pn * 256 + wc * 32 + 4 * fq;
#pragma unroll
        for (int ai = 0; ai < 2; ++ai)
#pragma unroll
            for (int m = 0; m < 4; ++m) {
                const int row = rbase + ai * 128 + m * 16;
                if (row < MTOT) {
                    const float* xr; const float* gr; float* orow;
                    if (row < MP) { xr = xp + (size_t)row * DM; gr = MOD + (size_t)(row >> 11) * 3072 + 2048; orow = out + O_YP + (size_t)row * DM; }
                    else { const int sb = row - MP; xr = xs + (size_t)sb * DM; gr = MOD + (size_t)(8 + sb) * 3072 + 2048; orow = out + O_YS + (size_t)sb * DM; }
#pragma unroll
                    for (int bj = 0; bj < 2; ++bj)
#pragma unroll
                        for (int n = 0; n < 2; ++n) {
                            const int col = cbase + 128 * bj + 16 * n;
                            const f32x4 xv = *(const f32x4*)(xr + col), gv = *(const f32x4*)(gr + col);
                            *(f32x4*)(orow + col) = xv + gv * acc[ai][bj][m][n];
                        }
                }
            }
    }
};

__device__ __forceinline__ void transpose_item(const float* src, int src_ld, int nvalid, bf16_t* dst, int dst_ld, LAS float* scr, int lane) {
#pragma unroll 8
    for (int i = 0; i < 32; ++i) { const int kk = 2 * i + (lane >> 5), cc = lane & 31; scr[kk * 33 + cc] = (cc < nvalid) ? src[(size_t)kk * src_ld + cc] : 0.f; }
    asm volatile("s_waitcnt lgkmcnt(0)" ::: "memory");
    const int c = lane & 7;
#pragma unroll
    for (int j = 0; j < 4; ++j) { const int n = (lane >> 3) + 8 * j; const LAS float* s = scr + (8 * c) * 33 + n;
        u32x4 o; o.x = pk2(s[0 * 33], s[1 * 33]); o.y = pk2(s[2 * 33], s[3 * 33]); o.z = pk2(s[4 * 33], s[5 * 33]); o.w = pk2(s[6 * 33], s[7 * 33]);
        *(u32x4*)(dst + (size_t)n * dst_ld + 8 * c) = o; }
    asm volatile("s_waitcnt lgkmcnt(0)" ::: "memory");
}

__device__ __forceinline__ void p0_prologue(const Params& P, LAS unsigned char* lds, int gw, int NGW, int lane, int wave, int gtid, int NT) {
    unsigned char* ws = P.ws;
    LAS float* scr = (LAS float*)(lds + wave * 16384);
    constexpr int I_MOD = 17 * 48, I_WIN = 16 * 176, I_WBR = 16 * 32, I_WOUT = 16 * 32, I_POOL = NSB * 64 * 2;
    constexpr int I_TOTAL = I_MOD + I_WIN + I_WBR + I_WOUT + I_POOL;
    for (int it0 = gw; it0 < I_TOTAL; it0 += NGW) {
        int it = it0;
        if (it < I_MOD) {
            const int rg = it / 48, cb = it % 48, n = cb * 64 + lane;
            const float* cbase = (rg == 0) ? P.in[9] : P.in[10] + (size_t)(8 * rg - 8) * DM;
            const float* w = P.in[11] + n;
            float a[8];
#pragma unroll
            for (int r = 0; r < 8; ++r) a[r] = 0.f;
#pragma unroll 4
            for (int k = 0; k < DM; ++k) { const float wv = w[(size_t)k * 3072];
#pragma unroll
                for (int r = 0; r < 8; ++r) a[r] += cbase[r * DM + k] * wv; }
            const float bb = P.in[12][n];
            float* MOD = (float*)(ws + WS_MOD);
#pragma unroll
            for (int r = 0; r < 8; ++r) MOD[(size_t)(8 * rg + r) * 3072 + n] = a[r] + bb;
            continue;
        }
        it -= I_MOD;
        if (it < I_WIN) {
            const int kb = it / 176, nb = it % 176;
            const int pn = nb >> 3, bj = (nb >> 2) & 1, wc = nb & 3;
            const int L0 = 256 * pn + 64 * wc + 32 * bj;
            int srcc, nvalid;
            if (L0 < 1280) { srcc = L0; nvalid = 32; } else if (L0 < LNSA) { srcc = L0 + 24; nvalid = 32; } else if (L0 == LNSA) { srcc = 1280; nvalid = 24; } else { srcc = 0; nvalid = 0; }
            transpose_item(P.in[14] + (size_t)(64 * kb) * 5400 + srcc, 5400, nvalid, (bf16_t*)(ws + WS_WTIN) + (size_t)(32 * nb) * DM + 64 * kb, DM, scr, lane);
            continue;
        }
        it -= I_WIN;
        if (it < I_WBR) {
            const int kb = it / 32, nb = it % 32;
            const float* src = (kb < 8) ? P.in[25] + (size_t)(64 * kb) * DM : P.in[26] + (size_t)(64 * (kb - 8)) * DM;
            transpose_item(src + 32 * nb, DM, 32, (bf16_t*)(ws + WS_WTBR) + (size_t)(32 * nb) * DM + 64 * kb, DM, scr, lane);
            continue;
        }
        it -= I_WBR;
        if (it < I_WOUT) {
            const int kb = it / 32, nb = it % 32;
            transpose_item(P.in[27] + (size_t)(64 * kb) * DM + 32 * nb, DM, 32, (bf16_t*)(ws + WS_WTOUT) + (size_t)(32 * nb) * DM + 64 * kb, DM, scr, lane);
            continue;
        }
        it -= I_WOUT;
        {
            const int sb = it >> 7, c = (it >> 1) & 63, which = it & 1;
            const int page = ((const int*)P.in[8])[sb * 16 + (c >> 2)];
            const float* src = P.in[2 + which] + ((size_t)page * 128 + (c & 3) * 32) * 128;
            const float* pe = P.in[17 + which]; const float* w = P.in[19 + which];
            float s0 = 0.f, s1 = 0.f, p0 = 0.f, p1 = 0.f;
            const int d0 = (2 * lane) & 63;
#pragma unroll 8
            for (int r = 0; r < 32; ++r) { const f32x2 v = *(const f32x2*)(src + (size_t)r * 128 + 2 * lane); s0 += v[0]; s1 += v[1]; p0 += pe[r * 64 + d0]; p1 += pe[r * 64 + d0 + 1]; }
            scr[2 * lane] = (s0 + p0) * (1.0f / 32.0f); scr[2 * lane + 1] = (s1 + p1) * (1.0f / 32.0f);
            asm volatile("s_waitcnt lgkmcnt(0)" ::: "memory");
            float a0 = 0.f, a1 = 0.f;
#pragma unroll 8
            for (int d = 0; d < 64; ++d) { const float wv = w[d * 64 + lane]; a0 += scr[d] * wv; a1 += scr[64 + d] * wv; }
            float* dst = (float*)(ws + (which ? WS_VCS : WS_KCS));
            dst[((size_t)(sb * 2 + 0) * 64 + c) * 64 + lane] = a0; dst[((size_t)(sb * 2 + 1) * 64 + c) * 64 + lane] = a1;
            asm volatile("s_waitcnt lgkmcnt(0)" ::: "memory");
        }
    }
    float* rope = (float*)(ws + WS_ROPE);
    for (int i = gtid; i < 2049 * 32; i += NT) {
        const int pos = i >> 5, k = i & 31;
        const float inv = (float)exp(-(double)k * (1.0 / 32.0) * 9.210340371976184);
        const float ang = (float)pos * inv;
        rope[2 * i] = (float)cos((double)ang); rope[2 * i + 1] = (float)sin((double)ang);
    }
    bf16_t* tril = (bf16_t*)(ws + WS_TRIL);
    for (int i = gtid; i < 4 * 128 * 128; i += NT) { const int r = (i >> 7) & 127, cidx = i & 127; tril[i] = (cidx <= r) ? (bf16_t)f2bf(P.in[23][i]) : (bf16_t)0; }
    constexpr int PER_SB = 511 * 32;
    for (int w2 = 0; w2 < 2; ++w2) {
        const f32x4* src = (const f32x4*)P.in[6 + w2]; f32x4* dst = (f32x4*)(P.out + (w2 ? O_SVW : O_SKW));
        for (int i = gtid; i < NSB * PER_SB; i += NT) { const int sb = i / PER_SB, rr = i - sb * PER_SB; dst[(size_t)sb * 512 * 32 + rr] = src[(size_t)sb * 512 * 32 + 32 + rr]; }
    }
}

__device__ __forceinline__ void p1_hrows(const Params& P, int gw, int NGW, int lane) {
    const float* MOD = (const float*)(P.ws + WS_MOD); bf16_t* H = (bf16_t*)(P.ws + WS_H); const float* ng = P.in[13];
    for (int row = gw; row < MPAD; row += NGW) {
        unsigned long long* o8 = (unsigned long long*)(H + (size_t)row * DM) + lane;
        if (row >= MTOT) {
#pragma unroll
            for (int j = 0; j < 4; ++j) o8[64 * j] = 0ull;
            continue; }
        const float* xr; const float* md;
        if (row < MP) { xr = P.in[0] + (size_t)row * DM; md = MOD + (size_t)(row >> 11) * 3072; } else { xr = P.in[1] + (size_t)(row - MP) * DM; md = MOD + (size_t)(8 + row - MP) * 3072; }
        f32x4 v[4]; float s = 0.f;
#pragma unroll
        for (int j = 0; j < 4; ++j) { v[j] = ((const f32x4*)xr)[lane + 64 * j]; s += (v[j][0] * v[j][0] + v[j][1] * v[j][1]) + (v[j][2] * v[j][2] + v[j][3] * v[j][3]); }
        const float rstd = rsqrtf(wave_sum(s) * (1.0f / DM) + 1e-6f);
#pragma unroll
        for (int j = 0; j < 4; ++j) {
            const int col = 4 * lane + 256 * j;
            const f32x4 g = *(const f32x4*)(ng + col), sh = *(const f32x4*)(md + col), sc = *(const f32x4*)(md + 1024 + col);
            const f32x4 h = (v[j] * rstd) * g * (sc + 1.0f) + sh;
            o8[64 * j] = (unsigned long long)pk2(h[0], h[1]) | ((unsigned long long)pk2(h[2], h[3]) << 32);
        }
    }
}

__device__ __forceinline__ void p3_compress(const Params& P, LAS unsigned char* lds, int gw, int NGW, int lane, int wave) {
    LAS float* scr = (LAS float*)(lds + wave * 1024);
    for (int it = gw; it < NBATCH * 64 * 2 * 2; it += NGW) {
        const int b = it >> 8, c = (it >> 2) & 63, kvh = (it >> 1) & 1, which = it & 1;
        const float* src = P.out + (which ? O_PVC : O_PKC) + ((size_t)(b * SEQ + 32 * c) * 2 + kvh) * 64;
        const float* pe = P.in[17 + which]; const float* w = P.in[19 + which];
        float s = 0.f;
#pragma unroll 8
        for (int r = 0; r < 32; ++r) s += src[(size_t)r * 128 + lane] + pe[r * 64 + lane];
        scr[lane] = s * (1.0f / 32.0f);
        asm volatile("s_waitcnt lgkmcnt(0)" ::: "memory");
        float a = 0.f;
#pragma unroll 8
        for (int d = 0; d < 64; ++d) a += scr[d] * w[d * 64 + lane];
        if (which == 0) ((bf16_t*)(P.ws + WS_KC))[((size_t)(b * 64 + c) * 2 + kvh) * 64 + lane] = (bf16_t)f2bf(a);
        else ((bf16_t*)(P.ws + WS_VCT))[((size_t)(b * 2 + kvh) * 64 + lane) * 64 + c] = (bf16_t)f2bf(a);
        asm volatile("s_waitcnt lgkmcnt(0)" ::: "memory");
    }
}

constexpr int KPITCH = 72;
constexpr int A_KS = 0, A_VTS = 18432, A_IMP = 36864, A_IMPS = A_IMP + 8 * 32 * 33 * 4, A_SEL = A_IMPS + 2 * 32 * 33 * 4;

__device__ __forceinline__ void attn_load_tile(LAS unsigned char* lds, const bf16_t* kb, size_t kpitch, const bf16_t* vt0, const bf16_t* vt1, size_t vpitch, int tid_in) {
    int tid = tid_in; asm volatile("" : "+v"(tid));
    LAS bf16_t* Ks = (LAS bf16_t*)(lds + A_KS); LAS bf16_t* Vts = (LAS bf16_t*)(lds + A_VTS);
#pragma unroll
    for (int i = 0; i < 2; ++i) {
        const int idx = tid + 512 * i;
        { const int key = idx >> 4, ch = idx & 15; const u32x4 v = *(const u32x4*)(kb + (size_t)key * kpitch + ch * 8); *(LAS u32x4*)(Ks + ((ch >> 3) * 64 + key) * KPITCH + (ch & 7) * 8) = v; }
        { const int kvh = idx >> 9, d = (idx >> 3) & 63, ch = idx & 7; const u32x4 v = *(const u32x4*)((kvh ? vt1 : vt0) + (size_t)d * vpitch + ch * 8); *(LAS u32x4*)(Vts + (kvh * 64 + d) * KPITCH + ch * 8) = v; }
    }
}

template <int MODE>
__device__ __forceinline__ void attn_tile(const LAS bf16_t* Kg, const LAS bf16_t* Vg, const bf16x8 (&qf)[2][2], f32x4 (&O)[4][2], float (&mrun)[2], float (&lrun)[2], f32x4 (&s)[2][4],
                                          int lane_in, int kbase, const int (&qpos)[2], const unsigned (&selm)[2], int jblk) {
    int lane = lane_in; asm volatile("" : "+v"(lane));
    const int lr = lane & 15, grp = lane >> 4;
#pragma unroll
    for (int kt = 0; kt < 4; ++kt) {
        const bf16x8 k0 = *(const LAS bf16x8*)(Kg + (16 * kt + lr) * KPITCH + 8 * grp);
        const bf16x8 k1 = *(const LAS bf16x8*)(Kg + (16 * kt + lr) * KPITCH + 32 + 8 * grp);
#pragma unroll
        for (int qt = 0; qt < 2; ++qt) {
            f32x4 a = __builtin_amdgcn_mfma_f32_16x16x32_bf16(k0, qf[qt][0], (f32x4){0.f, 0.f, 0.f, 0.f}, 0, 0, 0);
            s[qt][kt] = __builtin_amdgcn_mfma_f32_16x16x32_bf16(k1, qf[qt][1], a, 0, 0, 0);
        }
        __builtin_amdgcn_sched_barrier(0);
    }
#pragma unroll
    for (int qt = 0; qt < 2; ++qt) {
        float mx = NEGBIG;
#pragma unroll
        for (int kt = 0; kt < 4; ++kt)
#pragma unroll
            for (int r = 0; r < 4; ++r) {
                const int key = 16 * kt + 4 * grp + r;
                bool valid;
                if (MODE == 0) valid = key < ((qpos[qt] + 1) >> 5);
                else if (MODE == 1) valid = ((selm[qt] >> jblk) & 1u) && (64 * jblk + key <= qpos[qt]);
                else { const int kp = kbase + key; valid = (kp <= qpos[qt]) && (kp > qpos[qt] - 512); }
                const float v = valid ? s[qt][kt][r] : NEGBIG;
                s[qt][kt][r] = v; mx = fmaxf(mx, v);
            }
        mx = fmaxf(mx, __shfl_xor(mx, 16)); mx = fmaxf(mx, __shfl_xor(mx, 32));
        const float mnew = fmaxf(mrun[qt], mx);
        const float alpha = __builtin_amdgcn_exp2f(mrun[qt] - mnew);
        mrun[qt] = mnew;
        float ls = 0.f;
#pragma unroll
        for (int kt = 0; kt < 4; ++kt)
#pragma unroll
            for (int r = 0; r < 4; ++r) { const float p = __builtin_amdgcn_exp2f(s[qt][kt][r] - mnew); s[qt][kt][r] = p; ls += p; }
        lrun[qt] = lrun[qt] * alpha + ls;
#pragma unroll
        for (int dt = 0; dt < 4; ++dt) O[dt][qt] *= alpha;
    }
#pragma unroll
    for (int c2 = 0; c2 < 2; ++c2) {
        bf16x8 pf[2];
#pragma unroll
        for (int qt = 0; qt < 2; ++qt) {
            u32x4 w; w.x = cvt_pk_bf16(s[qt][2 * c2][0], s[qt][2 * c2][1]); w.y = cvt_pk_bf16(s[qt][2 * c2][2], s[qt][2 * c2][3]);
            w.z = cvt_pk_bf16(s[qt][2 * c2 + 1][0], s[qt][2 * c2 + 1][1]); w.w = cvt_pk_bf16(s[qt][2 * c2 + 1][2], s[qt][2 * c2 + 1][3]);
            pf[qt] = __builtin_bit_cast(bf16x8, w);
        }
#pragma unroll
        for (int dt = 0; dt < 4; ++dt) {
            const u32x2 lo = *(const LAS u32x2*)(Vg + (16 * dt + lr) * KPITCH + 32 * c2 + 4 * grp);
            const u32x2 hi = *(const LAS u32x2*)(Vg + (16 * dt + lr) * KPITCH + 32 * c2 + 16 + 4 * grp);
            const u32x4 vv = {lo.x, lo.y, hi.x, hi.y};
            const bf16x8 vf = __builtin_bit_cast(bf16x8, vv);
#pragma unroll
            for (int qt = 0; qt < 2; ++qt) O[dt][qt] = __builtin_amdgcn_mfma_f32_16x16x32_bf16(vf, pf[qt], O[dt][qt], 0, 0, 0);
            __builtin_amdgcn_sched_barrier(0);
        }
    }
}

__device__ __forceinline__ void attn_unit(const Params& P, LAS unsigned char* lds, int b, int qb32, int tid, int lane, int wave) {
    const bf16_t* ACT = (const bf16_t*)(P.ws + WS_ACT); const bf16_t* VT = (const bf16_t*)(P.ws + WS_VT); bf16_t* AB = (bf16_t*)(P.ws + WS_AB);
    const int lr = lane & 15, grp = lane >> 4, g = wave >> 2;
    const int t0 = 32 * qb32, qblk = t0 >> 6; const size_t row0 = (size_t)b * SEQ + t0;
    const LAS bf16_t* Kg = (const LAS bf16_t*)(lds + A_KS) + g * 64 * KPITCH; const LAS bf16_t* Vg = (const LAS bf16_t*)(lds + A_VTS) + g * 64 * KPITCH;
    LAS float* IMP = (LAS float*)(lds + A_IMP); LAS float* IMPS = (LAS float*)(lds + A_IMPS); LAS unsigned* SEL = (LAS unsigned*)(lds + A_SEL);
    bf16x8 qf[2][2]; int qpos[2]; float gate[2][3];
#pragma unroll
    for (int qt = 0; qt < 2; ++qt) {
        const size_t row = row0 + 16 * qt + lr; qpos[qt] = t0 + 16 * qt + lr;
#pragma unroll
        for (int ks = 0; ks < 2; ++ks) qf[qt][ks] = *(const bf16x8*)(ACT + row * NIN + LQ + 64 * wave + 32 * ks + 8 * grp);
#pragma unroll
        for (int br = 0; br < 3; ++br) gate[qt][br] = bf2f(ACT[row * NIN + LNSA + 3 * wave + br]);
    }
    f32x4 O[4][2], OA[4][2], s[2][4]; float mrun[2], lrun[2]; unsigned selm[2] = {0u, 0u};
#pragma unroll
    for (int dt = 0; dt < 4; ++dt)
#pragma unroll
        for (int qt = 0; qt < 2; ++qt) { O[dt][qt] = (f32x4){0.f, 0.f, 0.f, 0.f}; OA[dt][qt] = (f32x4){0.f, 0.f, 0.f, 0.f}; }
    mrun[0] = mrun[1] = MINIT; lrun[0] = lrun[1] = 0.f;
#define ATT_FINISH(br) do { _Pragma("unroll") for (int qt = 0; qt < 2; ++qt) { float lt = lrun[qt]; lt += __shfl_xor(lt, 16); lt += __shfl_xor(lt, 32); \
        const float f = (lt > 0.f) ? gate[qt][br] / lt : 0.f; _Pragma("unroll") for (int dt = 0; dt < 4; ++dt) { OA[dt][qt] += O[dt][qt] * f; O[dt][qt] = (f32x4){0.f, 0.f, 0.f, 0.f}; } \
        mrun[qt] = MINIT; lrun[qt] = 0.f; } } while (0)
    __syncthreads();
    attn_load_tile(lds, (const bf16_t*)(P.ws + WS_KC) + (size_t)b * 64 * 128, 128, (const bf16_t*)(P.ws + WS_VCT) + (size_t)(b * 2) * 4096, (const bf16_t*)(P.ws + WS_VCT) + (size_t)(b * 2 + 1) * 4096, 64, tid);
    __syncthreads();
    attn_tile<0>(Kg, Vg, qf, O, mrun, lrun, s, lane, 0, qpos, selm, 0);
#pragma unroll
    for (int qt = 0; qt < 2; ++qt) {
        float lt = lrun[qt]; lt += __shfl_xor(lt, 16); lt += __shfl_xor(lt, 32);
        const float inv = (lt > 0.f) ? 1.0f / lt : 0.f;
#pragma unroll
        for (int kt = 0; kt < 4; ++kt)
#pragma unroll
            for (int rr = 0; rr < 2; ++rr) IMP[(wave * 32 + 16 * qt + lr) * 33 + 8 * kt + 2 * grp + rr] = (s[qt][kt][2 * rr] + s[qt][kt][2 * rr + 1]) * inv;
    }
    ATT_FINISH(0);
    __syncthreads();
    for (int i = tid; i < 2 * 32 * 32; i += 512) { const int gg = i >> 10, q = (i >> 5) & 31, j = i & 31;
        IMPS[(gg * 32 + q) * 33 + j] = (IMP[((4 * gg + 0) * 32 + q) * 33 + j] + IMP[((4 * gg + 1) * 32 + q) * 33 + j]) + (IMP[((4 * gg + 2) * 32 + q) * 33 + j] + IMP[((4 * gg + 3) * 32 + q) * 33 + j]); }
    __syncthreads();
    if (tid < 64) {
        const int gg = tid >> 5, q = tid & 31;
        unsigned mask = 1u | (1u << qblk);
        if (qblk - 1 <= 6) mask = (qblk >= 31) ? 0xffffffffu : ((2u << qblk) - 1u);
        else {
            const LAS float* v = IMPS + (gg * 32 + q) * 33;
            for (int pick = 0; pick < 6; ++pick) { float best = -1.f; int bi = 1;
                for (int j = 1; j < qblk; ++j) { const float x = v[j]; if (!((mask >> j) & 1u) && x > best) { best = x; bi = j; } }
                mask |= 1u << bi; }
        }
        SEL[gg * 32 + q] = mask;
    }
    __syncthreads();
    selm[0] = SEL[g * 32 + lr]; selm[1] = SEL[g * 32 + 16 + lr];
    for (int jb = 0; jb <= qblk; ++jb) {
        __syncthreads();
        attn_load_tile(lds, ACT + ((size_t)b * SEQ + 64 * jb) * NIN + LK + 128, NIN, VT + ((size_t)(b * 6 + 2) * 64) * SEQ + 64 * jb, VT + ((size_t)(b * 6 + 3) * 64) * SEQ + 64 * jb, SEQ, tid);
        __syncthreads();
        const bool any = __any((int)(((selm[0] | selm[1]) >> jb) & 1u));
        if (any) attn_tile<1>(Kg, Vg, qf, O, mrun, lrun, s, lane, 64 * jb, qpos, selm, jb);
    }
    ATT_FINISH(1);
    { const int lo = (t0 - 511 > 0) ? ((t0 - 511) >> 6) : 0;
      for (int jt = lo; jt <= qblk; ++jt) {
        __syncthreads();
        attn_load_tile(lds, ACT + ((size_t)b * SEQ + 64 * jt) * NIN + LK + 256, NIN, VT + ((size_t)(b * 6 + 4) * 64) * SEQ + 64 * jt, VT + ((size_t)(b * 6 + 5) * 64) * SEQ + 64 * jt, SEQ, tid);
        __syncthreads();
        attn_tile<2>(Kg, Vg, qf, O, mrun, lrun, s, lane, 64 * jt, qpos, selm, 0);
      } }
    ATT_FINISH(2);
#undef ATT_FINISH
#pragma unroll
    for (int qt = 0; qt < 2; ++qt) {
        const size_t row = row0 + 16 * qt + lr;
#pragma unroll
        for (int dt = 0; dt < 4; ++dt) {
            const int col = 64 * wave + 16 * dt + 4 * grp;
            float za[4]; unpack4(*(const u32x2*)(ACT + row * NIN + LZA + col), za);
            u32x2 w; w.x = cvt_pk_bf16(OA[dt][qt][0] * za[0], OA[dt][qt][1] * za[1]); w.y = cvt_pk_bf16(OA[dt][qt][2] * za[2], OA[dt][qt][3] * za[3]);
            *(u32x2*)(AB + row * DM + col) = w;
        }
    }
}

constexpr int G_ST = 0, G_VNT = 1024, VPITCH = 136;
__device__ __forceinline__ void gmlp_unit(const Params& P, LAS unsigned char* lds, int b, int ch, int g, int tid, int lane, int wave) {
    const bf16_t* ACT = (const bf16_t*)(P.ws + WS_ACT); bf16_t* AB = (bf16_t*)(P.ws + WS_AB); const bf16_t* tril = (const bf16_t*)(P.ws + WS_TRIL) + (size_t)g * 128 * 128;
    LAS f32x2* ST = (LAS f32x2*)(lds + G_ST); LAS bf16_t* Vnt = (LAS bf16_t*)(lds + G_VNT);
    const size_t R0 = (size_t)b * SEQ + 128 * ch;
    __syncthreads();
    for (int j = wave; j < 128; j += 8) {
        const u32x4 raw = *(const u32x4*)(ACT + (R0 + j) * NIN + LVB + 8 * lane);
        float f[8]; f[0] = bf2f(raw.x); f[1] = bf2f(raw.x >> 16); f[2] = bf2f(raw.y); f[3] = bf2f(raw.y >> 16); f[4] = bf2f(raw.z); f[5] = bf2f(raw.z >> 16); f[6] = bf2f(raw.w); f[7] = bf2f(raw.w >> 16);
        float sm = 0.f;
#pragma unroll
        for (int i = 0; i < 8; ++i) sm += f[i];
        const float mean = wave_sum(sm) * (1.0f / 512.0f);
        float sq = 0.f;
#pragma unroll
        for (int i = 0; i < 8; ++i) { const float d = f[i] - mean; sq += d * d; }
        const float rstd = rsqrtf(wave_sum(sq) * (1.0f / 512.0f) + 1e-6f);
        if (lane == 0) ST[j] = (f32x2){mean, rstd};
    }
    __syncthreads();
    const float* vg = P.in[21] + 128 * g; const float* vb = P.in[22] + 128 * g;
#pragma unroll
    for (int i = 0; i < 4; ++i) {
        const int idx = tid + 512 * i, j = idx & 127, chn = idx >> 7;
        const u32x4 raw = *(const u32x4*)(ACT + (R0 + j) * NIN + LVB + 128 * g + 8 * chn);
        const f32x2 st = ST[j];
        float f[8]; f[0] = bf2f(raw.x); f[1] = bf2f(raw.x >> 16); f[2] = bf2f(raw.y); f[3] = bf2f(raw.y >> 16); f[4] = bf2f(raw.z); f[5] = bf2f(raw.z >> 16); f[6] = bf2f(raw.w); f[7] = bf2f(raw.w >> 16);
#pragma unroll
        for (int e = 0; e < 8; ++e) { const int d = 8 * chn + e; Vnt[d * VPITCH + j] = (bf16_t)f2bf((f[e] - st[0]) * st[1] * vg[d] + vb[d]); }
    }
    __syncthreads();
    const int lr = lane & 15, grp = lane >> 4;
    f32x4 acc[8];
#pragma unroll
    for (int it = 0; it < 8; ++it) acc[it] = (f32x4){0.f, 0.f, 0.f, 0.f};
#pragma unroll
    for (int ks = 0; ks < 4; ++ks) {
        const bf16x8 af = *(const LAS bf16x8*)(Vnt + (16 * wave + lr) * VPITCH + 32 * ks + 8 * grp);
#pragma unroll
        for (int it = 0; it < 8; ++it) {
            if ((it >> 1) >= ks) { const bf16x8 bfr = *(const bf16x8*)(tril + (size_t)(16 * it + lr) * 128 + 32 * ks + 8 * grp);
                acc[it] = __builtin_amdgcn_mfma_f32_16x16x32_bf16(af, bfr, acc[it], 0, 0, 0); }
        }
    }
    const float* bs = P.in[24] + 128 * g;
#pragma unroll
    for (int it = 0; it < 8; ++it) {
        const int i = 16 * it + lr; const size_t row = R0 + i; const int d0 = 128 * g + 16 * wave + 4 * grp;
        const float bsi = bs[i];
        float uu[4], zb[4]; unpack4(*(const u32x2*)(ACT + row * NIN + LU + d0), uu); unpack4(*(const u32x2*)(ACT + row * NIN + LZB + d0), zb);
        u32x2 w; w.x = cvt_pk_bf16(uu[0] * (acc[it][0] + bsi) * zb[0], uu[1] * (acc[it][1] + bsi) * zb[1]); w.y = cvt_pk_bf16(uu[2] * (acc[it][2] + bsi) * zb[2], uu[3] * (acc[it][3] + bsi) * zb[3]);
        *(u32x2*)(AB + row * DM + 512 + d0) = w;
    }
}

constexpr int S_Q = 0, S_KT = 1024, S_VT = S_KT + 64 * 65 * 4, S_SC = S_VT + 64 * 64 * 4, S_OB = S_SC + 4 * 576 * 4, S_MISC = S_OB + 2 * 256 * 4;
__device__ __forceinline__ void sample_unit(const Params& P, LAS unsigned char* lds, int sb, int g, int tid, int lane, int wave) {
    const bf16_t* ACT = (const bf16_t*)(P.ws + WS_ACT); bf16_t* AB = (bf16_t*)(P.ws + WS_AB);
    LAS float* Qs = (LAS float*)(lds + S_Q); LAS float* Kt = (LAS float*)(lds + S_KT); LAS float* Vt = (LAS float*)(lds + S_VT); LAS float* SC = (LAS float*)(lds + S_SC);
    LAS float* OB = (LAS float*)(lds + S_OB); LAS float* MISC = (LAS float*)(lds + S_MISC); LAS int* SELB = (LAS int*)(lds + S_MISC) + 8;
    const size_t row = (size_t)MP + sb;
    const int* ptab = (const int*)P.in[8] + sb * 16;
    __syncthreads();
    const int h_t = (tid >> 6) & 3, d_t = tid & 63;
    if (tid < 256) Qs[tid] = bf2f(ACT[row * NIN + LQ + 64 * (4 * g + h_t) + d_t]);
    float oacc = 0.f;
    for (int br = 0; br < 3; ++br) {
        const int nkeys = (br == 0) ? 64 : (br == 1) ? 449 : 512, ntile = (nkeys + 63) >> 6;
#define SROW(KV, kk, ptr) do { const int _kk = (kk); ptr = nullptr; \
        if (br == 0) { ptr = (const float*)(P.ws + ((KV) ? WS_VCS : WS_KCS)) + ((size_t)(sb * 2 + g) * 64 + _kk) * 64; } \
        else if (br == 1) { if (_kk < 448) { const int blk = SELB[_kk >> 6], r_ = _kk & 63; const int page = ptab[blk >> 1]; ptr = P.in[4 + (KV)] + (((size_t)page * 128 + (blk & 1) * 64 + r_) * 2 + g) * 64; } \
                            else if (_kk == 448) ptr = P.out + ((KV) ? O_SVS : O_SKS) + (size_t)sb * 128 + g * 64; } \
        else { if (_kk < 511) ptr = P.in[6 + (KV)] + (((size_t)sb * 512 + 1 + _kk) * 2 + g) * 64; else if (_kk == 511) ptr = P.out + ((KV) ? O_SVW : O_SKW) + ((size_t)(sb * 512 + 511) * 2 + g) * 64; } } while (0)
        for (int tl = 0; tl < ntile; ++tl) {
            __syncthreads();
#pragma unroll
            for (int i = 0; i < 2; ++i) { const int idx = tid + 512 * i, key = idx >> 4, c4 = idx & 15; const float* ptr; SROW(0, tl * 64 + key, ptr);
                f32x4 v = (f32x4){0.f, 0.f, 0.f, 0.f}; if (ptr) v = *(const f32x4*)(ptr + 4 * c4);
                LAS float* dst = Kt + key * 65 + 4 * c4; dst[0] = v[0]; dst[1] = v[1]; dst[2] = v[2]; dst[3] = v[3]; }
            __syncthreads();
            if (tid < 256) { const int key = tid & 63, hh = tid >> 6; float sc = 0.f;
#pragma unroll 8
                for (int d = 0; d < 64; ++d) sc += Qs[hh * 64 + d] * Kt[key * 65 + d];
                const int kk = tl * 64 + key; SC[hh * 576 + kk] = (kk < nkeys) ? sc : NEGBIG; }
        }
        __syncthreads();
        if (wave < 4) {
            const int np = ntile * 64; float mx = NEGBIG;
            for (int kk = lane; kk < np; kk += 64) mx = fmaxf(mx, SC[wave * 576 + kk]);
            mx = wave_max(mx); float ls = 0.f;
            for (int kk = lane; kk < np; kk += 64) { const float p = __builtin_amdgcn_exp2f(SC[wave * 576 + kk] - mx); SC[wave * 576 + kk] = p; ls += p; }
            ls = wave_sum(ls); if (lane == 0) MISC[wave] = ls;
        }
        __syncthreads();
        if (br == 0) {
            if (tid < 32) { float im = 0.f;
#pragma unroll
                for (int hh = 0; hh < 4; ++hh) im += (SC[hh * 576 + 2 * tid] + SC[hh * 576 + 2 * tid + 1]) / MISC[hh];
                MISC[16 + tid] = im; }
            __syncthreads();
            if (tid == 0) { unsigned mask = 1u; SELB[0] = 0;
                for (int pick = 0; pick < 6; ++pick) { float best = -1.f; int bi = 1;
                    for (int j = 1; j < 32; ++j) { const float x = MISC[16 + j]; if (!((mask >> j) & 1u) && x > best) { best = x; bi = j; } }
                    mask |= 1u << bi; SELB[1 + pick] = bi; } }
            __syncthreads();
        }
        float o = 0.f;
        for (int tl = 0; tl < ntile; ++tl) {
            __syncthreads();
#pragma unroll
            for (int i = 0; i < 2; ++i) { const int idx = tid + 512 * i, key = idx >> 4, c4 = idx & 15; const float* ptr; SROW(1, tl * 64 + key, ptr);
                f32x4 v = (f32x4){0.f, 0.f, 0.f, 0.f}; if (ptr) v = *(const f32x4*)(ptr + 4 * c4);
                *(LAS f32x4*)(Vt + key * 64 + 4 * c4) = v; }
            __syncthreads();
            { const int half = tid >> 8;
#pragma unroll 8
              for (int k2 = 0; k2 < 32; ++k2) { const int key = half * 32 + k2; o += SC[h_t * 576 + tl * 64 + key] * Vt[key * 64 + d_t]; } }
        }
#undef SROW
        __syncthreads();
        OB[tid] = o;
        __syncthreads();
        if (tid < 256) { const float gt = bf2f(ACT[row * NIN + LNSA + 3 * (4 * g + h_t) + br]); oacc += gt * (OB[tid] + OB[256 + tid]) / MISC[h_t]; }
    }
    if (tid < 256) { const int col = 64 * (4 * g + h_t) + d_t; AB[row * DM + col] = (bf16_t)f2bf(oacc * bf2f(ACT[row * NIN + LZA + col])); }
    if (wave == 0) {
        const u32x4 raw = *(const u32x4*)(ACT + row * NIN + LVB + 8 * lane);
        float f[8]; f[0] = bf2f(raw.x); f[1] = bf2f(raw.x >> 16); f[2] = bf2f(raw.y); f[3] = bf2f(raw.y >> 16); f[4] = bf2f(raw.z); f[5] = bf2f(raw.z >> 16); f[6] = bf2f(raw.w); f[7] = bf2f(raw.w >> 16);
        float sm = 0.f;
#pragma unroll
        for (int i = 0; i < 8; ++i) sm += f[i];
        const float mean = wave_sum(sm) * (1.0f / 512.0f); float sq = 0.f;
#pragma unroll
        for (int i = 0; i < 8; ++i) { const float d = f[i] - mean; sq += d * d; }
        const float rstd = rsqrtf(wave_sum(sq) * (1.0f / 512.0f) + 1e-6f);
        if (lane == 0) { MISC[48] = mean; MISC[49] = rstd; }
    }
    __syncthreads();
    if (tid < 256) {
        const int d = 256 * g + tid, gm = d >> 7;
        const float vn = (bf2f(ACT[row * NIN + LVB + d]) - MISC[48]) * MISC[49] * P.in[21][d] + P.in[22][d];
        P.out[O_SVCH + (size_t)sb * 512 + d] = vn;
        const float sv = P.in[23][(size_t)gm * 128 * 128] * vn + P.in[24][gm * 128];
        AB[row * DM + 512 + d] = (bf16_t)f2bf(bf2f(ACT[row * NIN + LU + d]) * sv * bf2f(ACT[row * NIN + LZB + d]));
    }
}

__global__ void __launch_bounds__(512, 2) mk_fwd(Params P) {
    extern __shared__ __attribute__((aligned(16))) unsigned char lds_raw[];
    LAS unsigned char* lds = (LAS unsigned char*)lds_raw;
    const int tid = threadIdx.x, lane = tid & 63, wave = __builtin_amdgcn_readfirstlane(tid >> 6);
    const int G = gridDim.x, c = blockIdx.x, gw = c * 8 + wave, NGW = G * 8, gtid = c * 512 + tid, NT = G * 512;
    cg::grid_group grid = cg::this_grid();
    const int lo = P.ph_lo, hi = P.ph_hi;
#define IN(k) (lo <= (k) && (k) < hi)
#define SEAM(k) do { if (IN(k) && IN((k) + 1)) grid.sync(); } while (0)
    unsigned char* ws = P.ws;
    if (IN(0)) { p0_prologue(P, lds, gw, NGW, lane, wave, gtid, NT); }
    SEAM(0);
    if (IN(1)) { p1_hrows(P, gw, NGW, lane); }
    SEAM(1);
    if (IN(2)) {
        pg8::Gemm gm{(const bf16_t*)(ws + WS_H), (const bf16_t*)(ws + WS_WTIN), DM, DM, DM};
        pg8::StaticOrder S; S.init(MPAD / 256, NIN / 256, G, c);
        EpiInProj E{(bf16_t*)(ws + WS_ACT), (bf16_t*)(ws + WS_VT), P.out, P.in[15], P.in[16], (const float*)(ws + WS_ROPE)};
        pg8::gemm_phase<EpiInProj, pg8::StaticOrder>(lds, gm, S, E);
    }
    SEAM(2);
    if (IN(3)) { p3_compress(P, lds, gw, NGW, lane, wave); }
    SEAM(3);
    if (IN(4)) {
        for (int i = 0;; ++i) { const int a = (i & 1) ? (i + 1) * G - 1 - c : i * G + c; if (a >= 512 || a < 0) break; attn_unit(P, lds, a & 7, 63 - (a >> 3), tid, lane, wave); }
        for (int su = c; su < 2 * NSB; su += G) sample_unit(P, lds, su >> 1, su & 1, tid, lane, wave);
        for (int gu = c; gu < 512; gu += G) gmlp_unit(P, lds, gu >> 6, (gu >> 2) & 15, gu & 3, tid, lane, wave);
        __syncthreads();
    }
    SEAM(4);
    if (IN(5)) {
        pg8::Gemm gm{(const bf16_t*)(ws + WS_AB), (const bf16_t*)(ws + WS_WTBR), DM, DM, 512};
        pg8::PairOrder S; S.S.init(MPAD / 256, DM / 256, G, c);
        EpiMix E{(const bf16_t*)(ws + WS_ACT), (bf16_t*)(ws + WS_H)};
        pg8::gemm_phase<EpiMix, pg8::PairOrder>(lds, gm, S, E);
    }
    SEAM(5);
    if (IN(6)) {
        pg8::Gemm gm{(const bf16_t*)(ws + WS_H), (const bf16_t*)(ws + WS_WTOUT), DM, DM, DM};
        pg8::StaticOrder S; S.init(MPAD / 256, DM / 256, G, c);
        EpiOut E{P.in[0], P.in[1], (const float*)(ws + WS_MOD), P.out};
        pg8::gemm_phase<EpiOut, pg8::StaticOrder>(lds, gm, S, E);
    }
#undef IN
#undef SEAM
}

extern "C" void kernel_launch(void* const* d_in, const int* in_sizes, int n_in, void* d_out, int out_size, void* d_ws, size_t ws_size, hipStream_t stream) {
    static int grid = 0;
    if (grid == 0) {
        if (n_in != 28 || out_size != (int)O_END || ws_size < WS_END) { fprintf(stderr, "kernel_launch: unexpected shapes (n_in %d, out %d, ws %zu); nothing launched\n", n_in, out_size, ws_size); grid = -1; return; }
        int dev = 0, cus = 0, per_cu = 0;
        if (hipGetDevice(&dev) != hipSuccess || hipDeviceGetAttribute(&cus, hipDeviceAttributeMultiprocessorCount, dev) != hipSuccess) { grid = -1; return; }
        if (hipFuncSetAttribute((const void*)mk_fwd, hipFuncAttributeMaxDynamicSharedMemorySize, LDS_BYTES) != hipSuccess) { fprintf(stderr, "kernel_launch: hipFuncSetAttribute failed\n"); grid = -1; return; }
        if (hipOccupancyMaxActiveBlocksPerMultiprocessor(&per_cu, (const void*)mk_fwd, 512, LDS_BYTES) != hipSuccess || per_cu < 1) { fprintf(stderr, "kernel_launch: occupancy query failed (%d)\n", per_cu); (void)hipGetLastError(); per_cu = 1; }
        if (per_cu > 1) per_cu = 1;
        grid = cus * per_cu;
    }
    if (grid < 0) return;
    Params p{};
    for (int i = 0; i < 28; ++i) p.in[i] = (const float*)d_in[i];
    p.out = (float*)d_out; p.ws = (unsigned char*)d_ws;
#if MK_N_LAUNCHES == 1
    p.ph_lo = 0; p.ph_hi = 7;
    void* args[] = {&p};
    hipError_t e = hipLaunchCooperativeKernel((const void*)mk_fwd, dim3(grid), dim3(512), args, LDS_BYTES, stream);
    if (e != hipSuccess) fprintf(stderr, "kernel_launch: cooperative launch failed: %s (grid %d)\n", hipGetErrorString(e), grid);
#else
    for (int ph = 0; ph < 7; ++ph) {
        p.ph_lo = ph; p.ph_hi = ph + 1;
        void* args[] = {&p};
        hipError_t e = hipLaunchCooperativeKernel((const void*)mk_fwd, dim3(grid), dim3(512), args, LDS_BYTES, stream);
        if (e != hipSuccess) { fprintf(stderr, "kernel_launch: launch %d failed: %s (grid %d)\n", ph, hipGetErrorString(e), grid); break; }
    }
#endif
}
```

```cpp
#include <hip/hip_runtime.h>
#include <hip/hip_cooperative_groups.h>
#include <cstdio>
#include <cstdint>
namespace cg = cooperative_groups;

#ifndef MK_N_LAUNCHES
#define MK_N_LAUNCHES 1
#endif
#define MK_REP0 1
#define MK_REP1 1
#define MK_REP2 1
#define MK_REP3 1
#define MK_REP4 1
#define MK_REP5 1
#define MK_REP6 1

#define LAS __attribute__((address_space(3)))
typedef unsigned short bf16_t;
typedef short bf16x8 __attribute__((ext_vector_type(8)));
typedef short bf16x4 __attribute__((ext_vector_type(4)));
typedef float f32x4 __attribute__((ext_vector_type(4)));
typedef float f32x2 __attribute__((ext_vector_type(2)));
typedef unsigned u32x4 __attribute__((ext_vector_type(4)));
typedef unsigned u32x2 __attribute__((ext_vector_type(2)));

constexpr int DM = 1024, SEQ = 2048, NBATCH = 8, MP = NBATCH * SEQ, NSB = 128, MTOT = MP + NSB, MPAD = 16640;
constexpr int NIN = 5632;
constexpr int LQ = 0, LK = 512, LV = 896, LZA = 1280, LU = 1792, LVB = 2304, LZB = 2816, LGA = 3328, LGB = 4352, LNSA = 5376;
constexpr float C2Q = 0.125f * 1.4426950408889634f;
constexpr float NEGBIG = -1e30f, MINIT = -1e29f;
constexpr size_t O_YP = 0, O_YS = 16777216, O_PKC = 16908288, O_PVC = 19005440, O_PKS = 21102592, O_PVS = 23199744, O_PKW = 25296896, O_PVW = 25821184,
                 O_SKC = 26345472, O_SVC = 26361856, O_SKS = 26378240, O_SVS = 26394624, O_SKW = 26411008, O_SVW = 34799616, O_SVCH = 43188224, O_END = 43253760;
constexpr size_t MiB = 1u << 20;
constexpr size_t WS_ROPE = 0, WS_MOD = 1 * MiB, WS_WTIN = 3 * MiB, WS_WTBR = 14 * MiB, WS_WTOUT = 16 * MiB, WS_TRIL = 18 * MiB, WS_KC = 18 * MiB + 512 * 1024, WS_VCT = WS_KC + 128 * 1024,
                 WS_KCS = 19 * MiB, WS_VCS = 23 * MiB, WS_VT = 27 * MiB, WS_H = 40 * MiB, WS_AB = 73 * MiB, WS_ACT = 106 * MiB, WS_END = 285 * MiB;
constexpr size_t WS_CTL = 768 * 1024, CTL_BYTES = 16384;
constexpr int LDS_BYTES = 147456, LDS_XB = LDS_BYTES - 64;

struct Params { const float* in[28]; float* out; unsigned char* ws; int ph_lo, ph_hi; };

__device__ __forceinline__ unsigned f2bf(float f) { unsigned u = __builtin_bit_cast(unsigned, f); return (u + 0x7fffu + ((u >> 16) & 1u)) >> 16; }
__device__ __forceinline__ unsigned pk2(float lo, float hi) { return f2bf(lo) | (f2bf(hi) << 16); }
__device__ __forceinline__ float bf2f(unsigned b) { return __builtin_bit_cast(float, (b & 0xffffu) << 16); }
__device__ __forceinline__ unsigned cvt_pk_bf16(float lo, float hi) { unsigned r; asm volatile("v_cvt_pk_bf16_f32 %0, %1, %2" : "=v"(r) : "v"(lo), "v"(hi)); return r; }
__device__ __forceinline__ float sigmoidf_(float x) { return 1.0f / (1.0f + __expf(-x)); }
__device__ __forceinline__ float wave_sum(float v) {
#pragma unroll
    for (int o = 1; o < 64; o <<= 1) v += __shfl_xor(v, o);
    return v;
}
__device__ __forceinline__ float wave_max(float v) {
#pragma unroll
    for (int o = 1; o < 64; o <<= 1) v = fmaxf(v, __shfl_xor(v, o));
    return v;
}
__device__ __forceinline__ void unpack4(u32x2 w, float (&f)[4]) { f[0] = bf2f(w.x); f[1] = bf2f(w.x >> 16); f[2] = bf2f(w.y); f[3] = bf2f(w.y >> 16); }

namespace pg8 {
constexpr int BM = 256, BK = 64, HALF = 128, HTB = HALF * BK * 2, STAGE_BYTES = 8 * HTB, NXCD = 8, WGM = 8;
__host__ __device__ __forceinline__ int lds_byte(int r, int c) { const int st = (r >> 4) * 2 + (c >> 5), rr = r & 15, cc = c & 31, ob = rr * 64 + cc * 2; return st * 1024 + (ob ^ (((ob >> 9) & 1) << 5)); }
__host__ __device__ __forceinline__ void stage_rc(int b, int& R, int& C) { const int st = b / 1024, sb = b % 1024, swz = sb ^ (((sb >> 9) & 1) << 5); R = (st >> 1) * 16 + swz / 64; C = (st & 1) * 32 + (swz % 64) / 2; }

struct Unit { int pm, pn, kofs, keep; };
struct Gemm { const bf16_t* A; const bf16_t* Bt; int lda, ldb, K; };

struct StaticOrder {
    int nM, nN, nwg, G, c;
    __device__ void init(int nM_, int nN_, int G_, int c_) { nM = nM_; nN = nN_; nwg = nM * nN; G = G_; c = c_; }
    __device__ bool tile(int i, int& pm, int& pn) const {
        const long L = (long)i * G + c; if (L >= nwg) return false;
        int wgid = (int)L; { const int q = nwg / NXCD, r = nwg % NXCD, xcd = wgid % NXCD, off = wgid / NXCD; wgid = (xcd < r ? xcd * (q + 1) : r * (q + 1) + (xcd - r) * q) + off; }
        const int nig = WGM * nN, gid = wgid / nig, fm = gid * WGM, gsz = (nM - fm) < WGM ? (nM - fm) : WGM;
        pm = fm + ((wgid % nig) % gsz); pn = (wgid % nig) / gsz; return true;
    }
    __device__ bool next(int i, Unit& u) const { u.kofs = 0; u.keep = 0; return tile(i, u.pm, u.pn); }
};
struct PairOrder {
    StaticOrder S;
    __device__ bool next(int i, Unit& u) const { u.kofs = (i & 1) * 512; u.keep = (i & 1) ? 0 : 1; return S.tile(i >> 1, u.pm, u.pn); }
};

template <class Epi, class Sched>
__device__ __forceinline__ void gemm_phase(LAS unsigned char* lds, const Gemm g, const Sched& S, const Epi& E) {
    const int tid = threadIdx.x, wid = __builtin_amdgcn_readfirstlane(tid >> 6), lane = tid & 63, wr = wid >> 2, wc = wid & 3, fr = lane & 15, fq = lane >> 4;
    const int nt = g.K / BK;
    unsigned voffA[2], voffB[2];
#pragma unroll
    for (int i = 0; i < 2; ++i) { int R, C; stage_rc(tid * 16 + i * 8192, R, C); voffA[i] = (unsigned)(R * g.lda + C) * 2u; voffB[i] = (unsigned)(R * g.ldb + C) * 2u; }
    const size_t kstep = (size_t)(BK * 2);
    const size_t hstepA = (size_t)HALF * g.lda * 2, hstepB = (size_t)HALF * g.ldb * 2, tstepA = 2 * hstepA, tstepB = 2 * hstepB;
    const unsigned ldsw = (unsigned)wid * 1024u;
    const int aoff = lds_byte(wr * 64 + fr, fq * 8), boff = lds_byte(wc * 32 + fr, fq * 8);
#define PG8_SA(b, h) (((b) * 2 + (h)) * HTB)
#define PG8_SB(b, h) ((4 + (b) * 2 + (h)) * HTB)
#define PG8_STAGE(bufoff, gbase, voff) do { _Pragma("unroll") for (int _i = 0; _i < 2; ++_i) \
        __builtin_amdgcn_global_load_lds((const unsigned*)((const char*)(gbase) + (voff)[_i]), (LAS unsigned*)(lds + (bufoff) + ldsw + _i * 8192), 16, 0, 0); } while (0)
#define PG8_LDA(dst, b, h) do { _Pragma("unroll") for (int m = 0; m < 4; ++m) _Pragma("unroll") for (int k = 0; k < 2; ++k) dst[m][k] = *(const LAS bf16x8*)(lds + PG8_SA(b, h) + aoff + m * 2048 + k * 1024); } while (0)
#define PG8_LDB(dst, b, h) do { _Pragma("unroll") for (int n = 0; n < 2; ++n) _Pragma("unroll") for (int k = 0; k < 2; ++k) dst[n][k] = *(const LAS bf16x8*)(lds + PG8_SB(b, h) + boff + n * 2048 + k * 1024); } while (0)
#define PG8_MMA(ai, bj, At, Bt) do { __builtin_amdgcn_s_setprio(1); _Pragma("unroll") for (int m = 0; m < 4; ++m) _Pragma("unroll") for (int n = 0; n < 2; ++n) _Pragma("unroll") for (int k = 0; k < 2; ++k) \
        acc[ai][bj][m][n] = __builtin_amdgcn_mfma_f32_16x16x32_bf16(Bt[n][k], At[m][k], acc[ai][bj][m][n], 0, 0, 0); __builtin_amdgcn_s_setprio(0); } while (0)
#define PG8_WAIT_V(n) asm volatile("s_waitcnt vmcnt(" #n ")" ::: "memory")
#define PG8_WAIT_L(n) asm volatile("s_waitcnt lgkmcnt(" #n ")" ::: "memory")
#define PG8_BAR __builtin_amdgcn_s_barrier()
#define PG8_SCHED __builtin_amdgcn_sched_barrier(0)
    Unit cur, nxt; int ui = 0;
    if (!S.next(0, cur)) return;
    f32x4 acc[2][2][4][2];
#pragma unroll
    for (int a = 0; a < 2; ++a)
#pragma unroll
        for (int b = 0; b < 2; ++b)
#pragma unroll
            for (int m = 0; m < 4; ++m)
#pragma unroll
                for (int n = 0; n < 2; ++n) acc[a][b][m][n] = (f32x4){0.f, 0.f, 0.f, 0.f};
    bf16x8 At[4][2], B0[2][2], B1[2][2];
    const char* cA = (const char*)g.A + (size_t)cur.pm * tstepA + (size_t)cur.kofs * 2; const char* cB = (const char*)g.Bt + (size_t)cur.pn * tstepB + (size_t)cur.kofs * 2;
    PG8_STAGE(PG8_SB(0, 0), cB, voffB); PG8_STAGE(PG8_SB(0, 1), cB + hstepB, voffB); PG8_STAGE(PG8_SA(0, 0), cA, voffA); PG8_STAGE(PG8_SA(0, 1), cA + hstepA, voffA);
    if (wr == 1) PG8_BAR;
    PG8_WAIT_V(2); PG8_BAR;
    PG8_STAGE(PG8_SB(1, 0), cB + kstep, voffB); PG8_STAGE(PG8_SA(1, 0), cA + kstep, voffA); PG8_STAGE(PG8_SB(1, 1), cB + hstepB + kstep, voffB);
    PG8_WAIT_V(6); PG8_BAR;
    for (;;) {
        const bool has_next = S.next(ui + 1, nxt);
        const char* nA = has_next ? (const char*)g.A + (size_t)nxt.pm * tstepA + (size_t)nxt.kofs * 2 : cA; const char* nB = has_next ? (const char*)g.Bt + (size_t)nxt.pn * tstepB + (size_t)nxt.kofs * 2 : cB;
        for (int t = 0; t < nt; t += 2) {
            const bool last = (t == nt - 2);
            const char* a1 = cA + (size_t)(t + 1) * kstep;
            const char* a2 = last ? nA : cA + (size_t)(t + 2) * kstep; const char* b2 = last ? nB : cB + (size_t)(t + 2) * kstep;
            const char* a3 = a2 + kstep; const char* b3 = b2 + kstep;
            PG8_LDB(B0, 0, 0); PG8_LDB(B1, 0, 1); PG8_SCHED; PG8_LDA(At, 0, 0); PG8_STAGE(PG8_SA(1, 1), a1 + hstepA, voffA);
            PG8_WAIT_V(8); PG8_WAIT_L(0); PG8_BAR; PG8_MMA(0, 0, At, B0); PG8_MMA(0, 1, At, B1); PG8_BAR; PG8_SCHED;
            PG8_LDA(At, 0, 1); PG8_STAGE(PG8_SB(0, 0), b2, voffB); PG8_STAGE(PG8_SB(0, 1), b2 + hstepB, voffB); PG8_STAGE(PG8_SA(0, 0), a2, voffA);
            PG8_WAIT_V(8); PG8_WAIT_L(0); PG8_BAR; PG8_MMA(1, 0, At, B0); PG8_MMA(1, 1, At, B1); PG8_BAR; PG8_SCHED;
            PG8_LDB(B0, 1, 0); PG8_LDB(B1, 1, 1); PG8_SCHED; PG8_LDA(At, 1, 0); PG8_STAGE(PG8_SA(0, 1), a2 + hstepA, voffA);
            PG8_WAIT_V(8); PG8_WAIT_L(0); PG8_BAR; PG8_MMA(0, 0, At, B0); PG8_MMA(0, 1, At, B1); PG8_BAR; PG8_SCHED;
            PG8_LDA(At, 1, 1); PG8_STAGE(PG8_SB(1, 0), b3, voffB); PG8_STAGE(PG8_SB(1, 1), b3 + hstepB, voffB); PG8_STAGE(PG8_SA(1, 0), a3, voffA);
            PG8_WAIT_V(8); PG8_WAIT_L(0); PG8_BAR; PG8_MMA(1, 0, At, B0); PG8_MMA(1, 1, At, B1); PG8_BAR; PG8_SCHED;
        }
        if (wr == 0) PG8_BAR;
        E(acc, cur, wr, wc, fr, fq);
        if (!has_next) break;
        if (!cur.keep) {
#pragma unroll
            for (int a = 0; a < 2; ++a)
#pragma unroll
                for (int b = 0; b < 2; ++b)
#pragma unroll
                    for (int m = 0; m < 4; ++m)
#pragma unroll
                        for (int n = 0; n < 2; ++n) acc[a][b][m][n] = (f32x4){0.f, 0.f, 0.f, 0.f};
        }
        cur = nxt; cA = nA; cB = nB; ++ui;
        if (wr == 1) PG8_BAR;
    }
    PG8_WAIT_V(0);
    PG8_BAR;
#undef PG8_SA
#undef PG8_SB
#undef PG8_STAGE
#undef PG8_LDA
#undef PG8_LDB
#undef PG8_MMA
#undef PG8_WAIT_V
#undef PG8_WAIT_L
#undef PG8_BAR
#undef PG8_SCHED
}
}

struct EpiInProj {
    bf16_t* ACT; bf16_t* VT; float* out; const float* qng; const float* kng; const float* rope;
    __device__ __forceinline__ void operator()(f32x4 (&acc)[2][2][4][2], const pg8::Unit& u, int wr, int wc, int fr, int fq) const {
        const int pn = u.pn;
        int type = 0, slot = 0;
        if (pn < 2) { type = 1; slot = 4 * pn + wc; }
        else if (pn == 2 || (pn == 3 && wc < 2)) { type = 2; slot = 4 * (pn - 2) + wc; }
        else if (pn == 3 || pn == 4) { type = 3; slot = 4 * (pn - 3) + wc - 2; }
        const int rbase = u.pm * 256 + wr * 64 + fr;
        if (type == 1 || type == 2) {
            const float* gn = (type == 1) ? qng : kng;
            f32x4 g4[2][2];
#pragma unroll
            for (int bj = 0; bj < 2; ++bj)
#pragma unroll
                for (int n = 0; n < 2; ++n) g4[bj][n] = *(const f32x4*)(gn + 32 * bj + 16 * n + 4 * fq);
            const int br = slot >> 1, kvh = slot & 1;
#pragma unroll
            for (int ai = 0; ai < 2; ++ai)
#pragma unroll
                for (int m = 0; m < 4; ++m) {
                    const int row = rbase + ai * 128 + m * 16;
                    float ss = 0.f;
#pragma unroll
                    for (int bj = 0; bj < 2; ++bj)
#pragma unroll
                        for (int n = 0; n < 2; ++n) { const f32x4 v = acc[ai][bj][m][n]; ss += (v[0] * v[0] + v[1] * v[1]) + (v[2] * v[2] + v[3] * v[3]); }
                    ss += __shfl_xor(ss, 16); ss += __shfl_xor(ss, 32);
                    const float rinv = rsqrtf(ss * (1.0f / 64.0f) + 1e-6f);
                    const int pos = (row < MP) ? (row & (SEQ - 1)) : SEQ;
                    const bool live = row < MTOT;
                    long obase = -1;
                    if (type == 2 && live) {
                        if (row < MP) {
                            const int t = row & (SEQ - 1), b = row >> 11;
                            if (br == 0) obase = (long)O_PKC + (long)row * 128 + kvh * 64;
                            else if (br == 1) obase = (long)O_PKS + (long)row * 128 + kvh * 64;
                            else if (t >= 1536) obase = (long)O_PKW + ((long)(b * 512 + t - 1536) * 2 + kvh) * 64;
                        } else {
                            const int sb = row - MP;
                            if (br == 0) obase = (long)O_SKC + sb * 128 + kvh * 64;
                            else if (br == 1) obase = (long)O_SKS + sb * 128 + kvh * 64;
                            else obase = (long)O_SKW + ((long)(sb * 512 + 511) * 2 + kvh) * 64;
                        }
                    }
#pragma unroll
                    for (int n = 0; n < 2; ++n) {
                        const f32x4 cs0 = *(const f32x4*)(rope + ((size_t)pos * 32 + 16 * n + 4 * fq) * 2);
                        const f32x4 cs1 = *(const f32x4*)(rope + ((size_t)pos * 32 + 16 * n + 4 * fq) * 2 + 4);
                        const float cc[4] = {cs0[0], cs0[2], cs1[0], cs1[2]}, sn[4] = {cs0[1], cs0[3], cs1[1], cs1[3]};
                        f32x4 o0, o1;
#pragma unroll
                        for (int j = 0; j < 4; ++j) {
                            const float y0 = acc[ai][0][m][n][j] * rinv * g4[0][n][j], y1 = acc[ai][1][m][n][j] * rinv * g4[1][n][j];
                            o0[j] = y0 * cc[j] - y1 * sn[j]; o1[j] = y1 * cc[j] + y0 * sn[j];
                        }
                        if (live) {
                            const int dcol = 16 * n + 4 * fq;
                            if (type == 1) {
                                bf16_t* p = ACT + (size_t)row * NIN + LQ + 64 * slot + dcol;
                                u32x2 w0, w1; w0.x = cvt_pk_bf16(o0[0] * C2Q, o0[1] * C2Q); w0.y = cvt_pk_bf16(o0[2] * C2Q, o0[3] * C2Q); w1.x = cvt_pk_bf16(o1[0] * C2Q, o1[1] * C2Q); w1.y = cvt_pk_bf16(o1[2] * C2Q, o1[3] * C2Q);
                                *(u32x2*)p = w0; *(u32x2*)(p + 32) = w1;
                            } else {
                                bf16_t* p = ACT + (size_t)row * NIN + LK + 64 * slot + dcol;
                                u32x2 w0, w1; w0.x = cvt_pk_bf16(o0[0], o0[1]); w0.y = cvt_pk_bf16(o0[2], o0[3]); w1.x = cvt_pk_bf16(o1[0], o1[1]); w1.y = cvt_pk_bf16(o1[2], o1[3]);
                                *(u32x2*)p = w0; *(u32x2*)(p + 32) = w1;
                                if (obase >= 0) { *(f32x4*)(out + obase + dcol) = o0; *(f32x4*)(out + obase + 32 + dcol) = o1; }
                            }
                        }
                    }
                }
        } else if (type == 3) {
            const int br = slot >> 1, kvh = slot & 1;
#pragma unroll
            for (int ai = 0; ai < 2; ++ai)
#pragma unroll
                for (int m = 0; m < 4; ++m) {
                    const int row = rbase + ai * 128 + m * 16;
                    if (row < MTOT) {
                        long obase = -1;
                        if (row < MP) {
                            const int t = row & (SEQ - 1), b = row >> 11;
                            if (br == 0) obase = (long)O_PVC + (long)row * 128 + kvh * 64;
                            else if (br == 1) obase = (long)O_PVS + (long)row * 128 + kvh * 64;
                            else if (t >= 1536) obase = (long)O_PVW + ((long)(b * 512 + t - 1536) * 2 + kvh) * 64;
                            bf16_t* vt = VT + ((size_t)(b * 6 + slot) * 64) * SEQ + t;
#pragma unroll
                            for (int bj = 0; bj < 2; ++bj)
#pragma unroll
                                for (int n = 0; n < 2; ++n)
#pragma unroll
                                    for (int j = 0; j < 4; ++j) vt[(size_t)(32 * bj + 16 * n + 4 * fq + j) * SEQ] = (bf16_t)f2bf(acc[ai][bj][m][n][j]);
                        } else {
                            const int sb = row - MP;
                            if (br == 0) obase = (long)O_SVC + sb * 128 + kvh * 64;
                            else if (br == 1) obase = (long)O_SVS + sb * 128 + kvh * 64;
                            else obase = (long)O_SVW + ((long)(sb * 512 + 511) * 2 + kvh) * 64;
                        }
                        if (obase >= 0) {
#pragma unroll
                            for (int bj = 0; bj < 2; ++bj)
#pragma unroll
                                for (int n = 0; n < 2; ++n) *(f32x4*)(out + obase + 32 * bj + 16 * n + 4 * fq) = acc[ai][bj][m][n];
                        }
                    }
                }
        } else {
            const int mode = (pn <= 6) ? 1 : (pn <= 10) ? 0 : (pn <= 12) ? 1 : 2;
#pragma unroll
            for (int ai = 0; ai < 2; ++ai)
#pragma unroll
                for (int m = 0; m < 4; ++m) {
                    const int row = rbase + ai * 128 + m * 16;
                    if (row < MTOT) {
                        bf16_t* p = ACT + (size_t)row * NIN + 256 * pn + 64 * wc + 4 * fq;
#pragma unroll
                        for (int bj = 0; bj < 2; ++bj)
#pragma unroll
                            for (int n = 0; n < 2; ++n) {
                                f32x4 v = acc[ai][bj][m][n];
#pragma unroll
                                for (int j = 0; j < 4; ++j) { const float sg = sigmoidf_(v[j]); v[j] = (mode == 0) ? v[j] : (mode == 1) ? v[j] * sg : sg; }
                                u32x2 w; w.x = cvt_pk_bf16(v[0], v[1]); w.y = cvt_pk_bf16(v[2], v[3]);
                                *(u32x2*)(p + 32 * bj + 16 * n) = w;
                            }
                    }
                }
        }
    }
};

struct EpiMix {
    const bf16_t* ACT; bf16_t* M;
    __device__ __forceinline__ void operator()(f32x4 (&acc)[2][2][4][2], const pg8::Unit& u, int wr, int wc, int fr, int fq) const {
        const int rbase = u.pm * 256 + wr * 64 + fr, cbase = u.pn * 256 + wc * 32 + 4 * fq;
#pragma unroll
        for (int ai = 0; ai < 2; ++ai)
#pragma unroll
            for (int m = 0; m < 4; ++m) {
                const int row = rbase + ai * 128 + m * 16;
                const bool live = row < MTOT;
                const int rr = live ? row : 0;
#pragma unroll
                for (int bj = 0; bj < 2; ++bj)
#pragma unroll
                    for (int n = 0; n < 2; ++n) {
                        const int col = cbase + 128 * bj + 16 * n;
                        float sb[4]; unpack4(*(const u32x2*)(ACT + (size_t)rr * NIN + LGB + col), sb);
                        if (u.keep) {
                            float sa[4]; unpack4(*(const u32x2*)(ACT + (size_t)rr * NIN + LGA + col), sa);
#pragma unroll
                            for (int j = 0; j < 4; ++j) acc[ai][bj][m][n][j] *= sa[j] * __builtin_amdgcn_rcpf(sb[j]);
                        } else if (live) {
                            const f32x4 v = acc[ai][bj][m][n];
                            u32x2 w; w.x = cvt_pk_bf16(v[0] * sb[0], v[1] * sb[1]); w.y = cvt_pk_bf16(v[2] * sb[2], v[3] * sb[3]);
                            *(u32x2*)(M + (size_t)row * DM + col) = w;
                        }
                    }
            }
    }
};

struct EpiOut {
    const float* xp; const float* xs; const float* MOD; float* out;
    __device__ __forceinline__ void operator()(f32x4 (&acc)[2][2][4][2], const pg8::Unit& u, int wr, int wc, int fr, int fq) const {
        const int rbase = u.pm * 256 + wr * 64 + fr, cbase = u.pn * 256 + wc * 32 + 4 * fq;
#pragma unroll
        for (int ai = 0; ai < 2; ++ai)
#pragma unroll
            for (int m = 0; m < 4; ++m) {
                const int row = rbase + ai * 128 + m * 16;
                if (row < MTOT) {
                    const float* xr; const float* gr; float* orow;
                    if (row < MP) { xr = xp + (size_t)row * DM; gr = MOD + (size_t)(row >> 11) * 3072 + 2048; orow = out + O_YP + (size_t)row * DM; }
                    else { const int sb = row - MP; xr = xs + (size_t)sb * DM; gr = MOD + (size_t)(8 + sb) * 3072 + 2048; orow = out + O_YS + (size_t)sb * DM; }
#pragma unroll
                    for (int bj = 0; bj < 2; ++bj)
#pragma unroll
                        for (int n = 0; n < 2; ++n) {
                            const int col = cbase + 128 * bj + 16 * n;
                            const f32x4 xv = *(const f32x4*)(xr + col), gv = *(const f32x4*)(gr + col);
                            *(f32x4*)(orow + col) = xv + gv * acc[ai][bj][m][n];
                        }
                }
            }
    }
};

__device__ __forceinline__ void transpose_item(const float* src, int src_ld, int nvalid, bf16_t* dst, int dst_ld, LAS float* scr, int lane) {
#pragma unroll 8
    for (int i = 0; i < 32; ++i) { const int kk = 2 * i + (lane >> 5), cc = lane & 31; scr[kk * 33 + cc] = (cc < nvalid) ? src[(size_t)kk * src_ld + cc] : 0.f; }
    asm volatile("s_waitcnt lgkmcnt(0)" ::: "memory");
    const int c = lane & 7;
#pragma unroll
    for (int j = 0; j < 4; ++j) { const int n = (lane >> 3) + 8 * j; const LAS float* s = scr + (8 * c) * 33 + n;
        u32x4 o; o.x = pk2(s[0 * 33], s[1 * 33]); o.y = pk2(s[2 * 33], s[3 * 33]); o.z = pk2(s[4 * 33], s[5 * 33]); o.w = pk2(s[6 * 33], s[7 * 33]);
        *(u32x4*)(dst + (size_t)n * dst_ld + 8 * c) = o; }
    asm volatile("s_waitcnt lgkmcnt(0)" ::: "memory");
}

__device__ __forceinline__ void p0_prologue(const Params& P, LAS unsigned char* lds, int gw, int NGW, int lane, int wave, int gtid, int NT) {
    unsigned char* ws = P.ws;
    LAS float* scr = (LAS float*)(lds + wave * 16384);
    constexpr int I_MOD = 9 * 48, I_WIN = 16 * 176, I_WBR = 16 * 32, I_WOUT = 16 * 32, I_POOL = NSB * 64 * 2;
    constexpr int I_TOTAL = I_MOD + I_WIN + I_WBR + I_WOUT + I_POOL;
    for (int it0 = gw; it0 < I_TOTAL; it0 += NGW) {
        int it = it0;
        if (it < I_MOD) {
            const int mt = it / 48, ng = it % 48, lr = lane & 15, kq = lane >> 4;
            int arow_i = 16 * mt + lr; if (arow_i > 135) arow_i = 135;
            const float* arow = ((arow_i < 8) ? P.in[9] + (size_t)arow_i * DM : P.in[10] + (size_t)(arow_i - 8) * DM) + kq;
            const float* bp = P.in[11] + (size_t)kq * 3072 + 64 * ng + lr;
            f32x4 macc[4];
#pragma unroll
            for (int nt = 0; nt < 4; ++nt) macc[nt] = (f32x4){0.f, 0.f, 0.f, 0.f};
#pragma unroll 8
            for (int k0 = 0; k0 < DM; k0 += 4) {
                const float a = arow[k0];
#pragma unroll
                for (int nt = 0; nt < 4; ++nt) macc[nt] = __builtin_amdgcn_mfma_f32_16x16x4f32(a, bp[(size_t)k0 * 3072 + 16 * nt], macc[nt], 0, 0, 0);
            }
            float* MOD = (float*)(ws + WS_MOD);
#pragma unroll
            for (int nt = 0; nt < 4; ++nt) { const int n = 64 * ng + 16 * nt + lr; const float bb = P.in[12][n];
#pragma unroll
                for (int r = 0; r < 4; ++r) { const int row = 16 * mt + 4 * kq + r; if (row < 136) MOD[(size_t)row * 3072 + n] = macc[nt][r] + bb; } }
            continue;
        }
        it -= I_MOD;
        if (it < I_WIN) {
            const int kb = it / 176, nb = it % 176;
            const int pn = nb >> 3, bj = (nb >> 2) & 1, wc = nb & 3;
            const int L0 = 256 * pn + 64 * wc + 32 * bj;
            int srcc, nvalid;
            if (L0 < 1280) { srcc = L0; nvalid = 32; } else if (L0 < LNSA) { srcc = L0 + 24; nvalid = 32; } else if (L0 == LNSA) { srcc = 1280; nvalid = 24; } else { srcc = 0; nvalid = 0; }
            transpose_item(P.in[14] + (size_t)(64 * kb) * 5400 + srcc, 5400, nvalid, (bf16_t*)(ws + WS_WTIN) + (size_t)(32 * nb) * DM + 64 * kb, DM, scr, lane);
            continue;
        }
        it -= I_WIN;
        if (it < I_WBR) {
            const int kb = it / 32, nb = it % 32;
            const float* src = (kb < 8) ? P.in[25] + (size_t)(64 * kb) * DM : P.in[26] + (size_t)(64 * (kb - 8)) * DM;
            transpose_item(src + 32 * nb, DM, 32, (bf16_t*)(ws + WS_WTBR) + (size_t)(32 * nb) * DM + 64 * kb, DM, scr, lane);
            continue;
        }
        it -= I_WBR;
        if (it < I_WOUT) {
            const int kb = it / 32, nb = it % 32;
            transpose_item(P.in[27] + (size_t)(64 * kb) * DM + 32 * nb, DM, 32, (bf16_t*)(ws + WS_WTOUT) + (size_t)(32 * nb) * DM + 64 * kb, DM, scr, lane);
            continue;
        }
        it -= I_WOUT;
        {
            const int sb = it >> 7, c = (it >> 1) & 63, which = it & 1;
            const int page = ((const int*)P.in[8])[sb * 16 + (c >> 2)];
            const float* src = P.in[2 + which] + ((size_t)page * 128 + (c & 3) * 32) * 128;
            const float* pe = P.in[17 + which]; const float* w = P.in[19 + which];
            float s0 = 0.f, s1 = 0.f, p0 = 0.f, p1 = 0.f;
            const int d0 = (2 * lane) & 63;
#pragma unroll 8
            for (int r = 0; r < 32; ++r) { const f32x2 v = *(const f32x2*)(src + (size_t)r * 128 + 2 * lane); s0 += v[0]; s1 += v[1]; p0 += pe[r * 64 + d0]; p1 += pe[r * 64 + d0 + 1]; }
            scr[2 * lane] = (s0 + p0) * (1.0f / 32.0f); scr[2 * lane + 1] = (s1 + p1) * (1.0f / 32.0f);
            asm volatile("s_waitcnt lgkmcnt(0)" ::: "memory");
            float a0 = 0.f, a1 = 0.f;
#pragma unroll 8
            for (int d = 0; d < 64; ++d) { const float wv = w[d * 64 + lane]; a0 += scr[d] * wv; a1 += scr[64 + d] * wv; }
            float* dst = (float*)(ws + (which ? WS_VCS : WS_KCS));
            dst[((size_t)(sb * 2 + 0) * 64 + c) * 64 + lane] = a0; dst[((size_t)(sb * 2 + 1) * 64 + c) * 64 + lane] = a1;
            asm volatile("s_waitcnt lgkmcnt(0)" ::: "memory");
        }
    }
    float* rope = (float*)(ws + WS_ROPE);
    for (int i = gtid; i < 2049 * 32; i += NT) {
        const int pos = i >> 5, k = i & 31;
        const float inv = (float)exp(-(double)k * (1.0 / 32.0) * 9.210340371976184);
        const float ang = (float)pos * inv;
        rope[2 * i] = (float)cos((double)ang); rope[2 * i + 1] = (float)sin((double)ang);
    }
    bf16_t* tril = (bf16_t*)(ws + WS_TRIL);
    for (int i = gtid; i < 4 * 128 * 128; i += NT) { const int r = (i >> 7) & 127, cidx = i & 127; tril[i] = (cidx <= r) ? (bf16_t)f2bf(P.in[23][i]) : (bf16_t)0; }
    constexpr int PER_SB = 511 * 32;
    for (int w2 = 0; w2 < 2; ++w2) {
        const f32x4* src = (const f32x4*)P.in[6 + w2]; f32x4* dst = (f32x4*)(P.out + (w2 ? O_SVW : O_SKW));
        for (int i = gtid; i < NSB * PER_SB; i += NT) { const int sb = i / PER_SB, rr = i - sb * PER_SB; dst[(size_t)sb * 512 * 32 + rr] = src[(size_t)sb * 512 * 32 + 32 + rr]; }
    }
}

__device__ __forceinline__ void p1_hrows(const Params& P, int gw, int NGW, int lane) {
    const float* MOD = (const float*)(P.ws + WS_MOD); bf16_t* H = (bf16_t*)(P.ws + WS_H); const float* ng = P.in[13];
    for (int row = gw; row < MPAD; row += NGW) {
        unsigned long long* o8 = (unsigned long long*)(H + (size_t)row * DM) + lane;
        if (row >= MTOT) {
#pragma unroll
            for (int j = 0; j < 4; ++j) o8[64 * j] = 0ull;
            continue; }
        const float* xr; const float* md;
        if (row < MP) { xr = P.in[0] + (size_t)row * DM; md = MOD + (size_t)(row >> 11) * 3072; } else { xr = P.in[1] + (size_t)(row - MP) * DM; md = MOD + (size_t)(8 + row - MP) * 3072; }
        f32x4 v[4]; float s = 0.f;
#pragma unroll
        for (int j = 0; j < 4; ++j) { v[j] = ((const f32x4*)xr)[lane + 64 * j]; s += (v[j][0] * v[j][0] + v[j][1] * v[j][1]) + (v[j][2] * v[j][2] + v[j][3] * v[j][3]); }
        const float rstd = rsqrtf(wave_sum(s) * (1.0f / DM) + 1e-6f);
#pragma unroll
        for (int j = 0; j < 4; ++j) {
            const int col = 4 * lane + 256 * j;
            const f32x4 g = *(const f32x4*)(ng + col), sh = *(const f32x4*)(md + col), sc = *(const f32x4*)(md + 1024 + col);
            const f32x4 h = (v[j] * rstd) * g * (sc + 1.0f) + sh;
            o8[64 * j] = (unsigned long long)pk2(h[0], h[1]) | ((unsigned long long)pk2(h[2], h[3]) << 32);
        }
    }
}

__device__ __forceinline__ void p3_compress(const Params& P, LAS unsigned char* lds, int gw, int NGW, int lane, int wave) {
    LAS float* scr = (LAS float*)(lds + wave * 1024);
    for (int it = gw; it < NBATCH * 64 * 2 * 2; it += NGW) {
        const int b = it >> 8, c = (it >> 2) & 63, kvh = (it >> 1) & 1, which = it & 1;
        const float* src = P.out + (which ? O_PVC : O_PKC) + ((size_t)(b * SEQ + 32 * c) * 2 + kvh) * 64;
        const float* pe = P.in[17 + which]; const float* w = P.in[19 + which];
        float s = 0.f;
#pragma unroll 8
        for (int r = 0; r < 32; ++r) s += src[(size_t)r * 128 + lane] + pe[r * 64 + lane];
        scr[lane] = s * (1.0f / 32.0f);
        asm volatile("s_waitcnt lgkmcnt(0)" ::: "memory");
        float a = 0.f;
#pragma unroll 8
        for (int d = 0; d < 64; ++d) a += scr[d] * w[d * 64 + lane];
        if (which == 0) ((bf16_t*)(P.ws + WS_KC))[((size_t)(b * 64 + c) * 2 + kvh) * 64 + lane] = (bf16_t)f2bf(a);
        else ((bf16_t*)(P.ws + WS_VCT))[((size_t)(b * 2 + kvh) * 64 + lane) * 64 + c] = (bf16_t)f2bf(a);
        asm volatile("s_waitcnt lgkmcnt(0)" ::: "memory");
    }
}

constexpr int KPITCH = 72;
constexpr int A_KS = 0, A_VTS = 18432, A_IMP = 36864, A_IMPS = A_IMP + 8 * 32 * 33 * 4, A_SEL = A_IMPS + 2 * 32 * 33 * 4, A_OA = A_SEL + 256;
static_assert(A_OA + 8 * 8192 <= LDS_BYTES, "attention LDS map");

__device__ __forceinline__ void attn_load_tile(LAS unsigned char* lds, const bf16_t* kb, size_t kpitch, const bf16_t* vt0, const bf16_t* vt1, size_t vpitch, int tid_in) {
    int tid = tid_in; asm volatile("" : "+v"(tid));
    LAS bf16_t* Ks = (LAS bf16_t*)(lds + A_KS); LAS bf16_t* Vts = (LAS bf16_t*)(lds + A_VTS);
#pragma unroll
    for (int i = 0; i < 2; ++i) {
        const int idx = tid + 512 * i;
        { const int key = idx >> 4, ch = idx & 15; const u32x4 v = *(const u32x4*)(kb + (size_t)key * kpitch + ch * 8); *(LAS u32x4*)(Ks + ((ch >> 3) * 64 + key) * KPITCH + (ch & 7) * 8) = v; }
        { const int kvh = idx >> 9, d = (idx >> 3) & 63, ch = idx & 7; const u32x4 v = *(const u32x4*)((kvh ? vt1 : vt0) + (size_t)d * vpitch + ch * 8); *(LAS u32x4*)(Vts + (kvh * 64 + d) * KPITCH + ch * 8) = v; }
    }
}

template <int MODE>
__device__ __forceinline__ void attn_tile(const LAS bf16_t* Kg, const LAS bf16_t* Vg, const bf16x8 (&qf)[2][2], f32x4 (&O)[4][2], float (&mrun)[2], float (&lrun)[2], f32x4 (&s)[2][4],
                                          int lane_in, int kbase, const int (&qpos)[2], const unsigned (&selm)[2], int jblk) {
    int lane = lane_in; asm volatile("" : "+v"(lane));
    const int lr = lane & 15, grp = lane >> 4;
#pragma unroll
    for (int kt = 0; kt < 4; ++kt) {
        const bf16x8 k0 = *(const LAS bf16x8*)(Kg + (16 * kt + lr) * KPITCH + 8 * grp);
        const bf16x8 k1 = *(const LAS bf16x8*)(Kg + (16 * kt + lr) * KPITCH + 32 + 8 * grp);
#pragma unroll
        for (int qt = 0; qt < 2; ++qt) {
            f32x4 a = __builtin_amdgcn_mfma_f32_16x16x32_bf16(k0, qf[qt][0], (f32x4){0.f, 0.f, 0.f, 0.f}, 0, 0, 0);
            s[qt][kt] = __builtin_amdgcn_mfma_f32_16x16x32_bf16(k1, qf[qt][1], a, 0, 0, 0);
        }
        __builtin_amdgcn_sched_barrier(0);
    }
#pragma unroll
    for (int qt = 0; qt < 2; ++qt) {
        float mx = NEGBIG;
#pragma unroll
        for (int kt = 0; kt < 4; ++kt)
#pragma unroll
            for (int r = 0; r < 4; ++r) {
                const int key = 16 * kt + 4 * grp + r;
                bool valid;
                if (MODE == 0) valid = key < ((qpos[qt] + 1) >> 5);
                else if (MODE == 1) valid = ((selm[qt] >> jblk) & 1u) && (64 * jblk + key <= qpos[qt]);
                else { const int kp = kbase + key; valid = (kp <= qpos[qt]) && (kp > qpos[qt] - 512); }
                const float v = valid ? s[qt][kt][r] : NEGBIG;
                s[qt][kt][r] = v; mx = fmaxf(mx, v);
            }
        mx = fmaxf(mx, __shfl_xor(mx, 16)); mx = fmaxf(mx, __shfl_xor(mx, 32));
        const float mnew = fmaxf(mrun[qt], mx);
        const float alpha = __builtin_amdgcn_exp2f(mrun[qt] - mnew);
        mrun[qt] = mnew;
        float ls = 0.f;
#pragma unroll
        for (int kt = 0; kt < 4; ++kt)
#pragma unroll
            for (int r = 0; r < 4; ++r) { const float p = __builtin_amdgcn_exp2f(s[qt][kt][r] - mnew); s[qt][kt][r] = p; ls += p; }
        lrun[qt] = lrun[qt] * alpha + ls;
#pragma unroll
        for (int dt = 0; dt < 4; ++dt) O[dt][qt] *= alpha;
    }
#pragma unroll
    for (int c2 = 0; c2 < 2; ++c2) {
        bf16x8 pf[2];
#pragma unroll
        for (int qt = 0; qt < 2; ++qt) {
            u32x4 w; w.x = cvt_pk_bf16(s[qt][2 * c2][0], s[qt][2 * c2][1]); w.y = cvt_pk_bf16(s[qt][2 * c2][2], s[qt][2 * c2][3]);
            w.z = cvt_pk_bf16(s[qt][2 * c2 + 1][0], s[qt][2 * c2 + 1][1]); w.w = cvt_pk_bf16(s[qt][2 * c2 + 1][2], s[qt][2 * c2 + 1][3]);
            pf[qt] = __builtin_bit_cast(bf16x8, w);
        }
#pragma unroll
        for (int dt = 0; dt < 4; ++dt) {
            const u32x2 lo = *(const LAS u32x2*)(Vg + (16 * dt + lr) * KPITCH + 32 * c2 + 4 * grp);
            const u32x2 hi = *(const LAS u32x2*)(Vg + (16 * dt + lr) * KPITCH + 32 * c2 + 16 + 4 * grp);
            const u32x4 vv = {lo.x, lo.y, hi.x, hi.y};
            const bf16x8 vf = __builtin_bit_cast(bf16x8, vv);
#pragma unroll
            for (int qt = 0; qt < 2; ++qt) O[dt][qt] = __builtin_amdgcn_mfma_f32_16x16x32_bf16(vf, pf[qt], O[dt][qt], 0, 0, 0);
            __builtin_amdgcn_sched_barrier(0);
        }
    }
}

__device__ __forceinline__ void attn_unit(const Params& P, LAS unsigned char* lds, int b, int qb32, int tid, int lane, int wave) {
    asm volatile("" : "+v"(tid), "+v"(lane));
    const bf16_t* ACT = (const bf16_t*)(P.ws + WS_ACT); const bf16_t* VT = (const bf16_t*)(P.ws + WS_VT); bf16_t* AB = (bf16_t*)(P.ws + WS_AB);
    const int lr = lane & 15, grp = lane >> 4, g = wave >> 2;
    const int t0 = 32 * qb32, qblk = t0 >> 6; const size_t row0 = (size_t)b * SEQ + t0;
    const LAS bf16_t* Kg = (const LAS bf16_t*)(lds + A_KS) + g * 64 * KPITCH; const LAS bf16_t* Vg = (const LAS bf16_t*)(lds + A_VTS) + g * 64 * KPITCH;
    LAS float* IMP = (LAS float*)(lds + A_IMP); LAS float* IMPS = (LAS float*)(lds + A_IMPS); LAS unsigned* SEL = (LAS unsigned*)(lds + A_SEL);
    bf16x8 qf[2][2]; int qpos[2]; float gate[2][3];
#pragma unroll
    for (int qt = 0; qt < 2; ++qt) {
        const size_t row = row0 + 16 * qt + lr; qpos[qt] = t0 + 16 * qt + lr;
#pragma unroll
        for (int ks = 0; ks < 2; ++ks) qf[qt][ks] = *(const bf16x8*)(ACT + row * NIN + LQ + 64 * wave + 32 * ks + 8 * grp);
#pragma unroll
        for (int br = 0; br < 3; ++br) gate[qt][br] = bf2f(ACT[row * NIN + LNSA + 3 * wave + br]);
    }
    f32x4 O[4][2], s[2][4]; float mrun[2], lrun[2]; unsigned selm[2] = {0u, 0u};
    LAS float* OAl = (LAS float*)(lds + A_OA) + wave * 2048 + lane;
#pragma unroll
    for (int dt = 0; dt < 4; ++dt)
#pragma unroll
        for (int qt = 0; qt < 2; ++qt) O[dt][qt] = (f32x4){0.f, 0.f, 0.f, 0.f};
    mrun[0] = mrun[1] = MINIT; lrun[0] = lrun[1] = 0.f;
#define ATT_FINISH(br) do { _Pragma("unroll") for (int qt = 0; qt < 2; ++qt) { float lt = lrun[qt]; lt += __shfl_xor(lt, 16); lt += __shfl_xor(lt, 32); \
        const float f = (lt > 0.f) ? gate[qt][br] / lt : 0.f; _Pragma("unroll") for (int dt = 0; dt < 4; ++dt) _Pragma("unroll") for (int r = 0; r < 4; ++r) { \
            float v = O[dt][qt][r] * f; if ((br) > 0) v += OAl[64 * ((dt * 2 + qt) * 4 + r)]; if ((br) < 2) { OAl[64 * ((dt * 2 + qt) * 4 + r)] = v; O[dt][qt][r] = 0.f; } else O[dt][qt][r] = v; } \
        mrun[qt] = MINIT; lrun[qt] = 0.f; } } while (0)
    __syncthreads();
    attn_load_tile(lds, (const bf16_t*)(P.ws + WS_KC) + (size_t)b * 64 * 128, 128, (const bf16_t*)(P.ws + WS_VCT) + (size_t)(b * 2) * 4096, (const bf16_t*)(P.ws + WS_VCT) + (size_t)(b * 2 + 1) * 4096, 64, tid);
    __syncthreads();
    attn_tile<0>(Kg, Vg, qf, O, mrun, lrun, s, lane, 0, qpos, selm, 0);
#pragma unroll
    for (int qt = 0; qt < 2; ++qt) {
        float lt = lrun[qt]; lt += __shfl_xor(lt, 16); lt += __shfl_xor(lt, 32);
        const float inv = (lt > 0.f) ? 1.0f / lt : 0.f;
#pragma unroll
        for (int kt = 0; kt < 4; ++kt)
#pragma unroll
            for (int rr = 0; rr < 2; ++rr) IMP[(wave * 32 + 16 * qt + lr) * 33 + 8 * kt + 2 * grp + rr] = (s[qt][kt][2 * rr] + s[qt][kt][2 * rr + 1]) * inv;
    }
    ATT_FINISH(0);
    __syncthreads();
    for (int i = tid; i < 2 * 32 * 32; i += 512) { const int gg = i >> 10, q = (i >> 5) & 31, j = i & 31;
        IMPS[(gg * 32 + q) * 33 + j] = (IMP[((4 * gg + 0) * 32 + q) * 33 + j] + IMP[((4 * gg + 1) * 32 + q) * 33 + j]) + (IMP[((4 * gg + 2) * 32 + q) * 33 + j] + IMP[((4 * gg + 3) * 32 + q) * 33 + j]); }
    __syncthreads();
    if (tid < 64) {
        const int gg = tid >> 5, q = tid & 31;
        unsigned mask = 1u | (1u << qblk);
        if (qblk - 1 <= 6) mask = (qblk >= 31) ? 0xffffffffu : ((2u << qblk) - 1u);
        else {
            const LAS float* v = IMPS + (gg * 32 + q) * 33;
            for (int pick = 0; pick < 6; ++pick) { float best = -1.f; int bi = 1;
                for (int j = 1; j < qblk; ++j) { const float x = v[j]; if (!((mask >> j) & 1u) && x > best) { best = x; bi = j; } }
                mask |= 1u << bi; }
        }
        SEL[gg * 32 + q] = mask;
    }
    __syncthreads();
    selm[0] = SEL[g * 32 + lr]; selm[1] = SEL[g * 32 + 16 + lr];
    for (int jb = 0; jb <= qblk; ++jb) {
        __syncthreads();
        attn_load_tile(lds, ACT + ((size_t)b * SEQ + 64 * jb) * NIN + LK + 128, NIN, VT + ((size_t)(b * 6 + 2) * 64) * SEQ + 64 * jb, VT + ((size_t)(b * 6 + 3) * 64) * SEQ + 64 * jb, SEQ, tid);
        __syncthreads();
        const bool any = __any((int)(((selm[0] | selm[1]) >> jb) & 1u));
        if (any) attn_tile<1>(Kg, Vg, qf, O, mrun, lrun, s, lane, 64 * jb, qpos, selm, jb);
    }
    ATT_FINISH(1);
    { const int lo = (t0 - 511 > 0) ? ((t0 - 511) >> 6) : 0;
      for (int jt = lo; jt <= qblk; ++jt) {
        __syncthreads();
        attn_load_tile(lds, ACT + ((size_t)b * SEQ + 64 * jt) * NIN + LK + 256, NIN, VT + ((size_t)(b * 6 + 4) * 64) * SEQ + 64 * jt, VT + ((size_t)(b * 6 + 5) * 64) * SEQ + 64 * jt, SEQ, tid);
        __syncthreads();
        attn_tile<2>(Kg, Vg, qf, O, mrun, lrun, s, lane, 64 * jt, qpos, selm, 0);
      } }
    ATT_FINISH(2);
#undef ATT_FINISH
#pragma unroll
    for (int qt = 0; qt < 2; ++qt) {
        const size_t row = row0 + 16 * qt + lr;
#pragma unroll
        for (int dt = 0; dt < 4; ++dt) {
            const int col = 64 * wave + 16 * dt + 4 * grp;
            float za[4]; unpack4(*(const u32x2*)(ACT + row * NIN + LZA + col), za);
            u32x2 w; w.x = cvt_pk_bf16(O[dt][qt][0] * za[0], O[dt][qt][1] * za[1]); w.y = cvt_pk_bf16(O[dt][qt][2] * za[2], O[dt][qt][3] * za[3]);
            *(u32x2*)(AB + row * DM + col) = w;
        }
    }
}

constexpr int G_ST = 0, G_VNT = 1024, VPITCH = 136;
__device__ __forceinline__ void gmlp_unit(const Params& P, LAS unsigned char* lds, int b, int ch, int g, int tid, int lane, int wave) {
    const bf16_t* ACT = (const bf16_t*)(P.ws + WS_ACT); bf16_t* AB = (bf16_t*)(P.ws + WS_AB); const bf16_t* tril = (const bf16_t*)(P.ws + WS_TRIL) + (size_t)g * 128 * 128;
    LAS f32x2* ST = (LAS f32x2*)(lds + G_ST); LAS bf16_t* Vnt = (LAS bf16_t*)(lds + G_VNT);
    const size_t R0 = (size_t)b * SEQ + 128 * ch;
    __syncthreads();
    for (int j = wave; j < 128; j += 8) {
        const u32x4 raw = *(const u32x4*)(ACT + (R0 + j) * NIN + LVB + 8 * lane);
        float f[8]; f[0] = bf2f(raw.x); f[1] = bf2f(raw.x >> 16); f[2] = bf2f(raw.y); f[3] = bf2f(raw.y >> 16); f[4] = bf2f(raw.z); f[5] = bf2f(raw.z >> 16); f[6] = bf2f(raw.w); f[7] = bf2f(raw.w >> 16);
        float sm = 0.f;
#pragma unroll
        for (int i = 0; i < 8; ++i) sm += f[i];
        const float mean = wave_sum(sm) * (1.0f / 512.0f);
        float sq = 0.f;
#pragma unroll
        for (int i = 0; i < 8; ++i) { const float d = f[i] - mean; sq += d * d; }
        const float rstd = rsqrtf(wave_sum(sq) * (1.0f / 512.0f) + 1e-6f);
        if (lane == 0) ST[j] = (f32x2){mean, rstd};
    }
    __syncthreads();
    const float* vg = P.in[21] + 128 * g; const float* vb = P.in[22] + 128 * g;
#pragma unroll
    for (int i = 0; i < 4; ++i) {
        const int idx = tid + 512 * i, j = idx & 127, chn = idx >> 7;
        const u32x4 raw = *(const u32x4*)(ACT + (R0 + j) * NIN + LVB + 128 * g + 8 * chn);
        const f32x2 st = ST[j];
        float f[8]; f[0] = bf2f(raw.x); f[1] = bf2f(raw.x >> 16); f[2] = bf2f(raw.y); f[3] = bf2f(raw.y >> 16); f[4] = bf2f(raw.z); f[5] = bf2f(raw.z >> 16); f[6] = bf2f(raw.w); f[7] = bf2f(raw.w >> 16);
#pragma unroll
        for (int e = 0; e < 8; ++e) { const int d = 8 * chn + e; Vnt[d * VPITCH + j] = (bf16_t)f2bf((f[e] - st[0]) * st[1] * vg[d] + vb[d]); }
    }
    __syncthreads();
    const int lr = lane & 15, grp = lane >> 4;
    f32x4 acc[8];
#pragma unroll
    for (int it = 0; it < 8; ++it) acc[it] = (f32x4){0.f, 0.f, 0.f, 0.f};
#pragma unroll
    for (int ks = 0; ks < 4; ++ks) {
        const bf16x8 af = *(const LAS bf16x8*)(Vnt + (16 * wave + lr) * VPITCH + 32 * ks + 8 * grp);
#pragma unroll
        for (int it = 0; it < 8; ++it) {
            if ((it >> 1) >= ks) { const bf16x8 bfr = *(const bf16x8*)(tril + (size_t)(16 * it + lr) * 128 + 32 * ks + 8 * grp);
                acc[it] = __builtin_amdgcn_mfma_f32_16x16x32_bf16(af, bfr, acc[it], 0, 0, 0); }
        }
    }
    const float* bs = P.in[24] + 128 * g;
#pragma unroll
    for (int it = 0; it < 8; ++it) {
        const int i = 16 * it + lr; const size_t row = R0 + i; const int d0 = 128 * g + 16 * wave + 4 * grp;
        const float bsi = bs[i];
        float uu[4], zb[4]; unpack4(*(const u32x2*)(ACT + row * NIN + LU + d0), uu); unpack4(*(const u32x2*)(ACT + row * NIN + LZB + d0), zb);
        u32x2 w; w.x = cvt_pk_bf16(uu[0] * (acc[it][0] + bsi) * zb[0], uu[1] * (acc[it][1] + bsi) * zb[1]); w.y = cvt_pk_bf16(uu[2] * (acc[it][2] + bsi) * zb[2], uu[3] * (acc[it][3] + bsi) * zb[3]);
        *(u32x2*)(AB + row * DM + 512 + d0) = w;
    }
}

constexpr int S_Q = 0, S_KT = 1024, S_VT = S_KT + 64 * 65 * 4, S_SC = S_VT + 64 * 64 * 4, S_OB = S_SC + 4 * 576 * 4, S_MISC = S_OB + 2 * 256 * 4;
__device__ __forceinline__ void sample_unit(const Params& P, LAS unsigned char* lds, int sb, int g, int tid, int lane, int wave) {
    const bf16_t* ACT = (const bf16_t*)(P.ws + WS_ACT); bf16_t* AB = (bf16_t*)(P.ws + WS_AB);
    LAS float* Qs = (LAS float*)(lds + S_Q); LAS float* Kt = (LAS float*)(lds + S_KT); LAS float* Vt = (LAS float*)(lds + S_VT); LAS float* SC = (LAS float*)(lds + S_SC);
    LAS float* OB = (LAS float*)(lds + S_OB); LAS float* MISC = (LAS float*)(lds + S_MISC); LAS int* SELB = (LAS int*)(lds + S_MISC) + 8;
    const size_t row = (size_t)MP + sb;
    const int* ptab = (const int*)P.in[8] + sb * 16;
    __syncthreads();
    const int h_t = (tid >> 6) & 3, d_t = tid & 63;
    if (tid < 256) Qs[tid] = bf2f(ACT[row * NIN + LQ + 64 * (4 * g + h_t) + d_t]);
    float oacc = 0.f;
    for (int br = 0; br < 3; ++br) {
        const int nkeys = (br == 0) ? 64 : (br == 1) ? 449 : 512, ntile = (nkeys + 63) >> 6;
#define SROW(KV, kk, ptr) do { const int _kk = (kk); ptr = nullptr; \
        if (br == 0) { ptr = (const float*)(P.ws + ((KV) ? WS_VCS : WS_KCS)) + ((size_t)(sb * 2 + g) * 64 + _kk) * 64; } \
        else if (br == 1) { if (_kk < 448) { const int blk = SELB[_kk >> 6], r_ = _kk & 63; const int page = ptab[blk >> 1]; ptr = P.in[4 + (KV)] + (((size_t)page * 128 + (blk & 1) * 64 + r_) * 2 + g) * 64; } \
                            else if (_kk == 448) ptr = P.out + ((KV) ? O_SVS : O_SKS) + (size_t)sb * 128 + g * 64; } \
        else { if (_kk < 511) ptr = P.in[6 + (KV)] + (((size_t)sb * 512 + 1 + _kk) * 2 + g) * 64; else if (_kk == 511) ptr = P.out + ((KV) ? O_SVW : O_SKW) + ((size_t)(sb * 512 + 511) * 2 + g) * 64; } } while (0)
        for (int tl = 0; tl < ntile; ++tl) {
            __syncthreads();
#pragma unroll
            for (int i = 0; i < 2; ++i) { const int idx = tid + 512 * i, key = idx >> 4, c4 = idx & 15; const float* ptr; SROW(0, tl * 64 + key, ptr);
                f32x4 v = (f32x4){0.f, 0.f, 0.f, 0.f}; if (ptr) v = *(const f32x4*)(ptr + 4 * c4);
                LAS float* dst = Kt + key * 65 + 4 * c4; dst[0] = v[0]; dst[1] = v[1]; dst[2] = v[2]; dst[3] = v[3]; }
            __syncthreads();
            if (tid < 256) { const int key = tid & 63, hh = tid >> 6; float sc = 0.f;
#pragma unroll 8
                for (int d = 0; d < 64; ++d) sc += Qs[hh * 64 + d] * Kt[key * 65 + d];
                const int kk = tl * 64 + key; SC[hh * 576 + kk] = (kk < nkeys) ? sc : NEGBIG; }
        }
        __syncthreads();
        if (wave < 4) {
            const int np = ntile * 64; float mx = NEGBIG;
            for (int kk = lane; kk < np; kk += 64) mx = fmaxf(mx, SC[wave * 576 + kk]);
            mx = wave_max(mx); float ls = 0.f;
            for (int kk = lane; kk < np; kk += 64) { const float p = __builtin_amdgcn_exp2f(SC[wave * 576 + kk] - mx); SC[wave * 576 + kk] = p; ls += p; }
            ls = wave_sum(ls); if (lane == 0) MISC[wave] = ls;
        }
        __syncthreads();
        if (br == 0) {
            if (tid < 32) { float im = 0.f;
#pragma unroll
                for (int hh = 0; hh < 4; ++hh) im += (SC[hh * 576 + 2 * tid] + SC[hh * 576 + 2 * tid + 1]) / MISC[hh];
                MISC[16 + tid] = im; }
            __syncthreads();
            if (tid == 0) { unsigned mask = 1u; SELB[0] = 0;
                for (int pick = 0; pick < 6; ++pick) { float best = -1.f; int bi = 1;
                    for (int j = 1; j < 32; ++j) { const float x = MISC[16 + j]; if (!((mask >> j) & 1u) && x > best) { best = x; bi = j; } }
                    mask |= 1u << bi; SELB[1 + pick] = bi; } }
            __syncthreads();
        }
        float o = 0.f;
        for (int tl = 0; tl < ntile; ++tl) {
            __syncthreads();
#pragma unroll
            for (int i = 0; i < 2; ++i) { const int idx = tid + 512 * i, key = idx >> 4, c4 = idx & 15; const float* ptr; SROW(1, tl * 64 + key, ptr);
                f32x4 v = (f32x4){0.f, 0.f, 0.f, 0.f}; if (ptr) v = *(const f32x4*)(ptr + 4 * c4);
                *(LAS f32x4*)(Vt + key * 64 + 4 * c4) = v; }
            __syncthreads();
            { const int half = tid >> 8;
#pragma unroll 8
              for (int k2 = 0; k2 < 32; ++k2) { const int key = half * 32 + k2; o += SC[h_t * 576 + tl * 64 + key] * Vt[key * 64 + d_t]; } }
        }
#undef SROW
        __syncthreads();
        OB[tid] = o;
        __syncthreads();
        if (tid < 256) { const float gt = bf2f(ACT[row * NIN + LNSA + 3 * (4 * g + h_t) + br]); oacc += gt * (OB[tid] + OB[256 + tid]) / MISC[h_t]; }
    }
    if (tid < 256) { const int col = 64 * (4 * g + h_t) + d_t; AB[row * DM + col] = (bf16_t)f2bf(oacc * bf2f(ACT[row * NIN + LZA + col])); }
    if (wave == 0) {
        const u32x4 raw = *(const u32x4*)(ACT + row * NIN + LVB + 8 * lane);
        float f[8]; f[0] = bf2f(raw.x); f[1] = bf2f(raw.x >> 16); f[2] = bf2f(raw.y); f[3] = bf2f(raw.y >> 16); f[4] = bf2f(raw.z); f[5] = bf2f(raw.z >> 16); f[6] = bf2f(raw.w); f[7] = bf2f(raw.w >> 16);
        float sm = 0.f;
#pragma unroll
        for (int i = 0; i < 8; ++i) sm += f[i];
        const float mean = wave_sum(sm) * (1.0f / 512.0f); float sq = 0.f;
#pragma unroll
        for (int i = 0; i < 8; ++i) { const float d = f[i] - mean; sq += d * d; }
        const float rstd = rsqrtf(wave_sum(sq) * (1.0f / 512.0f) + 1e-6f);
        if (lane == 0) { MISC[48] = mean; MISC[49] = rstd; }
    }
    __syncthreads();
    if (tid < 256) {
        const int d = 256 * g + tid, gm = d >> 7;
        const float vn = (bf2f(ACT[row * NIN + LVB + d]) - MISC[48]) * MISC[49] * P.in[21][d] + P.in[22][d];
        P.out[O_SVCH + (size_t)sb * 512 + d] = vn;
        const float sv = P.in[23][(size_t)gm * 128 * 128] * vn + P.in[24][gm * 128];
        AB[row * DM + 512 + d] = (bf16_t)f2bf(bf2f(ACT[row * NIN + LU + d]) * sv * bf2f(ACT[row * NIN + LZB + d]));
    }
}

#define XB_TMO      128
#define XB_XCNT(j)  (256  + 64 * (j))
#define XB_XSUB(j)  (1280 + 64 * (j))
#define XB_XGEN(j)  (2304 + 64 * (j))
#define XB_TOP      3328
#define XB_TOPGEN   3392
#define XCD_BAR_WORDS 3456
#define XB_SPIN_CAP (1u << 18)
__device__ __forceinline__ unsigned xb_ld(unsigned* p)              { return __hip_atomic_load(p, __ATOMIC_RELAXED, __HIP_MEMORY_SCOPE_AGENT); }
__device__ __forceinline__ unsigned xb_add(unsigned* p, unsigned v) { return __hip_atomic_fetch_add(p, v, __ATOMIC_RELAXED, __HIP_MEMORY_SCOPE_AGENT); }
__device__ __forceinline__ unsigned xb_xcc_id() { return (unsigned)__builtin_amdgcn_s_getreg((3 << 11) | 20) & 0xFu; }
#define XB_SPIN(cond, bar) do { unsigned _sp = 0; while (cond) { __builtin_amdgcn_s_sleep(1); \
    if ((++_sp & 255u) == 0u) { if (xb_ld(&(bar)[XB_TMO])) break; if (_sp > XB_SPIN_CAP) { atomicAdd(&(bar)[XB_TMO], 1u); break; } } } } while (0)
struct XcdBarrier { unsigned* bar; unsigned x; volatile LAS unsigned* st; };
__device__ __forceinline__ XcdBarrier xcd_barrier_post(unsigned* bar, volatile LAS unsigned* st) {
    XcdBarrier b; b.bar = bar; b.x = xb_xcc_id(); b.st = st;
    if (threadIdx.x == 0) (void)xb_add(&bar[XB_XCNT(b.x)], 1u);
    return b;
}
__device__ __forceinline__ void xcd_barrier_complete(unsigned* bar, unsigned x, unsigned& nloc, unsigned& nx) {
    const unsigned G = gridDim.x * gridDim.y * gridDim.z;
    unsigned sum, cnt, mine, sp = 0u;
    for (;;) {
        sum = 0u; cnt = 0u; mine = 0u;
#pragma unroll
        for (unsigned j = 0; j < 16; ++j) { const unsigned c = xb_ld(&bar[XB_XCNT(j)]); sum += c; cnt += (c > 0u) ? 1u : 0u; mine = (j == x) ? c : mine; }
        if (sum == G) break;
        __builtin_amdgcn_s_sleep(1);
        if ((++sp & 255u) == 0u) { if (xb_ld(&bar[XB_TMO])) break; if (sp > XB_SPIN_CAP) { atomicAdd(&bar[XB_TMO], 1u); break; } }
    }
    nloc = mine > 0u ? mine : 1u; nx = cnt > 0u ? cnt : 1u;
}
__device__ __forceinline__ void xcd_barrier(const XcdBarrier& b) {
    asm volatile("s_waitcnt vmcnt(0)" ::: "memory");
    __syncthreads();
    if (threadIdx.x == 0) {
        unsigned* bar = b.bar;
        __builtin_amdgcn_s_waitcnt(0);
        unsigned nloc = b.st[0], nx = b.st[1];
        if (nloc == 0u) { xcd_barrier_complete(bar, b.x, nloc, nx); b.st[0] = nloc; b.st[1] = nx; }
        const unsigned old = xb_add(&bar[XB_XSUB(b.x)], 1u);
        const unsigned gen = old / nloc;
        if (old + 1u == (gen + 1u) * nloc) {
            __builtin_amdgcn_fence(__ATOMIC_RELEASE, "agent");
            asm volatile("s_waitcnt vmcnt(0)" ::: "memory");
            const unsigned og = xb_add(&bar[XB_TOP], 1u);
            const unsigned tg = og / nx;
            if (og + 1u == (tg + 1u) * nx) xb_add(&bar[XB_TOPGEN], 1u);
            else XB_SPIN(xb_ld(&bar[XB_TOPGEN]) == tg, bar);
            __builtin_amdgcn_fence(__ATOMIC_ACQUIRE, "agent");
            xb_add(&bar[XB_XGEN(b.x)], 1u);
            asm volatile("s_waitcnt vmcnt(0)" ::: "memory");
        } else {
            XB_SPIN(xb_ld(&bar[XB_XGEN(b.x)]) == gen, bar);
            __builtin_amdgcn_fence(__ATOMIC_ACQUIRE, "agent");
            asm volatile("s_waitcnt vmcnt(0)" ::: "memory");
        }
    }
    __syncthreads();
}

__global__ void __launch_bounds__(512, 2) mk_fwd(Params P) {
    extern __shared__ __attribute__((aligned(16))) unsigned char lds_raw[];
    LAS unsigned char* lds = (LAS unsigned char*)lds_raw;
    const int tid = threadIdx.x, lane = tid & 63, wave = __builtin_amdgcn_readfirstlane(tid >> 6);
    const int G = gridDim.x, c = blockIdx.x, gw = c * 8 + wave, NGW = G * 8, gtid = c * 512 + tid, NT = G * 512;
    cg::grid_group grid = cg::this_grid();
    const int lo = P.ph_lo, hi = P.ph_hi;
    if (tid < 16) ((LAS unsigned*)(lds + LDS_XB))[tid] = 0u;
    __syncthreads();
    const XcdBarrier bar = xcd_barrier_post((unsigned*)(P.ws + WS_CTL), (volatile LAS unsigned*)(lds + LDS_XB));
    if (hi < 0) grid.sync();
#define IN(k) (lo <= (k) && (k) < hi)
#define SEAM(k) do { if (IN(k) && IN((k) + 1)) xcd_barrier(bar); } while (0)
    unsigned char* ws = P.ws;
    if (IN(0)) for (int rep = 0; rep < MK_REP0; ++rep) { p0_prologue(P, lds, gw, NGW, lane, wave, gtid, NT); }
    SEAM(0);
    if (IN(1)) for (int rep = 0; rep < MK_REP1; ++rep) { p1_hrows(P, gw, NGW, lane); }
    SEAM(1);
    if (IN(2)) for (int rep = 0; rep < MK_REP2; ++rep) {
        pg8::Gemm gm{(const bf16_t*)(ws + WS_H), (const bf16_t*)(ws + WS_WTIN), DM, DM, DM};
        pg8::StaticOrder S; S.init(MPAD / 256, NIN / 256, G, c);
        EpiInProj E{(bf16_t*)(ws + WS_ACT), (bf16_t*)(ws + WS_VT), P.out, P.in[15], P.in[16], (const float*)(ws + WS_ROPE)};
        pg8::gemm_phase<EpiInProj, pg8::StaticOrder>(lds, gm, S, E);
    }
    SEAM(2);
    if (IN(3)) for (int rep = 0; rep < MK_REP3; ++rep) { p3_compress(P, lds, gw, NGW, lane, wave); }
    SEAM(3);
    if (IN(4)) for (int rep = 0; rep < MK_REP4; ++rep) {
        asm volatile("" ::: "memory");
        for (int i = 0;; ++i) { const int a = (i & 1) ? (i + 1) * G - 1 - c : i * G + c; if (a >= 512 || a < 0) break; attn_unit(P, lds, a & 7, 63 - (a >> 3), tid, lane, wave); }
        for (int su = c; su < 2 * NSB; su += G) sample_unit(P, lds, su >> 1, su & 1, tid, lane, wave);
        for (int gu = c; gu < 512; gu += G) gmlp_unit(P, lds, gu >> 6, (gu >> 2) & 15, gu & 3, tid, lane, wave);
        __syncthreads();
    }
    SEAM(4);
    if (IN(5)) for (int rep = 0; rep < MK_REP5; ++rep) {
        pg8::Gemm gm{(const bf16_t*)(ws + WS_AB), (const bf16_t*)(ws + WS_WTBR), DM, DM, 512};
        pg8::PairOrder S; S.S.init(MPAD / 256, DM / 256, G, c);
        EpiMix E{(const bf16_t*)(ws + WS_ACT), (bf16_t*)(ws + WS_H)};
        pg8::gemm_phase<EpiMix, pg8::PairOrder>(lds, gm, S, E);
    }
    SEAM(5);
    if (IN(6)) for (int rep = 0; rep < MK_REP6; ++rep) {
        pg8::Gemm gm{(const bf16_t*)(ws + WS_H), (const bf16_t*)(ws + WS_WTOUT), DM, DM, DM};
        pg8::StaticOrder S; S.init(MPAD / 256, DM / 256, G, c);
        EpiOut E{P.in[0], P.in[1], (const float*)(ws + WS_MOD), P.out};
        pg8::gemm_phase<EpiOut, pg8::StaticOrder>(lds, gm, S, E);
    }
#undef IN
#undef SEAM
}

extern "C" void kernel_launch(void* const* d_in, const int* in_sizes, int n_in, void* d_out, int out_size, void* d_ws, size_t ws_size, hipStream_t stream) {
    static int grid = 0;
    if (grid == 0) {
        if (n_in != 28 || out_size != (int)O_END || ws_size < WS_END) { fprintf(stderr, "kernel_launch: unexpected shapes (n_in %d, out %d, ws %zu); nothing launched\n", n_in, out_size, ws_size); grid = -1; return; }
        int dev = 0, cus = 0, per_cu = 0;
        if (hipGetDevice(&dev) != hipSuccess || hipDeviceGetAttribute(&cus, hipDeviceAttributeMultiprocessorCount, dev) != hipSuccess) { grid = -1; return; }
        if (hipFuncSetAttribute((const void*)mk_fwd, hipFuncAttributeMaxDynamicSharedMemorySize, LDS_BYTES) != hipSuccess) { fprintf(stderr, "kernel_launch: hipFuncSetAttribute failed\n"); grid = -1; return; }
        if (hipOccupancyMaxActiveBlocksPerMultiprocessor(&per_cu, (const void*)mk_fwd, 512, LDS_BYTES) != hipSuccess || per_cu < 1) { fprintf(stderr, "kernel_launch: occupancy query failed (%d)\n", per_cu); (void)hipGetLastError(); per_cu = 1; }
        if (per_cu > 1) per_cu = 1;
        grid = cus * per_cu;
    }
    if (grid < 0) return;
    if (hipMemsetAsync((char*)d_ws + WS_CTL, 0, CTL_BYTES, stream) != hipSuccess) { fprintf(stderr, "kernel_launch: hipMemsetAsync failed\n"); return; }
    Params p{};
    for (int i = 0; i < 28; ++i) p.in[i] = (const float*)d_in[i];
    p.out = (float*)d_out; p.ws = (unsigned char*)d_ws;
#if MK_N_LAUNCHES == 1
    p.ph_lo = 0; p.ph_hi = 7;
    void* args[] = {&p};
    hipError_t e = hipLaunchCooperativeKernel((const void*)mk_fwd, dim3(grid), dim3(512), args, LDS_BYTES, stream);
    if (e != hipSuccess) fprintf(stderr, "kernel_launch: cooperative launch failed: %s (grid %d)\n", hipGetErrorString(e), grid);
#else
    for (int ph = 0; ph < 7; ++ph) {
        p.ph_lo = ph; p.ph_hi = ph + 1;
        void* args[] = {&p};
        hipError_t e = hipLaunchCooperativeKernel((const void*)mk_fwd, dim3(grid), dim3(512), args, LDS_BYTES, stream);
        if (e != hipSuccess) { fprintf(stderr, "kernel_launch: launch %d failed: %s (grid %d)\n", ph, hipGetErrorString(e), grid); break; }
    }
#endif
}
```

```cpp
#include <hip/hip_runtime.h>
#include <hip/hip_cooperative_groups.h>
#include <cstdio>
#include <cstdint>
namespace cg = cooperative_groups;

#ifndef MK_N_LAUNCHES
#define MK_N_LAUNCHES 1
#endif
#define MK_REP0 1
#define MK_REP1 1
#define MK_REP2 1
#define MK_REP3 1
#define MK_REP4 1
#define MK_REP5 1
#define MK_REP6 1

#define LAS __attribute__((address_space(3)))
typedef unsigned short bf16_t;
typedef short bf16x8 __attribute__((ext_vector_type(8)));
typedef short bf16x4 __attribute__((ext_vector_type(4)));
typedef float f32x4 __attribute__((ext_vector_type(4)));
typedef float f32x2 __attribute__((ext_vector_type(2)));
typedef unsigned u32x4 __attribute__((ext_vector_type(4)));
typedef unsigned u32x2 __attribute__((ext_vector_type(2)));

constexpr int DM = 1024, SEQ = 2048, NBATCH = 8, MP = NBATCH * SEQ, NSB = 128, MTOT = MP + NSB, MPAD = 16640;
constexpr int NIN = 5632;
constexpr int LQ = 0, LK = 512, LV = 896, LZA = 1280, LU = 1792, LVB = 2304, LZB = 2816, LGA = 3328, LGB = 4352, LNSA = 5376;
constexpr float C2Q = 0.125f * 1.4426950408889634f;
constexpr float NEGBIG = -1e30f, MINIT = -1e29f;
constexpr size_t O_YP = 0, O_YS = 16777216, O_PKC = 16908288, O_PVC = 19005440, O_PKS = 21102592, O_PVS = 23199744, O_PKW = 25296896, O_PVW = 25821184,
                 O_SKC = 26345472, O_SVC = 26361856, O_SKS = 26378240, O_SVS = 26394624, O_SKW = 26411008, O_SVW = 34799616, O_SVCH = 43188224, O_END = 43253760;
constexpr size_t MiB = 1u << 20;
constexpr size_t WS_ROPE = 0, WS_MOD = 1 * MiB, WS_WTIN = 3 * MiB, WS_WTBR = 14 * MiB, WS_WTOUT = 16 * MiB, WS_TRIL = 18 * MiB, WS_KC = 18 * MiB + 512 * 1024, WS_VCT = WS_KC + 128 * 1024,
                 WS_KCS = 19 * MiB, WS_VCS = 23 * MiB, WS_VT = 27 * MiB, WS_H = 40 * MiB, WS_AB = 73 * MiB, WS_ACT = 106 * MiB, WS_END = 285 * MiB;
constexpr size_t WS_CTL = 768 * 1024, CTL_BYTES = 16384;
constexpr int LDS_BYTES = 147456, LDS_XB = LDS_BYTES - 64;

struct Params { const float* in[28]; float* out; unsigned char* ws; int ph_lo, ph_hi; };

__device__ __forceinline__ unsigned f2bf(float f) { unsigned u = __builtin_bit_cast(unsigned, f); return (u + 0x7fffu + ((u >> 16) & 1u)) >> 16; }
__device__ __forceinline__ unsigned pk2(float lo, float hi) { return f2bf(lo) | (f2bf(hi) << 16); }
__device__ __forceinline__ float bf2f(unsigned b) { return __builtin_bit_cast(float, (b & 0xffffu) << 16); }
__device__ __forceinline__ unsigned cvt_pk_bf16(float lo, float hi) { unsigned r; asm volatile("v_cvt_pk_bf16_f32 %0, %1, %2" : "=v"(r) : "v"(lo), "v"(hi)); return r; }
__device__ __forceinline__ float sigmoidf_(float x) { return 1.0f / (1.0f + __expf(-x)); }
__device__ __forceinline__ float wave_sum(float v) {
#pragma unroll
    for (int o = 1; o < 64; o <<= 1) v += __shfl_xor(v, o);
    return v;
}
__device__ __forceinline__ float wave_max(float v) {
#pragma unroll
    for (int o = 1; o < 64; o <<= 1) v = fmaxf(v, __shfl_xor(v, o));
    return v;
}
__device__ __forceinline__ void unpack4(u32x2 w, float (&f)[4]) { f[0] = bf2f(w.x); f[1] = bf2f(w.x >> 16); f[2] = bf2f(w.y); f[3] = bf2f(w.y >> 16); }

namespace pg8 {
constexpr int BM = 256, BK = 64, HALF = 128, HTB = HALF * BK * 2, STAGE_BYTES = 8 * HTB, NXCD = 8, WGM = 8;
__host__ __device__ __forceinline__ int lds_byte(int r, int c) { const int st = (r >> 4) * 2 + (c >> 5), rr = r & 15, cc = c & 31, ob = rr * 64 + cc * 2; return st * 1024 + (ob ^ (((ob >> 9) & 1) << 5)); }
__host__ __device__ __forceinline__ void stage_rc(int b, int& R, int& C) { const int st = b / 1024, sb = b % 1024, swz = sb ^ (((sb >> 9) & 1) << 5); R = (st >> 1) * 16 + swz / 64; C = (st & 1) * 32 + (swz % 64) / 2; }

struct Unit { int pm, pn, kofs, keep; };
struct Gemm { const bf16_t* A; const bf16_t* Bt; int lda, ldb, K; };

struct StaticOrder {
    int nM, nN, nwg, G, c;
    __device__ void init(int nM_, int nN_, int G_, int c_) { nM = nM_; nN = nN_; nwg = nM * nN; G = G_; c = c_; }
    __device__ bool tile(int i, int& pm, int& pn) const {
        const long L = (long)i * G + c; if (L >= nwg) return false;
        int wgid = (int)L; { const int q = nwg / NXCD, r = nwg % NXCD, xcd = wgid % NXCD, off = wgid / NXCD; wgid = (xcd < r ? xcd * (q + 1) : r * (q + 1) + (xcd - r) * q) + off; }
        const int nig = WGM * nN, gid = wgid / nig, fm = gid * WGM, gsz = (nM - fm) < WGM ? (nM - fm) : WGM;
        pm = fm + ((wgid % nig) % gsz); pn = (wgid % nig) / gsz; return true;
    }
    __device__ bool next(int i, Unit& u) const { u.kofs = 0; u.keep = 0; return tile(i, u.pm, u.pn); }
};
struct PairOrder {
    StaticOrder S;
    __device__ bool next(int i, Unit& u) const { u.kofs = (i & 1) * 512; u.keep = (i & 1) ? 0 : 1; return S.tile(i >> 1, u.pm, u.pn); }
};

template <class Epi, class Sched>
__device__ __forceinline__ void gemm_phase(LAS unsigned char* lds, const Gemm g, const Sched& S, const Epi& E) {
    const int tid = threadIdx.x, wid = __builtin_amdgcn_readfirstlane(tid >> 6), lane = tid & 63, wr = wid >> 2, wc = wid & 3, fr = lane & 15, fq = lane >> 4;
    const int nt = g.K / BK;
    unsigned voffA[2], voffB[2];
#pragma unroll
    for (int i = 0; i < 2; ++i) { int R, C; stage_rc(tid * 16 + i * 8192, R, C); voffA[i] = (unsigned)(R * g.lda + C) * 2u; voffB[i] = (unsigned)(R * g.ldb + C) * 2u; }
    const size_t kstep = (size_t)(BK * 2);
    const size_t hstepA = (size_t)HALF * g.lda * 2, hstepB = (size_t)HALF * g.ldb * 2, tstepA = 2 * hstepA, tstepB = 2 * hstepB;
    const unsigned ldsw = (unsigned)wid * 1024u;
    const int aoff = lds_byte(wr * 64 + fr, fq * 8), boff = lds_byte(wc * 32 + fr, fq * 8);
#define PG8_SA(b, h) (((b) * 2 + (h)) * HTB)
#define PG8_SB(b, h) ((4 + (b) * 2 + (h)) * HTB)
#define PG8_STAGE(bufoff, gbase, voff) do { _Pragma("unroll") for (int _i = 0; _i < 2; ++_i) \
        __builtin_amdgcn_global_load_lds((const unsigned*)((const char*)(gbase) + (voff)[_i]), (LAS unsigned*)(lds + (bufoff) + ldsw + _i * 8192), 16, 0, 0); } while (0)
#define PG8_LDA(dst, b, h) do { _Pragma("unroll") for (int m = 0; m < 4; ++m) _Pragma("unroll") for (int k = 0; k < 2; ++k) dst[m][k] = *(const LAS bf16x8*)(lds + PG8_SA(b, h) + aoff + m * 2048 + k * 1024); } while (0)
#define PG8_LDB(dst, b, h) do { _Pragma("unroll") for (int n = 0; n < 2; ++n) _Pragma("unroll") for (int k = 0; k < 2; ++k) dst[n][k] = *(const LAS bf16x8*)(lds + PG8_SB(b, h) + boff + n * 2048 + k * 1024); } while (0)
#define PG8_MMA(ai, bj, At, Bt) do { __builtin_amdgcn_s_setprio(1); _Pragma("unroll") for (int m = 0; m < 4; ++m) _Pragma("unroll") for (int n = 0; n < 2; ++n) _Pragma("unroll") for (int k = 0; k < 2; ++k) \
        acc[ai][bj][m][n] = __builtin_amdgcn_mfma_f32_16x16x32_bf16(Bt[n][k], At[m][k], acc[ai][bj][m][n], 0, 0, 0); __builtin_amdgcn_s_setprio(0); } while (0)
#define PG8_WAIT_V(n) asm volatile("s_waitcnt vmcnt(" #n ")" ::: "memory")
#define PG8_WAIT_L(n) asm volatile("s_waitcnt lgkmcnt(" #n ")" ::: "memory")
#define PG8_BAR __builtin_amdgcn_s_barrier()
#define PG8_SCHED __builtin_amdgcn_sched_barrier(0)
    Unit cur, nxt; int ui = 0;
    if (!S.next(0, cur)) return;
    f32x4 acc[2][2][4][2];
#pragma unroll
    for (int a = 0; a < 2; ++a)
#pragma unroll
        for (int b = 0; b < 2; ++b)
#pragma unroll
            for (int m = 0; m < 4; ++m)
#pragma unroll
                for (int n = 0; n < 2; ++n) acc[a][b][m][n] = (f32x4){0.f, 0.f, 0.f, 0.f};
    bf16x8 At[4][2], B0[2][2], B1[2][2];
    const char* cA = (const char*)g.A + (size_t)cur.pm * tstepA + (size_t)cur.kofs * 2; const char* cB = (const char*)g.Bt + (size_t)cur.pn * tstepB + (size_t)cur.kofs * 2;
    PG8_STAGE(PG8_SB(0, 0), cB, voffB); PG8_STAGE(PG8_SB(0, 1), cB + hstepB, voffB); PG8_STAGE(PG8_SA(0, 0), cA, voffA); PG8_STAGE(PG8_SA(0, 1), cA + hstepA, voffA);
    if (wr == 1) PG8_BAR;
    PG8_WAIT_V(2); PG8_BAR;
    PG8_STAGE(PG8_SB(1, 0), cB + kstep, voffB); PG8_STAGE(PG8_SA(1, 0), cA + kstep, voffA); PG8_STAGE(PG8_SB(1, 1), cB + hstepB + kstep, voffB);
    PG8_WAIT_V(6); PG8_BAR;
    for (;;) {
        const bool has_next = S.next(ui + 1, nxt);
        const char* nA = has_next ? (const char*)g.A + (size_t)nxt.pm * tstepA + (size_t)nxt.kofs * 2 : cA; const char* nB = has_next ? (const char*)g.Bt + (size_t)nxt.pn * tstepB + (size_t)nxt.kofs * 2 : cB;
        for (int t = 0; t < nt; t += 2) {
            const bool last = (t == nt - 2);
            const char* a1 = cA + (size_t)(t + 1) * kstep;
            const char* a2 = last ? nA : cA + (size_t)(t + 2) * kstep; const char* b2 = last ? nB : cB + (size_t)(t + 2) * kstep;
            const char* a3 = a2 + kstep; const char* b3 = b2 + kstep;
            PG8_LDB(B0, 0, 0); PG8_LDB(B1, 0, 1); PG8_SCHED; PG8_LDA(At, 0, 0); PG8_STAGE(PG8_SA(1, 1), a1 + hstepA, voffA);
            PG8_WAIT_V(8); PG8_WAIT_L(0); PG8_BAR; PG8_MMA(0, 0, At, B0); PG8_MMA(0, 1, At, B1); PG8_BAR; PG8_SCHED;
            PG8_LDA(At, 0, 1); PG8_STAGE(PG8_SB(0, 0), b2, voffB); PG8_STAGE(PG8_SB(0, 1), b2 + hstepB, voffB); PG8_STAGE(PG8_SA(0, 0), a2, voffA);
            PG8_WAIT_V(8); PG8_WAIT_L(0); PG8_BAR; PG8_MMA(1, 0, At, B0); PG8_MMA(1, 1, At, B1); PG8_BAR; PG8_SCHED;
            PG8_LDB(B0, 1, 0); PG8_LDB(B1, 1, 1); PG8_SCHED; PG8_LDA(At, 1, 0); PG8_STAGE(PG8_SA(0, 1), a2 + hstepA, voffA);
            PG8_WAIT_V(8); PG8_WAIT_L(0); PG8_BAR; PG8_MMA(0, 0, At, B0); PG8_MMA(0, 1, At, B1); PG8_BAR; PG8_SCHED;
            PG8_LDA(At, 1, 1); PG8_STAGE(PG8_SB(1, 0), b3, voffB); PG8_STAGE(PG8_SB(1, 1), b3 + hstepB, voffB); PG8_STAGE(PG8_SA(1, 0), a3, voffA);
            PG8_WAIT_V(8); PG8_WAIT_L(0); PG8_BAR; PG8_MMA(1, 0, At, B0); PG8_MMA(1, 1, At, B1); PG8_BAR; PG8_SCHED;
        }
        if (wr == 0) PG8_BAR;
        E(acc, cur, wr, wc, fr, fq);
        if (!has_next) break;
        if (!cur.keep) {
#pragma unroll
            for (int a = 0; a < 2; ++a)
#pragma unroll
                for (int b = 0; b < 2; ++b)
#pragma unroll
                    for (int m = 0; m < 4; ++m)
#pragma unroll
                        for (int n = 0; n < 2; ++n) acc[a][b][m][n] = (f32x4){0.f, 0.f, 0.f, 0.f};
        }
        cur = nxt; cA = nA; cB = nB; ++ui;
        if (wr == 1) PG8_BAR;
    }
    PG8_WAIT_V(0);
    PG8_BAR;
#undef PG8_SA
#undef PG8_SB
#undef PG8_STAGE
#undef PG8_LDA
#undef PG8_LDB
#undef PG8_MMA
#undef PG8_WAIT_V
#undef PG8_WAIT_L
#undef PG8_BAR
#undef PG8_SCHED
}
}

struct EpiInProj {
    bf16_t* ACT; bf16_t* VT; float* out; const float* qng; const float* kng; const float* rope;
    __device__ __forceinline__ void operator()(f32x4 (&acc)[2][2][4][2], const pg8::Unit& u, int wr, int wc, int fr, int fq) const {
        const int pn = u.pn;
        int type = 0, slot = 0;
        if (pn < 2) { type = 1; slot = 4 * pn + wc; }
        else if (pn == 2 || (pn == 3 && wc < 2)) { type = 2; slot = 4 * (pn - 2) + wc; }
        else if (pn == 3 || pn == 4) { type = 3; slot = 4 * (pn - 3) + wc - 2; }
        const int rbase = u.pm * 256 + wr * 64 + fr;
        if (type == 1 || type == 2) {
            const float* gn = (type == 1) ? qng : kng;
            f32x4 g4[2][2];
#pragma unroll
            for (int bj = 0; bj < 2; ++bj)
#pragma unroll
                for (int n = 0; n < 2; ++n) g4[bj][n] = *(const f32x4*)(gn + 32 * bj + 16 * n + 4 * fq);
            const int br = slot >> 1, kvh = slot & 1;
#pragma unroll
            for (int ai = 0; ai < 2; ++ai)
#pragma unroll
                for (int m = 0; m < 4; ++m) {
                    const int row = rbase + ai * 128 + m * 16;
                    float ss = 0.f;
#pragma unroll
                    for (int bj = 0; bj < 2; ++bj)
#pragma unroll
                        for (int n = 0; n < 2; ++n) { const f32x4 v = acc[ai][bj][m][n]; ss += (v[0] * v[0] + v[1] * v[1]) + (v[2] * v[2] + v[3] * v[3]); }
                    ss += __shfl_xor(ss, 16); ss += __shfl_xor(ss, 32);
                    const float rinv = rsqrtf(ss * (1.0f / 64.0f) + 1e-6f);
                    const int pos = (row < MP) ? (row & (SEQ - 1)) : SEQ;
                    const bool live = row < MTOT;
                    long obase = -1;
                    if (type == 2 && live) {
                        if (row < MP) {
                            const int t = row & (SEQ - 1), b = row >> 11;
                            if (br == 0) obase = (long)O_PKC + (long)row * 128 + kvh * 64;
                            else if (br == 1) obase = (long)O_PKS + (long)row * 128 + kvh * 64;
                            else if (t >= 1536) obase = (long)O_PKW + ((long)(b * 512 + t - 1536) * 2 + kvh) * 64;
                        } else {
                            const int sb = row - MP;
                            if (br == 0) obase = (long)O_SKC + sb * 128 + kvh * 64;
                            else if (br == 1) obase = (long)O_SKS + sb * 128 + kvh * 64;
                            else obase = (long)O_SKW + ((long)(sb * 512 + 511) * 2 + kvh) * 64;
                        }
                    }
#pragma unroll
                    for (int n = 0; n < 2; ++n) {
                        const f32x4 cs0 = *(const f32x4*)(rope + ((size_t)pos * 32 + 16 * n + 4 * fq) * 2);
                        const f32x4 cs1 = *(const f32x4*)(rope + ((size_t)pos * 32 + 16 * n + 4 * fq) * 2 + 4);
                        const float cc[4] = {cs0[0], cs0[2], cs1[0], cs1[2]}, sn[4] = {cs0[1], cs0[3], cs1[1], cs1[3]};
                        f32x4 o0, o1;
#pragma unroll
                        for (int j = 0; j < 4; ++j) {
                            const float y0 = acc[ai][0][m][n][j] * rinv * g4[0][n][j], y1 = acc[ai][1][m][n][j] * rinv * g4[1][n][j];
                            o0[j] = y0 * cc[j] - y1 * sn[j]; o1[j] = y1 * cc[j] + y0 * sn[j];
                        }
                        if (live) {
                            const int dcol = 16 * n + 4 * fq;
                            if (type == 1) {
                                bf16_t* p = ACT + (size_t)row * NIN + LQ + 64 * slot + dcol;
                                u32x2 w0, w1; w0.x = cvt_pk_bf16(o0[0] * C2Q, o0[1] * C2Q); w0.y = cvt_pk_bf16(o0[2] * C2Q, o0[3] * C2Q); w1.x = cvt_pk_bf16(o1[0] * C2Q, o1[1] * C2Q); w1.y = cvt_pk_bf16(o1[2] * C2Q, o1[3] * C2Q);
                                *(u32x2*)p = w0; *(u32x2*)(p + 32) = w1;
                            } else {
                                bf16_t* p = ACT + (size_t)row * NIN + LK + 64 * slot + dcol;
                                u32x2 w0, w1; w0.x = cvt_pk_bf16(o0[0], o0[1]); w0.y = cvt_pk_bf16(o0[2], o0[3]); w1.x = cvt_pk_bf16(o1[0], o1[1]); w1.y = cvt_pk_bf16(o1[2], o1[3]);
                                *(u32x2*)p = w0; *(u32x2*)(p + 32) = w1;
                                if (obase >= 0) { *(f32x4*)(out + obase + dcol) = o0; *(f32x4*)(out + obase + 32 + dcol) = o1; }
                            }
                        }
                    }
                }
        } else if (type == 3) {
            const int br = slot >> 1, kvh = slot & 1;
#pragma unroll
            for (int ai = 0; ai < 2; ++ai)
#pragma unroll
                for (int m = 0; m < 4; ++m) {
                    const int row = rbase + ai * 128 + m * 16;
                    if (row < MTOT) {
                        long obase = -1;
                        if (row < MP) {
                            const int t = row & (SEQ - 1), b = row >> 11;
                            if (br == 0) obase = (long)O_PVC + (long)row * 128 + kvh * 64;
                            else if (br == 1) obase = (long)O_PVS + (long)row * 128 + kvh * 64;
                            else if (t >= 1536) obase = (long)O_PVW + ((long)(b * 512 + t - 1536) * 2 + kvh) * 64;
                            bf16_t* vt = VT + ((size_t)(b * 6 + slot) * 64) * SEQ + t;
#pragma unroll
                            for (int bj = 0; bj < 2; ++bj)
#pragma unroll
                                for (int n = 0; n < 2; ++n)
#pragma unroll
                                    for (int j = 0; j < 4; ++j) vt[(size_t)(32 * bj + 16 * n + 4 * fq + j) * SEQ] = (bf16_t)f2bf(acc[ai][bj][m][n][j]);
                        } else {
                            const int sb = row - MP;
                            if (br == 0) obase = (long)O_SVC + sb * 128 + kvh * 64;
                            else if (br == 1) obase = (long)O_SVS + sb * 128 + kvh * 64;
                            else obase = (long)O_SVW + ((long)(sb * 512 + 511) * 2 + kvh) * 64;
                        }
                        if (obase >= 0) {
#pragma unroll
                            for (int bj = 0; bj < 2; ++bj)
#pragma unroll
                                for (int n = 0; n < 2; ++n) *(f32x4*)(out + obase + 32 * bj + 16 * n + 4 * fq) = acc[ai][bj][m][n];
                        }
                    }
                }
        } else {
            const int mode = (pn <= 6) ? 1 : (pn <= 10) ? 0 : (pn <= 12) ? 1 : 2;
#pragma unroll
            for (int ai = 0; ai < 2; ++ai)
#pragma unroll
                for (int m = 0; m < 4; ++m) {
                    const int row = rbase + ai * 128 + m * 16;
                    if (row < MTOT) {
                        bf16_t* p = ACT + (size_t)row * NIN + 256 * pn + 64 * wc + 4 * fq;
#pragma unroll
                        for (int bj = 0; bj < 2; ++bj)
#pragma unroll
                            for (int n = 0; n < 2; ++n) {
                                f32x4 v = acc[ai][bj][m][n];
#pragma unroll
                                for (int j = 0; j < 4; ++j) { const float sg = sigmoidf_(v[j]); v[j] = (mode == 0) ? v[j] : (mode == 1) ? v[j] * sg : sg; }
                                u32x2 w; w.x = cvt_pk_bf16(v[0], v[1]); w.y = cvt_pk_bf16(v[2], v[3]);
                                *(u32x2*)(p + 32 * bj + 16 * n) = w;
                            }
                    }
                }
        }
    }
};

struct EpiMix {
    const bf16_t* ACT; bf16_t* M;
    __device__ __forceinline__ void operator()(f32x4 (&acc)[2][2][4][2], const pg8::Unit& u, int wr, int wc, int fr, int fq) const {
        const int rbase = u.pm * 256 + wr * 64 + fr, cbase = u.pn * 256 + wc * 32 + 4 * fq;
#pragma unroll
        for (int ai = 0; ai < 2; ++ai)
#pragma unroll
            for (int m = 0; m < 4; ++m) {
                const int row = rbase + ai * 128 + m * 16;
                const bool live = row < MTOT;
                const int rr = live ? row : 0;
#pragma unroll
                for (int bj = 0; bj < 2; ++bj)
#pragma unroll
                    for (int n = 0; n < 2; ++n) {
                        const int col = cbase + 128 * bj + 16 * n;
                        float sb[4]; unpack4(*(const u32x2*)(ACT + (size_t)rr * NIN + LGB + col), sb);
                        if (u.keep) {
                            float sa[4]; unpack4(*(const u32x2*)(ACT + (size_t)rr * NIN + LGA + col), sa);
#pragma unroll
                            for (int j = 0; j < 4; ++j) acc[ai][bj][m][n][j] *= sa[j] * __builtin_amdgcn_rcpf(sb[j]);
                        } else if (live) {
                            const f32x4 v = acc[ai][bj][m][n];
                            u32x2 w; w.x = cvt_pk_bf16(v[0] * sb[0], v[1] * sb[1]); w.y = cvt_pk_bf16(v[2] * sb[2], v[3] * sb[3]);
                            *(u32x2*)(M + (size_t)row * DM + col) = w;
                        }
                    }
            }
    }
};

struct EpiOut {
    const float* xp; const float* xs; const float* MOD; float* out;
    __device__ __forceinline__ void operator()(f32x4 (&acc)[2][2][4][2], const pg8::Unit& u, int wr, int wc, int fr, int fq) const {
        const int rbase = u.pm * 256 + wr * 64 + fr, cbase = u.pn * 256 + wc * 32 + 4 * fq;
#pragma unroll
        for (int ai = 0; ai < 2; ++ai)
#pragma unroll
            for (int m = 0; m < 4; ++m) {
                const int row = rbase + ai * 128 + m * 16;
                if (row < MTOT) {
                    const float* xr; const float* gr; float* orow;
                    if (row < MP) { xr = xp + (size_t)row * DM; gr = MOD + (size_t)(row >> 11) * 3072 + 2048; orow = out + O_YP + (size_t)row * DM; }
                    else { const int sb = row - MP; xr = xs + (size_t)sb * DM; gr = MOD + (size_t)(8 + sb) * 3072 + 2048; orow = out + O_YS + (size_t)sb * DM; }
#pragma unroll
                    for (int bj = 0; bj < 2; ++bj)
#pragma unroll
                        for (int n = 0; n < 2; ++n) {
                            const int col = cbase + 128 * bj + 16 * n;
                            const f32x4 xv = *(const f32x4*)(xr + col), gv = *(const f32x4*)(gr + col);
                            *(f32x4*)(orow + col) = xv + gv * acc[ai][bj][m][n];
                        }
                }
            }
    }
};

__device__ __forceinline__ void transpose_item(const float* src, int src_ld, int nvalid, bf16_t* dst, int dst_ld, LAS float* scr, int lane) {
#pragma unroll 8
    for (int i = 0; i < 32; ++i) { const int kk = 2 * i + (lane >> 5), cc = lane & 31; scr[kk * 33 + cc] = (cc < nvalid) ? src[(size_t)kk * src_ld + cc] : 0.f; }
    asm volatile("s_waitcnt lgkmcnt(0)" ::: "memory");
    const int c = lane & 7;
#pragma unroll
    for (int j = 0; j < 4; ++j) { const int n = (lane >> 3) + 8 * j; const LAS float* s = scr + (8 * c) * 33 + n;
        u32x4 o; o.x = pk2(s[0 * 33], s[1 * 33]); o.y = pk2(s[2 * 33], s[3 * 33]); o.z = pk2(s[4 * 33], s[5 * 33]); o.w = pk2(s[6 * 33], s[7 * 33]);
        *(u32x4*)(dst + (size_t)n * dst_ld + 8 * c) = o; }
    asm volatile("s_waitcnt lgkmcnt(0)" ::: "memory");
}

__device__ __forceinline__ void p0_prologue(const Params& P, LAS unsigned char* lds, int gw, int NGW, int lane, int wave, int gtid, int NT) {
    unsigned char* ws = P.ws;
    LAS float* scr = (LAS float*)(lds + wave * 16384);
    constexpr int I_MOD = 9 * 48, I_WIN = 16 * 176, I_WBR = 16 * 32, I_WOUT = 16 * 32, I_POOL = NSB * 16 * 2;
    constexpr int I_TOTAL = I_MOD + I_WIN + I_WBR + I_WOUT + I_POOL;
    for (int it0 = gw; it0 < I_TOTAL; it0 += NGW) {
        int it = it0;
        if (it < I_MOD) {
            const int mt = it / 48, ng = it % 48, lr = lane & 15, kq = lane >> 4;
            int arow_i = 16 * mt + lr; if (arow_i > 135) arow_i = 135;
            const float* arow = ((arow_i < 8) ? P.in[9] + (size_t)arow_i * DM : P.in[10] + (size_t)(arow_i - 8) * DM) + kq;
            const float* bp = P.in[11] + (size_t)kq * 3072 + 64 * ng + lr;
            f32x4 macc[4];
#pragma unroll
            for (int nt = 0; nt < 4; ++nt) macc[nt] = (f32x4){0.f, 0.f, 0.f, 0.f};
#pragma unroll 8
            for (int k0 = 0; k0 < DM; k0 += 4) {
                const float a = arow[k0];
#pragma unroll
                for (int nt = 0; nt < 4; ++nt) macc[nt] = __builtin_amdgcn_mfma_f32_16x16x4f32(a, bp[(size_t)k0 * 3072 + 16 * nt], macc[nt], 0, 0, 0);
            }
            float* MOD = (float*)(ws + WS_MOD);
#pragma unroll
            for (int nt = 0; nt < 4; ++nt) { const int n = 64 * ng + 16 * nt + lr; const float bb = P.in[12][n];
#pragma unroll
                for (int r = 0; r < 4; ++r) { const int row = 16 * mt + 4 * kq + r; if (row < 136) MOD[(size_t)row * 3072 + n] = macc[nt][r] + bb; } }
            continue;
        }
        it -= I_MOD;
        if (it < I_WIN) {
            const int kb = it / 176, nb = it % 176;
            const int pn = nb >> 3, bj = (nb >> 2) & 1, wc = nb & 3;
            const int L0 = 256 * pn + 64 * wc + 32 * bj;
            int srcc, nvalid;
            if (L0 < 1280) { srcc = L0; nvalid = 32; } else if (L0 < LNSA) { srcc = L0 + 24; nvalid = 32; } else if (L0 == LNSA) { srcc = 1280; nvalid = 24; } else { srcc = 0; nvalid = 0; }
            transpose_item(P.in[14] + (size_t)(64 * kb) * 5400 + srcc, 5400, nvalid, (bf16_t*)(ws + WS_WTIN) + (size_t)(32 * nb) * DM + 64 * kb, DM, scr, lane);
            continue;
        }
        it -= I_WIN;
        if (it < I_WBR) {
            const int kb = it / 32, nb = it % 32;
            const float* src = (kb < 8) ? P.in[25] + (size_t)(64 * kb) * DM : P.in[26] + (size_t)(64 * (kb - 8)) * DM;
            transpose_item(src + 32 * nb, DM, 32, (bf16_t*)(ws + WS_WTBR) + (size_t)(32 * nb) * DM + 64 * kb, DM, scr, lane);
            continue;
        }
        it -= I_WBR;
        if (it < I_WOUT) {
            const int kb = it / 32, nb = it % 32;
            transpose_item(P.in[27] + (size_t)(64 * kb) * DM + 32 * nb, DM, 32, (bf16_t*)(ws + WS_WTOUT) + (size_t)(32 * nb) * DM + 64 * kb, DM, scr, lane);
            continue;
        }
        it -= I_WOUT;
        {
            const int sb = it >> 5, pg = (it >> 1) & 15, which = it & 1;
            const int page = ((const int*)P.in[8])[sb * 16 + pg];
            const float* src = P.in[2 + which] + (size_t)page * 128 * 128;
            const float* pe = P.in[17 + which]; const float* w = P.in[19 + which];
            const int d0 = (2 * lane) & 63;
            float p0 = 0.f, p1 = 0.f;
#pragma unroll 8
            for (int r = 0; r < 32; ++r) { const f32x2 v = *(const f32x2*)(pe + r * 64 + d0); p0 += v[0]; p1 += v[1]; }
#pragma unroll
            for (int cb = 0; cb < 4; ++cb) {
                f32x2 v[32];
#pragma unroll
                for (int r = 0; r < 32; ++r) v[r] = __builtin_nontemporal_load((const f32x2*)(src + (size_t)(cb * 32 + r) * 128 + 2 * lane));
                float s0 = 0.f, s1 = 0.f;
#pragma unroll
                for (int r = 0; r < 32; ++r) { s0 += v[r][0]; s1 += v[r][1]; }
                scr[d0 * 8 + cb * 2 + (lane >> 5)] = (s0 + p0) * (1.0f / 32.0f); scr[(d0 + 1) * 8 + cb * 2 + (lane >> 5)] = (s1 + p1) * (1.0f / 32.0f);
            }
            asm volatile("s_waitcnt lgkmcnt(0)" ::: "memory");
            float a[8];
#pragma unroll
            for (int q = 0; q < 8; ++q) a[q] = 0.f;
#pragma unroll 8
            for (int d = 0; d < 64; ++d) { const float wv = w[d * 64 + lane]; const f32x4 pa = *(const LAS f32x4*)(scr + d * 8), pb = *(const LAS f32x4*)(scr + d * 8 + 4);
                a[0] += pa[0] * wv; a[1] += pa[1] * wv; a[2] += pa[2] * wv; a[3] += pa[3] * wv; a[4] += pb[0] * wv; a[5] += pb[1] * wv; a[6] += pb[2] * wv; a[7] += pb[3] * wv; }
            float* dst = (float*)(ws + (which ? WS_VCS : WS_KCS));
#pragma unroll
            for (int q = 0; q < 8; ++q) dst[((size_t)(sb * 2 + (q & 1)) * 64 + 4 * pg + (q >> 1)) * 64 + lane] = a[q];
            asm volatile("s_waitcnt lgkmcnt(0)" ::: "memory");
        }
    }
    float* rope = (float*)(ws + WS_ROPE);
    for (int i = gtid; i < 2049 * 32; i += NT) {
        const int pos = i >> 5, k = i & 31;
        const float inv = (float)exp(-(double)k * (1.0 / 32.0) * 9.210340371976184);
        const float ang = (float)pos * inv;
        rope[2 * i] = (float)cos((double)ang); rope[2 * i + 1] = (float)sin((double)ang);
    }
    bf16_t* tril = (bf16_t*)(ws + WS_TRIL);
    for (int i = gtid; i < 4 * 128 * 128; i += NT) { const int r = (i >> 7) & 127, cidx = i & 127; tril[i] = (cidx <= r) ? (bf16_t)f2bf(P.in[23][i]) : (bf16_t)0; }
    for (int tk = blockIdx.x; tk < 2 * NSB * 2; tk += gridDim.x) {
        const int w2 = tk >> 8, sb = (tk >> 1) & 127, half = tk & 1;
        const f32x4* src = (const f32x4*)P.in[6 + w2] + (size_t)sb * 512 * 32 + 32 + half * 8176; f32x4* dst = (f32x4*)(P.out + (w2 ? O_SVW : O_SKW)) + (size_t)sb * 512 * 32 + half * 8176;
        for (int i = threadIdx.x; i < 8176; i += 512) __builtin_nontemporal_store(__builtin_nontemporal_load(src + i), dst + i);
    }
}

__device__ __forceinline__ void p1_hrows(const Params& P, int gw, int NGW, int lane) {
    const float* MOD = (const float*)(P.ws + WS_MOD); bf16_t* H = (bf16_t*)(P.ws + WS_H); const float* ng = P.in[13];
    for (int row = gw; row < MPAD; row += NGW) {
        unsigned long long* o8 = (unsigned long long*)(H + (size_t)row * DM) + lane;
        if (row >= MTOT) {
#pragma unroll
            for (int j = 0; j < 4; ++j) o8[64 * j] = 0ull;
            continue; }
        const float* xr; const float* md;
        if (row < MP) { xr = P.in[0] + (size_t)row * DM; md = MOD + (size_t)(row >> 11) * 3072; } else { xr = P.in[1] + (size_t)(row - MP) * DM; md = MOD + (size_t)(8 + row - MP) * 3072; }
        f32x4 v[4]; float s = 0.f;
#pragma unroll
        for (int j = 0; j < 4; ++j) { v[j] = ((const f32x4*)xr)[lane + 64 * j]; s += (v[j][0] * v[j][0] + v[j][1] * v[j][1]) + (v[j][2] * v[j][2] + v[j][3] * v[j][3]); }
        const float rstd = rsqrtf(wave_sum(s) * (1.0f / DM) + 1e-6f);
#pragma unroll
        for (int j = 0; j < 4; ++j) {
            const int col = 4 * lane + 256 * j;
            const f32x4 g = *(const f32x4*)(ng + col), sh = *(const f32x4*)(md + col), sc = *(const f32x4*)(md + 1024 + col);
            const f32x4 h = (v[j] * rstd) * g * (sc + 1.0f) + sh;
            o8[64 * j] = (unsigned long long)pk2(h[0], h[1]) | ((unsigned long long)pk2(h[2], h[3]) << 32);
        }
    }
}

__device__ __forceinline__ void p3_compress(const Params& P, LAS unsigned char* lds, int gw, int NGW, int lane, int wave) {
    LAS float* scr = (LAS float*)(lds + wave * 1024);
    for (int it = gw; it < NBATCH * 64 * 2 * 2; it += NGW) {
        const int b = it >> 8, c = (it >> 2) & 63, kvh = (it >> 1) & 1, which = it & 1;
        const float* src = P.out + (which ? O_PVC : O_PKC) + ((size_t)(b * SEQ + 32 * c) * 2 + kvh) * 64;
        const float* pe = P.in[17 + which]; const float* w = P.in[19 + which];
        float s = 0.f;
#pragma unroll 8
        for (int r = 0; r < 32; ++r) s += src[(size_t)r * 128 + lane] + pe[r * 64 + lane];
        scr[lane] = s * (1.0f / 32.0f);
        asm volatile("s_waitcnt lgkmcnt(0)" ::: "memory");
        float a = 0.f;
#pragma unroll 8
        for (int d = 0; d < 64; ++d) a += scr[d] * w[d * 64 + lane];
        if (which == 0) ((bf16_t*)(P.ws + WS_KC))[((size_t)(b * 64 + c) * 2 + kvh) * 64 + lane] = (bf16_t)f2bf(a);
        else ((bf16_t*)(P.ws + WS_VCT))[((size_t)(b * 2 + kvh) * 64 + lane) * 64 + c] = (bf16_t)f2bf(a);
        asm volatile("s_waitcnt lgkmcnt(0)" ::: "memory");
    }
}

constexpr int KPITCH = 72;
constexpr int A_KS = 0, A_VTS = 18432, A_IMP = 36864, A_IMPS = A_IMP + 8 * 32 * 33 * 4, A_SEL = A_IMPS + 2 * 32 * 33 * 4, A_OA = A_SEL + 256;
static_assert(A_OA + 8 * 8192 <= LDS_BYTES, "attention LDS map");

__device__ __forceinline__ void attn_load_tile(LAS unsigned char* lds, const bf16_t* kb, size_t kpitch, const bf16_t* vt0, const bf16_t* vt1, size_t vpitch, int tid_in) {
    int tid = tid_in; asm volatile("" : "+v"(tid));
    LAS bf16_t* Ks = (LAS bf16_t*)(lds + A_KS); LAS bf16_t* Vts = (LAS bf16_t*)(lds + A_VTS);
#pragma unroll
    for (int i = 0; i < 2; ++i) {
        const int idx = tid + 512 * i;
        { const int key = idx >> 4, ch = idx & 15; const u32x4 v = *(const u32x4*)(kb + (size_t)key * kpitch + ch * 8); *(LAS u32x4*)(Ks + ((ch >> 3) * 64 + key) * KPITCH + (ch & 7) * 8) = v; }
        { const int kvh = idx >> 9, d = (idx >> 3) & 63, ch = idx & 7; const u32x4 v = *(const u32x4*)((kvh ? vt1 : vt0) + (size_t)d * vpitch + ch * 8); *(LAS u32x4*)(Vts + (kvh * 64 + d) * KPITCH + ch * 8) = v; }
    }
}

template <int MODE>
__device__ __forceinline__ void attn_tile(const LAS bf16_t* Kg, const LAS bf16_t* Vg, const bf16x8 (&qf)[2][2], f32x4 (&O)[4][2], float (&mrun)[2], float (&lrun)[2], f32x4 (&s)[2][4],
                                          int lane_in, int kbase, const int (&qpos)[2], const unsigned (&selm)[2], int jblk) {
    int lane = lane_in; asm volatile("" : "+v"(lane));
    const int lr = lane & 15, grp = lane >> 4;
#pragma unroll
    for (int kt = 0; kt < 4; ++kt) {
        const bf16x8 k0 = *(const LAS bf16x8*)(Kg + (16 * kt + lr) * KPITCH + 8 * grp);
        const bf16x8 k1 = *(const LAS bf16x8*)(Kg + (16 * kt + lr) * KPITCH + 32 + 8 * grp);
#pragma unroll
        for (int qt = 0; qt < 2; ++qt) {
            f32x4 a = __builtin_amdgcn_mfma_f32_16x16x32_bf16(k0, qf[qt][0], (f32x4){0.f, 0.f, 0.f, 0.f}, 0, 0, 0);
            s[qt][kt] = __builtin_amdgcn_mfma_f32_16x16x32_bf16(k1, qf[qt][1], a, 0, 0, 0);
        }
        __builtin_amdgcn_sched_barrier(0);
    }
#pragma unroll
    for (int qt = 0; qt < 2; ++qt) {
        float mx = NEGBIG;
#pragma unroll
        for (int kt = 0; kt < 4; ++kt)
#pragma unroll
            for (int r = 0; r < 4; ++r) {
                const int key = 16 * kt + 4 * grp + r;
                bool valid;
                if (MODE == 0) valid = key < ((qpos[qt] + 1) >> 5);
                else if (MODE == 1) valid = ((selm[qt] >> jblk) & 1u) && (64 * jblk + key <= qpos[qt]);
                else { const int kp = kbase + key; valid = (kp <= qpos[qt]) && (kp > qpos[qt] - 512); }
                const float v = valid ? s[qt][kt][r] : NEGBIG;
                s[qt][kt][r] = v; mx = fmaxf(mx, v);
            }
        mx = fmaxf(mx, __shfl_xor(mx, 16)); mx = fmaxf(mx, __shfl_xor(mx, 32));
        const float mnew = fmaxf(mrun[qt], mx);
        const float alpha = __builtin_amdgcn_exp2f(mrun[qt] - mnew);
        mrun[qt] = mnew;
        float ls = 0.f;
#pragma unroll
        for (int kt = 0; kt < 4; ++kt)
#pragma unroll
            for (int r = 0; r < 4; ++r) { const float p = __builtin_amdgcn_exp2f(s[qt][kt][r] - mnew); s[qt][kt][r] = p; ls += p; }
        lrun[qt] = lrun[qt] * alpha + ls;
#pragma unroll
        for (int dt = 0; dt < 4; ++dt) O[dt][qt] *= alpha;
    }
#pragma unroll
    for (int c2 = 0; c2 < 2; ++c2) {
        bf16x8 pf[2];
#pragma unroll
        for (int qt = 0; qt < 2; ++qt) {
            u32x4 w; w.x = cvt_pk_bf16(s[qt][2 * c2][0], s[qt][2 * c2][1]); w.y = cvt_pk_bf16(s[qt][2 * c2][2], s[qt][2 * c2][3]);
            w.z = cvt_pk_bf16(s[qt][2 * c2 + 1][0], s[qt][2 * c2 + 1][1]); w.w = cvt_pk_bf16(s[qt][2 * c2 + 1][2], s[qt][2 * c2 + 1][3]);
            pf[qt] = __builtin_bit_cast(bf16x8, w);
        }
#pragma unroll
        for (int dt = 0; dt < 4; ++dt) {
            const u32x2 lo = *(const LAS u32x2*)(Vg + (16 * dt + lr) * KPITCH + 32 * c2 + 4 * grp);
            const u32x2 hi = *(const LAS u32x2*)(Vg + (16 * dt + lr) * KPITCH + 32 * c2 + 16 + 4 * grp);
            const u32x4 vv = {lo.x, lo.y, hi.x, hi.y};
            const bf16x8 vf = __builtin_bit_cast(bf16x8, vv);
#pragma unroll
            for (int qt = 0; qt < 2; ++qt) O[dt][qt] = __builtin_amdgcn_mfma_f32_16x16x32_bf16(vf, pf[qt], O[dt][qt], 0, 0, 0);
            __builtin_amdgcn_sched_barrier(0);
        }
    }
}

__device__ __forceinline__ void attn_unit(const Params& P, LAS unsigned char* lds, int b, int qb32, int tid, int lane, int wave) {
    asm volatile("" : "+v"(tid), "+v"(lane));
    const bf16_t* ACT = (const bf16_t*)(P.ws + WS_ACT); const bf16_t* VT = (const bf16_t*)(P.ws + WS_VT); bf16_t* AB = (bf16_t*)(P.ws + WS_AB);
    const int lr = lane & 15, grp = lane >> 4, g = wave >> 2;
    const int t0 = 32 * qb32, qblk = t0 >> 6; const size_t row0 = (size_t)b * SEQ + t0;
    const LAS bf16_t* Kg = (const LAS bf16_t*)(lds + A_KS) + g * 64 * KPITCH; const LAS bf16_t* Vg = (const LAS bf16_t*)(lds + A_VTS) + g * 64 * KPITCH;
    LAS float* IMP = (LAS float*)(lds + A_IMP); LAS float* IMPS = (LAS float*)(lds + A_IMPS); LAS unsigned* SEL = (LAS unsigned*)(lds + A_SEL);
    bf16x8 qf[2][2]; int qpos[2]; float gate[2][3];
#pragma unroll
    for (int qt = 0; qt < 2; ++qt) {
        const size_t row = row0 + 16 * qt + lr; qpos[qt] = t0 + 16 * qt + lr;
#pragma unroll
        for (int ks = 0; ks < 2; ++ks) qf[qt][ks] = *(const bf16x8*)(ACT + row * NIN + LQ + 64 * wave + 32 * ks + 8 * grp);
#pragma unroll
        for (int br = 0; br < 3; ++br) gate[qt][br] = bf2f(ACT[row * NIN + LNSA + 3 * wave + br]);
    }
    f32x4 O[4][2], s[2][4]; float mrun[2], lrun[2]; unsigned selm[2] = {0u, 0u};
    LAS float* OAl = (LAS float*)(lds + A_OA) + wave * 2048 + lane;
#pragma unroll
    for (int dt = 0; dt < 4; ++dt)
#pragma unroll
        for (int qt = 0; qt < 2; ++qt) O[dt][qt] = (f32x4){0.f, 0.f, 0.f, 0.f};
    mrun[0] = mrun[1] = MINIT; lrun[0] = lrun[1] = 0.f;
#define ATT_FINISH(br) do { _Pragma("unroll") for (int qt = 0; qt < 2; ++qt) { float lt = lrun[qt]; lt += __shfl_xor(lt, 16); lt += __shfl_xor(lt, 32); \
        const float f = (lt > 0.f) ? gate[qt][br] / lt : 0.f; _Pragma("unroll") for (int dt = 0; dt < 4; ++dt) _Pragma("unroll") for (int r = 0; r < 4; ++r) { \
            float v = O[dt][qt][r] * f; if ((br) > 0) v += OAl[64 * ((dt * 2 + qt) * 4 + r)]; if ((br) < 2) { OAl[64 * ((dt * 2 + qt) * 4 + r)] = v; O[dt][qt][r] = 0.f; } else O[dt][qt][r] = v; } \
        mrun[qt] = MINIT; lrun[qt] = 0.f; } } while (0)
    __syncthreads();
    attn_load_tile(lds, (const bf16_t*)(P.ws + WS_KC) + (size_t)b * 64 * 128, 128, (const bf16_t*)(P.ws + WS_VCT) + (size_t)(b * 2) * 4096, (const bf16_t*)(P.ws + WS_VCT) + (size_t)(b * 2 + 1) * 4096, 64, tid);
    __syncthreads();
    attn_tile<0>(Kg, Vg, qf, O, mrun, lrun, s, lane, 0, qpos, selm, 0);
#pragma unroll
    for (int qt = 0; qt < 2; ++qt) {
        float lt = lrun[qt]; lt += __shfl_xor(lt, 16); lt += __shfl_xor(lt, 32);
        const float inv = (lt > 0.f) ? 1.0f / lt : 0.f;
#pragma unroll
        for (int kt = 0; kt < 4; ++kt)
#pragma unroll
            for (int rr = 0; rr < 2; ++rr) IMP[(wave * 32 + 16 * qt + lr) * 33 + 8 * kt + 2 * grp + rr] = (s[qt][kt][2 * rr] + s[qt][kt][2 * rr + 1]) * inv;
    }
    ATT_FINISH(0);
    __syncthreads();
    for (int i = tid; i < 2 * 32 * 32; i += 512) { const int gg = i >> 10, q = (i >> 5) & 31, j = i & 31;
        IMPS[(gg * 32 + q) * 33 + j] = (IMP[((4 * gg + 0) * 32 + q) * 33 + j] + IMP[((4 * gg + 1) * 32 + q) * 33 + j]) + (IMP[((4 * gg + 2) * 32 + q) * 33 + j] + IMP[((4 * gg + 3) * 32 + q) * 33 + j]); }
    __syncthreads();
    if (tid < 64) {
        const int gg = tid >> 5, q = tid & 31;
        unsigned mask = 1u | (1u << qblk);
        if (qblk - 1 <= 6) mask = (qblk >= 31) ? 0xffffffffu : ((2u << qblk) - 1u);
        else {
            const LAS float* v = IMPS + (gg * 32 + q) * 33;
            for (int pick = 0; pick < 6; ++pick) { float best = -1.f; int bi = 1;
                for (int j = 1; j < qblk; ++j) { const float x = v[j]; if (!((mask >> j) & 1u) && x > best) { best = x; bi = j; } }
                mask |= 1u << bi; }
        }
        SEL[gg * 32 + q] = mask;
    }
    __syncthreads();
    selm[0] = SEL[g * 32 + lr]; selm[1] = SEL[g * 32 + 16 + lr];
    for (int jb = 0; jb <= qblk; ++jb) {
        __syncthreads();
        attn_load_tile(lds, ACT + ((size_t)b * SEQ + 64 * jb) * NIN + LK + 128, NIN, VT + ((size_t)(b * 6 + 2) * 64) * SEQ + 64 * jb, VT + ((size_t)(b * 6 + 3) * 64) * SEQ + 64 * jb, SEQ, tid);
        __syncthreads();
        const bool any = __any((int)(((selm[0] | selm[1]) >> jb) & 1u));
        if (any) attn_tile<1>(Kg, Vg, qf, O, mrun, lrun, s, lane, 64 * jb, qpos, selm, jb);
    }
    ATT_FINISH(1);
    { const int lo = (t0 - 511 > 0) ? ((t0 - 511) >> 6) : 0;
      for (int jt = lo; jt <= qblk; ++jt) {
        __syncthreads();
        attn_load_tile(lds, ACT + ((size_t)b * SEQ + 64 * jt) * NIN + LK + 256, NIN, VT + ((size_t)(b * 6 + 4) * 64) * SEQ + 64 * jt, VT + ((size_t)(b * 6 + 5) * 64) * SEQ + 64 * jt, SEQ, tid);
        __syncthreads();
        attn_tile<2>(Kg, Vg, qf, O, mrun, lrun, s, lane, 64 * jt, qpos, selm, 0);
      } }
    ATT_FINISH(2);
#undef ATT_FINISH
#pragma unroll
    for (int qt = 0; qt < 2; ++qt) {
        const size_t row = row0 + 16 * qt + lr;
#pragma unroll
        for (int dt = 0; dt < 4; ++dt) {
            const int col = 64 * wave + 16 * dt + 4 * grp;
            float za[4]; unpack4(*(const u32x2*)(ACT + row * NIN + LZA + col), za);
            u32x2 w; w.x = cvt_pk_bf16(O[dt][qt][0] * za[0], O[dt][qt][1] * za[1]); w.y = cvt_pk_bf16(O[dt][qt][2] * za[2], O[dt][qt][3] * za[3]);
            *(u32x2*)(AB + row * DM + col) = w;
        }
    }
}

constexpr int G_ST = 0, G_VNT = 1024, VPITCH = 136;
__device__ __forceinline__ void gmlp_unit(const Params& P, LAS unsigned char* lds, int b, int ch, int g, int tid, int lane, int wave) {
    const bf16_t* ACT = (const bf16_t*)(P.ws + WS_ACT); bf16_t* AB = (bf16_t*)(P.ws + WS_AB); const bf16_t* tril = (const bf16_t*)(P.ws + WS_TRIL) + (size_t)g * 128 * 128;
    LAS f32x2* ST = (LAS f32x2*)(lds + G_ST); LAS bf16_t* Vnt = (LAS bf16_t*)(lds + G_VNT);
    const size_t R0 = (size_t)b * SEQ + 128 * ch;
    __syncthreads();
    for (int j = wave; j < 128; j += 8) {
        const u32x4 raw = *(const u32x4*)(ACT + (R0 + j) * NIN + LVB + 8 * lane);
        float f[8]; f[0] = bf2f(raw.x); f[1] = bf2f(raw.x >> 16); f[2] = bf2f(raw.y); f[3] = bf2f(raw.y >> 16); f[4] = bf2f(raw.z); f[5] = bf2f(raw.z >> 16); f[6] = bf2f(raw.w); f[7] = bf2f(raw.w >> 16);
        float sm = 0.f;
#pragma unroll
        for (int i = 0; i < 8; ++i) sm += f[i];
        const float mean = wave_sum(sm) * (1.0f / 512.0f);
        float sq = 0.f;
#pragma unroll
        for (int i = 0; i < 8; ++i) { const float d = f[i] - mean; sq += d * d; }
        const float rstd = rsqrtf(wave_sum(sq) * (1.0f / 512.0f) + 1e-6f);
        if (lane == 0) ST[j] = (f32x2){mean, rstd};
    }
    __syncthreads();
    const float* vg = P.in[21] + 128 * g; const float* vb = P.in[22] + 128 * g;
#pragma unroll
    for (int i = 0; i < 4; ++i) {
        const int idx = tid + 512 * i, j = idx & 127, chn = idx >> 7;
        const u32x4 raw = *(const u32x4*)(ACT + (R0 + j) * NIN + LVB + 128 * g + 8 * chn);
        const f32x2 st = ST[j];
        float f[8]; f[0] = bf2f(raw.x); f[1] = bf2f(raw.x >> 16); f[2] = bf2f(raw.y); f[3] = bf2f(raw.y >> 16); f[4] = bf2f(raw.z); f[5] = bf2f(raw.z >> 16); f[6] = bf2f(raw.w); f[7] = bf2f(raw.w >> 16);
#pragma unroll
        for (int e = 0; e < 8; ++e) { const int d = 8 * chn + e; Vnt[d * VPITCH + j] = (bf16_t)f2bf((f[e] - st[0]) * st[1] * vg[d] + vb[d]); }
    }
    __syncthreads();
    const int lr = lane & 15, grp = lane >> 4;
    f32x4 acc[8];
#pragma unroll
    for (int it = 0; it < 8; ++it) acc[it] = (f32x4){0.f, 0.f, 0.f, 0.f};
#pragma unroll
    for (int ks = 0; ks < 4; ++ks) {
        const bf16x8 af = *(const LAS bf16x8*)(Vnt + (16 * wave + lr) * VPITCH + 32 * ks + 8 * grp);
#pragma unroll
        for (int it = 0; it < 8; ++it) {
            if ((it >> 1) >= ks) { const bf16x8 bfr = *(const bf16x8*)(tril + (size_t)(16 * it + lr) * 128 + 32 * ks + 8 * grp);
                acc[it] = __builtin_amdgcn_mfma_f32_16x16x32_bf16(af, bfr, acc[it], 0, 0, 0); }
        }
    }
    const float* bs = P.in[24] + 128 * g;
#pragma unroll
    for (int it = 0; it < 8; ++it) {
        const int i = 16 * it + lr; const size_t row = R0 + i; const int d0 = 128 * g + 16 * wave + 4 * grp;
        const float bsi = bs[i];
        float uu[4], zb[4]; unpack4(*(const u32x2*)(ACT + row * NIN + LU + d0), uu); unpack4(*(const u32x2*)(ACT + row * NIN + LZB + d0), zb);
        u32x2 w; w.x = cvt_pk_bf16(uu[0] * (acc[it][0] + bsi) * zb[0], uu[1] * (acc[it][1] + bsi) * zb[1]); w.y = cvt_pk_bf16(uu[2] * (acc[it][2] + bsi) * zb[2], uu[3] * (acc[it][3] + bsi) * zb[3]);
        *(u32x2*)(AB + row * DM + 512 + d0) = w;
    }
}

constexpr int S_Q = 0, S_KT = 1024, S_VT = S_KT + 64 * 65 * 4, S_SC = S_VT + 64 * 64 * 4, S_OB = S_SC + 4 * 576 * 4, S_MISC = S_OB + 2 * 256 * 4;
__device__ __forceinline__ void sample_unit(const Params& P, LAS unsigned char* lds, int sb, int g, int tid, int lane, int wave) {
    const bf16_t* ACT = (const bf16_t*)(P.ws + WS_ACT); bf16_t* AB = (bf16_t*)(P.ws + WS_AB);
    LAS float* Qs = (LAS float*)(lds + S_Q); LAS float* Kt = (LAS float*)(lds + S_KT); LAS float* Vt = (LAS float*)(lds + S_VT); LAS float* SC = (LAS float*)(lds + S_SC);
    LAS float* OB = (LAS float*)(lds + S_OB); LAS float* MISC = (LAS float*)(lds + S_MISC); LAS int* SELB = (LAS int*)(lds + S_MISC) + 8;
    const size_t row = (size_t)MP + sb;
    const int* ptab = (const int*)P.in[8] + sb * 16;
    __syncthreads();
    const int h_t = (tid >> 6) & 3, d_t = tid & 63;
    if (tid < 256) Qs[tid] = bf2f(ACT[row * NIN + LQ + 64 * (4 * g + h_t) + d_t]);
    float oacc = 0.f;
    for (int br = 0; br < 3; ++br) {
        const int nkeys = (br == 0) ? 64 : (br == 1) ? 449 : 512, ntile = (nkeys + 63) >> 6;
#define SROW(KV, kk, ptr) do { const int _kk = (kk); ptr = nullptr; \
        if (br == 0) { ptr = (const float*)(P.ws + ((KV) ? WS_VCS : WS_KCS)) + ((size_t)(sb * 2 + g) * 64 + _kk) * 64; } \
        else if (br == 1) { if (_kk < 448) { const int blk = SELB[_kk >> 6], r_ = _kk & 63; const int page = ptab[blk >> 1]; ptr = P.in[4 + (KV)] + (((size_t)page * 128 + (blk & 1) * 64 + r_) * 2 + g) * 64; } \
                            else if (_kk == 448) ptr = P.out + ((KV) ? O_SVS : O_SKS) + (size_t)sb * 128 + g * 64; } \
        else { if (_kk < 511) ptr = P.in[6 + (KV)] + (((size_t)sb * 512 + 1 + _kk) * 2 + g) * 64; else if (_kk == 511) ptr = P.out + ((KV) ? O_SVW : O_SKW) + ((size_t)(sb * 512 + 511) * 2 + g) * 64; } } while (0)
        for (int tl = 0; tl < ntile; ++tl) {
            __syncthreads();
#pragma unroll
            for (int i = 0; i < 2; ++i) { const int idx = tid + 512 * i, key = idx >> 4, c4 = idx & 15; const float* ptr; SROW(0, tl * 64 + key, ptr);
                f32x4 v = (f32x4){0.f, 0.f, 0.f, 0.f}; if (ptr) v = *(const f32x4*)(ptr + 4 * c4);
                LAS float* dst = Kt + key * 65 + 4 * c4; dst[0] = v[0]; dst[1] = v[1]; dst[2] = v[2]; dst[3] = v[3]; }
            __syncthreads();
            if (tid < 256) { const int key = tid & 63, hh = tid >> 6; float sc = 0.f;
#pragma unroll 8
                for (int d = 0; d < 64; ++d) sc += Qs[hh * 64 + d] * Kt[key * 65 + d];
                const int kk = tl * 64 + key; SC[hh * 576 + kk] = (kk < nkeys) ? sc : NEGBIG; }
        }
        __syncthreads();
        if (wave < 4) {
            const int np = ntile * 64; float mx = NEGBIG;
            for (int kk = lane; kk < np; kk += 64) mx = fmaxf(mx, SC[wave * 576 + kk]);
            mx = wave_max(mx); float ls = 0.f;
            for (int kk = lane; kk < np; kk += 64) { const float p = __builtin_amdgcn_exp2f(SC[wave * 576 + kk] - mx); SC[wave * 576 + kk] = p; ls += p; }
            ls = wave_sum(ls); if (lane == 0) MISC[wave] = ls;
        }
        __syncthreads();
        if (br == 0) {
            if (tid < 32) { float im = 0.f;
#pragma unroll
                for (int hh = 0; hh < 4; ++hh) im += (SC[hh * 576 + 2 * tid] + SC[hh * 576 + 2 * tid + 1]) / MISC[hh];
                MISC[16 + tid] = im; }
            __syncthreads();
            if (tid == 0) { unsigned mask = 1u; SELB[0] = 0;
                for (int pick = 0; pick < 6; ++pick) { float best = -1.f; int bi = 1;
                    for (int j = 1; j < 32; ++j) { const float x = MISC[16 + j]; if (!((mask >> j) & 1u) && x > best) { best = x; bi = j; } }
                    mask |= 1u << bi; SELB[1 + pick] = bi; } }
            __syncthreads();
        }
        float o = 0.f;
        for (int tl = 0; tl < ntile; ++tl) {
            __syncthreads();
#pragma unroll
            for (int i = 0; i < 2; ++i) { const int idx = tid + 512 * i, key = idx >> 4, c4 = idx & 15; const float* ptr; SROW(1, tl * 64 + key, ptr);
                f32x4 v = (f32x4){0.f, 0.f, 0.f, 0.f}; if (ptr) v = *(const f32x4*)(ptr + 4 * c4);
                *(LAS f32x4*)(Vt + key * 64 + 4 * c4) = v; }
            __syncthreads();
            { const int half = tid >> 8;
#pragma unroll 8
              for (int k2 = 0; k2 < 32; ++k2) { const int key = half * 32 + k2; o += SC[h_t * 576 + tl * 64 + key] * Vt[key * 64 + d_t]; } }
        }
#undef SROW
        __syncthreads();
        OB[tid] = o;
        __syncthreads();
        if (tid < 256) { const float gt = bf2f(ACT[row * NIN + LNSA + 3 * (4 * g + h_t) + br]); oacc += gt * (OB[tid] + OB[256 + tid]) / MISC[h_t]; }
    }
    if (tid < 256) { const int col = 64 * (4 * g + h_t) + d_t; AB[row * DM + col] = (bf16_t)f2bf(oacc * bf2f(ACT[row * NIN + LZA + col])); }
    if (wave == 0) {
        const u32x4 raw = *(const u32x4*)(ACT + row * NIN + LVB + 8 * lane);
        float f[8]; f[0] = bf2f(raw.x); f[1] = bf2f(raw.x >> 16); f[2] = bf2f(raw.y); f[3] = bf2f(raw.y >> 16); f[4] = bf2f(raw.z); f[5] = bf2f(raw.z >> 16); f[6] = bf2f(raw.w); f[7] = bf2f(raw.w >> 16);
        float sm = 0.f;
#pragma unroll
        for (int i = 0; i < 8; ++i) sm += f[i];
        const float mean = wave_sum(sm) * (1.0f / 512.0f); float sq = 0.f;
#pragma unroll
        for (int i = 0; i < 8; ++i) { const float d = f[i] - mean; sq += d * d; }
        const float rstd = rsqrtf(wave_sum(sq) * (1.0f / 512.0f) + 1e-6f);
        if (lane == 0) { MISC[48] = mean; MISC[49] = rstd; }
    }
    __syncthreads();
    if (tid < 256) {
        const int d = 256 * g + tid, gm = d >> 7;
        const float vn = (bf2f(ACT[row * NIN + LVB + d]) - MISC[48]) * MISC[49] * P.in[21][d] + P.in[22][d];
        P.out[O_SVCH + (size_t)sb * 512 + d] = vn;
        const float sv = P.in[23][(size_t)gm * 128 * 128] * vn + P.in[24][gm * 128];
        AB[row * DM + 512 + d] = (bf16_t)f2bf(bf2f(ACT[row * NIN + LU + d]) * sv * bf2f(ACT[row * NIN + LZB + d]));
    }
}

template <int MODE>
__device__ __forceinline__ void small_gemm(const Params& P, int c, int G, int wave, int lane) {
    const int lr = lane & 15, grp = lane >> 4;
    for (int t = c + G * wave; t < 512; t += G * 8) {
        const int rt = t & 7, ct = t >> 3;
        const size_t row = (size_t)MP + 16 * rt + lr;
        const bf16_t* A = (const bf16_t*)(P.ws + (MODE == 0 ? WS_AB : WS_H)) + row * DM + 8 * grp;
        const bf16_t* W = (const bf16_t*)(P.ws + (MODE == 0 ? WS_WTBR : WS_WTOUT)) + (size_t)(16 * ct + lr) * DM + 8 * grp;
        f32x4 acc0 = (f32x4){0.f, 0.f, 0.f, 0.f}, acc1 = (f32x4){0.f, 0.f, 0.f, 0.f};
#pragma unroll 8
        for (int ks = 0; ks < 16; ++ks) acc0 = __builtin_amdgcn_mfma_f32_16x16x32_bf16(*(const bf16x8*)(W + 32 * ks), *(const bf16x8*)(A + 32 * ks), acc0, 0, 0, 0);
#pragma unroll 8
        for (int ks = 16; ks < 32; ++ks) acc1 = __builtin_amdgcn_mfma_f32_16x16x32_bf16(*(const bf16x8*)(W + 32 * ks), *(const bf16x8*)(A + 32 * ks), acc1, 0, 0, 0);
        const int col = 16 * ct + 4 * grp;
        if (MODE == 0) {
            const bf16_t* ACT = (const bf16_t*)(P.ws + WS_ACT);
            float sa[4], sb[4]; unpack4(*(const u32x2*)(ACT + row * NIN + LGA + col), sa); unpack4(*(const u32x2*)(ACT + row * NIN + LGB + col), sb);
            u32x2 w; w.x = cvt_pk_bf16(sa[0] * acc0[0] + sb[0] * acc1[0], sa[1] * acc0[1] + sb[1] * acc1[1]); w.y = cvt_pk_bf16(sa[2] * acc0[2] + sb[2] * acc1[2], sa[3] * acc0[3] + sb[3] * acc1[3]);
            *(u32x2*)((bf16_t*)(P.ws + WS_H) + row * DM + col) = w;
        } else {
            const int sbi = 16 * rt + lr;
            const f32x4 xv = *(const f32x4*)(P.in[1] + (size_t)sbi * DM + col), gv = *(const f32x4*)((const float*)(P.ws + WS_MOD) + (size_t)(8 + sbi) * 3072 + 2048 + col);
            *(f32x4*)(P.out + O_YS + (size_t)sbi * DM + col) = xv + gv * (acc0 + acc1);
        }
    }
}

#define XB_TMO      128
#define XB_XCNT(j)  (256  + 64 * (j))
#define XB_XSUB(j)  (1280 + 64 * (j))
#define XB_XGEN(j)  (2304 + 64 * (j))
#define XB_TOP      3328
#define XB_TOPGEN   3392
#define XCD_BAR_WORDS 3456
#define XB_SPIN_CAP (1u << 18)
__device__ __forceinline__ unsigned xb_ld(unsigned* p)              { return __hip_atomic_load(p, __ATOMIC_RELAXED, __HIP_MEMORY_SCOPE_AGENT); }
__device__ __forceinline__ unsigned xb_add(unsigned* p, unsigned v) { return __hip_atomic_fetch_add(p, v, __ATOMIC_RELAXED, __HIP_MEMORY_SCOPE_AGENT); }
__device__ __forceinline__ unsigned xb_xcc_id() { return (unsigned)__builtin_amdgcn_s_getreg((3 << 11) | 20) & 0xFu; }
#define XB_SPIN(cond, bar) do { unsigned _sp = 0; while (cond) { __builtin_amdgcn_s_sleep(1); \
    if ((++_sp & 255u) == 0u) { if (xb_ld(&(bar)[XB_TMO])) break; if (_sp > XB_SPIN_CAP) { atomicAdd(&(bar)[XB_TMO], 1u); break; } } } } while (0)
struct XcdBarrier { unsigned* bar; unsigned x; volatile LAS unsigned* st; };
__device__ __forceinline__ XcdBarrier xcd_barrier_post(unsigned* bar, volatile LAS unsigned* st) {
    XcdBarrier b; b.bar = bar; b.x = xb_xcc_id(); b.st = st;
    if (threadIdx.x == 0) (void)xb_add(&bar[XB_XCNT(b.x)], 1u);
    return b;
}
__device__ __forceinline__ void xcd_barrier_complete(unsigned* bar, unsigned x, unsigned& nloc, unsigned& nx) {
    const unsigned G = gridDim.x * gridDim.y * gridDim.z;
    unsigned sum, cnt, mine, sp = 0u;
    for (;;) {
        sum = 0u; cnt = 0u; mine = 0u;
#pragma unroll
        for (unsigned j = 0; j < 16; ++j) { const unsigned c = xb_ld(&bar[XB_XCNT(j)]); sum += c; cnt += (c > 0u) ? 1u : 0u; mine = (j == x) ? c : mine; }
        if (sum == G) break;
        __builtin_amdgcn_s_sleep(1);
        if ((++sp & 255u) == 0u) { if (xb_ld(&bar[XB_TMO])) break; if (sp > XB_SPIN_CAP) { atomicAdd(&bar[XB_TMO], 1u); break; } }
    }
    nloc = mine > 0u ? mine : 1u; nx = cnt > 0u ? cnt : 1u;
}
__device__ __forceinline__ void xcd_barrier(const XcdBarrier& b) {
    asm volatile("s_waitcnt vmcnt(0)" ::: "memory");
    __syncthreads();
    if (threadIdx.x == 0) {
        unsigned* bar = b.bar;
        __builtin_amdgcn_s_waitcnt(0);
        unsigned nloc = b.st[0], nx = b.st[1];
        if (nloc == 0u) { xcd_barrier_complete(bar, b.x, nloc, nx); b.st[0] = nloc; b.st[1] = nx; }
        const unsigned old = xb_add(&bar[XB_XSUB(b.x)], 1u);
        const unsigned gen = old / nloc;
        if (old + 1u == (gen + 1u) * nloc) {
            __builtin_amdgcn_fence(__ATOMIC_RELEASE, "agent");
            asm volatile("s_waitcnt vmcnt(0)" ::: "memory");
            const unsigned og = xb_add(&bar[XB_TOP], 1u);
            const unsigned tg = og / nx;
            if (og + 1u == (tg + 1u) * nx) xb_add(&bar[XB_TOPGEN], 1u);
            else XB_SPIN(xb_ld(&bar[XB_TOPGEN]) == tg, bar);
            __builtin_amdgcn_fence(__ATOMIC_ACQUIRE, "agent");
            xb_add(&bar[XB_XGEN(b.x)], 1u);
            asm volatile("s_waitcnt vmcnt(0)" ::: "memory");
        } else {
            XB_SPIN(xb_ld(&bar[XB_XGEN(b.x)]) == gen, bar);
            __builtin_amdgcn_fence(__ATOMIC_ACQUIRE, "agent");
            asm volatile("s_waitcnt vmcnt(0)" ::: "memory");
        }
    }
    __syncthreads();
}

__global__ void __launch_bounds__(512, 2) mk_fwd(Params P) {
    extern __shared__ __attribute__((aligned(16))) unsigned char lds_raw[];
    LAS unsigned char* lds = (LAS unsigned char*)lds_raw;
    const int tid = threadIdx.x, lane = tid & 63, wave = __builtin_amdgcn_readfirstlane(tid >> 6);
    const int G = gridDim.x, c = blockIdx.x, gw = c * 8 + wave, NGW = G * 8, gtid = c * 512 + tid, NT = G * 512;
    cg::grid_group grid = cg::this_grid();
    const int lo = P.ph_lo, hi = P.ph_hi;
    if (tid < 16) ((LAS unsigned*)(lds + LDS_XB))[tid] = 0u;
    __syncthreads();
    const XcdBarrier bar = xcd_barrier_post((unsigned*)(P.ws + WS_CTL), (volatile LAS unsigned*)(lds + LDS_XB));
    if (hi < 0) grid.sync();
#define IN(k) (lo <= (k) && (k) < hi)
#define SEAM(k) do { if (IN(k) && IN((k) + 1)) xcd_barrier(bar); } while (0)
    unsigned char* ws = P.ws;
    if (IN(0)) for (int rep = 0; rep < MK_REP0; ++rep) { p0_prologue(P, lds, gw, NGW, lane, wave, gtid, NT); }
    SEAM(0);
    if (IN(1)) for (int rep = 0; rep < MK_REP1; ++rep) { p1_hrows(P, gw, NGW, lane); }
    SEAM(1);
    if (IN(2)) for (int rep = 0; rep < MK_REP2; ++rep) {
        pg8::Gemm gm{(const bf16_t*)(ws + WS_H), (const bf16_t*)(ws + WS_WTIN), DM, DM, DM};
        pg8::StaticOrder S; S.init(MPAD / 256, NIN / 256, G, c);
        EpiInProj E{(bf16_t*)(ws + WS_ACT), (bf16_t*)(ws + WS_VT), P.out, P.in[15], P.in[16], (const float*)(ws + WS_ROPE)};
        pg8::gemm_phase<EpiInProj, pg8::StaticOrder>(lds, gm, S, E);
    }
    SEAM(2);
    if (IN(3)) for (int rep = 0; rep < MK_REP3; ++rep) { p3_compress(P, lds, gw, NGW, lane, wave); }
    SEAM(3);
    if (IN(4)) for (int rep = 0; rep < MK_REP4; ++rep) {
        asm volatile("" ::: "memory");
        for (int i = 0;; ++i) { const int a = (i & 1) ? (i + 1) * G - 1 - c : i * G + c; if (a >= 512 || a < 0) break; attn_unit(P, lds, a & 7, 63 - (a >> 3), tid, lane, wave); }
        for (int su = c; su < 2 * NSB; su += G) sample_unit(P, lds, su >> 1, su & 1, tid, lane, wave);
        for (int gu = c; gu < 512; gu += G) gmlp_unit(P, lds, gu >> 6, (gu >> 2) & 15, gu & 3, tid, lane, wave);
        __syncthreads();
    }
    SEAM(4);
    if (IN(5)) for (int rep = 0; rep < MK_REP5; ++rep) {
        pg8::Gemm gm{(const bf16_t*)(ws + WS_AB), (const bf16_t*)(ws + WS_WTBR), DM, DM, 512};
        small_gemm<0>(P, c, G, wave, lane);
        pg8::PairOrder S; S.S.init(MP / 256, DM / 256, G, c);
        EpiMix E{(const bf16_t*)(ws + WS_ACT), (bf16_t*)(ws + WS_H)};
        pg8::gemm_phase<EpiMix, pg8::PairOrder>(lds, gm, S, E);
    }
    SEAM(5);
    if (IN(6)) for (int rep = 0; rep < MK_REP6; ++rep) {
        pg8::Gemm gm{(const bf16_t*)(ws + WS_H), (const bf16_t*)(ws + WS_WTOUT), DM, DM, DM};
        small_gemm<1>(P, c, G, wave, lane);
        pg8::StaticOrder S; S.init(MP / 256, DM / 256, G, c);
        EpiOut E{P.in[0], P.in[1], (const float*)(ws + WS_MOD), P.out};
        pg8::gemm_phase<EpiOut, pg8::StaticOrder>(lds, gm, S, E);
    }
#undef IN
#undef SEAM
}

extern "C" void kernel_launch(void* const* d_in, const int* in_sizes, int n_in, void* d_out, int out_size, void* d_ws, size_t ws_size, hipStream_t stream) {
    static int grid = 0;
    if (grid == 0) {
        if (n_in != 28 || out_size != (int)O_END || ws_size < WS_END) { fprintf(stderr, "kernel_launch: unexpected shapes (n_in %d, out %d, ws %zu); nothing launched\n", n_in, out_size, ws_size); grid = -1; return; }
        int dev = 0, cus = 0, per_cu = 0;
        if (hipGetDevice(&dev) != hipSuccess || hipDeviceGetAttribute(&cus, hipDeviceAttributeMultiprocessorCount, dev) != hipSuccess) { grid = -1; return; }
        if (hipFuncSetAttribute((const void*)mk_fwd, hipFuncAttributeMaxDynamicSharedMemorySize, LDS_BYTES) != hipSuccess) { fprintf(stderr, "kernel_launch: hipFuncSetAttribute failed\n"); grid = -1; return; }
        if (hipOccupancyMaxActiveBlocksPerMultiprocessor(&per_cu, (const void*)mk_fwd, 512, LDS_BYTES) != hipSuccess || per_cu < 1) { fprintf(stderr, "kernel_launch: occupancy query failed (%d)\n", per_cu); (void)hipGetLastError(); per_cu = 1; }
        if (per_cu > 1) per_cu = 1;
        grid = cus * per_cu;
    }
    if (grid < 0) return;
    if (hipMemsetAsync((char*)d_ws + WS_CTL, 0, CTL_BYTES, stream) != hipSuccess) { fprintf(stderr, "kernel_launch: hipMemsetAsync failed\n"); return; }
    Params p{};
    for (int i = 0; i < 28; ++i) p.in[i] = (const float*)d_in[i];
    p.out = (float*)d_out; p.ws = (unsigned char*)d_ws;
#if MK_N_LAUNCHES == 1
    p.ph_lo = 0; p.ph_hi = 7;
    void* args[] = {&p};
    hipError_t e = hipLaunchCooperativeKernel((const void*)mk_fwd, dim3(grid), dim3(512), args, LDS_BYTES, stream);
    if (e != hipSuccess) fprintf(stderr, "kernel_launch: cooperative launch failed: %s (grid %d)\n", hipGetErrorString(e), grid);
#else
    for (int ph = 0; ph < 7; ++ph) {
        p.ph_lo = ph; p.ph_hi = ph + 1;
        void* args[] = {&p};
        hipError_t e = hipLaunchCooperativeKernel((const void*)mk_fwd, dim3(grid), dim3(512), args, LDS_BYTES, stream);
        if (e != hipSuccess) { fprintf(stderr, "kernel_launch: launch %d failed: %s (grid %d)\n", ph, hipGetErrorString(e), grid); break; }
    }
#endif
}
```

```cpp
#include <hip/hip_runtime.h>
#include <hip/hip_cooperative_groups.h>
#include <cstdio>
#include <cstdint>
namespace cg = cooperative_groups;

#ifndef MK_N_LAUNCHES
#define MK_N_LAUNCHES 1
#endif
#define MK_REP0 1
#define MK_REP1 1
#define MK_REP2 1
#define MK_REP3 1
#define MK_REP4 1
#define MK_REP5 1
#define MK_REP6 1

#define LAS __attribute__((address_space(3)))
typedef unsigned short bf16_t;
typedef short bf16x8 __attribute__((ext_vector_type(8)));
typedef short bf16x4 __attribute__((ext_vector_type(4)));
typedef float f32x4 __attribute__((ext_vector_type(4)));
typedef float f32x2 __attribute__((ext_vector_type(2)));
typedef unsigned u32x4 __attribute__((ext_vector_type(4)));
typedef unsigned u32x2 __attribute__((ext_vector_type(2)));

constexpr int DM = 1024, SEQ = 2048, NBATCH = 8, MP = NBATCH * SEQ, NSB = 128, MTOT = MP + NSB, MPAD = 16640;
constexpr int NIN = 5632;
constexpr int LQ = 0, LK = 512, LV = 896, LZA = 1280, LU = 1792, LVB = 2304, LZB = 2816, LGA = 3328, LGB = 4352, LNSA = 5376;
constexpr float C2Q = 0.125f * 1.4426950408889634f;
constexpr float NEGBIG = -1e30f, MINIT = -1e29f;
constexpr size_t O_YP = 0, O_YS = 16777216, O_PKC = 16908288, O_PVC = 19005440, O_PKS = 21102592, O_PVS = 23199744, O_PKW = 25296896, O_PVW = 25821184,
                 O_SKC = 26345472, O_SVC = 26361856, O_SKS = 26378240, O_SVS = 26394624, O_SKW = 26411008, O_SVW = 34799616, O_SVCH = 43188224, O_END = 43253760;
constexpr size_t MiB = 1u << 20;
constexpr size_t WS_ROPE = 0, WS_MOD = 1 * MiB, WS_WTIN = 3 * MiB, WS_WTBR = 14 * MiB, WS_WTOUT = 16 * MiB, WS_TRIL = 18 * MiB, WS_KC = 18 * MiB + 512 * 1024, WS_VCT = WS_KC + 128 * 1024,
                 WS_KCS = 19 * MiB, WS_VCS = 23 * MiB, WS_VT = 27 * MiB, WS_H = 40 * MiB, WS_AB = 73 * MiB, WS_ACT = 106 * MiB, WS_END = 285 * MiB;
constexpr size_t WS_CTL = 768 * 1024, CTL_BYTES = 16384;
constexpr int LDS_BYTES = 147456, LDS_XB = LDS_BYTES - 64;

struct Params { const float* in[28]; float* out; unsigned char* ws; int ph_lo, ph_hi; };

__device__ __forceinline__ unsigned f2bf(float f) { unsigned u = __builtin_bit_cast(unsigned, f); return (u + 0x7fffu + ((u >> 16) & 1u)) >> 16; }
__device__ __forceinline__ unsigned pk2(float lo, float hi) { return f2bf(lo) | (f2bf(hi) << 16); }
__device__ __forceinline__ float bf2f(unsigned b) { return __builtin_bit_cast(float, (b & 0xffffu) << 16); }
__device__ __forceinline__ unsigned cvt_pk_bf16(float lo, float hi) { unsigned r; asm volatile("v_cvt_pk_bf16_f32 %0, %1, %2" : "=v"(r) : "v"(lo), "v"(hi)); return r; }
__device__ __forceinline__ float sigmoidf_(float x) { return 1.0f / (1.0f + __expf(-x)); }
__device__ __forceinline__ float wave_sum(float v) {
#pragma unroll
    for (int o = 1; o < 64; o <<= 1) v += __shfl_xor(v, o);
    return v;
}
__device__ __forceinline__ float wave_max(float v) {
#pragma unroll
    for (int o = 1; o < 64; o <<= 1) v = fmaxf(v, __shfl_xor(v, o));
    return v;
}
__device__ __forceinline__ void unpack4(u32x2 w, float (&f)[4]) { f[0] = bf2f(w.x); f[1] = bf2f(w.x >> 16); f[2] = bf2f(w.y); f[3] = bf2f(w.y >> 16); }

namespace pg8 {
constexpr int BM = 256, BK = 64, HALF = 128, HTB = HALF * BK * 2, STAGE_BYTES = 8 * HTB, NXCD = 8, WGM = 8;
__host__ __device__ __forceinline__ int lds_byte(int r, int c) { const int st = (r >> 4) * 2 + (c >> 5), rr = r & 15, cc = c & 31, ob = rr * 64 + cc * 2; return st * 1024 + (ob ^ (((ob >> 9) & 1) << 5)); }
__host__ __device__ __forceinline__ void stage_rc(int b, int& R, int& C) { const int st = b / 1024, sb = b % 1024, swz = sb ^ (((sb >> 9) & 1) << 5); R = (st >> 1) * 16 + swz / 64; C = (st & 1) * 32 + (swz % 64) / 2; }

struct Unit { int pm, pn, kofs, keep; };
struct Gemm { const bf16_t* A; const bf16_t* Bt; int lda, ldb, K; };

struct StaticOrder {
    int nM, nN, nwg, G, c;
    __device__ void init(int nM_, int nN_, int G_, int c_) { nM = nM_; nN = nN_; nwg = nM * nN; G = G_; c = c_; }
    __device__ bool tile(int i, int& pm, int& pn) const {
        const long L = (long)i * G + c; if (L >= nwg) return false;
        int wgid = (int)L; { const int q = nwg / NXCD, r = nwg % NXCD, xcd = wgid % NXCD, off = wgid / NXCD; wgid = (xcd < r ? xcd * (q + 1) : r * (q + 1) + (xcd - r) * q) + off; }
        const int nig = WGM * nN, gid = wgid / nig, fm = gid * WGM, gsz = (nM - fm) < WGM ? (nM - fm) : WGM;
        pm = fm + ((wgid % nig) % gsz); pn = (wgid % nig) / gsz; return true;
    }
    __device__ bool next(int i, Unit& u) const { u.kofs = 0; u.keep = 0; return tile(i, u.pm, u.pn); }
};
struct PairOrder {
    StaticOrder S;
    __device__ bool next(int i, Unit& u) const { u.kofs = (i & 1) * 512; u.keep = (i & 1) ? 0 : 1; return S.tile(i >> 1, u.pm, u.pn); }
};

template <class Epi, class Sched>
__device__ __forceinline__ void gemm_phase(LAS unsigned char* lds, const Gemm g, const Sched& S, const Epi& E) {
    const int tid = threadIdx.x, wid = __builtin_amdgcn_readfirstlane(tid >> 6), lane = tid & 63, wr = wid >> 2, wc = wid & 3, fr = lane & 15, fq = lane >> 4;
    const int nt = g.K / BK;
    unsigned voffA[2], voffB[2];
#pragma unroll
    for (int i = 0; i < 2; ++i) { int R, C; stage_rc(tid * 16 + i * 8192, R, C); voffA[i] = (unsigned)(R * g.lda + C) * 2u; voffB[i] = (unsigned)(R * g.ldb + C) * 2u; }
    const size_t kstep = (size_t)(BK * 2);
    const size_t hstepA = (size_t)HALF * g.lda * 2, hstepB = (size_t)HALF * g.ldb * 2, tstepA = 2 * hstepA, tstepB = 2 * hstepB;
    const unsigned ldsw = (unsigned)wid * 1024u;
    const int aoff = lds_byte(wr * 64 + fr, fq * 8), boff = lds_byte(wc * 32 + fr, fq * 8);
#define PG8_SA(b, h) (((b) * 2 + (h)) * HTB)
#define PG8_SB(b, h) ((4 + (b) * 2 + (h)) * HTB)
#define PG8_STAGE(bufoff, gbase, voff) do { _Pragma("unroll") for (int _i = 0; _i < 2; ++_i) \
        __builtin_amdgcn_global_load_lds((const unsigned*)((const char*)(gbase) + (voff)[_i]), (LAS unsigned*)(lds + (bufoff) + ldsw + _i * 8192), 16, 0, 0); } while (0)
#define PG8_LDA(dst, b, h) do { _Pragma("unroll") for (int m = 0; m < 4; ++m) _Pragma("unroll") for (int k = 0; k < 2; ++k) dst[m][k] = *(const LAS bf16x8*)(lds + PG8_SA(b, h) + aoff + m * 2048 + k * 1024); } while (0)
#define PG8_LDB(dst, b, h) do { _Pragma("unroll") for (int n = 0; n < 2; ++n) _Pragma("unroll") for (int k = 0; k < 2; ++k) dst[n][k] = *(const LAS bf16x8*)(lds + PG8_SB(b, h) + boff + n * 2048 + k * 1024); } while (0)
#define PG8_MMA(ai, bj, At, Bt) do { __builtin_amdgcn_s_setprio(1); _Pragma("unroll") for (int m = 0; m < 4; ++m) _Pragma("unroll") for (int n = 0; n < 2; ++n) _Pragma("unroll") for (int k = 0; k < 2; ++k) \
        acc[ai][bj][m][n] = __builtin_amdgcn_mfma_f32_16x16x32_bf16(Bt[n][k], At[m][k], acc[ai][bj][m][n], 0, 0, 0); __builtin_amdgcn_s_setprio(0); } while (0)
#define PG8_WAIT_V(n) asm volatile("s_waitcnt vmcnt(" #n ")" ::: "memory")
#define PG8_WAIT_L(n) asm volatile("s_waitcnt lgkmcnt(" #n ")" ::: "memory")
#define PG8_BAR __builtin_amdgcn_s_barrier()
#define PG8_SCHED __builtin_amdgcn_sched_barrier(0)
    Unit cur, nxt; int ui = 0;
    if (!S.next(0, cur)) return;
    f32x4 acc[2][2][4][2];
#pragma unroll
    for (int a = 0; a < 2; ++a)
#pragma unroll
        for (int b = 0; b < 2; ++b)
#pragma unroll
            for (int m = 0; m < 4; ++m)
#pragma unroll
                for (int n = 0; n < 2; ++n) acc[a][b][m][n] = (f32x4){0.f, 0.f, 0.f, 0.f};
    bf16x8 At[4][2], B0[2][2], B1[2][2];
    const char* cA = (const char*)g.A + (size_t)cur.pm * tstepA + (size_t)cur.kofs * 2; const char* cB = (const char*)g.Bt + (size_t)cur.pn * tstepB + (size_t)cur.kofs * 2;
    PG8_STAGE(PG8_SB(0, 0), cB, voffB); PG8_STAGE(PG8_SB(0, 1), cB + hstepB, voffB); PG8_STAGE(PG8_SA(0, 0), cA, voffA); PG8_STAGE(PG8_SA(0, 1), cA + hstepA, voffA);
    if (wr == 1) PG8_BAR;
    PG8_WAIT_V(2); PG8_BAR;
    PG8_STAGE(PG8_SB(1, 0), cB + kstep, voffB); PG8_STAGE(PG8_SA(1, 0), cA + kstep, voffA); PG8_STAGE(PG8_SB(1, 1), cB + hstepB + kstep, voffB);
    PG8_WAIT_V(6); PG8_BAR;
    for (;;) {
        const bool has_next = S.next(ui + 1, nxt);
        const char* nA = has_next ? (const char*)g.A + (size_t)nxt.pm * tstepA + (size_t)nxt.kofs * 2 : cA; const char* nB = has_next ? (const char*)g.Bt + (size_t)nxt.pn * tstepB + (size_t)nxt.kofs * 2 : cB;
        for (int t = 0; t < nt; t += 2) {
            const bool last = (t == nt - 2);
            const char* a1 = cA + (size_t)(t + 1) * kstep;
            const char* a2 = last ? nA : cA + (size_t)(t + 2) * kstep; const char* b2 = last ? nB : cB + (size_t)(t + 2) * kstep;
            const char* a3 = a2 + kstep; const char* b3 = b2 + kstep;
            PG8_LDB(B0, 0, 0); PG8_LDB(B1, 0, 1); PG8_SCHED; PG8_LDA(At, 0, 0); PG8_STAGE(PG8_SA(1, 1), a1 + hstepA, voffA);
            PG8_WAIT_V(8); PG8_WAIT_L(0); PG8_BAR; PG8_MMA(0, 0, At, B0); PG8_MMA(0, 1, At, B1); PG8_BAR; PG8_SCHED;
            PG8_LDA(At, 0, 1); PG8_STAGE(PG8_SB(0, 0), b2, voffB); PG8_STAGE(PG8_SB(0, 1), b2 + hstepB, voffB); PG8_STAGE(PG8_SA(0, 0), a2, voffA);
            PG8_WAIT_V(8); PG8_WAIT_L(0); PG8_BAR; PG8_MMA(1, 0, At, B0); PG8_MMA(1, 1, At, B1); PG8_BAR; PG8_SCHED;
            PG8_LDB(B0, 1, 0); PG8_LDB(B1, 1, 1); PG8_SCHED; PG8_LDA(At, 1, 0); PG8_STAGE(PG8_SA(0, 1), a2 + hstepA, voffA);
            PG8_WAIT_V(8); PG8_WAIT_L(0); PG8_BAR; PG8_MMA(0, 0, At, B0); PG8_MMA(0, 1, At, B1); PG8_BAR; PG8_SCHED;
            PG8_LDA(At, 1, 1); PG8_STAGE(PG8_SB(1, 0), b3, voffB); PG8_STAGE(PG8_SB(1, 1), b3 + hstepB, voffB); PG8_STAGE(PG8_SA(1, 0), a3, voffA);
            PG8_WAIT_V(8); PG8_WAIT_L(0); PG8_BAR; PG8_MMA(1, 0, At, B0); PG8_MMA(1, 1, At, B1); PG8_BAR; PG8_SCHED;
        }
        if (wr == 0) PG8_BAR;
        E(acc, cur, wr, wc, fr, fq);
        if (!has_next) break;
        if (!cur.keep) {
#pragma unroll
            for (int a = 0; a < 2; ++a)
#pragma unroll
                for (int b = 0; b < 2; ++b)
#pragma unroll
                    for (int m = 0; m < 4; ++m)
#pragma unroll
                        for (int n = 0; n < 2; ++n) acc[a][b][m][n] = (f32x4){0.f, 0.f, 0.f, 0.f};
        }
        cur = nxt; cA = nA; cB = nB; ++ui;
        if (wr == 1) PG8_BAR;
    }
    PG8_WAIT_V(0);
    PG8_BAR;
#undef PG8_SA
#undef PG8_SB
#undef PG8_STAGE
#undef PG8_LDA
#undef PG8_LDB
#undef PG8_MMA
#undef PG8_WAIT_V
#undef PG8_WAIT_L
#undef PG8_BAR
#undef PG8_SCHED
}
}

struct EpiInProj {
    bf16_t* ACT; bf16_t* VT; float* out; const float* qng; const float* kng; const float* rope;
    __device__ __forceinline__ void operator()(f32x4 (&acc)[2][2][4][2], const pg8::Unit& u, int wr, int wc, int fr, int fq) const {
        const int pn = u.pn;
        int type = 0, slot = 0;
        if (pn < 2) { type = 1; slot = 4 * pn + wc; }
        else if (pn == 2 || (pn == 3 && wc < 2)) { type = 2; slot = 4 * (pn - 2) + wc; }
        else if (pn == 3 || pn == 4) { type = 3; slot = 4 * (pn - 3) + wc - 2; }
        const int rbase = u.pm * 256 + wr * 64 + fr;
        if (type == 1 || type == 2) {
            const float* gn = (type == 1) ? qng : kng;
            f32x4 g4[2][2];
#pragma unroll
            for (int bj = 0; bj < 2; ++bj)
#pragma unroll
                for (int n = 0; n < 2; ++n) g4[bj][n] = *(const f32x4*)(gn + 32 * bj + 16 * n + 4 * fq);
            const int br = slot >> 1, kvh = slot & 1;
#pragma unroll
            for (int ai = 0; ai < 2; ++ai)
#pragma unroll
                for (int m = 0; m < 4; ++m) {
                    const int row = rbase + ai * 128 + m * 16;
                    float ss = 0.f;
#pragma unroll
                    for (int bj = 0; bj < 2; ++bj)
#pragma unroll
                        for (int n = 0; n < 2; ++n) { const f32x4 v = acc[ai][bj][m][n]; ss += (v[0] * v[0] + v[1] * v[1]) + (v[2] * v[2] + v[3] * v[3]); }
                    ss += __shfl_xor(ss, 16); ss += __shfl_xor(ss, 32);
                    const float rinv = rsqrtf(ss * (1.0f / 64.0f) + 1e-6f);
                    const int pos = (row < MP) ? (row & (SEQ - 1)) : SEQ;
                    const bool live = row < MTOT;
                    long obase = -1;
                    if (type == 2 && live) {
                        if (row < MP) {
                            const int t = row & (SEQ - 1), b = row >> 11;
                            if (br == 0) obase = (long)O_PKC + (long)row * 128 + kvh * 64;
                            else if (br == 1) obase = (long)O_PKS + (long)row * 128 + kvh * 64;
                            else if (t >= 1536) obase = (long)O_PKW + ((long)(b * 512 + t - 1536) * 2 + kvh) * 64;
                        } else {
                            const int sb = row - MP;
                            if (br == 0) obase = (long)O_SKC + sb * 128 + kvh * 64;
                            else if (br == 1) obase = (long)O_SKS + sb * 128 + kvh * 64;
                            else obase = (long)O_SKW + ((long)(sb * 512 + 511) * 2 + kvh) * 64;
                        }
                    }
#pragma unroll
                    for (int n = 0; n < 2; ++n) {
                        const f32x4 cs0 = *(const f32x4*)(rope + ((size_t)pos * 32 + 16 * n + 4 * fq) * 2);
                        const f32x4 cs1 = *(const f32x4*)(rope + ((size_t)pos * 32 + 16 * n + 4 * fq) * 2 + 4);
                        const float cc[4] = {cs0[0], cs0[2], cs1[0], cs1[2]}, sn[4] = {cs0[1], cs0[3], cs1[1], cs1[3]};
                        f32x4 o0, o1;
#pragma unroll
                        for (int j = 0; j < 4; ++j) {
                            const float y0 = acc[ai][0][m][n][j] * rinv * g4[0][n][j], y1 = acc[ai][1][m][n][j] * rinv * g4[1][n][j];
                            o0[j] = y0 * cc[j] - y1 * sn[j]; o1[j] = y1 * cc[j] + y0 * sn[j];
                        }
                        if (live) {
                            const int dcol = 16 * n + 4 * fq;
                            if (type == 1) {
                                bf16_t* p = ACT + (size_t)row * NIN + LQ + 64 * slot + dcol;
                                u32x2 w0, w1; w0.x = cvt_pk_bf16(o0[0] * C2Q, o0[1] * C2Q); w0.y = cvt_pk_bf16(o0[2] * C2Q, o0[3] * C2Q); w1.x = cvt_pk_bf16(o1[0] * C2Q, o1[1] * C2Q); w1.y = cvt_pk_bf16(o1[2] * C2Q, o1[3] * C2Q);
                                *(u32x2*)p = w0; *(u32x2*)(p + 32) = w1;
                            } else {
                                bf16_t* p = ACT + (size_t)row * NIN + LK + 64 * slot + dcol;
                                u32x2 w0, w1; w0.x = cvt_pk_bf16(o0[0], o0[1]); w0.y = cvt_pk_bf16(o0[2], o0[3]); w1.x = cvt_pk_bf16(o1[0], o1[1]); w1.y = cvt_pk_bf16(o1[2], o1[3]);
                                *(u32x2*)p = w0; *(u32x2*)(p + 32) = w1;
                                if (obase >= 0) { *(f32x4*)(out + obase + dcol) = o0; *(f32x4*)(out + obase + 32 + dcol) = o1; }
                            }
                        }
                    }
                }
        } else if (type == 3) {
            const int br = slot >> 1, kvh = slot & 1;
#pragma unroll
            for (int ai = 0; ai < 2; ++ai)
#pragma unroll
                for (int m = 0; m < 4; ++m) {
                    const int row = rbase + ai * 128 + m * 16;
                    if (row < MTOT) {
                        long obase = -1;
                        if (row < MP) {
                            const int t = row & (SEQ - 1), b = row >> 11;
                            if (br == 0) obase = (long)O_PVC + (long)row * 128 + kvh * 64;
                            else if (br == 1) obase = (long)O_PVS + (long)row * 128 + kvh * 64;
                            else if (t >= 1536) obase = (long)O_PVW + ((long)(b * 512 + t - 1536) * 2 + kvh) * 64;
                            bf16_t* vt = VT + ((size_t)(b * 6 + slot) * 64) * SEQ + t;
#pragma unroll
                            for (int bj = 0; bj < 2; ++bj)
#pragma unroll
                                for (int n = 0; n < 2; ++n)
#pragma unroll
                                    for (int j = 0; j < 4; ++j) vt[(size_t)(32 * bj + 16 * n + 4 * fq + j) * SEQ] = (bf16_t)f2bf(acc[ai][bj][m][n][j]);
                        } else {
                            const int sb = row - MP;
                            if (br == 0) obase = (long)O_SVC + sb * 128 + kvh * 64;
                            else if (br == 1) obase = (long)O_SVS + sb * 128 + kvh * 64;
                            else obase = (long)O_SVW + ((long)(sb * 512 + 511) * 2 + kvh) * 64;
                        }
                        if (obase >= 0) {
#pragma unroll
                            for (int bj = 0; bj < 2; ++bj)
#pragma unroll
                                for (int n = 0; n < 2; ++n) *(f32x4*)(out + obase + 32 * bj + 16 * n + 4 * fq) = acc[ai][bj][m][n];
                        }
                    }
                }
        } else {
            const int mode = (pn <= 6) ? 1 : (pn <= 10) ? 0 : (pn <= 12) ? 1 : 2;
#pragma unroll
            for (int ai = 0; ai < 2; ++ai)
#pragma unroll
                for (int m = 0; m < 4; ++m) {
                    const int row = rbase + ai * 128 + m * 16;
                    if (row < MTOT) {
                        bf16_t* p = ACT + (size_t)row * NIN + 256 * pn + 64 * wc + 4 * fq;
#pragma unroll
                        for (int bj = 0; bj < 2; ++bj)
#pragma unroll
                            for (int n = 0; n < 2; ++n) {
                                f32x4 v = acc[ai][bj][m][n];
#pragma unroll
                                for (int j = 0; j < 4; ++j) { const float sg = sigmoidf_(v[j]); v[j] = (mode == 0) ? v[j] : (mode == 1) ? v[j] * sg : sg; }
                                u32x2 w; w.x = cvt_pk_bf16(v[0], v[1]); w.y = cvt_pk_bf16(v[2], v[3]);
                                *(u32x2*)(p + 32 * bj + 16 * n) = w;
                            }
                    }
                }
        }
    }
};

struct EpiMix {
    const bf16_t* ACT; bf16_t* M;
    __device__ __forceinline__ void operator()(f32x4 (&acc)[2][2][4][2], const pg8::Unit& u, int wr, int wc, int fr, int fq) const {
        const int rbase = u.pm * 256 + wr * 64 + fr, cbase = u.pn * 256 + wc * 32 + 4 * fq;
#pragma unroll
        for (int ai = 0; ai < 2; ++ai)
#pragma unroll
            for (int m = 0; m < 4; ++m) {
                const int row = rbase + ai * 128 + m * 16;
                const bool live = row < MTOT;
                const int rr = live ? row : 0;
#pragma unroll
                for (int bj = 0; bj < 2; ++bj)
#pragma unroll
                    for (int n = 0; n < 2; ++n) {
                        const int col = cbase + 128 * bj + 16 * n;
                        float sb[4]; unpack4(*(const u32x2*)(ACT + (size_t)rr * NIN + LGB + col), sb);
                        if (u.keep) {
                            float sa[4]; unpack4(*(const u32x2*)(ACT + (size_t)rr * NIN + LGA + col), sa);
#pragma unroll
                            for (int j = 0; j < 4; ++j) acc[ai][bj][m][n][j] *= sa[j] * __builtin_amdgcn_rcpf(sb[j]);
                        } else if (live) {
                            const f32x4 v = acc[ai][bj][m][n];
                            u32x2 w; w.x = cvt_pk_bf16(v[0] * sb[0], v[1] * sb[1]); w.y = cvt_pk_bf16(v[2] * sb[2], v[3] * sb[3]);
                            *(u32x2*)(M + (size_t)row * DM + col) = w;
                        }
                    }
            }
    }
};

struct EpiOut {
    const float* xp; const float* xs; const float* MOD; float* out;
    __device__ __forceinline__ void operator()(f32x4 (&acc)[2][2][4][2], const pg8::Unit& u, int wr, int wc, int fr, int fq) const {
        const int rbase = u.pm * 256 + wr * 64 + fr, cbase = u.pn * 256 + wc * 32 + 4 * fq;
#pragma unroll
        for (int ai = 0; ai < 2; ++ai)
#pragma unroll
            for (int m = 0; m < 4; ++m) {
                const int row = rbase + ai * 128 + m * 16;
                if (row < MTOT) {
                    const float* xr; const float* gr; float* orow;
                    if (row < MP) { xr = xp + (size_t)row * DM; gr = MOD + (size_t)(row >> 11) * 3072 + 2048; orow = out + O_YP + (size_t)row * DM; }
                    else { const int sb = row - MP; xr = xs + (size_t)sb * DM; gr = MOD + (size_t)(8 + sb) * 3072 + 2048; orow = out + O_YS + (size_t)sb * DM; }
#pragma unroll
                    for (int bj = 0; bj < 2; ++bj)
#pragma unroll
                        for (int n = 0; n < 2; ++n) {
                            const int col = cbase + 128 * bj + 16 * n;
                            const f32x4 xv = *(const f32x4*)(xr + col), gv = *(const f32x4*)(gr + col);
                            *(f32x4*)(orow + col) = xv + gv * acc[ai][bj][m][n];
                        }
                }
            }
    }
};

__device__ __forceinline__ void transpose_item(const float* src, int src_ld, int nvalid, bf16_t* dst, int dst_ld, LAS float* scr, int lane) {
#pragma unroll 8
    for (int i = 0; i < 32; ++i) { const int kk = 2 * i + (lane >> 5), cc = lane & 31; scr[kk * 33 + cc] = (cc < nvalid) ? src[(size_t)kk * src_ld + cc] : 0.f; }
    asm volatile("s_waitcnt lgkmcnt(0)" ::: "memory");
    const int c = lane & 7;
#pragma unroll
    for (int j = 0; j < 4; ++j) { const int n = (lane >> 3) + 8 * j; const LAS float* s = scr + (8 * c) * 33 + n;
        u32x4 o; o.x = pk2(s[0 * 33], s[1 * 33]); o.y = pk2(s[2 * 33], s[3 * 33]); o.z = pk2(s[4 * 33], s[5 * 33]); o.w = pk2(s[6 * 33], s[7 * 33]);
        *(u32x4*)(dst + (size_t)n * dst_ld + 8 * c) = o; }
    asm volatile("s_waitcnt lgkmcnt(0)" ::: "memory");
}

__device__ __forceinline__ void p0_prologue(const Params& P, LAS unsigned char* lds, int gw, int NGW, int lane, int wave, int gtid, int NT) {
    unsigned char* ws = P.ws;
    LAS float* scr = (LAS float*)(lds + wave * 16384);
    constexpr int I_MOD = 9 * 48, I_WIN = 16 * 176, I_WBR = 16 * 32, I_WOUT = 16 * 32, I_POOL = NSB * 16 * 2;
    constexpr int I_TOTAL = I_MOD + I_WIN + I_WBR + I_WOUT + I_POOL;
    for (int it0 = gw; it0 < I_TOTAL; it0 += NGW) {
        int it = it0;
        if (it < I_MOD) {
            const int mt = it / 48, ng = it % 48, lr = lane & 15, kq = lane >> 4;
            int arow_i = 16 * mt + lr; if (arow_i > 135) arow_i = 135;
            const float* arow = ((arow_i < 8) ? P.in[9] + (size_t)arow_i * DM : P.in[10] + (size_t)(arow_i - 8) * DM) + kq;
            const float* bp = P.in[11] + (size_t)kq * 3072 + 64 * ng + lr;
            f32x4 macc[4];
#pragma unroll
            for (int nt = 0; nt < 4; ++nt) macc[nt] = (f32x4){0.f, 0.f, 0.f, 0.f};
#pragma unroll 8
            for (int k0 = 0; k0 < DM; k0 += 4) {
                const float a = arow[k0];
#pragma unroll
                for (int nt = 0; nt < 4; ++nt) macc[nt] = __builtin_amdgcn_mfma_f32_16x16x4f32(a, bp[(size_t)k0 * 3072 + 16 * nt], macc[nt], 0, 0, 0);
            }
            float* MOD = (float*)(ws + WS_MOD);
#pragma unroll
            for (int nt = 0; nt < 4; ++nt) { const int n = 64 * ng + 16 * nt + lr; const float bb = P.in[12][n];
#pragma unroll
                for (int r = 0; r < 4; ++r) { const int row = 16 * mt + 4 * kq + r; if (row < 136) MOD[(size_t)row * 3072 + n] = macc[nt][r] + bb; } }
            continue;
        }
        it -= I_MOD;
        if (it < I_WIN) {
            const int kb = it / 176, nb = it % 176;
            const int pn = nb >> 3, bj = (nb >> 2) & 1, wc = nb & 3;
            const int L0 = 256 * pn + 64 * wc + 32 * bj;
            int srcc, nvalid;
            if (L0 < 1280) { srcc = L0; nvalid = 32; } else if (L0 < LNSA) { srcc = L0 + 24; nvalid = 32; } else if (L0 == LNSA) { srcc = 1280; nvalid = 24; } else { srcc = 0; nvalid = 0; }
            transpose_item(P.in[14] + (size_t)(64 * kb) * 5400 + srcc, 5400, nvalid, (bf16_t*)(ws + WS_WTIN) + (size_t)(32 * nb) * DM + 64 * kb, DM, scr, lane);
            continue;
        }
        it -= I_WIN;
        if (it < I_WBR) {
            const int kb = it / 32, nb = it % 32;
            const float* src = (kb < 8) ? P.in[25] + (size_t)(64 * kb) * DM : P.in[26] + (size_t)(64 * (kb - 8)) * DM;
            transpose_item(src + 32 * nb, DM, 32, (bf16_t*)(ws + WS_WTBR) + (size_t)(32 * nb) * DM + 64 * kb, DM, scr, lane);
            continue;
        }
        it -= I_WBR;
        if (it < I_WOUT) {
            const int kb = it / 32, nb = it % 32;
            transpose_item(P.in[27] + (size_t)(64 * kb) * DM + 32 * nb, DM, 32, (bf16_t*)(ws + WS_WTOUT) + (size_t)(32 * nb) * DM + 64 * kb, DM, scr, lane);
            continue;
        }
        it -= I_WOUT;
        {
            const int sb = it >> 5, pg = (it >> 1) & 15, which = it & 1;
            const int page = ((const int*)P.in[8])[sb * 16 + pg];
            const float* src = P.in[2 + which] + (size_t)page * 128 * 128;
            const float* pe = P.in[17 + which]; const float* w = P.in[19 + which];
            const int d0 = (2 * lane) & 63;
            float p0 = 0.f, p1 = 0.f;
#pragma unroll 8
            for (int r = 0; r < 32; ++r) { const f32x2 v = *(const f32x2*)(pe + r * 64 + d0); p0 += v[0]; p1 += v[1]; }
#pragma unroll
            for (int cb = 0; cb < 4; ++cb) {
                f32x2 v[32];
#pragma unroll
                for (int r = 0; r < 32; ++r) v[r] = __builtin_nontemporal_load((const f32x2*)(src + (size_t)(cb * 32 + r) * 128 + 2 * lane));
                float s0 = 0.f, s1 = 0.f;
#pragma unroll
                for (int r = 0; r < 32; ++r) { s0 += v[r][0]; s1 += v[r][1]; }
                scr[d0 * 8 + cb * 2 + (lane >> 5)] = (s0 + p0) * (1.0f / 32.0f); scr[(d0 + 1) * 8 + cb * 2 + (lane >> 5)] = (s1 + p1) * (1.0f / 32.0f);
            }
            asm volatile("s_waitcnt lgkmcnt(0)" ::: "memory");
            float a[8];
#pragma unroll
            for (int q = 0; q < 8; ++q) a[q] = 0.f;
#pragma unroll 8
            for (int d = 0; d < 64; ++d) { const float wv = w[d * 64 + lane]; const f32x4 pa = *(const LAS f32x4*)(scr + d * 8), pb = *(const LAS f32x4*)(scr + d * 8 + 4);
                a[0] += pa[0] * wv; a[1] += pa[1] * wv; a[2] += pa[2] * wv; a[3] += pa[3] * wv; a[4] += pb[0] * wv; a[5] += pb[1] * wv; a[6] += pb[2] * wv; a[7] += pb[3] * wv; }
            float* dst = (float*)(ws + (which ? WS_VCS : WS_KCS));
#pragma unroll
            for (int q = 0; q < 8; ++q) dst[((size_t)(sb * 2 + (q & 1)) * 64 + 4 * pg + (q >> 1)) * 64 + lane] = a[q];
            asm volatile("s_waitcnt lgkmcnt(0)" ::: "memory");
        }
    }
    float* rope = (float*)(ws + WS_ROPE);
    for (int i = gtid; i < 2049 * 32; i += NT) {
        const int pos = i >> 5, k = i & 31;
        const float inv = (float)exp(-(double)k * (1.0 / 32.0) * 9.210340371976184);
        const float ang = (float)pos * inv;
        rope[2 * i] = (float)cos((double)ang); rope[2 * i + 1] = (float)sin((double)ang);
    }
    bf16_t* tril = (bf16_t*)(ws + WS_TRIL);
    for (int i = gtid; i < 4 * 128 * 128; i += NT) { const int r = (i >> 7) & 127, cidx = i & 127; tril[i] = (cidx <= r) ? (bf16_t)f2bf(P.in[23][i]) : (bf16_t)0; }
    for (int tk = blockIdx.x; tk < 2 * NSB * 2; tk += gridDim.x) {
        const int w2 = tk >> 8, sb = (tk >> 1) & 127, half = tk & 1;
        const f32x4* src = (const f32x4*)P.in[6 + w2] + (size_t)sb * 512 * 32 + 32 + half * 8176; f32x4* dst = (f32x4*)(P.out + (w2 ? O_SVW : O_SKW)) + (size_t)sb * 512 * 32 + half * 8176;
        for (int i = threadIdx.x; i < 8176; i += 512) __builtin_nontemporal_store(__builtin_nontemporal_load(src + i), dst + i);
    }
}

__device__ __forceinline__ void p1_hrows(const Params& P, int gw, int NGW, int lane) {
    const float* MOD = (const float*)(P.ws + WS_MOD); bf16_t* H = (bf16_t*)(P.ws + WS_H); const float* ng = P.in[13];
    for (int row = gw; row < MPAD; row += NGW) {
        unsigned long long* o8 = (unsigned long long*)(H + (size_t)row * DM) + lane;
        if (row >= MTOT) {
#pragma unroll
            for (int j = 0; j < 4; ++j) o8[64 * j] = 0ull;
            continue; }
        const float* xr; const float* md;
        if (row < MP) { xr = P.in[0] + (size_t)row * DM; md = MOD + (size_t)(row >> 11) * 3072; } else { xr = P.in[1] + (size_t)(row - MP) * DM; md = MOD + (size_t)(8 + row - MP) * 3072; }
        f32x4 v[4]; float s = 0.f;
#pragma unroll
        for (int j = 0; j < 4; ++j) { v[j] = ((const f32x4*)xr)[lane + 64 * j]; s += (v[j][0] * v[j][0] + v[j][1] * v[j][1]) + (v[j][2] * v[j][2] + v[j][3] * v[j][3]); }
        const float rstd = rsqrtf(wave_sum(s) * (1.0f / DM) + 1e-6f);
#pragma unroll
        for (int j = 0; j < 4; ++j) {
            const int col = 4 * lane + 256 * j;
            const f32x4 g = *(const f32x4*)(ng + col), sh = *(const f32x4*)(md + col), sc = *(const f32x4*)(md + 1024 + col);
            const f32x4 h = (v[j] * rstd) * g * (sc + 1.0f) + sh;
            o8[64 * j] = (unsigned long long)pk2(h[0], h[1]) | ((unsigned long long)pk2(h[2], h[3]) << 32);
        }
    }
}

__device__ __forceinline__ void p3_compress(const Params& P, LAS unsigned char* lds, int gw, int NGW, int lane, int wave) {
    LAS float* scr = (LAS float*)(lds + wave * 1024);
    for (int it = gw; it < NBATCH * 64 * 2 * 2; it += NGW) {
        const int b = it >> 8, c = (it >> 2) & 63, kvh = (it >> 1) & 1, which = it & 1;
        const float* src = P.out + (which ? O_PVC : O_PKC) + ((size_t)(b * SEQ + 32 * c) * 2 + kvh) * 64;
        const float* pe = P.in[17 + which]; const float* w = P.in[19 + which];
        float s = 0.f;
#pragma unroll 8
        for (int r = 0; r < 32; ++r) s += src[(size_t)r * 128 + lane] + pe[r * 64 + lane];
        scr[lane] = s * (1.0f / 32.0f);
        asm volatile("s_waitcnt lgkmcnt(0)" ::: "memory");
        float a = 0.f;
#pragma unroll 8
        for (int d = 0; d < 64; ++d) a += scr[d] * w[d * 64 + lane];
        if (which == 0) ((bf16_t*)(P.ws + WS_KC))[((size_t)(b * 64 + c) * 2 + kvh) * 64 + lane] = (bf16_t)f2bf(a);
        else ((bf16_t*)(P.ws + WS_VCT))[((size_t)(b * 2 + kvh) * 64 + lane) * 64 + c] = (bf16_t)f2bf(a);
        asm volatile("s_waitcnt lgkmcnt(0)" ::: "memory");
    }
}

constexpr int KPITCH = 72;
constexpr int A_KS = 0, A_VTS = 18432, A_IMP = 36864, A_IMPS = A_IMP + 8 * 32 * 33 * 4, A_SEL = A_IMPS + 2 * 32 * 33 * 4, A_OA = A_SEL + 256;
static_assert(A_OA + 8 * 8192 <= LDS_BYTES, "attention LDS map");

__device__ __forceinline__ void attn_load_tile(LAS unsigned char* lds, const bf16_t* kb, size_t kpitch, const bf16_t* vt0, const bf16_t* vt1, size_t vpitch, int tid_in) {
    int tid = tid_in; asm volatile("" : "+v"(tid));
    LAS bf16_t* Ks = (LAS bf16_t*)(lds + A_KS); LAS bf16_t* Vts = (LAS bf16_t*)(lds + A_VTS);
#pragma unroll
    for (int i = 0; i < 2; ++i) {
        const int idx = tid + 512 * i;
        { const int key = idx >> 4, ch = idx & 15; const u32x4 v = *(const u32x4*)(kb + (size_t)key * kpitch + ch * 8); *(LAS u32x4*)(Ks + ((ch >> 3) * 64 + key) * KPITCH + (ch & 7) * 8) = v; }
        { const int kvh = idx >> 9, d = (idx >> 3) & 63, ch = idx & 7; const u32x4 v = *(const u32x4*)((kvh ? vt1 : vt0) + (size_t)d * vpitch + ch * 8); *(LAS u32x4*)(Vts + (kvh * 64 + d) * KPITCH + ch * 8) = v; }
    }
}

template <int MODE>
__device__ __forceinline__ void attn_tile(const LAS bf16_t* Kg, const LAS bf16_t* Vg, const bf16x8 (&qf)[2][2], f32x4 (&O)[4][2], float (&mrun)[2], float (&lrun)[2], f32x4 (&s)[2][4],
                                          int lane_in, int kbase, const int (&qpos)[2], const unsigned (&selm)[2], int jblk) {
    int lane = lane_in; asm volatile("" : "+v"(lane));
    const int lr = lane & 15, grp = lane >> 4;
#pragma unroll
    for (int kt = 0; kt < 4; ++kt) {
        const bf16x8 k0 = *(const LAS bf16x8*)(Kg + (16 * kt + lr) * KPITCH + 8 * grp);
        const bf16x8 k1 = *(const LAS bf16x8*)(Kg + (16 * kt + lr) * KPITCH + 32 + 8 * grp);
#pragma unroll
        for (int qt = 0; qt < 2; ++qt) {
            f32x4 a = __builtin_amdgcn_mfma_f32_16x16x32_bf16(k0, qf[qt][0], (f32x4){0.f, 0.f, 0.f, 0.f}, 0, 0, 0);
            s[qt][kt] = __builtin_amdgcn_mfma_f32_16x16x32_bf16(k1, qf[qt][1], a, 0, 0, 0);
        }
        __builtin_amdgcn_sched_barrier(0);
    }
#pragma unroll
    for (int qt = 0; qt < 2; ++qt) {
        float mx = NEGBIG;
#pragma unroll
        for (int kt = 0; kt < 4; ++kt)
#pragma unroll
            for (int r = 0; r < 4; ++r) {
                const int key = 16 * kt + 4 * grp + r;
                bool valid;
                if (MODE == 0) valid = key < ((qpos[qt] + 1) >> 5);
                else if (MODE == 1) valid = ((selm[qt] >> jblk) & 1u) && (64 * jblk + key <= qpos[qt]);
                else { const int kp = kbase + key; valid = (kp <= qpos[qt]) && (kp > qpos[qt] - 512); }
                const float v = valid ? s[qt][kt][r] : NEGBIG;
                s[qt][kt][r] = v; mx = fmaxf(mx, v);
            }
        mx = fmaxf(mx, __shfl_xor(mx, 16)); mx = fmaxf(mx, __shfl_xor(mx, 32));
        const float mnew = fmaxf(mrun[qt], mx);
        const float alpha = __builtin_amdgcn_exp2f(mrun[qt] - mnew);
        mrun[qt] = mnew;
        float ls = 0.f;
#pragma unroll
        for (int kt = 0; kt < 4; ++kt)
#pragma unroll
            for (int r = 0; r < 4; ++r) { const float p = __builtin_amdgcn_exp2f(s[qt][kt][r] - mnew); s[qt][kt][r] = p; ls += p; }
        lrun[qt] = lrun[qt] * alpha + ls;
#pragma unroll
        for (int dt = 0; dt < 4; ++dt) O[dt][qt] *= alpha;
    }
#pragma unroll
    for (int c2 = 0; c2 < 2; ++c2) {
        bf16x8 pf[2];
#pragma unroll
        for (int qt = 0; qt < 2; ++qt) {
            u32x4 w; w.x = cvt_pk_bf16(s[qt][2 * c2][0], s[qt][2 * c2][1]); w.y = cvt_pk_bf16(s[qt][2 * c2][2], s[qt][2 * c2][3]);
            w.z = cvt_pk_bf16(s[qt][2 * c2 + 1][0], s[qt][2 * c2 + 1][1]); w.w = cvt_pk_bf16(s[qt][2 * c2 + 1][2], s[qt][2 * c2 + 1][3]);
            pf[qt] = __builtin_bit_cast(bf16x8, w);
        }
#pragma unroll
        for (int dt = 0; dt < 4; ++dt) {
            const u32x2 lo = *(const LAS u32x2*)(Vg + (16 * dt + lr) * KPITCH + 32 * c2 + 4 * grp);
            const u32x2 hi = *(const LAS u32x2*)(Vg + (16 * dt + lr) * KPITCH + 32 * c2 + 16 + 4 * grp);
            const u32x4 vv = {lo.x, lo.y, hi.x, hi.y};
            const bf16x8 vf = __builtin_bit_cast(bf16x8, vv);
#pragma unroll
            for (int qt = 0; qt < 2; ++qt) O[dt][qt] = __builtin_amdgcn_mfma_f32_16x16x32_bf16(vf, pf[qt], O[dt][qt], 0, 0, 0);
            __builtin_amdgcn_sched_barrier(0);
        }
    }
}

__device__ __forceinline__ void attn_unit(const Params& P, LAS unsigned char* lds, int b, int qb32, int tid, int lane, int wave) {
    asm volatile("" : "+v"(tid), "+v"(lane));
    const bf16_t* ACT = (const bf16_t*)(P.ws + WS_ACT); const bf16_t* VT = (const bf16_t*)(P.ws + WS_VT); bf16_t* AB = (bf16_t*)(P.ws + WS_AB);
    const int lr = lane & 15, grp = lane >> 4, g = wave >> 2;
    const int t0 = 32 * qb32, qblk = t0 >> 6; const size_t row0 = (size_t)b * SEQ + t0;
    const LAS bf16_t* Kg = (const LAS bf16_t*)(lds + A_KS) + g * 64 * KPITCH; const LAS bf16_t* Vg = (const LAS bf16_t*)(lds + A_VTS) + g * 64 * KPITCH;
    LAS float* IMP = (LAS float*)(lds + A_IMP); LAS float* IMPS = (LAS float*)(lds + A_IMPS); LAS unsigned* SEL = (LAS unsigned*)(lds + A_SEL);
    bf16x8 qf[2][2]; int qpos[2]; float gate[2][3];
#pragma unroll
    for (int qt = 0; qt < 2; ++qt) {
        const size_t row = row0 + 16 * qt + lr; qpos[qt] = t0 + 16 * qt + lr;
#pragma unroll
        for (int ks = 0; ks < 2; ++ks) qf[qt][ks] = *(const bf16x8*)(ACT + row * NIN + LQ + 64 * wave + 32 * ks + 8 * grp);
#pragma unroll
        for (int br = 0; br < 3; ++br) gate[qt][br] = bf2f(ACT[row * NIN + LNSA + 3 * wave + br]);
    }
    f32x4 O[4][2], s[2][4]; float mrun[2], lrun[2]; unsigned selm[2] = {0u, 0u};
    LAS float* OAl = (LAS float*)(lds + A_OA) + wave * 2048 + lane;
#pragma unroll
    for (int dt = 0; dt < 4; ++dt)
#pragma unroll
        for (int qt = 0; qt < 2; ++qt) O[dt][qt] = (f32x4){0.f, 0.f, 0.f, 0.f};
    mrun[0] = mrun[1] = MINIT; lrun[0] = lrun[1] = 0.f;
#define ATT_FINISH(br) do { _Pragma("unroll") for (int qt = 0; qt < 2; ++qt) { float lt = lrun[qt]; lt += __shfl_xor(lt, 16); lt += __shfl_xor(lt, 32); \
        const float f = (lt > 0.f) ? gate[qt][br] / lt : 0.f; _Pragma("unroll") for (int dt = 0; dt < 4; ++dt) _Pragma("unroll") for (int r = 0; r < 4; ++r) { \
            float v = O[dt][qt][r] * f; if ((br) > 0) v += OAl[64 * ((dt * 2 + qt) * 4 + r)]; if ((br) < 2) { OAl[64 * ((dt * 2 + qt) * 4 + r)] = v; O[dt][qt][r] = 0.f; } else O[dt][qt][r] = v; } \
        mrun[qt] = MINIT; lrun[qt] = 0.f; } } while (0)
    __syncthreads();
    attn_load_tile(lds, (const bf16_t*)(P.ws + WS_KC) + (size_t)b * 64 * 128, 128, (const bf16_t*)(P.ws + WS_VCT) + (size_t)(b * 2) * 4096, (const bf16_t*)(P.ws + WS_VCT) + (size_t)(b * 2 + 1) * 4096, 64, tid);
    __syncthreads();
    attn_tile<0>(Kg, Vg, qf, O, mrun, lrun, s, lane, 0, qpos, selm, 0);
#pragma unroll
    for (int qt = 0; qt < 2; ++qt) {
        float lt = lrun[qt]; lt += __shfl_xor(lt, 16); lt += __shfl_xor(lt, 32);
        const float inv = (lt > 0.f) ? 1.0f / lt : 0.f;
#pragma unroll
        for (int kt = 0; kt < 4; ++kt)
#pragma unroll
            for (int rr = 0; rr < 2; ++rr) IMP[(wave * 32 + 16 * qt + lr) * 33 + 8 * kt + 2 * grp + rr] = (s[qt][kt][2 * rr] + s[qt][kt][2 * rr + 1]) * inv;
    }
    ATT_FINISH(0);
    __syncthreads();
    for (int i = tid; i < 2 * 32 * 32; i += 512) { const int gg = i >> 10, q = (i >> 5) & 31, j = i & 31;
        IMPS[(gg * 32 + q) * 33 + j] = (IMP[((4 * gg + 0) * 32 + q) * 33 + j] + IMP[((4 * gg + 1) * 32 + q) * 33 + j]) + (IMP[((4 * gg + 2) * 32 + q) * 33 + j] + IMP[((4 * gg + 3) * 32 + q) * 33 + j]); }
    __syncthreads();
    if (tid < 64) {
        const int gg = tid >> 5, q = tid & 31;
        unsigned mask = 1u | (1u << qblk);
        if (qblk - 1 <= 6) mask = (qblk >= 31) ? 0xffffffffu : ((2u << qblk) - 1u);
        else {
            const LAS float* v = IMPS + (gg * 32 + q) * 33;
            for (int pick = 0; pick < 6; ++pick) { float best = -1.f; int bi = 1;
                for (int j = 1; j < qblk; ++j) { const float x = v[j]; if (!((mask >> j) & 1u) && x > best) { best = x; bi = j; } }
                mask |= 1u << bi; }
        }
        SEL[gg * 32 + q] = mask;
    }
    __syncthreads();
    selm[0] = SEL[g * 32 + lr]; selm[1] = SEL[g * 32 + 16 + lr];
    for (int jb = 0; jb <= qblk; ++jb) {
        __syncthreads();
        attn_load_tile(lds, ACT + ((size_t)b * SEQ + 64 * jb) * NIN + LK + 128, NIN, VT + ((size_t)(b * 6 + 2) * 64) * SEQ + 64 * jb, VT + ((size_t)(b * 6 + 3) * 64) * SEQ + 64 * jb, SEQ, tid);
        __syncthreads();
        const bool any = __any((int)(((selm[0] | selm[1]) >> jb) & 1u));
        if (any) attn_tile<1>(Kg, Vg, qf, O, mrun, lrun, s, lane, 64 * jb, qpos, selm, jb);
    }
    ATT_FINISH(1);
    { const int lo = (t0 - 511 > 0) ? ((t0 - 511) >> 6) : 0;
      for (int jt = lo; jt <= qblk; ++jt) {
        __syncthreads();
        attn_load_tile(lds, ACT + ((size_t)b * SEQ + 64 * jt) * NIN + LK + 256, NIN, VT + ((size_t)(b * 6 + 4) * 64) * SEQ + 64 * jt, VT + ((size_t)(b * 6 + 5) * 64) * SEQ + 64 * jt, SEQ, tid);
        __syncthreads();
        attn_tile<2>(Kg, Vg, qf, O, mrun, lrun, s, lane, 64 * jt, qpos, selm, 0);
      } }
    ATT_FINISH(2);
#undef ATT_FINISH
#pragma unroll
    for (int qt = 0; qt < 2; ++qt) {
        const size_t row = row0 + 16 * qt + lr;
#pragma unroll
        for (int dt = 0; dt < 4; ++dt) {
            const int col = 64 * wave + 16 * dt + 4 * grp;
            float za[4]; unpack4(*(const u32x2*)(ACT + row * NIN + LZA + col), za);
            u32x2 w; w.x = cvt_pk_bf16(O[dt][qt][0] * za[0], O[dt][qt][1] * za[1]); w.y = cvt_pk_bf16(O[dt][qt][2] * za[2], O[dt][qt][3] * za[3]);
            *(u32x2*)(AB + row * DM + col) = w;
        }
    }
}

constexpr int G_ST = 0, G_VNT = 1024, VPITCH = 136;
__device__ __forceinline__ void gmlp_unit(const Params& P, LAS unsigned char* lds, int b, int ch, int g, int tid, int lane, int wave) {
    const bf16_t* ACT = (const bf16_t*)(P.ws + WS_ACT); bf16_t* AB = (bf16_t*)(P.ws + WS_AB); const bf16_t* tril = (const bf16_t*)(P.ws + WS_TRIL) + (size_t)g * 128 * 128;
    LAS f32x2* ST = (LAS f32x2*)(lds + G_ST); LAS bf16_t* Vnt = (LAS bf16_t*)(lds + G_VNT);
    const size_t R0 = (size_t)b * SEQ + 128 * ch;
    __syncthreads();
    for (int j = wave; j < 128; j += 8) {
        const u32x4 raw = *(const u32x4*)(ACT + (R0 + j) * NIN + LVB + 8 * lane);
        float f[8]; f[0] = bf2f(raw.x); f[1] = bf2f(raw.x >> 16); f[2] = bf2f(raw.y); f[3] = bf2f(raw.y >> 16); f[4] = bf2f(raw.z); f[5] = bf2f(raw.z >> 16); f[6] = bf2f(raw.w); f[7] = bf2f(raw.w >> 16);
        float sm = 0.f;
#pragma unroll
        for (int i = 0; i < 8; ++i) sm += f[i];
        const float mean = wave_sum(sm) * (1.0f / 512.0f);
        float sq = 0.f;
#pragma unroll
        for (int i = 0; i < 8; ++i) { const float d = f[i] - mean; sq += d * d; }
        const float rstd = rsqrtf(wave_sum(sq) * (1.0f / 512.0f) + 1e-6f);
        if (lane == 0) ST[j] = (f32x2){mean, rstd};
    }
    __syncthreads();
    const float* vg = P.in[21] + 128 * g; const float* vb = P.in[22] + 128 * g;
#pragma unroll
    for (int i = 0; i < 4; ++i) {
        const int idx = tid + 512 * i, j = idx & 127, chn = idx >> 7;
        const u32x4 raw = *(const u32x4*)(ACT + (R0 + j) * NIN + LVB + 128 * g + 8 * chn);
        const f32x2 st = ST[j];
        float f[8]; f[0] = bf2f(raw.x); f[1] = bf2f(raw.x >> 16); f[2] = bf2f(raw.y); f[3] = bf2f(raw.y >> 16); f[4] = bf2f(raw.z); f[5] = bf2f(raw.z >> 16); f[6] = bf2f(raw.w); f[7] = bf2f(raw.w >> 16);
#pragma unroll
        for (int e = 0; e < 8; ++e) { const int d = 8 * chn + e; Vnt[d * VPITCH + j] = (bf16_t)f2bf((f[e] - st[0]) * st[1] * vg[d] + vb[d]); }
    }
    __syncthreads();
    const int lr = lane & 15, grp = lane >> 4;
    f32x4 acc[8];
#pragma unroll
    for (int it = 0; it < 8; ++it) acc[it] = (f32x4){0.f, 0.f, 0.f, 0.f};
#pragma unroll
    for (int ks = 0; ks < 4; ++ks) {
        const bf16x8 af = *(const LAS bf16x8*)(Vnt + (16 * wave + lr) * VPITCH + 32 * ks + 8 * grp);
#pragma unroll
        for (int it = 0; it < 8; ++it) {
            if ((it >> 1) >= ks) { const bf16x8 bfr = *(const bf16x8*)(tril + (size_t)(16 * it + lr) * 128 + 32 * ks + 8 * grp);
                acc[it] = __builtin_amdgcn_mfma_f32_16x16x32_bf16(af, bfr, acc[it], 0, 0, 0); }
        }
    }
    const float* bs = P.in[24] + 128 * g;
#pragma unroll
    for (int it = 0; it < 8; ++it) {
        const int i = 16 * it + lr; const size_t row = R0 + i; const int d0 = 128 * g + 16 * wave + 4 * grp;
        const float bsi = bs[i];
        float uu[4], zb[4]; unpack4(*(const u32x2*)(ACT + row * NIN + LU + d0), uu); unpack4(*(const u32x2*)(ACT + row * NIN + LZB + d0), zb);
        u32x2 w; w.x = cvt_pk_bf16(uu[0] * (acc[it][0] + bsi) * zb[0], uu[1] * (acc[it][1] + bsi) * zb[1]); w.y = cvt_pk_bf16(uu[2] * (acc[it][2] + bsi) * zb[2], uu[3] * (acc[it][3] + bsi) * zb[3]);
        *(u32x2*)(AB + row * DM + 512 + d0) = w;
    }
}

__device__ __forceinline__ void stile(const float* kb, const float* vb, int stride, int kmin, const f32x4 (&q4)[4], float (&m)[4], float (&l)[4], f32x4 (&o4)[4], float (&pout)[4], int lane_in) {
    int lane = lane_in; asm volatile("" : "+v"(lane));
    const int li = lane & 15, gq = lane >> 4;
    __builtin_amdgcn_sched_barrier(0);
    const float* kl = kb + (size_t)(gq * stride + 4 * li); const float* vl = vb + (size_t)(gq * stride + 4 * li);
    f32x4 kreg[16], vreg[16];
#pragma unroll
    for (int i = 0; i < 16; ++i) kreg[i] = __builtin_nontemporal_load((const f32x4*)(kl + (size_t)(4 * i) * stride));
#pragma unroll
    for (int i = 0; i < 16; ++i) vreg[i] = __builtin_nontemporal_load((const f32x4*)(vl + (size_t)(4 * i) * stride));
    float sc[4];
#pragma unroll
    for (int h = 0; h < 4; ++h) {
        float v[16], w8[8], w4[4], w2[2];
#pragma unroll
        for (int i = 0; i < 16; ++i) v[i] = (kreg[i][0] * q4[h][0] + kreg[i][1] * q4[h][1]) + (kreg[i][2] * q4[h][2] + kreg[i][3] * q4[h][3]);
#pragma unroll
        for (int t = 0; t < 8; ++t) { const float snd = (li & 8) ? v[t] : v[t + 8], kp = (li & 8) ? v[t + 8] : v[t]; w8[t] = kp + __shfl_xor(snd, 8); }
#pragma unroll
        for (int t = 0; t < 4; ++t) { const float snd = (li & 4) ? w8[t] : w8[t + 4], kp = (li & 4) ? w8[t + 4] : w8[t]; w4[t] = kp + __shfl_xor(snd, 4); }
#pragma unroll
        for (int t = 0; t < 2; ++t) { const float snd = (li & 2) ? w4[t] : w4[t + 2], kp = (li & 2) ? w4[t + 2] : w4[t]; w2[t] = kp + __shfl_xor(snd, 2); }
        { const float snd = (li & 1) ? w2[0] : w2[1], kp = (li & 1) ? w2[1] : w2[0]; sc[h] = kp + __shfl_xor(snd, 1); }
        __builtin_amdgcn_sched_barrier(0);
    }
    const bool valid = (4 * li + gq) >= kmin;
#pragma unroll
    for (int h = 0; h < 4; ++h) {
        const float sv = valid ? sc[h] : NEGBIG;
        const float mnew = fmaxf(m[h], wave_max(sv));
        const float alpha = __builtin_amdgcn_exp2f(m[h] - mnew), p = __builtin_amdgcn_exp2f(sv - mnew);
        l[h] = l[h] * alpha + wave_sum(p); o4[h] *= alpha; m[h] = mnew; pout[h] = p;
    }
    const int src0 = lane & 48;
#pragma unroll
    for (int i = 0; i < 16; ++i) {
#pragma unroll
        for (int h = 0; h < 4; ++h) o4[h] += vreg[i] * __shfl(pout[h], src0 + i);
    }
    __builtin_amdgcn_sched_barrier(0);
}
__device__ __forceinline__ void skey(const float* kb, const float* vb, const f32x4 (&q4)[4], float (&m)[4], float (&l)[4], f32x4 (&o4)[4], int lane) {
    const int li = lane & 15, gq = lane >> 4;
    const f32x4 kd = *(const f32x4*)(kb + 4 * li), vd = *(const f32x4*)(vb + 4 * li);
#pragma unroll
    for (int h = 0; h < 4; ++h) {
        float sv = (kd[0] * q4[h][0] + kd[1] * q4[h][1]) + (kd[2] * q4[h][2] + kd[3] * q4[h][3]);
        sv += __shfl_xor(sv, 1); sv += __shfl_xor(sv, 2); sv += __shfl_xor(sv, 4); sv += __shfl_xor(sv, 8);
        const float mnew = fmaxf(m[h], sv), alpha = __builtin_amdgcn_exp2f(m[h] - mnew), p = __builtin_amdgcn_exp2f(sv - mnew);
        l[h] = l[h] * alpha + p; o4[h] *= alpha; if (gq == 0) o4[h] += vd * p; m[h] = mnew;
    }
}

constexpr int S_ST = 0, S_MISC = 8 * 3 * 4 * 66 * 4;
__device__ __forceinline__ void sample_unit(const Params& P, LAS unsigned char* lds, int sb, int g, int tid, int lane, int wave) {
    const bf16_t* ACT = (const bf16_t*)(P.ws + WS_ACT); bf16_t* AB = (bf16_t*)(P.ws + WS_AB);
    LAS float* ST = (LAS float*)(lds + S_ST); LAS float* MISC = (LAS float*)(lds + S_MISC);
    const size_t row = (size_t)MP + sb;
    const int* ptab = (const int*)P.in[8] + sb * 16;
    const int li = lane & 15;
    __syncthreads();
    f32x4 q4[4];
#pragma unroll
    for (int h = 0; h < 4; ++h) { float t4[4]; unpack4(*(const u32x2*)(ACT + row * NIN + LQ + 64 * (4 * g + h) + 4 * li), t4); q4[h] = (f32x4){t4[0], t4[1], t4[2], t4[3]}; }
    float ms[4], ls[4]; f32x4 os[4];
#define S_RESET() do { _Pragma("unroll") for (int h = 0; h < 4; ++h) { ms[h] = MINIT; ls[h] = 0.f; os[h] = (f32x4){0.f, 0.f, 0.f, 0.f}; } } while (0)
#define S_PUBLISH(b2, doit) do { _Pragma("unroll") for (int h = 0; h < 4; ++h) { f32x4 v = os[h]; \
        _Pragma("unroll") for (int e = 0; e < 4; ++e) { float x = v[e]; x += __shfl_xor(x, 16); x += __shfl_xor(x, 32); v[e] = x; } \
        if (doit) { LAS float* st = ST + ((wave * 3 + (b2)) * 4 + h) * 66; if (lane < 16) *(LAS f32x4*)(st + 4 * lane) = v; if (lane == 0) { st[64] = ms[h]; st[65] = ls[h]; } } } } while (0)
    float pdummy[4], pc[4];
    S_RESET();
    { const size_t off = (((size_t)sb * 512 + 64 * wave) * 2 + g) * 64; stile(P.in[6] + off, P.in[7] + off, 128, (wave == 0) ? 1 : 0, q4, ms, ls, os, pdummy, lane); }
    if (wave == 0) { const size_t off = ((size_t)(sb * 512 + 511) * 2 + g) * 64; skey(P.out + O_SKW + off, P.out + O_SVW + off, q4, ms, ls, os, lane); }
    S_PUBLISH(1, true);
    S_RESET();
    stile((const float*)(P.ws + WS_KCS) + (size_t)(sb * 2 + g) * 4096, (const float*)(P.ws + WS_VCS) + (size_t)(sb * 2 + g) * 4096, 64, 0, q4, ms, ls, os, pc, lane);
    float imp = 0.f;
#pragma unroll
    for (int h = 0; h < 4; ++h) { const float pn = pc[h] / ls[h]; imp += pn + __shfl_down(pn, 16); }
    S_PUBLISH(2, wave == 0);
    const int jblk = 2 * li + (lane >> 5);
    const bool cand = ((lane >> 4) & 1) == 0 && jblk >= 1;
    unsigned key = cand ? ((__builtin_bit_cast(unsigned, imp) & 0xffffffe0u) | (unsigned)(31 - jblk)) : 0u;
    unsigned long long selpack = 0ull;
#pragma unroll
    for (int pick = 0; pick < 6; ++pick) {
        unsigned best = key;
#pragma unroll
        for (int o2 = 1; o2 < 64; o2 <<= 1) { const unsigned other = (unsigned)__shfl_xor((int)best, o2); best = other > best ? other : best; }
        const int bj = 31 - (int)(best & 31u);
        selpack |= (unsigned long long)bj << (5 * (pick + 1));
        if (cand && jblk == bj) key = 0u;
    }
    S_RESET();
    if (wave < 7) { const int blk = (int)((selpack >> (5 * wave)) & 31ull); const int page = __builtin_amdgcn_readfirstlane(ptab[blk >> 1]); const size_t off = (((size_t)page * 128 + (blk & 1) * 64) * 2 + g) * 64;
        stile(P.in[4] + off, P.in[5] + off, 128, 0, q4, ms, ls, os, pdummy, lane); }
    else skey(P.out + O_SKS + (size_t)sb * 128 + g * 64, P.out + O_SVS + (size_t)sb * 128 + g * 64, q4, ms, ls, os, lane);
    S_PUBLISH(0, true);
#undef S_RESET
#undef S_PUBLISH
    if (wave == 7) {
        const u32x4 raw = *(const u32x4*)(ACT + row * NIN + LVB + 8 * lane);
        float f[8]; f[0] = bf2f(raw.x); f[1] = bf2f(raw.x >> 16); f[2] = bf2f(raw.y); f[3] = bf2f(raw.y >> 16); f[4] = bf2f(raw.z); f[5] = bf2f(raw.z >> 16); f[6] = bf2f(raw.w); f[7] = bf2f(raw.w >> 16);
        float sm = 0.f;
#pragma unroll
        for (int i = 0; i < 8; ++i) sm += f[i];
        const float mean = wave_sum(sm) * (1.0f / 512.0f); float sq = 0.f;
#pragma unroll
        for (int i = 0; i < 8; ++i) { const float d = f[i] - mean; sq += d * d; }
        const float rstd = rsqrtf(wave_sum(sq) * (1.0f / 512.0f) + 1e-6f);
        if (lane == 0) { MISC[0] = mean; MISC[1] = rstd; }
    }
    __syncthreads();
    if (wave < 4) {
        const int h = wave, head = 4 * g + h;
        const LAS float* stc = ST + ((0 * 3 + 2) * 4 + h) * 66;
        float oa = bf2f(ACT[row * NIN + LNSA + 3 * head + 0]) * stc[lane] / stc[65];
#pragma unroll
        for (int b2 = 0; b2 < 2; ++b2) {
            float M = MINIT;
#pragma unroll
            for (int w = 0; w < 8; ++w) M = fmaxf(M, ST[((w * 3 + b2) * 4 + h) * 66 + 64]);
            float L = 0.f, O = 0.f;
#pragma unroll
            for (int w = 0; w < 8; ++w) { const LAS float* st = ST + ((w * 3 + b2) * 4 + h) * 66; const float f = __builtin_amdgcn_exp2f(st[64] - M); L += st[65] * f; O += st[lane] * f; }
            oa += bf2f(ACT[row * NIN + LNSA + 3 * head + 1 + b2]) * O / L;
        }
        const int col = 64 * head + lane;
        AB[row * DM + col] = (bf16_t)f2bf(oa * bf2f(ACT[row * NIN + LZA + col]));
    }
    if (tid < 256) {
        const int d = 256 * g + tid, gm = d >> 7;
        const float vn = (bf2f(ACT[row * NIN + LVB + d]) - MISC[0]) * MISC[1] * P.in[21][d] + P.in[22][d];
        P.out[O_SVCH + (size_t)sb * 512 + d] = vn;
        const float sv = P.in[23][(size_t)gm * 128 * 128] * vn + P.in[24][gm * 128];
        AB[row * DM + 512 + d] = (bf16_t)f2bf(bf2f(ACT[row * NIN + LU + d]) * sv * bf2f(ACT[row * NIN + LZB + d]));
    }
}

template <int MODE>
__device__ __forceinline__ void small_gemm(const Params& P, int c, int G, int wave, int lane) {
    const int lr = lane & 15, grp = lane >> 4;
    for (int t = c + G * wave; t < 512; t += G * 8) {
        const int rt = t & 7, ct = t >> 3;
        const size_t row = (size_t)MP + 16 * rt + lr;
        const bf16_t* A = (const bf16_t*)(P.ws + (MODE == 0 ? WS_AB : WS_H)) + row * DM + 8 * grp;
        const bf16_t* W = (const bf16_t*)(P.ws + (MODE == 0 ? WS_WTBR : WS_WTOUT)) + (size_t)(16 * ct + lr) * DM + 8 * grp;
        f32x4 acc0 = (f32x4){0.f, 0.f, 0.f, 0.f}, acc1 = (f32x4){0.f, 0.f, 0.f, 0.f};
#pragma unroll 8
        for (int ks = 0; ks < 16; ++ks) acc0 = __builtin_amdgcn_mfma_f32_16x16x32_bf16(*(const bf16x8*)(W + 32 * ks), *(const bf16x8*)(A + 32 * ks), acc0, 0, 0, 0);
#pragma unroll 8
        for (int ks = 16; ks < 32; ++ks) acc1 = __builtin_amdgcn_mfma_f32_16x16x32_bf16(*(const bf16x8*)(W + 32 * ks), *(const bf16x8*)(A + 32 * ks), acc1, 0, 0, 0);
        const int col = 16 * ct + 4 * grp;
        if (MODE == 0) {
            const bf16_t* ACT = (const bf16_t*)(P.ws + WS_ACT);
            float sa[4], sb[4]; unpack4(*(const u32x2*)(ACT + row * NIN + LGA + col), sa); unpack4(*(const u32x2*)(ACT + row * NIN + LGB + col), sb);
            u32x2 w; w.x = cvt_pk_bf16(sa[0] * acc0[0] + sb[0] * acc1[0], sa[1] * acc0[1] + sb[1] * acc1[1]); w.y = cvt_pk_bf16(sa[2] * acc0[2] + sb[2] * acc1[2], sa[3] * acc0[3] + sb[3] * acc1[3]);
            *(u32x2*)((bf16_t*)(P.ws + WS_H) + row * DM + col) = w;
        } else {
            const int sbi = 16 * rt + lr;
            const f32x4 xv = *(const f32x4*)(P.in[1] + (size_t)sbi * DM + col), gv = *(const f32x4*)((const float*)(P.ws + WS_MOD) + (size_t)(8 + sbi) * 3072 + 2048 + col);
            *(f32x4*)(P.out + O_YS + (size_t)sbi * DM + col) = xv + gv * (acc0 + acc1);
        }
    }
}

#define XB_TMO      128
#define XB_XCNT(j)  (256  + 64 * (j))
#define XB_XSUB(j)  (1280 + 64 * (j))
#define XB_XGEN(j)  (2304 + 64 * (j))
#define XB_TOP      3328
#define XB_TOPGEN   3392
#define XCD_BAR_WORDS 3456
#define XB_SPIN_CAP (1u << 18)
__device__ __forceinline__ unsigned xb_ld(unsigned* p)              { return __hip_atomic_load(p, __ATOMIC_RELAXED, __HIP_MEMORY_SCOPE_AGENT); }
__device__ __forceinline__ unsigned xb_add(unsigned* p, unsigned v) { return __hip_atomic_fetch_add(p, v, __ATOMIC_RELAXED, __HIP_MEMORY_SCOPE_AGENT); }
__device__ __forceinline__ unsigned xb_xcc_id() { return (unsigned)__builtin_amdgcn_s_getreg((3 << 11) | 20) & 0xFu; }
#define XB_SPIN(cond, bar) do { unsigned _sp = 0; while (cond) { __builtin_amdgcn_s_sleep(1); \
    if ((++_sp & 255u) == 0u) { if (xb_ld(&(bar)[XB_TMO])) break; if (_sp > XB_SPIN_CAP) { atomicAdd(&(bar)[XB_TMO], 1u); break; } } } } while (0)
struct XcdBarrier { unsigned* bar; unsigned x; volatile LAS unsigned* st; };
__device__ __forceinline__ XcdBarrier xcd_barrier_post(unsigned* bar, volatile LAS unsigned* st) {
    XcdBarrier b; b.bar = bar; b.x = xb_xcc_id(); b.st = st;
    if (threadIdx.x == 0) (void)xb_add(&bar[XB_XCNT(b.x)], 1u);
    return b;
}
__device__ __forceinline__ void xcd_barrier_complete(unsigned* bar, unsigned x, unsigned& nloc, unsigned& nx) {
    const unsigned G = gridDim.x * gridDim.y * gridDim.z;
    unsigned sum, cnt, mine, sp = 0u;
    for (;;) {
        sum = 0u; cnt = 0u; mine = 0u;
#pragma unroll
        for (unsigned j = 0; j < 16; ++j) { const unsigned c = xb_ld(&bar[XB_XCNT(j)]); sum += c; cnt += (c > 0u) ? 1u : 0u; mine = (j == x) ? c : mine; }
        if (sum == G) break;
        __builtin_amdgcn_s_sleep(1);
        if ((++sp & 255u) == 0u) { if (xb_ld(&bar[XB_TMO])) break; if (sp > XB_SPIN_CAP) { atomicAdd(&bar[XB_TMO], 1u); break; } }
    }
    nloc = mine > 0u ? mine : 1u; nx = cnt > 0u ? cnt : 1u;
}
__device__ __forceinline__ void xcd_barrier(const XcdBarrier& b) {
    asm volatile("s_waitcnt vmcnt(0)" ::: "memory");
    __syncthreads();
    if (threadIdx.x == 0) {
        unsigned* bar = b.bar;
        __builtin_amdgcn_s_waitcnt(0);
        unsigned nloc = b.st[0], nx = b.st[1];
        if (nloc == 0u) { xcd_barrier_complete(bar, b.x, nloc, nx); b.st[0] = nloc; b.st[1] = nx; }
        const unsigned old = xb_add(&bar[XB_XSUB(b.x)], 1u);
        const unsigned gen = old / nloc;
        if (old + 1u == (gen + 1u) * nloc) {
            __builtin_amdgcn_fence(__ATOMIC_RELEASE, "agent");
            asm volatile("s_waitcnt vmcnt(0)" ::: "memory");
            const unsigned og = xb_add(&bar[XB_TOP], 1u);
            const unsigned tg = og / nx;
            if (og + 1u == (tg + 1u) * nx) xb_add(&bar[XB_TOPGEN], 1u);
            else XB_SPIN(xb_ld(&bar[XB_TOPGEN]) == tg, bar);
            __builtin_amdgcn_fence(__ATOMIC_ACQUIRE, "agent");
            xb_add(&bar[XB_XGEN(b.x)], 1u);
            asm volatile("s_waitcnt vmcnt(0)" ::: "memory");
        } else {
            XB_SPIN(xb_ld(&bar[XB_XGEN(b.x)]) == gen, bar);
            __builtin_amdgcn_fence(__ATOMIC_ACQUIRE, "agent");
            asm volatile("s_waitcnt vmcnt(0)" ::: "memory");
        }
    }
    __syncthreads();
}

__global__ void __launch_bounds__(512, 2) mk_fwd(Params P) {
    extern __shared__ __attribute__((aligned(16))) unsigned char lds_raw[];
    LAS unsigned char* lds = (LAS unsigned char*)lds_raw;
    const int tid = threadIdx.x, lane = tid & 63, wave = __builtin_amdgcn_readfirstlane(tid >> 6);
    const int G = gridDim.x, c = blockIdx.x, gw = c * 8 + wave, NGW = G * 8, gtid = c * 512 + tid, NT = G * 512;
    cg::grid_group grid = cg::this_grid();
    const int lo = P.ph_lo, hi = P.ph_hi;
    if (tid < 16) ((LAS unsigned*)(lds + LDS_XB))[tid] = 0u;
    __syncthreads();
    const XcdBarrier bar = xcd_barrier_post((unsigned*)(P.ws + WS_CTL), (volatile LAS unsigned*)(lds + LDS_XB));
    if (hi < 0) grid.sync();
#define IN(k) (lo <= (k) && (k) < hi)
#define SEAM(k) do { if (IN(k) && IN((k) + 1)) xcd_barrier(bar); } while (0)
    unsigned char* ws = P.ws;
    if (IN(0)) for (int rep = 0; rep < MK_REP0; ++rep) { p0_prologue(P, lds, gw, NGW, lane, wave, gtid, NT); }
    SEAM(0);
    if (IN(1)) for (int rep = 0; rep < MK_REP1; ++rep) { p1_hrows(P, gw, NGW, lane); }
    SEAM(1);
    if (IN(2)) for (int rep = 0; rep < MK_REP2; ++rep) {
        pg8::Gemm gm{(const bf16_t*)(ws + WS_H), (const bf16_t*)(ws + WS_WTIN), DM, DM, DM};
        pg8::StaticOrder S; S.init(MPAD / 256, NIN / 256, G, c);
        EpiInProj E{(bf16_t*)(ws + WS_ACT), (bf16_t*)(ws + WS_VT), P.out, P.in[15], P.in[16], (const float*)(ws + WS_ROPE)};
        pg8::gemm_phase<EpiInProj, pg8::StaticOrder>(lds, gm, S, E);
    }
    SEAM(2);
    if (IN(3)) for (int rep = 0; rep < MK_REP3; ++rep) { p3_compress(P, lds, gw, NGW, lane, wave); }
    SEAM(3);
    if (IN(4)) for (int rep = 0; rep < MK_REP4; ++rep) {
        asm volatile("" ::: "memory");
        for (int i = 0;; ++i) { const int a = (i & 1) ? (i + 1) * G - 1 - c : i * G + c; if (a >= 512 || a < 0) break; attn_unit(P, lds, a & 7, 63 - (a >> 3), tid, lane, wave); }
        for (int su = c; su < 2 * NSB; su += G) sample_unit(P, lds, su >> 1, su & 1, tid, lane, wave);
        for (int gu = c; gu < 512; gu += G) gmlp_unit(P, lds, gu >> 6, (gu >> 2) & 15, gu & 3, tid, lane, wave);
        __syncthreads();
    }
    SEAM(4);
    if (IN(5)) for (int rep = 0; rep < MK_REP5; ++rep) {
        pg8::Gemm gm{(const bf16_t*)(ws + WS_AB), (const bf16_t*)(ws + WS_WTBR), DM, DM, 512};
        small_gemm<0>(P, c, G, wave, lane);
        pg8::PairOrder S; S.S.init(MP / 256, DM / 256, G, c);
        EpiMix E{(const bf16_t*)(ws + WS_ACT), (bf16_t*)(ws + WS_H)};
        pg8::gemm_phase<EpiMix, pg8::PairOrder>(lds, gm, S, E);
    }
    SEAM(5);
    if (IN(6)) for (int rep = 0; rep < MK_REP6; ++rep) {
        pg8::Gemm gm{(const bf16_t*)(ws + WS_H), (const bf16_t*)(ws + WS_WTOUT), DM, DM, DM};
        small_gemm<1>(P, c, G, wave, lane);
        pg8::StaticOrder S; S.init(MP / 256, DM / 256, G, c);
        EpiOut E{P.in[0], P.in[1], (const float*)(ws + WS_MOD), P.out};
        pg8::gemm_phase<EpiOut, pg8::StaticOrder>(lds, gm, S, E);
    }
#undef IN
#undef SEAM
}

extern "C" void kernel_launch(void* const* d_in, const int* in_sizes, int n_in, void* d_out, int out_size, void* d_ws, size_t ws_size, hipStream_t stream) {
    static int grid = 0;
    if (grid == 0) {
        if (n_in != 28 || out_size != (int)O_END || ws_size < WS_END) { fprintf(stderr, "kernel_launch: unexpected shapes (n_in %d, out %d, ws %zu); nothing launched\n", n_in, out_size, ws_size); grid = -1; return; }
        int dev = 0, cus = 0, per_cu = 0;
        if (hipGetDevice(&dev) != hipSuccess || hipDeviceGetAttribute(&cus, hipDeviceAttributeMultiprocessorCount, dev) != hipSuccess) { grid = -1; return; }
        if (hipFuncSetAttribute((const void*)mk_fwd, hipFuncAttributeMaxDynamicSharedMemorySize, LDS_BYTES) != hipSuccess) { fprintf(stderr, "kernel_launch: hipFuncSetAttribute failed\n"); grid = -1; return; }
        if (hipOccupancyMaxActiveBlocksPerMultiprocessor(&per_cu, (const void*)mk_fwd, 512, LDS_BYTES) != hipSuccess || per_cu < 1) { fprintf(stderr, "kernel_launch: occupancy query failed (%d)\n", per_cu); (void)hipGetLastError(); per_cu = 1; }
        if (per_cu > 1) per_cu = 1;
        grid = cus * per_cu;
    }
    if (grid < 0) return;
    if (hipMemsetAsync((char*)d_ws + WS_CTL, 0, CTL_BYTES, stream) != hipSuccess) { fprintf(stderr, "kernel_launch: hipMemsetAsync failed\n"); return; }
    Params p{};
    for (int i = 0; i < 28; ++i) p.in[i] = (const float*)d_in[i];
    p.out = (float*)d_out; p.ws = (unsigned char*)d_ws;
#if MK_N_LAUNCHES == 1
    p.ph_lo = 0; p.ph_hi = 7;
    void* args[] = {&p};
    hipError_t e = hipLaunchCooperativeKernel((const void*)mk_fwd, dim3(grid), dim3(512), args, LDS_BYTES, stream);
    if (e != hipSuccess) fprintf(stderr, "kernel_launch: cooperative launch failed: %s (grid %d)\n", hipGetErrorString(e), grid);
#else
    for (int ph = 0; ph < 7; ++ph) {
        p.ph_lo = ph; p.ph_hi = ph + 1;
        void* args[] = {&p};
        hipError_t e = hipLaunchCooperativeKernel((const void*)mk_fwd, dim3(grid), dim3(512), args, LDS_BYTES, stream);
        if (e != hipSuccess) { fprintf(stderr, "kernel_launch: launch %d failed: %s (grid %d)\n", ph, hipGetErrorString(e), grid); break; }
    }
#endif
}
```

```cpp
#include <hip/hip_runtime.h>
#include <hip/hip_cooperative_groups.h>
#include <cstdio>
#include <cstdint>
namespace cg = cooperative_groups;

#ifndef MK_N_LAUNCHES
#define MK_N_LAUNCHES 1
#endif
#define MK_REP0 1
#define MK_REP1 1
#define MK_REP2 1
#define MK_REP3 1
#define MK_REP4 1
#define MK_REP5 1
#define MK_REP6 1

#define LAS __attribute__((address_space(3)))
typedef unsigned short bf16_t;
typedef short bf16x8 __attribute__((ext_vector_type(8)));
typedef short bf16x4 __attribute__((ext_vector_type(4)));
typedef float f32x4 __attribute__((ext_vector_type(4)));
typedef float f32x2 __attribute__((ext_vector_type(2)));
typedef unsigned u32x4 __attribute__((ext_vector_type(4)));
typedef unsigned u32x2 __attribute__((ext_vector_type(2)));

constexpr int DM = 1024, SEQ = 2048, NBATCH = 8, MP = NBATCH * SEQ, NSB = 128, MTOT = MP + NSB, MPAD = 16640;
constexpr int NIN = 5632;
constexpr int LQ = 0, LK = 512, LV = 896, LZA = 1280, LU = 1792, LVB = 2304, LZB = 2816, LGA = 3328, LGB = 4352, LNSA = 5376;
constexpr float C2Q = 0.125f * 1.4426950408889634f;
constexpr float NEGBIG = -1e30f, MINIT = -1e29f;
constexpr size_t O_YP = 0, O_YS = 16777216, O_PKC = 16908288, O_PVC = 19005440, O_PKS = 21102592, O_PVS = 23199744, O_PKW = 25296896, O_PVW = 25821184,
                 O_SKC = 26345472, O_SVC = 26361856, O_SKS = 26378240, O_SVS = 26394624, O_SKW = 26411008, O_SVW = 34799616, O_SVCH = 43188224, O_END = 43253760;
constexpr size_t MiB = 1u << 20;
constexpr size_t WS_ROPE = 0, WS_MOD = 1 * MiB, WS_WTIN = 3 * MiB, WS_WTBR = 14 * MiB, WS_WTOUT = 16 * MiB, WS_TRIL = 18 * MiB, WS_KC = 18 * MiB + 512 * 1024, WS_VCT = WS_KC + 128 * 1024,
                 WS_KCS = 19 * MiB, WS_VCS = 23 * MiB, WS_VT = 27 * MiB, WS_H = 40 * MiB, WS_AB = 73 * MiB, WS_ACT = 106 * MiB, WS_END = 285 * MiB;
constexpr size_t WS_CTL = 768 * 1024, CTL_BYTES = 16384;
constexpr int LDS_BYTES = 147456, LDS_XB = LDS_BYTES - 64;

struct Params { const float* in[28]; float* out; unsigned char* ws; int ph_lo, ph_hi; };

__device__ __forceinline__ unsigned f2bf(float f) { unsigned u = __builtin_bit_cast(unsigned, f); return (u + 0x7fffu + ((u >> 16) & 1u)) >> 16; }
__device__ __forceinline__ unsigned pk2(float lo, float hi) { return f2bf(lo) | (f2bf(hi) << 16); }
__device__ __forceinline__ float bf2f(unsigned b) { return __builtin_bit_cast(float, (b & 0xffffu) << 16); }
__device__ __forceinline__ unsigned cvt_pk_bf16(float lo, float hi) { unsigned r; asm volatile("v_cvt_pk_bf16_f32 %0, %1, %2" : "=v"(r) : "v"(lo), "v"(hi)); return r; }
__device__ __forceinline__ float sigmoidf_(float x) { return 1.0f / (1.0f + __expf(-x)); }
__device__ __forceinline__ float wave_sum(float v) {
#pragma unroll
    for (int o = 1; o < 64; o <<= 1) v += __shfl_xor(v, o);
    return v;
}
__device__ __forceinline__ float wave_max(float v) {
#pragma unroll
    for (int o = 1; o < 64; o <<= 1) v = fmaxf(v, __shfl_xor(v, o));
    return v;
}
__device__ __forceinline__ void unpack4(u32x2 w, float (&f)[4]) { f[0] = bf2f(w.x); f[1] = bf2f(w.x >> 16); f[2] = bf2f(w.y); f[3] = bf2f(w.y >> 16); }

namespace pg8 {
constexpr int BM = 256, BK = 64, HALF = 128, HTB = HALF * BK * 2, STAGE_BYTES = 8 * HTB, NXCD = 8, WGM = 8;
__host__ __device__ __forceinline__ int lds_byte(int r, int c) { const int st = (r >> 4) * 2 + (c >> 5), rr = r & 15, cc = c & 31, ob = rr * 64 + cc * 2; return st * 1024 + (ob ^ (((ob >> 9) & 1) << 5)); }
__host__ __device__ __forceinline__ void stage_rc(int b, int& R, int& C) { const int st = b / 1024, sb = b % 1024, swz = sb ^ (((sb >> 9) & 1) << 5); R = (st >> 1) * 16 + swz / 64; C = (st & 1) * 32 + (swz % 64) / 2; }

struct Unit { int pm, pn, kofs, keep; };
struct Gemm { const bf16_t* A; const bf16_t* Bt; int lda, ldb, K; };

struct StaticOrder {
    int nM, nN, nwg, G, c;
    __device__ void init(int nM_, int nN_, int G_, int c_) { nM = nM_; nN = nN_; nwg = nM * nN; G = G_; c = c_; }
    __device__ bool tile(int i, int& pm, int& pn) const {
        const long L = (long)i * G + c; if (L >= nwg) return false;
        int wgid = (int)L; { const int q = nwg / NXCD, r = nwg % NXCD, xcd = wgid % NXCD, off = wgid / NXCD; wgid = (xcd < r ? xcd * (q + 1) : r * (q + 1) + (xcd - r) * q) + off; }
        const int nig = WGM * nN, gid = wgid / nig, fm = gid * WGM, gsz = (nM - fm) < WGM ? (nM - fm) : WGM;
        pm = fm + ((wgid % nig) % gsz); pn = (wgid % nig) / gsz; return true;
    }
    __device__ bool next(int i, Unit& u) const { u.kofs = 0; u.keep = 0; return tile(i, u.pm, u.pn); }
};
struct PairOrder {
    StaticOrder S;
    __device__ bool next(int i, Unit& u) const { u.kofs = (i & 1) * 512; u.keep = (i & 1) ? 0 : 1; return S.tile(i >> 1, u.pm, u.pn); }
};

template <class Epi, class Sched>
__device__ __forceinline__ void gemm_phase(LAS unsigned char* lds, const Gemm g, const Sched& S, const Epi& E) {
    const int tid = threadIdx.x, wid = __builtin_amdgcn_readfirstlane(tid >> 6), lane = tid & 63, wr = wid >> 2, wc = wid & 3, fr = lane & 15, fq = lane >> 4;
    const int nt = g.K / BK;
    unsigned voffA[2], voffB[2];
#pragma unroll
    for (int i = 0; i < 2; ++i) { int R, C; stage_rc(tid * 16 + i * 8192, R, C); voffA[i] = (unsigned)(R * g.lda + C) * 2u; voffB[i] = (unsigned)(R * g.ldb + C) * 2u; }
    const size_t kstep = (size_t)(BK * 2);
    const size_t hstepA = (size_t)HALF * g.lda * 2, hstepB = (size_t)HALF * g.ldb * 2, tstepA = 2 * hstepA, tstepB = 2 * hstepB;
    const unsigned ldsw = (unsigned)wid * 1024u;
    const int aoff = lds_byte(wr * 64 + fr, fq * 8), boff = lds_byte(wc * 32 + fr, fq * 8);
#define PG8_SA(b, h) (((b) * 2 + (h)) * HTB)
#define PG8_SB(b, h) ((4 + (b) * 2 + (h)) * HTB)
#define PG8_STAGE(bufoff, gbase, voff) do { _Pragma("unroll") for (int _i = 0; _i < 2; ++_i) \
        __builtin_amdgcn_global_load_lds((const unsigned*)((const char*)(gbase) + (voff)[_i]), (LAS unsigned*)(lds + (bufoff) + ldsw + _i * 8192), 16, 0, 0); } while (0)
#define PG8_LDA(dst, b, h) do { _Pragma("unroll") for (int m = 0; m < 4; ++m) _Pragma("unroll") for (int k = 0; k < 2; ++k) dst[m][k] = *(const LAS bf16x8*)(lds + PG8_SA(b, h) + aoff + m * 2048 + k * 1024); } while (0)
#define PG8_LDB(dst, b, h) do { _Pragma("unroll") for (int n = 0; n < 2; ++n) _Pragma("unroll") for (int k = 0; k < 2; ++k) dst[n][k] = *(const LAS bf16x8*)(lds + PG8_SB(b, h) + boff + n * 2048 + k * 1024); } while (0)
#define PG8_MMA(ai, bj, At, Bt) do { __builtin_amdgcn_s_setprio(1); _Pragma("unroll") for (int m = 0; m < 4; ++m) _Pragma("unroll") for (int n = 0; n < 2; ++n) _Pragma("unroll") for (int k = 0; k < 2; ++k) \
        acc[ai][bj][m][n] = __builtin_amdgcn_mfma_f32_16x16x32_bf16(Bt[n][k], At[m][k], acc[ai][bj][m][n], 0, 0, 0); __builtin_amdgcn_s_setprio(0); } while (0)
#define PG8_WAIT_V(n) asm volatile("s_waitcnt vmcnt(" #n ")" ::: "memory")
#define PG8_WAIT_L(n) asm volatile("s_waitcnt lgkmcnt(" #n ")" ::: "memory")
#define PG8_BAR __builtin_amdgcn_s_barrier()
#define PG8_SCHED __builtin_amdgcn_sched_barrier(0)
    Unit cur, nxt; int ui = 0;
    if (!S.next(0, cur)) return;
    f32x4 acc[2][2][4][2];
#pragma unroll
    for (int a = 0; a < 2; ++a)
#pragma unroll
        for (int b = 0; b < 2; ++b)
#pragma unroll
            for (int m = 0; m < 4; ++m)
#pragma unroll
                for (int n = 0; n < 2; ++n) acc[a][b][m][n] = (f32x4){0.f, 0.f, 0.f, 0.f};
    bf16x8 At[4][2], B0[2][2], B1[2][2];
    const char* cA = (const char*)g.A + (size_t)cur.pm * tstepA + (size_t)cur.kofs * 2; const char* cB = (const char*)g.Bt + (size_t)cur.pn * tstepB + (size_t)cur.kofs * 2;
    PG8_STAGE(PG8_SB(0, 0), cB, voffB); PG8_STAGE(PG8_SB(0, 1), cB + hstepB, voffB); PG8_STAGE(PG8_SA(0, 0), cA, voffA); PG8_STAGE(PG8_SA(0, 1), cA + hstepA, voffA);
    if (wr == 1) PG8_BAR;
    PG8_WAIT_V(2); PG8_BAR;
    PG8_STAGE(PG8_SB(1, 0), cB + kstep, voffB); PG8_STAGE(PG8_SA(1, 0), cA + kstep, voffA); PG8_STAGE(PG8_SB(1, 1), cB + hstepB + kstep, voffB);
    PG8_WAIT_V(6); PG8_BAR;
    for (;;) {
        const bool has_next = S.next(ui + 1, nxt);
        const char* nA = has_next ? (const char*)g.A + (size_t)nxt.pm * tstepA + (size_t)nxt.kofs * 2 : cA; const char* nB = has_next ? (const char*)g.Bt + (size_t)nxt.pn * tstepB + (size_t)nxt.kofs * 2 : cB;
        for (int t = 0; t < nt; t += 2) {
            const bool last = (t == nt - 2);
            const char* a1 = cA + (size_t)(t + 1) * kstep;
            const char* a2 = last ? nA : cA + (size_t)(t + 2) * kstep; const char* b2 = last ? nB : cB + (size_t)(t + 2) * kstep;
            const char* a3 = a2 + kstep; const char* b3 = b2 + kstep;
            PG8_LDB(B0, 0, 0); PG8_LDB(B1, 0, 1); PG8_SCHED; PG8_LDA(At, 0, 0); PG8_STAGE(PG8_SA(1, 1), a1 + hstepA, voffA);
            PG8_WAIT_V(8); PG8_WAIT_L(0); PG8_BAR; PG8_MMA(0, 0, At, B0); PG8_MMA(0, 1, At, B1); PG8_BAR; PG8_SCHED;
            PG8_LDA(At, 0, 1); PG8_STAGE(PG8_SB(0, 0), b2, voffB); PG8_STAGE(PG8_SB(0, 1), b2 + hstepB, voffB); PG8_STAGE(PG8_SA(0, 0), a2, voffA);
            PG8_WAIT_V(8); PG8_WAIT_L(0); PG8_BAR; PG8_MMA(1, 0, At, B0); PG8_MMA(1, 1, At, B1); PG8_BAR; PG8_SCHED;
            PG8_LDB(B0, 1, 0); PG8_LDB(B1, 1, 1); PG8_SCHED; PG8_LDA(At, 1, 0); PG8_STAGE(PG8_SA(0, 1), a2 + hstepA, voffA);
            PG8_WAIT_V(8); PG8_WAIT_L(0); PG8_BAR; PG8_MMA(0, 0, At, B0); PG8_MMA(0, 1, At, B1); PG8_BAR; PG8_SCHED;
            PG8_LDA(At, 1, 1); PG8_STAGE(PG8_SB(1, 0), b3, voffB); PG8_STAGE(PG8_SB(1, 1), b3 + hstepB, voffB); PG8_STAGE(PG8_SA(1, 0), a3, voffA);
            PG8_WAIT_V(8); PG8_WAIT_L(0); PG8_BAR; PG8_MMA(1, 0, At, B0); PG8_MMA(1, 1, At, B1); PG8_BAR; PG8_SCHED;
        }
        if (wr == 0) PG8_BAR;
        E(acc, cur, wr, wc, fr, fq);
        if (!has_next) break;
        if (!cur.keep) {
#pragma unroll
            for (int a = 0; a < 2; ++a)
#pragma unroll
                for (int b = 0; b < 2; ++b)
#pragma unroll
                    for (int m = 0; m < 4; ++m)
#pragma unroll
                        for (int n = 0; n < 2; ++n) acc[a][b][m][n] = (f32x4){0.f, 0.f, 0.f, 0.f};
        }
        cur = nxt; cA = nA; cB = nB; ++ui;
        if (wr == 1) PG8_BAR;
    }
    PG8_WAIT_V(0);
    PG8_BAR;
#undef PG8_SA
#undef PG8_SB
#undef PG8_STAGE
#undef PG8_LDA
#undef PG8_LDB
#undef PG8_MMA
#undef PG8_WAIT_V
#undef PG8_WAIT_L
#undef PG8_BAR
#undef PG8_SCHED
}
}

struct EpiInProj {
    bf16_t* ACT; bf16_t* VT; float* out; const float* qng; const float* kng; const float* rope;
    __device__ __forceinline__ void operator()(f32x4 (&acc)[2][2][4][2], const pg8::Unit& u, int wr, int wc, int fr, int fq) const {
        const int pn = u.pn;
        int type = 0, slot = 0;
        if (pn < 2) { type = 1; slot = 4 * pn + wc; }
        else if (pn == 2 || (pn == 3 && wc < 2)) { type = 2; slot = 4 * (pn - 2) + wc; }
        else if (pn == 3 || pn == 4) { type = 3; slot = 4 * (pn - 3) + wc - 2; }
        const int rbase = u.pm * 256 + wr * 64 + fr;
        if (type == 1 || type == 2) {
            const float* gn = (type == 1) ? qng : kng;
            f32x4 g4[2][2];
#pragma unroll
            for (int bj = 0; bj < 2; ++bj)
#pragma unroll
                for (int n = 0; n < 2; ++n) g4[bj][n] = *(const f32x4*)(gn + 32 * bj + 16 * n + 4 * fq);
            const int br = slot >> 1, kvh = slot & 1;
#pragma unroll
            for (int ai = 0; ai < 2; ++ai)
#pragma unroll
                for (int m = 0; m < 4; ++m) {
                    const int row = rbase + ai * 128 + m * 16;
                    float ss = 0.f;
#pragma unroll
                    for (int bj = 0; bj < 2; ++bj)
#pragma unroll
                        for (int n = 0; n < 2; ++n) { const f32x4 v = acc[ai][bj][m][n]; ss += (v[0] * v[0] + v[1] * v[1]) + (v[2] * v[2] + v[3] * v[3]); }
                    ss += __shfl_xor(ss, 16); ss += __shfl_xor(ss, 32);
                    const float rinv = rsqrtf(ss * (1.0f / 64.0f) + 1e-6f);
                    const int pos = (row < MP) ? (row & (SEQ - 1)) : SEQ;
                    const bool live = row < MTOT;
                    long obase = -1;
                    if (type == 2 && live) {
                        if (row < MP) {
                            const int t = row & (SEQ - 1), b = row >> 11;
                            if (br == 0) obase = (long)O_PKC + (long)row * 128 + kvh * 64;
                            else if (br == 1) obase = (long)O_PKS + (long)row * 128 + kvh * 64;
                            else if (t >= 1536) obase = (long)O_PKW + ((long)(b * 512 + t - 1536) * 2 + kvh) * 64;
                        } else {
                            const int sb = row - MP;
                            if (br == 0) obase = (long)O_SKC + sb * 128 + kvh * 64;
                            else if (br == 1) obase = (long)O_SKS + sb * 128 + kvh * 64;
                            else obase = (long)O_SKW + ((long)(sb * 512 + 511) * 2 + kvh) * 64;
                        }
                    }
#pragma unroll
                    for (int n = 0; n < 2; ++n) {
                        const f32x4 cs0 = *(const f32x4*)(rope + ((size_t)pos * 32 + 16 * n + 4 * fq) * 2);
                        const f32x4 cs1 = *(const f32x4*)(rope + ((size_t)pos * 32 + 16 * n + 4 * fq) * 2 + 4);
                        const float cc[4] = {cs0[0], cs0[2], cs1[0], cs1[2]}, sn[4] = {cs0[1], cs0[3], cs1[1], cs1[3]};
                        f32x4 o0, o1;
#pragma unroll
                        for (int j = 0; j < 4; ++j) {
                            const float y0 = acc[ai][0][m][n][j] * rinv * g4[0][n][j], y1 = acc[ai][1][m][n][j] * rinv * g4[1][n][j];
                            o0[j] = y0 * cc[j] - y1 * sn[j]; o1[j] = y1 * cc[j] + y0 * sn[j];
                        }
                        if (live) {
                            const int dcol = 16 * n + 4 * fq;
                            if (type == 1) {
                                bf16_t* p = ACT + (size_t)row * NIN + LQ + 64 * slot + dcol;
                                u32x2 w0, w1; w0.x = cvt_pk_bf16(o0[0] * C2Q, o0[1] * C2Q); w0.y = cvt_pk_bf16(o0[2] * C2Q, o0[3] * C2Q); w1.x = cvt_pk_bf16(o1[0] * C2Q, o1[1] * C2Q); w1.y = cvt_pk_bf16(o1[2] * C2Q, o1[3] * C2Q);
                                *(u32x2*)p = w0; *(u32x2*)(p + 32) = w1;
                            } else {
                                bf16_t* p = ACT + (size_t)row * NIN + LK + 64 * slot + dcol;
                                u32x2 w0, w1; w0.x = cvt_pk_bf16(o0[0], o0[1]); w0.y = cvt_pk_bf16(o0[2], o0[3]); w1.x = cvt_pk_bf16(o1[0], o1[1]); w1.y = cvt_pk_bf16(o1[2], o1[3]);
                                *(u32x2*)p = w0; *(u32x2*)(p + 32) = w1;
                                if (obase >= 0) { *(f32x4*)(out + obase + dcol) = o0; *(f32x4*)(out + obase + 32 + dcol) = o1; }
                            }
                        }
                    }
                }
        } else if (type == 3) {
            const int br = slot >> 1, kvh = slot & 1;
#pragma unroll
            for (int ai = 0; ai < 2; ++ai)
#pragma unroll
                for (int m = 0; m < 4; ++m) {
                    const int row = rbase + ai * 128 + m * 16;
                    if (row < MTOT) {
                        long obase = -1;
                        if (row < MP) {
                            const int t = row & (SEQ - 1), b = row >> 11;
                            if (br == 0) obase = (long)O_PVC + (long)row * 128 + kvh * 64;
                            else if (br == 1) obase = (long)O_PVS + (long)row * 128 + kvh * 64;
                            else if (t >= 1536) obase = (long)O_PVW + ((long)(b * 512 + t - 1536) * 2 + kvh) * 64;
                            bf16_t* vt = VT + ((size_t)(b * 6 + slot) * 64) * SEQ + t;
#pragma unroll
                            for (int bj = 0; bj < 2; ++bj)
#pragma unroll
                                for (int n = 0; n < 2; ++n)
#pragma unroll
                                    for (int j = 0; j < 4; ++j) vt[(size_t)(32 * bj + 16 * n + 4 * fq + j) * SEQ] = (bf16_t)f2bf(acc[ai][bj][m][n][j]);
                        } else {
                            const int sb = row - MP;
                            if (br == 0) obase = (long)O_SVC + sb * 128 + kvh * 64;
                            else if (br == 1) obase = (long)O_SVS + sb * 128 + kvh * 64;
                            else obase = (long)O_SVW + ((long)(sb * 512 + 511) * 2 + kvh) * 64;
                        }
                        if (obase >= 0) {
#pragma unroll
                            for (int bj = 0; bj < 2; ++bj)
#pragma unroll
                                for (int n = 0; n < 2; ++n) *(f32x4*)(out + obase + 32 * bj + 16 * n + 4 * fq) = acc[ai][bj][m][n];
                        }
                    }
                }
        } else {
            const int mode = (pn <= 6) ? 1 : (pn <= 10) ? 0 : (pn <= 12) ? 1 : 2;
#pragma unroll
            for (int ai = 0; ai < 2; ++ai)
#pragma unroll
                for (int m = 0; m < 4; ++m) {
                    const int row = rbase + ai * 128 + m * 16;
                    if (row < MTOT) {
                        bf16_t* p = ACT + (size_t)row * NIN + 256 * pn + 64 * wc + 4 * fq;
#pragma unroll
                        for (int bj = 0; bj < 2; ++bj)
#pragma unroll
                            for (int n = 0; n < 2; ++n) {
                                f32x4 v = acc[ai][bj][m][n];
#pragma unroll
                                for (int j = 0; j < 4; ++j) { const float sg = sigmoidf_(v[j]); v[j] = (mode == 0) ? v[j] : (mode == 1) ? v[j] * sg : sg; }
                                u32x2 w; w.x = cvt_pk_bf16(v[0], v[1]); w.y = cvt_pk_bf16(v[2], v[3]);
                                *(u32x2*)(p + 32 * bj + 16 * n) = w;
                            }
                    }
                }
        }
    }
};

struct EpiMix {
    const bf16_t* ACT; bf16_t* M;
    __device__ __forceinline__ void operator()(f32x4 (&acc)[2][2][4][2], const pg8::Unit& u, int wr, int wc, int fr, int fq) const {
        const int rbase = u.pm * 256 + wr * 64 + fr, cbase = u.pn * 256 + wc * 32 + 4 * fq;
#pragma unroll
        for (int ai = 0; ai < 2; ++ai)
#pragma unroll
            for (int m = 0; m < 4; ++m) {
                const int row = rbase + ai * 128 + m * 16;
                const bool live = row < MTOT;
                const int rr = live ? row : 0;
#pragma unroll
                for (int bj = 0; bj < 2; ++bj)
#pragma unroll
                    for (int n = 0; n < 2; ++n) {
                        const int col = cbase + 128 * bj + 16 * n;
                        float sb[4]; unpack4(*(const u32x2*)(ACT + (size_t)rr * NIN + LGB + col), sb);
                        if (u.keep) {
                            float sa[4]; unpack4(*(const u32x2*)(ACT + (size_t)rr * NIN + LGA + col), sa);
#pragma unroll
                            for (int j = 0; j < 4; ++j) acc[ai][bj][m][n][j] *= sa[j] * __builtin_amdgcn_rcpf(sb[j]);
                        } else if (live) {
                            const f32x4 v = acc[ai][bj][m][n];
                            u32x2 w; w.x = cvt_pk_bf16(v[0] * sb[0], v[1] * sb[1]); w.y = cvt_pk_bf16(v[2] * sb[2], v[3] * sb[3]);
                            *(u32x2*)(M + (size_t)row * DM + col) = w;
                        }
                    }
            }
    }
};

struct EpiOut {
    const float* xp; const float* xs; const float* MOD; float* out;
    __device__ __forceinline__ void operator()(f32x4 (&acc)[2][2][4][2], const pg8::Unit& u, int wr, int wc, int fr, int fq) const {
        const int rbase = u.pm * 256 + wr * 64 + fr, cbase = u.pn * 256 + wc * 32 + 4 * fq;
#pragma unroll
        for (int ai = 0; ai < 2; ++ai)
#pragma unroll
            for (int m = 0; m < 4; ++m) {
                const int row = rbase + ai * 128 + m * 16;
                if (row < MTOT) {
                    const float* xr; const float* gr; float* orow;
                    if (row < MP) { xr = xp + (size_t)row * DM; gr = MOD + (size_t)(row >> 11) * 3072 + 2048; orow = out + O_YP + (size_t)row * DM; }
                    else { const int sb = row - MP; xr = xs + (size_t)sb * DM; gr = MOD + (size_t)(8 + sb) * 3072 + 2048; orow = out + O_YS + (size_t)sb * DM; }
#pragma unroll
                    for (int bj = 0; bj < 2; ++bj)
#pragma unroll
                        for (int n = 0; n < 2; ++n) {
                            const int col = cbase + 128 * bj + 16 * n;
                            const f32x4 xv = *(const f32x4*)(xr + col), gv = *(const f32x4*)(gr + col);
                            *(f32x4*)(orow + col) = xv + gv * acc[ai][bj][m][n];
                        }
                }
            }
    }
};

__device__ __forceinline__ void transpose_item(const float* src, int src_ld, int nvalid, bf16_t* dst, int dst_ld, LAS float* scr, int lane) {
    float tv[32];
#pragma unroll
    for (int i = 0; i < 32; ++i) { const int kk = 2 * i + (lane >> 5), cc = lane & 31; tv[i] = src[(size_t)kk * src_ld + (cc < nvalid ? cc : 0)]; }
#pragma unroll
    for (int i = 0; i < 32; ++i) { const int kk = 2 * i + (lane >> 5), cc = lane & 31; scr[kk * 33 + cc] = (cc < nvalid) ? tv[i] : 0.f; }
    asm volatile("s_waitcnt lgkmcnt(0)" ::: "memory");
    const int c = lane & 7;
#pragma unroll
    for (int j = 0; j < 4; ++j) { const int n = (lane >> 3) + 8 * j; const LAS float* s = scr + (8 * c) * 33 + n;
        u32x4 o; o.x = pk2(s[0 * 33], s[1 * 33]); o.y = pk2(s[2 * 33], s[3 * 33]); o.z = pk2(s[4 * 33], s[5 * 33]); o.w = pk2(s[6 * 33], s[7 * 33]);
        *(u32x4*)(dst + (size_t)n * dst_ld + 8 * c) = o; }
    asm volatile("s_waitcnt lgkmcnt(0)" ::: "memory");
}

__device__ __forceinline__ void p0_prologue(const Params& P, LAS unsigned char* lds, int gw, int NGW, int lane, int wave, int gtid, int NT) {
    unsigned char* ws = P.ws;
    LAS float* scr = (LAS float*)(lds + wave * 16384);
    constexpr int I_MOD = 9 * 48, I_WIN = 16 * 176, I_WBR = 16 * 32, I_WOUT = 16 * 32, I_POOL = NSB * 16 * 2;
    constexpr int I_TOTAL = I_MOD + I_WIN + I_WBR + I_WOUT + I_POOL;
    for (int it0 = gw; it0 < I_TOTAL; it0 += NGW) {
        int it = it0;
        if (it < I_MOD) {
            const int mt = it / 48, ng = it % 48, lr = lane & 15, kq = lane >> 4;
            int arow_i = 16 * mt + lr; if (arow_i > 135) arow_i = 135;
            const float* arow = ((arow_i < 8) ? P.in[9] + (size_t)arow_i * DM : P.in[10] + (size_t)(arow_i - 8) * DM) + 4 * kq;
            const float* bp = P.in[11] + (size_t)(4 * kq) * 3072 + 64 * ng + 4 * lr;
            f32x4 macc[4];
#pragma unroll
            for (int nt = 0; nt < 4; ++nt) macc[nt] = (f32x4){0.f, 0.f, 0.f, 0.f};
#pragma unroll 4
            for (int k16 = 0; k16 < DM; k16 += 16) {
                const f32x4 a = *(const f32x4*)(arow + k16);
#pragma unroll
                for (int e = 0; e < 4; ++e) {
                    const f32x4 bv = *(const f32x4*)(bp + (size_t)(k16 + e) * 3072);
#pragma unroll
                    for (int nt = 0; nt < 4; ++nt) macc[nt] = __builtin_amdgcn_mfma_f32_16x16x4f32(a[e], bv[nt], macc[nt], 0, 0, 0);
                }
            }
            float* MOD = (float*)(ws + WS_MOD);
            const f32x4 bb = *(const f32x4*)(P.in[12] + 64 * ng + 4 * lr);
#pragma unroll
            for (int r = 0; r < 4; ++r) { const int row = 16 * mt + 4 * kq + r;
                if (row < 136) *(f32x4*)(MOD + (size_t)row * 3072 + 64 * ng + 4 * lr) = (f32x4){macc[0][r] + bb[0], macc[1][r] + bb[1], macc[2][r] + bb[2], macc[3][r] + bb[3]}; }
            continue;
        }
        it -= I_MOD;
        if (it < I_WIN) {
            const int kb = it / 176, nb = it % 176;
            const int pn = nb >> 3, bj = (nb >> 2) & 1, wc = nb & 3;
            const int L0 = 256 * pn + 64 * wc + 32 * bj;
            int srcc, nvalid;
            if (L0 < 1280) { srcc = L0; nvalid = 32; } else if (L0 < LNSA) { srcc = L0 + 24; nvalid = 32; } else if (L0 == LNSA) { srcc = 1280; nvalid = 24; } else { srcc = 0; nvalid = 0; }
            transpose_item(P.in[14] + (size_t)(64 * kb) * 5400 + srcc, 5400, nvalid, (bf16_t*)(ws + WS_WTIN) + (size_t)(32 * nb) * DM + 64 * kb, DM, scr, lane);
            continue;
        }
        it -= I_WIN;
        if (it < I_WBR) {
            const int kb = it / 32, nb = it % 32;
            const float* src = (kb < 8) ? P.in[25] + (size_t)(64 * kb) * DM : P.in[26] + (size_t)(64 * (kb - 8)) * DM;
            transpose_item(src + 32 * nb, DM, 32, (bf16_t*)(ws + WS_WTBR) + (size_t)(32 * nb) * DM + 64 * kb, DM, scr, lane);
            continue;
        }
        it -= I_WBR;
        if (it < I_WOUT) {
            const int kb = it / 32, nb = it % 32;
            transpose_item(P.in[27] + (size_t)(64 * kb) * DM + 32 * nb, DM, 32, (bf16_t*)(ws + WS_WTOUT) + (size_t)(32 * nb) * DM + 64 * kb, DM, scr, lane);
            continue;
        }
        it -= I_WOUT;
        {
            const int sb = it >> 5, pg = (it >> 1) & 15, which = it & 1;
            const int page = ((const int*)P.in[8])[sb * 16 + pg];
            const float* src = P.in[2 + which] + (size_t)page * 128 * 128;
            const float* pe = P.in[17 + which]; const float* w = P.in[19 + which];
            const int d0 = (2 * lane) & 63;
            float p0 = 0.f, p1 = 0.f;
#pragma unroll 8
            for (int r = 0; r < 32; ++r) { const f32x2 v = *(const f32x2*)(pe + r * 64 + d0); p0 += v[0]; p1 += v[1]; }
#pragma unroll
            for (int cb = 0; cb < 4; ++cb) {
                f32x2 v[32];
#pragma unroll
                for (int r = 0; r < 32; ++r) v[r] = __builtin_nontemporal_load((const f32x2*)(src + (size_t)(cb * 32 + r) * 128 + 2 * lane));
                float s0 = 0.f, s1 = 0.f;
#pragma unroll
                for (int r = 0; r < 32; ++r) { s0 += v[r][0]; s1 += v[r][1]; }
                scr[d0 * 8 + cb * 2 + (lane >> 5)] = (s0 + p0) * (1.0f / 32.0f); scr[(d0 + 1) * 8 + cb * 2 + (lane >> 5)] = (s1 + p1) * (1.0f / 32.0f);
            }
            asm volatile("s_waitcnt lgkmcnt(0)" ::: "memory");
            float a[8];
#pragma unroll
            for (int q = 0; q < 8; ++q) a[q] = 0.f;
#pragma unroll 8
            for (int d = 0; d < 64; ++d) { const float wv = w[d * 64 + lane]; const f32x4 pa = *(const LAS f32x4*)(scr + d * 8), pb = *(const LAS f32x4*)(scr + d * 8 + 4);
                a[0] += pa[0] * wv; a[1] += pa[1] * wv; a[2] += pa[2] * wv; a[3] += pa[3] * wv; a[4] += pb[0] * wv; a[5] += pb[1] * wv; a[6] += pb[2] * wv; a[7] += pb[3] * wv; }
            float* dst = (float*)(ws + (which ? WS_VCS : WS_KCS));
#pragma unroll
            for (int q = 0; q < 8; ++q) dst[((size_t)(sb * 2 + (q & 1)) * 64 + 4 * pg + (q >> 1)) * 64 + lane] = a[q];
            asm volatile("s_waitcnt lgkmcnt(0)" ::: "memory");
        }
    }
    float* rope = (float*)(ws + WS_ROPE);
    for (int i = gtid; i < 2049 * 32; i += NT) {
        const int pos = i >> 5, k = i & 31;
        const float inv = (float)exp(-(double)k * (1.0 / 32.0) * 9.210340371976184);
        const float ang = (float)pos * inv;
        rope[2 * i] = (float)cos((double)ang); rope[2 * i + 1] = (float)sin((double)ang);
    }
    bf16_t* tril = (bf16_t*)(ws + WS_TRIL);
    for (int i = gtid; i < 4 * 128 * 128; i += NT) { const int r = (i >> 7) & 127, cidx = i & 127; tril[i] = (cidx <= r) ? (bf16_t)f2bf(P.in[23][i]) : (bf16_t)0; }
    for (int tk = blockIdx.x; tk < 2 * NSB * 2; tk += gridDim.x) {
        const int w2 = tk >> 8, sb = (tk >> 1) & 127, half = tk & 1;
        const f32x4* src = (const f32x4*)P.in[6 + w2] + (size_t)sb * 512 * 32 + 32 + half * 8176; f32x4* dst = (f32x4*)(P.out + (w2 ? O_SVW : O_SKW)) + (size_t)sb * 512 * 32 + half * 8176;
        f32x4 cv[16];
#pragma unroll
        for (int u = 0; u < 16; ++u) { const int i = threadIdx.x + 512 * u; if (i < 8176) cv[u] = __builtin_nontemporal_load(src + i); }
#pragma unroll
        for (int u = 0; u < 16; ++u) { const int i = threadIdx.x + 512 * u; if (i < 8176) __builtin_nontemporal_store(cv[u], dst + i); }
    }
}

__device__ __forceinline__ void p1_hrows(const Params& P, int gw, int NGW, int lane) {
    const float* MOD = (const float*)(P.ws + WS_MOD); bf16_t* H = (bf16_t*)(P.ws + WS_H); const float* ng = P.in[13];
    for (int row = gw; row < MPAD; row += NGW) {
        unsigned long long* o8 = (unsigned long long*)(H + (size_t)row * DM) + lane;
        if (row >= MTOT) {
#pragma unroll
            for (int j = 0; j < 4; ++j) o8[64 * j] = 0ull;
            continue; }
        const float* xr; const float* md;
        if (row < MP) { xr = P.in[0] + (size_t)row * DM; md = MOD + (size_t)(row >> 11) * 3072; } else { xr = P.in[1] + (size_t)(row - MP) * DM; md = MOD + (size_t)(8 + row - MP) * 3072; }
        f32x4 v[4]; float s = 0.f;
#pragma unroll
        for (int j = 0; j < 4; ++j) { v[j] = ((const f32x4*)xr)[lane + 64 * j]; s += (v[j][0] * v[j][0] + v[j][1] * v[j][1]) + (v[j][2] * v[j][2] + v[j][3] * v[j][3]); }
        const float rstd = rsqrtf(wave_sum(s) * (1.0f / DM) + 1e-6f);
#pragma unroll
        for (int j = 0; j < 4; ++j) {
            const int col = 4 * lane + 256 * j;
            const f32x4 g = *(const f32x4*)(ng + col), sh = *(const f32x4*)(md + col), sc = *(const f32x4*)(md + 1024 + col);
            const f32x4 h = (v[j] * rstd) * g * (sc + 1.0f) + sh;
            o8[64 * j] = (unsigned long long)pk2(h[0], h[1]) | ((unsigned long long)pk2(h[2], h[3]) << 32);
        }
    }
}

__device__ __forceinline__ void p3_compress(const Params& P, LAS unsigned char* lds, int gw, int NGW, int lane, int wave) {
    LAS float* scr = (LAS float*)(lds + wave * 1024);
    for (int it = gw; it < NBATCH * 64 * 2 * 2; it += NGW) {
        const int b = it >> 8, c = (it >> 2) & 63, kvh = (it >> 1) & 1, which = it & 1;
        const float* src = P.out + (which ? O_PVC : O_PKC) + ((size_t)(b * SEQ + 32 * c) * 2 + kvh) * 64;
        const float* pe = P.in[17 + which]; const float* w = P.in[19 + which];
        float s = 0.f;
#pragma unroll 8
        for (int r = 0; r < 32; ++r) s += src[(size_t)r * 128 + lane] + pe[r * 64 + lane];
        scr[lane] = s * (1.0f / 32.0f);
        asm volatile("s_waitcnt lgkmcnt(0)" ::: "memory");
        float a = 0.f;
#pragma unroll 8
        for (int d = 0; d < 64; ++d) a += scr[d] * w[d * 64 + lane];
        if (which == 0) ((bf16_t*)(P.ws + WS_KC))[((size_t)(b * 64 + c) * 2 + kvh) * 64 + lane] = (bf16_t)f2bf(a);
        else ((bf16_t*)(P.ws + WS_VCT))[((size_t)(b * 2 + kvh) * 64 + lane) * 64 + c] = (bf16_t)f2bf(a);
        asm volatile("s_waitcnt lgkmcnt(0)" ::: "memory");
    }
}

constexpr int KPITCH = 72;
constexpr int A_TILE = 36864;
constexpr int A_OA = 2 * A_TILE;
constexpr int A_IMP = A_TILE, A_IMPS = 0, A_SEL = 2 * 32 * 33 * 4;
static_assert(A_OA + 8 * 8192 <= LDS_XB && 8 * 32 * 33 * 4 <= A_TILE && A_SEL + 256 <= A_TILE, "attention LDS map");

struct TileSrc { const bf16_t* kb; const bf16_t* v0; const bf16_t* v1; unsigned kpitch, vpitch; };
__device__ __forceinline__ TileSrc attn_tile_src(const Params& P, int b, int T, int n_slc, int lo) {
    TileSrc s;
    if (T == 0) { s.kb = (const bf16_t*)(P.ws + WS_KC) + (size_t)b * 64 * 128; s.v0 = (const bf16_t*)(P.ws + WS_VCT) + (size_t)(b * 2) * 4096; s.v1 = s.v0 + 4096; s.kpitch = 128; s.vpitch = 64; }
    else {
        const bool slc = T <= n_slc; const int j = slc ? T - 1 : lo + (T - 1 - n_slc), br = slc ? 1 : 2;
        s.kb = (const bf16_t*)(P.ws + WS_ACT) + ((size_t)b * SEQ + 64 * j) * NIN + LK + 128 * br;
        s.v0 = (const bf16_t*)(P.ws + WS_VT) + ((size_t)(b * 6 + 2 * br) * 64) * SEQ + 64 * j; s.v1 = s.v0 + (size_t)64 * SEQ; s.kpitch = NIN; s.vpitch = SEQ;
    }
    return s;
}
__device__ __forceinline__ void attn_fetch(u32x4 (&R)[4], const TileSrc& s, int tid_in) {
    int tid = tid_in; asm volatile("" : "+v"(tid));
#pragma unroll
    for (int i = 0; i < 2; ++i) {
        const int idx = tid + 512 * i;
        R[i] = *(const u32x4*)(s.kb + (size_t)(idx >> 4) * s.kpitch + (idx & 15) * 8);
        R[2 + i] = *(const u32x4*)((i ? s.v1 : s.v0) + (size_t)((idx >> 3) & 63) * s.vpitch + (idx & 7) * 8);
    }
}
__device__ __forceinline__ void attn_store(LAS unsigned char* buf, const u32x4 (&R)[4], int tid_in) {
    int tid = tid_in; asm volatile("" : "+v"(tid));
    LAS bf16_t* Ks = (LAS bf16_t*)buf; LAS bf16_t* Vts = Ks + 2 * 64 * KPITCH;
#pragma unroll
    for (int i = 0; i < 2; ++i) {
        const int idx = tid + 512 * i, key = idx >> 4, ch = idx & 15, d = (idx >> 3) & 63, cv = idx & 7;
        *(LAS u32x4*)(Ks + ((ch >> 3) * 64 + key) * KPITCH + (ch & 7) * 8) = R[i];
        *(LAS u32x4*)(Vts + (i * 64 + d) * KPITCH + cv * 8) = R[2 + i];
    }
}

template <int MODE>
__device__ __forceinline__ void attn_tile(const LAS bf16_t* Kg, const LAS bf16_t* Vg, const bf16x8 (&qf)[2][2], f32x4 (&O)[4][2], float (&mrun)[2], float (&lrun)[2], f32x4 (&s)[2][4],
                                          int lane_in, int kbase, const int (&qpos)[2], const float (&cinit)[2], bool emask) {
    int lane = lane_in; asm volatile("" : "+v"(lane));
    const int lr = lane & 15, grp = lane >> 4;
#pragma unroll
    for (int kt = 0; kt < 4; ++kt) {
        const bf16x8 k0 = *(const LAS bf16x8*)(Kg + (16 * kt + lr) * KPITCH + 8 * grp);
        const bf16x8 k1 = *(const LAS bf16x8*)(Kg + (16 * kt + lr) * KPITCH + 32 + 8 * grp);
#pragma unroll
        for (int qt = 0; qt < 2; ++qt) {
            const f32x4 a = __builtin_amdgcn_mfma_f32_16x16x32_bf16(k0, qf[qt][0], (f32x4){cinit[qt], cinit[qt], cinit[qt], cinit[qt]}, 0, 0, 0);
            s[qt][kt] = __builtin_amdgcn_mfma_f32_16x16x32_bf16(k1, qf[qt][1], a, 0, 0, 0);
        }
    }
    if (emask) {
#pragma unroll
        for (int qt = 0; qt < 2; ++qt)
#pragma unroll
            for (int kt = 0; kt < 4; ++kt)
#pragma unroll
                for (int r = 0; r < 4; ++r) {
                    const int key = 16 * kt + 4 * grp + r;
                    bool valid;
                    if (MODE == 0) valid = key < ((qpos[qt] + 1) >> 5);
                    else if (MODE == 1) valid = (kbase + key <= qpos[qt]);
                    else { const int kp = kbase + key; valid = (kp <= qpos[qt]) && (kp > qpos[qt] - 512); }
                    s[qt][kt][r] = valid ? s[qt][kt][r] : NEGBIG;
                }
    }
#pragma unroll
    for (int qt = 0; qt < 2; ++qt) {
        float mx = fmaxf(fmaxf(s[qt][0][0], s[qt][0][1]), fmaxf(s[qt][0][2], s[qt][0][3]));
#pragma unroll
        for (int kt = 1; kt < 4; ++kt) mx = fmaxf(mx, fmaxf(fmaxf(s[qt][kt][0], s[qt][kt][1]), fmaxf(s[qt][kt][2], s[qt][kt][3])));
        mx = fmaxf(mx, __shfl_xor(mx, 16)); mx = fmaxf(mx, __shfl_xor(mx, 32));
        const float mnew = fmaxf(mrun[qt], mx);
        const float alpha = __builtin_amdgcn_exp2f(mrun[qt] - mnew);
        mrun[qt] = mnew;
        float ls = 0.f;
#pragma unroll
        for (int kt = 0; kt < 4; ++kt)
#pragma unroll
            for (int r = 0; r < 4; ++r) { const float p = __builtin_amdgcn_exp2f(s[qt][kt][r] - mnew); s[qt][kt][r] = p; ls += p; }
        lrun[qt] = lrun[qt] * alpha + ls;
#pragma unroll
        for (int dt = 0; dt < 4; ++dt) O[dt][qt] *= alpha;
    }
#pragma unroll
    for (int c2 = 0; c2 < 2; ++c2) {
        bf16x8 pf[2];
#pragma unroll
        for (int qt = 0; qt < 2; ++qt) {
            u32x4 w; w.x = cvt_pk_bf16(s[qt][2 * c2][0], s[qt][2 * c2][1]); w.y = cvt_pk_bf16(s[qt][2 * c2][2], s[qt][2 * c2][3]);
            w.z = cvt_pk_bf16(s[qt][2 * c2 + 1][0], s[qt][2 * c2 + 1][1]); w.w = cvt_pk_bf16(s[qt][2 * c2 + 1][2], s[qt][2 * c2 + 1][3]);
            pf[qt] = __builtin_bit_cast(bf16x8, w);
        }
#pragma unroll
        for (int dt = 0; dt < 4; ++dt) {
            const u32x2 lo = *(const LAS u32x2*)(Vg + (16 * dt + lr) * KPITCH + 32 * c2 + 4 * grp);
            const u32x2 hi = *(const LAS u32x2*)(Vg + (16 * dt + lr) * KPITCH + 32 * c2 + 16 + 4 * grp);
            const u32x4 vv = {lo.x, lo.y, hi.x, hi.y};
            const bf16x8 vf = __builtin_bit_cast(bf16x8, vv);
#pragma unroll
            for (int qt = 0; qt < 2; ++qt) O[dt][qt] = __builtin_amdgcn_mfma_f32_16x16x32_bf16(vf, pf[qt], O[dt][qt], 0, 0, 0);
        }
    }
}

__device__ __forceinline__ void attn_unit(const Params& P, LAS unsigned char* lds, int b, int qb32, int tid, int lane, int wave) {
    asm volatile("" : "+v"(tid), "+v"(lane));
    const bf16_t* ACT = (const bf16_t*)(P.ws + WS_ACT); bf16_t* AB = (bf16_t*)(P.ws + WS_AB);
    const int lr = lane & 15, grp = lane >> 4, g = wave >> 2;
    const int t0 = 32 * qb32, qblk = t0 >> 6; const size_t row0 = (size_t)b * SEQ + t0;
    const int n_slc = qblk + 1, lo = (t0 - 511 > 0) ? ((t0 - 511) >> 6) : 0, NT = 1 + n_slc + (qblk - lo + 1);
    LAS float* IMP = (LAS float*)(lds + A_IMP); LAS float* IMPS = (LAS float*)(lds + A_IMPS); LAS unsigned* SEL = (LAS unsigned*)(lds + A_SEL);
    bf16x8 qf[2][2]; int qpos[2]; float gate[2][3];
#pragma unroll
    for (int qt = 0; qt < 2; ++qt) {
        const size_t row = row0 + 16 * qt + lr; qpos[qt] = t0 + 16 * qt + lr;
#pragma unroll
        for (int ks = 0; ks < 2; ++ks) qf[qt][ks] = *(const bf16x8*)(ACT + row * NIN + LQ + 64 * wave + 32 * ks + 8 * grp);
#pragma unroll
        for (int br = 0; br < 3; ++br) gate[qt][br] = bf2f(ACT[row * NIN + LNSA + 3 * wave + br]);
    }
    f32x4 O[4][2], s[2][4]; float mrun[2], lrun[2]; unsigned selm[2] = {0u, 0u};
    LAS float* OAl = (LAS float*)(lds + A_OA) + wave * 2048 + lane;
#pragma unroll
    for (int dt = 0; dt < 4; ++dt)
#pragma unroll
        for (int qt = 0; qt < 2; ++qt) O[dt][qt] = (f32x4){0.f, 0.f, 0.f, 0.f};
    mrun[0] = mrun[1] = MINIT; lrun[0] = lrun[1] = 0.f;
#define ATT_FINISH(br) do { _Pragma("unroll") for (int qt = 0; qt < 2; ++qt) { float lt = lrun[qt]; lt += __shfl_xor(lt, 16); lt += __shfl_xor(lt, 32); \
        const float f = (lt > 0.f) ? gate[qt][br] / lt : 0.f; _Pragma("unroll") for (int dt = 0; dt < 4; ++dt) _Pragma("unroll") for (int r = 0; r < 4; ++r) { \
            float v = O[dt][qt][r] * f; if ((br) > 0) v += OAl[64 * ((dt * 2 + qt) * 4 + r)]; if ((br) < 2) { OAl[64 * ((dt * 2 + qt) * 4 + r)] = v; O[dt][qt][r] = 0.f; } else O[dt][qt][r] = v; } \
        mrun[qt] = MINIT; lrun[qt] = 0.f; } } while (0)
    u32x4 R[4];
    __syncthreads();
    { const TileSrc s0 = attn_tile_src(P, b, 0, n_slc, lo); attn_fetch(R, s0, tid); attn_store(lds, R, tid); }
    __syncthreads();
    for (int T = 0; T < NT; ++T) {
        const bool more = T + 1 < NT;
        if (more) { const TileSrc sn = attn_tile_src(P, b, T + 1, n_slc, lo); attn_fetch(R, sn, tid); }
        const LAS bf16_t* Kg = (const LAS bf16_t*)(lds + (T & 1) * A_TILE) + g * 64 * KPITCH; const LAS bf16_t* Vg = Kg + 2 * 64 * KPITCH;
        const float czero[2] = {0.f, 0.f};
        if (T == 0) {
            attn_tile<0>(Kg, Vg, qf, O, mrun, lrun, s, lane, 0, qpos, czero, true);
#pragma unroll
            for (int qt = 0; qt < 2; ++qt) {
                float lt = lrun[qt]; lt += __shfl_xor(lt, 16); lt += __shfl_xor(lt, 32);
                const float inv = (lt > 0.f) ? 1.0f / lt : 0.f;
#pragma unroll
                for (int kt = 0; kt < 4; ++kt)
#pragma unroll
                    for (int rr = 0; rr < 2; ++rr) IMP[(wave * 32 + 16 * qt + lr) * 33 + 8 * kt + 2 * grp + rr] = (s[qt][kt][2 * rr] + s[qt][kt][2 * rr + 1]) * inv;
            }
            ATT_FINISH(0);
            __syncthreads();
            for (int i = tid; i < 2 * 32 * 32; i += 512) { const int gg = i >> 10, q = (i >> 5) & 31, j = i & 31;
                IMPS[(gg * 32 + q) * 33 + j] = (IMP[((4 * gg + 0) * 32 + q) * 33 + j] + IMP[((4 * gg + 1) * 32 + q) * 33 + j]) + (IMP[((4 * gg + 2) * 32 + q) * 33 + j] + IMP[((4 * gg + 3) * 32 + q) * 33 + j]); }
            __syncthreads();
            if (tid < 64) {
                const int gg = tid >> 5, q = tid & 31;
                unsigned mask = 1u | (1u << qblk);
                if (qblk - 1 <= 6) mask = (qblk >= 31) ? 0xffffffffu : ((2u << qblk) - 1u);
                else {
                    const LAS float* v = IMPS + (gg * 32 + q) * 33;
                    for (int pick = 0; pick < 6; ++pick) { float best = -1.f; int bi = 1;
                        for (int j = 1; j < qblk; ++j) { const float x = v[j]; if (!((mask >> j) & 1u) && x > best) { best = x; bi = j; } }
                        mask |= 1u << bi; }
                }
                SEL[gg * 32 + q] = mask;
            }
            __syncthreads();
            selm[0] = SEL[g * 32 + lr]; selm[1] = SEL[g * 32 + 16 + lr];
        } else if (T <= n_slc) {
            const int jb = T - 1;
            const float cin[2] = {((selm[0] >> jb) & 1u) ? 0.f : NEGBIG, ((selm[1] >> jb) & 1u) ? 0.f : NEGBIG};
            if (__any((int)(((selm[0] | selm[1]) >> jb) & 1u))) attn_tile<1>(Kg, Vg, qf, O, mrun, lrun, s, lane, 64 * jb, qpos, cin, jb == qblk);
            if (T == n_slc) ATT_FINISH(1);
        } else {
            const int jt = lo + (T - 1 - n_slc);
            const bool em = (64 * jt + 63 > t0) || (64 * jt <= t0 + 31 - 512);
            attn_tile<2>(Kg, Vg, qf, O, mrun, lrun, s, lane, 64 * jt, qpos, czero, em);
            if (T == NT - 1) ATT_FINISH(2);
        }
        if (more) attn_store(lds + ((T + 1) & 1) * A_TILE, R, tid);
        __syncthreads();
    }
#undef ATT_FINISH
#pragma unroll
    for (int qt = 0; qt < 2; ++qt) {
        const size_t row = row0 + 16 * qt + lr;
#pragma unroll
        for (int dt = 0; dt < 4; ++dt) {
            const int col = 64 * wave + 16 * dt + 4 * grp;
            float za[4]; unpack4(*(const u32x2*)(ACT + row * NIN + LZA + col), za);
            u32x2 w; w.x = cvt_pk_bf16(O[dt][qt][0] * za[0], O[dt][qt][1] * za[1]); w.y = cvt_pk_bf16(O[dt][qt][2] * za[2], O[dt][qt][3] * za[3]);
            *(u32x2*)(AB + row * DM + col) = w;
        }
    }
}

constexpr int G_ST = 0, G_VNT = 1024, VPITCH = 136;
__device__ __forceinline__ void gmlp_unit(const Params& P, LAS unsigned char* lds, int b, int ch, int g, int tid, int lane, int wave) {
    const bf16_t* ACT = (const bf16_t*)(P.ws + WS_ACT); bf16_t* AB = (bf16_t*)(P.ws + WS_AB); const bf16_t* tril = (const bf16_t*)(P.ws + WS_TRIL) + (size_t)g * 128 * 128;
    LAS f32x2* ST = (LAS f32x2*)(lds + G_ST); LAS bf16_t* Vnt = (LAS bf16_t*)(lds + G_VNT);
    const size_t R0 = (size_t)b * SEQ + 128 * ch;
    __syncthreads();
    for (int j = wave; j < 128; j += 8) {
        const u32x4 raw = *(const u32x4*)(ACT + (R0 + j) * NIN + LVB + 8 * lane);
        float f[8]; f[0] = bf2f(raw.x); f[1] = bf2f(raw.x >> 16); f[2] = bf2f(raw.y); f[3] = bf2f(raw.y >> 16); f[4] = bf2f(raw.z); f[5] = bf2f(raw.z >> 16); f[6] = bf2f(raw.w); f[7] = bf2f(raw.w >> 16);
        float sm = 0.f;
#pragma unroll
        for (int i = 0; i < 8; ++i) sm += f[i];
        const float mean = wave_sum(sm) * (1.0f / 512.0f);
        float sq = 0.f;
#pragma unroll
        for (int i = 0; i < 8; ++i) { const float d = f[i] - mean; sq += d * d; }
        const float rstd = rsqrtf(wave_sum(sq) * (1.0f / 512.0f) + 1e-6f);
        if (lane == 0) ST[j] = (f32x2){mean, rstd};
    }
    __syncthreads();
    const float* vg = P.in[21] + 128 * g; const float* vb = P.in[22] + 128 * g;
#pragma unroll
    for (int i = 0; i < 4; ++i) {
        const int idx = tid + 512 * i, j = idx & 127, chn = idx >> 7;
        const u32x4 raw = *(const u32x4*)(ACT + (R0 + j) * NIN + LVB + 128 * g + 8 * chn);
        const f32x2 st = ST[j];
        float f[8]; f[0] = bf2f(raw.x); f[1] = bf2f(raw.x >> 16); f[2] = bf2f(raw.y); f[3] = bf2f(raw.y >> 16); f[4] = bf2f(raw.z); f[5] = bf2f(raw.z >> 16); f[6] = bf2f(raw.w); f[7] = bf2f(raw.w >> 16);
#pragma unroll
        for (int e = 0; e < 8; ++e) { const int d = 8 * chn + e; Vnt[d * VPITCH + j] = (bf16_t)f2bf((f[e] - st[0]) * st[1] * vg[d] + vb[d]); }
    }
    __syncthreads();
    const int lr = lane & 15, grp = lane >> 4;
    f32x4 acc[8];
#pragma unroll
    for (int it = 0; it < 8; ++it) acc[it] = (f32x4){0.f, 0.f, 0.f, 0.f};
#pragma unroll
    for (int ks = 0; ks < 4; ++ks) {
        const bf16x8 af = *(const LAS bf16x8*)(Vnt + (16 * wave + lr) * VPITCH + 32 * ks + 8 * grp);
#pragma unroll
        for (int it = 0; it < 8; ++it) {
            if ((it >> 1) >= ks) { const bf16x8 bfr = *(const bf16x8*)(tril + (size_t)(16 * it + lr) * 128 + 32 * ks + 8 * grp);
                acc[it] = __builtin_amdgcn_mfma_f32_16x16x32_bf16(af, bfr, acc[it], 0, 0, 0); }
        }
    }
    const float* bs = P.in[24] + 128 * g;
#pragma unroll
    for (int it = 0; it < 8; ++it) {
        const int i = 16 * it + lr; const size_t row = R0 + i; const int d0 = 128 * g + 16 * wave + 4 * grp;
        const float bsi = bs[i];
        float uu[4], zb[4]; unpack4(*(const u32x2*)(ACT + row * NIN + LU + d0), uu); unpack4(*(const u32x2*)(ACT + row * NIN + LZB + d0), zb);
        u32x2 w; w.x = cvt_pk_bf16(uu[0] * (acc[it][0] + bsi) * zb[0], uu[1] * (acc[it][1] + bsi) * zb[1]); w.y = cvt_pk_bf16(uu[2] * (acc[it][2] + bsi) * zb[2], uu[3] * (acc[it][3] + bsi) * zb[3]);
        *(u32x2*)(AB + row * DM + 512 + d0) = w;
    }
}

__device__ __forceinline__ void stile(const float* kb, const float* vb, int stride, int kmin, const f32x4 (&q4)[4], float (&m)[4], float (&l)[4], f32x4 (&o4)[4], float (&pout)[4], int lane_in) {
    int lane = lane_in; asm volatile("" : "+v"(lane));
    const int li = lane & 15, gq = lane >> 4;
    __builtin_amdgcn_sched_barrier(0);
    const float* kl = kb + (size_t)(gq * stride + 4 * li); const float* vl = vb + (size_t)(gq * stride + 4 * li);
    f32x4 kreg[16], vreg[16];
#pragma unroll
    for (int i = 0; i < 16; ++i) kreg[i] = __builtin_nontemporal_load((const f32x4*)(kl + (size_t)(4 * i) * stride));
#pragma unroll
    for (int i = 0; i < 16; ++i) vreg[i] = __builtin_nontemporal_load((const f32x4*)(vl + (size_t)(4 * i) * stride));
    float sc[4];
#pragma unroll
    for (int h = 0; h < 4; ++h) {
        float v[16], w8[8], w4[4], w2[2];
#pragma unroll
        for (int i = 0; i < 16; ++i) v[i] = (kreg[i][0] * q4[h][0] + kreg[i][1] * q4[h][1]) + (kreg[i][2] * q4[h][2] + kreg[i][3] * q4[h][3]);
#pragma unroll
        for (int t = 0; t < 8; ++t) { const float snd = (li & 8) ? v[t] : v[t + 8], kp = (li & 8) ? v[t + 8] : v[t]; w8[t] = kp + __shfl_xor(snd, 8); }
#pragma unroll
        for (int t = 0; t < 4; ++t) { const float snd = (li & 4) ? w8[t] : w8[t + 4], kp = (li & 4) ? w8[t + 4] : w8[t]; w4[t] = kp + __shfl_xor(snd, 4); }
#pragma unroll
        for (int t = 0; t < 2; ++t) { const float snd = (li & 2) ? w4[t] : w4[t + 2], kp = (li & 2) ? w4[t + 2] : w4[t]; w2[t] = kp + __shfl_xor(snd, 2); }
        { const float snd = (li & 1) ? w2[0] : w2[1], kp = (li & 1) ? w2[1] : w2[0]; sc[h] = kp + __shfl_xor(snd, 1); }
        __builtin_amdgcn_sched_barrier(0);
    }
    const bool valid = (4 * li + gq) >= kmin;
#pragma unroll
    for (int h = 0; h < 4; ++h) {
        const float sv = valid ? sc[h] : NEGBIG;
        const float mnew = fmaxf(m[h], wave_max(sv));
        const float alpha = __builtin_amdgcn_exp2f(m[h] - mnew), p = __builtin_amdgcn_exp2f(sv - mnew);
        l[h] = l[h] * alpha + wave_sum(p); o4[h] *= alpha; m[h] = mnew; pout[h] = p;
    }
    const int src0 = lane & 48;
#pragma unroll
    for (int i = 0; i < 16; ++i) {
#pragma unroll
        for (int h = 0; h < 4; ++h) o4[h] += vreg[i] * __shfl(pout[h], src0 + i);
    }
    __builtin_amdgcn_sched_barrier(0);
}
__device__ __forceinline__ void skey(const float* kb, const float* vb, const f32x4 (&q4)[4], float (&m)[4], float (&l)[4], f32x4 (&o4)[4], int lane) {
    const int li = lane & 15, gq = lane >> 4;
    const f32x4 kd = *(const f32x4*)(kb + 4 * li), vd = *(const f32x4*)(vb + 4 * li);
#pragma unroll
    for (int h = 0; h < 4; ++h) {
        float sv = (kd[0] * q4[h][0] + kd[1] * q4[h][1]) + (kd[2] * q4[h][2] + kd[3] * q4[h][3]);
        sv += __shfl_xor(sv, 1); sv += __shfl_xor(sv, 2); sv += __shfl_xor(sv, 4); sv += __shfl_xor(sv, 8);
        const float mnew = fmaxf(m[h], sv), alpha = __builtin_amdgcn_exp2f(m[h] - mnew), p = __builtin_amdgcn_exp2f(sv - mnew);
        l[h] = l[h] * alpha + p; o4[h] *= alpha; if (gq == 0) o4[h] += vd * p; m[h] = mnew;
    }
}

constexpr int S_ST = 0, S_MISC = 8 * 3 * 4 * 66 * 4;
__device__ __forceinline__ void sample_unit(const Params& P, LAS unsigned char* lds, int sb, int g, int tid, int lane, int wave) {
    const bf16_t* ACT = (const bf16_t*)(P.ws + WS_ACT); bf16_t* AB = (bf16_t*)(P.ws + WS_AB);
    LAS float* ST = (LAS float*)(lds + S_ST); LAS float* MISC = (LAS float*)(lds + S_MISC);
    const size_t row = (size_t)MP + sb;
    const int* ptab = (const int*)P.in[8] + sb * 16;
    const int li = lane & 15;
    __syncthreads();
    f32x4 q4[4];
#pragma unroll
    for (int h = 0; h < 4; ++h) { float t4[4]; unpack4(*(const u32x2*)(ACT + row * NIN + LQ + 64 * (4 * g + h) + 4 * li), t4); q4[h] = (f32x4){t4[0], t4[1], t4[2], t4[3]}; }
    float ms[4], ls[4]; f32x4 os[4];
#define S_RESET() do { _Pragma("unroll") for (int h = 0; h < 4; ++h) { ms[h] = MINIT; ls[h] = 0.f; os[h] = (f32x4){0.f, 0.f, 0.f, 0.f}; } } while (0)
#define S_PUBLISH(b2, doit) do { _Pragma("unroll") for (int h = 0; h < 4; ++h) { f32x4 v = os[h]; \
        _Pragma("unroll") for (int e = 0; e < 4; ++e) { float x = v[e]; x += __shfl_xor(x, 16); x += __shfl_xor(x, 32); v[e] = x; } \
        if (doit) { LAS float* st = ST + ((wave * 3 + (b2)) * 4 + h) * 66; if (lane < 16) *(LAS f32x4*)(st + 4 * lane) = v; if (lane == 0) { st[64] = ms[h]; st[65] = ls[h]; } } } } while (0)
    float pdummy[4], pc[4];
    S_RESET();
    { const size_t off = (((size_t)sb * 512 + 64 * wave) * 2 + g) * 64; stile(P.in[6] + off, P.in[7] + off, 128, (wave == 0) ? 1 : 0, q4, ms, ls, os, pdummy, lane); }
    if (wave == 0) { const size_t off = ((size_t)(sb * 512 + 511) * 2 + g) * 64; skey(P.out + O_SKW + off, P.out + O_SVW + off, q4, ms, ls, os, lane); }
    S_PUBLISH(1, true);
    S_RESET();
    stile((const float*)(P.ws + WS_KCS) + (size_t)(sb * 2 + g) * 4096, (const float*)(P.ws + WS_VCS) + (size_t)(sb * 2 + g) * 4096, 64, 0, q4, ms, ls, os, pc, lane);
    float imp = 0.f;
#pragma unroll
    for (int h = 0; h < 4; ++h) { const float pn = pc[h] / ls[h]; imp += pn + __shfl_down(pn, 16); }
    S_PUBLISH(2, wave == 0);
    const int jblk = 2 * li + (lane >> 5);
    const bool cand = ((lane >> 4) & 1) == 0 && jblk >= 1;
    unsigned key = cand ? ((__builtin_bit_cast(unsigned, imp) & 0xffffffe0u) | (unsigned)(31 - jblk)) : 0u;
    unsigned long long selpack = 0ull;
#pragma unroll
    for (int pick = 0; pick < 6; ++pick) {
        unsigned best = key;
#pragma unroll
        for (int o2 = 1; o2 < 64; o2 <<= 1) { const unsigned other = (unsigned)__shfl_xor((int)best, o2); best = other > best ? other : best; }
        const int bj = 31 - (int)(best & 31u);
        selpack |= (unsigned long long)bj << (5 * (pick + 1));
        if (cand && jblk == bj) key = 0u;
    }
    S_RESET();
    if (wave < 7) { const int blk = (int)((selpack >> (5 * wave)) & 31ull); const int page = __builtin_amdgcn_readfirstlane(ptab[blk >> 1]); const size_t off = (((size_t)page * 128 + (blk & 1) * 64) * 2 + g) * 64;
        stile(P.in[4] + off, P.in[5] + off, 128, 0, q4, ms, ls, os, pdummy, lane); }
    else skey(P.out + O_SKS + (size_t)sb * 128 + g * 64, P.out + O_SVS + (size_t)sb * 128 + g * 64, q4, ms, ls, os, lane);
    S_PUBLISH(0, true);
#undef S_RESET
#undef S_PUBLISH
    if (wave == 7) {
        const u32x4 raw = *(const u32x4*)(ACT + row * NIN + LVB + 8 * lane);
        float f[8]; f[0] = bf2f(raw.x); f[1] = bf2f(raw.x >> 16); f[2] = bf2f(raw.y); f[3] = bf2f(raw.y >> 16); f[4] = bf2f(raw.z); f[5] = bf2f(raw.z >> 16); f[6] = bf2f(raw.w); f[7] = bf2f(raw.w >> 16);
        float sm = 0.f;
#pragma unroll
        for (int i = 0; i < 8; ++i) sm += f[i];
        const float mean = wave_sum(sm) * (1.0f / 512.0f); float sq = 0.f;
#pragma unroll
        for (int i = 0; i < 8; ++i) { const float d = f[i] - mean; sq += d * d; }
        const float rstd = rsqrtf(wave_sum(sq) * (1.0f / 512.0f) + 1e-6f);
        if (lane == 0) { MISC[0] = mean; MISC[1] = rstd; }
    }
    __syncthreads();
    if (wave < 4) {
        const int h = wave, head = 4 * g + h;
        const LAS float* stc = ST + ((0 * 3 + 2) * 4 + h) * 66;
        float oa = bf2f(ACT[row * NIN + LNSA + 3 * head + 0]) * stc[lane] / stc[65];
#pragma unroll
        for (int b2 = 0; b2 < 2; ++b2) {
            float M = MINIT;
#pragma unroll
            for (int w = 0; w < 8; ++w) M = fmaxf(M, ST[((w * 3 + b2) * 4 + h) * 66 + 64]);
            float L = 0.f, O = 0.f;
#pragma unroll
            for (int w = 0; w < 8; ++w) { const LAS float* st = ST + ((w * 3 + b2) * 4 + h) * 66; const float f = __builtin_amdgcn_exp2f(st[64] - M); L += st[65] * f; O += st[lane] * f; }
            oa += bf2f(ACT[row * NIN + LNSA + 3 * head + 1 + b2]) * O / L;
        }
        const int col = 64 * head + lane;
        AB[row * DM + col] = (bf16_t)f2bf(oa * bf2f(ACT[row * NIN + LZA + col]));
    }
    if (tid < 256) {
        const int d = 256 * g + tid, gm = d >> 7;
        const float vn = (bf2f(ACT[row * NIN + LVB + d]) - MISC[0]) * MISC[1] * P.in[21][d] + P.in[22][d];
        P.out[O_SVCH + (size_t)sb * 512 + d] = vn;
        const float sv = P.in[23][(size_t)gm * 128 * 128] * vn + P.in[24][gm * 128];
        AB[row * DM + 512 + d] = (bf16_t)f2bf(bf2f(ACT[row * NIN + LU + d]) * sv * bf2f(ACT[row * NIN + LZB + d]));
    }
}

template <int MODE>
__device__ __forceinline__ void small_gemm(const Params& P, int c, int G, int wave, int lane) {
    const int lr = lane & 15, grp = lane >> 4;
    for (int t = c + G * wave; t < 512; t += G * 8) {
        const int rt = t & 7, ct = t >> 3;
        const size_t row = (size_t)MP + 16 * rt + lr;
        const bf16_t* A = (const bf16_t*)(P.ws + (MODE == 0 ? WS_AB : WS_H)) + row * DM + 8 * grp;
        const bf16_t* W = (const bf16_t*)(P.ws + (MODE == 0 ? WS_WTBR : WS_WTOUT)) + (size_t)(16 * ct + lr) * DM + 8 * grp;
        f32x4 acc0 = (f32x4){0.f, 0.f, 0.f, 0.f}, acc1 = (f32x4){0.f, 0.f, 0.f, 0.f};
#pragma unroll 8
        for (int ks = 0; ks < 16; ++ks) acc0 = __builtin_amdgcn_mfma_f32_16x16x32_bf16(*(const bf16x8*)(W + 32 * ks), *(const bf16x8*)(A + 32 * ks), acc0, 0, 0, 0);
#pragma unroll 8
        for (int ks = 16; ks < 32; ++ks) acc1 = __builtin_amdgcn_mfma_f32_16x16x32_bf16(*(const bf16x8*)(W + 32 * ks), *(const bf16x8*)(A + 32 * ks), acc1, 0, 0, 0);
        const int col = 16 * ct + 4 * grp;
        if (MODE == 0) {
            const bf16_t* ACT = (const bf16_t*)(P.ws + WS_ACT);
            float sa[4], sb[4]; unpack4(*(const u32x2*)(ACT + row * NIN + LGA + col), sa); unpack4(*(const u32x2*)(ACT + row * NIN + LGB + col), sb);
            u32x2 w; w.x = cvt_pk_bf16(sa[0] * acc0[0] + sb[0] * acc1[0], sa[1] * acc0[1] + sb[1] * acc1[1]); w.y = cvt_pk_bf16(sa[2] * acc0[2] + sb[2] * acc1[2], sa[3] * acc0[3] + sb[3] * acc1[3]);
            *(u32x2*)((bf16_t*)(P.ws + WS_H) + row * DM + col) = w;
        } else {
            const int sbi = 16 * rt + lr;
            const f32x4 xv = *(const f32x4*)(P.in[1] + (size_t)sbi * DM + col), gv = *(const f32x4*)((const float*)(P.ws + WS_MOD) + (size_t)(8 + sbi) * 3072 + 2048 + col);
            *(f32x4*)(P.out + O_YS + (size_t)sbi * DM + col) = xv + gv * (acc0 + acc1);
        }
    }
}

#define XB_TMO      128
#define XB_XCNT(j)  (256  + 64 * (j))
#define XB_XSUB(j)  (1280 + 64 * (j))
#define XB_XGEN(j)  (2304 + 64 * (j))
#define XB_TOP      3328
#define XB_TOPGEN   3392
#define XCD_BAR_WORDS 3456
#define XB_SPIN_CAP (1u << 18)
__device__ __forceinline__ unsigned xb_ld(unsigned* p)              { return __hip_atomic_load(p, __ATOMIC_RELAXED, __HIP_MEMORY_SCOPE_AGENT); }
__device__ __forceinline__ unsigned xb_add(unsigned* p, unsigned v) { return __hip_atomic_fetch_add(p, v, __ATOMIC_RELAXED, __HIP_MEMORY_SCOPE_AGENT); }
__device__ __forceinline__ unsigned xb_xcc_id() { return (unsigned)__builtin_amdgcn_s_getreg((3 << 11) | 20) & 0xFu; }
#define XB_SPIN(cond, bar) do { unsigned _sp = 0; while (cond) { __builtin_amdgcn_s_sleep(1); \
    if ((++_sp & 255u) == 0u) { if (xb_ld(&(bar)[XB_TMO])) break; if (_sp > XB_SPIN_CAP) { atomicAdd(&(bar)[XB_TMO], 1u); break; } } } } while (0)
struct XcdBarrier { unsigned* bar; unsigned x; volatile LAS unsigned* st; };
__device__ __forceinline__ XcdBarrier xcd_barrier_post(unsigned* bar, volatile LAS unsigned* st) {
    XcdBarrier b; b.bar = bar; b.x = xb_xcc_id(); b.st = st;
    if (threadIdx.x == 0) (void)xb_add(&bar[XB_XCNT(b.x)], 1u);
    return b;
}
__device__ __forceinline__ void xcd_barrier_complete(unsigned* bar, unsigned x, unsigned& nloc, unsigned& nx) {
    const unsigned G = gridDim.x * gridDim.y * gridDim.z;
    unsigned sum, cnt, mine, sp = 0u;
    for (;;) {
        sum = 0u; cnt = 0u; mine = 0u;
#pragma unroll
        for (unsigned j = 0; j < 16; ++j) { const unsigned c = xb_ld(&bar[XB_XCNT(j)]); sum += c; cnt += (c > 0u) ? 1u : 0u; mine = (j == x) ? c : mine; }
        if (sum == G) break;
        __builtin_amdgcn_s_sleep(1);
        if ((++sp & 255u) == 0u) { if (xb_ld(&bar[XB_TMO])) break; if (sp > XB_SPIN_CAP) { atomicAdd(&bar[XB_TMO], 1u); break; } }
    }
    nloc = mine > 0u ? mine : 1u; nx = cnt > 0u ? cnt : 1u;
}
__device__ __forceinline__ void xcd_barrier(const XcdBarrier& b) {
    asm volatile("s_waitcnt vmcnt(0)" ::: "memory");
    __syncthreads();
    if (threadIdx.x == 0) {
        unsigned* bar = b.bar;
        __builtin_amdgcn_s_waitcnt(0);
        unsigned nloc = b.st[0], nx = b.st[1];
        if (nloc == 0u) { xcd_barrier_complete(bar, b.x, nloc, nx); b.st[0] = nloc; b.st[1] = nx; }
        const unsigned old = xb_add(&bar[XB_XSUB(b.x)], 1u);
        const unsigned gen = old / nloc;
        if (old + 1u == (gen + 1u) * nloc) {
            __builtin_amdgcn_fence(__ATOMIC_RELEASE, "agent");
            asm volatile("s_waitcnt vmcnt(0)" ::: "memory");
            const unsigned og = xb_add(&bar[XB_TOP], 1u);
            const unsigned tg = og / nx;
            if (og + 1u == (tg + 1u) * nx) xb_add(&bar[XB_TOPGEN], 1u);
            else XB_SPIN(xb_ld(&bar[XB_TOPGEN]) == tg, bar);
            __builtin_amdgcn_fence(__ATOMIC_ACQUIRE, "agent");
            xb_add(&bar[XB_XGEN(b.x)], 1u);
            asm volatile("s_waitcnt vmcnt(0)" ::: "memory");
        } else {
            XB_SPIN(xb_ld(&bar[XB_XGEN(b.x)]) == gen, bar);
            __builtin_amdgcn_fence(__ATOMIC_ACQUIRE, "agent");
            asm volatile("s_waitcnt vmcnt(0)" ::: "memory");
        }
    }
    __syncthreads();
}

__global__ void __launch_bounds__(512, 2) mk_fwd(Params P) {
    extern __shared__ __attribute__((aligned(16))) unsigned char lds_raw[];
    LAS unsigned char* lds = (LAS unsigned char*)lds_raw;
    const int tid = threadIdx.x, lane = tid & 63, wave = __builtin_amdgcn_readfirstlane(tid >> 6);
    const int G = gridDim.x, c = blockIdx.x, gw = c * 8 + wave, NGW = G * 8, gtid = c * 512 + tid, NT = G * 512;
    cg::grid_group grid = cg::this_grid();
    const int lo = P.ph_lo, hi = P.ph_hi;
    if (tid < 16) ((LAS unsigned*)(lds + LDS_XB))[tid] = 0u;
    __syncthreads();
    const XcdBarrier bar = xcd_barrier_post((unsigned*)(P.ws + WS_CTL), (volatile LAS unsigned*)(lds + LDS_XB));
    if (hi < 0) grid.sync();
#define IN(k) (lo <= (k) && (k) < hi)
#define SEAM(k) do { if (IN(k) && IN((k) + 1)) xcd_barrier(bar); } while (0)
    unsigned char* ws = P.ws;
    if (IN(0)) for (int rep = 0; rep < MK_REP0; ++rep) { p0_prologue(P, lds, gw, NGW, lane, wave, gtid, NT); }
    SEAM(0);
    if (IN(1)) for (int rep = 0; rep < MK_REP1; ++rep) { p1_hrows(P, gw, NGW, lane); }
    SEAM(1);
    if (IN(2)) for (int rep = 0; rep < MK_REP2; ++rep) {
        pg8::Gemm gm{(const bf16_t*)(ws + WS_H), (const bf16_t*)(ws + WS_WTIN), DM, DM, DM};
        pg8::StaticOrder S; S.init(MPAD / 256, NIN / 256, G, c);
        EpiInProj E{(bf16_t*)(ws + WS_ACT), (bf16_t*)(ws + WS_VT), P.out, P.in[15], P.in[16], (const float*)(ws + WS_ROPE)};
        pg8::gemm_phase<EpiInProj, pg8::StaticOrder>(lds, gm, S, E);
    }
    SEAM(2);
    if (IN(3)) for (int rep = 0; rep < MK_REP3; ++rep) { p3_compress(P, lds, gw, NGW, lane, wave); }
    SEAM(3);
    if (IN(4)) for (int rep = 0; rep < MK_REP4; ++rep) {
        asm volatile("" ::: "memory");
        for (int i = 0;; ++i) { const int a = (i & 1) ? (i + 1) * G - 1 - c : i * G + c; if (a >= 512 || a < 0) break; attn_unit(P, lds, a & 7, 63 - (a >> 3), tid, lane, wave); }
        for (int su = c; su < 2 * NSB; su += G) sample_unit(P, lds, su >> 1, su & 1, tid, lane, wave);
        for (int gu = c; gu < 512; gu += G) gmlp_unit(P, lds, gu >> 6, (gu >> 2) & 15, gu & 3, tid, lane, wave);
        __syncthreads();
    }
    SEAM(4);
    if (IN(5)) for (int rep = 0; rep < MK_REP5; ++rep) {
        pg8::Gemm gm{(const bf16_t*)(ws + WS_AB), (const bf16_t*)(ws + WS_WTBR), DM, DM, 512};
        small_gemm<0>(P, c, G, wave, lane);
        pg8::PairOrder S; S.S.init(MP / 256, DM / 256, G, c);
        EpiMix E{(const bf16_t*)(ws + WS_ACT), (bf16_t*)(ws + WS_H)};
        pg8::gemm_phase<EpiMix, pg8::PairOrder>(lds, gm, S, E);
    }
    SEAM(5);
    if (IN(6)) for (int rep = 0; rep < MK_REP6; ++rep) {
        pg8::Gemm gm{(const bf16_t*)(ws + WS_H), (const bf16_t*)(ws + WS_WTOUT), DM, DM, DM};
        small_gemm<1>(P, c, G, wave, lane);
        pg8::StaticOrder S; S.init(MP / 256, DM / 256, G, c);
        EpiOut E{P.in[0], P.in[1], (const float*)(ws + WS_MOD), P.out};
        pg8::gemm_phase<EpiOut, pg8::StaticOrder>(lds, gm, S, E);
    }
#undef IN
#undef SEAM
}

extern "C" void kernel_launch(void* const* d_in, const int* in_sizes, int n_in, void* d_out, int out_size, void* d_ws, size_t ws_size, hipStream_t stream) {
    static int grid = 0;
    if (grid == 0) {
        if (n_in != 28 || out_size != (int)O_END || ws_size < WS_END) { fprintf(stderr, "kernel_launch: unexpected shapes (n_in %d, out %d, ws %zu); nothing launched\n", n_in, out_size, ws_size); grid = -1; return; }
        int dev = 0, cus = 0, per_cu = 0;
        if (hipGetDevice(&dev) != hipSuccess || hipDeviceGetAttribute(&cus, hipDeviceAttributeMultiprocessorCount, dev) != hipSuccess) { grid = -1; return; }
        if (hipFuncSetAttribute((const void*)mk_fwd, hipFuncAttributeMaxDynamicSharedMemorySize, LDS_BYTES) != hipSuccess) { fprintf(stderr, "kernel_launch: hipFuncSetAttribute failed\n"); grid = -1; return; }
        if (hipOccupancyMaxActiveBlocksPerMultiprocessor(&per_cu, (const void*)mk_fwd, 512, LDS_BYTES) != hipSuccess || per_cu < 1) { fprintf(stderr, "kernel_launch: occupancy query failed (%d)\n", per_cu); (void)hipGetLastError(); per_cu = 1; }
        if (per_cu > 1) per_cu = 1;
        grid = cus * per_cu;
    }
    if (grid < 0) return;
    if (hipMemsetAsync((char*)d_ws + WS_CTL, 0, CTL_BYTES, stream) != hipSuccess) { fprintf(stderr, "kernel_launch: hipMemsetAsync failed\n"); return; }
    Params p{};
    for (int i = 0; i < 28; ++i) p.in[i] = (const float*)d_in[i];
    p.out = (float*)d_out; p.ws = (unsigned char*)d_ws;
#if MK_N_LAUNCHES == 1
    p.ph_lo = 0; p.ph_hi = 7;
    void* args[] = {&p};
    hipError_t e = hipLaunchCooperativeKernel((const void*)mk_fwd, dim3(grid), dim3(512), args, LDS_BYTES, stream);
    if (e != hipSuccess) fprintf(stderr, "kernel_launch: cooperative launch failed: %s (grid %d)\n", hipGetErrorString(e), grid);
#else
    for (int ph = 0; ph < 7; ++ph) {
        p.ph_lo = ph; p.ph_hi = ph + 1;
        void* args[] = {&p};
        hipError_t e = hipLaunchCooperativeKernel((const void*)mk_fwd, dim3(grid), dim3(512), args, LDS_BYTES, stream);
        if (e != hipSuccess) { fprintf(stderr, "kernel_launch: launch %d failed: %s (grid %d)\n", ph, hipGetErrorString(e), grid); break; }
    }
#endif
}
```

```cpp
#include <hip/hip_runtime.h>
#include <hip/hip_cooperative_groups.h>
#include <cstdio>
#include <cstdint>
namespace cg = cooperative_groups;

#ifndef MK_N_LAUNCHES
#define MK_N_LAUNCHES 1
#endif
#define MK_REP0 1
#define MK_REP1 1
#define MK_REP2 1
#define MK_REP3 1
#define MK_REP4 1
#define MK_REP5 1
#define MK_REP6 1

#define LAS __attribute__((address_space(3)))
typedef unsigned short bf16_t;
typedef short bf16x8 __attribute__((ext_vector_type(8)));
typedef short bf16x4 __attribute__((ext_vector_type(4)));
typedef float f32x4 __attribute__((ext_vector_type(4)));
typedef float f32x2 __attribute__((ext_vector_type(2)));
typedef unsigned u32x4 __attribute__((ext_vector_type(4)));
typedef unsigned u32x2 __attribute__((ext_vector_type(2)));

constexpr int DM = 1024, SEQ = 2048, NBATCH = 8, MP = NBATCH * SEQ, NSB = 128, MTOT = MP + NSB, MPAD = 16640;
constexpr int NIN = 5632;
constexpr int LQ = 0, LK = 512, LV = 896, LZA = 1280, LU = 1792, LVB = 2304, LZB = 2816, LGA = 3328, LGB = 4352, LNSA = 5376;
constexpr float C2Q = 0.125f * 1.4426950408889634f;
constexpr float NEGBIG = -1e30f, MINIT = -1e29f;
constexpr size_t O_YP = 0, O_YS = 16777216, O_PKC = 16908288, O_PVC = 19005440, O_PKS = 21102592, O_PVS = 23199744, O_PKW = 25296896, O_PVW = 25821184,
                 O_SKC = 26345472, O_SVC = 26361856, O_SKS = 26378240, O_SVS = 26394624, O_SKW = 26411008, O_SVW = 34799616, O_SVCH = 43188224, O_END = 43253760;
constexpr size_t MiB = 1u << 20;
constexpr size_t WS_ROPE = 0, WS_MOD = 1 * MiB, WS_WTIN = 3 * MiB, WS_WTBR = 14 * MiB, WS_WTOUT = 16 * MiB, WS_TRIL = 18 * MiB, WS_KC = 18 * MiB + 512 * 1024, WS_VCT = WS_KC + 128 * 1024,
                 WS_KCS = 19 * MiB, WS_VCS = 23 * MiB, WS_VT = 27 * MiB, WS_H = 40 * MiB, WS_AB = 73 * MiB, WS_ACT = 106 * MiB, WS_END = 285 * MiB;
constexpr size_t WS_CTL = 768 * 1024, CTL_BYTES = 16384;
constexpr int LDS_BYTES = 147456, LDS_XB = LDS_BYTES - 64;

struct Params { const float* in[28]; float* out; unsigned char* ws; int ph_lo, ph_hi; };

__device__ __forceinline__ unsigned f2bf(float f) { unsigned u = __builtin_bit_cast(unsigned, f); return (u + 0x7fffu + ((u >> 16) & 1u)) >> 16; }
__device__ __forceinline__ unsigned pk2(float lo, float hi) { return f2bf(lo) | (f2bf(hi) << 16); }
__device__ __forceinline__ float bf2f(unsigned b) { return __builtin_bit_cast(float, (b & 0xffffu) << 16); }
__device__ __forceinline__ unsigned cvt_pk_bf16(float lo, float hi) { unsigned r; asm volatile("v_cvt_pk_bf16_f32 %0, %1, %2" : "=v"(r) : "v"(lo), "v"(hi)); return r; }
__device__ __forceinline__ float sigmoidf_(float x) { return 1.0f / (1.0f + __expf(-x)); }
__device__ __forceinline__ float wave_sum(float v) {
#pragma unroll
    for (int o = 1; o < 64; o <<= 1) v += __shfl_xor(v, o);
    return v;
}
__device__ __forceinline__ float wave_max(float v) {
#pragma unroll
    for (int o = 1; o < 64; o <<= 1) v = fmaxf(v, __shfl_xor(v, o));
    return v;
}
__device__ __forceinline__ void unpack4(u32x2 w, float (&f)[4]) { f[0] = bf2f(w.x); f[1] = bf2f(w.x >> 16); f[2] = bf2f(w.y); f[3] = bf2f(w.y >> 16); }

namespace pg8 {
constexpr int BM = 256, BK = 64, HALF = 128, HTB = HALF * BK * 2, STAGE_BYTES = 8 * HTB, NXCD = 8, WGM = 8;
__host__ __device__ __forceinline__ int lds_byte(int r, int c) { const int st = (r >> 4) * 2 + (c >> 5), rr = r & 15, cc = c & 31, ob = rr * 64 + cc * 2; return st * 1024 + (ob ^ (((ob >> 9) & 1) << 5)); }
__host__ __device__ __forceinline__ void stage_rc(int b, int& R, int& C) { const int st = b / 1024, sb = b % 1024, swz = sb ^ (((sb >> 9) & 1) << 5); R = (st >> 1) * 16 + swz / 64; C = (st & 1) * 32 + (swz % 64) / 2; }

struct Unit { int pm, pn, kofs, keep; };
struct Gemm { const bf16_t* A; const bf16_t* Bt; int lda, ldb, K; };

struct StaticOrder {
    int nM, nN, nwg, G, c;
    __device__ void init(int nM_, int nN_, int G_, int c_) { nM = nM_; nN = nN_; nwg = nM * nN; G = G_; c = c_; }
    __device__ bool tile(int i, int& pm, int& pn) const {
        const long L = (long)i * G + c; if (L >= nwg) return false;
        int wgid = (int)L; { const int q = nwg / NXCD, r = nwg % NXCD, xcd = wgid % NXCD, off = wgid / NXCD; wgid = (xcd < r ? xcd * (q + 1) : r * (q + 1) + (xcd - r) * q) + off; }
        const int nig = WGM * nN, gid = wgid / nig, fm = gid * WGM, gsz = (nM - fm) < WGM ? (nM - fm) : WGM;
        pm = fm + ((wgid % nig) % gsz); pn = (wgid % nig) / gsz; return true;
    }
    __device__ bool next(int i, Unit& u) const { u.kofs = 0; u.keep = 0; return tile(i, u.pm, u.pn); }
};
struct PairOrder {
    StaticOrder S;
    __device__ bool next(int i, Unit& u) const { u.kofs = (i & 1) * 512; u.keep = (i & 1) ? 0 : 1; return S.tile(i >> 1, u.pm, u.pn); }
};

template <class Epi, class Sched>
__device__ __forceinline__ void gemm_phase(LAS unsigned char* lds, const Gemm g, const Sched& S, const Epi& E) {
    const int tid = threadIdx.x, wid = __builtin_amdgcn_readfirstlane(tid >> 6), lane = tid & 63, wr = wid >> 2, wc = wid & 3, fr = lane & 15, fq = lane >> 4;
    const int nt = g.K / BK;
    unsigned voffA[2], voffB[2];
#pragma unroll
    for (int i = 0; i < 2; ++i) { int R, C; stage_rc(tid * 16 + i * 8192, R, C); voffA[i] = (unsigned)(R * g.lda + C) * 2u; voffB[i] = (unsigned)(R * g.ldb + C) * 2u; }
    const size_t kstep = (size_t)(BK * 2);
    const size_t hstepA = (size_t)HALF * g.lda * 2, hstepB = (size_t)HALF * g.ldb * 2, tstepA = 2 * hstepA, tstepB = 2 * hstepB;
    const unsigned ldsw = (unsigned)wid * 1024u;
    const int aoff = lds_byte(wr * 64 + fr, fq * 8), boff = lds_byte(wc * 32 + fr, fq * 8);
#define PG8_SA(b, h) (((b) * 2 + (h)) * HTB)
#define PG8_SB(b, h) ((4 + (b) * 2 + (h)) * HTB)
#define PG8_STAGE(bufoff, gbase, voff) do { _Pragma("unroll") for (int _i = 0; _i < 2; ++_i) \
        __builtin_amdgcn_global_load_lds((const unsigned*)((const char*)(gbase) + (voff)[_i]), (LAS unsigned*)(lds + (bufoff) + ldsw + _i * 8192), 16, 0, 0); } while (0)
#define PG8_LDA(dst, b, h) do { _Pragma("unroll") for (int m = 0; m < 4; ++m) _Pragma("unroll") for (int k = 0; k < 2; ++k) dst[m][k] = *(const LAS bf16x8*)(lds + PG8_SA(b, h) + aoff + m * 2048 + k * 1024); } while (0)
#define PG8_LDB(dst, b, h) do { _Pragma("unroll") for (int n = 0; n < 2; ++n) _Pragma("unroll") for (int k = 0; k < 2; ++k) dst[n][k] = *(const LAS bf16x8*)(lds + PG8_SB(b, h) + boff + n * 2048 + k * 1024); } while (0)
#define PG8_MMA(ai, bj, At, Bt) do { __builtin_amdgcn_s_setprio(1); _Pragma("unroll") for (int m = 0; m < 4; ++m) _Pragma("unroll") for (int n = 0; n < 2; ++n) _Pragma("unroll") for (int k = 0; k < 2; ++k) \
        acc[ai][bj][m][n] = __builtin_amdgcn_mfma_f32_16x16x32_bf16(Bt[n][k], At[m][k], acc[ai][bj][m][n], 0, 0, 0); __builtin_amdgcn_s_setprio(0); } while (0)
#define PG8_WAIT_V(n) asm volatile("s_waitcnt vmcnt(" #n ")" ::: "memory")
#define PG8_WAIT_L(n) asm volatile("s_waitcnt lgkmcnt(" #n ")" ::: "memory")
#define PG8_BAR __builtin_amdgcn_s_barrier()
#define PG8_SCHED __builtin_amdgcn_sched_barrier(0)
    Unit cur, nxt; int ui = 0;
    if (!S.next(0, cur)) return;
    f32x4 acc[2][2][4][2];
#pragma unroll
    for (int a = 0; a < 2; ++a)
#pragma unroll
        for (int b = 0; b < 2; ++b)
#pragma unroll
            for (int m = 0; m < 4; ++m)
#pragma unroll
                for (int n = 0; n < 2; ++n) acc[a][b][m][n] = (f32x4){0.f, 0.f, 0.f, 0.f};
    bf16x8 At[4][2], B0[2][2], B1[2][2];
    const char* cA = (const char*)g.A + (size_t)cur.pm * tstepA + (size_t)cur.kofs * 2; const char* cB = (const char*)g.Bt + (size_t)cur.pn * tstepB + (size_t)cur.kofs * 2;
    PG8_STAGE(PG8_SB(0, 0), cB, voffB); PG8_STAGE(PG8_SB(0, 1), cB + hstepB, voffB); PG8_STAGE(PG8_SA(0, 0), cA, voffA); PG8_STAGE(PG8_SA(0, 1), cA + hstepA, voffA);
    if (wr == 1) PG8_BAR;
    PG8_WAIT_V(2); PG8_BAR;
    PG8_STAGE(PG8_SB(1, 0), cB + kstep, voffB); PG8_STAGE(PG8_SA(1, 0), cA + kstep, voffA); PG8_STAGE(PG8_SB(1, 1), cB + hstepB + kstep, voffB);
    PG8_WAIT_V(6); PG8_BAR;
    for (;;) {
        const bool has_next = S.next(ui + 1, nxt);
        const char* nA = has_next ? (const char*)g.A + (size_t)nxt.pm * tstepA + (size_t)nxt.kofs * 2 : cA; const char* nB = has_next ? (const char*)g.Bt + (size_t)nxt.pn * tstepB + (size_t)nxt.kofs * 2 : cB;
        for (int t = 0; t < nt; t += 2) {
            const bool last = (t == nt - 2);
            const char* a1 = cA + (size_t)(t + 1) * kstep;
            const char* a2 = last ? nA : cA + (size_t)(t + 2) * kstep; const char* b2 = last ? nB : cB + (size_t)(t + 2) * kstep;
            const char* a3 = a2 + kstep; const char* b3 = b2 + kstep;
            PG8_LDB(B0, 0, 0); PG8_LDB(B1, 0, 1); PG8_SCHED; PG8_LDA(At, 0, 0); PG8_STAGE(PG8_SA(1, 1), a1 + hstepA, voffA);
            PG8_WAIT_V(8); PG8_WAIT_L(0); PG8_BAR; PG8_MMA(0, 0, At, B0); PG8_MMA(0, 1, At, B1); PG8_BAR; PG8_SCHED;
            PG8_LDA(At, 0, 1); PG8_STAGE(PG8_SB(0, 0), b2, voffB); PG8_STAGE(PG8_SB(0, 1), b2 + hstepB, voffB); PG8_STAGE(PG8_SA(0, 0), a2, voffA);
            PG8_WAIT_V(8); PG8_WAIT_L(0); PG8_BAR; PG8_MMA(1, 0, At, B0); PG8_MMA(1, 1, At, B1); PG8_BAR; PG8_SCHED;
            PG8_LDB(B0, 1, 0); PG8_LDB(B1, 1, 1); PG8_SCHED; PG8_LDA(At, 1, 0); PG8_STAGE(PG8_SA(0, 1), a2 + hstepA, voffA);
            PG8_WAIT_V(8); PG8_WAIT_L(0); PG8_BAR; PG8_MMA(0, 0, At, B0); PG8_MMA(0, 1, At, B1); PG8_BAR; PG8_SCHED;
            PG8_LDA(At, 1, 1); PG8_STAGE(PG8_SB(1, 0), b3, voffB); PG8_STAGE(PG8_SB(1, 1), b3 + hstepB, voffB); PG8_STAGE(PG8_SA(1, 0), a3, voffA);
            PG8_WAIT_V(8); PG8_WAIT_L(0); PG8_BAR; PG8_MMA(1, 0, At, B0); PG8_MMA(1, 1, At, B1); PG8_BAR; PG8_SCHED;
        }
        if (wr == 0) PG8_BAR;
        E(acc, cur, wr, wc, fr, fq);
        if (!has_next) break;
        if (!cur.keep) {
#pragma unroll
            for (int a = 0; a < 2; ++a)
#pragma unroll
                for (int b = 0; b < 2; ++b)
#pragma unroll
                    for (int m = 0; m < 4; ++m)
#pragma unroll
                        for (int n = 0; n < 2; ++n) acc[a][b][m][n] = (f32x4){0.f, 0.f, 0.f, 0.f};
        }
        cur = nxt; cA = nA; cB = nB; ++ui;
        if (wr == 1) PG8_BAR;
    }
    PG8_WAIT_V(0);
    PG8_BAR;
#undef PG8_SA
#undef PG8_SB
#undef PG8_STAGE
#undef PG8_LDA
#undef PG8_LDB
#undef PG8_MMA
#undef PG8_WAIT_V
#undef PG8_WAIT_L
#undef PG8_BAR
#undef PG8_SCHED
}
}

struct EpiInProj {
    bf16_t* ACT; bf16_t* VT; float* out; const float* qng; const float* kng; const float* rope;
    __device__ __forceinline__ void operator()(f32x4 (&acc)[2][2][4][2], const pg8::Unit& u, int wr, int wc, int fr, int fq) const {
        const int pn = u.pn;
        int type = 0, slot = 0;
        if (pn < 2) { type = 1; slot = 4 * pn + wc; }
        else if (pn == 2 || (pn == 3 && wc < 2)) { type = 2; slot = 4 * (pn - 2) + wc; }
        else if (pn == 3 || pn == 4) { type = 3; slot = 4 * (pn - 3) + wc - 2; }
        const int rbase = u.pm * 256 + wr * 64 + fr;
        if (type == 1 || type == 2) {
            const float* gn = (type == 1) ? qng : kng;
            f32x4 g4[2][2];
#pragma unroll
            for (int bj = 0; bj < 2; ++bj)
#pragma unroll
                for (int n = 0; n < 2; ++n) g4[bj][n] = *(const f32x4*)(gn + 32 * bj + 16 * n + 4 * fq);
            const int br = slot >> 1, kvh = slot & 1;
#pragma unroll
            for (int ai = 0; ai < 2; ++ai)
#pragma unroll
                for (int m = 0; m < 4; ++m) {
                    const int row = rbase + ai * 128 + m * 16;
                    float ss = 0.f;
#pragma unroll
                    for (int bj = 0; bj < 2; ++bj)
#pragma unroll
                        for (int n = 0; n < 2; ++n) { const f32x4 v = acc[ai][bj][m][n]; ss += (v[0] * v[0] + v[1] * v[1]) + (v[2] * v[2] + v[3] * v[3]); }
                    ss += __shfl_xor(ss, 16); ss += __shfl_xor(ss, 32);
                    const float rinv = rsqrtf(ss * (1.0f / 64.0f) + 1e-6f);
                    const int pos = (row < MP) ? (row & (SEQ - 1)) : SEQ;
                    const bool live = row < MTOT;
                    long obase = -1;
                    if (type == 2 && live) {
                        if (row < MP) {
                            const int t = row & (SEQ - 1), b = row >> 11;
                            if (br == 0) obase = (long)O_PKC + (long)row * 128 + kvh * 64;
                            else if (br == 1) obase = (long)O_PKS + (long)row * 128 + kvh * 64;
                            else if (t >= 1536) obase = (long)O_PKW + ((long)(b * 512 + t - 1536) * 2 + kvh) * 64;
                        } else {
                            const int sb = row - MP;
                            if (br == 0) obase = (long)O_SKC + sb * 128 + kvh * 64;
                            else if (br == 1) obase = (long)O_SKS + sb * 128 + kvh * 64;
                            else obase = (long)O_SKW + ((long)(sb * 512 + 511) * 2 + kvh) * 64;
                        }
                    }
#pragma unroll
                    for (int n = 0; n < 2; ++n) {
                        const f32x4 cs0 = *(const f32x4*)(rope + ((size_t)pos * 32 + 16 * n + 4 * fq) * 2);
                        const f32x4 cs1 = *(const f32x4*)(rope + ((size_t)pos * 32 + 16 * n + 4 * fq) * 2 + 4);
                        const float cc[4] = {cs0[0], cs0[2], cs1[0], cs1[2]}, sn[4] = {cs0[1], cs0[3], cs1[1], cs1[3]};
                        f32x4 o0, o1;
#pragma unroll
                        for (int j = 0; j < 4; ++j) {
                            const float y0 = acc[ai][0][m][n][j] * rinv * g4[0][n][j], y1 = acc[ai][1][m][n][j] * rinv * g4[1][n][j];
                            o0[j] = y0 * cc[j] - y1 * sn[j]; o1[j] = y1 * cc[j] + y0 * sn[j];
                        }
                        if (live) {
                            const int dcol = 16 * n + 4 * fq;
                            if (type == 1) {
                                bf16_t* p = ACT + (size_t)row * NIN + LQ + 64 * slot + dcol;
                                u32x2 w0, w1; w0.x = cvt_pk_bf16(o0[0] * C2Q, o0[1] * C2Q); w0.y = cvt_pk_bf16(o0[2] * C2Q, o0[3] * C2Q); w1.x = cvt_pk_bf16(o1[0] * C2Q, o1[1] * C2Q); w1.y = cvt_pk_bf16(o1[2] * C2Q, o1[3] * C2Q);
                                *(u32x2*)p = w0; *(u32x2*)(p + 32) = w1;
                            } else {
                                bf16_t* p = ACT + (size_t)row * NIN + LK + 64 * slot + dcol;
                                u32x2 w0, w1; w0.x = cvt_pk_bf16(o0[0], o0[1]); w0.y = cvt_pk_bf16(o0[2], o0[3]); w1.x = cvt_pk_bf16(o1[0], o1[1]); w1.y = cvt_pk_bf16(o1[2], o1[3]);
                                *(u32x2*)p = w0; *(u32x2*)(p + 32) = w1;
                                if (obase >= 0) { *(f32x4*)(out + obase + dcol) = o0; *(f32x4*)(out + obase + 32 + dcol) = o1; }
                            }
                        }
                    }
                }
        } else if (type == 3) {
            const int br = slot >> 1, kvh = slot & 1;
#pragma unroll
            for (int ai = 0; ai < 2; ++ai)
#pragma unroll
                for (int m = 0; m < 4; ++m) {
                    const int row = rbase + ai * 128 + m * 16;
                    if (row < MTOT) {
                        long obase = -1;
                        if (row < MP) {
                            const int t = row & (SEQ - 1), b = row >> 11;
                            if (br == 0) obase = (long)O_PVC + (long)row * 128 + kvh * 64;
                            else if (br == 1) obase = (long)O_PVS + (long)row * 128 + kvh * 64;
                            else if (t >= 1536) obase = (long)O_PVW + ((long)(b * 512 + t - 1536) * 2 + kvh) * 64;
                            bf16_t* vt = VT + ((size_t)(b * 6 + slot) * 64) * SEQ + t;
#pragma unroll
                            for (int bj = 0; bj < 2; ++bj)
#pragma unroll
                                for (int n = 0; n < 2; ++n)
#pragma unroll
                                    for (int j = 0; j < 4; ++j) vt[(size_t)(32 * bj + 16 * n + 4 * fq + j) * SEQ] = (bf16_t)f2bf(acc[ai][bj][m][n][j]);
                        } else {
                            const int sb = row - MP;
                            if (br == 0) obase = (long)O_SVC + sb * 128 + kvh * 64;
                            else if (br == 1) obase = (long)O_SVS + sb * 128 + kvh * 64;
                            else obase = (long)O_SVW + ((long)(sb * 512 + 511) * 2 + kvh) * 64;
                        }
                        if (obase >= 0) {
#pragma unroll
                            for (int bj = 0; bj < 2; ++bj)
#pragma unroll
                                for (int n = 0; n < 2; ++n) *(f32x4*)(out + obase + 32 * bj + 16 * n + 4 * fq) = acc[ai][bj][m][n];
                        }
                    }
                }
        } else {
            const int mode = (pn <= 6) ? 1 : (pn <= 10) ? 0 : (pn <= 12) ? 1 : 2;
#pragma unroll
            for (int ai = 0; ai < 2; ++ai)
#pragma unroll
                for (int m = 0; m < 4; ++m) {
                    const int row = rbase + ai * 128 + m * 16;
                    if (row < MTOT) {
                        bf16_t* p = ACT + (size_t)row * NIN + 256 * pn + 64 * wc + 4 * fq;
#pragma unroll
                        for (int bj = 0; bj < 2; ++bj)
#pragma unroll
                            for (int n = 0; n < 2; ++n) {
                                f32x4 v = acc[ai][bj][m][n];
#pragma unroll
                                for (int j = 0; j < 4; ++j) { const float sg = sigmoidf_(v[j]); v[j] = (mode == 0) ? v[j] : (mode == 1) ? v[j] * sg : sg; }
                                u32x2 w; w.x = cvt_pk_bf16(v[0], v[1]); w.y = cvt_pk_bf16(v[2], v[3]);
                                *(u32x2*)(p + 32 * bj + 16 * n) = w;
                            }
                    }
                }
        }
    }
};

struct EpiMix {
    const bf16_t* ACT; bf16_t* M;
    __device__ __forceinline__ void operator()(f32x4 (&acc)[2][2][4][2], const pg8::Unit& u, int wr, int wc, int fr, int fq) const {
        const int rbase = u.pm * 256 + wr * 64 + fr, cbase = u.pn * 256 + wc * 32 + 4 * fq;
#pragma unroll
        for (int ai = 0; ai < 2; ++ai)
#pragma unroll
            for (int m = 0; m < 4; ++m) {
                const int row = rbase + ai * 128 + m * 16;
                const bool live = row < MTOT;
                const int rr = live ? row : 0;
#pragma unroll
                for (int bj = 0; bj < 2; ++bj)
#pragma unroll
                    for (int n = 0; n < 2; ++n) {
                        const int col = cbase + 128 * bj + 16 * n;
                        float sb[4]; unpack4(*(const u32x2*)(ACT + (size_t)rr * NIN + LGB + col), sb);
                        if (u.keep) {
                            float sa[4]; unpack4(*(const u32x2*)(ACT + (size_t)rr * NIN + LGA + col), sa);
#pragma unroll
                            for (int j = 0; j < 4; ++j) acc[ai][bj][m][n][j] *= sa[j] * __builtin_amdgcn_rcpf(sb[j]);
                        } else if (live) {
                            const f32x4 v = acc[ai][bj][m][n];
                            u32x2 w; w.x = cvt_pk_bf16(v[0] * sb[0], v[1] * sb[1]); w.y = cvt_pk_bf16(v[2] * sb[2], v[3] * sb[3]);
                            *(u32x2*)(M + (size_t)row * DM + col) = w;
                        }
                    }
            }
    }
};

struct EpiOut {
    const float* xp; const float* xs; const float* MOD; float* out;
    __device__ __forceinline__ void operator()(f32x4 (&acc)[2][2][4][2], const pg8::Unit& u, int wr, int wc, int fr, int fq) const {
        const int rbase = u.pm * 256 + wr * 64 + fr, cbase = u.pn * 256 + wc * 32 + 4 * fq;
#pragma unroll
        for (int ai = 0; ai < 2; ++ai)
#pragma unroll
            for (int m = 0; m < 4; ++m) {
                const int row = rbase + ai * 128 + m * 16;
                if (row < MTOT) {
                    const float* xr; const float* gr; float* orow;
                    if (row < MP) { xr = xp + (size_t)row * DM; gr = MOD + (size_t)(row >> 11) * 3072 + 2048; orow = out + O_YP + (size_t)row * DM; }
                    else { const int sb = row - MP; xr = xs + (size_t)sb * DM; gr = MOD + (size_t)(8 + sb) * 3072 + 2048; orow = out + O_YS + (size_t)sb * DM; }
#pragma unroll
                    for (int bj = 0; bj < 2; ++bj)
#pragma unroll
                        for (int n = 0; n < 2; ++n) {
                            const int col = cbase + 128 * bj + 16 * n;
                            const f32x4 xv = *(const f32x4*)(xr + col), gv = *(const f32x4*)(gr + col);
                            *(f32x4*)(orow + col) = xv + gv * acc[ai][bj][m][n];
                        }
                }
            }
    }
};

__device__ __forceinline__ void transpose_item(const float* src, int src_ld, int nvalid, bf16_t* dst, int dst_ld, LAS float* scr, int lane) {
    float tv[32];
#pragma unroll
    for (int i = 0; i < 32; ++i) { const int kk = 2 * i + (lane >> 5), cc = lane & 31; tv[i] = src[(size_t)kk * src_ld + (cc < nvalid ? cc : 0)]; }
#pragma unroll
    for (int i = 0; i < 32; ++i) { const int kk = 2 * i + (lane >> 5), cc = lane & 31; scr[kk * 33 + cc] = (cc < nvalid) ? tv[i] : 0.f; }
    asm volatile("s_waitcnt lgkmcnt(0)" ::: "memory");
    const int c = lane & 7;
#pragma unroll
    for (int j = 0; j < 4; ++j) { const int n = (lane >> 3) + 8 * j; const LAS float* s = scr + (8 * c) * 33 + n;
        u32x4 o; o.x = pk2(s[0 * 33], s[1 * 33]); o.y = pk2(s[2 * 33], s[3 * 33]); o.z = pk2(s[4 * 33], s[5 * 33]); o.w = pk2(s[6 * 33], s[7 * 33]);
        *(u32x4*)(dst + (size_t)n * dst_ld + 8 * c) = o; }
    asm volatile("s_waitcnt lgkmcnt(0)" ::: "memory");
}

__device__ __forceinline__ void p0_prologue(const Params& P, LAS unsigned char* lds, int gw, int NGW, int lane_p, int wave, int gtid, int NT) {
    unsigned char* ws = P.ws;
    LAS float* scr = (LAS float*)(lds + wave * 16384);
    constexpr int I_MOD = 9 * 48, I_WIN = 16 * 176, I_WBR = 16 * 32, I_WOUT = 16 * 32, I_POOL = NSB * 16 * 2;
    constexpr int I_TOTAL = I_MOD + I_WIN + I_WBR + I_WOUT + I_POOL;
    constexpr int I_TR = I_WIN + I_WBR + I_WOUT;
    const bool modw = gw < I_MOD; const int NO = NGW - I_MOD, io = gw - I_MOD;
    for (int stp = 0;; ++stp) {
        int it;
        if (NGW < 2 * I_MOD) { it = gw + stp * NGW; if (it >= I_TOTAL) break; }
        else if (modw) { if (stp == 0) it = gw; else if (stp == 1) it = I_MOD + I_TR + gw; else break; }
        else { const int r = io + stp * NO; if (r >= I_TR + (I_POOL - I_MOD)) break; it = (r < I_TR) ? I_MOD + r : I_MOD + I_TR + I_MOD + (r - I_TR); }
        int lane = lane_p; asm volatile("" : "+v"(lane));
        if (it < I_MOD) {
            const int mt = it / 48, ng = it % 48, lr = lane & 15, kq = lane >> 4;
            int arow_i = 16 * mt + lr; if (arow_i > 135) arow_i = 135;
            const float* arow = ((arow_i < 8) ? P.in[9] + (size_t)arow_i * DM : P.in[10] + (size_t)(arow_i - 8) * DM) + 4 * kq;
            const float* bp = P.in[11] + (size_t)(4 * kq) * 3072 + 64 * ng + 4 * lr;
            f32x4 macc[4];
#pragma unroll
            for (int nt = 0; nt < 4; ++nt) macc[nt] = (f32x4){0.f, 0.f, 0.f, 0.f};
            f32x4 a0[4], b0[16], a1[4], b1[16];
#define MOD_LOAD(A_, B_, k0) do { _Pragma("unroll") for (int j = 0; j < 4; ++j) { A_[j] = *(const f32x4*)(arow + (k0) + 16 * j); \
                _Pragma("unroll") for (int e = 0; e < 4; ++e) B_[4 * j + e] = *(const f32x4*)(bp + (size_t)((k0) + 16 * j + e) * 3072); } } while (0)
#define MOD_MMA(A_, B_) do { _Pragma("unroll") for (int j = 0; j < 4; ++j) _Pragma("unroll") for (int e = 0; e < 4; ++e) _Pragma("unroll") for (int nt = 0; nt < 4; ++nt) \
                macc[nt] = __builtin_amdgcn_mfma_f32_16x16x4f32(A_[j][e], B_[4 * j + e][nt], macc[nt], 0, 0, 0); } while (0)
            MOD_LOAD(a0, b0, 0);
            for (int k0 = 0; k0 < DM; k0 += 128) {
                MOD_LOAD(a1, b1, k0 + 64);
                __builtin_amdgcn_sched_barrier(0);
                MOD_MMA(a0, b0);
                __builtin_amdgcn_sched_barrier(0);
                if (k0 + 128 < DM) MOD_LOAD(a0, b0, k0 + 128);
                __builtin_amdgcn_sched_barrier(0);
                MOD_MMA(a1, b1);
                __builtin_amdgcn_sched_barrier(0);
            }
#undef MOD_LOAD
#undef MOD_MMA
            float* MOD = (float*)(ws + WS_MOD);
            const f32x4 bb = *(const f32x4*)(P.in[12] + 64 * ng + 4 * lr);
#pragma unroll
            for (int r = 0; r < 4; ++r) { const int row = 16 * mt + 4 * kq + r;
                if (row < 136) *(f32x4*)(MOD + (size_t)row * 3072 + 64 * ng + 4 * lr) = (f32x4){macc[0][r] + bb[0], macc[1][r] + bb[1], macc[2][r] + bb[2], macc[3][r] + bb[3]}; }
            continue;
        }
        it -= I_MOD;
        if (it < I_WIN) {
            const int kb = it / 176, nb = it % 176;
            const int pn = nb >> 3, bj = (nb >> 2) & 1, wc = nb & 3;
            const int L0 = 256 * pn + 64 * wc + 32 * bj;
            int srcc, nvalid;
            if (L0 < 1280) { srcc = L0; nvalid = 32; } else if (L0 < LNSA) { srcc = L0 + 24; nvalid = 32; } else if (L0 == LNSA) { srcc = 1280; nvalid = 24; } else { srcc = 0; nvalid = 0; }
            transpose_item(P.in[14] + (size_t)(64 * kb) * 5400 + srcc, 5400, nvalid, (bf16_t*)(ws + WS_WTIN) + (size_t)(32 * nb) * DM + 64 * kb, DM, scr, lane);
            continue;
        }
        it -= I_WIN;
        if (it < I_WBR) {
            const int kb = it / 32, nb = it % 32;
            const float* src = (kb < 8) ? P.in[25] + (size_t)(64 * kb) * DM : P.in[26] + (size_t)(64 * (kb - 8)) * DM;
            transpose_item(src + 32 * nb, DM, 32, (bf16_t*)(ws + WS_WTBR) + (size_t)(32 * nb) * DM + 64 * kb, DM, scr, lane);
            continue;
        }
        it -= I_WBR;
        if (it < I_WOUT) {
            const int kb = it / 32, nb = it % 32;
            transpose_item(P.in[27] + (size_t)(64 * kb) * DM + 32 * nb, DM, 32, (bf16_t*)(ws + WS_WTOUT) + (size_t)(32 * nb) * DM + 64 * kb, DM, scr, lane);
            continue;
        }
        it -= I_WOUT;
        {
            const int sb = it >> 5, pg = (it >> 1) & 15, which = it & 1;
            const int page = ((const int*)P.in[8])[sb * 16 + pg];
            const float* src = P.in[2 + which] + (size_t)page * 128 * 128;
            const float* pe = P.in[17 + which]; const float* w = P.in[19 + which];
            const int d0 = (2 * lane) & 63;
            float p0 = 0.f, p1 = 0.f;
#pragma unroll 8
            for (int r = 0; r < 32; ++r) { const f32x2 v = *(const f32x2*)(pe + r * 64 + d0); p0 += v[0]; p1 += v[1]; }
#pragma unroll
            for (int cb = 0; cb < 4; ++cb) {
                f32x2 v[32];
#pragma unroll
                for (int r = 0; r < 32; ++r) v[r] = __builtin_nontemporal_load((const f32x2*)(src + (size_t)(cb * 32 + r) * 128 + 2 * lane));
                float s0 = 0.f, s1 = 0.f;
#pragma unroll
                for (int r = 0; r < 32; ++r) { s0 += v[r][0]; s1 += v[r][1]; }
                scr[d0 * 8 + cb * 2 + (lane >> 5)] = (s0 + p0) * (1.0f / 32.0f); scr[(d0 + 1) * 8 + cb * 2 + (lane >> 5)] = (s1 + p1) * (1.0f / 32.0f);
            }
            asm volatile("s_waitcnt lgkmcnt(0)" ::: "memory");
            float a[8];
#pragma unroll
            for (int q = 0; q < 8; ++q) a[q] = 0.f;
#pragma unroll 8
            for (int d = 0; d < 64; ++d) { const float wv = w[d * 64 + lane]; const f32x4 pa = *(const LAS f32x4*)(scr + d * 8), pb = *(const LAS f32x4*)(scr + d * 8 + 4);
                a[0] += pa[0] * wv; a[1] += pa[1] * wv; a[2] += pa[2] * wv; a[3] += pa[3] * wv; a[4] += pb[0] * wv; a[5] += pb[1] * wv; a[6] += pb[2] * wv; a[7] += pb[3] * wv; }
            float* dst = (float*)(ws + (which ? WS_VCS : WS_KCS));
#pragma unroll
            for (int q = 0; q < 8; ++q) dst[((size_t)(sb * 2 + (q & 1)) * 64 + 4 * pg + (q >> 1)) * 64 + lane] = a[q];
            asm volatile("s_waitcnt lgkmcnt(0)" ::: "memory");
        }
    }
    float* rope = (float*)(ws + WS_ROPE);
    for (int i = gtid; i < 2049 * 32; i += NT) {
        const int pos = i >> 5, k = i & 31;
        double invd = 1.0;
        for (int q = 0; q < k; ++q) invd *= 0.7498942093324559;
        const float ang = (float)pos * (float)invd;
        const double rev = (double)ang * 0.15915494309189535;
        const float fr = (float)(rev - __builtin_rint(rev));
        rope[2 * i] = __builtin_amdgcn_cosf(fr); rope[2 * i + 1] = __builtin_amdgcn_sinf(fr);
    }
    bf16_t* tril = (bf16_t*)(ws + WS_TRIL);
    for (int i = gtid; i < 4 * 128 * 128; i += NT) { const int r = (i >> 7) & 127, cidx = i & 127; tril[i] = (cidx <= r) ? (bf16_t)f2bf(P.in[23][i]) : (bf16_t)0; }
    for (int tk = blockIdx.x; tk < 2 * NSB * 2; tk += gridDim.x) {
        const int w2 = tk >> 8, sb = (tk >> 1) & 127, half = tk & 1;
        const f32x4* src = (const f32x4*)P.in[6 + w2] + (size_t)sb * 512 * 32 + 32 + half * 8176; f32x4* dst = (f32x4*)(P.out + (w2 ? O_SVW : O_SKW)) + (size_t)sb * 512 * 32 + half * 8176;
        f32x4 cv[16];
#pragma unroll
        for (int u = 0; u < 16; ++u) { const int i = threadIdx.x + 512 * u; if (i < 8176) cv[u] = __builtin_nontemporal_load(src + i); }
#pragma unroll
        for (int u = 0; u < 16; ++u) { const int i = threadIdx.x + 512 * u; if (i < 8176) __builtin_nontemporal_store(cv[u], dst + i); }
    }
}

__device__ __forceinline__ void p1_hrows(const Params& P, int gw, int NGW, int lane) {
    const float* MOD = (const float*)(P.ws + WS_MOD); bf16_t* H = (bf16_t*)(P.ws + WS_H); const float* ng = P.in[13];
    for (int row = gw; row < MPAD; row += NGW) {
        unsigned long long* o8 = (unsigned long long*)(H + (size_t)row * DM) + lane;
        if (row >= MTOT) {
#pragma unroll
            for (int j = 0; j < 4; ++j) o8[64 * j] = 0ull;
            continue; }
        const float* xr; const float* md;
        if (row < MP) { xr = P.in[0] + (size_t)row * DM; md = MOD + (size_t)(row >> 11) * 3072; } else { xr = P.in[1] + (size_t)(row - MP) * DM; md = MOD + (size_t)(8 + row - MP) * 3072; }
        f32x4 v[4]; float s = 0.f;
#pragma unroll
        for (int j = 0; j < 4; ++j) { v[j] = ((const f32x4*)xr)[lane + 64 * j]; s += (v[j][0] * v[j][0] + v[j][1] * v[j][1]) + (v[j][2] * v[j][2] + v[j][3] * v[j][3]); }
        const float rstd = rsqrtf(wave_sum(s) * (1.0f / DM) + 1e-6f);
#pragma unroll
        for (int j = 0; j < 4; ++j) {
            const int col = 4 * lane + 256 * j;
            const f32x4 g = *(const f32x4*)(ng + col), sh = *(const f32x4*)(md + col), sc = *(const f32x4*)(md + 1024 + col);
            const f32x4 h = (v[j] * rstd) * g * (sc + 1.0f) + sh;
            o8[64 * j] = (unsigned long long)pk2(h[0], h[1]) | ((unsigned long long)pk2(h[2], h[3]) << 32);
        }
    }
}

__device__ __forceinline__ void p3_compress(const Params& P, LAS unsigned char* lds, int gw, int NGW, int lane, int wave) {
    LAS float* scr = (LAS float*)(lds + wave * 1024);
    for (int it = gw; it < NBATCH * 64 * 2 * 2; it += NGW) {
        const int b = it >> 8, c = (it >> 2) & 63, kvh = (it >> 1) & 1, which = it & 1;
        const float* src = P.out + (which ? O_PVC : O_PKC) + ((size_t)(b * SEQ + 32 * c) * 2 + kvh) * 64;
        const float* pe = P.in[17 + which]; const float* w = P.in[19 + which];
        float s = 0.f;
#pragma unroll 8
        for (int r = 0; r < 32; ++r) s += src[(size_t)r * 128 + lane] + pe[r * 64 + lane];
        scr[lane] = s * (1.0f / 32.0f);
        asm volatile("s_waitcnt lgkmcnt(0)" ::: "memory");
        float a = 0.f;
#pragma unroll 8
        for (int d = 0; d < 64; ++d) a += scr[d] * w[d * 64 + lane];
        if (which == 0) ((bf16_t*)(P.ws + WS_KC))[((size_t)(b * 64 + c) * 2 + kvh) * 64 + lane] = (bf16_t)f2bf(a);
        else ((bf16_t*)(P.ws + WS_VCT))[((size_t)(b * 2 + kvh) * 64 + lane) * 64 + c] = (bf16_t)f2bf(a);
        asm volatile("s_waitcnt lgkmcnt(0)" ::: "memory");
    }
}

constexpr int A_TILE = 32768, A_IMP = 3 * A_TILE, A_IMPS = A_IMP + 8 * 32 * 33 * 4, A_SEL = A_IMPS + 2 * 32 * 33 * 4;
static_assert(A_SEL + 256 <= LDS_XB, "attention LDS map");
#define ATT_BAR() do { asm volatile("s_waitcnt lgkmcnt(0)" ::: "memory"); __builtin_amdgcn_s_barrier(); asm volatile("" ::: "memory"); } while (0)

struct TileSrc { const bf16_t* kb; const bf16_t* v0; const bf16_t* v1; unsigned kpitch, vpitch; };
__device__ __forceinline__ TileSrc attn_tile_src(const Params& P, int b, int T, int n_slc, int lo) {
    TileSrc s;
    if (T == 0) { s.kb = (const bf16_t*)(P.ws + WS_KC) + (size_t)b * 64 * 128; s.v0 = (const bf16_t*)(P.ws + WS_VCT) + (size_t)(b * 2) * 4096; s.v1 = s.v0 + 4096; s.kpitch = 128; s.vpitch = 64; }
    else {
        const bool slc = T <= n_slc; const int j = slc ? T - 1 : lo + (T - 1 - n_slc), br = slc ? 1 : 2;
        s.kb = (const bf16_t*)(P.ws + WS_ACT) + ((size_t)b * SEQ + 64 * j) * NIN + LK + 128 * br;
        s.v0 = (const bf16_t*)(P.ws + WS_VT) + ((size_t)(b * 6 + 2 * br) * 64) * SEQ + 64 * j; s.v1 = s.v0 + (size_t)64 * SEQ; s.kpitch = NIN; s.vpitch = SEQ;
    }
    return s;
}
__device__ __forceinline__ void attn_dma(LAS unsigned char* buf, const TileSrc& s, int wave, int lane_in) {
    int lane = lane_in; asm volatile("" : "+v"(lane));
    const int r = 8 * wave + (lane >> 3), ch = (lane & 7) ^ (lane >> 3);
#pragma unroll
    for (int i = 0; i < 2; ++i) {
        __builtin_amdgcn_global_load_lds((const unsigned*)(s.kb + (size_t)r * s.kpitch + i * 64 + ch * 8), (LAS unsigned*)(buf + (wave + 8 * i) * 1024), 16, 0, 0);
        __builtin_amdgcn_global_load_lds((const unsigned*)((i ? s.v1 : s.v0) + (size_t)r * s.vpitch + ch * 8), (LAS unsigned*)(buf + 16384 + (wave + 8 * i) * 1024), 16, 0, 0);
    }
}

constexpr float ATT_M0 = -30.f, ATT_THR = 12.f;
template <int MODE>
__device__ __forceinline__ void attn_tile(const LAS unsigned char* Kg, const LAS unsigned char* Vg, const bf16x8 (&qf)[2][2], f32x4 (&O)[4][2], float (&mrun)[2], float (&lrun)[2], f32x4 (&s)[2][4],
                                          int lane_in, int kbase, const int (&qpos)[2], const float (&cinit)[2], bool emask) {
    int lane = lane_in; asm volatile("" : "+v"(lane));
    const int lr = lane & 15, grp = lane >> 4, sw = lr & 7;
    const float c0[2] = {cinit[0] - mrun[0], cinit[1] - mrun[1]};
#pragma unroll
    for (int kt = 0; kt < 4; ++kt) {
        const bf16x8 k0 = *(const LAS bf16x8*)(Kg + (16 * kt + lr) * 128 + ((grp ^ sw) << 4));
        const bf16x8 k1 = *(const LAS bf16x8*)(Kg + (16 * kt + lr) * 128 + (((4 + grp) ^ sw) << 4));
#pragma unroll
        for (int qt = 0; qt < 2; ++qt) {
            const f32x4 a = __builtin_amdgcn_mfma_f32_16x16x32_bf16(k0, qf[qt][0], (f32x4){c0[qt], c0[qt], c0[qt], c0[qt]}, 0, 0, 0);
            s[qt][kt] = __builtin_amdgcn_mfma_f32_16x16x32_bf16(k1, qf[qt][1], a, 0, 0, 0);
        }
    }
    bf16x8 vf[2][4];
#pragma unroll
    for (int c2 = 0; c2 < 2; ++c2)
#pragma unroll
        for (int dt = 0; dt < 4; ++dt) {
            const LAS unsigned char* vr = Vg + (16 * dt + lr) * 128 + 8 * (grp & 1);
            const u32x2 lo = *(const LAS u32x2*)(vr + (((4 * c2 + (grp >> 1)) ^ sw) << 4));
            const u32x2 hi = *(const LAS u32x2*)(vr + (((4 * c2 + 2 + (grp >> 1)) ^ sw) << 4));
            const u32x4 vv = {lo.x, lo.y, hi.x, hi.y};
            vf[c2][dt] = __builtin_bit_cast(bf16x8, vv);
        }
    if (emask) {
#pragma unroll
        for (int qt = 0; qt < 2; ++qt)
#pragma unroll
            for (int kt = 0; kt < 4; ++kt)
#pragma unroll
                for (int r = 0; r < 4; ++r) {
                    const int key = 16 * kt + 4 * grp + r;
                    bool valid;
                    if (MODE == 0) valid = key < ((qpos[qt] + 1) >> 5);
                    else if (MODE == 1) valid = (kbase + key <= qpos[qt]);
                    else { const int kp = kbase + key; valid = (kp <= qpos[qt]) && (kp > qpos[qt] - 512); }
                    s[qt][kt][r] = valid ? s[qt][kt][r] : NEGBIG;
                }
    }
    float mx[2];
#pragma unroll
    for (int qt = 0; qt < 2; ++qt) {
        float m0 = fmaxf(fmaxf(s[qt][0][0], s[qt][0][1]), fmaxf(s[qt][0][2], s[qt][0][3]));
#pragma unroll
        for (int kt = 1; kt < 4; ++kt) m0 = fmaxf(m0, fmaxf(fmaxf(s[qt][kt][0], s[qt][kt][1]), fmaxf(s[qt][kt][2], s[qt][kt][3])));
        m0 = fmaxf(m0, __shfl_xor(m0, 16)); mx[qt] = fmaxf(m0, __shfl_xor(m0, 32));
    }
    if (__any((int)(fmaxf(mx[0], mx[1]) > ATT_THR))) {
#pragma unroll
        for (int qt = 0; qt < 2; ++qt) {
            const float delta = fmaxf(mx[qt], 0.f), f = __builtin_amdgcn_exp2f(-delta);
            mrun[qt] += delta; lrun[qt] *= f;
#pragma unroll
            for (int dt = 0; dt < 4; ++dt) O[dt][qt] *= f;
#pragma unroll
            for (int kt = 0; kt < 4; ++kt) s[qt][kt] -= delta;
        }
    }
#pragma unroll
    for (int qt = 0; qt < 2; ++qt) {
        float ls = 0.f;
#pragma unroll
        for (int kt = 0; kt < 4; ++kt)
#pragma unroll
            for (int r = 0; r < 4; ++r) { const float p = __builtin_amdgcn_exp2f(s[qt][kt][r]); s[qt][kt][r] = p; ls += p; }
        lrun[qt] += ls;
#pragma unroll
        for (int c2 = 0; c2 < 2; ++c2) {
            u32x4 w; w.x = cvt_pk_bf16(s[qt][2 * c2][0], s[qt][2 * c2][1]); w.y = cvt_pk_bf16(s[qt][2 * c2][2], s[qt][2 * c2][3]);
            w.z = cvt_pk_bf16(s[qt][2 * c2 + 1][0], s[qt][2 * c2 + 1][1]); w.w = cvt_pk_bf16(s[qt][2 * c2 + 1][2], s[qt][2 * c2 + 1][3]);
            const bf16x8 pf = __builtin_bit_cast(bf16x8, w);
#pragma unroll
            for (int dt = 0; dt < 4; ++dt) O[dt][qt] = __builtin_amdgcn_mfma_f32_16x16x32_bf16(vf[c2][dt], pf, O[dt][qt], 0, 0, 0);
        }
    }
}

__device__ __forceinline__ void attn_unit(const Params& P, LAS unsigned char* lds, int b, int qb32, int tid, int lane, int wave) {
    asm volatile("" : "+v"(tid), "+v"(lane));
    const bf16_t* ACT = (const bf16_t*)(P.ws + WS_ACT); bf16_t* AB = (bf16_t*)(P.ws + WS_AB);
    const int lr = lane & 15, grp = lane >> 4, g = wave >> 2;
    const int t0 = 32 * qb32, qblk = t0 >> 6; const size_t row0 = (size_t)b * SEQ + t0;
    const int n_slc = qblk + 1, lo = (t0 - 511 > 0) ? ((t0 - 511) >> 6) : 0, NT = 1 + n_slc + (qblk - lo + 1);
    LAS float* IMP = (LAS float*)(lds + A_IMP); LAS float* IMPS = (LAS float*)(lds + A_IMPS); LAS unsigned* SEL = (LAS unsigned*)(lds + A_SEL);
    bf16x8 qf[2][2]; int qpos[2]; float gate[2][3];
#pragma unroll
    for (int qt = 0; qt < 2; ++qt) {
        const size_t row = row0 + 16 * qt + lr; qpos[qt] = t0 + 16 * qt + lr;
#pragma unroll
        for (int ks = 0; ks < 2; ++ks) qf[qt][ks] = *(const bf16x8*)(ACT + row * NIN + LQ + 64 * wave + 32 * ks + 8 * grp);
#pragma unroll
        for (int br = 0; br < 3; ++br) gate[qt][br] = bf2f(ACT[row * NIN + LNSA + 3 * wave + br]);
    }
    f32x4 O[4][2], OA[4][2], s[2][4]; float mrun[2], lrun[2]; unsigned selm[2] = {0u, 0u};
#pragma unroll
    for (int dt = 0; dt < 4; ++dt)
#pragma unroll
        for (int qt = 0; qt < 2; ++qt) { O[dt][qt] = (f32x4){0.f, 0.f, 0.f, 0.f}; OA[dt][qt] = (f32x4){0.f, 0.f, 0.f, 0.f}; }
    mrun[0] = mrun[1] = ATT_M0; lrun[0] = lrun[1] = 0.f;
#define ATT_FINISH(br) do { _Pragma("unroll") for (int qt = 0; qt < 2; ++qt) { float lt = lrun[qt]; lt += __shfl_xor(lt, 16); lt += __shfl_xor(lt, 32); \
        const float f = (lt > 0.f) ? gate[qt][br] / lt : 0.f; _Pragma("unroll") for (int dt = 0; dt < 4; ++dt) { OA[dt][qt] += O[dt][qt] * f; O[dt][qt] = (f32x4){0.f, 0.f, 0.f, 0.f}; } \
        mrun[qt] = ATT_M0; lrun[qt] = 0.f; } } while (0)
    const float czero[2] = {0.f, 0.f};
    ATT_BAR();
    { const TileSrc s0 = attn_tile_src(P, b, 0, n_slc, lo); attn_dma(lds, s0, wave, lane); }
    { const TileSrc s1 = attn_tile_src(P, b, 1, n_slc, lo); attn_dma(lds + A_TILE, s1, wave, lane); }
    asm volatile("s_waitcnt vmcnt(4)" ::: "memory");
    ATT_BAR();
    { const TileSrc s2 = attn_tile_src(P, b, 2, n_slc, lo); attn_dma(lds + 2 * A_TILE, s2, wave, lane); }
    {
        attn_tile<0>(lds + g * 8192, lds + 16384 + g * 8192, qf, O, mrun, lrun, s, lane, 0, qpos, czero, true);
#pragma unroll
        for (int qt = 0; qt < 2; ++qt) {
            float lt = lrun[qt]; lt += __shfl_xor(lt, 16); lt += __shfl_xor(lt, 32);
            const float inv = (lt > 0.f) ? 1.0f / lt : 0.f;
#pragma unroll
            for (int kt = 0; kt < 4; ++kt)
#pragma unroll
                for (int rr = 0; rr < 2; ++rr) IMP[(wave * 32 + 16 * qt + lr) * 33 + 8 * kt + 2 * grp + rr] = (s[qt][kt][2 * rr] + s[qt][kt][2 * rr + 1]) * inv;
        }
        ATT_FINISH(0);
        ATT_BAR();
        for (int i = tid; i < 2 * 32 * 32; i += 512) { const int gg = i >> 10, q = (i >> 5) & 31, j = i & 31;
            IMPS[(gg * 32 + q) * 33 + j] = (IMP[((4 * gg + 0) * 32 + q) * 33 + j] + IMP[((4 * gg + 1) * 32 + q) * 33 + j]) + (IMP[((4 * gg + 2) * 32 + q) * 33 + j] + IMP[((4 * gg + 3) * 32 + q) * 33 + j]); }
        ATT_BAR();
        if (tid < 64) {
            const int gg = tid >> 5, q = tid & 31;
            unsigned mask = 1u | (1u << qblk);
            if (qblk - 1 <= 6) mask = (qblk >= 31) ? 0xffffffffu : ((2u << qblk) - 1u);
            else {
                const LAS float* v = IMPS + (gg * 32 + q) * 33;
                for (int pick = 0; pick < 6; ++pick) { float best = -1.f; int bi = 1;
                    for (int j = 1; j < qblk; ++j) { const float x = v[j]; if (!((mask >> j) & 1u) && x > best) { best = x; bi = j; } }
                    mask |= 1u << bi; }
            }
            SEL[gg * 32 + q] = mask;
        }
        asm volatile("s_waitcnt vmcnt(4)" ::: "memory");
        ATT_BAR();
        selm[0] = SEL[g * 32 + lr]; selm[1] = SEL[g * 32 + 16 + lr];
    }
    int cur = 1, nxt = 0;
    for (int T = 1; T < NT; ++T) {
        const bool more = T + 2 < NT;
        if (more) { const TileSrc sn = attn_tile_src(P, b, T + 2, n_slc, lo); attn_dma(lds + nxt * A_TILE, sn, wave, lane); }
        const LAS unsigned char* Kg = lds + cur * A_TILE + g * 8192; const LAS unsigned char* Vg = Kg + 16384;
        if (T <= n_slc) {
            const int jb = T - 1;
            const float cin[2] = {((selm[0] >> jb) & 1u) ? 0.f : NEGBIG, ((selm[1] >> jb) & 1u) ? 0.f : NEGBIG};
            if (__any((int)(((selm[0] | selm[1]) >> jb) & 1u))) attn_tile<1>(Kg, Vg, qf, O, mrun, lrun, s, lane, 64 * jb, qpos, cin, jb == qblk);
            if (T == n_slc) ATT_FINISH(1);
        } else {
            const int jt = lo + (T - 1 - n_slc);
            const bool em = (64 * jt + 63 > t0) || (64 * jt <= t0 + 31 - 512);
            attn_tile<2>(Kg, Vg, qf, O, mrun, lrun, s, lane, 64 * jt, qpos, czero, em);
            if (T == NT - 1) ATT_FINISH(2);
        }
        if (more) asm volatile("s_waitcnt vmcnt(4)" ::: "memory"); else asm volatile("s_waitcnt vmcnt(0)" ::: "memory");
        ATT_BAR();
        cur = (cur == 2) ? 0 : cur + 1; nxt = (nxt == 2) ? 0 : nxt + 1;
    }
#undef ATT_FINISH
#pragma unroll
    for (int qt = 0; qt < 2; ++qt) {
        const size_t row = row0 + 16 * qt + lr;
#pragma unroll
        for (int dt = 0; dt < 4; ++dt) {
            const int col = 64 * wave + 16 * dt + 4 * grp;
            float za[4]; unpack4(*(const u32x2*)(ACT + row * NIN + LZA + col), za);
            u32x2 w; w.x = cvt_pk_bf16(OA[dt][qt][0] * za[0], OA[dt][qt][1] * za[1]); w.y = cvt_pk_bf16(OA[dt][qt][2] * za[2], OA[dt][qt][3] * za[3]);
            *(u32x2*)(AB + row * DM + col) = w;
        }
    }
}

constexpr int G_ST = 0, G_VNT = 1024, VPITCH = 136;
__device__ __forceinline__ void gmlp_unit(const Params& P, LAS unsigned char* lds, int b, int ch, int g, int tid, int lane, int wave) {
    const bf16_t* ACT = (const bf16_t*)(P.ws + WS_ACT); bf16_t* AB = (bf16_t*)(P.ws + WS_AB); const bf16_t* tril = (const bf16_t*)(P.ws + WS_TRIL) + (size_t)g * 128 * 128;
    LAS f32x2* ST = (LAS f32x2*)(lds + G_ST); LAS bf16_t* Vnt = (LAS bf16_t*)(lds + G_VNT);
    const size_t R0 = (size_t)b * SEQ + 128 * ch;
    __syncthreads();
    {
        u32x4 raw[16];
#pragma unroll
        for (int i = 0; i < 16; ++i) raw[i] = *(const u32x4*)(ACT + (R0 + wave + 8 * i) * NIN + LVB + 8 * lane);
#pragma unroll
        for (int i = 0; i < 16; ++i) {
            float f[8]; f[0] = bf2f(raw[i].x); f[1] = bf2f(raw[i].x >> 16); f[2] = bf2f(raw[i].y); f[3] = bf2f(raw[i].y >> 16); f[4] = bf2f(raw[i].z); f[5] = bf2f(raw[i].z >> 16); f[6] = bf2f(raw[i].w); f[7] = bf2f(raw[i].w >> 16);
            float sm = 0.f, sq = 0.f;
#pragma unroll
            for (int e = 0; e < 8; ++e) { sm += f[e]; sq += f[e] * f[e]; }
#pragma unroll
            for (int o = 1; o < 64; o <<= 1) { sm += __shfl_xor(sm, o); sq += __shfl_xor(sq, o); }
            const float mean = sm * (1.0f / 512.0f), var = fmaxf(sq * (1.0f / 512.0f) - mean * mean, 0.f);
            if (lane == 0) ST[wave + 8 * i] = (f32x2){mean, rsqrtf(var + 1e-6f)};
        }
    }
    __syncthreads();
    const float* vg = P.in[21] + 128 * g; const float* vb = P.in[22] + 128 * g;
#pragma unroll
    for (int i = 0; i < 4; ++i) {
        const int idx = tid + 512 * i, j = idx & 127, chn = idx >> 7;
        const u32x4 raw = *(const u32x4*)(ACT + (R0 + j) * NIN + LVB + 128 * g + 8 * chn);
        const f32x2 st = ST[j];
        float f[8]; f[0] = bf2f(raw.x); f[1] = bf2f(raw.x >> 16); f[2] = bf2f(raw.y); f[3] = bf2f(raw.y >> 16); f[4] = bf2f(raw.z); f[5] = bf2f(raw.z >> 16); f[6] = bf2f(raw.w); f[7] = bf2f(raw.w >> 16);
#pragma unroll
        for (int e = 0; e < 8; ++e) { const int d = 8 * chn + e; Vnt[d * VPITCH + j] = (bf16_t)f2bf((f[e] - st[0]) * st[1] * vg[d] + vb[d]); }
    }
    __syncthreads();
    const int lr = lane & 15, grp = lane >> 4;
    f32x4 acc[8];
#pragma unroll
    for (int it = 0; it < 8; ++it) acc[it] = (f32x4){0.f, 0.f, 0.f, 0.f};
#pragma unroll
    for (int ks = 0; ks < 4; ++ks) {
        const bf16x8 af = *(const LAS bf16x8*)(Vnt + (16 * wave + lr) * VPITCH + 32 * ks + 8 * grp);
#pragma unroll
        for (int it = 0; it < 8; ++it) {
            if ((it >> 1) >= ks) { const bf16x8 bfr = *(const bf16x8*)(tril + (size_t)(16 * it + lr) * 128 + 32 * ks + 8 * grp);
                acc[it] = __builtin_amdgcn_mfma_f32_16x16x32_bf16(af, bfr, acc[it], 0, 0, 0); }
        }
    }
    const float* bs = P.in[24] + 128 * g;
#pragma unroll
    for (int it = 0; it < 8; ++it) {
        const int i = 16 * it + lr; const size_t row = R0 + i; const int d0 = 128 * g + 16 * wave + 4 * grp;
        const float bsi = bs[i];
        float uu[4], zb[4]; unpack4(*(const u32x2*)(ACT + row * NIN + LU + d0), uu); unpack4(*(const u32x2*)(ACT + row * NIN + LZB + d0), zb);
        u32x2 w; w.x = cvt_pk_bf16(uu[0] * (acc[it][0] + bsi) * zb[0], uu[1] * (acc[it][1] + bsi) * zb[1]); w.y = cvt_pk_bf16(uu[2] * (acc[it][2] + bsi) * zb[2], uu[3] * (acc[it][3] + bsi) * zb[3]);
        *(u32x2*)(AB + row * DM + 512 + d0) = w;
    }
}

__device__ __forceinline__ void stile(const float* kb, const float* vb, int stride, int kmin, const f32x4 (&q4)[4], float (&m)[4], float (&l)[4], f32x4 (&o4)[4], float (&pout)[4], int lane_in) {
    int lane = lane_in; asm volatile("" : "+v"(lane));
    const int li = lane & 15, gq = lane >> 4;
    __builtin_amdgcn_sched_barrier(0);
    const float* kl = kb + (size_t)(gq * stride + 4 * li); const float* vl = vb + (size_t)(gq * stride + 4 * li);
    f32x4 kreg[16], vreg[16];
#pragma unroll
    for (int i = 0; i < 16; ++i) kreg[i] = __builtin_nontemporal_load((const f32x4*)(kl + (size_t)(4 * i) * stride));
#pragma unroll
    for (int i = 0; i < 16; ++i) vreg[i] = __builtin_nontemporal_load((const f32x4*)(vl + (size_t)(4 * i) * stride));
    float sc[4];
#pragma unroll
    for (int h = 0; h < 4; ++h) {
        float v[16], w8[8], w4[4], w2[2];
#pragma unroll
        for (int i = 0; i < 16; ++i) v[i] = (kreg[i][0] * q4[h][0] + kreg[i][1] * q4[h][1]) + (kreg[i][2] * q4[h][2] + kreg[i][3] * q4[h][3]);
#pragma unroll
        for (int t = 0; t < 8; ++t) { const float snd = (li & 8) ? v[t] : v[t + 8], kp = (li & 8) ? v[t + 8] : v[t]; w8[t] = kp + __shfl_xor(snd, 8); }
#pragma unroll
        for (int t = 0; t < 4; ++t) { const float snd = (li & 4) ? w8[t] : w8[t + 4], kp = (li & 4) ? w8[t + 4] : w8[t]; w4[t] = kp + __shfl_xor(snd, 4); }
#pragma unroll
        for (int t = 0; t < 2; ++t) { const float snd = (li & 2) ? w4[t] : w4[t + 2], kp = (li & 2) ? w4[t + 2] : w4[t]; w2[t] = kp + __shfl_xor(snd, 2); }
        { const float snd = (li & 1) ? w2[0] : w2[1], kp = (li & 1) ? w2[1] : w2[0]; sc[h] = kp + __shfl_xor(snd, 1); }
        __builtin_amdgcn_sched_barrier(0);
    }
    const bool valid = (4 * li + gq) >= kmin;
#pragma unroll
    for (int h = 0; h < 4; ++h) {
        const float sv = valid ? sc[h] : NEGBIG;
        const float mnew = fmaxf(m[h], wave_max(sv));
        const float alpha = __builtin_amdgcn_exp2f(m[h] - mnew), p = __builtin_amdgcn_exp2f(sv - mnew);
        l[h] = l[h] * alpha + wave_sum(p); o4[h] *= alpha; m[h] = mnew; pout[h] = p;
    }
    const int src0 = lane & 48;
#pragma unroll
    for (int i = 0; i < 16; ++i) {
#pragma unroll
        for (int h = 0; h < 4; ++h) o4[h] += vreg[i] * __shfl(pout[h], src0 + i);
    }
    __builtin_amdgcn_sched_barrier(0);
}
__device__ __forceinline__ void skey(const float* kb, const float* vb, const f32x4 (&q4)[4], float (&m)[4], float (&l)[4], f32x4 (&o4)[4], int lane) {
    const int li = lane & 15, gq = lane >> 4;
    const f32x4 kd = *(const f32x4*)(kb + 4 * li), vd = *(const f32x4*)(vb + 4 * li);
#pragma unroll
    for (int h = 0; h < 4; ++h) {
        float sv = (kd[0] * q4[h][0] + kd[1] * q4[h][1]) + (kd[2] * q4[h][2] + kd[3] * q4[h][3]);
        sv += __shfl_xor(sv, 1); sv += __shfl_xor(sv, 2); sv += __shfl_xor(sv, 4); sv += __shfl_xor(sv, 8);
        const float mnew = fmaxf(m[h], sv), alpha = __builtin_amdgcn_exp2f(m[h] - mnew), p = __builtin_amdgcn_exp2f(sv - mnew);
        l[h] = l[h] * alpha + p; o4[h] *= alpha; if (gq == 0) o4[h] += vd * p; m[h] = mnew;
    }
}

constexpr int S_ST = 0, S_MISC = 8 * 3 * 4 * 66 * 4;
__device__ __forceinline__ void sample_unit(const Params& P, LAS unsigned char* lds, int sb, int g, int tid, int lane, int wave) {
    const bf16_t* ACT = (const bf16_t*)(P.ws + WS_ACT); bf16_t* AB = (bf16_t*)(P.ws + WS_AB);
    LAS float* ST = (LAS float*)(lds + S_ST); LAS float* MISC = (LAS float*)(lds + S_MISC);
    const size_t row = (size_t)MP + sb;
    const int* ptab = (const int*)P.in[8] + sb * 16;
    const int li = lane & 15;
    __syncthreads();
    f32x4 q4[4];
#pragma unroll
    for (int h = 0; h < 4; ++h) { float t4[4]; unpack4(*(const u32x2*)(ACT + row * NIN + LQ + 64 * (4 * g + h) + 4 * li), t4); q4[h] = (f32x4){t4[0], t4[1], t4[2], t4[3]}; }
    float ms[4], ls[4]; f32x4 os[4];
#define S_RESET() do { _Pragma("unroll") for (int h = 0; h < 4; ++h) { ms[h] = MINIT; ls[h] = 0.f; os[h] = (f32x4){0.f, 0.f, 0.f, 0.f}; } } while (0)
#define S_PUBLISH(b2, doit) do { _Pragma("unroll") for (int h = 0; h < 4; ++h) { f32x4 v = os[h]; \
        _Pragma("unroll") for (int e = 0; e < 4; ++e) { float x = v[e]; x += __shfl_xor(x, 16); x += __shfl_xor(x, 32); v[e] = x; } \
        if (doit) { LAS float* st = ST + ((wave * 3 + (b2)) * 4 + h) * 66; if (lane < 16) *(LAS f32x4*)(st + 4 * lane) = v; if (lane == 0) { st[64] = ms[h]; st[65] = ls[h]; } } } } while (0)
    float pdummy[4], pc[4];
    S_RESET();
    { const size_t off = (((size_t)sb * 512 + 64 * wave) * 2 + g) * 64; stile(P.in[6] + off, P.in[7] + off, 128, (wave == 0) ? 1 : 0, q4, ms, ls, os, pdummy, lane); }
    if (wave == 0) { const size_t off = ((size_t)(sb * 512 + 511) * 2 + g) * 64; skey(P.out + O_SKW + off, P.out + O_SVW + off, q4, ms, ls, os, lane); }
    S_PUBLISH(1, true);
    S_RESET();
    stile((const float*)(P.ws + WS_KCS) + (size_t)(sb * 2 + g) * 4096, (const float*)(P.ws + WS_VCS) + (size_t)(sb * 2 + g) * 4096, 64, 0, q4, ms, ls, os, pc, lane);
    float imp = 0.f;
#pragma unroll
    for (int h = 0; h < 4; ++h) { const float pn = pc[h] / ls[h]; imp += pn + __shfl_down(pn, 16); }
    S_PUBLISH(2, wave == 0);
    const int jblk = 2 * li + (lane >> 5);
    const bool cand = ((lane >> 4) & 1) == 0 && jblk >= 1;
    unsigned key = cand ? ((__builtin_bit_cast(unsigned, imp) & 0xffffffe0u) | (unsigned)(31 - jblk)) : 0u;
    unsigned long long selpack = 0ull;
#pragma unroll
    for (int pick = 0; pick < 6; ++pick) {
        unsigned best = key;
#pragma unroll
        for (int o2 = 1; o2 < 64; o2 <<= 1) { const unsigned other = (unsigned)__shfl_xor((int)best, o2); best = other > best ? other : best; }
        const int bj = 31 - (int)(best & 31u);
        selpack |= (unsigned long long)bj << (5 * (pick + 1));
        if (cand && jblk == bj) key = 0u;
    }
    S_RESET();
    if (wave < 7) { const int blk = (int)((selpack >> (5 * wave)) & 31ull); const int page = __builtin_amdgcn_readfirstlane(ptab[blk >> 1]); const size_t off = (((size_t)page * 128 + (blk & 1) * 64) * 2 + g) * 64;
        stile(P.in[4] + off, P.in[5] + off, 128, 0, q4, ms, ls, os, pdummy, lane); }
    else skey(P.out + O_SKS + (size_t)sb * 128 + g * 64, P.out + O_SVS + (size_t)sb * 128 + g * 64, q4, ms, ls, os, lane);
    S_PUBLISH(0, true);
#undef S_RESET
#undef S_PUBLISH
    if (wave == 7) {
        const u32x4 raw = *(const u32x4*)(ACT + row * NIN + LVB + 8 * lane);
        float f[8]; f[0] = bf2f(raw.x); f[1] = bf2f(raw.x >> 16); f[2] = bf2f(raw.y); f[3] = bf2f(raw.y >> 16); f[4] = bf2f(raw.z); f[5] = bf2f(raw.z >> 16); f[6] = bf2f(raw.w); f[7] = bf2f(raw.w >> 16);
        float sm = 0.f;
#pragma unroll
        for (int i = 0; i < 8; ++i) sm += f[i];
        const float mean = wave_sum(sm) * (1.0f / 512.0f); float sq = 0.f;
#pragma unroll
        for (int i = 0; i < 8; ++i) { const float d = f[i] - mean; sq += d * d; }
        const float rstd = rsqrtf(wave_sum(sq) * (1.0f / 512.0f) + 1e-6f);
        if (lane == 0) { MISC[0] = mean; MISC[1] = rstd; }
    }
    __syncthreads();
    if (wave < 4) {
        const int h = wave, head = 4 * g + h;
        const LAS float* stc = ST + ((0 * 3 + 2) * 4 + h) * 66;
        float oa = bf2f(ACT[row * NIN + LNSA + 3 * head + 0]) * stc[lane] / stc[65];
#pragma unroll
        for (int b2 = 0; b2 < 2; ++b2) {
            float M = MINIT;
#pragma unroll
            for (int w = 0; w < 8; ++w) M = fmaxf(M, ST[((w * 3 + b2) * 4 + h) * 66 + 64]);
            float L = 0.f, O = 0.f;
#pragma unroll
            for (int w = 0; w < 8; ++w) { const LAS float* st = ST + ((w * 3 + b2) * 4 + h) * 66; const float f = __builtin_amdgcn_exp2f(st[64] - M); L += st[65] * f; O += st[lane] * f; }
            oa += bf2f(ACT[row * NIN + LNSA + 3 * head + 1 + b2]) * O / L;
        }
        const int col = 64 * head + lane;
        AB[row * DM + col] = (bf16_t)f2bf(oa * bf2f(ACT[row * NIN + LZA + col]));
    }
    if (tid < 256) {
        const int d = 256 * g + tid, gm = d >> 7;
        const float vn = (bf2f(ACT[row * NIN + LVB + d]) - MISC[0]) * MISC[1] * P.in[21][d] + P.in[22][d];
        P.out[O_SVCH + (size_t)sb * 512 + d] = vn;
        const float sv = P.in[23][(size_t)gm * 128 * 128] * vn + P.in[24][gm * 128];
        AB[row * DM + 512 + d] = (bf16_t)f2bf(bf2f(ACT[row * NIN + LU + d]) * sv * bf2f(ACT[row * NIN + LZB + d]));
    }
}

template <int MODE>
__device__ __forceinline__ void small_gemm(const Params& P, int c, int G, int wave, int lane) {
    const int lr = lane & 15, grp = lane >> 4;
    for (int t = c + G * wave; t < 512; t += G * 8) {
        const int rt = t & 7, ct = t >> 3;
        const size_t row = (size_t)MP + 16 * rt + lr;
        const bf16_t* A = (const bf16_t*)(P.ws + (MODE == 0 ? WS_AB : WS_H)) + row * DM + 8 * grp;
        const bf16_t* W = (const bf16_t*)(P.ws + (MODE == 0 ? WS_WTBR : WS_WTOUT)) + (size_t)(16 * ct + lr) * DM + 8 * grp;
        f32x4 acc0 = (f32x4){0.f, 0.f, 0.f, 0.f}, acc1 = (f32x4){0.f, 0.f, 0.f, 0.f};
#pragma unroll 8
        for (int ks = 0; ks < 16; ++ks) acc0 = __builtin_amdgcn_mfma_f32_16x16x32_bf16(*(const bf16x8*)(W + 32 * ks), *(const bf16x8*)(A + 32 * ks), acc0, 0, 0, 0);
#pragma unroll 8
        for (int ks = 16; ks < 32; ++ks) acc1 = __builtin_amdgcn_mfma_f32_16x16x32_bf16(*(const bf16x8*)(W + 32 * ks), *(const bf16x8*)(A + 32 * ks), acc1, 0, 0, 0);
        const int col = 16 * ct + 4 * grp;
        if (MODE == 0) {
            const bf16_t* ACT = (const bf16_t*)(P.ws + WS_ACT);
            float sa[4], sb[4]; unpack4(*(const u32x2*)(ACT + row * NIN + LGA + col), sa); unpack4(*(const u32x2*)(ACT + row * NIN + LGB + col), sb);
            u32x2 w; w.x = cvt_pk_bf16(sa[0] * acc0[0] + sb[0] * acc1[0], sa[1] * acc0[1] + sb[1] * acc1[1]); w.y = cvt_pk_bf16(sa[2] * acc0[2] + sb[2] * acc1[2], sa[3] * acc0[3] + sb[3] * acc1[3]);
            *(u32x2*)((bf16_t*)(P.ws + WS_H) + row * DM + col) = w;
        } else {
            const int sbi = 16 * rt + lr;
            const f32x4 xv = *(const f32x4*)(P.in[1] + (size_t)sbi * DM + col), gv = *(const f32x4*)((const float*)(P.ws + WS_MOD) + (size_t)(8 + sbi) * 3072 + 2048 + col);
            *(f32x4*)(P.out + O_YS + (size_t)sbi * DM + col) = xv + gv * (acc0 + acc1);
        }
    }
}

#define XB_TMO      128
#define XB_XCNT(j)  (256  + 64 * (j))
#define XB_XSUB(j)  (1280 + 64 * (j))
#define XB_XGEN(j)  (2304 + 64 * (j))
#define XB_TOP      3328
#define XB_TOPGEN   3392
#define XCD_BAR_WORDS 3456
#define XB_SPIN_CAP (1u << 18)
__device__ __forceinline__ unsigned xb_ld(unsigned* p)              { return __hip_atomic_load(p, __ATOMIC_RELAXED, __HIP_MEMORY_SCOPE_AGENT); }
__device__ __forceinline__ unsigned xb_add(unsigned* p, unsigned v) { return __hip_atomic_fetch_add(p, v, __ATOMIC_RELAXED, __HIP_MEMORY_SCOPE_AGENT); }
__device__ __forceinline__ unsigned xb_xcc_id() { return (unsigned)__builtin_amdgcn_s_getreg((3 << 11) | 20) & 0xFu; }
#define XB_SPIN(cond, bar) do { unsigned _sp = 0; while (cond) { __builtin_amdgcn_s_sleep(1); \
    if ((++_sp & 255u) == 0u) { if (xb_ld(&(bar)[XB_TMO])) break; if (_sp > XB_SPIN_CAP) { atomicAdd(&(bar)[XB_TMO], 1u); break; } } } } while (0)
struct XcdBarrier { unsigned* bar; unsigned x; volatile LAS unsigned* st; };
__device__ __forceinline__ XcdBarrier xcd_barrier_post(unsigned* bar, volatile LAS unsigned* st) {
    XcdBarrier b; b.bar = bar; b.x = xb_xcc_id(); b.st = st;
    if (threadIdx.x == 0) (void)xb_add(&bar[XB_XCNT(b.x)], 1u);
    return b;
}
__device__ __forceinline__ void xcd_barrier_complete(unsigned* bar, unsigned x, unsigned& nloc, unsigned& nx) {
    const unsigned G = gridDim.x * gridDim.y * gridDim.z;
    unsigned sum, cnt, mine, sp = 0u;
    for (;;) {
        sum = 0u; cnt = 0u; mine = 0u;
#pragma unroll
        for (unsigned j = 0; j < 16; ++j) { const unsigned c = xb_ld(&bar[XB_XCNT(j)]); sum += c; cnt += (c > 0u) ? 1u : 0u; mine = (j == x) ? c : mine; }
        if (sum == G) break;
        __builtin_amdgcn_s_sleep(1);
        if ((++sp & 255u) == 0u) { if (xb_ld(&bar[XB_TMO])) break; if (sp > XB_SPIN_CAP) { atomicAdd(&bar[XB_TMO], 1u); break; } }
    }
    nloc = mine > 0u ? mine : 1u; nx = cnt > 0u ? cnt : 1u;
}
__device__ __forceinline__ void xcd_barrier(const XcdBarrier& b) {
    asm volatile("s_waitcnt vmcnt(0)" ::: "memory");
    __syncthreads();
    if (threadIdx.x == 0) {
        unsigned* bar = b.bar;
        __builtin_amdgcn_s_waitcnt(0);
        unsigned nloc = b.st[0], nx = b.st[1];
        if (nloc == 0u) { xcd_barrier_complete(bar, b.x, nloc, nx); b.st[0] = nloc; b.st[1] = nx; }
        const unsigned old = xb_add(&bar[XB_XSUB(b.x)], 1u);
        const unsigned gen = old / nloc;
        if (old + 1u == (gen + 1u) * nloc) {
            __builtin_amdgcn_fence(__ATOMIC_RELEASE, "agent");
            asm volatile("s_waitcnt vmcnt(0)" ::: "memory");
            const unsigned og = xb_add(&bar[XB_TOP], 1u);
            const unsigned tg = og / nx;
            if (og + 1u == (tg + 1u) * nx) xb_add(&bar[XB_TOPGEN], 1u);
            else XB_SPIN(xb_ld(&bar[XB_TOPGEN]) == tg, bar);
            __builtin_amdgcn_fence(__ATOMIC_ACQUIRE, "agent");
            xb_add(&bar[XB_XGEN(b.x)], 1u);
            asm volatile("s_waitcnt vmcnt(0)" ::: "memory");
        } else {
            XB_SPIN(xb_ld(&bar[XB_XGEN(b.x)]) == gen, bar);
            __builtin_amdgcn_fence(__ATOMIC_ACQUIRE, "agent");
            asm volatile("s_waitcnt vmcnt(0)" ::: "memory");
        }
    }
    __syncthreads();
}

__global__ void __launch_bounds__(512, 2) mk_fwd(Params P) {
    extern __shared__ __attribute__((aligned(16))) unsigned char lds_raw[];
    LAS unsigned char* lds = (LAS unsigned char*)lds_raw;
    const int tid = threadIdx.x, lane = tid & 63, wave = __builtin_amdgcn_readfirstlane(tid >> 6);
    const int G = gridDim.x, c = blockIdx.x, gw = c * 8 + wave, NGW = G * 8, gtid = c * 512 + tid, NT = G * 512;
    cg::grid_group grid = cg::this_grid();
    const int lo = P.ph_lo, hi = P.ph_hi;
    if (tid < 16) ((LAS unsigned*)(lds + LDS_XB))[tid] = 0u;
    __syncthreads();
    const XcdBarrier bar = xcd_barrier_post((unsigned*)(P.ws + WS_CTL), (volatile LAS unsigned*)(lds + LDS_XB));
    if (hi < 0) grid.sync();
#define IN(k) (lo <= (k) && (k) < hi)
#define SEAM(k) do { if (IN(k) && IN((k) + 1)) xcd_barrier(bar); } while (0)
    unsigned char* ws = P.ws;
    if (IN(0)) for (int rep = 0; rep < MK_REP0; ++rep) { p0_prologue(P, lds, gw, NGW, lane, wave, gtid, NT); }
    SEAM(0);
    if (IN(1)) for (int rep = 0; rep < MK_REP1; ++rep) { p1_hrows(P, gw, NGW, lane); }
    SEAM(1);
    if (IN(2)) for (int rep = 0; rep < MK_REP2; ++rep) {
        pg8::Gemm gm{(const bf16_t*)(ws + WS_H), (const bf16_t*)(ws + WS_WTIN), DM, DM, DM};
        pg8::StaticOrder S; S.init(MPAD / 256, NIN / 256, G, c);
        EpiInProj E{(bf16_t*)(ws + WS_ACT), (bf16_t*)(ws + WS_VT), P.out, P.in[15], P.in[16], (const float*)(ws + WS_ROPE)};
        pg8::gemm_phase<EpiInProj, pg8::StaticOrder>(lds, gm, S, E);
    }
    SEAM(2);
    if (IN(3)) for (int rep = 0; rep < MK_REP3; ++rep) { p3_compress(P, lds, gw, NGW, lane, wave); }
    SEAM(3);
    if (IN(4)) for (int rep = 0; rep < MK_REP4; ++rep) {
        asm volatile("" ::: "memory");
        for (int i = 0;; ++i) { const int a = (i & 1) ? (i + 1) * G - 1 - c : i * G + c; if (a >= 512 || a < 0) break; attn_unit(P, lds, a & 7, 63 - (a >> 3), tid, lane, wave); }
        for (int su = c; su < 2 * NSB; su += G) sample_unit(P, lds, su >> 1, su & 1, tid, lane, wave);
        for (int gu = c; gu < 512; gu += G) gmlp_unit(P, lds, gu >> 6, (gu >> 2) & 15, gu & 3, tid, lane, wave);
        __syncthreads();
    }
    SEAM(4);
    if (IN(5)) for (int rep = 0; rep < MK_REP5; ++rep) {
        pg8::Gemm gm{(const bf16_t*)(ws + WS_AB), (const bf16_t*)(ws + WS_WTBR), DM, DM, 512};
        small_gemm<0>(P, c, G, wave, lane);
        pg8::PairOrder S; S.S.init(MP / 256, DM / 256, G, c);
        EpiMix E{(const bf16_t*)(ws + WS_ACT), (bf16_t*)(ws + WS_H)};
        pg8::gemm_phase<EpiMix, pg8::PairOrder>(lds, gm, S, E);
    }
    SEAM(5);
    if (IN(6)) for (int rep = 0; rep < MK_REP6; ++rep) {
        pg8::Gemm gm{(const bf16_t*)(ws + WS_H), (const bf16_t*)(ws + WS_WTOUT), DM, DM, DM};
        small_gemm<1>(P, c, G, wave, lane);
        pg8::StaticOrder S; S.init(MP / 256, DM / 256, G, c);
        EpiOut E{P.in[0], P.in[1], (const float*)(ws + WS_MOD), P.out};
        pg8::gemm_phase<EpiOut, pg8::StaticOrder>(lds, gm, S, E);
    }
#undef IN
#undef SEAM
}

extern "C" void kernel_launch(void* const* d_in, const int* in_sizes, int n_in, void* d_out, int out_size, void* d_ws, size_t ws_size, hipStream_t stream) {
    static int grid = 0;
    if (grid == 0) {
        if (n_in != 28 || out_size != (int)O_END || ws_size < WS_END) { fprintf(stderr, "kernel_launch: unexpected shapes (n_in %d, out %d, ws %zu); nothing launched\n", n_in, out_size, ws_size); grid = -1; return; }
        int dev = 0, cus = 0, per_cu = 0;
        if (hipGetDevice(&dev) != hipSuccess || hipDeviceGetAttribute(&cus, hipDeviceAttributeMultiprocessorCount, dev) != hipSuccess) { grid = -1; return; }
        if (hipFuncSetAttribute((const void*)mk_fwd, hipFuncAttributeMaxDynamicSharedMemorySize, LDS_BYTES) != hipSuccess) { fprintf(stderr, "kernel_launch: hipFuncSetAttribute failed\n"); grid = -1; return; }
        if (hipOccupancyMaxActiveBlocksPerMultiprocessor(&per_cu, (const void*)mk_fwd, 512, LDS_BYTES) != hipSuccess || per_cu < 1) { fprintf(stderr, "kernel_launch: occupancy query failed (%d)\n", per_cu); (void)hipGetLastError(); per_cu = 1; }
        if (per_cu > 1) per_cu = 1;
        grid = cus * per_cu;
    }
    if (grid < 0) return;
    if (hipMemsetAsync((char*)d_ws + WS_CTL, 0, CTL_BYTES, stream) != hipSuccess) { fprintf(stderr, "kernel_launch: hipMemsetAsync failed\n"); return; }
    Params p{};
    for (int i = 0; i < 28; ++i) p.in[i] = (const float*)d_in[i];
    p.out = (float*)d_out; p.ws = (unsigned char*)d_ws;
#if MK_N_LAUNCHES == 1
    p.ph_lo = 0; p.ph_hi = 7;
    void* args[] = {&p};
    hipError_t e = hipLaunchCooperativeKernel((const void*)mk_fwd, dim3(grid), dim3(512), args, LDS_BYTES, stream);
    if (e != hipSuccess) fprintf(stderr, "kernel_launch: cooperative launch failed: %s (grid %d)\n", hipGetErrorString(e), grid);
#else
    for (int ph = 0; ph < 7; ++ph) {
        p.ph_lo = ph; p.ph_hi = ph + 1;
        void* args[] = {&p};
        hipError_t e = hipLaunchCooperativeKernel((const void*)mk_fwd, dim3(grid), dim3(512), args, LDS_BYTES, stream);
        if (e != hipSuccess) { fprintf(stderr, "kernel_launch: launch %d failed: %s (grid %d)\n", ph, hipGetErrorString(e), grid); break; }
    }
#endif
}
```

```cpp
#include <hip/hip_runtime.h>
#include <hip/hip_cooperative_groups.h>
#include <cstdio>
#include <cstdint>
namespace cg = cooperative_groups;

#ifndef MK_N_LAUNCHES
#define MK_N_LAUNCHES 1
#endif
#define MK_REP0 1
#define MK_REP1 1
#define MK_REP2 1
#define MK_REP3 1
#define MK_REP4 1
#define MK_REP5 1
#define MK_REP6 1

#define LAS __attribute__((address_space(3)))
typedef unsigned short bf16_t;
typedef short bf16x8 __attribute__((ext_vector_type(8)));
typedef short bf16x4 __attribute__((ext_vector_type(4)));
typedef float f32x4 __attribute__((ext_vector_type(4)));
typedef float f32x2 __attribute__((ext_vector_type(2)));
typedef unsigned u32x4 __attribute__((ext_vector_type(4)));
typedef unsigned u32x2 __attribute__((ext_vector_type(2)));

constexpr int DM = 1024, SEQ = 2048, NBATCH = 8, MP = NBATCH * SEQ, NSB = 128, MTOT = MP + NSB, MPAD = 16640;
constexpr int NIN = 5632;
constexpr int LQ = 0, LK = 512, LV = 896, LZA = 1280, LU = 1792, LVB = 2304, LZB = 2816, LGA = 3328, LGB = 4352, LNSA = 5376;
constexpr float C2Q = 0.125f * 1.4426950408889634f;
constexpr float NEGBIG = -1e30f, MINIT = -1e29f;
constexpr size_t O_YP = 0, O_YS = 16777216, O_PKC = 16908288, O_PVC = 19005440, O_PKS = 21102592, O_PVS = 23199744, O_PKW = 25296896, O_PVW = 25821184,
                 O_SKC = 26345472, O_SVC = 26361856, O_SKS = 26378240, O_SVS = 26394624, O_SKW = 26411008, O_SVW = 34799616, O_SVCH = 43188224, O_END = 43253760;
constexpr size_t MiB = 1u << 20;
constexpr size_t WS_ROPE = 0, WS_MOD = 1 * MiB, WS_WTIN = 3 * MiB, WS_WTBR = 14 * MiB, WS_WTOUT = 16 * MiB, WS_TRIL = 18 * MiB, WS_KC = 18 * MiB + 512 * 1024, WS_VCT = WS_KC + 128 * 1024,
                 WS_KCS = 19 * MiB, WS_VCS = 23 * MiB, WS_VT = 27 * MiB, WS_H = 40 * MiB, WS_AB = 73 * MiB, WS_ACT = 106 * MiB, WS_GBUF = 285 * MiB, WS_END = 355 * MiB;
constexpr size_t WS_CTL = 768 * 1024, CTL_BYTES = 16384;
constexpr int LDS_BYTES = 147456, LDS_XB = LDS_BYTES - 64;

struct Params { const float* in[28]; float* out; unsigned char* ws; int ph_lo, ph_hi; };

__device__ __forceinline__ unsigned f2bf(float f) { unsigned u = __builtin_bit_cast(unsigned, f); return (u + 0x7fffu + ((u >> 16) & 1u)) >> 16; }
__device__ __forceinline__ unsigned pk2(float lo, float hi) { return f2bf(lo) | (f2bf(hi) << 16); }
__device__ __forceinline__ float bf2f(unsigned b) { return __builtin_bit_cast(float, (b & 0xffffu) << 16); }
typedef __bf16 bf16x2_t __attribute__((ext_vector_type(2)));
__device__ __forceinline__ unsigned cvt_pk_bf16(float lo, float hi) { const f32x2 v = {lo, hi}; const bf16x2_t b = __builtin_convertvector(v, bf16x2_t); return __builtin_bit_cast(unsigned, b); }
__device__ __forceinline__ float sigmoidf_(float x) { return __builtin_amdgcn_rcpf(1.0f + __builtin_amdgcn_exp2f(x * -1.4426950408889634f)); }
__device__ __forceinline__ float wave_sum(float v) {
#pragma unroll
    for (int o = 1; o < 64; o <<= 1) v += __shfl_xor(v, o);
    return v;
}
__device__ __forceinline__ float wave_max(float v) {
#pragma unroll
    for (int o = 1; o < 64; o <<= 1) v = fmaxf(v, __shfl_xor(v, o));
    return v;
}
__device__ __forceinline__ void unpack4(u32x2 w, float (&f)[4]) { f[0] = bf2f(w.x); f[1] = bf2f(w.x >> 16); f[2] = bf2f(w.y); f[3] = bf2f(w.y >> 16); }

namespace pg8 {
constexpr int BM = 256, BK = 64, HALF = 128, HTB = HALF * BK * 2, STAGE_BYTES = 8 * HTB, NXCD = 8, WGM = 8;
__host__ __device__ __forceinline__ int lds_byte(int r, int c) { const int st = (r >> 4) * 2 + (c >> 5), rr = r & 15, cc = c & 31, ob = rr * 64 + cc * 2; return st * 1024 + (ob ^ (((ob >> 9) & 1) << 5)); }
__host__ __device__ __forceinline__ void stage_rc(int b, int& R, int& C) { const int st = b / 1024, sb = b % 1024, swz = sb ^ (((sb >> 9) & 1) << 5); R = (st >> 1) * 16 + swz / 64; C = (st & 1) * 32 + (swz % 64) / 2; }

struct Unit { int pm, pn, kofs, keep; };
struct Gemm { const bf16_t* A; const bf16_t* Bt; int lda, ldb, K; };

struct StaticOrder {
    int nM, nN, nwg, G, c;
    __device__ void init(int nM_, int nN_, int G_, int c_) { nM = nM_; nN = nN_; nwg = nM * nN; G = G_; c = c_; }
    __device__ bool tile(int i, int& pm, int& pn) const {
        const long L = (long)i * G + c; if (L >= nwg) return false;
        int wgid = (int)L; { const int q = nwg / NXCD, r = nwg % NXCD, xcd = wgid % NXCD, off = wgid / NXCD; wgid = (xcd < r ? xcd * (q + 1) : r * (q + 1) + (xcd - r) * q) + off; }
        const int nig = WGM * nN, gid = wgid / nig, fm = gid * WGM, gsz = (nM - fm) < WGM ? (nM - fm) : WGM;
        pm = fm + ((wgid % nig) % gsz); pn = (wgid % nig) / gsz; return true;
    }
    __device__ bool next(int i, Unit& u) const { u.kofs = 0; u.keep = 0; return tile(i, u.pm, u.pn); }
};
struct PairOrder {
    StaticOrder S;
    __device__ bool next(int i, Unit& u) const { u.kofs = (i & 1) * 512; u.keep = (i & 1) ? 0 : 1; return S.tile(i >> 1, u.pm, u.pn); }
};

template <class Epi, class Sched>
__device__ __forceinline__ void gemm_phase(LAS unsigned char* lds, const Gemm g, const Sched& S, const Epi& E) {
    const int tid = threadIdx.x, wid = __builtin_amdgcn_readfirstlane(tid >> 6), lane = tid & 63, wr = wid >> 2, wc = wid & 3, fr = lane & 15, fq = lane >> 4;
    const int nt = g.K / BK;
    unsigned voffA[2], voffB[2];
#pragma unroll
    for (int i = 0; i < 2; ++i) { int R, C; stage_rc(tid * 16 + i * 8192, R, C); voffA[i] = (unsigned)(R * g.lda + C) * 2u; voffB[i] = (unsigned)(R * g.ldb + C) * 2u; }
    const size_t kstep = (size_t)(BK * 2);
    const size_t hstepA = (size_t)HALF * g.lda * 2, hstepB = (size_t)HALF * g.ldb * 2, tstepA = 2 * hstepA, tstepB = 2 * hstepB;
    const unsigned ldsw = (unsigned)wid * 1024u;
    const int aoff = lds_byte(wr * 64 + fr, fq * 8), boff = lds_byte(wc * 32 + fr, fq * 8);
#define PG8_SA(b, h) (((b) * 2 + (h)) * HTB)
#define PG8_SB(b, h) ((4 + (b) * 2 + (h)) * HTB)
#define PG8_STAGE(bufoff, gbase, voff) do { _Pragma("unroll") for (int _i = 0; _i < 2; ++_i) \
        __builtin_amdgcn_global_load_lds((const unsigned*)((const char*)(gbase) + (voff)[_i]), (LAS unsigned*)(lds + (bufoff) + ldsw + _i * 8192), 16, 0, 0); } while (0)
#define PG8_LDA(dst, b, h) do { _Pragma("unroll") for (int m = 0; m < 4; ++m) _Pragma("unroll") for (int k = 0; k < 2; ++k) dst[m][k] = *(const LAS bf16x8*)(lds + PG8_SA(b, h) + aoff + m * 2048 + k * 1024); } while (0)
#define PG8_LDB(dst, b, h) do { _Pragma("unroll") for (int n = 0; n < 2; ++n) _Pragma("unroll") for (int k = 0; k < 2; ++k) dst[n][k] = *(const LAS bf16x8*)(lds + PG8_SB(b, h) + boff + n * 2048 + k * 1024); } while (0)
#define PG8_MMA(ai, bj, At, Bt) do { __builtin_amdgcn_s_setprio(1); _Pragma("unroll") for (int m = 0; m < 4; ++m) _Pragma("unroll") for (int n = 0; n < 2; ++n) _Pragma("unroll") for (int k = 0; k < 2; ++k) \
        acc[ai][bj][m][n] = __builtin_amdgcn_mfma_f32_16x16x32_bf16(Bt[n][k], At[m][k], acc[ai][bj][m][n], 0, 0, 0); __builtin_amdgcn_s_setprio(0); } while (0)
#define PG8_WAIT_V(n) asm volatile("s_waitcnt vmcnt(" #n ")" ::: "memory")
#define PG8_WAIT_L(n) asm volatile("s_waitcnt lgkmcnt(" #n ")" ::: "memory")
#define PG8_BAR __builtin_amdgcn_s_barrier()
#define PG8_SCHED __builtin_amdgcn_sched_barrier(0)
    Unit cur, nxt; int ui = 0;
    if (!S.next(0, cur)) return;
    f32x4 acc[2][2][4][2];
#pragma unroll
    for (int a = 0; a < 2; ++a)
#pragma unroll
        for (int b = 0; b < 2; ++b)
#pragma unroll
            for (int m = 0; m < 4; ++m)
#pragma unroll
                for (int n = 0; n < 2; ++n) acc[a][b][m][n] = (f32x4){0.f, 0.f, 0.f, 0.f};
    bf16x8 At[4][2], B0[2][2], B1[2][2];
    const char* cA = (const char*)g.A + (size_t)cur.pm * tstepA + (size_t)cur.kofs * 2; const char* cB = (const char*)g.Bt + (size_t)cur.pn * tstepB + (size_t)cur.kofs * 2;
    PG8_STAGE(PG8_SB(0, 0), cB, voffB); PG8_STAGE(PG8_SB(0, 1), cB + hstepB, voffB); PG8_STAGE(PG8_SA(0, 0), cA, voffA); PG8_STAGE(PG8_SA(0, 1), cA + hstepA, voffA);
    if (wr == 1) PG8_BAR;
    PG8_WAIT_V(2); PG8_BAR;
    PG8_STAGE(PG8_SB(1, 0), cB + kstep, voffB); PG8_STAGE(PG8_SA(1, 0), cA + kstep, voffA); PG8_STAGE(PG8_SB(1, 1), cB + hstepB + kstep, voffB);
    PG8_WAIT_V(6); PG8_BAR;
    for (;;) {
        const bool has_next = S.next(ui + 1, nxt);
        const char* nA = has_next ? (const char*)g.A + (size_t)nxt.pm * tstepA + (size_t)nxt.kofs * 2 : cA; const char* nB = has_next ? (const char*)g.Bt + (size_t)nxt.pn * tstepB + (size_t)nxt.kofs * 2 : cB;
        for (int t = 0; t < nt; t += 2) {
            const bool last = (t == nt - 2);
            const char* a1 = cA + (size_t)(t + 1) * kstep;
            const char* a2 = last ? nA : cA + (size_t)(t + 2) * kstep; const char* b2 = last ? nB : cB + (size_t)(t + 2) * kstep;
            const char* a3 = a2 + kstep; const char* b3 = b2 + kstep;
            PG8_LDB(B0, 0, 0); PG8_LDB(B1, 0, 1); PG8_SCHED; PG8_LDA(At, 0, 0); PG8_STAGE(PG8_SA(1, 1), a1 + hstepA, voffA);
            PG8_WAIT_V(8); PG8_WAIT_L(0); PG8_BAR; PG8_MMA(0, 0, At, B0); PG8_MMA(0, 1, At, B1); PG8_BAR; PG8_SCHED;
            PG8_LDA(At, 0, 1); PG8_STAGE(PG8_SB(0, 0), b2, voffB); PG8_STAGE(PG8_SB(0, 1), b2 + hstepB, voffB); PG8_STAGE(PG8_SA(0, 0), a2, voffA);
            PG8_WAIT_V(8); PG8_WAIT_L(0); PG8_BAR; PG8_MMA(1, 0, At, B0); PG8_MMA(1, 1, At, B1); PG8_BAR; PG8_SCHED;
            PG8_LDB(B0, 1, 0); PG8_LDB(B1, 1, 1); PG8_SCHED; PG8_LDA(At, 1, 0); PG8_STAGE(PG8_SA(0, 1), a2 + hstepA, voffA);
            PG8_WAIT_V(8); PG8_WAIT_L(0); PG8_BAR; PG8_MMA(0, 0, At, B0); PG8_MMA(0, 1, At, B1); PG8_BAR; PG8_SCHED;
            PG8_LDA(At, 1, 1); PG8_STAGE(PG8_SB(1, 0), b3, voffB); PG8_STAGE(PG8_SB(1, 1), b3 + hstepB, voffB); PG8_STAGE(PG8_SA(1, 0), a3, voffA);
            PG8_WAIT_V(8); PG8_WAIT_L(0); PG8_BAR; PG8_MMA(1, 0, At, B0); PG8_MMA(1, 1, At, B1); PG8_BAR; PG8_SCHED;
        }
        if (wr == 0) PG8_BAR;
        E(acc, cur, wr, wc, fr, fq);
        if (!has_next) break;
        if (!cur.keep) {
#pragma unroll
            for (int a = 0; a < 2; ++a)
#pragma unroll
                for (int b = 0; b < 2; ++b)
#pragma unroll
                    for (int m = 0; m < 4; ++m)
#pragma unroll
                        for (int n = 0; n < 2; ++n) acc[a][b][m][n] = (f32x4){0.f, 0.f, 0.f, 0.f};
        }
        cur = nxt; cA = nA; cB = nB; ++ui;
        if (wr == 1) PG8_BAR;
    }
    PG8_WAIT_V(0);
    PG8_BAR;
#undef PG8_SA
#undef PG8_SB
#undef PG8_STAGE
#undef PG8_LDA
#undef PG8_LDB
#undef PG8_MMA
#undef PG8_WAIT_V
#undef PG8_WAIT_L
#undef PG8_BAR
#undef PG8_SCHED
}
}

struct EpiInProj {
    bf16_t* ACT; bf16_t* VT; bf16_t* GB; float* out; const float* qng; const float* kng; const float* rope;
    __device__ __forceinline__ void operator()(f32x4 (&acc)[2][2][4][2], const pg8::Unit& u, int wr, int wc, int fr, int fq) const {
        const int pn = u.pn;
        int type = 0, slot = 0;
        if (pn < 2) { type = 1; slot = 4 * pn + wc; }
        else if (pn == 2 || (pn == 3 && wc < 2)) { type = 2; slot = 4 * (pn - 2) + wc; }
        else if (pn == 3 || pn == 4) { type = 3; slot = 4 * (pn - 3) + wc - 2; }
        const int rbase = u.pm * 256 + wr * 64 + fr;
        if (type == 1 || type == 2) {
            const float* gn = (type == 1) ? qng : kng;
            f32x4 g4[2][2];
#pragma unroll
            for (int bj = 0; bj < 2; ++bj)
#pragma unroll
                for (int n = 0; n < 2; ++n) g4[bj][n] = *(const f32x4*)(gn + 32 * bj + 16 * n + 4 * fq);
            const int br = slot >> 1, kvh = slot & 1;
#pragma unroll
            for (int ai = 0; ai < 2; ++ai)
#pragma unroll
                for (int m = 0; m < 4; ++m) {
                    const int row = rbase + ai * 128 + m * 16;
                    float ss = 0.f;
#pragma unroll
                    for (int bj = 0; bj < 2; ++bj)
#pragma unroll
                        for (int n = 0; n < 2; ++n) { const f32x4 v = acc[ai][bj][m][n]; ss += (v[0] * v[0] + v[1] * v[1]) + (v[2] * v[2] + v[3] * v[3]); }
                    ss += __shfl_xor(ss, 16); ss += __shfl_xor(ss, 32);
                    const float rinv = __builtin_amdgcn_rsqf(ss * (1.0f / 64.0f) + 1e-6f);
                    const int pos = (row < MP) ? (row & (SEQ - 1)) : SEQ;
                    const bool live = row < MTOT;
                    long obase = -1;
                    if (type == 2 && live) {
                        if (row < MP) {
                            const int t = row & (SEQ - 1), b = row >> 11;
                            if (br == 0) obase = (long)O_PKC + (long)row * 128 + kvh * 64;
                            else if (br == 1) obase = (long)O_PKS + (long)row * 128 + kvh * 64;
                            else if (t >= 1536) obase = (long)O_PKW + ((long)(b * 512 + t - 1536) * 2 + kvh) * 64;
                        } else {
                            const int sb = row - MP;
                            if (br == 0) obase = (long)O_SKC + sb * 128 + kvh * 64;
                            else if (br == 1) obase = (long)O_SKS + sb * 128 + kvh * 64;
                            else obase = (long)O_SKW + ((long)(sb * 512 + 511) * 2 + kvh) * 64;
                        }
                    }
#pragma unroll
                    for (int n = 0; n < 2; ++n) {
                        const f32x4 cs0 = *(const f32x4*)(rope + ((size_t)pos * 32 + 16 * n + 4 * fq) * 2);
                        const f32x4 cs1 = *(const f32x4*)(rope + ((size_t)pos * 32 + 16 * n + 4 * fq) * 2 + 4);
                        const float cc[4] = {cs0[0], cs0[2], cs1[0], cs1[2]}, sn[4] = {cs0[1], cs0[3], cs1[1], cs1[3]};
                        f32x4 o0, o1;
#pragma unroll
                        for (int j = 0; j < 4; ++j) {
                            const float y0 = acc[ai][0][m][n][j] * rinv * g4[0][n][j], y1 = acc[ai][1][m][n][j] * rinv * g4[1][n][j];
                            o0[j] = y0 * cc[j] - y1 * sn[j]; o1[j] = y1 * cc[j] + y0 * sn[j];
                        }
                        if (live) {
                            const int dcol = 16 * n + 4 * fq;
                            if (type == 1) {
                                bf16_t* p = ACT + (size_t)row * NIN + LQ + 64 * slot + dcol;
                                u32x2 w0, w1; w0.x = cvt_pk_bf16(o0[0] * C2Q, o0[1] * C2Q); w0.y = cvt_pk_bf16(o0[2] * C2Q, o0[3] * C2Q); w1.x = cvt_pk_bf16(o1[0] * C2Q, o1[1] * C2Q); w1.y = cvt_pk_bf16(o1[2] * C2Q, o1[3] * C2Q);
                                *(u32x2*)p = w0; *(u32x2*)(p + 32) = w1;
                            } else {
                                bf16_t* p = ACT + (size_t)row * NIN + LK + 64 * slot + dcol;
                                u32x2 w0, w1; w0.x = cvt_pk_bf16(o0[0], o0[1]); w0.y = cvt_pk_bf16(o0[2], o0[3]); w1.x = cvt_pk_bf16(o1[0], o1[1]); w1.y = cvt_pk_bf16(o1[2], o1[3]);
                                *(u32x2*)p = w0; *(u32x2*)(p + 32) = w1;
                                if (obase >= 0) { *(f32x4*)(out + obase + dcol) = o0; *(f32x4*)(out + obase + 32 + dcol) = o1; }
                            }
                        }
                    }
                }
        } else if (type == 3) {
            const int br = slot >> 1, kvh = slot & 1;
#pragma unroll
            for (int ai = 0; ai < 2; ++ai)
#pragma unroll
                for (int m = 0; m < 4; ++m) {
                    const int row = rbase + ai * 128 + m * 16;
                    if (row < MTOT) {
                        long obase = -1;
                        if (row < MP) {
                            const int t = row & (SEQ - 1), b = row >> 11;
                            if (br == 0) obase = (long)O_PVC + (long)row * 128 + kvh * 64;
                            else if (br == 1) obase = (long)O_PVS + (long)row * 128 + kvh * 64;
                            else if (t >= 1536) obase = (long)O_PVW + ((long)(b * 512 + t - 1536) * 2 + kvh) * 64;
                            bf16_t* vt = VT + ((size_t)(b * 6 + slot) * 64) * SEQ + t;
#pragma unroll
                            for (int bj = 0; bj < 2; ++bj)
#pragma unroll
                                for (int n = 0; n < 2; ++n)
#pragma unroll
                                    for (int j = 0; j < 4; ++j) vt[(size_t)(32 * bj + 16 * n + 4 * fq + j) * SEQ] = (bf16_t)f2bf(acc[ai][bj][m][n][j]);
                        } else {
                            const int sb = row - MP;
                            if (br == 0) obase = (long)O_SVC + sb * 128 + kvh * 64;
                            else if (br == 1) obase = (long)O_SVS + sb * 128 + kvh * 64;
                            else obase = (long)O_SVW + ((long)(sb * 512 + 511) * 2 + kvh) * 64;
                        }
                        if (obase >= 0) {
#pragma unroll
                            for (int bj = 0; bj < 2; ++bj)
#pragma unroll
                                for (int n = 0; n < 2; ++n) *(f32x4*)(out + obase + 32 * bj + 16 * n + 4 * fq) = acc[ai][bj][m][n];
                        }
                    }
                }
        } else if (pn >= 13 && pn <= 20) {
            bf16_t* gp = GB + ((size_t)((u.pm * 8 + (pn - 13)) * 8 + wr * 4 + wc) * 32) * 256 + (size_t)(fq * 16 + fr) * 4;
#pragma unroll
            for (int ai = 0; ai < 2; ++ai)
#pragma unroll
                for (int m = 0; m < 4; ++m)
#pragma unroll
                    for (int bj = 0; bj < 2; ++bj)
#pragma unroll
                        for (int n = 0; n < 2; ++n) {
                            const f32x4 v = acc[ai][bj][m][n];
                            u32x2 w; w.x = cvt_pk_bf16(sigmoidf_(v[0]), sigmoidf_(v[1])); w.y = cvt_pk_bf16(sigmoidf_(v[2]), sigmoidf_(v[3]));
                            *(u32x2*)(gp + (size_t)(((ai * 4 + m) * 2 + bj) * 2 + n) * 256) = w;
                        }
        } else {
            const int mode = (pn <= 6) ? 1 : (pn <= 10) ? 0 : (pn <= 12) ? 1 : 2;
#pragma unroll
            for (int ai = 0; ai < 2; ++ai)
#pragma unroll
                for (int m = 0; m < 4; ++m) {
                    const int row = rbase + ai * 128 + m * 16;
                    if (row < MTOT) {
                        bf16_t* p = ACT + (size_t)row * NIN + 256 * pn + 64 * wc + 4 * fq;
#pragma unroll
                        for (int bj = 0; bj < 2; ++bj)
#pragma unroll
                            for (int n = 0; n < 2; ++n) {
                                f32x4 v = acc[ai][bj][m][n];
#pragma unroll
                                for (int j = 0; j < 4; ++j) { const float sg = sigmoidf_(v[j]); v[j] = (mode == 0) ? v[j] : (mode == 1) ? v[j] * sg : sg; }
                                u32x2 w; w.x = cvt_pk_bf16(v[0], v[1]); w.y = cvt_pk_bf16(v[2], v[3]);
                                *(u32x2*)(p + 32 * bj + 16 * n) = w;
                            }
                    }
                }
        }
    }
};

struct EpiMix {
    const bf16_t* GB; bf16_t* M;
    __device__ __forceinline__ void operator()(f32x4 (&acc)[2][2][4][2], const pg8::Unit& u, int wr, int wc, int fr, int fq) const {
        const int rbase = u.pm * 256 + wr * 64 + fr, cbase = u.pn * 256 + 64 * wc + 4 * fq;
        const bf16_t* ga = GB + ((size_t)((u.pm * 8 + u.pn) * 8 + wr * 4 + wc) * 32) * 256 + (size_t)(fq * 16 + fr) * 4;
        const bf16_t* gb = ga + (size_t)4 * 8 * 32 * 256;
#pragma unroll
        for (int ai = 0; ai < 2; ++ai)
#pragma unroll
            for (int m = 0; m < 4; ++m) {
                const int row = rbase + ai * 128 + m * 16;
#pragma unroll
                for (int bj = 0; bj < 2; ++bj)
#pragma unroll
                    for (int n = 0; n < 2; ++n) {
                        const int fo = (((ai * 4 + m) * 2 + bj) * 2 + n) * 256;
                        float sb[4]; unpack4(*(const u32x2*)(gb + fo), sb);
                        if (u.keep) {
                            float sa[4]; unpack4(*(const u32x2*)(ga + fo), sa);
#pragma unroll
                            for (int j = 0; j < 4; ++j) acc[ai][bj][m][n][j] *= sa[j] * __builtin_amdgcn_rcpf(sb[j]);
                        } else if (row < MP) {
                            const f32x4 v = acc[ai][bj][m][n];
                            u32x2 w; w.x = cvt_pk_bf16(v[0] * sb[0], v[1] * sb[1]); w.y = cvt_pk_bf16(v[2] * sb[2], v[3] * sb[3]);
                            *(u32x2*)(M + (size_t)row * DM + cbase + 32 * bj + 16 * n) = w;
                        }
                    }
            }
    }
};

struct EpiOut {
    const float* xp; const float* xs; const float* MOD; float* out;
    __device__ __forceinline__ void operator()(f32x4 (&acc)[2][2][4][2], const pg8::Unit& u, int wr, int wc, int fr, int fq) const {
        const int rbase = u.pm * 256 + wr * 64 + fr, cbase = u.pn * 256 + wc * 32 + 4 * fq;
#pragma unroll
        for (int ai = 0; ai < 2; ++ai)
#pragma unroll
            for (int m = 0; m < 4; ++m) {
                const int row = rbase + ai * 128 + m * 16;
                if (row < MTOT) {
                    const float* xr; const float* gr; float* orow;
                    if (row < MP) { xr = xp + (size_t)row * DM; gr = MOD + (size_t)(row >> 11) * 3072 + 2048; orow = out + O_YP + (size_t)row * DM; }
                    else { const int sb = row - MP; xr = xs + (size_t)sb * DM; gr = MOD + (size_t)(8 + sb) * 3072 + 2048; orow = out + O_YS + (size_t)sb * DM; }
#pragma unroll
                    for (int bj = 0; bj < 2; ++bj)
#pragma unroll
                        for (int n = 0; n < 2; ++n) {
                            const int col = cbase + 128 * bj + 16 * n;
                            const f32x4 xv = *(const f32x4*)(xr + col), gv = *(const f32x4*)(gr + col);
                            *(f32x4*)(orow + col) = xv + gv * acc[ai][bj][m][n];
                        }
                }
            }
    }
};

__device__ __forceinline__ void transpose_item(const float* src, int src_ld, int nvalid, bf16_t* dst, int dst_ld, LAS float* scr, int lane) {
    float tv[32];
#pragma unroll
    for (int i = 0; i < 32; ++i) { const int kk = 2 * i + (lane >> 5), cc = lane & 31; tv[i] = src[(size_t)kk * src_ld + (cc < nvalid ? cc : 0)]; }
#pragma unroll
    for (int i = 0; i < 32; ++i) { const int kk = 2 * i + (lane >> 5), cc = lane & 31; scr[kk * 33 + cc] = (cc < nvalid) ? tv[i] : 0.f; }
    asm volatile("s_waitcnt lgkmcnt(0)" ::: "memory");
    const int c = lane & 7;
#pragma unroll
    for (int j = 0; j < 4; ++j) { const int n = (lane >> 3) + 8 * j; const LAS float* s = scr + (8 * c) * 33 + n;
        u32x4 o; o.x = pk2(s[0 * 33], s[1 * 33]); o.y = pk2(s[2 * 33], s[3 * 33]); o.z = pk2(s[4 * 33], s[5 * 33]); o.w = pk2(s[6 * 33], s[7 * 33]);
        *(u32x4*)(dst + (size_t)n * dst_ld + 8 * c) = o; }
    asm volatile("s_waitcnt lgkmcnt(0)" ::: "memory");
}

__device__ __forceinline__ void p0_prologue(const Params& P, LAS unsigned char* lds, int gw, int NGW, int lane_p, int wave, int gtid, int NT) {
    unsigned char* ws = P.ws;
    LAS float* scr = (LAS float*)(lds + wave * 16384);
    constexpr int I_MOD = 9 * 48, I_WIN = 16 * 176, I_WBR = 16 * 32, I_WOUT = 16 * 32, I_POOL = NSB * 16 * 2;
    constexpr int I_TOTAL = I_MOD + I_WIN + I_WBR + I_WOUT + I_POOL;
    constexpr int I_TR = I_WIN + I_WBR + I_WOUT;
    const bool modw = gw < I_MOD; const int NO = NGW - I_MOD, io = gw - I_MOD;
    for (int stp = 0;; ++stp) {
        int it;
        if (NGW < 2 * I_MOD) { it = gw + stp * NGW; if (it >= I_TOTAL) break; }
        else if (modw) { if (stp == 0) it = gw; else if (stp == 1) it = I_MOD + I_TR + gw; else break; }
        else { const int r = io + stp * NO; if (r >= I_TR + (I_POOL - I_MOD)) break; it = (r < I_TR) ? I_MOD + r : I_MOD + I_TR + I_MOD + (r - I_TR); }
        int lane = lane_p; asm volatile("" : "+v"(lane));
        if (it < I_MOD) {
            const int mt = it / 48, ng = it % 48, lr = lane & 15, kq = lane >> 4;
            int arow_i = 16 * mt + lr; if (arow_i > 135) arow_i = 135;
            const float* arow = ((arow_i < 8) ? P.in[9] + (size_t)arow_i * DM : P.in[10] + (size_t)(arow_i - 8) * DM) + 4 * kq;
            const float* bp = P.in[11] + (size_t)(4 * kq) * 3072 + 64 * ng + 4 * lr;
            f32x4 macc[4];
#pragma unroll
            for (int nt = 0; nt < 4; ++nt) macc[nt] = (f32x4){0.f, 0.f, 0.f, 0.f};
            f32x4 a0[4], b0[16], a1[4], b1[16];
#define MOD_LOAD(A_, B_, k0) do { _Pragma("unroll") for (int j = 0; j < 4; ++j) { A_[j] = *(const f32x4*)(arow + (k0) + 16 * j); \
                _Pragma("unroll") for (int e = 0; e < 4; ++e) B_[4 * j + e] = *(const f32x4*)(bp + (size_t)((k0) + 16 * j + e) * 3072); } } while (0)
#define MOD_MMA(A_, B_) do { _Pragma("unroll") for (int j = 0; j < 4; ++j) _Pragma("unroll") for (int e = 0; e < 4; ++e) _Pragma("unroll") for (int nt = 0; nt < 4; ++nt) \
                macc[nt] = __builtin_amdgcn_mfma_f32_16x16x4f32(A_[j][e], B_[4 * j + e][nt], macc[nt], 0, 0, 0); } while (0)
            MOD_LOAD(a0, b0, 0);
            for (int k0 = 0; k0 < DM; k0 += 128) {
                MOD_LOAD(a1, b1, k0 + 64);
                __builtin_amdgcn_sched_barrier(0);
                MOD_MMA(a0, b0);
                __builtin_amdgcn_sched_barrier(0);
                if (k0 + 128 < DM) MOD_LOAD(a0, b0, k0 + 128);
                __builtin_amdgcn_sched_barrier(0);
                MOD_MMA(a1, b1);
                __builtin_amdgcn_sched_barrier(0);
            }
#undef MOD_LOAD
#undef MOD_MMA
            float* MOD = (float*)(ws + WS_MOD);
            const f32x4 bb = *(const f32x4*)(P.in[12] + 64 * ng + 4 * lr);
#pragma unroll
            for (int r = 0; r < 4; ++r) { const int row = 16 * mt + 4 * kq + r;
                if (row < 136) *(f32x4*)(MOD + (size_t)row * 3072 + 64 * ng + 4 * lr) = (f32x4){macc[0][r] + bb[0], macc[1][r] + bb[1], macc[2][r] + bb[2], macc[3][r] + bb[3]}; }
            continue;
        }
        it -= I_MOD;
        if (it < I_WIN) {
            const int kb = it / 176, nb = it % 176;
            const int pn = nb >> 3, bj = (nb >> 2) & 1, wc = nb & 3;
            const int L0 = 256 * pn + 64 * wc + 32 * bj;
            int srcc, nvalid;
            if (L0 < 1280) { srcc = L0; nvalid = 32; } else if (L0 < LNSA) { srcc = L0 + 24; nvalid = 32; } else if (L0 == LNSA) { srcc = 1280; nvalid = 24; } else { srcc = 0; nvalid = 0; }
            transpose_item(P.in[14] + (size_t)(64 * kb) * 5400 + srcc, 5400, nvalid, (bf16_t*)(ws + WS_WTIN) + (size_t)(32 * nb) * DM + 64 * kb, DM, scr, lane);
            continue;
        }
        it -= I_WIN;
        if (it < I_WBR) {
            const int kb = it / 32, nb = it % 32;
            const float* src = (kb < 8) ? P.in[25] + (size_t)(64 * kb) * DM : P.in[26] + (size_t)(64 * (kb - 8)) * DM;
            const int L0 = 256 * (nb >> 3) + 64 * (nb & 3) + 32 * ((nb >> 2) & 1);
            transpose_item(src + L0, DM, 32, (bf16_t*)(ws + WS_WTBR) + (size_t)(32 * nb) * DM + 64 * kb, DM, scr, lane);
            continue;
        }
        it -= I_WBR;
        if (it < I_WOUT) {
            const int kb = it / 32, nb = it % 32;
            transpose_item(P.in[27] + (size_t)(64 * kb) * DM + 32 * nb, DM, 32, (bf16_t*)(ws + WS_WTOUT) + (size_t)(32 * nb) * DM + 64 * kb, DM, scr, lane);
            continue;
        }
        it -= I_WOUT;
        {
            const int sb = it >> 5, pg = (it >> 1) & 15, which = it & 1;
            const int page = ((const int*)P.in[8])[sb * 16 + pg];
            const float* src = P.in[2 + which] + (size_t)page * 128 * 128;
            const float* pe = P.in[17 + which]; const float* w = P.in[19 + which];
            const int d0 = (2 * lane) & 63;
            float p0 = 0.f, p1 = 0.f;
#pragma unroll 8
            for (int r = 0; r < 32; ++r) { const f32x2 v = *(const f32x2*)(pe + r * 64 + d0); p0 += v[0]; p1 += v[1]; }
#pragma unroll
            for (int cb = 0; cb < 4; ++cb) {
                f32x2 v[32];
#pragma unroll
                for (int r = 0; r < 32; ++r) v[r] = __builtin_nontemporal_load((const f32x2*)(src + (size_t)(cb * 32 + r) * 128 + 2 * lane));
                float s0 = 0.f, s1 = 0.f;
#pragma unroll
                for (int r = 0; r < 32; ++r) { s0 += v[r][0]; s1 += v[r][1]; }
                scr[d0 * 8 + cb * 2 + (lane >> 5)] = (s0 + p0) * (1.0f / 32.0f); scr[(d0 + 1) * 8 + cb * 2 + (lane >> 5)] = (s1 + p1) * (1.0f / 32.0f);
            }
            asm volatile("s_waitcnt lgkmcnt(0)" ::: "memory");
            float a[8];
#pragma unroll
            for (int q = 0; q < 8; ++q) a[q] = 0.f;
#pragma unroll 8
            for (int d = 0; d < 64; ++d) { const float wv = w[d * 64 + lane]; const f32x4 pa = *(const LAS f32x4*)(scr + d * 8), pb = *(const LAS f32x4*)(scr + d * 8 + 4);
                a[0] += pa[0] * wv; a[1] += pa[1] * wv; a[2] += pa[2] * wv; a[3] += pa[3] * wv; a[4] += pb[0] * wv; a[5] += pb[1] * wv; a[6] += pb[2] * wv; a[7] += pb[3] * wv; }
            float* dst = (float*)(ws + (which ? WS_VCS : WS_KCS));
#pragma unroll
            for (int q = 0; q < 8; ++q) dst[((size_t)(sb * 2 + (q & 1)) * 64 + 4 * pg + (q >> 1)) * 64 + lane] = a[q];
            asm volatile("s_waitcnt lgkmcnt(0)" ::: "memory");
        }
    }
    float* rope = (float*)(ws + WS_ROPE);
    for (int i = gtid; i < 2049 * 32; i += NT) {
        const int pos = i >> 5, k = i & 31;
        double invd = 1.0;
        for (int q = 0; q < k; ++q) invd *= 0.7498942093324559;
        const float ang = (float)pos * (float)invd;
        const double rev = (double)ang * 0.15915494309189535;
        const float fr = (float)(rev - __builtin_rint(rev));
        rope[2 * i] = __builtin_amdgcn_cosf(fr); rope[2 * i + 1] = __builtin_amdgcn_sinf(fr);
    }
    bf16_t* tril = (bf16_t*)(ws + WS_TRIL);
    for (int i = gtid; i < 4 * 128 * 128; i += NT) { const int r = (i >> 7) & 127, cidx = i & 127; tril[i] = (cidx <= r) ? (bf16_t)f2bf(P.in[23][i]) : (bf16_t)0; }
    for (int tk = blockIdx.x; tk < 2 * NSB * 2; tk += gridDim.x) {
        const int w2 = tk >> 8, sb = (tk >> 1) & 127, half = tk & 1;
        const f32x4* src = (const f32x4*)P.in[6 + w2] + (size_t)sb * 512 * 32 + 32 + half * 8176; f32x4* dst = (f32x4*)(P.out + (w2 ? O_SVW : O_SKW)) + (size_t)sb * 512 * 32 + half * 8176;
        f32x4 cv[16];
#pragma unroll
        for (int u = 0; u < 16; ++u) { const int i = threadIdx.x + 512 * u; if (i < 8176) cv[u] = __builtin_nontemporal_load(src + i); }
#pragma unroll
        for (int u = 0; u < 16; ++u) { const int i = threadIdx.x + 512 * u; if (i < 8176) __builtin_nontemporal_store(cv[u], dst + i); }
    }
}

__device__ __forceinline__ void p1_hrows(const Params& P, int gw, int NGW, int lane) {
    const float* MOD = (const float*)(P.ws + WS_MOD); bf16_t* H = (bf16_t*)(P.ws + WS_H); const float* ng = P.in[13];
    for (int row = gw; row < MPAD; row += NGW) {
        unsigned long long* o8 = (unsigned long long*)(H + (size_t)row * DM) + lane;
        if (row >= MTOT) {
#pragma unroll
            for (int j = 0; j < 4; ++j) o8[64 * j] = 0ull;
            continue; }
        const float* xr; const float* md;
        if (row < MP) { xr = P.in[0] + (size_t)row * DM; md = MOD + (size_t)(row >> 11) * 3072; } else { xr = P.in[1] + (size_t)(row - MP) * DM; md = MOD + (size_t)(8 + row - MP) * 3072; }
        f32x4 v[4]; float s = 0.f;
#pragma unroll
        for (int j = 0; j < 4; ++j) { v[j] = ((const f32x4*)xr)[lane + 64 * j]; s += (v[j][0] * v[j][0] + v[j][1] * v[j][1]) + (v[j][2] * v[j][2] + v[j][3] * v[j][3]); }
        const float rstd = rsqrtf(wave_sum(s) * (1.0f / DM) + 1e-6f);
#pragma unroll
        for (int j = 0; j < 4; ++j) {
            const int col = 4 * lane + 256 * j;
            const f32x4 g = *(const f32x4*)(ng + col), sh = *(const f32x4*)(md + col), sc = *(const f32x4*)(md + 1024 + col);
            const f32x4 h = (v[j] * rstd) * g * (sc + 1.0f) + sh;
            o8[64 * j] = (unsigned long long)pk2(h[0], h[1]) | ((unsigned long long)pk2(h[2], h[3]) << 32);
        }
    }
}

__device__ __forceinline__ void p3_compress(const Params& P, LAS unsigned char* lds, int gw, int NGW, int lane, int wave) {
    LAS float* scr = (LAS float*)(lds + wave * 1024);
    for (int it = gw; it < NBATCH * 64 * 2 * 2; it += NGW) {
        const int b = it >> 8, c = (it >> 2) & 63, kvh = (it >> 1) & 1, which = it & 1;
        const float* src = P.out + (which ? O_PVC : O_PKC) + ((size_t)(b * SEQ + 32 * c) * 2 + kvh) * 64;
        const float* pe = P.in[17 + which]; const float* w = P.in[19 + which];
        float s = 0.f;
#pragma unroll 8
        for (int r = 0; r < 32; ++r) s += src[(size_t)r * 128 + lane] + pe[r * 64 + lane];
        scr[lane] = s * (1.0f / 32.0f);
        asm volatile("s_waitcnt lgkmcnt(0)" ::: "memory");
        float a = 0.f;
#pragma unroll 8
        for (int d = 0; d < 64; ++d) a += scr[d] * w[d * 64 + lane];
        if (which == 0) ((bf16_t*)(P.ws + WS_KC))[((size_t)(b * 64 + c) * 2 + kvh) * 64 + lane] = (bf16_t)f2bf(a);
        else ((bf16_t*)(P.ws + WS_VCT))[((size_t)(b * 2 + kvh) * 64 + lane) * 64 + c] = (bf16_t)f2bf(a);
        asm volatile("s_waitcnt lgkmcnt(0)" ::: "memory");
    }
}

constexpr int A_TILE = 32768, A_IMP = 3 * A_TILE, A_IMPS = A_IMP + 8 * 32 * 33 * 4, A_SEL = A_IMPS + 2 * 32 * 33 * 4;
static_assert(A_SEL + 256 <= LDS_XB, "attention LDS map");
#define ATT_BAR() do { asm volatile("s_waitcnt lgkmcnt(0)" ::: "memory"); __builtin_amdgcn_s_barrier(); asm volatile("" ::: "memory"); } while (0)

struct TileSrc { const bf16_t* kb; const bf16_t* v0; const bf16_t* v1; unsigned kpitch, vpitch; };
__device__ __forceinline__ TileSrc attn_tile_src(const Params& P, int b, int T, int n_slc, int lo) {
    TileSrc s;
    if (T == 0) { s.kb = (const bf16_t*)(P.ws + WS_KC) + (size_t)b * 64 * 128; s.v0 = (const bf16_t*)(P.ws + WS_VCT) + (size_t)(b * 2) * 4096; s.v1 = s.v0 + 4096; s.kpitch = 128; s.vpitch = 64; }
    else {
        const bool slc = T <= n_slc; const int j = slc ? T - 1 : lo + (T - 1 - n_slc), br = slc ? 1 : 2;
        s.kb = (const bf16_t*)(P.ws + WS_ACT) + ((size_t)b * SEQ + 64 * j) * NIN + LK + 128 * br;
        s.v0 = (const bf16_t*)(P.ws + WS_VT) + ((size_t)(b * 6 + 2 * br) * 64) * SEQ + 64 * j; s.v1 = s.v0 + (size_t)64 * SEQ; s.kpitch = NIN; s.vpitch = SEQ;
    }
    return s;
}
__device__ __forceinline__ void attn_dma(LAS unsigned char* buf, const TileSrc& s, int wave, int lane_in) {
    int lane = lane_in; asm volatile("" : "+v"(lane));
    const int r = 8 * wave + (lane >> 3), ch = (lane & 7) ^ (lane >> 3);
#pragma unroll
    for (int i = 0; i < 2; ++i) {
        __builtin_amdgcn_global_load_lds((const unsigned*)(s.kb + (size_t)r * s.kpitch + i * 64 + ch * 8), (LAS unsigned*)(buf + (wave + 8 * i) * 1024), 16, 0, 0);
        __builtin_amdgcn_global_load_lds((const unsigned*)((i ? s.v1 : s.v0) + (size_t)r * s.vpitch + ch * 8), (LAS unsigned*)(buf + 16384 + (wave + 8 * i) * 1024), 16, 0, 0);
    }
}

constexpr float ATT_M0 = -30.f, ATT_THR = 12.f;
template <int MODE>
__device__ __forceinline__ void attn_tile(const LAS unsigned char* Kg, const LAS unsigned char* Vg, const bf16x8 (&qf)[2][2], f32x4 (&O)[4][2], float (&mrun)[2], float (&lrun)[2], f32x4 (&s)[2][4],
                                          int lane_in, int kbase, const int (&qpos)[2], const float (&cinit)[2], bool emask) {
    int lane = lane_in; asm volatile("" : "+v"(lane));
    const int lr = lane & 15, grp = lane >> 4, sw = lr & 7;
    const float c0[2] = {cinit[0] - mrun[0], cinit[1] - mrun[1]};
#pragma unroll
    for (int kt = 0; kt < 4; ++kt) {
        const bf16x8 k0 = *(const LAS bf16x8*)(Kg + (16 * kt + lr) * 128 + ((grp ^ sw) << 4));
        const bf16x8 k1 = *(const LAS bf16x8*)(Kg + (16 * kt + lr) * 128 + (((4 + grp) ^ sw) << 4));
#pragma unroll
        for (int qt = 0; qt < 2; ++qt) {
            const f32x4 a = __builtin_amdgcn_mfma_f32_16x16x32_bf16(k0, qf[qt][0], (f32x4){c0[qt], c0[qt], c0[qt], c0[qt]}, 0, 0, 0);
            s[qt][kt] = __builtin_amdgcn_mfma_f32_16x16x32_bf16(k1, qf[qt][1], a, 0, 0, 0);
        }
    }
    bf16x8 vf[2][4];
#pragma unroll
    for (int c2 = 0; c2 < 2; ++c2)
#pragma unroll
        for (int dt = 0; dt < 4; ++dt) {
            const LAS unsigned char* vr = Vg + (16 * dt + lr) * 128 + 8 * (grp & 1);
            const u32x2 lo = *(const LAS u32x2*)(vr + (((4 * c2 + (grp >> 1)) ^ sw) << 4));
            const u32x2 hi = *(const LAS u32x2*)(vr + (((4 * c2 + 2 + (grp >> 1)) ^ sw) << 4));
            const u32x4 vv = {lo.x, lo.y, hi.x, hi.y};
            vf[c2][dt] = __builtin_bit_cast(bf16x8, vv);
        }
    if (emask) {
#pragma unroll
        for (int qt = 0; qt < 2; ++qt)
#pragma unroll
            for (int kt = 0; kt < 4; ++kt)
#pragma unroll
                for (int r = 0; r < 4; ++r) {
                    const int key = 16 * kt + 4 * grp + r;
                    bool valid;
                    if (MODE == 0) valid = key < ((qpos[qt] + 1) >> 5);
                    else if (MODE == 1) valid = (kbase + key <= qpos[qt]);
                    else { const int kp = kbase + key; valid = (kp <= qpos[qt]) && (kp > qpos[qt] - 512); }
                    s[qt][kt][r] = valid ? s[qt][kt][r] : NEGBIG;
                }
    }
    float mx[2];
#pragma unroll
    for (int qt = 0; qt < 2; ++qt) {
        float m0 = fmaxf(fmaxf(s[qt][0][0], s[qt][0][1]), fmaxf(s[qt][0][2], s[qt][0][3]));
#pragma unroll
        for (int kt = 1; kt < 4; ++kt) m0 = fmaxf(m0, fmaxf(fmaxf(s[qt][kt][0], s[qt][kt][1]), fmaxf(s[qt][kt][2], s[qt][kt][3])));
        m0 = fmaxf(m0, __shfl_xor(m0, 16)); mx[qt] = fmaxf(m0, __shfl_xor(m0, 32));
    }
    if (__any((int)(fmaxf(mx[0], mx[1]) > ATT_THR))) {
#pragma unroll
        for (int qt = 0; qt < 2; ++qt) {
            const float delta = fmaxf(mx[qt], 0.f), f = __builtin_amdgcn_exp2f(-delta);
            mrun[qt] += delta; lrun[qt] *= f;
#pragma unroll
            for (int dt = 0; dt < 4; ++dt) O[dt][qt] *= f;
#pragma unroll
            for (int kt = 0; kt < 4; ++kt) s[qt][kt] -= delta;
        }
    }
#pragma unroll
    for (int qt = 0; qt < 2; ++qt) {
        float ls = 0.f;
#pragma unroll
        for (int kt = 0; kt < 4; ++kt)
#pragma unroll
            for (int r = 0; r < 4; ++r) { const float p = __builtin_amdgcn_exp2f(s[qt][kt][r]); s[qt][kt][r] = p; ls += p; }
        lrun[qt] += ls;
#pragma unroll
        for (int c2 = 0; c2 < 2; ++c2) {
            u32x4 w; w.x = cvt_pk_bf16(s[qt][2 * c2][0], s[qt][2 * c2][1]); w.y = cvt_pk_bf16(s[qt][2 * c2][2], s[qt][2 * c2][3]);
            w.z = cvt_pk_bf16(s[qt][2 * c2 + 1][0], s[qt][2 * c2 + 1][1]); w.w = cvt_pk_bf16(s[qt][2 * c2 + 1][2], s[qt][2 * c2 + 1][3]);
            const bf16x8 pf = __builtin_bit_cast(bf16x8, w);
#pragma unroll
            for (int dt = 0; dt < 4; ++dt) O[dt][qt] = __builtin_amdgcn_mfma_f32_16x16x32_bf16(vf[c2][dt], pf, O[dt][qt], 0, 0, 0);
        }
    }
}

__device__ __forceinline__ void attn_unit(const Params& P, LAS unsigned char* lds, int b, int qb32, int tid, int lane, int wave) {
    asm volatile("" : "+v"(tid), "+v"(lane));
    const bf16_t* ACT = (const bf16_t*)(P.ws + WS_ACT); bf16_t* AB = (bf16_t*)(P.ws + WS_AB);
    const int lr = lane & 15, grp = lane >> 4, g = wave >> 2;
    const int t0 = 32 * qb32, qblk = t0 >> 6; const size_t row0 = (size_t)b * SEQ + t0;
    const int n_slc = qblk + 1, lo = (t0 - 511 > 0) ? ((t0 - 511) >> 6) : 0, NT = 1 + n_slc + (qblk - lo + 1);
    LAS float* IMP = (LAS float*)(lds + A_IMP); LAS float* IMPS = (LAS float*)(lds + A_IMPS); LAS unsigned* SEL = (LAS unsigned*)(lds + A_SEL);
    bf16x8 qf[2][2]; int qpos[2]; float gate[2][3];
#pragma unroll
    for (int qt = 0; qt < 2; ++qt) {
        const size_t row = row0 + 16 * qt + lr; qpos[qt] = t0 + 16 * qt + lr;
#pragma unroll
        for (int ks = 0; ks < 2; ++ks) qf[qt][ks] = *(const bf16x8*)(ACT + row * NIN + LQ + 64 * wave + 32 * ks + 8 * grp);
#pragma unroll
        for (int br = 0; br < 3; ++br) gate[qt][br] = bf2f(ACT[row * NIN + LNSA + 3 * wave + br]);
    }
    f32x4 O[4][2], OA[4][2], s[2][4]; float mrun[2], lrun[2]; unsigned selm[2] = {0u, 0u};
#pragma unroll
    for (int dt = 0; dt < 4; ++dt)
#pragma unroll
        for (int qt = 0; qt < 2; ++qt) { O[dt][qt] = (f32x4){0.f, 0.f, 0.f, 0.f}; OA[dt][qt] = (f32x4){0.f, 0.f, 0.f, 0.f}; }
    mrun[0] = mrun[1] = ATT_M0; lrun[0] = lrun[1] = 0.f;
#define ATT_FINISH(br) do { _Pragma("unroll") for (int qt = 0; qt < 2; ++qt) { float lt = lrun[qt]; lt += __shfl_xor(lt, 16); lt += __shfl_xor(lt, 32); \
        const float f = (lt > 0.f) ? gate[qt][br] / lt : 0.f; _Pragma("unroll") for (int dt = 0; dt < 4; ++dt) { OA[dt][qt] += O[dt][qt] * f; O[dt][qt] = (f32x4){0.f, 0.f, 0.f, 0.f}; } \
        mrun[qt] = ATT_M0; lrun[qt] = 0.f; } } while (0)
    const float czero[2] = {0.f, 0.f};
    ATT_BAR();
    { const TileSrc s0 = attn_tile_src(P, b, 0, n_slc, lo); attn_dma(lds, s0, wave, lane); }
    { const TileSrc s1 = attn_tile_src(P, b, 1, n_slc, lo); attn_dma(lds + A_TILE, s1, wave, lane); }
    asm volatile("s_waitcnt vmcnt(4)" ::: "memory");
    ATT_BAR();
    { const TileSrc s2 = attn_tile_src(P, b, 2, n_slc, lo); attn_dma(lds + 2 * A_TILE, s2, wave, lane); }
    {
        attn_tile<0>(lds + g * 8192, lds + 16384 + g * 8192, qf, O, mrun, lrun, s, lane, 0, qpos, czero, true);
#pragma unroll
        for (int qt = 0; qt < 2; ++qt) {
            float lt = lrun[qt]; lt += __shfl_xor(lt, 16); lt += __shfl_xor(lt, 32);
            const float inv = (lt > 0.f) ? 1.0f / lt : 0.f;
#pragma unroll
            for (int kt = 0; kt < 4; ++kt)
#pragma unroll
                for (int rr = 0; rr < 2; ++rr) IMP[(wave * 32 + 16 * qt + lr) * 33 + 8 * kt + 2 * grp + rr] = (s[qt][kt][2 * rr] + s[qt][kt][2 * rr + 1]) * inv;
        }
        ATT_FINISH(0);
        ATT_BAR();
        for (int i = tid; i < 2 * 32 * 32; i += 512) { const int gg = i >> 10, q = (i >> 5) & 31, j = i & 31;
            IMPS[(gg * 32 + q) * 33 + j] = (IMP[((4 * gg + 0) * 32 + q) * 33 + j] + IMP[((4 * gg + 1) * 32 + q) * 33 + j]) + (IMP[((4 * gg + 2) * 32 + q) * 33 + j] + IMP[((4 * gg + 3) * 32 + q) * 33 + j]); }
        ATT_BAR();
        if (tid < 64) {
            const int gg = tid >> 5, q = tid & 31;
            unsigned mask = 1u | (1u << qblk);
            if (qblk - 1 <= 6) mask = (qblk >= 31) ? 0xffffffffu : ((2u << qblk) - 1u);
            else {
                const LAS float* v = IMPS + (gg * 32 + q) * 33;
                for (int pick = 0; pick < 6; ++pick) { float best = -1.f; int bi = 1;
                    for (int j = 1; j < qblk; ++j) { const float x = v[j]; if (!((mask >> j) & 1u) && x > best) { best = x; bi = j; } }
                    mask |= 1u << bi; }
            }
            SEL[gg * 32 + q] = mask;
        }
        asm volatile("s_waitcnt vmcnt(4)" ::: "memory");
        ATT_BAR();
        selm[0] = SEL[g * 32 + lr]; selm[1] = SEL[g * 32 + 16 + lr];
    }
    int cur = 1, nxt = 0;
    for (int T = 1; T < NT; ++T) {
        const bool more = T + 2 < NT;
        if (more) { const TileSrc sn = attn_tile_src(P, b, T + 2, n_slc, lo); attn_dma(lds + nxt * A_TILE, sn, wave, lane); }
        const LAS unsigned char* Kg = lds + cur * A_TILE + g * 8192; const LAS unsigned char* Vg = Kg + 16384;
        if (T <= n_slc) {
            const int jb = T - 1;
            const float cin[2] = {((selm[0] >> jb) & 1u) ? 0.f : NEGBIG, ((selm[1] >> jb) & 1u) ? 0.f : NEGBIG};
            if (__any((int)(((selm[0] | selm[1]) >> jb) & 1u))) attn_tile<1>(Kg, Vg, qf, O, mrun, lrun, s, lane, 64 * jb, qpos, cin, jb == qblk);
            if (T == n_slc) ATT_FINISH(1);
        } else {
            const int jt = lo + (T - 1 - n_slc);
            const bool em = (64 * jt + 63 > t0) || (64 * jt <= t0 + 31 - 512);
            attn_tile<2>(Kg, Vg, qf, O, mrun, lrun, s, lane, 64 * jt, qpos, czero, em);
            if (T == NT - 1) ATT_FINISH(2);
        }
        if (more) asm volatile("s_waitcnt vmcnt(4)" ::: "memory"); else asm volatile("s_waitcnt vmcnt(0)" ::: "memory");
        ATT_BAR();
        cur = (cur == 2) ? 0 : cur + 1; nxt = (nxt == 2) ? 0 : nxt + 1;
    }
#undef ATT_FINISH
#pragma unroll
    for (int qt = 0; qt < 2; ++qt) {
        const size_t row = row0 + 16 * qt + lr;
#pragma unroll
        for (int dt = 0; dt < 4; ++dt) {
            const int col = 64 * wave + 16 * dt + 4 * grp;
            float za[4]; unpack4(*(const u32x2*)(ACT + row * NIN + LZA + col), za);
            u32x2 w; w.x = cvt_pk_bf16(OA[dt][qt][0] * za[0], OA[dt][qt][1] * za[1]); w.y = cvt_pk_bf16(OA[dt][qt][2] * za[2], OA[dt][qt][3] * za[3]);
            *(u32x2*)(AB + row * DM + col) = w;
        }
    }
}

constexpr int G_ST = 0, G_VNT = 1024, VPITCH = 136;
__device__ __forceinline__ void gmlp_unit(const Params& P, LAS unsigned char* lds, int b, int ch, int gp, int tid, int lane, int wave) {
    asm volatile("" : "+v"(tid), "+v"(lane));
    const bf16_t* ACT = (const bf16_t*)(P.ws + WS_ACT); bf16_t* AB = (bf16_t*)(P.ws + WS_AB);
    LAS f32x2* ST = (LAS f32x2*)(lds + G_ST); LAS bf16_t* Vnt = (LAS bf16_t*)(lds + G_VNT);
    const size_t R0 = (size_t)b * SEQ + 128 * ch;
    __syncthreads();
    {
        u32x4 raw[16];
#pragma unroll
        for (int i = 0; i < 16; ++i) raw[i] = *(const u32x4*)(ACT + (R0 + wave + 8 * i) * NIN + LVB + 8 * lane);
#pragma unroll
        for (int i = 0; i < 16; ++i) {
            float f[8]; f[0] = bf2f(raw[i].x); f[1] = bf2f(raw[i].x >> 16); f[2] = bf2f(raw[i].y); f[3] = bf2f(raw[i].y >> 16); f[4] = bf2f(raw[i].z); f[5] = bf2f(raw[i].z >> 16); f[6] = bf2f(raw[i].w); f[7] = bf2f(raw[i].w >> 16);
            float sm = 0.f, sq = 0.f;
#pragma unroll
            for (int e = 0; e < 8; ++e) { sm += f[e]; sq += f[e] * f[e]; }
#pragma unroll
            for (int o = 1; o < 64; o <<= 1) { sm += __shfl_xor(sm, o); sq += __shfl_xor(sq, o); }
            const float mean = sm * (1.0f / 512.0f), var = fmaxf(sq * (1.0f / 512.0f) - mean * mean, 0.f);
            if (lane == 0) ST[wave + 8 * i] = (f32x2){mean, rsqrtf(var + 1e-6f)};
        }
    }
    __syncthreads();
    {
        const float* vg = P.in[21] + 256 * gp; const float* vb = P.in[22] + 256 * gp;
        u32x4 raw[8];
#pragma unroll
        for (int i = 0; i < 8; ++i) { const int idx = tid + 512 * i, j = idx & 127, chn = idx >> 7; raw[i] = *(const u32x4*)(ACT + (R0 + j) * NIN + LVB + 256 * gp + 8 * chn); }
#pragma unroll
        for (int i = 0; i < 8; ++i) {
            const int idx = tid + 512 * i, j = idx & 127, chn = idx >> 7;
            const f32x2 st = ST[j];
            float f[8]; f[0] = bf2f(raw[i].x); f[1] = bf2f(raw[i].x >> 16); f[2] = bf2f(raw[i].y); f[3] = bf2f(raw[i].y >> 16); f[4] = bf2f(raw[i].z); f[5] = bf2f(raw[i].z >> 16); f[6] = bf2f(raw[i].w); f[7] = bf2f(raw[i].w >> 16);
#pragma unroll
            for (int e = 0; e < 8; ++e) { const int d = 8 * chn + e; Vnt[d * VPITCH + j] = (bf16_t)f2bf((f[e] - st[0]) * st[1] * vg[d] + vb[d]); }
        }
    }
    __syncthreads();
    const int lr = lane & 15, grp = lane >> 4, g = 2 * gp + (wave >> 2);
    const bf16_t* tril = (const bf16_t*)(P.ws + WS_TRIL) + (size_t)g * 128 * 128;
    f32x4 acc[2][8];
#pragma unroll
    for (int t2 = 0; t2 < 2; ++t2)
#pragma unroll
        for (int it = 0; it < 8; ++it) acc[t2][it] = (f32x4){0.f, 0.f, 0.f, 0.f};
#pragma unroll
    for (int ks = 0; ks < 4; ++ks) {
        const bf16x8 af0 = *(const LAS bf16x8*)(Vnt + (32 * wave + lr) * VPITCH + 32 * ks + 8 * grp);
        const bf16x8 af1 = *(const LAS bf16x8*)(Vnt + (32 * wave + 16 + lr) * VPITCH + 32 * ks + 8 * grp);
#pragma unroll
        for (int it = 0; it < 8; ++it) {
            if ((it >> 1) >= ks) { const bf16x8 bfr = *(const bf16x8*)(tril + (size_t)(16 * it + lr) * 128 + 32 * ks + 8 * grp);
                acc[0][it] = __builtin_amdgcn_mfma_f32_16x16x32_bf16(af0, bfr, acc[0][it], 0, 0, 0); acc[1][it] = __builtin_amdgcn_mfma_f32_16x16x32_bf16(af1, bfr, acc[1][it], 0, 0, 0); }
        }
    }
    const float* bs = P.in[24] + 128 * g;
#pragma unroll
    for (int it = 0; it < 8; ++it) {
        const int i = 16 * it + lr; const size_t row = R0 + i;
        const float bsi = bs[i];
#pragma unroll
        for (int t2 = 0; t2 < 2; ++t2) {
            const int d0 = 256 * gp + 32 * wave + 16 * t2 + 4 * grp;
            float uu[4], zb[4]; unpack4(*(const u32x2*)(ACT + row * NIN + LU + d0), uu); unpack4(*(const u32x2*)(ACT + row * NIN + LZB + d0), zb);
            u32x2 w; w.x = cvt_pk_bf16(uu[0] * (acc[t2][it][0] + bsi) * zb[0], uu[1] * (acc[t2][it][1] + bsi) * zb[1]); w.y = cvt_pk_bf16(uu[2] * (acc[t2][it][2] + bsi) * zb[2], uu[3] * (acc[t2][it][3] + bsi) * zb[3]);
            *(u32x2*)(AB + row * DM + 512 + d0) = w;
        }
    }
}

__device__ __forceinline__ void stile(const float* kb, const float* vb, int stride, int kmin, const f32x4 (&q4)[4], float (&m)[4], float (&l)[4], f32x4 (&o4)[4], float (&pout)[4], int lane_in) {
    int lane = lane_in; asm volatile("" : "+v"(lane));
    const int li = lane & 15, gq = lane >> 4;
    __builtin_amdgcn_sched_barrier(0);
    const float* kl = kb + (size_t)(gq * stride + 4 * li); const float* vl = vb + (size_t)(gq * stride + 4 * li);
    f32x4 kreg[16], vreg[16];
#pragma unroll
    for (int i = 0; i < 16; ++i) kreg[i] = __builtin_nontemporal_load((const f32x4*)(kl + (size_t)(4 * i) * stride));
#pragma unroll
    for (int i = 0; i < 16; ++i) vreg[i] = __builtin_nontemporal_load((const f32x4*)(vl + (size_t)(4 * i) * stride));
    float sc[4];
#pragma unroll
    for (int h = 0; h < 4; ++h) {
        float v[16], w8[8], w4[4], w2[2];
#pragma unroll
        for (int i = 0; i < 16; ++i) v[i] = (kreg[i][0] * q4[h][0] + kreg[i][1] * q4[h][1]) + (kreg[i][2] * q4[h][2] + kreg[i][3] * q4[h][3]);
#pragma unroll
        for (int t = 0; t < 8; ++t) { const float snd = (li & 8) ? v[t] : v[t + 8], kp = (li & 8) ? v[t + 8] : v[t]; w8[t] = kp + __shfl_xor(snd, 8); }
#pragma unroll
        for (int t = 0; t < 4; ++t) { const float snd = (li & 4) ? w8[t] : w8[t + 4], kp = (li & 4) ? w8[t + 4] : w8[t]; w4[t] = kp + __shfl_xor(snd, 4); }
#pragma unroll
        for (int t = 0; t < 2; ++t) { const float snd = (li & 2) ? w4[t] : w4[t + 2], kp = (li & 2) ? w4[t + 2] : w4[t]; w2[t] = kp + __shfl_xor(snd, 2); }
        { const float snd = (li & 1) ? w2[0] : w2[1], kp = (li & 1) ? w2[1] : w2[0]; sc[h] = kp + __shfl_xor(snd, 1); }
        __builtin_amdgcn_sched_barrier(0);
    }
    const bool valid = (4 * li + gq) >= kmin;
#pragma unroll
    for (int h = 0; h < 4; ++h) {
        const float sv = valid ? sc[h] : NEGBIG;
        const float mnew = fmaxf(m[h], wave_max(sv));
        const float alpha = __builtin_amdgcn_exp2f(m[h] - mnew), p = __builtin_amdgcn_exp2f(sv - mnew);
        l[h] = l[h] * alpha + wave_sum(p); o4[h] *= alpha; m[h] = mnew; pout[h] = p;
    }
    const int src0 = lane & 48;
#pragma unroll
    for (int i = 0; i < 16; ++i) {
#pragma unroll
        for (int h = 0; h < 4; ++h) o4[h] += vreg[i] * __shfl(pout[h], src0 + i);
    }
    __builtin_amdgcn_sched_barrier(0);
}
__device__ __forceinline__ void skey(const float* kb, const float* vb, const f32x4 (&q4)[4], float (&m)[4], float (&l)[4], f32x4 (&o4)[4], int lane) {
    const int li = lane & 15, gq = lane >> 4;
    const f32x4 kd = *(const f32x4*)(kb + 4 * li), vd = *(const f32x4*)(vb + 4 * li);
#pragma unroll
    for (int h = 0; h < 4; ++h) {
        float sv = (kd[0] * q4[h][0] + kd[1] * q4[h][1]) + (kd[2] * q4[h][2] + kd[3] * q4[h][3]);
        sv += __shfl_xor(sv, 1); sv += __shfl_xor(sv, 2); sv += __shfl_xor(sv, 4); sv += __shfl_xor(sv, 8);
        const float mnew = fmaxf(m[h], sv), alpha = __builtin_amdgcn_exp2f(m[h] - mnew), p = __builtin_amdgcn_exp2f(sv - mnew);
        l[h] = l[h] * alpha + p; o4[h] *= alpha; if (gq == 0) o4[h] += vd * p; m[h] = mnew;
    }
}

constexpr int S_ST = 0, S_MISC = 8 * 3 * 4 * 66 * 4;
__device__ __forceinline__ void sample_unit(const Params& P, LAS unsigned char* lds, int sb, int g, int tid, int lane, int wave) {
    const bf16_t* ACT = (const bf16_t*)(P.ws + WS_ACT); bf16_t* AB = (bf16_t*)(P.ws + WS_AB);
    LAS float* ST = (LAS float*)(lds + S_ST); LAS float* MISC = (LAS float*)(lds + S_MISC);
    const size_t row = (size_t)MP + sb;
    const int* ptab = (const int*)P.in[8] + sb * 16;
    const int li = lane & 15;
    __syncthreads();
    f32x4 q4[4];
#pragma unroll
    for (int h = 0; h < 4; ++h) { float t4[4]; unpack4(*(const u32x2*)(ACT + row * NIN + LQ + 64 * (4 * g + h) + 4 * li), t4); q4[h] = (f32x4){t4[0], t4[1], t4[2], t4[3]}; }
    float ms[4], ls[4]; f32x4 os[4];
#define S_RESET() do { _Pragma("unroll") for (int h = 0; h < 4; ++h) { ms[h] = MINIT; ls[h] = 0.f; os[h] = (f32x4){0.f, 0.f, 0.f, 0.f}; } } while (0)
#define S_PUBLISH(b2, doit) do { _Pragma("unroll") for (int h = 0; h < 4; ++h) { f32x4 v = os[h]; \
        _Pragma("unroll") for (int e = 0; e < 4; ++e) { float x = v[e]; x += __shfl_xor(x, 16); x += __shfl_xor(x, 32); v[e] = x; } \
        if (doit) { LAS float* st = ST + ((wave * 3 + (b2)) * 4 + h) * 66; if (lane < 16) *(LAS f32x4*)(st + 4 * lane) = v; if (lane == 0) { st[64] = ms[h]; st[65] = ls[h]; } } } } while (0)
    float pdummy[4], pc[4];
    S_RESET();
    { const size_t off = (((size_t)sb * 512 + 64 * wave) * 2 + g) * 64; stile(P.in[6] + off, P.in[7] + off, 128, (wave == 0) ? 1 : 0, q4, ms, ls, os, pdummy, lane); }
    if (wave == 0) { const size_t off = ((size_t)(sb * 512 + 511) * 2 + g) * 64; skey(P.out + O_SKW + off, P.out + O_SVW + off, q4, ms, ls, os, lane); }
    S_PUBLISH(1, true);
    S_RESET();
    stile((const float*)(P.ws + WS_KCS) + (size_t)(sb * 2 + g) * 4096, (const float*)(P.ws + WS_VCS) + (size_t)(sb * 2 + g) * 4096, 64, 0, q4, ms, ls, os, pc, lane);
    float imp = 0.f;
#pragma unroll
    for (int h = 0; h < 4; ++h) { const float pn = pc[h] / ls[h]; imp += pn + __shfl_down(pn, 16); }
    S_PUBLISH(2, wave == 0);
    const int jblk = 2 * li + (lane >> 5);
    const bool cand = ((lane >> 4) & 1) == 0 && jblk >= 1;
    unsigned key = cand ? ((__builtin_bit_cast(unsigned, imp) & 0xffffffe0u) | (unsigned)(31 - jblk)) : 0u;
    unsigned long long selpack = 0ull;
#pragma unroll
    for (int pick = 0; pick < 6; ++pick) {
        unsigned best = key;
#pragma unroll
        for (int o2 = 1; o2 < 64; o2 <<= 1) { const unsigned other = (unsigned)__shfl_xor((int)best, o2); best = other > best ? other : best; }
        const int bj = 31 - (int)(best & 31u);
        selpack |= (unsigned long long)bj << (5 * (pick + 1));
        if (cand && jblk == bj) key = 0u;
    }
    S_RESET();
    if (wave < 7) { const int blk = (int)((selpack >> (5 * wave)) & 31ull); const int page = __builtin_amdgcn_readfirstlane(ptab[blk >> 1]); const size_t off = (((size_t)page * 128 + (blk & 1) * 64) * 2 + g) * 64;
        stile(P.in[4] + off, P.in[5] + off, 128, 0, q4, ms, ls, os, pdummy, lane); }
    else skey(P.out + O_SKS + (size_t)sb * 128 + g * 64, P.out + O_SVS + (size_t)sb * 128 + g * 64, q4, ms, ls, os, lane);
    S_PUBLISH(0, true);
#undef S_RESET
#undef S_PUBLISH
    if (wave == 7) {
        const u32x4 raw = *(const u32x4*)(ACT + row * NIN + LVB + 8 * lane);
        float f[8]; f[0] = bf2f(raw.x); f[1] = bf2f(raw.x >> 16); f[2] = bf2f(raw.y); f[3] = bf2f(raw.y >> 16); f[4] = bf2f(raw.z); f[5] = bf2f(raw.z >> 16); f[6] = bf2f(raw.w); f[7] = bf2f(raw.w >> 16);
        float sm = 0.f;
#pragma unroll
        for (int i = 0; i < 8; ++i) sm += f[i];
        const float mean = wave_sum(sm) * (1.0f / 512.0f); float sq = 0.f;
#pragma unroll
        for (int i = 0; i < 8; ++i) { const float d = f[i] - mean; sq += d * d; }
        const float rstd = rsqrtf(wave_sum(sq) * (1.0f / 512.0f) + 1e-6f);
        if (lane == 0) { MISC[0] = mean; MISC[1] = rstd; }
    }
    __syncthreads();
    if (wave < 4) {
        const int h = wave, head = 4 * g + h;
        const LAS float* stc = ST + ((0 * 3 + 2) * 4 + h) * 66;
        float oa = bf2f(ACT[row * NIN + LNSA + 3 * head + 0]) * stc[lane] / stc[65];
#pragma unroll
        for (int b2 = 0; b2 < 2; ++b2) {
            float M = MINIT;
#pragma unroll
            for (int w = 0; w < 8; ++w) M = fmaxf(M, ST[((w * 3 + b2) * 4 + h) * 66 + 64]);
            float L = 0.f, O = 0.f;
#pragma unroll
            for (int w = 0; w < 8; ++w) { const LAS float* st = ST + ((w * 3 + b2) * 4 + h) * 66; const float f = __builtin_amdgcn_exp2f(st[64] - M); L += st[65] * f; O += st[lane] * f; }
            oa += bf2f(ACT[row * NIN + LNSA + 3 * head + 1 + b2]) * O / L;
        }
        const int col = 64 * head + lane;
        AB[row * DM + col] = (bf16_t)f2bf(oa * bf2f(ACT[row * NIN + LZA + col]));
    }
    if (tid < 256) {
        const int d = 256 * g + tid, gm = d >> 7;
        const float vn = (bf2f(ACT[row * NIN + LVB + d]) - MISC[0]) * MISC[1] * P.in[21][d] + P.in[22][d];
        P.out[O_SVCH + (size_t)sb * 512 + d] = vn;
        const float sv = P.in[23][(size_t)gm * 128 * 128] * vn + P.in[24][gm * 128];
        AB[row * DM + 512 + d] = (bf16_t)f2bf(bf2f(ACT[row * NIN + LU + d]) * sv * bf2f(ACT[row * NIN + LZB + d]));
    }
}

template <int MODE>
__device__ __forceinline__ void small_gemm(const Params& P, int c, int G, int wave, int lane) {
    const int lr = lane & 15, grp = lane >> 4;
    for (int t = c + G * wave; t < 512; t += G * 8) {
        const int rt = t & 7, ct = t >> 3;
        const size_t row = (size_t)MP + 16 * rt + lr;
        const bf16_t* A = (const bf16_t*)(P.ws + (MODE == 0 ? WS_AB : WS_H)) + row * DM + 8 * grp;
        const int wrow = (MODE == 0) ? (256 * (ct >> 4) + 128 * ((ct >> 1) & 1) + 32 * ((ct >> 2) & 3) + 16 * (ct & 1) + lr) : (16 * ct + lr);
        const bf16_t* W = (const bf16_t*)(P.ws + (MODE == 0 ? WS_WTBR : WS_WTOUT)) + (size_t)wrow * DM + 8 * grp;
        f32x4 acc0 = (f32x4){0.f, 0.f, 0.f, 0.f}, acc1 = (f32x4){0.f, 0.f, 0.f, 0.f};
#pragma unroll 8
        for (int ks = 0; ks < 16; ++ks) acc0 = __builtin_amdgcn_mfma_f32_16x16x32_bf16(*(const bf16x8*)(W + 32 * ks), *(const bf16x8*)(A + 32 * ks), acc0, 0, 0, 0);
#pragma unroll 8
        for (int ks = 16; ks < 32; ++ks) acc1 = __builtin_amdgcn_mfma_f32_16x16x32_bf16(*(const bf16x8*)(W + 32 * ks), *(const bf16x8*)(A + 32 * ks), acc1, 0, 0, 0);
        const int col = 16 * ct + 4 * grp;
        if (MODE == 0) {
            const int i = 16 * rt + lr, cc = col & 255;
            const size_t go = ((size_t)(((64 * 8 + (col >> 8)) * 8 + (i >> 6) * 4 + (cc >> 6)) * 32 + ((((i >> 4) & 3) * 2 + ((cc >> 5) & 1)) * 2 + ((cc >> 4) & 1))) * 64 + ((cc >> 2) & 3) * 16 + (i & 15)) * 4;
            const bf16_t* GB = (const bf16_t*)(P.ws + WS_GBUF);
            float sa[4], sb[4]; unpack4(*(const u32x2*)(GB + go), sa); unpack4(*(const u32x2*)(GB + go + (size_t)4 * 8 * 32 * 256), sb);
            u32x2 w; w.x = cvt_pk_bf16(sa[0] * acc0[0] + sb[0] * acc1[0], sa[1] * acc0[1] + sb[1] * acc1[1]); w.y = cvt_pk_bf16(sa[2] * acc0[2] + sb[2] * acc1[2], sa[3] * acc0[3] + sb[3] * acc1[3]);
            *(u32x2*)((bf16_t*)(P.ws + WS_H) + row * DM + col) = w;
        } else {
            const int sbi = 16 * rt + lr;
            const f32x4 xv = *(const f32x4*)(P.in[1] + (size_t)sbi * DM + col), gv = *(const f32x4*)((const float*)(P.ws + WS_MOD) + (size_t)(8 + sbi) * 3072 + 2048 + col);
            *(f32x4*)(P.out + O_YS + (size_t)sbi * DM + col) = xv + gv * (acc0 + acc1);
        }
    }
}

#define XB_TMO      128
#define XB_XCNT(j)  (256  + 64 * (j))
#define XB_XSUB(j)  (1280 + 64 * (j))
#define XB_XGEN(j)  (2304 + 64 * (j))
#define XB_TOP      3328
#define XB_TOPGEN   3392
#define XCD_BAR_WORDS 3456
#define XB_SPIN_CAP (1u << 18)
__device__ __forceinline__ unsigned xb_ld(unsigned* p)              { return __hip_atomic_load(p, __ATOMIC_RELAXED, __HIP_MEMORY_SCOPE_AGENT); }
__device__ __forceinline__ unsigned xb_add(unsigned* p, unsigned v) { return __hip_atomic_fetch_add(p, v, __ATOMIC_RELAXED, __HIP_MEMORY_SCOPE_AGENT); }
__device__ __forceinline__ unsigned xb_xcc_id() { return (unsigned)__builtin_amdgcn_s_getreg((3 << 11) | 20) & 0xFu; }
#define XB_SPIN(cond, bar) do { unsigned _sp = 0; while (cond) { __builtin_amdgcn_s_sleep(1); \
    if ((++_sp & 255u) == 0u) { if (xb_ld(&(bar)[XB_TMO])) break; if (_sp > XB_SPIN_CAP) { atomicAdd(&(bar)[XB_TMO], 1u); break; } } } } while (0)
struct XcdBarrier { unsigned* bar; unsigned x; volatile LAS unsigned* st; };
__device__ __forceinline__ XcdBarrier xcd_barrier_post(unsigned* bar, volatile LAS unsigned* st) {
    XcdBarrier b; b.bar = bar; b.x = xb_xcc_id(); b.st = st;
    if (threadIdx.x == 0) (void)xb_add(&bar[XB_XCNT(b.x)], 1u);
    return b;
}
__device__ __forceinline__ void xcd_barrier_complete(unsigned* bar, unsigned x, unsigned& nloc, unsigned& nx) {
    const unsigned G = gridDim.x * gridDim.y * gridDim.z;
    unsigned sum, cnt, mine, sp = 0u;
    for (;;) {
        sum = 0u; cnt = 0u; mine = 0u;
#pragma unroll
        for (unsigned j = 0; j < 16; ++j) { const unsigned c = xb_ld(&bar[XB_XCNT(j)]); sum += c; cnt += (c > 0u) ? 1u : 0u; mine = (j == x) ? c : mine; }
        if (sum == G) break;
        __builtin_amdgcn_s_sleep(1);
        if ((++sp & 255u) == 0u) { if (xb_ld(&bar[XB_TMO])) break; if (sp > XB_SPIN_CAP) { atomicAdd(&bar[XB_TMO], 1u); break; } }
    }
    nloc = mine > 0u ? mine : 1u; nx = cnt > 0u ? cnt : 1u;
}
__device__ __forceinline__ void xcd_barrier(const XcdBarrier& b) {
    asm volatile("s_waitcnt vmcnt(0)" ::: "memory");
    __syncthreads();
    if (threadIdx.x == 0) {
        unsigned* bar = b.bar;
        __builtin_amdgcn_s_waitcnt(0);
        unsigned nloc = b.st[0], nx = b.st[1];
        if (nloc == 0u) { xcd_barrier_complete(bar, b.x, nloc, nx); b.st[0] = nloc; b.st[1] = nx; }
        const unsigned old = xb_add(&bar[XB_XSUB(b.x)], 1u);
        const unsigned gen = old / nloc;
        if (old + 1u == (gen + 1u) * nloc) {
            __builtin_amdgcn_fence(__ATOMIC_RELEASE, "agent");
            asm volatile("s_waitcnt vmcnt(0)" ::: "memory");
            const unsigned og = xb_add(&bar[XB_TOP], 1u);
            const unsigned tg = og / nx;
            if (og + 1u == (tg + 1u) * nx) xb_add(&bar[XB_TOPGEN], 1u);
            else XB_SPIN(xb_ld(&bar[XB_TOPGEN]) == tg, bar);
            __builtin_amdgcn_fence(__ATOMIC_ACQUIRE, "agent");
            xb_add(&bar[XB_XGEN(b.x)], 1u);
            asm volatile("s_waitcnt vmcnt(0)" ::: "memory");
        } else {
            XB_SPIN(xb_ld(&bar[XB_XGEN(b.x)]) == gen, bar);
            __builtin_amdgcn_fence(__ATOMIC_ACQUIRE, "agent");
            asm volatile("s_waitcnt vmcnt(0)" ::: "memory");
        }
    }
    __syncthreads();
}

__global__ void __launch_bounds__(512, 2) mk_fwd(Params P) {
    extern __shared__ __attribute__((aligned(16))) unsigned char lds_raw[];
    LAS unsigned char* lds = (LAS unsigned char*)lds_raw;
    const int tid = threadIdx.x, lane = tid & 63, wave = __builtin_amdgcn_readfirstlane(tid >> 6);
    const int G = gridDim.x, c = blockIdx.x, gw = c * 8 + wave, NGW = G * 8, gtid = c * 512 + tid, NT = G * 512;
    cg::grid_group grid = cg::this_grid();
    const int lo = P.ph_lo, hi = P.ph_hi;
    if (tid < 16) ((LAS unsigned*)(lds + LDS_XB))[tid] = 0u;
    __syncthreads();
    const XcdBarrier bar = xcd_barrier_post((unsigned*)(P.ws + WS_CTL), (volatile LAS unsigned*)(lds + LDS_XB));
    if (hi < 0) grid.sync();
#define IN(k) (lo <= (k) && (k) < hi)
#define SEAM(k) do { if (IN(k) && IN((k) + 1)) xcd_barrier(bar); } while (0)
    unsigned char* ws = P.ws;
    if (IN(0)) for (int rep = 0; rep < MK_REP0; ++rep) { p0_prologue(P, lds, gw, NGW, lane, wave, gtid, NT); }
    SEAM(0);
    if (IN(1)) for (int rep = 0; rep < MK_REP1; ++rep) { p1_hrows(P, gw, NGW, lane); }
    SEAM(1);
    if (IN(2)) for (int rep = 0; rep < MK_REP2; ++rep) {
        pg8::Gemm gm{(const bf16_t*)(ws + WS_H), (const bf16_t*)(ws + WS_WTIN), DM, DM, DM};
        pg8::StaticOrder S; S.init(MPAD / 256, NIN / 256, G, c);
        EpiInProj E{(bf16_t*)(ws + WS_ACT), (bf16_t*)(ws + WS_VT), (bf16_t*)(ws + WS_GBUF), P.out, P.in[15], P.in[16], (const float*)(ws + WS_ROPE)};
        pg8::gemm_phase<EpiInProj, pg8::StaticOrder>(lds, gm, S, E);
    }
    SEAM(2);
    if (IN(3)) for (int rep = 0; rep < MK_REP3; ++rep) { p3_compress(P, lds, gw, NGW, lane, wave); }
    SEAM(3);
    if (IN(4)) for (int rep = 0; rep < MK_REP4; ++rep) {
        asm volatile("" ::: "memory");
        for (int i = 0;; ++i) { const int a = (i & 1) ? (i + 1) * G - 1 - c : i * G + c; if (a >= 512 || a < 0) break; attn_unit(P, lds, a & 7, 63 - (a >> 3), tid, lane, wave); }
        {
            unsigned* qctr = (unsigned*)(ws + WS_CTL) + 3584;
            LAS unsigned* qsl = (LAS unsigned*)(lds + LDS_XB + 32);
            for (;;) {
                __syncthreads();
                if (tid == 0) *qsl = __hip_atomic_fetch_add(qctr, 1u, __ATOMIC_RELAXED, __HIP_MEMORY_SCOPE_AGENT);
                __syncthreads();
                const int u = (int)*qsl;
                if (u >= 512) break;
                if (u < 256) gmlp_unit(P, lds, u >> 5, (u >> 1) & 15, u & 1, tid, lane, wave);
                else { const int su = u - 256; sample_unit(P, lds, su >> 1, su & 1, tid, lane, wave); }
            }
        }
        __syncthreads();
    }
    SEAM(4);
    if (IN(5)) for (int rep = 0; rep < MK_REP5; ++rep) {
        pg8::Gemm gm{(const bf16_t*)(ws + WS_AB), (const bf16_t*)(ws + WS_WTBR), DM, DM, 512};
        small_gemm<0>(P, c, G, wave, lane);
        pg8::PairOrder S; S.S.init(MP / 256, DM / 256, G, c);
        EpiMix E{(const bf16_t*)(ws + WS_GBUF), (bf16_t*)(ws + WS_H)};
        pg8::gemm_phase<EpiMix, pg8::PairOrder>(lds, gm, S, E);
    }
    SEAM(5);
    if (IN(6)) for (int rep = 0; rep < MK_REP6; ++rep) {
        pg8::Gemm gm{(const bf16_t*)(ws + WS_H), (const bf16_t*)(ws + WS_WTOUT), DM, DM, DM};
        small_gemm<1>(P, c, G, wave, lane);
        pg8::StaticOrder S; S.init(MP / 256, DM / 256, G, c);
        EpiOut E{P.in[0], P.in[1], (const float*)(ws + WS_MOD), P.out};
        pg8::gemm_phase<EpiOut, pg8::StaticOrder>(lds, gm, S, E);
    }
#undef IN
#undef SEAM
}

extern "C" void kernel_launch(void* const* d_in, const int* in_sizes, int n_in, void* d_out, int out_size, void* d_ws, size_t ws_size, hipStream_t stream) {
    static int grid = 0;
    if (grid == 0) {
        if (n_in != 28 || out_size != (int)O_END || ws_size < WS_END) { fprintf(stderr, "kernel_launch: unexpected shapes (n_in %d, out %d, ws %zu); nothing launched\n", n_in, out_size, ws_size); grid = -1; return; }
        int dev = 0, cus = 0, per_cu = 0;
        if (hipGetDevice(&dev) != hipSuccess || hipDeviceGetAttribute(&cus, hipDeviceAttributeMultiprocessorCount, dev) != hipSuccess) { grid = -1; return; }
        if (hipFuncSetAttribute((const void*)mk_fwd, hipFuncAttributeMaxDynamicSharedMemorySize, LDS_BYTES) != hipSuccess) { fprintf(stderr, "kernel_launch: hipFuncSetAttribute failed\n"); grid = -1; return; }
        if (hipOccupancyMaxActiveBlocksPerMultiprocessor(&per_cu, (const void*)mk_fwd, 512, LDS_BYTES) != hipSuccess || per_cu < 1) { fprintf(stderr, "kernel_launch: occupancy query failed (%d)\n", per_cu); (void)hipGetLastError(); per_cu = 1; }
        if (per_cu > 1) per_cu = 1;
        grid = cus * per_cu;
    }
    if (grid < 0) return;
    if (hipMemsetAsync((char*)d_ws + WS_CTL, 0, CTL_BYTES, stream) != hipSuccess) { fprintf(stderr, "kernel_launch: hipMemsetAsync failed\n"); return; }
    Params p{};
    for (int i = 0; i < 28; ++i) p.in[i] = (const float*)d_in[i];
    p.out = (float*)d_out; p.ws = (unsigned char*)d_ws;
#if MK_N_LAUNCHES == 1
    p.ph_lo = 0; p.ph_hi = 7;
    void* args[] = {&p};
    hipError_t e = hipLaunchCooperativeKernel((const void*)mk_fwd, dim3(grid), dim3(512), args, LDS_BYTES, stream);
    if (e != hipSuccess) fprintf(stderr, "kernel_launch: cooperative launch failed: %s (grid %d)\n", hipGetErrorString(e), grid);
#else
    for (int ph = 0; ph < 7; ++ph) {
        p.ph_lo = ph; p.ph_hi = ph + 1;
        void* args[] = {&p};
        hipError_t e = hipLaunchCooperativeKernel((const void*)mk_fwd, dim3(grid), dim3(512), args, LDS_BYTES, stream);
        if (e != hipSuccess) { fprintf(stderr, "kernel_launch: launch %d failed: %s (grid %d)\n", ph, hipGetErrorString(e), grid); break; }
    }
#endif
}
```

```cpp
#include <hip/hip_runtime.h>
#include <hip/hip_cooperative_groups.h>
#include <cstdio>
#include <cstdint>
namespace cg = cooperative_groups;

#ifndef MK_N_LAUNCHES
#define MK_N_LAUNCHES 1
#endif
#define MK_REP0 1
#define MK_REP1 1
#define MK_REP2 1
#define MK_REP3 1
#define MK_REP4 1
#define MK_REP5 1
#define MK_REP6 1

#define LAS __attribute__((address_space(3)))
typedef unsigned short bf16_t;
typedef short bf16x8 __attribute__((ext_vector_type(8)));
typedef short bf16x4 __attribute__((ext_vector_type(4)));
typedef float f32x4 __attribute__((ext_vector_type(4)));
typedef float f32x2 __attribute__((ext_vector_type(2)));
typedef unsigned u32x4 __attribute__((ext_vector_type(4)));
typedef unsigned u32x2 __attribute__((ext_vector_type(2)));

constexpr int DM = 1024, SEQ = 2048, NBATCH = 8, MP = NBATCH * SEQ, NSB = 128, MTOT = MP + NSB, MPAD = 16640;
constexpr int NIN = 5632;
constexpr int LQ = 0, LK = 512, LV = 896, LZA = 1280, LU = 1792, LVB = 2304, LZB = 2816, LGA = 3328, LGB = 4352, LNSA = 5376;
constexpr float C2Q = 0.125f * 1.4426950408889634f;
constexpr float NEGBIG = -1e30f, MINIT = -1e29f;
constexpr size_t O_YP = 0, O_YS = 16777216, O_PKC = 16908288, O_PVC = 19005440, O_PKS = 21102592, O_PVS = 23199744, O_PKW = 25296896, O_PVW = 25821184,
                 O_SKC = 26345472, O_SVC = 26361856, O_SKS = 26378240, O_SVS = 26394624, O_SKW = 26411008, O_SVW = 34799616, O_SVCH = 43188224, O_END = 43253760;
constexpr size_t MiB = 1u << 20;
constexpr size_t WS_ROPE = 0, WS_MOD = 1 * MiB, WS_WTIN = 3 * MiB, WS_WTBR = 14 * MiB, WS_WTOUT = 16 * MiB, WS_TRIL = 18 * MiB, WS_KC = 18 * MiB + 512 * 1024, WS_VCT = WS_KC + 128 * 1024,
                 WS_KCS = 19 * MiB, WS_VCS = 23 * MiB, WS_VT = 27 * MiB, WS_H = 40 * MiB, WS_AB = 73 * MiB, WS_ACT = 106 * MiB, WS_GBUF = 285 * MiB, WS_END = 355 * MiB;
constexpr size_t WS_CTL = 768 * 1024, CTL_BYTES = 16384;
constexpr int LDS_BYTES = 151552, LDS_XB = LDS_BYTES - 64;
constexpr int LDS_EPI = 131072, EPI_PITCH = 144, EPI_WAVE = 16 * EPI_PITCH;
static_assert(LDS_EPI + 8 * EPI_WAVE <= LDS_XB - 64, "epilogue staging");

struct Params { const float* in[28]; float* out; unsigned char* ws; int ph_lo, ph_hi; };

__device__ __forceinline__ unsigned f2bf(float f) { unsigned u = __builtin_bit_cast(unsigned, f); return (u + 0x7fffu + ((u >> 16) & 1u)) >> 16; }
__device__ __forceinline__ unsigned pk2(float lo, float hi) { return f2bf(lo) | (f2bf(hi) << 16); }
__device__ __forceinline__ float bf2f(unsigned b) { return __builtin_bit_cast(float, (b & 0xffffu) << 16); }
typedef __bf16 bf16x2_t __attribute__((ext_vector_type(2)));
__device__ __forceinline__ unsigned cvt_pk_bf16(float lo, float hi) { const f32x2 v = {lo, hi}; const bf16x2_t b = __builtin_convertvector(v, bf16x2_t); return __builtin_bit_cast(unsigned, b); }
__device__ __forceinline__ void stage_store_rows(LAS unsigned char* sw, int lane, int fr, int fq, const u32x2 (&w)[2][2], bf16_t* dst0, size_t pitch, int nrows) {
#pragma unroll
    for (int bj = 0; bj < 2; ++bj)
#pragma unroll
        for (int n = 0; n < 2; ++n) *(LAS u32x2*)(sw + fr * EPI_PITCH + (32 * bj + 16 * n + 4 * fq) * 2) = w[bj][n];
    const int r = lane >> 3, ch = lane & 7;
    const u32x4 v0 = *(const LAS u32x4*)(sw + r * EPI_PITCH + ch * 16), v1 = *(const LAS u32x4*)(sw + (r + 8) * EPI_PITCH + ch * 16);
    if (r < nrows) *(u32x4*)(dst0 + (size_t)r * pitch + ch * 8) = v0;
    if (r + 8 < nrows) *(u32x4*)(dst0 + (size_t)(r + 8) * pitch + ch * 8) = v1;
}
__device__ __forceinline__ float sigmoidf_(float x) { return __builtin_amdgcn_rcpf(1.0f + __builtin_amdgcn_exp2f(x * -1.4426950408889634f)); }
__device__ __forceinline__ float wave_sum(float v) {
#pragma unroll
    for (int o = 1; o < 64; o <<= 1) v += __shfl_xor(v, o);
    return v;
}
__device__ __forceinline__ float wave_max(float v) {
#pragma unroll
    for (int o = 1; o < 64; o <<= 1) v = fmaxf(v, __shfl_xor(v, o));
    return v;
}
__device__ __forceinline__ void unpack4(u32x2 w, float (&f)[4]) { f[0] = bf2f(w.x); f[1] = bf2f(w.x >> 16); f[2] = bf2f(w.y); f[3] = bf2f(w.y >> 16); }

namespace pg8 {
constexpr int BM = 256, BK = 64, HALF = 128, HTB = HALF * BK * 2, STAGE_BYTES = 8 * HTB, NXCD = 8, WGM = 8;
__host__ __device__ __forceinline__ int lds_byte(int r, int c) { const int st = (r >> 4) * 2 + (c >> 5), rr = r & 15, cc = c & 31, ob = rr * 64 + cc * 2; return st * 1024 + (ob ^ (((ob >> 9) & 1) << 5)); }
__host__ __device__ __forceinline__ void stage_rc(int b, int& R, int& C) { const int st = b / 1024, sb = b % 1024, swz = sb ^ (((sb >> 9) & 1) << 5); R = (st >> 1) * 16 + swz / 64; C = (st & 1) * 32 + (swz % 64) / 2; }

struct Unit { int pm, pn, kofs, keep; };
struct Gemm { const bf16_t* A; const bf16_t* Bt; int lda, ldb, K; };

struct StaticOrder {
    int nM, nN, nwg, G, c;
    __device__ void init(int nM_, int nN_, int G_, int c_) { nM = nM_; nN = nN_; nwg = nM * nN; G = G_; c = c_; }
    __device__ bool tile(int i, int& pm, int& pn) const {
        const long L = (long)i * G + c; if (L >= nwg) return false;
        int wgid = (int)L; { const int q = nwg / NXCD, r = nwg % NXCD, xcd = wgid % NXCD, off = wgid / NXCD; wgid = (xcd < r ? xcd * (q + 1) : r * (q + 1) + (xcd - r) * q) + off; }
        const int nig = WGM * nN, gid = wgid / nig, fm = gid * WGM, gsz = (nM - fm) < WGM ? (nM - fm) : WGM;
        pm = fm + ((wgid % nig) % gsz); pn = (wgid % nig) / gsz; return true;
    }
    __device__ bool next(int i, Unit& u) const { u.kofs = 0; u.keep = 0; return tile(i, u.pm, u.pn); }
};
struct PairOrder {
    StaticOrder S;
    __device__ bool next(int i, Unit& u) const { u.kofs = (i & 1) * 512; u.keep = (i & 1) ? 0 : 1; return S.tile(i >> 1, u.pm, u.pn); }
};

template <class Epi, class Sched>
__device__ __forceinline__ void gemm_phase(LAS unsigned char* lds, const Gemm g, const Sched& S, const Epi& E) {
    const int tid = threadIdx.x, wid = __builtin_amdgcn_readfirstlane(tid >> 6), lane = tid & 63, wr = wid >> 2, wc = wid & 3, fr = lane & 15, fq = lane >> 4;
    const int nt = g.K / BK;
    unsigned voffA[2], voffB[2];
#pragma unroll
    for (int i = 0; i < 2; ++i) { int R, C; stage_rc(tid * 16 + i * 8192, R, C); voffA[i] = (unsigned)(R * g.lda + C) * 2u; voffB[i] = (unsigned)(R * g.ldb + C) * 2u; }
    const size_t kstep = (size_t)(BK * 2);
    const size_t hstepA = (size_t)HALF * g.lda * 2, hstepB = (size_t)HALF * g.ldb * 2, tstepA = 2 * hstepA, tstepB = 2 * hstepB;
    const unsigned ldsw = (unsigned)wid * 1024u;
    const int aoff = lds_byte(wr * 64 + fr, fq * 8), boff = lds_byte(wc * 32 + fr, fq * 8);
#define PG8_SA(b, h) (((b) * 2 + (h)) * HTB)
#define PG8_SB(b, h) ((4 + (b) * 2 + (h)) * HTB)
#define PG8_STAGE(bufoff, gbase, voff) do { _Pragma("unroll") for (int _i = 0; _i < 2; ++_i) \
        __builtin_amdgcn_global_load_lds((const unsigned*)((const char*)(gbase) + (voff)[_i]), (LAS unsigned*)(lds + (bufoff) + ldsw + _i * 8192), 16, 0, 0); } while (0)
#define PG8_LDA(dst, b, h) do { _Pragma("unroll") for (int m = 0; m < 4; ++m) _Pragma("unroll") for (int k = 0; k < 2; ++k) dst[m][k] = *(const LAS bf16x8*)(lds + PG8_SA(b, h) + aoff + m * 2048 + k * 1024); } while (0)
#define PG8_LDB(dst, b, h) do { _Pragma("unroll") for (int n = 0; n < 2; ++n) _Pragma("unroll") for (int k = 0; k < 2; ++k) dst[n][k] = *(const LAS bf16x8*)(lds + PG8_SB(b, h) + boff + n * 2048 + k * 1024); } while (0)
#define PG8_MMA(ai, bj, At, Bt) do { __builtin_amdgcn_s_setprio(1); _Pragma("unroll") for (int m = 0; m < 4; ++m) _Pragma("unroll") for (int n = 0; n < 2; ++n) _Pragma("unroll") for (int k = 0; k < 2; ++k) \
        acc[ai][bj][m][n] = __builtin_amdgcn_mfma_f32_16x16x32_bf16(Bt[n][k], At[m][k], acc[ai][bj][m][n], 0, 0, 0); __builtin_amdgcn_s_setprio(0); } while (0)
#define PG8_WAIT_V(n) asm volatile("s_waitcnt vmcnt(" #n ")" ::: "memory")
#define PG8_WAIT_L(n) asm volatile("s_waitcnt lgkmcnt(" #n ")" ::: "memory")
#define PG8_BAR __builtin_amdgcn_s_barrier()
#define PG8_SCHED __builtin_amdgcn_sched_barrier(0)
    Unit cur, nxt; int ui = 0;
    if (!S.next(0, cur)) return;
    f32x4 acc[2][2][4][2];
#pragma unroll
    for (int a = 0; a < 2; ++a)
#pragma unroll
        for (int b = 0; b < 2; ++b)
#pragma unroll
            for (int m = 0; m < 4; ++m)
#pragma unroll
                for (int n = 0; n < 2; ++n) acc[a][b][m][n] = (f32x4){0.f, 0.f, 0.f, 0.f};
    bf16x8 At[4][2], B0[2][2], B1[2][2];
    const char* cA = (const char*)g.A + (size_t)cur.pm * tstepA + (size_t)cur.kofs * 2; const char* cB = (const char*)g.Bt + (size_t)cur.pn * tstepB + (size_t)cur.kofs * 2;
    PG8_STAGE(PG8_SB(0, 0), cB, voffB); PG8_STAGE(PG8_SB(0, 1), cB + hstepB, voffB); PG8_STAGE(PG8_SA(0, 0), cA, voffA); PG8_STAGE(PG8_SA(0, 1), cA + hstepA, voffA);
    if (wr == 1) PG8_BAR;
    PG8_WAIT_V(2); PG8_BAR;
    PG8_STAGE(PG8_SB(1, 0), cB + kstep, voffB); PG8_STAGE(PG8_SA(1, 0), cA + kstep, voffA); PG8_STAGE(PG8_SB(1, 1), cB + hstepB + kstep, voffB);
    PG8_WAIT_V(6); PG8_BAR;
    for (;;) {
        const bool has_next = S.next(ui + 1, nxt);
        const char* nA = has_next ? (const char*)g.A + (size_t)nxt.pm * tstepA + (size_t)nxt.kofs * 2 : cA; const char* nB = has_next ? (const char*)g.Bt + (size_t)nxt.pn * tstepB + (size_t)nxt.kofs * 2 : cB;
        for (int t = 0; t < nt; t += 2) {
            const bool last = (t == nt - 2);
            const char* a1 = cA + (size_t)(t + 1) * kstep;
            const char* a2 = last ? nA : cA + (size_t)(t + 2) * kstep; const char* b2 = last ? nB : cB + (size_t)(t + 2) * kstep;
            const char* a3 = a2 + kstep; const char* b3 = b2 + kstep;
            PG8_LDB(B0, 0, 0); PG8_LDB(B1, 0, 1); PG8_SCHED; PG8_LDA(At, 0, 0); PG8_STAGE(PG8_SA(1, 1), a1 + hstepA, voffA);
            PG8_WAIT_V(8); PG8_WAIT_L(0); PG8_BAR; PG8_MMA(0, 0, At, B0); PG8_MMA(0, 1, At, B1); PG8_BAR; PG8_SCHED;
            PG8_LDA(At, 0, 1); PG8_STAGE(PG8_SB(0, 0), b2, voffB); PG8_STAGE(PG8_SB(0, 1), b2 + hstepB, voffB); PG8_STAGE(PG8_SA(0, 0), a2, voffA);
            PG8_WAIT_V(8); PG8_WAIT_L(0); PG8_BAR; PG8_MMA(1, 0, At, B0); PG8_MMA(1, 1, At, B1); PG8_BAR; PG8_SCHED;
            PG8_LDB(B0, 1, 0); PG8_LDB(B1, 1, 1); PG8_SCHED; PG8_LDA(At, 1, 0); PG8_STAGE(PG8_SA(0, 1), a2 + hstepA, voffA);
            PG8_WAIT_V(8); PG8_WAIT_L(0); PG8_BAR; PG8_MMA(0, 0, At, B0); PG8_MMA(0, 1, At, B1); PG8_BAR; PG8_SCHED;
            PG8_LDA(At, 1, 1); PG8_STAGE(PG8_SB(1, 0), b3, voffB); PG8_STAGE(PG8_SB(1, 1), b3 + hstepB, voffB); PG8_STAGE(PG8_SA(1, 0), a3, voffA);
            PG8_WAIT_V(8); PG8_WAIT_L(0); PG8_BAR; PG8_MMA(1, 0, At, B0); PG8_MMA(1, 1, At, B1); PG8_BAR; PG8_SCHED;
        }
        if (wr == 0) PG8_BAR;
        E(acc, cur, wr, wc, fr, fq);
        if (!has_next) break;
        if (!cur.keep) {
#pragma unroll
            for (int a = 0; a < 2; ++a)
#pragma unroll
                for (int b = 0; b < 2; ++b)
#pragma unroll
                    for (int m = 0; m < 4; ++m)
#pragma unroll
                        for (int n = 0; n < 2; ++n) acc[a][b][m][n] = (f32x4){0.f, 0.f, 0.f, 0.f};
        }
        cur = nxt; cA = nA; cB = nB; ++ui;
        if (wr == 1) PG8_BAR;
    }
    PG8_WAIT_V(0);
    PG8_BAR;
#undef PG8_SA
#undef PG8_SB
#undef PG8_STAGE
#undef PG8_LDA
#undef PG8_LDB
#undef PG8_MMA
#undef PG8_WAIT_V
#undef PG8_WAIT_L
#undef PG8_BAR
#undef PG8_SCHED
}
}

struct EpiInProj {
    bf16_t* ACT; bf16_t* VT; bf16_t* GB; float* out; const float* qng; const float* kng; const float* rope; LAS unsigned char* stg;
    __device__ __forceinline__ void operator()(f32x4 (&acc)[2][2][4][2], const pg8::Unit& u, int wr, int wc, int fr, int fq) const {
        const int pn = u.pn;
        int type = 0, slot = 0;
        if (pn < 2) { type = 1; slot = 4 * pn + wc; }
        else if (pn == 2 || (pn == 3 && wc < 2)) { type = 2; slot = 4 * (pn - 2) + wc; }
        else if (pn == 3 || pn == 4) { type = 3; slot = 4 * (pn - 3) + wc - 2; }
        const int rbase = u.pm * 256 + wr * 64 + fr;
        if (type == 1 || type == 2) {
            const float* gn = (type == 1) ? qng : kng;
            f32x4 g4[2][2];
#pragma unroll
            for (int bj = 0; bj < 2; ++bj)
#pragma unroll
                for (int n = 0; n < 2; ++n) g4[bj][n] = *(const f32x4*)(gn + 32 * bj + 16 * n + 4 * fq);
            const int br = slot >> 1, kvh = slot & 1;
#pragma unroll
            for (int ai = 0; ai < 2; ++ai)
#pragma unroll
                for (int m = 0; m < 4; ++m) {
                    const int row = rbase + ai * 128 + m * 16;
                    float ss = 0.f;
#pragma unroll
                    for (int bj = 0; bj < 2; ++bj)
#pragma unroll
                        for (int n = 0; n < 2; ++n) { const f32x4 v = acc[ai][bj][m][n]; ss += (v[0] * v[0] + v[1] * v[1]) + (v[2] * v[2] + v[3] * v[3]); }
                    ss += __shfl_xor(ss, 16); ss += __shfl_xor(ss, 32);
                    const float rinv = __builtin_amdgcn_rsqf(ss * (1.0f / 64.0f) + 1e-6f);
                    const int pos = (row < MP) ? (row & (SEQ - 1)) : SEQ;
                    const bool live = row < MTOT;
                    long obase = -1;
                    if (type == 2 && live) {
                        if (row < MP) {
                            const int t = row & (SEQ - 1), b = row >> 11;
                            if (br == 0) obase = (long)O_PKC + (long)row * 128 + kvh * 64;
                            else if (br == 1) obase = (long)O_PKS + (long)row * 128 + kvh * 64;
                            else if (t >= 1536) obase = (long)O_PKW + ((long)(b * 512 + t - 1536) * 2 + kvh) * 64;
                        } else {
                            const int sb = row - MP;
                            if (br == 0) obase = (long)O_SKC + sb * 128 + kvh * 64;
                            else if (br == 1) obase = (long)O_SKS + sb * 128 + kvh * 64;
                            else obase = (long)O_SKW + ((long)(sb * 512 + 511) * 2 + kvh) * 64;
                        }
                    }
                    u32x2 wst[2][2];
#pragma unroll
                    for (int n = 0; n < 2; ++n) {
                        const f32x4 cs0 = *(const f32x4*)(rope + ((size_t)pos * 32 + 16 * n + 4 * fq) * 2);
                        const f32x4 cs1 = *(const f32x4*)(rope + ((size_t)pos * 32 + 16 * n + 4 * fq) * 2 + 4);
                        const float cc[4] = {cs0[0], cs0[2], cs1[0], cs1[2]}, sn[4] = {cs0[1], cs0[3], cs1[1], cs1[3]};
                        f32x4 o0, o1;
#pragma unroll
                        for (int j = 0; j < 4; ++j) {
                            const float y0 = acc[ai][0][m][n][j] * rinv * g4[0][n][j], y1 = acc[ai][1][m][n][j] * rinv * g4[1][n][j];
                            o0[j] = y0 * cc[j] - y1 * sn[j]; o1[j] = y1 * cc[j] + y0 * sn[j];
                        }
                        const float qs = (type == 1) ? C2Q : 1.0f;
                        wst[0][n].x = cvt_pk_bf16(o0[0] * qs, o0[1] * qs); wst[0][n].y = cvt_pk_bf16(o0[2] * qs, o0[3] * qs); wst[1][n].x = cvt_pk_bf16(o1[0] * qs, o1[1] * qs); wst[1][n].y = cvt_pk_bf16(o1[2] * qs, o1[3] * qs);
                        if (type == 2 && obase >= 0) { const int dcol = 16 * n + 4 * fq; *(f32x4*)(out + obase + dcol) = o0; *(f32x4*)(out + obase + 32 + dcol) = o1; }
                    }
                    { const int row0 = row - fr; stage_store_rows(stg + (wr * 4 + wc) * EPI_WAVE, fq * 16 + fr, fr, fq, wst, ACT + (size_t)row0 * NIN + ((type == 1) ? LQ : LK) + 64 * slot, NIN, MTOT - row0); }
                }
        } else if (type == 3) {
            const int br = slot >> 1, kvh = slot & 1;
#pragma unroll
            for (int ai = 0; ai < 2; ++ai)
#pragma unroll
                for (int m = 0; m < 4; ++m) {
                    const int row = rbase + ai * 128 + m * 16;
                    if (row < MTOT) {
                        long obase = -1;
                        if (row < MP) {
                            const int t = row & (SEQ - 1), b = row >> 11;
                            if (br == 0) obase = (long)O_PVC + (long)row * 128 + kvh * 64;
                            else if (br == 1) obase = (long)O_PVS + (long)row * 128 + kvh * 64;
                            else if (t >= 1536) obase = (long)O_PVW + ((long)(b * 512 + t - 1536) * 2 + kvh) * 64;
                            bf16_t* vt = VT + ((size_t)(b * 6 + slot) * 64) * SEQ + t;
#pragma unroll
                            for (int bj = 0; bj < 2; ++bj)
#pragma unroll
                                for (int n = 0; n < 2; ++n)
#pragma unroll
                                    for (int j = 0; j < 4; ++j) vt[(size_t)(32 * bj + 16 * n + 4 * fq + j) * SEQ] = (bf16_t)f2bf(acc[ai][bj][m][n][j]);
                        } else {
                            const int sb = row - MP;
                            if (br == 0) obase = (long)O_SVC + sb * 128 + kvh * 64;
                            else if (br == 1) obase = (long)O_SVS + sb * 128 + kvh * 64;
                            else obase = (long)O_SVW + ((long)(sb * 512 + 511) * 2 + kvh) * 64;
                        }
                        if (obase >= 0) {
#pragma unroll
                            for (int bj = 0; bj < 2; ++bj)
#pragma unroll
                                for (int n = 0; n < 2; ++n) *(f32x4*)(out + obase + 32 * bj + 16 * n + 4 * fq) = acc[ai][bj][m][n];
                        }
                    }
                }
        } else if (pn >= 13 && pn <= 20) {
            bf16_t* gp = GB + ((size_t)((u.pm * 8 + (pn - 13)) * 8 + wr * 4 + wc) * 32) * 256 + (size_t)(fq * 16 + fr) * 4;
#pragma unroll
            for (int ai = 0; ai < 2; ++ai)
#pragma unroll
                for (int m = 0; m < 4; ++m)
#pragma unroll
                    for (int bj = 0; bj < 2; ++bj)
#pragma unroll
                        for (int n = 0; n < 2; ++n) {
                            const f32x4 v = acc[ai][bj][m][n];
                            u32x2 w; w.x = cvt_pk_bf16(sigmoidf_(v[0]), sigmoidf_(v[1])); w.y = cvt_pk_bf16(sigmoidf_(v[2]), sigmoidf_(v[3]));
                            *(u32x2*)(gp + (size_t)(((ai * 4 + m) * 2 + bj) * 2 + n) * 256) = w;
                        }
        } else {
            const int mode = (pn <= 6) ? 1 : (pn <= 10) ? 0 : (pn <= 12) ? 1 : 2;
            LAS unsigned char* sw = stg + (wr * 4 + wc) * EPI_WAVE; const int lane = fq * 16 + fr;
#pragma unroll
            for (int ai = 0; ai < 2; ++ai)
#pragma unroll
                for (int m = 0; m < 4; ++m) {
                    const int row0 = u.pm * 256 + wr * 64 + ai * 128 + m * 16;
                    u32x2 w[2][2];
#pragma unroll
                    for (int bj = 0; bj < 2; ++bj)
#pragma unroll
                        for (int n = 0; n < 2; ++n) {
                            f32x4 v = acc[ai][bj][m][n];
#pragma unroll
                            for (int j = 0; j < 4; ++j) { const float sg = sigmoidf_(v[j]); v[j] = (mode == 0) ? v[j] : (mode == 1) ? v[j] * sg : sg; }
                            w[bj][n].x = cvt_pk_bf16(v[0], v[1]); w[bj][n].y = cvt_pk_bf16(v[2], v[3]);
                        }
                    stage_store_rows(sw, lane, fr, fq, w, ACT + (size_t)row0 * NIN + 256 * pn + 64 * wc, NIN, MTOT - row0);
                }
        }
    }
};

struct EpiMix {
    const bf16_t* GB; bf16_t* M;
    __device__ __forceinline__ void operator()(f32x4 (&acc)[2][2][4][2], const pg8::Unit& u, int wr, int wc, int fr, int fq) const {
        const int rbase = u.pm * 256 + wr * 64 + fr, cbase = u.pn * 256 + 64 * wc + 4 * fq;
        const bf16_t* ga = GB + ((size_t)((u.pm * 8 + u.pn) * 8 + wr * 4 + wc) * 32) * 256 + (size_t)(fq * 16 + fr) * 4;
        const bf16_t* gb = ga + (size_t)4 * 8 * 32 * 256;
#pragma unroll
        for (int ai = 0; ai < 2; ++ai)
#pragma unroll
            for (int m = 0; m < 4; ++m) {
                const int row = rbase + ai * 128 + m * 16;
#pragma unroll
                for (int bj = 0; bj < 2; ++bj)
#pragma unroll
                    for (int n = 0; n < 2; ++n) {
                        const int fo = (((ai * 4 + m) * 2 + bj) * 2 + n) * 256;
                        float sb[4]; unpack4(*(const u32x2*)(gb + fo), sb);
                        if (u.keep) {
                            float sa[4]; unpack4(*(const u32x2*)(ga + fo), sa);
#pragma unroll
                            for (int j = 0; j < 4; ++j) acc[ai][bj][m][n][j] *= sa[j] * __builtin_amdgcn_rcpf(sb[j]);
                        } else if (row < MP) {
                            const f32x4 v = acc[ai][bj][m][n];
                            u32x2 w; w.x = cvt_pk_bf16(v[0] * sb[0], v[1] * sb[1]); w.y = cvt_pk_bf16(v[2] * sb[2], v[3] * sb[3]);
                            *(u32x2*)(M + (size_t)row * DM + cbase + 32 * bj + 16 * n) = w;
                        }
                    }
            }
    }
};

struct EpiOut {
    const float* xp; const float* xs; const float* MOD; float* out;
    __device__ __forceinline__ void operator()(f32x4 (&acc)[2][2][4][2], const pg8::Unit& u, int wr, int wc, int fr, int fq) const {
        const int rbase = u.pm * 256 + wr * 64 + fr, cbase = u.pn * 256 + wc * 32 + 4 * fq;
#pragma unroll
        for (int ai = 0; ai < 2; ++ai)
#pragma unroll
            for (int m = 0; m < 4; ++m) {
                const int row = rbase + ai * 128 + m * 16;
                if (row < MTOT) {
                    const float* xr; const float* gr; float* orow;
                    if (row < MP) { xr = xp + (size_t)row * DM; gr = MOD + (size_t)(row >> 11) * 3072 + 2048; orow = out + O_YP + (size_t)row * DM; }
                    else { const int sb = row - MP; xr = xs + (size_t)sb * DM; gr = MOD + (size_t)(8 + sb) * 3072 + 2048; orow = out + O_YS + (size_t)sb * DM; }
#pragma unroll
                    for (int bj = 0; bj < 2; ++bj)
#pragma unroll
                        for (int n = 0; n < 2; ++n) {
                            const int col = cbase + 128 * bj + 16 * n;
                            const f32x4 xv = *(const f32x4*)(xr + col), gv = *(const f32x4*)(gr + col);
                            *(f32x4*)(orow + col) = xv + gv * acc[ai][bj][m][n];
                        }
                }
            }
    }
};

__device__ __forceinline__ void transpose_item(const float* src, int src_ld, int nvalid, bf16_t* dst, int dst_ld, LAS float* scr, int lane) {
    float tv[32];
#pragma unroll
    for (int i = 0; i < 32; ++i) { const int kk = 2 * i + (lane >> 5), cc = lane & 31; tv[i] = src[(size_t)kk * src_ld + (cc < nvalid ? cc : 0)]; }
#pragma unroll
    for (int i = 0; i < 32; ++i) { const int kk = 2 * i + (lane >> 5), cc = lane & 31; scr[kk * 33 + cc] = (cc < nvalid) ? tv[i] : 0.f; }
    asm volatile("s_waitcnt lgkmcnt(0)" ::: "memory");
    const int c = lane & 7;
#pragma unroll
    for (int j = 0; j < 4; ++j) { const int n = (lane >> 3) + 8 * j; const LAS float* s = scr + (8 * c) * 33 + n;
        u32x4 o; o.x = pk2(s[0 * 33], s[1 * 33]); o.y = pk2(s[2 * 33], s[3 * 33]); o.z = pk2(s[4 * 33], s[5 * 33]); o.w = pk2(s[6 * 33], s[7 * 33]);
        *(u32x4*)(dst + (size_t)n * dst_ld + 8 * c) = o; }
    asm volatile("s_waitcnt lgkmcnt(0)" ::: "memory");
}

__device__ __forceinline__ void p0_prologue(const Params& P, LAS unsigned char* lds, int gw, int NGW, int lane_p, int wave, int gtid, int NT) {
    unsigned char* ws = P.ws;
    LAS float* scr = (LAS float*)(lds + wave * 16384);
    constexpr int I_MOD = 9 * 48, I_WIN = 16 * 176, I_WBR = 16 * 32, I_WOUT = 16 * 32, I_POOL = NSB * 16 * 2;
    constexpr int I_TOTAL = I_MOD + I_WIN + I_WBR + I_WOUT + I_POOL;
    constexpr int I_TR = I_WIN + I_WBR + I_WOUT;
    const bool modw = gw < I_MOD; const int NO = NGW - I_MOD, io = gw - I_MOD;
    for (int stp = 0;; ++stp) {
        int it;
        if (NGW < 2 * I_MOD) { it = gw + stp * NGW; if (it >= I_TOTAL) break; }
        else if (modw) { if (stp == 0) it = gw; else if (stp == 1) it = I_MOD + I_TR + gw; else break; }
        else { const int r = io + stp * NO; if (r >= I_TR + (I_POOL - I_MOD)) break; it = (r < I_TR) ? I_MOD + r : I_MOD + I_TR + I_MOD + (r - I_TR); }
        int lane = lane_p; asm volatile("" : "+v"(lane));
        if (it < I_MOD) {
            const int mt = it / 48, ng = it % 48, lr = lane & 15, kq = lane >> 4;
            int arow_i = 16 * mt + lr; if (arow_i > 135) arow_i = 135;
            const float* arow = ((arow_i < 8) ? P.in[9] + (size_t)arow_i * DM : P.in[10] + (size_t)(arow_i - 8) * DM) + 4 * kq;
            const float* bp = P.in[11] + (size_t)(4 * kq) * 3072 + 64 * ng + 4 * lr;
            f32x4 macc[4];
#pragma unroll
            for (int nt = 0; nt < 4; ++nt) macc[nt] = (f32x4){0.f, 0.f, 0.f, 0.f};
            f32x4 a0[4], b0[16], a1[4], b1[16];
#define MOD_LOAD(A_, B_, k0) do { _Pragma("unroll") for (int j = 0; j < 4; ++j) { A_[j] = *(const f32x4*)(arow + (k0) + 16 * j); \
                _Pragma("unroll") for (int e = 0; e < 4; ++e) B_[4 * j + e] = *(const f32x4*)(bp + (size_t)((k0) + 16 * j + e) * 3072); } } while (0)
#define MOD_MMA(A_, B_) do { _Pragma("unroll") for (int j = 0; j < 4; ++j) _Pragma("unroll") for (int e = 0; e < 4; ++e) _Pragma("unroll") for (int nt = 0; nt < 4; ++nt) \
                macc[nt] = __builtin_amdgcn_mfma_f32_16x16x4f32(A_[j][e], B_[4 * j + e][nt], macc[nt], 0, 0, 0); } while (0)
            MOD_LOAD(a0, b0, 0);
            for (int k0 = 0; k0 < DM; k0 += 128) {
                MOD_LOAD(a1, b1, k0 + 64);
                __builtin_amdgcn_sched_barrier(0);
                MOD_MMA(a0, b0);
                __builtin_amdgcn_sched_barrier(0);
                if (k0 + 128 < DM) MOD_LOAD(a0, b0, k0 + 128);
                __builtin_amdgcn_sched_barrier(0);
                MOD_MMA(a1, b1);
                __builtin_amdgcn_sched_barrier(0);
            }
#undef MOD_LOAD
#undef MOD_MMA
            float* MOD = (float*)(ws + WS_MOD);
            const f32x4 bb = *(const f32x4*)(P.in[12] + 64 * ng + 4 * lr);
#pragma unroll
            for (int r = 0; r < 4; ++r) { const int row = 16 * mt + 4 * kq + r;
                if (row < 136) *(f32x4*)(MOD + (size_t)row * 3072 + 64 * ng + 4 * lr) = (f32x4){macc[0][r] + bb[0], macc[1][r] + bb[1], macc[2][r] + bb[2], macc[3][r] + bb[3]}; }
            continue;
        }
        it -= I_MOD;
        if (it < I_WIN) {
            const int kb = it / 176, nb = it % 176;
            const int pn = nb >> 3, bj = (nb >> 2) & 1, wc = nb & 3;
            const int L0 = 256 * pn + 64 * wc + 32 * bj;
            int srcc, nvalid;
            if (L0 < 1280) { srcc = L0; nvalid = 32; } else if (L0 < LNSA) { srcc = L0 + 24; nvalid = 32; } else if (L0 == LNSA) { srcc = 1280; nvalid = 24; } else { srcc = 0; nvalid = 0; }
            transpose_item(P.in[14] + (size_t)(64 * kb) * 5400 + srcc, 5400, nvalid, (bf16_t*)(ws + WS_WTIN) + (size_t)(32 * nb) * DM + 64 * kb, DM, scr, lane);
            continue;
        }
        it -= I_WIN;
        if (it < I_WBR) {
            const int kb = it / 32, nb = it % 32;
            const float* src = (kb < 8) ? P.in[25] + (size_t)(64 * kb) * DM : P.in[26] + (size_t)(64 * (kb - 8)) * DM;
            const int L0 = 256 * (nb >> 3) + 64 * (nb & 3) + 32 * ((nb >> 2) & 1);
            transpose_item(src + L0, DM, 32, (bf16_t*)(ws + WS_WTBR) + (size_t)(32 * nb) * DM + 64 * kb, DM, scr, lane);
            continue;
        }
        it -= I_WBR;
        if (it < I_WOUT) {
            const int kb = it / 32, nb = it % 32;
            transpose_item(P.in[27] + (size_t)(64 * kb) * DM + 32 * nb, DM, 32, (bf16_t*)(ws + WS_WTOUT) + (size_t)(32 * nb) * DM + 64 * kb, DM, scr, lane);
            continue;
        }
        it -= I_WOUT;
        {
            const int sb = it >> 5, pg = (it >> 1) & 15, which = it & 1;
            const int page = ((const int*)P.in[8])[sb * 16 + pg];
            const float* src = P.in[2 + which] + (size_t)page * 128 * 128;
            const float* pe = P.in[17 + which]; const float* w = P.in[19 + which];
            const int d0 = (2 * lane) & 63;
            float p0 = 0.f, p1 = 0.f;
#pragma unroll 8
            for (int r = 0; r < 32; ++r) { const f32x2 v = *(const f32x2*)(pe + r * 64 + d0); p0 += v[0]; p1 += v[1]; }
#pragma unroll
            for (int cb = 0; cb < 4; ++cb) {
                f32x2 v[32];
#pragma unroll
                for (int r = 0; r < 32; ++r) v[r] = __builtin_nontemporal_load((const f32x2*)(src + (size_t)(cb * 32 + r) * 128 + 2 * lane));
                float s0 = 0.f, s1 = 0.f;
#pragma unroll
                for (int r = 0; r < 32; ++r) { s0 += v[r][0]; s1 += v[r][1]; }
                scr[d0 * 8 + cb * 2 + (lane >> 5)] = (s0 + p0) * (1.0f / 32.0f); scr[(d0 + 1) * 8 + cb * 2 + (lane >> 5)] = (s1 + p1) * (1.0f / 32.0f);
            }
            asm volatile("s_waitcnt lgkmcnt(0)" ::: "memory");
            float a[8];
#pragma unroll
            for (int q = 0; q < 8; ++q) a[q] = 0.f;
#pragma unroll 8
            for (int d = 0; d < 64; ++d) { const float wv = w[d * 64 + lane]; const f32x4 pa = *(const LAS f32x4*)(scr + d * 8), pb = *(const LAS f32x4*)(scr + d * 8 + 4);
                a[0] += pa[0] * wv; a[1] += pa[1] * wv; a[2] += pa[2] * wv; a[3] += pa[3] * wv; a[4] += pb[0] * wv; a[5] += pb[1] * wv; a[6] += pb[2] * wv; a[7] += pb[3] * wv; }
            float* dst = (float*)(ws + (which ? WS_VCS : WS_KCS));
#pragma unroll
            for (int q = 0; q < 8; ++q) dst[((size_t)(sb * 2 + (q & 1)) * 64 + 4 * pg + (q >> 1)) * 64 + lane] = a[q];
            asm volatile("s_waitcnt lgkmcnt(0)" ::: "memory");
        }
    }
    float* rope = (float*)(ws + WS_ROPE);
    for (int i = gtid; i < 2049 * 32; i += NT) {
        const int pos = i >> 5, k = i & 31;
        double invd = 1.0;
        for (int q = 0; q < k; ++q) invd *= 0.7498942093324559;
        const float ang = (float)pos * (float)invd;
        const double rev = (double)ang * 0.15915494309189535;
        const float fr = (float)(rev - __builtin_rint(rev));
        rope[2 * i] = __builtin_amdgcn_cosf(fr); rope[2 * i + 1] = __builtin_amdgcn_sinf(fr);
    }
    bf16_t* tril = (bf16_t*)(ws + WS_TRIL);
    for (int i = gtid; i < 4 * 128 * 128; i += NT) { const int r = (i >> 7) & 127, cidx = i & 127; tril[i] = (cidx <= r) ? (bf16_t)f2bf(P.in[23][i]) : (bf16_t)0; }
    for (int tk = blockIdx.x; tk < 2 * NSB * 2; tk += gridDim.x) {
        const int w2 = tk >> 8, sb = (tk >> 1) & 127, half = tk & 1;
        const f32x4* src = (const f32x4*)P.in[6 + w2] + (size_t)sb * 512 * 32 + 32 + half * 8176; f32x4* dst = (f32x4*)(P.out + (w2 ? O_SVW : O_SKW)) + (size_t)sb * 512 * 32 + half * 8176;
        f32x4 cv[16];
#pragma unroll
        for (int u = 0; u < 16; ++u) { const int i = threadIdx.x + 512 * u; if (i < 8176) cv[u] = __builtin_nontemporal_load(src + i); }
#pragma unroll
        for (int u = 0; u < 16; ++u) { const int i = threadIdx.x + 512 * u; if (i < 8176) __builtin_nontemporal_store(cv[u], dst + i); }
    }
}

__device__ __forceinline__ void p1_hrows(const Params& P, int gw, int NGW, int lane) {
    const float* MOD = (const float*)(P.ws + WS_MOD); bf16_t* H = (bf16_t*)(P.ws + WS_H); const float* ng = P.in[13];
    for (int row = gw; row < MPAD; row += NGW) {
        unsigned long long* o8 = (unsigned long long*)(H + (size_t)row * DM) + lane;
        if (row >= MTOT) {
#pragma unroll
            for (int j = 0; j < 4; ++j) o8[64 * j] = 0ull;
            continue; }
        const float* xr; const float* md;
        if (row < MP) { xr = P.in[0] + (size_t)row * DM; md = MOD + (size_t)(row >> 11) * 3072; } else { xr = P.in[1] + (size_t)(row - MP) * DM; md = MOD + (size_t)(8 + row - MP) * 3072; }
        f32x4 v[4]; float s = 0.f;
#pragma unroll
        for (int j = 0; j < 4; ++j) { v[j] = ((const f32x4*)xr)[lane + 64 * j]; s += (v[j][0] * v[j][0] + v[j][1] * v[j][1]) + (v[j][2] * v[j][2] + v[j][3] * v[j][3]); }
        const float rstd = rsqrtf(wave_sum(s) * (1.0f / DM) + 1e-6f);
#pragma unroll
        for (int j = 0; j < 4; ++j) {
            const int col = 4 * lane + 256 * j;
            const f32x4 g = *(const f32x4*)(ng + col), sh = *(const f32x4*)(md + col), sc = *(const f32x4*)(md + 1024 + col);
            const f32x4 h = (v[j] * rstd) * g * (sc + 1.0f) + sh;
            o8[64 * j] = (unsigned long long)pk2(h[0], h[1]) | ((unsigned long long)pk2(h[2], h[3]) << 32);
        }
    }
}

__device__ __forceinline__ void p3_compress(const Params& P, LAS unsigned char* lds, int gw, int NGW, int lane, int wave) {
    LAS float* scr = (LAS float*)(lds + wave * 1024);
    for (int it = gw; it < NBATCH * 64 * 2 * 2; it += NGW) {
        const int b = it >> 8, c = (it >> 2) & 63, kvh = (it >> 1) & 1, which = it & 1;
        const float* src = P.out + (which ? O_PVC : O_PKC) + ((size_t)(b * SEQ + 32 * c) * 2 + kvh) * 64;
        const float* pe = P.in[17 + which]; const float* w = P.in[19 + which];
        float s = 0.f;
#pragma unroll 8
        for (int r = 0; r < 32; ++r) s += src[(size_t)r * 128 + lane] + pe[r * 64 + lane];
        scr[lane] = s * (1.0f / 32.0f);
        asm volatile("s_waitcnt lgkmcnt(0)" ::: "memory");
        float a = 0.f;
#pragma unroll 8
        for (int d = 0; d < 64; ++d) a += scr[d] * w[d * 64 + lane];
        if (which == 0) ((bf16_t*)(P.ws + WS_KC))[((size_t)(b * 64 + c) * 2 + kvh) * 64 + lane] = (bf16_t)f2bf(a);
        else ((bf16_t*)(P.ws + WS_VCT))[((size_t)(b * 2 + kvh) * 64 + lane) * 64 + c] = (bf16_t)f2bf(a);
        asm volatile("s_waitcnt lgkmcnt(0)" ::: "memory");
    }
}

constexpr int A_TILE = 32768, A_IMP = 3 * A_TILE, A_IMPS = A_IMP + 8 * 32 * 33 * 4, A_SEL = A_IMPS + 2 * 32 * 33 * 4;
static_assert(A_SEL + 256 <= LDS_XB, "attention LDS map");
#define ATT_BAR() do { asm volatile("s_waitcnt lgkmcnt(0)" ::: "memory"); __builtin_amdgcn_s_barrier(); asm volatile("" ::: "memory"); } while (0)

struct TileSrc { const bf16_t* kb; const bf16_t* v0; const bf16_t* v1; unsigned kpitch, vpitch; };
__device__ __forceinline__ TileSrc attn_tile_src(const Params& P, int b, int T, int n_slc, int lo) {
    TileSrc s;
    if (T == 0) { s.kb = (const bf16_t*)(P.ws + WS_KC) + (size_t)b * 64 * 128; s.v0 = (const bf16_t*)(P.ws + WS_VCT) + (size_t)(b * 2) * 4096; s.v1 = s.v0 + 4096; s.kpitch = 128; s.vpitch = 64; }
    else {
        const bool slc = T <= n_slc; const int j = slc ? T - 1 : lo + (T - 1 - n_slc), br = slc ? 1 : 2;
        s.kb = (const bf16_t*)(P.ws + WS_ACT) + ((size_t)b * SEQ + 64 * j) * NIN + LK + 128 * br;
        s.v0 = (const bf16_t*)(P.ws + WS_VT) + ((size_t)(b * 6 + 2 * br) * 64) * SEQ + 64 * j; s.v1 = s.v0 + (size_t)64 * SEQ; s.kpitch = NIN; s.vpitch = SEQ;
    }
    return s;
}
__device__ __forceinline__ void attn_dma(LAS unsigned char* buf, const TileSrc& s, int wave, int lane_in) {
    int lane = lane_in; asm volatile("" : "+v"(lane));
    const int r = 8 * wave + (lane >> 3), ch = (lane & 7) ^ (lane >> 3);
#pragma unroll
    for (int i = 0; i < 2; ++i) {
        __builtin_amdgcn_global_load_lds((const unsigned*)(s.kb + (size_t)r * s.kpitch + i * 64 + ch * 8), (LAS unsigned*)(buf + (wave + 8 * i) * 1024), 16, 0, 0);
        __builtin_amdgcn_global_load_lds((const unsigned*)((i ? s.v1 : s.v0) + (size_t)r * s.vpitch + ch * 8), (LAS unsigned*)(buf + 16384 + (wave + 8 * i) * 1024), 16, 0, 0);
    }
}

constexpr float ATT_M0 = -30.f, ATT_THR = 12.f;
template <int MODE>
__device__ __forceinline__ void attn_tile(const LAS unsigned char* Kg, const LAS unsigned char* Vg, const bf16x8 (&qf)[2][2], f32x4 (&O)[4][2], float (&mrun)[2], float (&lrun)[2], f32x4 (&s)[2][4],
                                          int lane_in, int kbase, const int (&qpos)[2], const float (&cinit)[2], bool emask) {
    int lane = lane_in; asm volatile("" : "+v"(lane));
    const int lr = lane & 15, grp = lane >> 4, sw = lr & 7;
    const float c0[2] = {cinit[0] - mrun[0], cinit[1] - mrun[1]};
#pragma unroll
    for (int kt = 0; kt < 4; ++kt) {
        const bf16x8 k0 = *(const LAS bf16x8*)(Kg + (16 * kt + lr) * 128 + ((grp ^ sw) << 4));
        const bf16x8 k1 = *(const LAS bf16x8*)(Kg + (16 * kt + lr) * 128 + (((4 + grp) ^ sw) << 4));
#pragma unroll
        for (int qt = 0; qt < 2; ++qt) {
            const f32x4 a = __builtin_amdgcn_mfma_f32_16x16x32_bf16(k0, qf[qt][0], (f32x4){c0[qt], c0[qt], c0[qt], c0[qt]}, 0, 0, 0);
            s[qt][kt] = __builtin_amdgcn_mfma_f32_16x16x32_bf16(k1, qf[qt][1], a, 0, 0, 0);
        }
    }
    bf16x8 vf[2][4];
#pragma unroll
    for (int c2 = 0; c2 < 2; ++c2)
#pragma unroll
        for (int dt = 0; dt < 4; ++dt) {
            const LAS unsigned char* vr = Vg + (16 * dt + lr) * 128 + 8 * (grp & 1);
            const u32x2 lo = *(const LAS u32x2*)(vr + (((4 * c2 + (grp >> 1)) ^ sw) << 4));
            const u32x2 hi = *(const LAS u32x2*)(vr + (((4 * c2 + 2 + (grp >> 1)) ^ sw) << 4));
            const u32x4 vv = {lo.x, lo.y, hi.x, hi.y};
            vf[c2][dt] = __builtin_bit_cast(bf16x8, vv);
        }
    if (emask) {
#pragma unroll
        for (int qt = 0; qt < 2; ++qt)
#pragma unroll
            for (int kt = 0; kt < 4; ++kt)
#pragma unroll
                for (int r = 0; r < 4; ++r) {
                    const int key = 16 * kt + 4 * grp + r;
                    bool valid;
                    if (MODE == 0) valid = key < ((qpos[qt] + 1) >> 5);
                    else if (MODE == 1) valid = (kbase + key <= qpos[qt]);
                    else { const int kp = kbase + key; valid = (kp <= qpos[qt]) && (kp > qpos[qt] - 512); }
                    s[qt][kt][r] = valid ? s[qt][kt][r] : NEGBIG;
                }
    }
    float mx[2];
#pragma unroll
    for (int qt = 0; qt < 2; ++qt) {
        float m0 = fmaxf(fmaxf(s[qt][0][0], s[qt][0][1]), fmaxf(s[qt][0][2], s[qt][0][3]));
#pragma unroll
        for (int kt = 1; kt < 4; ++kt) m0 = fmaxf(m0, fmaxf(fmaxf(s[qt][kt][0], s[qt][kt][1]), fmaxf(s[qt][kt][2], s[qt][kt][3])));
        m0 = fmaxf(m0, __shfl_xor(m0, 16)); mx[qt] = fmaxf(m0, __shfl_xor(m0, 32));
    }
    if (__any((int)(fmaxf(mx[0], mx[1]) > ATT_THR))) {
#pragma unroll
        for (int qt = 0; qt < 2; ++qt) {
            const float delta = fmaxf(mx[qt], 0.f), f = __builtin_amdgcn_exp2f(-delta);
            mrun[qt] += delta; lrun[qt] *= f;
#pragma unroll
            for (int dt = 0; dt < 4; ++dt) O[dt][qt] *= f;
#pragma unroll
            for (int kt = 0; kt < 4; ++kt) s[qt][kt] -= delta;
        }
    }
#pragma unroll
    for (int qt = 0; qt < 2; ++qt) {
        float ls = 0.f;
#pragma unroll
        for (int kt = 0; kt < 4; ++kt)
#pragma unroll
            for (int r = 0; r < 4; ++r) { const float p = __builtin_amdgcn_exp2f(s[qt][kt][r]); s[qt][kt][r] = p; ls += p; }
        lrun[qt] += ls;
#pragma unroll
        for (int c2 = 0; c2 < 2; ++c2) {
            u32x4 w; w.x = cvt_pk_bf16(s[qt][2 * c2][0], s[qt][2 * c2][1]); w.y = cvt_pk_bf16(s[qt][2 * c2][2], s[qt][2 * c2][3]);
            w.z = cvt_pk_bf16(s[qt][2 * c2 + 1][0], s[qt][2 * c2 + 1][1]); w.w = cvt_pk_bf16(s[qt][2 * c2 + 1][2], s[qt][2 * c2 + 1][3]);
            const bf16x8 pf = __builtin_bit_cast(bf16x8, w);
#pragma unroll
            for (int dt = 0; dt < 4; ++dt) O[dt][qt] = __builtin_amdgcn_mfma_f32_16x16x32_bf16(vf[c2][dt], pf, O[dt][qt], 0, 0, 0);
        }
    }
}

__device__ __forceinline__ void attn_unit(const Params& P, LAS unsigned char* lds, int b, int qb32, int tid, int lane, int wave) {
    asm volatile("" : "+v"(tid), "+v"(lane));
    const bf16_t* ACT = (const bf16_t*)(P.ws + WS_ACT); bf16_t* AB = (bf16_t*)(P.ws + WS_AB);
    const int lr = lane & 15, grp = lane >> 4, g = wave >> 2;
    const int t0 = 32 * qb32, qblk = t0 >> 6; const size_t row0 = (size_t)b * SEQ + t0;
    const int n_slc = qblk + 1, lo = (t0 - 511 > 0) ? ((t0 - 511) >> 6) : 0, NT = 1 + n_slc + (qblk - lo + 1);
    LAS float* IMP = (LAS float*)(lds + A_IMP); LAS float* IMPS = (LAS float*)(lds + A_IMPS); LAS unsigned* SEL = (LAS unsigned*)(lds + A_SEL);
    bf16x8 qf[2][2]; int qpos[2]; float gate[2][3];
#pragma unroll
    for (int qt = 0; qt < 2; ++qt) {
        const size_t row = row0 + 16 * qt + lr; qpos[qt] = t0 + 16 * qt + lr;
#pragma unroll
        for (int ks = 0; ks < 2; ++ks) qf[qt][ks] = *(const bf16x8*)(ACT + row * NIN + LQ + 64 * wave + 32 * ks + 8 * grp);
#pragma unroll
        for (int br = 0; br < 3; ++br) gate[qt][br] = bf2f(ACT[row * NIN + LNSA + 3 * wave + br]);
    }
    f32x4 O[4][2], OA[4][2], s[2][4]; float mrun[2], lrun[2]; unsigned selm[2] = {0u, 0u};
#pragma unroll
    for (int dt = 0; dt < 4; ++dt)
#pragma unroll
        for (int qt = 0; qt < 2; ++qt) { O[dt][qt] = (f32x4){0.f, 0.f, 0.f, 0.f}; OA[dt][qt] = (f32x4){0.f, 0.f, 0.f, 0.f}; }
    mrun[0] = mrun[1] = ATT_M0; lrun[0] = lrun[1] = 0.f;
#define ATT_FINISH(br) do { _Pragma("unroll") for (int qt = 0; qt < 2; ++qt) { float lt = lrun[qt]; lt += __shfl_xor(lt, 16); lt += __shfl_xor(lt, 32); \
        const float f = (lt > 0.f) ? gate[qt][br] / lt : 0.f; _Pragma("unroll") for (int dt = 0; dt < 4; ++dt) { OA[dt][qt] += O[dt][qt] * f; O[dt][qt] = (f32x4){0.f, 0.f, 0.f, 0.f}; } \
        mrun[qt] = ATT_M0; lrun[qt] = 0.f; } } while (0)
    const float czero[2] = {0.f, 0.f};
    ATT_BAR();
    { const TileSrc s0 = attn_tile_src(P, b, 0, n_slc, lo); attn_dma(lds, s0, wave, lane); }
    { const TileSrc s1 = attn_tile_src(P, b, 1, n_slc, lo); attn_dma(lds + A_TILE, s1, wave, lane); }
    asm volatile("s_waitcnt vmcnt(4)" ::: "memory");
    ATT_BAR();
    { const TileSrc s2 = attn_tile_src(P, b, 2, n_slc, lo); attn_dma(lds + 2 * A_TILE, s2, wave, lane); }
    {
        attn_tile<0>(lds + g * 8192, lds + 16384 + g * 8192, qf, O, mrun, lrun, s, lane, 0, qpos, czero, true);
#pragma unroll
        for (int qt = 0; qt < 2; ++qt) {
            float lt = lrun[qt]; lt += __shfl_xor(lt, 16); lt += __shfl_xor(lt, 32);
            const float inv = (lt > 0.f) ? 1.0f / lt : 0.f;
#pragma unroll
            for (int kt = 0; kt < 4; ++kt)
#pragma unroll
                for (int rr = 0; rr < 2; ++rr) IMP[(wave * 32 + 16 * qt + lr) * 33 + 8 * kt + 2 * grp + rr] = (s[qt][kt][2 * rr] + s[qt][kt][2 * rr + 1]) * inv;
        }
        ATT_FINISH(0);
        ATT_BAR();
        for (int i = tid; i < 2 * 32 * 32; i += 512) { const int gg = i >> 10, q = (i >> 5) & 31, j = i & 31;
            IMPS[(gg * 32 + q) * 33 + j] = (IMP[((4 * gg + 0) * 32 + q) * 33 + j] + IMP[((4 * gg + 1) * 32 + q) * 33 + j]) + (IMP[((4 * gg + 2) * 32 + q) * 33 + j] + IMP[((4 * gg + 3) * 32 + q) * 33 + j]); }
        ATT_BAR();
        if (tid < 64) {
            const int gg = tid >> 5, q = tid & 31;
            unsigned mask = 1u | (1u << qblk);
            if (qblk - 1 <= 6) mask = (qblk >= 31) ? 0xffffffffu : ((2u << qblk) - 1u);
            else {
                const LAS float* v = IMPS + (gg * 32 + q) * 33;
                for (int pick = 0; pick < 6; ++pick) { float best = -1.f; int bi = 1;
                    for (int j = 1; j < qblk; ++j) { const float x = v[j]; if (!((mask >> j) & 1u) && x > best) { best = x; bi = j; } }
                    mask |= 1u << bi; }
            }
            SEL[gg * 32 + q] = mask;
        }
        asm volatile("s_waitcnt vmcnt(4)" ::: "memory");
        ATT_BAR();
        selm[0] = SEL[g * 32 + lr]; selm[1] = SEL[g * 32 + 16 + lr];
    }
    int cur = 1, nxt = 0;
    for (int T = 1; T < NT; ++T) {
        const bool more = T + 2 < NT;
        if (more) { const TileSrc sn = attn_tile_src(P, b, T + 2, n_slc, lo); attn_dma(lds + nxt * A_TILE, sn, wave, lane); }
        const LAS unsigned char* Kg = lds + cur * A_TILE + g * 8192; const LAS unsigned char* Vg = Kg + 16384;
        if (T <= n_slc) {
            const int jb = T - 1;
            const float cin[2] = {((selm[0] >> jb) & 1u) ? 0.f : NEGBIG, ((selm[1] >> jb) & 1u) ? 0.f : NEGBIG};
            if (__any((int)(((selm[0] | selm[1]) >> jb) & 1u))) attn_tile<1>(Kg, Vg, qf, O, mrun, lrun, s, lane, 64 * jb, qpos, cin, jb == qblk);
            if (T == n_slc) ATT_FINISH(1);
        } else {
            const int jt = lo + (T - 1 - n_slc);
            const bool em = (64 * jt + 63 > t0) || (64 * jt <= t0 + 31 - 512);
            attn_tile<2>(Kg, Vg, qf, O, mrun, lrun, s, lane, 64 * jt, qpos, czero, em);
            if (T == NT - 1) ATT_FINISH(2);
        }
        if (more) asm volatile("s_waitcnt vmcnt(4)" ::: "memory"); else asm volatile("s_waitcnt vmcnt(0)" ::: "memory");
        ATT_BAR();
        cur = (cur == 2) ? 0 : cur + 1; nxt = (nxt == 2) ? 0 : nxt + 1;
    }
#undef ATT_FINISH
#pragma unroll
    for (int qt = 0; qt < 2; ++qt) {
        const size_t row = row0 + 16 * qt + lr;
#pragma unroll
        for (int dt = 0; dt < 4; ++dt) {
            const int col = 64 * wave + 16 * dt + 4 * grp;
            float za[4]; unpack4(*(const u32x2*)(ACT + row * NIN + LZA + col), za);
            u32x2 w; w.x = cvt_pk_bf16(OA[dt][qt][0] * za[0], OA[dt][qt][1] * za[1]); w.y = cvt_pk_bf16(OA[dt][qt][2] * za[2], OA[dt][qt][3] * za[3]);
            *(u32x2*)(AB + row * DM + col) = w;
        }
    }
}

constexpr int G_ST = 0, G_VNT = 1024, VPITCH = 136;
__device__ __forceinline__ void gmlp_unit(const Params& P, LAS unsigned char* lds, int b, int ch, int gp, int tid, int lane, int wave) {
    asm volatile("" : "+v"(tid), "+v"(lane));
    const bf16_t* ACT = (const bf16_t*)(P.ws + WS_ACT); bf16_t* AB = (bf16_t*)(P.ws + WS_AB);
    LAS f32x2* ST = (LAS f32x2*)(lds + G_ST); LAS bf16_t* Vnt = (LAS bf16_t*)(lds + G_VNT);
    const size_t R0 = (size_t)b * SEQ + 128 * ch;
    __syncthreads();
    {
        u32x4 raw[16];
#pragma unroll
        for (int i = 0; i < 16; ++i) raw[i] = *(const u32x4*)(ACT + (R0 + wave + 8 * i) * NIN + LVB + 8 * lane);
#pragma unroll
        for (int i = 0; i < 16; ++i) {
            float f[8]; f[0] = bf2f(raw[i].x); f[1] = bf2f(raw[i].x >> 16); f[2] = bf2f(raw[i].y); f[3] = bf2f(raw[i].y >> 16); f[4] = bf2f(raw[i].z); f[5] = bf2f(raw[i].z >> 16); f[6] = bf2f(raw[i].w); f[7] = bf2f(raw[i].w >> 16);
            float sm = 0.f, sq = 0.f;
#pragma unroll
            for (int e = 0; e < 8; ++e) { sm += f[e]; sq += f[e] * f[e]; }
#pragma unroll
            for (int o = 1; o < 64; o <<= 1) { sm += __shfl_xor(sm, o); sq += __shfl_xor(sq, o); }
            const float mean = sm * (1.0f / 512.0f), var = fmaxf(sq * (1.0f / 512.0f) - mean * mean, 0.f);
            if (lane == 0) ST[wave + 8 * i] = (f32x2){mean, rsqrtf(var + 1e-6f)};
        }
    }
    __syncthreads();
    {
        const float* vg = P.in[21] + 256 * gp; const float* vb = P.in[22] + 256 * gp;
        u32x4 raw[8];
#pragma unroll
        for (int i = 0; i < 8; ++i) { const int idx = tid + 512 * i, j = idx & 127, chn = idx >> 7; raw[i] = *(const u32x4*)(ACT + (R0 + j) * NIN + LVB + 256 * gp + 8 * chn); }
#pragma unroll
        for (int i = 0; i < 8; ++i) {
            const int idx = tid + 512 * i, j = idx & 127, chn = idx >> 7;
            const f32x2 st = ST[j];
            float f[8]; f[0] = bf2f(raw[i].x); f[1] = bf2f(raw[i].x >> 16); f[2] = bf2f(raw[i].y); f[3] = bf2f(raw[i].y >> 16); f[4] = bf2f(raw[i].z); f[5] = bf2f(raw[i].z >> 16); f[6] = bf2f(raw[i].w); f[7] = bf2f(raw[i].w >> 16);
#pragma unroll
            for (int e = 0; e < 8; ++e) { const int d = 8 * chn + e; Vnt[d * VPITCH + j] = (bf16_t)f2bf((f[e] - st[0]) * st[1] * vg[d] + vb[d]); }
        }
    }
    __syncthreads();
    const int lr = lane & 15, grp = lane >> 4, g = 2 * gp + (wave >> 2);
    const bf16_t* tril = (const bf16_t*)(P.ws + WS_TRIL) + (size_t)g * 128 * 128;
    f32x4 acc[2][8];
#pragma unroll
    for (int t2 = 0; t2 < 2; ++t2)
#pragma unroll
        for (int it = 0; it < 8; ++it) acc[t2][it] = (f32x4){0.f, 0.f, 0.f, 0.f};
#pragma unroll
    for (int ks = 0; ks < 4; ++ks) {
        const bf16x8 af0 = *(const LAS bf16x8*)(Vnt + (32 * wave + lr) * VPITCH + 32 * ks + 8 * grp);
        const bf16x8 af1 = *(const LAS bf16x8*)(Vnt + (32 * wave + 16 + lr) * VPITCH + 32 * ks + 8 * grp);
#pragma unroll
        for (int it = 0; it < 8; ++it) {
            if ((it >> 1) >= ks) { const bf16x8 bfr = *(const bf16x8*)(tril + (size_t)(16 * it + lr) * 128 + 32 * ks + 8 * grp);
                acc[0][it] = __builtin_amdgcn_mfma_f32_16x16x32_bf16(af0, bfr, acc[0][it], 0, 0, 0); acc[1][it] = __builtin_amdgcn_mfma_f32_16x16x32_bf16(af1, bfr, acc[1][it], 0, 0, 0); }
        }
    }
    const float* bs = P.in[24] + 128 * g;
#pragma unroll
    for (int it = 0; it < 8; ++it) {
        const int i = 16 * it + lr; const size_t row = R0 + i;
        const float bsi = bs[i];
#pragma unroll
        for (int t2 = 0; t2 < 2; ++t2) {
            const int d0 = 256 * gp + 32 * wave + 16 * t2 + 4 * grp;
            float uu[4], zb[4]; unpack4(*(const u32x2*)(ACT + row * NIN + LU + d0), uu); unpack4(*(const u32x2*)(ACT + row * NIN + LZB + d0), zb);
            u32x2 w; w.x = cvt_pk_bf16(uu[0] * (acc[t2][it][0] + bsi) * zb[0], uu[1] * (acc[t2][it][1] + bsi) * zb[1]); w.y = cvt_pk_bf16(uu[2] * (acc[t2][it][2] + bsi) * zb[2], uu[3] * (acc[t2][it][3] + bsi) * zb[3]);
            *(u32x2*)(AB + row * DM + 512 + d0) = w;
        }
    }
}

__device__ __forceinline__ void stile(const float* kb, const float* vb, int stride, int kmin, const f32x4 (&q4)[4], float (&m)[4], float (&l)[4], f32x4 (&o4)[4], float (&pout)[4], int lane_in) {
    int lane = lane_in; asm volatile("" : "+v"(lane));
    const int li = lane & 15, gq = lane >> 4;
    __builtin_amdgcn_sched_barrier(0);
    const float* kl = kb + (size_t)(gq * stride + 4 * li); const float* vl = vb + (size_t)(gq * stride + 4 * li);
    f32x4 kreg[16], vreg[16];
#pragma unroll
    for (int i = 0; i < 16; ++i) kreg[i] = __builtin_nontemporal_load((const f32x4*)(kl + (size_t)(4 * i) * stride));
#pragma unroll
    for (int i = 0; i < 16; ++i) vreg[i] = __builtin_nontemporal_load((const f32x4*)(vl + (size_t)(4 * i) * stride));
    float sc[4];
#pragma unroll
    for (int h = 0; h < 4; ++h) {
        float v[16], w8[8], w4[4], w2[2];
#pragma unroll
        for (int i = 0; i < 16; ++i) v[i] = (kreg[i][0] * q4[h][0] + kreg[i][1] * q4[h][1]) + (kreg[i][2] * q4[h][2] + kreg[i][3] * q4[h][3]);
#pragma unroll
        for (int t = 0; t < 8; ++t) { const float snd = (li & 8) ? v[t] : v[t + 8], kp = (li & 8) ? v[t + 8] : v[t]; w8[t] = kp + __shfl_xor(snd, 8); }
#pragma unroll
        for (int t = 0; t < 4; ++t) { const float snd = (li & 4) ? w8[t] : w8[t + 4], kp = (li & 4) ? w8[t + 4] : w8[t]; w4[t] = kp + __shfl_xor(snd, 4); }
#pragma unroll
        for (int t = 0; t < 2; ++t) { const float snd = (li & 2) ? w4[t] : w4[t + 2], kp = (li & 2) ? w4[t + 2] : w4[t]; w2[t] = kp + __shfl_xor(snd, 2); }
        { const float snd = (li & 1) ? w2[0] : w2[1], kp = (li & 1) ? w2[1] : w2[0]; sc[h] = kp + __shfl_xor(snd, 1); }
        __builtin_amdgcn_sched_barrier(0);
    }
    const bool valid = (4 * li + gq) >= kmin;
#pragma unroll
    for (int h = 0; h < 4; ++h) {
        const float sv = valid ? sc[h] : NEGBIG;
        const float mnew = fmaxf(m[h], wave_max(sv));
        const float alpha = __builtin_amdgcn_exp2f(m[h] - mnew), p = __builtin_amdgcn_exp2f(sv - mnew);
        l[h] = l[h] * alpha + wave_sum(p); o4[h] *= alpha; m[h] = mnew; pout[h] = p;
    }
    const int src0 = lane & 48;
#pragma unroll
    for (int i = 0; i < 16; ++i) {
#pragma unroll
        for (int h = 0; h < 4; ++h) o4[h] += vreg[i] * __shfl(pout[h], src0 + i);
    }
    __builtin_amdgcn_sched_barrier(0);
}
__device__ __forceinline__ void skey(const float* kb, const float* vb, const f32x4 (&q4)[4], float (&m)[4], float (&l)[4], f32x4 (&o4)[4], int lane) {
    const int li = lane & 15, gq = lane >> 4;
    const f32x4 kd = *(const f32x4*)(kb + 4 * li), vd = *(const f32x4*)(vb + 4 * li);
#pragma unroll
    for (int h = 0; h < 4; ++h) {
        float sv = (kd[0] * q4[h][0] + kd[1] * q4[h][1]) + (kd[2] * q4[h][2] + kd[3] * q4[h][3]);
        sv += __shfl_xor(sv, 1); sv += __shfl_xor(sv, 2); sv += __shfl_xor(sv, 4); sv += __shfl_xor(sv, 8);
        const float mnew = fmaxf(m[h], sv), alpha = __builtin_amdgcn_exp2f(m[h] - mnew), p = __builtin_amdgcn_exp2f(sv - mnew);
        l[h] = l[h] * alpha + p; o4[h] *= alpha; if (gq == 0) o4[h] += vd * p; m[h] = mnew;
    }
}

constexpr int S_ST = 0, S_MISC = 8 * 3 * 4 * 66 * 4;
__device__ __forceinline__ void sample_unit(const Params& P, LAS unsigned char* lds, int sb, int g, int tid, int lane, int wave) {
    const bf16_t* ACT = (const bf16_t*)(P.ws + WS_ACT); bf16_t* AB = (bf16_t*)(P.ws + WS_AB);
    LAS float* ST = (LAS float*)(lds + S_ST); LAS float* MISC = (LAS float*)(lds + S_MISC);
    const size_t row = (size_t)MP + sb;
    const int* ptab = (const int*)P.in[8] + sb * 16;
    const int li = lane & 15;
    __syncthreads();
    f32x4 q4[4];
#pragma unroll
    for (int h = 0; h < 4; ++h) { float t4[4]; unpack4(*(const u32x2*)(ACT + row * NIN + LQ + 64 * (4 * g + h) + 4 * li), t4); q4[h] = (f32x4){t4[0], t4[1], t4[2], t4[3]}; }
    float ms[4], ls[4]; f32x4 os[4];
#define S_RESET() do { _Pragma("unroll") for (int h = 0; h < 4; ++h) { ms[h] = MINIT; ls[h] = 0.f; os[h] = (f32x4){0.f, 0.f, 0.f, 0.f}; } } while (0)
#define S_PUBLISH(b2, doit) do { _Pragma("unroll") for (int h = 0; h < 4; ++h) { f32x4 v = os[h]; \
        _Pragma("unroll") for (int e = 0; e < 4; ++e) { float x = v[e]; x += __shfl_xor(x, 16); x += __shfl_xor(x, 32); v[e] = x; } \
        if (doit) { LAS float* st = ST + ((wave * 3 + (b2)) * 4 + h) * 66; if (lane < 16) *(LAS f32x4*)(st + 4 * lane) = v; if (lane == 0) { st[64] = ms[h]; st[65] = ls[h]; } } } } while (0)
    float pdummy[4], pc[4];
    S_RESET();
    { const size_t off = (((size_t)sb * 512 + 64 * wave) * 2 + g) * 64; stile(P.in[6] + off, P.in[7] + off, 128, (wave == 0) ? 1 : 0, q4, ms, ls, os, pdummy, lane); }
    if (wave == 0) { const size_t off = ((size_t)(sb * 512 + 511) * 2 + g) * 64; skey(P.out + O_SKW + off, P.out + O_SVW + off, q4, ms, ls, os, lane); }
    S_PUBLISH(1, true);
    S_RESET();
    stile((const float*)(P.ws + WS_KCS) + (size_t)(sb * 2 + g) * 4096, (const float*)(P.ws + WS_VCS) + (size_t)(sb * 2 + g) * 4096, 64, 0, q4, ms, ls, os, pc, lane);
    float imp = 0.f;
#pragma unroll
    for (int h = 0; h < 4; ++h) { const float pn = pc[h] / ls[h]; imp += pn + __shfl_down(pn, 16); }
    S_PUBLISH(2, wave == 0);
    const int jblk = 2 * li + (lane >> 5);
    const bool cand = ((lane >> 4) & 1) == 0 && jblk >= 1;
    unsigned key = cand ? ((__builtin_bit_cast(unsigned, imp) & 0xffffffe0u) | (unsigned)(31 - jblk)) : 0u;
    unsigned long long selpack = 0ull;
#pragma unroll
    for (int pick = 0; pick < 6; ++pick) {
        unsigned best = key;
#pragma unroll
        for (int o2 = 1; o2 < 64; o2 <<= 1) { const unsigned other = (unsigned)__shfl_xor((int)best, o2); best = other > best ? other : best; }
        const int bj = 31 - (int)(best & 31u);
        selpack |= (unsigned long long)bj << (5 * (pick + 1));
        if (cand && jblk == bj) key = 0u;
    }
    S_RESET();
    if (wave < 7) { const int blk = (int)((selpack >> (5 * wave)) & 31ull); const int page = __builtin_amdgcn_readfirstlane(ptab[blk >> 1]); const size_t off = (((size_t)page * 128 + (blk & 1) * 64) * 2 + g) * 64;
        stile(P.in[4] + off, P.in[5] + off, 128, 0, q4, ms, ls, os, pdummy, lane); }
    else skey(P.out + O_SKS + (size_t)sb * 128 + g * 64, P.out + O_SVS + (size_t)sb * 128 + g * 64, q4, ms, ls, os, lane);
    S_PUBLISH(0, true);
#undef S_RESET
#undef S_PUBLISH
    if (wave == 7) {
        const u32x4 raw = *(const u32x4*)(ACT + row * NIN + LVB + 8 * lane);
        float f[8]; f[0] = bf2f(raw.x); f[1] = bf2f(raw.x >> 16); f[2] = bf2f(raw.y); f[3] = bf2f(raw.y >> 16); f[4] = bf2f(raw.z); f[5] = bf2f(raw.z >> 16); f[6] = bf2f(raw.w); f[7] = bf2f(raw.w >> 16);
        float sm = 0.f;
#pragma unroll
        for (int i = 0; i < 8; ++i) sm += f[i];
        const float mean = wave_sum(sm) * (1.0f / 512.0f); float sq = 0.f;
#pragma unroll
        for (int i = 0; i < 8; ++i) { const float d = f[i] - mean; sq += d * d; }
        const float rstd = rsqrtf(wave_sum(sq) * (1.0f / 512.0f) + 1e-6f);
        if (lane == 0) { MISC[0] = mean; MISC[1] = rstd; }
    }
    __syncthreads();
    if (wave < 4) {
        const int h = wave, head = 4 * g + h;
        const LAS float* stc = ST + ((0 * 3 + 2) * 4 + h) * 66;
        float oa = bf2f(ACT[row * NIN + LNSA + 3 * head + 0]) * stc[lane] / stc[65];
#pragma unroll
        for (int b2 = 0; b2 < 2; ++b2) {
            float M = MINIT;
#pragma unroll
            for (int w = 0; w < 8; ++w) M = fmaxf(M, ST[((w * 3 + b2) * 4 + h) * 66 + 64]);
            float L = 0.f, O = 0.f;
#pragma unroll
            for (int w = 0; w < 8; ++w) { const LAS float* st = ST + ((w * 3 + b2) * 4 + h) * 66; const float f = __builtin_amdgcn_exp2f(st[64] - M); L += st[65] * f; O += st[lane] * f; }
            oa += bf2f(ACT[row * NIN + LNSA + 3 * head + 1 + b2]) * O / L;
        }
        const int col = 64 * head + lane;
        AB[row * DM + col] = (bf16_t)f2bf(oa * bf2f(ACT[row * NIN + LZA + col]));
    }
    if (tid < 256) {
        const int d = 256 * g + tid, gm = d >> 7;
        const float vn = (bf2f(ACT[row * NIN + LVB + d]) - MISC[0]) * MISC[1] * P.in[21][d] + P.in[22][d];
        P.out[O_SVCH + (size_t)sb * 512 + d] = vn;
        const float sv = P.in[23][(size_t)gm * 128 * 128] * vn + P.in[24][gm * 128];
        AB[row * DM + 512 + d] = (bf16_t)f2bf(bf2f(ACT[row * NIN + LU + d]) * sv * bf2f(ACT[row * NIN + LZB + d]));
    }
}

template <int MODE>
__device__ __forceinline__ void small_gemm(const Params& P, int c, int G, int wave, int lane) {
    const int lr = lane & 15, grp = lane >> 4;
    for (int t = c + G * wave; t < 512; t += G * 8) {
        const int rt = t & 7, ct = t >> 3;
        const size_t row = (size_t)MP + 16 * rt + lr;
        const bf16_t* A = (const bf16_t*)(P.ws + (MODE == 0 ? WS_AB : WS_H)) + row * DM + 8 * grp;
        const int wrow = (MODE == 0) ? (256 * (ct >> 4) + 128 * ((ct >> 1) & 1) + 32 * ((ct >> 2) & 3) + 16 * (ct & 1) + lr) : (16 * ct + lr);
        const bf16_t* W = (const bf16_t*)(P.ws + (MODE == 0 ? WS_WTBR : WS_WTOUT)) + (size_t)wrow * DM + 8 * grp;
        f32x4 acc0 = (f32x4){0.f, 0.f, 0.f, 0.f}, acc1 = (f32x4){0.f, 0.f, 0.f, 0.f};
#pragma unroll 8
        for (int ks = 0; ks < 16; ++ks) acc0 = __builtin_amdgcn_mfma_f32_16x16x32_bf16(*(const bf16x8*)(W + 32 * ks), *(const bf16x8*)(A + 32 * ks), acc0, 0, 0, 0);
#pragma unroll 8
        for (int ks = 16; ks < 32; ++ks) acc1 = __builtin_amdgcn_mfma_f32_16x16x32_bf16(*(const bf16x8*)(W + 32 * ks), *(const bf16x8*)(A + 32 * ks), acc1, 0, 0, 0);
        const int col = 16 * ct + 4 * grp;
        if (MODE == 0) {
            const int i = 16 * rt + lr, cc = col & 255;
            const size_t go = ((size_t)(((64 * 8 + (col >> 8)) * 8 + (i >> 6) * 4 + (cc >> 6)) * 32 + ((((i >> 4) & 3) * 2 + ((cc >> 5) & 1)) * 2 + ((cc >> 4) & 1))) * 64 + ((cc >> 2) & 3) * 16 + (i & 15)) * 4;
            const bf16_t* GB = (const bf16_t*)(P.ws + WS_GBUF);
            float sa[4], sb[4]; unpack4(*(const u32x2*)(GB + go), sa); unpack4(*(const u32x2*)(GB + go + (size_t)4 * 8 * 32 * 256), sb);
            u32x2 w; w.x = cvt_pk_bf16(sa[0] * acc0[0] + sb[0] * acc1[0], sa[1] * acc0[1] + sb[1] * acc1[1]); w.y = cvt_pk_bf16(sa[2] * acc0[2] + sb[2] * acc1[2], sa[3] * acc0[3] + sb[3] * acc1[3]);
            *(u32x2*)((bf16_t*)(P.ws + WS_H) + row * DM + col) = w;
        } else {
            const int sbi = 16 * rt + lr;
            const f32x4 xv = *(const f32x4*)(P.in[1] + (size_t)sbi * DM + col), gv = *(const f32x4*)((const float*)(P.ws + WS_MOD) + (size_t)(8 + sbi) * 3072 + 2048 + col);
            *(f32x4*)(P.out + O_YS + (size_t)sbi * DM + col) = xv + gv * (acc0 + acc1);
        }
    }
}

#define XB_TMO      128
#define XB_XCNT(j)  (256  + 64 * (j))
#define XB_XSUB(j)  (1280 + 64 * (j))
#define XB_XGEN(j)  (2304 + 64 * (j))
#define XB_TOP      3328
#define XB_TOPGEN   3392
#define XCD_BAR_WORDS 3456
#define XB_SPIN_CAP (1u << 18)
__device__ __forceinline__ unsigned xb_ld(unsigned* p)              { return __hip_atomic_load(p, __ATOMIC_RELAXED, __HIP_MEMORY_SCOPE_AGENT); }
__device__ __forceinline__ unsigned xb_add(unsigned* p, unsigned v) { return __hip_atomic_fetch_add(p, v, __ATOMIC_RELAXED, __HIP_MEMORY_SCOPE_AGENT); }
__device__ __forceinline__ unsigned xb_xcc_id() { return (unsigned)__builtin_amdgcn_s_getreg((3 << 11) | 20) & 0xFu; }
#define XB_SPIN(cond, bar) do { unsigned _sp = 0; while (cond) { __builtin_amdgcn_s_sleep(1); \
    if ((++_sp & 255u) == 0u) { if (xb_ld(&(bar)[XB_TMO])) break; if (_sp > XB_SPIN_CAP) { atomicAdd(&(bar)[XB_TMO], 1u); break; } } } } while (0)
struct XcdBarrier { unsigned* bar; unsigned x; volatile LAS unsigned* st; };
__device__ __forceinline__ XcdBarrier xcd_barrier_post(unsigned* bar, volatile LAS unsigned* st) {
    XcdBarrier b; b.bar = bar; b.x = xb_xcc_id(); b.st = st;
    if (threadIdx.x == 0) (void)xb_add(&bar[XB_XCNT(b.x)], 1u);
    return b;
}
__device__ __forceinline__ void xcd_barrier_complete(unsigned* bar, unsigned x, unsigned& nloc, unsigned& nx) {
    const unsigned G = gridDim.x * gridDim.y * gridDim.z;
    unsigned sum, cnt, mine, sp = 0u;
    for (;;) {
        sum = 0u; cnt = 0u; mine = 0u;
#pragma unroll
        for (unsigned j = 0; j < 16; ++j) { const unsigned c = xb_ld(&bar[XB_XCNT(j)]); sum += c; cnt += (c > 0u) ? 1u : 0u; mine = (j == x) ? c : mine; }
        if (sum == G) break;
        __builtin_amdgcn_s_sleep(1);
        if ((++sp & 255u) == 0u) { if (xb_ld(&bar[XB_TMO])) break; if (sp > XB_SPIN_CAP) { atomicAdd(&bar[XB_TMO], 1u); break; } }
    }
    nloc = mine > 0u ? mine : 1u; nx = cnt > 0u ? cnt : 1u;
}
__device__ __forceinline__ void xcd_barrier(const XcdBarrier& b) {
    asm volatile("s_waitcnt vmcnt(0)" ::: "memory");
    __syncthreads();
    if (threadIdx.x == 0) {
        unsigned* bar = b.bar;
        __builtin_amdgcn_s_waitcnt(0);
        unsigned nloc = b.st[0], nx = b.st[1];
        if (nloc == 0u) { xcd_barrier_complete(bar, b.x, nloc, nx); b.st[0] = nloc; b.st[1] = nx; }
        const unsigned old = xb_add(&bar[XB_XSUB(b.x)], 1u);
        const unsigned gen = old / nloc;
        if (old + 1u == (gen + 1u) * nloc) {
            __builtin_amdgcn_fence(__ATOMIC_RELEASE, "agent");
            asm volatile("s_waitcnt vmcnt(0)" ::: "memory");
            const unsigned og = xb_add(&bar[XB_TOP], 1u);
            const unsigned tg = og / nx;
            if (og + 1u == (tg + 1u) * nx) xb_add(&bar[XB_TOPGEN], 1u);
            else XB_SPIN(xb_ld(&bar[XB_TOPGEN]) == tg, bar);
            __builtin_amdgcn_fence(__ATOMIC_ACQUIRE, "agent");
            xb_add(&bar[XB_XGEN(b.x)], 1u);
            asm volatile("s_waitcnt vmcnt(0)" ::: "memory");
        } else {
            XB_SPIN(xb_ld(&bar[XB_XGEN(b.x)]) == gen, bar);
            __builtin_amdgcn_fence(__ATOMIC_ACQUIRE, "agent");
            asm volatile("s_waitcnt vmcnt(0)" ::: "memory");
        }
    }
    __syncthreads();
}

__global__ void __launch_bounds__(512, 2) mk_fwd(Params P) {
    extern __shared__ __attribute__((aligned(16))) unsigned char lds_raw[];
    LAS unsigned char* lds = (LAS unsigned char*)lds_raw;
    const int tid = threadIdx.x, lane = tid & 63, wave = __builtin_amdgcn_readfirstlane(tid >> 6);
    const int G = gridDim.x, c = blockIdx.x, gw = c * 8 + wave, NGW = G * 8, gtid = c * 512 + tid, NT = G * 512;
    cg::grid_group grid = cg::this_grid();
    const int lo = P.ph_lo, hi = P.ph_hi;
    if (tid < 16) ((LAS unsigned*)(lds + LDS_XB))[tid] = 0u;
    __syncthreads();
    const XcdBarrier bar = xcd_barrier_post((unsigned*)(P.ws + WS_CTL), (volatile LAS unsigned*)(lds + LDS_XB));
    if (hi < 0) grid.sync();
#define IN(k) (lo <= (k) && (k) < hi)
#define SEAM(k) do { if (IN(k) && IN((k) + 1)) xcd_barrier(bar); } while (0)
    unsigned char* ws = P.ws;
    if (IN(0)) for (int rep = 0; rep < MK_REP0; ++rep) { p0_prologue(P, lds, gw, NGW, lane, wave, gtid, NT); }
    SEAM(0);
    if (IN(1)) for (int rep = 0; rep < MK_REP1; ++rep) { p1_hrows(P, gw, NGW, lane); }
    SEAM(1);
    if (IN(2)) for (int rep = 0; rep < MK_REP2; ++rep) {
        pg8::Gemm gm{(const bf16_t*)(ws + WS_H), (const bf16_t*)(ws + WS_WTIN), DM, DM, DM};
        pg8::StaticOrder S; S.init(MPAD / 256, NIN / 256, G, c);
        EpiInProj E{(bf16_t*)(ws + WS_ACT), (bf16_t*)(ws + WS_VT), (bf16_t*)(ws + WS_GBUF), P.out, P.in[15], P.in[16], (const float*)(ws + WS_ROPE), lds + LDS_EPI};
        pg8::gemm_phase<EpiInProj, pg8::StaticOrder>(lds, gm, S, E);
    }
    SEAM(2);
    if (IN(3)) for (int rep = 0; rep < MK_REP3; ++rep) { p3_compress(P, lds, gw, NGW, lane, wave); }
    SEAM(3);
    if (IN(4)) for (int rep = 0; rep < MK_REP4; ++rep) {
        asm volatile("" ::: "memory");
        for (int i = 0;; ++i) { const int a = (i & 1) ? (i + 1) * G - 1 - c : i * G + c; if (a >= 512 || a < 0) break; attn_unit(P, lds, a & 7, 63 - (a >> 3), tid, lane, wave); }
        {
            unsigned* qctr = (unsigned*)(ws + WS_CTL) + 3584;
            LAS unsigned* qsl = (LAS unsigned*)(lds + LDS_XB + 32);
            for (;;) {
                __syncthreads();
                if (tid == 0) *qsl = __hip_atomic_fetch_add(qctr, 1u, __ATOMIC_RELAXED, __HIP_MEMORY_SCOPE_AGENT);
                __syncthreads();
                const int u = (int)*qsl;
                if (u >= 512) break;
                if (u < 256) gmlp_unit(P, lds, u >> 5, (u >> 1) & 15, u & 1, tid, lane, wave);
                else { const int su = u - 256; sample_unit(P, lds, su >> 1, su & 1, tid, lane, wave); }
            }
        }
        __syncthreads();
    }
    SEAM(4);
    if (IN(5)) for (int rep = 0; rep < MK_REP5; ++rep) {
        pg8::Gemm gm{(const bf16_t*)(ws + WS_AB), (const bf16_t*)(ws + WS_WTBR), DM, DM, 512};
        small_gemm<0>(P, c, G, wave, lane);
        pg8::PairOrder S; S.S.init(MP / 256, DM / 256, G, c);
        EpiMix E{(const bf16_t*)(ws + WS_GBUF), (bf16_t*)(ws + WS_H)};
        pg8::gemm_phase<EpiMix, pg8::PairOrder>(lds, gm, S, E);
    }
    SEAM(5);
    if (IN(6)) for (int rep = 0; rep < MK_REP6; ++rep) {
        pg8::Gemm gm{(const bf16_t*)(ws + WS_H), (const bf16_t*)(ws + WS_WTOUT), DM, DM, DM};
        small_gemm<1>(P, c, G, wave, lane);
        pg8::StaticOrder S; S.init(MP / 256, DM / 256, G, c);
        EpiOut E{P.in[0], P.in[1], (const float*)(ws + WS_MOD), P.out};
        pg8::gemm_phase<EpiOut, pg8::StaticOrder>(lds, gm, S, E);
    }
#undef IN
#undef SEAM
}

extern "C" void kernel_launch(void* const* d_in, const int* in_sizes, int n_in, void* d_out, int out_size, void* d_ws, size_t ws_size, hipStream_t stream) {
    static int grid = 0;
    if (grid == 0) {
        if (n_in != 28 || out_size != (int)O_END || ws_size < WS_END) { fprintf(stderr, "kernel_launch: unexpected shapes (n_in %d, out %d, ws %zu); nothing launched\n", n_in, out_size, ws_size); grid = -1; return; }
        int dev = 0, cus = 0, per_cu = 0;
        if (hipGetDevice(&dev) != hipSuccess || hipDeviceGetAttribute(&cus, hipDeviceAttributeMultiprocessorCount, dev) != hipSuccess) { grid = -1; return; }
        if (hipFuncSetAttribute((const void*)mk_fwd, hipFuncAttributeMaxDynamicSharedMemorySize, LDS_BYTES) != hipSuccess) { fprintf(stderr, "kernel_launch: hipFuncSetAttribute failed\n"); grid = -1; return; }
        if (hipOccupancyMaxActiveBlocksPerMultiprocessor(&per_cu, (const void*)mk_fwd, 512, LDS_BYTES) != hipSuccess || per_cu < 1) { fprintf(stderr, "kernel_launch: occupancy query failed (%d)\n", per_cu); (void)hipGetLastError(); per_cu = 1; }
        if (per_cu > 1) per_cu = 1;
        grid = cus * per_cu;
    }
    if (grid < 0) return;
    if (hipMemsetAsync((char*)d_ws + WS_CTL, 0, CTL_BYTES, stream) != hipSuccess) { fprintf(stderr, "kernel_launch: hipMemsetAsync failed\n"); return; }
    Params p{};
    for (int i = 0; i < 28; ++i) p.in[i] = (const float*)d_in[i];
    p.out = (float*)d_out; p.ws = (unsigned char*)d_ws;
#if MK_N_LAUNCHES == 1
    p.ph_lo = 0; p.ph_hi = 7;
    void* args[] = {&p};
    hipError_t e = hipLaunchCooperativeKernel((const void*)mk_fwd, dim3(grid), dim3(512), args, LDS_BYTES, stream);
    if (e != hipSuccess) fprintf(stderr, "kernel_launch: cooperative launch failed: %s (grid %d)\n", hipGetErrorString(e), grid);
#else
    for (int ph = 0; ph < 7; ++ph) {
        p.ph_lo = ph; p.ph_hi = ph + 1;
        void* args[] = {&p};
        hipError_t e = hipLaunchCooperativeKernel((const void*)mk_fwd, dim3(grid), dim3(512), args, LDS_BYTES, stream);
        if (e != hipSuccess) { fprintf(stderr, "kernel_launch: launch %d failed: %s (grid %d)\n", ph, hipGetErrorString(e), grid); break; }
    }
#endif
}
```

```cpp
#include <hip/hip_runtime.h>
#include <hip/hip_cooperative_groups.h>
#include <cstdio>
#include <cstdint>
namespace cg = cooperative_groups;

#ifndef MK_N_LAUNCHES
#define MK_N_LAUNCHES 1
#endif
#define MK_REP0 1
#define MK_REP1 1
#define MK_REP2 1
#define MK_REP3 1
#define MK_REP4 1
#define MK_REP5 1
#define MK_REP6 1

#define LAS __attribute__((address_space(3)))
typedef unsigned short bf16_t;
typedef short bf16x8 __attribute__((ext_vector_type(8)));
typedef short bf16x4 __attribute__((ext_vector_type(4)));
typedef float f32x4 __attribute__((ext_vector_type(4)));
typedef float f32x2 __attribute__((ext_vector_type(2)));
typedef unsigned u32x4 __attribute__((ext_vector_type(4)));
typedef unsigned u32x2 __attribute__((ext_vector_type(2)));

constexpr int DM = 1024, SEQ = 2048, NBATCH = 8, MP = NBATCH * SEQ, NSB = 128, MTOT = MP + NSB, MPAD = 16640;
constexpr int NIN = 5632;
constexpr int LQ = 0, LK = 512, LV = 896, LZA = 1280, LU = 1792, LVB = 2304, LZB = 2816, LGA = 3328, LGB = 4352, LNSA = 5376;
constexpr float C2Q = 0.125f * 1.4426950408889634f;
constexpr float NEGBIG = -1e30f, MINIT = -1e29f;
constexpr size_t O_YP = 0, O_YS = 16777216, O_PKC = 16908288, O_PVC = 19005440, O_PKS = 21102592, O_PVS = 23199744, O_PKW = 25296896, O_PVW = 25821184,
                 O_SKC = 26345472, O_SVC = 26361856, O_SKS = 26378240, O_SVS = 26394624, O_SKW = 26411008, O_SVW = 34799616, O_SVCH = 43188224, O_END = 43253760;
constexpr size_t MiB = 1u << 20;
constexpr size_t WS_ROPE = 0, WS_MOD = 1 * MiB, WS_WTIN = 3 * MiB, WS_WTBR = 14 * MiB, WS_WTOUT = 16 * MiB, WS_TRIL = 18 * MiB, WS_KC = 18 * MiB + 512 * 1024, WS_VCT = WS_KC + 128 * 1024,
                 WS_KCS = 19 * MiB, WS_VCS = 23 * MiB, WS_VT = 27 * MiB, WS_H = 40 * MiB, WS_AB = 73 * MiB, WS_ACT = 106 * MiB, WS_GBUF = 285 * MiB, WS_END = 355 * MiB;
constexpr size_t WS_CTL = 768 * 1024, CTL_BYTES = 16384;
constexpr int LDS_BYTES = 151552, LDS_XB = LDS_BYTES - 64;
constexpr int LDS_EPI = 131072, EPI_PITCH = 144, EPI_WAVE = 16 * EPI_PITCH;
static_assert(LDS_EPI + 8 * EPI_WAVE <= LDS_XB - 64, "epilogue staging");

struct Params { const float* in[28]; float* out; unsigned char* ws; int ph_lo, ph_hi; };

__device__ __forceinline__ unsigned f2bf(float f) { unsigned u = __builtin_bit_cast(unsigned, f); return (u + 0x7fffu + ((u >> 16) & 1u)) >> 16; }
__device__ __forceinline__ unsigned pk2(float lo, float hi) { return f2bf(lo) | (f2bf(hi) << 16); }
__device__ __forceinline__ float bf2f(unsigned b) { return __builtin_bit_cast(float, (b & 0xffffu) << 16); }
typedef __bf16 bf16x2_t __attribute__((ext_vector_type(2)));
__device__ __forceinline__ unsigned cvt_pk_bf16(float lo, float hi) { const f32x2 v = {lo, hi}; const bf16x2_t b = __builtin_convertvector(v, bf16x2_t); return __builtin_bit_cast(unsigned, b); }
__device__ __forceinline__ void stage_store_rows(LAS unsigned char* sw, int lane, int fr, int fq, const u32x2 (&w)[2][2], bf16_t* dst0, size_t pitch, int nrows) {
#pragma unroll
    for (int bj = 0; bj < 2; ++bj)
#pragma unroll
        for (int n = 0; n < 2; ++n) *(LAS u32x2*)(sw + fr * EPI_PITCH + (32 * bj + 16 * n + 4 * fq) * 2) = w[bj][n];
    const int r = lane >> 3, ch = lane & 7;
    const u32x4 v0 = *(const LAS u32x4*)(sw + r * EPI_PITCH + ch * 16), v1 = *(const LAS u32x4*)(sw + (r + 8) * EPI_PITCH + ch * 16);
    if (r < nrows) *(u32x4*)(dst0 + (size_t)r * pitch + ch * 8) = v0;
    if (r + 8 < nrows) *(u32x4*)(dst0 + (size_t)(r + 8) * pitch + ch * 8) = v1;
}
__device__ __forceinline__ float sigmoidf_(float x) { return __builtin_amdgcn_rcpf(1.0f + __builtin_amdgcn_exp2f(x * -1.4426950408889634f)); }
__device__ __forceinline__ float wave_sum(float v) {
#pragma unroll
    for (int o = 1; o < 64; o <<= 1) v += __shfl_xor(v, o);
    return v;
}
__device__ __forceinline__ float wave_max(float v) {
#pragma unroll
    for (int o = 1; o < 64; o <<= 1) v = fmaxf(v, __shfl_xor(v, o));
    return v;
}
__device__ __forceinline__ void unpack4(u32x2 w, float (&f)[4]) { f[0] = bf2f(w.x); f[1] = bf2f(w.x >> 16); f[2] = bf2f(w.y); f[3] = bf2f(w.y >> 16); }

namespace pg8 {
constexpr int BM = 256, BK = 64, HALF = 128, HTB = HALF * BK * 2, STAGE_BYTES = 8 * HTB, NXCD = 8, WGM = 8;
__host__ __device__ __forceinline__ int lds_byte(int r, int c) { const int st = (r >> 4) * 2 + (c >> 5), rr = r & 15, cc = c & 31, ob = rr * 64 + cc * 2; return st * 1024 + (ob ^ (((ob >> 9) & 1) << 5)); }
__host__ __device__ __forceinline__ void stage_rc(int b, int& R, int& C) { const int st = b / 1024, sb = b % 1024, swz = sb ^ (((sb >> 9) & 1) << 5); R = (st >> 1) * 16 + swz / 64; C = (st & 1) * 32 + (swz % 64) / 2; }

struct Unit { int pm, pn, kofs, keep; };
struct Gemm { const bf16_t* A; const bf16_t* Bt; int lda, ldb, K; };

struct StaticOrder {
    int nM, nN, nwg, G, c;
    __device__ void init(int nM_, int nN_, int G_, int c_) { nM = nM_; nN = nN_; nwg = nM * nN; G = G_; c = c_; }
    __device__ bool tile(int i, int& pm, int& pn) const {
        const long L = (long)i * G + c; if (L >= nwg) return false;
        int wgid = (int)L; { const int q = nwg / NXCD, r = nwg % NXCD, xcd = wgid % NXCD, off = wgid / NXCD; wgid = (xcd < r ? xcd * (q + 1) : r * (q + 1) + (xcd - r) * q) + off; }
        const int nig = WGM * nN, gid = wgid / nig, fm = gid * WGM, gsz = (nM - fm) < WGM ? (nM - fm) : WGM;
        pm = fm + ((wgid % nig) % gsz); pn = (wgid % nig) / gsz; return true;
    }
    __device__ bool next(int i, Unit& u) const { u.kofs = 0; u.keep = 0; return tile(i, u.pm, u.pn); }
};
struct PairOrder {
    StaticOrder S;
    __device__ bool next(int i, Unit& u) const { u.kofs = (i & 1) * 512; u.keep = (i & 1) ? 0 : 1; return S.tile(i >> 1, u.pm, u.pn); }
};

template <class Epi, class Sched>
__device__ __forceinline__ void gemm_phase(LAS unsigned char* lds, const Gemm g, const Sched& S, const Epi& E) {
    const int tid = threadIdx.x, wid = __builtin_amdgcn_readfirstlane(tid >> 6), lane = tid & 63, wr = wid >> 2, wc = wid & 3, fr = lane & 15, fq = lane >> 4;
    const int nt = g.K / BK;
    unsigned voffA[2], voffB[2];
#pragma unroll
    for (int i = 0; i < 2; ++i) { int R, C; stage_rc(tid * 16 + i * 8192, R, C); voffA[i] = (unsigned)(R * g.lda + C) * 2u; voffB[i] = (unsigned)(R * g.ldb + C) * 2u; }
    const size_t kstep = (size_t)(BK * 2);
    const size_t hstepA = (size_t)HALF * g.lda * 2, hstepB = (size_t)HALF * g.ldb * 2, tstepA = 2 * hstepA, tstepB = 2 * hstepB;
    const unsigned ldsw = (unsigned)wid * 1024u;
    const int aoff = lds_byte(wr * 64 + fr, fq * 8), boff = lds_byte(wc * 32 + fr, fq * 8);
#define PG8_SA(b, h) (((b) * 2 + (h)) * HTB)
#define PG8_SB(b, h) ((4 + (b) * 2 + (h)) * HTB)
#define PG8_STAGE(bufoff, gbase, voff) do { _Pragma("unroll") for (int _i = 0; _i < 2; ++_i) \
        __builtin_amdgcn_global_load_lds((const unsigned*)((const char*)(gbase) + (voff)[_i]), (LAS unsigned*)(lds + (bufoff) + ldsw + _i * 8192), 16, 0, 0); } while (0)
#define PG8_LDA(dst, b, h) do { _Pragma("unroll") for (int m = 0; m < 4; ++m) _Pragma("unroll") for (int k = 0; k < 2; ++k) dst[m][k] = *(const LAS bf16x8*)(lds + PG8_SA(b, h) + aoff + m * 2048 + k * 1024); } while (0)
#define PG8_LDB(dst, b, h) do { _Pragma("unroll") for (int n = 0; n < 2; ++n) _Pragma("unroll") for (int k = 0; k < 2; ++k) dst[n][k] = *(const LAS bf16x8*)(lds + PG8_SB(b, h) + boff + n * 2048 + k * 1024); } while (0)
#define PG8_MMA(ai, bj, At, Bt) do { __builtin_amdgcn_s_setprio(1); _Pragma("unroll") for (int m = 0; m < 4; ++m) _Pragma("unroll") for (int n = 0; n < 2; ++n) _Pragma("unroll") for (int k = 0; k < 2; ++k) \
        acc[ai][bj][m][n] = __builtin_amdgcn_mfma_f32_16x16x32_bf16(Bt[n][k], At[m][k], acc[ai][bj][m][n], 0, 0, 0); __builtin_amdgcn_s_setprio(0); } while (0)
#define PG8_WAIT_V(n) asm volatile("s_waitcnt vmcnt(" #n ")" ::: "memory")
#define PG8_WAIT_L(n) asm volatile("s_waitcnt lgkmcnt(" #n ")" ::: "memory")
#define PG8_BAR __builtin_amdgcn_s_barrier()
#define PG8_SCHED __builtin_amdgcn_sched_barrier(0)
    Unit cur, nxt; int ui = 0;
    if (!S.next(0, cur)) return;
    f32x4 acc[2][2][4][2];
#pragma unroll
    for (int a = 0; a < 2; ++a)
#pragma unroll
        for (int b = 0; b < 2; ++b)
#pragma unroll
            for (int m = 0; m < 4; ++m)
#pragma unroll
                for (int n = 0; n < 2; ++n) acc[a][b][m][n] = (f32x4){0.f, 0.f, 0.f, 0.f};
    bf16x8 At[4][2], B0[2][2], B1[2][2];
    const char* cA = (const char*)g.A + (size_t)cur.pm * tstepA + (size_t)cur.kofs * 2; const char* cB = (const char*)g.Bt + (size_t)cur.pn * tstepB + (size_t)cur.kofs * 2;
    PG8_STAGE(PG8_SB(0, 0), cB, voffB); PG8_STAGE(PG8_SB(0, 1), cB + hstepB, voffB); PG8_STAGE(PG8_SA(0, 0), cA, voffA); PG8_STAGE(PG8_SA(0, 1), cA + hstepA, voffA);
    if (wr == 1) PG8_BAR;
    PG8_WAIT_V(2); PG8_BAR;
    PG8_STAGE(PG8_SB(1, 0), cB + kstep, voffB); PG8_STAGE(PG8_SA(1, 0), cA + kstep, voffA); PG8_STAGE(PG8_SB(1, 1), cB + hstepB + kstep, voffB);
    PG8_WAIT_V(6); PG8_BAR;
    for (;;) {
        const bool has_next = S.next(ui + 1, nxt);
        const char* nA = has_next ? (const char*)g.A + (size_t)nxt.pm * tstepA + (size_t)nxt.kofs * 2 : cA; const char* nB = has_next ? (const char*)g.Bt + (size_t)nxt.pn * tstepB + (size_t)nxt.kofs * 2 : cB;
        for (int t = 0; t < nt; t += 2) {
            const bool last = (t == nt - 2);
            const char* a1 = cA + (size_t)(t + 1) * kstep;
            const char* a2 = last ? nA : cA + (size_t)(t + 2) * kstep; const char* b2 = last ? nB : cB + (size_t)(t + 2) * kstep;
            const char* a3 = a2 + kstep; const char* b3 = b2 + kstep;
            PG8_LDB(B0, 0, 0); PG8_LDB(B1, 0, 1); PG8_SCHED; PG8_LDA(At, 0, 0); PG8_STAGE(PG8_SA(1, 1), a1 + hstepA, voffA);
            PG8_WAIT_V(8); PG8_WAIT_L(0); PG8_BAR; PG8_MMA(0, 0, At, B0); PG8_MMA(0, 1, At, B1); PG8_BAR; PG8_SCHED;
            PG8_LDA(At, 0, 1); PG8_STAGE(PG8_SB(0, 0), b2, voffB); PG8_STAGE(PG8_SB(0, 1), b2 + hstepB, voffB); PG8_STAGE(PG8_SA(0, 0), a2, voffA);
            PG8_WAIT_V(8); PG8_WAIT_L(0); PG8_BAR; PG8_MMA(1, 0, At, B0); PG8_MMA(1, 1, At, B1); PG8_BAR; PG8_SCHED;
            PG8_LDB(B0, 1, 0); PG8_LDB(B1, 1, 1); PG8_SCHED; PG8_LDA(At, 1, 0); PG8_STAGE(PG8_SA(0, 1), a2 + hstepA, voffA);
            PG8_WAIT_V(8); PG8_WAIT_L(0); PG8_BAR; PG8_MMA(0, 0, At, B0); PG8_MMA(0, 1, At, B1); PG8_BAR; PG8_SCHED;
            PG8_LDA(At, 1, 1); PG8_STAGE(PG8_SB(1, 0), b3, voffB); PG8_STAGE(PG8_SB(1, 1), b3 + hstepB, voffB); PG8_STAGE(PG8_SA(1, 0), a3, voffA);
            PG8_WAIT_V(8); PG8_WAIT_L(0); PG8_BAR; PG8_MMA(1, 0, At, B0); PG8_MMA(1, 1, At, B1); PG8_BAR; PG8_SCHED;
        }
        if (wr == 0) PG8_BAR;
        E(acc, cur, wr, wc, fr, fq);
        if (!has_next) break;
        if (!cur.keep) {
#pragma unroll
            for (int a = 0; a < 2; ++a)
#pragma unroll
                for (int b = 0; b < 2; ++b)
#pragma unroll
                    for (int m = 0; m < 4; ++m)
#pragma unroll
                        for (int n = 0; n < 2; ++n) acc[a][b][m][n] = (f32x4){0.f, 0.f, 0.f, 0.f};
        }
        cur = nxt; cA = nA; cB = nB; ++ui;
        if (wr == 1) PG8_BAR;
    }
    PG8_WAIT_V(0);
    PG8_BAR;
#undef PG8_SA
#undef PG8_SB
#undef PG8_STAGE
#undef PG8_LDA
#undef PG8_LDB
#undef PG8_MMA
#undef PG8_WAIT_V
#undef PG8_WAIT_L
#undef PG8_BAR
#undef PG8_SCHED
}
}

struct EpiInProj {
    bf16_t* ACT; bf16_t* VT; bf16_t* GB; float* out; const float* qng; const float* kng; const float* rope; LAS unsigned char* stg;
    __device__ __forceinline__ void operator()(f32x4 (&acc)[2][2][4][2], const pg8::Unit& u, int wr, int wc, int fr, int fq) const {
        const int pn = u.pn;
        int type = 0, slot = 0;
        if (pn < 2) { type = 1; slot = 4 * pn + wc; }
        else if (pn == 2 || (pn == 3 && wc < 2)) { type = 2; slot = 4 * (pn - 2) + wc; }
        else if (pn == 3 || pn == 4) { type = 3; slot = 4 * (pn - 3) + wc - 2; }
        const int rbase = u.pm * 256 + wr * 64 + fr;
        if (type == 1 || type == 2) {
            const float* gn = (type == 1) ? qng : kng;
            f32x4 g4[2][2];
#pragma unroll
            for (int bj = 0; bj < 2; ++bj)
#pragma unroll
                for (int n = 0; n < 2; ++n) g4[bj][n] = *(const f32x4*)(gn + 32 * bj + 16 * n + 4 * fq);
            const int br = slot >> 1, kvh = slot & 1;
#pragma unroll
            for (int ai = 0; ai < 2; ++ai)
#pragma unroll
                for (int m = 0; m < 4; ++m) {
                    const int row = rbase + ai * 128 + m * 16;
                    float ss = 0.f;
#pragma unroll
                    for (int bj = 0; bj < 2; ++bj)
#pragma unroll
                        for (int n = 0; n < 2; ++n) { const f32x4 v = acc[ai][bj][m][n]; ss += (v[0] * v[0] + v[1] * v[1]) + (v[2] * v[2] + v[3] * v[3]); }
                    ss += __shfl_xor(ss, 16); ss += __shfl_xor(ss, 32);
                    const float rinv = __builtin_amdgcn_rsqf(ss * (1.0f / 64.0f) + 1e-6f);
                    const int pos = (row < MP) ? (row & (SEQ - 1)) : SEQ;
                    const bool live = row < MTOT;
                    long obase = -1;
                    if (type == 2 && live) {
                        if (row < MP) {
                            const int t = row & (SEQ - 1), b = row >> 11;
                            if (br == 0) obase = (long)O_PKC + (long)row * 128 + kvh * 64;
                            else if (br == 1) obase = (long)O_PKS + (long)row * 128 + kvh * 64;
                            else if (t >= 1536) obase = (long)O_PKW + ((long)(b * 512 + t - 1536) * 2 + kvh) * 64;
                        } else {
                            const int sb = row - MP;
                            if (br == 0) obase = (long)O_SKC + sb * 128 + kvh * 64;
                            else if (br == 1) obase = (long)O_SKS + sb * 128 + kvh * 64;
                            else obase = (long)O_SKW + ((long)(sb * 512 + 511) * 2 + kvh) * 64;
                        }
                    }
                    u32x2 wst[2][2];
#pragma unroll
                    for (int n = 0; n < 2; ++n) {
                        const f32x4 cs0 = *(const f32x4*)(rope + ((size_t)pos * 32 + 16 * n + 4 * fq) * 2);
                        const f32x4 cs1 = *(const f32x4*)(rope + ((size_t)pos * 32 + 16 * n + 4 * fq) * 2 + 4);
                        const float cc[4] = {cs0[0], cs0[2], cs1[0], cs1[2]}, sn[4] = {cs0[1], cs0[3], cs1[1], cs1[3]};
                        f32x4 o0, o1;
#pragma unroll
                        for (int j = 0; j < 4; ++j) {
                            const float y0 = acc[ai][0][m][n][j] * rinv * g4[0][n][j], y1 = acc[ai][1][m][n][j] * rinv * g4[1][n][j];
                            o0[j] = y0 * cc[j] - y1 * sn[j]; o1[j] = y1 * cc[j] + y0 * sn[j];
                        }
                        const float qs = (type == 1) ? C2Q : 1.0f;
                        wst[0][n].x = cvt_pk_bf16(o0[0] * qs, o0[1] * qs); wst[0][n].y = cvt_pk_bf16(o0[2] * qs, o0[3] * qs); wst[1][n].x = cvt_pk_bf16(o1[0] * qs, o1[1] * qs); wst[1][n].y = cvt_pk_bf16(o1[2] * qs, o1[3] * qs);
                        if (type == 2 && obase >= 0) { const int dcol = 16 * n + 4 * fq; *(f32x4*)(out + obase + dcol) = o0; *(f32x4*)(out + obase + 32 + dcol) = o1; }
                    }
                    { const int row0 = row - fr; stage_store_rows(stg + (wr * 4 + wc) * EPI_WAVE, fq * 16 + fr, fr, fq, wst, ACT + (size_t)row0 * NIN + ((type == 1) ? LQ : LK) + 64 * slot, NIN, MTOT - row0); }
                }
        } else if (type == 3) {
            const int br = slot >> 1, kvh = slot & 1;
#pragma unroll
            for (int ai = 0; ai < 2; ++ai)
#pragma unroll
                for (int m = 0; m < 4; ++m) {
                    const int row = rbase + ai * 128 + m * 16;
                    if (row < MTOT) {
                        long obase = -1;
                        if (row < MP) {
                            const int t = row & (SEQ - 1), b = row >> 11;
                            if (br == 0) obase = (long)O_PVC + (long)row * 128 + kvh * 64;
                            else if (br == 1) obase = (long)O_PVS + (long)row * 128 + kvh * 64;
                            else if (t >= 1536) obase = (long)O_PVW + ((long)(b * 512 + t - 1536) * 2 + kvh) * 64;
                            bf16_t* vt = VT + ((size_t)(b * 6 + slot) * 64) * SEQ + t;
#pragma unroll
                            for (int bj = 0; bj < 2; ++bj)
#pragma unroll
                                for (int n = 0; n < 2; ++n)
#pragma unroll
                                    for (int j = 0; j < 4; ++j) vt[(size_t)(32 * bj + 16 * n + 4 * fq + j) * SEQ] = (bf16_t)f2bf(acc[ai][bj][m][n][j]);
                        } else {
                            const int sb = row - MP;
                            if (br == 0) obase = (long)O_SVC + sb * 128 + kvh * 64;
                            else if (br == 1) obase = (long)O_SVS + sb * 128 + kvh * 64;
                            else obase = (long)O_SVW + ((long)(sb * 512 + 511) * 2 + kvh) * 64;
                        }
                        if (obase >= 0) {
#pragma unroll
                            for (int bj = 0; bj < 2; ++bj)
#pragma unroll
                                for (int n = 0; n < 2; ++n) *(f32x4*)(out + obase + 32 * bj + 16 * n + 4 * fq) = acc[ai][bj][m][n];
                        }
                    }
                }
        } else if (pn >= 13 && pn <= 20) {
            bf16_t* gp = GB + ((size_t)((u.pm * 8 + (pn - 13)) * 8 + wr * 4 + wc) * 32) * 256 + (size_t)(fq * 16 + fr) * 4;
#pragma unroll
            for (int ai = 0; ai < 2; ++ai)
#pragma unroll
                for (int m = 0; m < 4; ++m)
#pragma unroll
                    for (int bj = 0; bj < 2; ++bj)
#pragma unroll
                        for (int n = 0; n < 2; ++n) {
                            const f32x4 v = acc[ai][bj][m][n];
                            u32x2 w; w.x = cvt_pk_bf16(sigmoidf_(v[0]), sigmoidf_(v[1])); w.y = cvt_pk_bf16(sigmoidf_(v[2]), sigmoidf_(v[3]));
                            *(u32x2*)(gp + (size_t)(((ai * 4 + m) * 2 + bj) * 2 + n) * 256) = w;
                        }
        } else {
            const int mode = (pn <= 6) ? 1 : (pn <= 10) ? 0 : (pn <= 12) ? 1 : 2;
            LAS unsigned char* sw = stg + (wr * 4 + wc) * EPI_WAVE; const int lane = fq * 16 + fr;
#pragma unroll
            for (int ai = 0; ai < 2; ++ai)
#pragma unroll
                for (int m = 0; m < 4; ++m) {
                    const int row0 = u.pm * 256 + wr * 64 + ai * 128 + m * 16;
                    u32x2 w[2][2];
#pragma unroll
                    for (int bj = 0; bj < 2; ++bj)
#pragma unroll
                        for (int n = 0; n < 2; ++n) {
                            f32x4 v = acc[ai][bj][m][n];
#pragma unroll
                            for (int j = 0; j < 4; ++j) { const float sg = sigmoidf_(v[j]); v[j] = (mode == 0) ? v[j] : (mode == 1) ? v[j] * sg : sg; }
                            w[bj][n].x = cvt_pk_bf16(v[0], v[1]); w[bj][n].y = cvt_pk_bf16(v[2], v[3]);
                        }
                    stage_store_rows(sw, lane, fr, fq, w, ACT + (size_t)row0 * NIN + 256 * pn + 64 * wc, NIN, MTOT - row0);
                }
        }
    }
};

struct EpiMix {
    const bf16_t* GB; bf16_t* M;
    __device__ __forceinline__ void operator()(f32x4 (&acc)[2][2][4][2], const pg8::Unit& u, int wr, int wc, int fr, int fq) const {
        const int rbase = u.pm * 256 + wr * 64 + fr, cbase = u.pn * 256 + 64 * wc + 4 * fq;
        const bf16_t* ga = GB + ((size_t)((u.pm * 8 + u.pn) * 8 + wr * 4 + wc) * 32) * 256 + (size_t)(fq * 16 + fr) * 4;
        const bf16_t* gb = ga + (size_t)4 * 8 * 32 * 256;
#pragma unroll
        for (int ai = 0; ai < 2; ++ai) {
            u32x2 gsb[16], gsa[16];
#pragma unroll
            for (int f = 0; f < 16; ++f) { gsb[f] = *(const u32x2*)(gb + (ai * 16 + f) * 256); if (u.keep) gsa[f] = *(const u32x2*)(ga + (ai * 16 + f) * 256); }
#pragma unroll
            for (int m = 0; m < 4; ++m) {
                const int row = rbase + ai * 128 + m * 16;
#pragma unroll
                for (int bj = 0; bj < 2; ++bj)
#pragma unroll
                    for (int n = 0; n < 2; ++n) {
                        const int f = (m * 2 + bj) * 2 + n;
                        float sb[4]; unpack4(gsb[f], sb);
                        if (u.keep) {
                            float sa[4]; unpack4(gsa[f], sa);
#pragma unroll
                            for (int j = 0; j < 4; ++j) acc[ai][bj][m][n][j] *= sa[j] * __builtin_amdgcn_rcpf(sb[j]);
                        } else if (row < MP) {
                            const f32x4 v = acc[ai][bj][m][n];
                            u32x2 w; w.x = cvt_pk_bf16(v[0] * sb[0], v[1] * sb[1]); w.y = cvt_pk_bf16(v[2] * sb[2], v[3] * sb[3]);
                            *(u32x2*)(M + (size_t)row * DM + cbase + 32 * bj + 16 * n) = w;
                        }
                    }
            }
        }
    }
};

struct EpiOut {
    const float* xp; const float* xs; const float* MOD; float* out;
    __device__ __forceinline__ void operator()(f32x4 (&acc)[2][2][4][2], const pg8::Unit& u, int wr, int wc, int fr, int fq) const {
        const int rbase = u.pm * 256 + wr * 64 + fr, cbase = u.pn * 256 + wc * 32 + 4 * fq;
        const float* gr = MOD + (size_t)(rbase >> 11) * 3072 + 2048;
        f32x4 gv[2][2];
#pragma unroll
        for (int bj = 0; bj < 2; ++bj)
#pragma unroll
            for (int n = 0; n < 2; ++n) gv[bj][n] = *(const f32x4*)(gr + cbase + 128 * bj + 16 * n);
#pragma unroll
        for (int ai = 0; ai < 2; ++ai) {
            f32x4 xv[4][2][2];
#pragma unroll
            for (int m = 0; m < 4; ++m)
#pragma unroll
                for (int bj = 0; bj < 2; ++bj)
#pragma unroll
                    for (int n = 0; n < 2; ++n) xv[m][bj][n] = __builtin_nontemporal_load((const f32x4*)(xp + (size_t)(rbase + ai * 128 + m * 16) * DM + cbase + 128 * bj + 16 * n));
#pragma unroll
            for (int m = 0; m < 4; ++m)
#pragma unroll
                for (int bj = 0; bj < 2; ++bj)
#pragma unroll
                    for (int n = 0; n < 2; ++n)
                        __builtin_nontemporal_store(xv[m][bj][n] + gv[bj][n] * acc[ai][bj][m][n], (f32x4*)(out + O_YP + (size_t)(rbase + ai * 128 + m * 16) * DM + cbase + 128 * bj + 16 * n));
        }
    }
};

__device__ __forceinline__ void transpose_item(const float* src, int src_ld, int nvalid, bf16_t* dst, int dst_ld, LAS float* scr, int lane) {
    float tv[64];
    const int cc = lane & 31, ccl = cc < nvalid ? cc : 0;
#pragma unroll
    for (int i = 0; i < 64; ++i) tv[i] = src[(size_t)(2 * i + (lane >> 5)) * src_ld + ccl];
#pragma unroll
    for (int hf = 0; hf < 2; ++hf) {
#pragma unroll
        for (int i = 0; i < 32; ++i) scr[(2 * i + (lane >> 5)) * 33 + cc] = (cc < nvalid) ? tv[32 * hf + i] : 0.f;
        asm volatile("s_waitcnt lgkmcnt(0)" ::: "memory");
        const int c = lane & 7;
#pragma unroll
        for (int j = 0; j < 4; ++j) { const int n = (lane >> 3) + 8 * j; const LAS float* sp = scr + (8 * c) * 33 + n;
            u32x4 o; o.x = pk2(sp[0 * 33], sp[1 * 33]); o.y = pk2(sp[2 * 33], sp[3 * 33]); o.z = pk2(sp[4 * 33], sp[5 * 33]); o.w = pk2(sp[6 * 33], sp[7 * 33]);
            *(u32x4*)(dst + (size_t)n * dst_ld + 64 * hf + 8 * c) = o; }
        asm volatile("s_waitcnt lgkmcnt(0)" ::: "memory");
    }
}

__device__ __forceinline__ void p0_prologue(const Params& P, LAS unsigned char* lds, int gw, int NGW, int lane_p, int wave, int gtid, int NT) {
    unsigned char* ws = P.ws;
    LAS float* scr = (LAS float*)(lds + wave * 16384);
    constexpr int I_MOD = 9 * 48, I_WIN = 8 * 176, I_WBR = 8 * 32, I_WOUT = 8 * 32, I_POOL = NSB * 16 * 2;
    constexpr int I_TOTAL = I_MOD + I_WIN + I_WBR + I_WOUT + I_POOL;
    constexpr int I_TR = I_WIN + I_WBR + I_WOUT;
    const bool modw = gw < I_MOD; const int NO = NGW - I_MOD, io = gw - I_MOD;
    static_assert(I_TR == 1920 && I_POOL == 4096 && I_MOD == 432, "the deal below is written for these counts and a 2048-wave grid");
    for (int stp = 0;; ++stp) {
        int it;
        if (NGW != 2048) { it = gw + stp * NGW; if (it >= I_TOTAL) break; }
        else if (modw) { if (stp == 0) it = gw; else if (stp == 1) it = I_MOD + I_TR + gw; else break; }
        else {
            const int j = io - 432;
            const int nT = (j < 0) ? 0 : (j < 736 ? 2 : 1);
            if (stp < nT) it = I_MOD + (stp == 0 ? j : 1184 + j);
            else { const int q = stp - nT; if (q == 0) it = I_MOD + I_TR + 432 + io; else if (q == 1) it = I_MOD + I_TR + 432 + 1616 + io; else if (q == 2 && io < 432) it = I_MOD + I_TR + 3664 + io; else break; }
        }
        int lane = lane_p; asm volatile("" : "+v"(lane));
        if (it < I_MOD) {
            const int mt = it / 48, ng = it % 48, lr = lane & 15, kq = lane >> 4;
            int arow_i = 16 * mt + lr; if (arow_i > 135) arow_i = 135;
            const float* arow = ((arow_i < 8) ? P.in[9] + (size_t)arow_i * DM : P.in[10] + (size_t)(arow_i - 8) * DM) + 4 * kq;
            const float* bp = P.in[11] + (size_t)(4 * kq) * 3072 + 64 * ng + 4 * lr;
            f32x4 macc[4];
#pragma unroll
            for (int nt = 0; nt < 4; ++nt) macc[nt] = (f32x4){0.f, 0.f, 0.f, 0.f};
            f32x4 a0[4], b0[16], a1[4], b1[16];
#define MOD_LOAD(A_, B_, k0) do { _Pragma("unroll") for (int j = 0; j < 4; ++j) { A_[j] = *(const f32x4*)(arow + (k0) + 16 * j); \
                _Pragma("unroll") for (int e = 0; e < 4; ++e) B_[4 * j + e] = *(const f32x4*)(bp + (size_t)((k0) + 16 * j + e) * 3072); } } while (0)
#define MOD_MMA(A_, B_) do { _Pragma("unroll") for (int j = 0; j < 4; ++j) _Pragma("unroll") for (int e = 0; e < 4; ++e) _Pragma("unroll") for (int nt = 0; nt < 4; ++nt) \
                macc[nt] = __builtin_amdgcn_mfma_f32_16x16x4f32(A_[j][e], B_[4 * j + e][nt], macc[nt], 0, 0, 0); } while (0)
            MOD_LOAD(a0, b0, 0);
            for (int k0 = 0; k0 < DM; k0 += 128) {
                MOD_LOAD(a1, b1, k0 + 64);
                __builtin_amdgcn_sched_barrier(0);
                MOD_MMA(a0, b0);
                __builtin_amdgcn_sched_barrier(0);
                if (k0 + 128 < DM) MOD_LOAD(a0, b0, k0 + 128);
                __builtin_amdgcn_sched_barrier(0);
                MOD_MMA(a1, b1);
                __builtin_amdgcn_sched_barrier(0);
            }
#undef MOD_LOAD
#undef MOD_MMA
            float* MOD = (float*)(ws + WS_MOD);
            const f32x4 bb = *(const f32x4*)(P.in[12] + 64 * ng + 4 * lr);
#pragma unroll
            for (int r = 0; r < 4; ++r) { const int row = 16 * mt + 4 * kq + r;
                if (row < 136) *(f32x4*)(MOD + (size_t)row * 3072 + 64 * ng + 4 * lr) = (f32x4){macc[0][r] + bb[0], macc[1][r] + bb[1], macc[2][r] + bb[2], macc[3][r] + bb[3]}; }
            continue;
        }
        it -= I_MOD;
        if (it < I_WIN) {
            const int kb = it / 176, nb = it % 176;
            const int pn = nb >> 3, bj = (nb >> 2) & 1, wc = nb & 3;
            const int L0 = 256 * pn + 64 * wc + 32 * bj;
            int srcc, nvalid;
            if (L0 < 1280) { srcc = L0; nvalid = 32; } else if (L0 < LNSA) { srcc = L0 + 24; nvalid = 32; } else if (L0 == LNSA) { srcc = 1280; nvalid = 24; } else { srcc = 0; nvalid = 0; }
            transpose_item(P.in[14] + (size_t)(128 * kb) * 5400 + srcc, 5400, nvalid, (bf16_t*)(ws + WS_WTIN) + (size_t)(32 * nb) * DM + 128 * kb, DM, scr, lane);
            continue;
        }
        it -= I_WIN;
        if (it < I_WBR) {
            const int kb = it / 32, nb = it % 32;
            const float* src = (kb < 4) ? P.in[25] + (size_t)(128 * kb) * DM : P.in[26] + (size_t)(128 * (kb - 4)) * DM;
            const int L0 = 256 * (nb >> 3) + 64 * (nb & 3) + 32 * ((nb >> 2) & 1);
            transpose_item(src + L0, DM, 32, (bf16_t*)(ws + WS_WTBR) + (size_t)(32 * nb) * DM + 128 * kb, DM, scr, lane);
            continue;
        }
        it -= I_WBR;
        if (it < I_WOUT) {
            const int kb = it / 32, nb = it % 32;
            transpose_item(P.in[27] + (size_t)(128 * kb) * DM + 32 * nb, DM, 32, (bf16_t*)(ws + WS_WTOUT) + (size_t)(32 * nb) * DM + 128 * kb, DM, scr, lane);
            continue;
        }
        it -= I_WOUT;
        {
            const int sb = it >> 5, pg = (it >> 1) & 15, which = it & 1;
            const int page = ((const int*)P.in[8])[sb * 16 + pg];
            const float* src = P.in[2 + which] + (size_t)page * 128 * 128;
            const float* pe = P.in[17 + which]; const float* w = P.in[19 + which];
            const int d0 = (2 * lane) & 63;
            float p0 = 0.f, p1 = 0.f;
#pragma unroll 8
            for (int r = 0; r < 32; ++r) { const f32x2 v = *(const f32x2*)(pe + r * 64 + d0); p0 += v[0]; p1 += v[1]; }
#pragma unroll
            for (int cb = 0; cb < 4; ++cb) {
                f32x2 v[32];
#pragma unroll
                for (int r = 0; r < 32; ++r) v[r] = __builtin_nontemporal_load((const f32x2*)(src + (size_t)(cb * 32 + r) * 128 + 2 * lane));
                float s0 = 0.f, s1 = 0.f;
#pragma unroll
                for (int r = 0; r < 32; ++r) { s0 += v[r][0]; s1 += v[r][1]; }
                scr[d0 * 8 + cb * 2 + (lane >> 5)] = (s0 + p0) * (1.0f / 32.0f); scr[(d0 + 1) * 8 + cb * 2 + (lane >> 5)] = (s1 + p1) * (1.0f / 32.0f);
            }
            asm volatile("s_waitcnt lgkmcnt(0)" ::: "memory");
            float a[8];
#pragma unroll
            for (int q = 0; q < 8; ++q) a[q] = 0.f;
#pragma unroll 8
            for (int d = 0; d < 64; ++d) { const float wv = w[d * 64 + lane]; const f32x4 pa = *(const LAS f32x4*)(scr + d * 8), pb = *(const LAS f32x4*)(scr + d * 8 + 4);
                a[0] += pa[0] * wv; a[1] += pa[1] * wv; a[2] += pa[2] * wv; a[3] += pa[3] * wv; a[4] += pb[0] * wv; a[5] += pb[1] * wv; a[6] += pb[2] * wv; a[7] += pb[3] * wv; }
            float* dst = (float*)(ws + (which ? WS_VCS : WS_KCS));
#pragma unroll
            for (int q = 0; q < 8; ++q) dst[((size_t)(sb * 2 + (q & 1)) * 64 + 4 * pg + (q >> 1)) * 64 + lane] = a[q];
            asm volatile("s_waitcnt lgkmcnt(0)" ::: "memory");
        }
    }
    float* rope = (float*)(ws + WS_ROPE);
    for (int i = gtid; i < 2049 * 32; i += NT) {
        const int pos = i >> 5, k = i & 31;
        double invd = 1.0;
        for (int q = 0; q < k; ++q) invd *= 0.7498942093324559;
        const float ang = (float)pos * (float)invd;
        const double rev = (double)ang * 0.15915494309189535;
        const float fr = (float)(rev - __builtin_rint(rev));
        rope[2 * i] = __builtin_amdgcn_cosf(fr); rope[2 * i + 1] = __builtin_amdgcn_sinf(fr);
    }
    bf16_t* tril = (bf16_t*)(ws + WS_TRIL);
    for (int i = gtid; i < 4 * 128 * 128; i += NT) { const int r = (i >> 7) & 127, cidx = i & 127; tril[i] = (cidx <= r) ? (bf16_t)f2bf(P.in[23][i]) : (bf16_t)0; }
    for (int tk = blockIdx.x; tk < 2 * NSB * 2; tk += gridDim.x) {
        const int w2 = tk >> 8, sb = (tk >> 1) & 127, half = tk & 1;
        const f32x4* src = (const f32x4*)P.in[6 + w2] + (size_t)sb * 512 * 32 + 32 + half * 8176; f32x4* dst = (f32x4*)(P.out + (w2 ? O_SVW : O_SKW)) + (size_t)sb * 512 * 32 + half * 8176;
        f32x4 cv[16];
#pragma unroll
        for (int u = 0; u < 16; ++u) { const int i = threadIdx.x + 512 * u; if (i < 8176) cv[u] = __builtin_nontemporal_load(src + i); }
#pragma unroll
        for (int u = 0; u < 16; ++u) { const int i = threadIdx.x + 512 * u; if (i < 8176) __builtin_nontemporal_store(cv[u], dst + i); }
    }
}

__device__ __forceinline__ void p1_hrows(const Params& P, int gw, int NGW, int lane) {
    const float* MOD = (const float*)(P.ws + WS_MOD); bf16_t* H = (bf16_t*)(P.ws + WS_H); const float* ng = P.in[13];
    for (int row0 = gw; row0 < MPAD; row0 += 4 * NGW) {
        f32x4 v[4][4];
#pragma unroll
        for (int q = 0; q < 4; ++q) { const int row = row0 + q * NGW; const int rr = row < MTOT ? row : 0;
            const float* xr = (rr < MP) ? P.in[0] + (size_t)rr * DM : P.in[1] + (size_t)(rr - MP) * DM;
#pragma unroll
            for (int j = 0; j < 4; ++j) v[q][j] = __builtin_nontemporal_load((const f32x4*)xr + lane + 64 * j); }
#pragma unroll
        for (int q = 0; q < 4; ++q) {
            const int row = row0 + q * NGW;
            if (row >= MPAD) break;
            unsigned long long* o8 = (unsigned long long*)(H + (size_t)row * DM) + lane;
            if (row >= MTOT) {
#pragma unroll
                for (int j = 0; j < 4; ++j) o8[64 * j] = 0ull;
                continue; }
            const float* md = (row < MP) ? MOD + (size_t)(row >> 11) * 3072 : MOD + (size_t)(8 + row - MP) * 3072;
            float s = 0.f;
#pragma unroll
            for (int j = 0; j < 4; ++j) s += (v[q][j][0] * v[q][j][0] + v[q][j][1] * v[q][j][1]) + (v[q][j][2] * v[q][j][2] + v[q][j][3] * v[q][j][3]);
            const float rstd = rsqrtf(wave_sum(s) * (1.0f / DM) + 1e-6f);
#pragma unroll
            for (int j = 0; j < 4; ++j) {
                const int col = 4 * lane + 256 * j;
                const f32x4 g = *(const f32x4*)(ng + col), sh = *(const f32x4*)(md + col), sc = *(const f32x4*)(md + 1024 + col);
                const f32x4 h = (v[q][j] * rstd) * g * (sc + 1.0f) + sh;
                o8[64 * j] = (unsigned long long)pk2(h[0], h[1]) | ((unsigned long long)pk2(h[2], h[3]) << 32);
            }
        }
    }
}

__device__ __forceinline__ void p3_compress(const Params& P, LAS unsigned char* lds, int gw, int NGW, int lane, int wave) {
    LAS float* scr = (LAS float*)(lds + wave * 1024);
    for (int it = gw; it < NBATCH * 64 * 2 * 2; it += NGW) {
        const int b = it >> 8, c = (it >> 2) & 63, kvh = (it >> 1) & 1, which = it & 1;
        const float* src = P.out + (which ? O_PVC : O_PKC) + ((size_t)(b * SEQ + 32 * c) * 2 + kvh) * 64;
        const float* pe = P.in[17 + which]; const float* w = P.in[19 + which];
        float s = 0.f;
#pragma unroll
        for (int r = 0; r < 32; ++r) s += src[(size_t)r * 128 + lane] + pe[r * 64 + lane];
        scr[lane] = s * (1.0f / 32.0f);
        asm volatile("s_waitcnt lgkmcnt(0)" ::: "memory");
        float a = 0.f;
#pragma unroll 8
        for (int d = 0; d < 64; ++d) a += scr[d] * w[d * 64 + lane];
        if (which == 0) ((bf16_t*)(P.ws + WS_KC))[((size_t)(b * 64 + c) * 2 + kvh) * 64 + lane] = (bf16_t)f2bf(a);
        else ((bf16_t*)(P.ws + WS_VCT))[((size_t)(b * 2 + kvh) * 64 + lane) * 64 + c] = (bf16_t)f2bf(a);
        asm volatile("s_waitcnt lgkmcnt(0)" ::: "memory");
    }
}

constexpr int A_TILE = 32768, A_IMP = 3 * A_TILE, A_IMPS = A_IMP + 8 * 32 * 33 * 4, A_SEL = A_IMPS + 2 * 32 * 33 * 4;
static_assert(A_SEL + 256 <= LDS_XB, "attention LDS map");
#define ATT_BAR() do { asm volatile("s_waitcnt lgkmcnt(0)" ::: "memory"); __builtin_amdgcn_s_barrier(); asm volatile("" ::: "memory"); } while (0)

struct TileSrc { const bf16_t* kb; const bf16_t* v0; const bf16_t* v1; unsigned kpitch, vpitch; };
__device__ __forceinline__ TileSrc attn_tile_src(const Params& P, int b, int T, int n_slc, int lo) {
    TileSrc s;
    if (T == 0) { s.kb = (const bf16_t*)(P.ws + WS_KC) + (size_t)b * 64 * 128; s.v0 = (const bf16_t*)(P.ws + WS_VCT) + (size_t)(b * 2) * 4096; s.v1 = s.v0 + 4096; s.kpitch = 128; s.vpitch = 64; }
    else {
        const bool slc = T <= n_slc; const int j = slc ? T - 1 : lo + (T - 1 - n_slc), br = slc ? 1 : 2;
        s.kb = (const bf16_t*)(P.ws + WS_ACT) + ((size_t)b * SEQ + 64 * j) * NIN + LK + 128 * br;
        s.v0 = (const bf16_t*)(P.ws + WS_VT) + ((size_t)(b * 6 + 2 * br) * 64) * SEQ + 64 * j; s.v1 = s.v0 + (size_t)64 * SEQ; s.kpitch = NIN; s.vpitch = SEQ;
    }
    return s;
}
__device__ __forceinline__ void attn_dma(LAS unsigned char* buf, const TileSrc& s, int wave, int lane_in) {
    int lane = lane_in; asm volatile("" : "+v"(lane));
    const int r = 8 * wave + (lane >> 3), ch = (lane & 7) ^ (lane >> 3);
#pragma unroll
    for (int i = 0; i < 2; ++i) {
        __builtin_amdgcn_global_load_lds((const unsigned*)(s.kb + (size_t)r * s.kpitch + i * 64 + ch * 8), (LAS unsigned*)(buf + (wave + 8 * i) * 1024), 16, 0, 0);
        __builtin_amdgcn_global_load_lds((const unsigned*)((i ? s.v1 : s.v0) + (size_t)r * s.vpitch + ch * 8), (LAS unsigned*)(buf + 16384 + (wave + 8 * i) * 1024), 16, 0, 0);
    }
}

constexpr float ATT_M0 = -30.f, ATT_THR = 12.f;
template <int MODE>
__device__ __forceinline__ void attn_tile(const LAS unsigned char* Kg, const LAS unsigned char* Vg, const bf16x8 (&qf)[2][2], f32x4 (&O)[4][2], float (&mrun)[2], float (&lrun)[2], f32x4 (&s)[2][4],
                                          int lane_in, int kbase, const int (&qpos)[2], const float (&cinit)[2], bool emask) {
    int lane = lane_in; asm volatile("" : "+v"(lane));
    const int lr = lane & 15, grp = lane >> 4, sw = lr & 7;
    const float c0[2] = {cinit[0] - mrun[0], cinit[1] - mrun[1]};
#pragma unroll
    for (int kt = 0; kt < 4; ++kt) {
        const bf16x8 k0 = *(const LAS bf16x8*)(Kg + (16 * kt + lr) * 128 + ((grp ^ sw) << 4));
        const bf16x8 k1 = *(const LAS bf16x8*)(Kg + (16 * kt + lr) * 128 + (((4 + grp) ^ sw) << 4));
#pragma unroll
        for (int qt = 0; qt < 2; ++qt) {
            const f32x4 a = __builtin_amdgcn_mfma_f32_16x16x32_bf16(k0, qf[qt][0], (f32x4){c0[qt], c0[qt], c0[qt], c0[qt]}, 0, 0, 0);
            s[qt][kt] = __builtin_amdgcn_mfma_f32_16x16x32_bf16(k1, qf[qt][1], a, 0, 0, 0);
        }
    }
    bf16x8 vf[2][4];
#pragma unroll
    for (int c2 = 0; c2 < 2; ++c2)
#pragma unroll
        for (int dt = 0; dt < 4; ++dt) {
            const LAS unsigned char* vr = Vg + (16 * dt + lr) * 128 + 8 * (grp & 1);
            const u32x2 lo = *(const LAS u32x2*)(vr + (((4 * c2 + (grp >> 1)) ^ sw) << 4));
            const u32x2 hi = *(const LAS u32x2*)(vr + (((4 * c2 + 2 + (grp >> 1)) ^ sw) << 4));
            const u32x4 vv = {lo.x, lo.y, hi.x, hi.y};
            vf[c2][dt] = __builtin_bit_cast(bf16x8, vv);
        }
    if (emask) {
#pragma unroll
        for (int qt = 0; qt < 2; ++qt)
#pragma unroll
            for (int kt = 0; kt < 4; ++kt)
#pragma unroll
                for (int r = 0; r < 4; ++r) {
                    const int key = 16 * kt + 4 * grp + r;
                    bool valid;
                    if (MODE == 0) valid = key < ((qpos[qt] + 1) >> 5);
                    else if (MODE == 1) valid = (kbase + key <= qpos[qt]);
                    else { const int kp = kbase + key; valid = (kp <= qpos[qt]) && (kp > qpos[qt] - 512); }
                    s[qt][kt][r] = valid ? s[qt][kt][r] : NEGBIG;
                }
    }
    float mx[2];
#pragma unroll
    for (int qt = 0; qt < 2; ++qt) {
        float m0 = fmaxf(fmaxf(s[qt][0][0], s[qt][0][1]), fmaxf(s[qt][0][2], s[qt][0][3]));
#pragma unroll
        for (int kt = 1; kt < 4; ++kt) m0 = fmaxf(m0, fmaxf(fmaxf(s[qt][kt][0], s[qt][kt][1]), fmaxf(s[qt][kt][2], s[qt][kt][3])));
        m0 = fmaxf(m0, __shfl_xor(m0, 16)); mx[qt] = fmaxf(m0, __shfl_xor(m0, 32));
    }
    if (__any((int)(fmaxf(mx[0], mx[1]) > ATT_THR))) {
#pragma unroll
        for (int qt = 0; qt < 2; ++qt) {
            const float delta = fmaxf(mx[qt], 0.f), f = __builtin_amdgcn_exp2f(-delta);
            mrun[qt] += delta; lrun[qt] *= f;
#pragma unroll
            for (int dt = 0; dt < 4; ++dt) O[dt][qt] *= f;
#pragma unroll
            for (int kt = 0; kt < 4; ++kt) s[qt][kt] -= delta;
        }
    }
#pragma unroll
    for (int qt = 0; qt < 2; ++qt) {
        float ls = 0.f;
#pragma unroll
        for (int kt = 0; kt < 4; ++kt)
#pragma unroll
            for (int r = 0; r < 4; ++r) { const float p = __builtin_amdgcn_exp2f(s[qt][kt][r]); s[qt][kt][r] = p; ls += p; }
        lrun[qt] += ls;
#pragma unroll
        for (int c2 = 0; c2 < 2; ++c2) {
            u32x4 w; w.x = cvt_pk_bf16(s[qt][2 * c2][0], s[qt][2 * c2][1]); w.y = cvt_pk_bf16(s[qt][2 * c2][2], s[qt][2 * c2][3]);
            w.z = cvt_pk_bf16(s[qt][2 * c2 + 1][0], s[qt][2 * c2 + 1][1]); w.w = cvt_pk_bf16(s[qt][2 * c2 + 1][2], s[qt][2 * c2 + 1][3]);
            const bf16x8 pf = __builtin_bit_cast(bf16x8, w);
#pragma unroll
            for (int dt = 0; dt < 4; ++dt) O[dt][qt] = __builtin_amdgcn_mfma_f32_16x16x32_bf16(vf[c2][dt], pf, O[dt][qt], 0, 0, 0);
        }
    }
}

__device__ __forceinline__ void attn_unit(const Params& P, LAS unsigned char* lds, int b, int qb32, int tid, int lane, int wave) {
    asm volatile("" : "+v"(tid), "+v"(lane));
    const bf16_t* ACT = (const bf16_t*)(P.ws + WS_ACT); bf16_t* AB = (bf16_t*)(P.ws + WS_AB);
    const int lr = lane & 15, grp = lane >> 4, g = wave >> 2;
    const int t0 = 32 * qb32, qblk = t0 >> 6; const size_t row0 = (size_t)b * SEQ + t0;
    const int n_slc = qblk + 1, lo = (t0 - 511 > 0) ? ((t0 - 511) >> 6) : 0, NT = 1 + n_slc + (qblk - lo + 1);
    LAS float* IMP = (LAS float*)(lds + A_IMP); LAS float* IMPS = (LAS float*)(lds + A_IMPS); LAS unsigned* SEL = (LAS unsigned*)(lds + A_SEL);
    bf16x8 qf[2][2]; int qpos[2]; float gate[2][3];
#pragma unroll
    for (int qt = 0; qt < 2; ++qt) {
        const size_t row = row0 + 16 * qt + lr; qpos[qt] = t0 + 16 * qt + lr;
#pragma unroll
        for (int ks = 0; ks < 2; ++ks) qf[qt][ks] = *(const bf16x8*)(ACT + row * NIN + LQ + 64 * wave + 32 * ks + 8 * grp);
#pragma unroll
        for (int br = 0; br < 3; ++br) gate[qt][br] = bf2f(ACT[row * NIN + LNSA + 3 * wave + br]);
    }
    f32x4 O[4][2], OA[4][2], s[2][4]; float mrun[2], lrun[2]; unsigned selm[2] = {0u, 0u};
#pragma unroll
    for (int dt = 0; dt < 4; ++dt)
#pragma unroll
        for (int qt = 0; qt < 2; ++qt) { O[dt][qt] = (f32x4){0.f, 0.f, 0.f, 0.f}; OA[dt][qt] = (f32x4){0.f, 0.f, 0.f, 0.f}; }
    mrun[0] = mrun[1] = ATT_M0; lrun[0] = lrun[1] = 0.f;
#define ATT_FINISH(br) do { _Pragma("unroll") for (int qt = 0; qt < 2; ++qt) { float lt = lrun[qt]; lt += __shfl_xor(lt, 16); lt += __shfl_xor(lt, 32); \
        const float f = (lt > 0.f) ? gate[qt][br] / lt : 0.f; _Pragma("unroll") for (int dt = 0; dt < 4; ++dt) { OA[dt][qt] += O[dt][qt] * f; O[dt][qt] = (f32x4){0.f, 0.f, 0.f, 0.f}; } \
        mrun[qt] = ATT_M0; lrun[qt] = 0.f; } } while (0)
    const float czero[2] = {0.f, 0.f};
    ATT_BAR();
    { const TileSrc s0 = attn_tile_src(P, b, 0, n_slc, lo); attn_dma(lds, s0, wave, lane); }
    { const TileSrc s1 = attn_tile_src(P, b, 1, n_slc, lo); attn_dma(lds + A_TILE, s1, wave, lane); }
    asm volatile("s_waitcnt vmcnt(4)" ::: "memory");
    ATT_BAR();
    { const TileSrc s2 = attn_tile_src(P, b, 2, n_slc, lo); attn_dma(lds + 2 * A_TILE, s2, wave, lane); }
    {
        attn_tile<0>(lds + g * 8192, lds + 16384 + g * 8192, qf, O, mrun, lrun, s, lane, 0, qpos, czero, true);
#pragma unroll
        for (int qt = 0; qt < 2; ++qt) {
            float lt = lrun[qt]; lt += __shfl_xor(lt, 16); lt += __shfl_xor(lt, 32);
            const float inv = (lt > 0.f) ? 1.0f / lt : 0.f;
#pragma unroll
            for (int kt = 0; kt < 4; ++kt)
#pragma unroll
                for (int rr = 0; rr < 2; ++rr) IMP[(wave * 32 + 16 * qt + lr) * 33 + 8 * kt + 2 * grp + rr] = (s[qt][kt][2 * rr] + s[qt][kt][2 * rr + 1]) * inv;
        }
        ATT_FINISH(0);
        ATT_BAR();
        for (int i = tid; i < 2 * 32 * 32; i += 512) { const int gg = i >> 10, q = (i >> 5) & 31, j = i & 31;
            IMPS[(gg * 32 + q) * 33 + j] = (IMP[((4 * gg + 0) * 32 + q) * 33 + j] + IMP[((4 * gg + 1) * 32 + q) * 33 + j]) + (IMP[((4 * gg + 2) * 32 + q) * 33 + j] + IMP[((4 * gg + 3) * 32 + q) * 33 + j]); }
        ATT_BAR();
        if (tid < 64) {
            const int gg = tid >> 5, q = tid & 31;
            unsigned mask = 1u | (1u << qblk);
            if (qblk - 1 <= 6) mask = (qblk >= 31) ? 0xffffffffu : ((2u << qblk) - 1u);
            else {
                const LAS float* v = IMPS + (gg * 32 + q) * 33;
                for (int pick = 0; pick < 6; ++pick) { float best = -1.f; int bi = 1;
                    for (int j = 1; j < qblk; ++j) { const float x = v[j]; if (!((mask >> j) & 1u) && x > best) { best = x; bi = j; } }
                    mask |= 1u << bi; }
            }
            SEL[gg * 32 + q] = mask;
        }
        asm volatile("s_waitcnt vmcnt(4)" ::: "memory");
        ATT_BAR();
        selm[0] = SEL[g * 32 + lr]; selm[1] = SEL[g * 32 + 16 + lr];
    }
    int cur = 1, nxt = 0;
    for (int T = 1; T < NT; ++T) {
        const bool more = T + 2 < NT;
        if (more) { const TileSrc sn = attn_tile_src(P, b, T + 2, n_slc, lo); attn_dma(lds + nxt * A_TILE, sn, wave, lane); }
        const LAS unsigned char* Kg = lds + cur * A_TILE + g * 8192; const LAS unsigned char* Vg = Kg + 16384;
        if (T <= n_slc) {
            const int jb = T - 1;
            const float cin[2] = {((selm[0] >> jb) & 1u) ? 0.f : NEGBIG, ((selm[1] >> jb) & 1u) ? 0.f : NEGBIG};
            if (__any((int)(((selm[0] | selm[1]) >> jb) & 1u))) attn_tile<1>(Kg, Vg, qf, O, mrun, lrun, s, lane, 64 * jb, qpos, cin, jb == qblk);
            if (T == n_slc) ATT_FINISH(1);
        } else {
            const int jt = lo + (T - 1 - n_slc);
            const bool em = (64 * jt + 63 > t0) || (64 * jt <= t0 + 31 - 512);
            attn_tile<2>(Kg, Vg, qf, O, mrun, lrun, s, lane, 64 * jt, qpos, czero, em);
            if (T == NT - 1) ATT_FINISH(2);
        }
        if (more) asm volatile("s_waitcnt vmcnt(4)" ::: "memory"); else asm volatile("s_waitcnt vmcnt(0)" ::: "memory");
        ATT_BAR();
        cur = (cur == 2) ? 0 : cur + 1; nxt = (nxt == 2) ? 0 : nxt + 1;
    }
#undef ATT_FINISH
#pragma unroll
    for (int qt = 0; qt < 2; ++qt) {
        const size_t row = row0 + 16 * qt + lr;
#pragma unroll
        for (int dt = 0; dt < 4; ++dt) {
            const int col = 64 * wave + 16 * dt + 4 * grp;
            float za[4]; unpack4(*(const u32x2*)(ACT + row * NIN + LZA + col), za);
            u32x2 w; w.x = cvt_pk_bf16(OA[dt][qt][0] * za[0], OA[dt][qt][1] * za[1]); w.y = cvt_pk_bf16(OA[dt][qt][2] * za[2], OA[dt][qt][3] * za[3]);
            *(u32x2*)(AB + row * DM + col) = w;
        }
    }
}

constexpr int G_ST = 0, G_VNT = 1024, VPITCH = 136;
__device__ __forceinline__ void gmlp_unit(const Params& P, LAS unsigned char* lds, int b, int ch, int gp, int tid, int lane, int wave) {
    asm volatile("" : "+v"(tid), "+v"(lane));
    const bf16_t* ACT = (const bf16_t*)(P.ws + WS_ACT); bf16_t* AB = (bf16_t*)(P.ws + WS_AB);
    LAS f32x2* ST = (LAS f32x2*)(lds + G_ST); LAS bf16_t* Vnt = (LAS bf16_t*)(lds + G_VNT);
    const size_t R0 = (size_t)b * SEQ + 128 * ch;
    __syncthreads();
    {
        u32x4 raw[16];
#pragma unroll
        for (int i = 0; i < 16; ++i) raw[i] = *(const u32x4*)(ACT + (R0 + wave + 8 * i) * NIN + LVB + 8 * lane);
#pragma unroll
        for (int i = 0; i < 16; ++i) {
            float f[8]; f[0] = bf2f(raw[i].x); f[1] = bf2f(raw[i].x >> 16); f[2] = bf2f(raw[i].y); f[3] = bf2f(raw[i].y >> 16); f[4] = bf2f(raw[i].z); f[5] = bf2f(raw[i].z >> 16); f[6] = bf2f(raw[i].w); f[7] = bf2f(raw[i].w >> 16);
            float sm = 0.f, sq = 0.f;
#pragma unroll
            for (int e = 0; e < 8; ++e) { sm += f[e]; sq += f[e] * f[e]; }
#pragma unroll
            for (int o = 1; o < 64; o <<= 1) { sm += __shfl_xor(sm, o); sq += __shfl_xor(sq, o); }
            const float mean = sm * (1.0f / 512.0f), var = fmaxf(sq * (1.0f / 512.0f) - mean * mean, 0.f);
            if (lane == 0) ST[wave + 8 * i] = (f32x2){mean, rsqrtf(var + 1e-6f)};
        }
    }
    __syncthreads();
    {
        const float* vg = P.in[21] + 256 * gp; const float* vb = P.in[22] + 256 * gp;
        u32x4 raw[8];
#pragma unroll
        for (int i = 0; i < 8; ++i) { const int idx = tid + 512 * i, j = idx & 127, chn = idx >> 7; raw[i] = *(const u32x4*)(ACT + (R0 + j) * NIN + LVB + 256 * gp + 8 * chn); }
#pragma unroll
        for (int i = 0; i < 8; ++i) {
            const int idx = tid + 512 * i, j = idx & 127, chn = idx >> 7;
            const f32x2 st = ST[j];
            float f[8]; f[0] = bf2f(raw[i].x); f[1] = bf2f(raw[i].x >> 16); f[2] = bf2f(raw[i].y); f[3] = bf2f(raw[i].y >> 16); f[4] = bf2f(raw[i].z); f[5] = bf2f(raw[i].z >> 16); f[6] = bf2f(raw[i].w); f[7] = bf2f(raw[i].w >> 16);
#pragma unroll
            for (int e = 0; e < 8; ++e) { const int d = 8 * chn + e; Vnt[d * VPITCH + j] = (bf16_t)f2bf((f[e] - st[0]) * st[1] * vg[d] + vb[d]); }
        }
    }
    __syncthreads();
    const int lr = lane & 15, grp = lane >> 4, g = 2 * gp + (wave >> 2);
    const bf16_t* tril = (const bf16_t*)(P.ws + WS_TRIL) + (size_t)g * 128 * 128;
    f32x4 acc[2][8];
#pragma unroll
    for (int t2 = 0; t2 < 2; ++t2)
#pragma unroll
        for (int it = 0; it < 8; ++it) acc[t2][it] = (f32x4){0.f, 0.f, 0.f, 0.f};
#pragma unroll
    for (int ks = 0; ks < 4; ++ks) {
        const bf16x8 af0 = *(const LAS bf16x8*)(Vnt + (32 * wave + lr) * VPITCH + 32 * ks + 8 * grp);
        const bf16x8 af1 = *(const LAS bf16x8*)(Vnt + (32 * wave + 16 + lr) * VPITCH + 32 * ks + 8 * grp);
#pragma unroll
        for (int it = 0; it < 8; ++it) {
            if ((it >> 1) >= ks) { const bf16x8 bfr = *(const bf16x8*)(tril + (size_t)(16 * it + lr) * 128 + 32 * ks + 8 * grp);
                acc[0][it] = __builtin_amdgcn_mfma_f32_16x16x32_bf16(af0, bfr, acc[0][it], 0, 0, 0); acc[1][it] = __builtin_amdgcn_mfma_f32_16x16x32_bf16(af1, bfr, acc[1][it], 0, 0, 0); }
        }
    }
    const float* bs = P.in[24] + 128 * g;
#pragma unroll
    for (int it = 0; it < 8; ++it) {
        const int i = 16 * it + lr; const size_t row = R0 + i;
        const float bsi = bs[i];
#pragma unroll
        for (int t2 = 0; t2 < 2; ++t2) {
            const int d0 = 256 * gp + 32 * wave + 16 * t2 + 4 * grp;
            float uu[4], zb[4]; unpack4(*(const u32x2*)(ACT + row * NIN + LU + d0), uu); unpack4(*(const u32x2*)(ACT + row * NIN + LZB + d0), zb);
            u32x2 w; w.x = cvt_pk_bf16(uu[0] * (acc[t2][it][0] + bsi) * zb[0], uu[1] * (acc[t2][it][1] + bsi) * zb[1]); w.y = cvt_pk_bf16(uu[2] * (acc[t2][it][2] + bsi) * zb[2], uu[3] * (acc[t2][it][3] + bsi) * zb[3]);
            *(u32x2*)(AB + row * DM + 512 + d0) = w;
        }
    }
}

__device__ __forceinline__ void stile(const float* kb, const float* vb, int stride, int kmin, const f32x4 (&q4)[4], float (&m)[4], float (&l)[4], f32x4 (&o4)[4], float (&pout)[4], int lane_in) {
    int lane = lane_in; asm volatile("" : "+v"(lane));
    const int li = lane & 15, gq = lane >> 4;
    __builtin_amdgcn_sched_barrier(0);
    const float* kl = kb + (size_t)(gq * stride + 4 * li); const float* vl = vb + (size_t)(gq * stride + 4 * li);
    f32x4 kreg[16], vreg[16];
#pragma unroll
    for (int i = 0; i < 16; ++i) kreg[i] = __builtin_nontemporal_load((const f32x4*)(kl + (size_t)(4 * i) * stride));
#pragma unroll
    for (int i = 0; i < 16; ++i) vreg[i] = __builtin_nontemporal_load((const f32x4*)(vl + (size_t)(4 * i) * stride));
    float sc[4];
#pragma unroll
    for (int h = 0; h < 4; ++h) {
        float v[16], w8[8], w4[4], w2[2];
#pragma unroll
        for (int i = 0; i < 16; ++i) v[i] = (kreg[i][0] * q4[h][0] + kreg[i][1] * q4[h][1]) + (kreg[i][2] * q4[h][2] + kreg[i][3] * q4[h][3]);
#pragma unroll
        for (int t = 0; t < 8; ++t) { const float snd = (li & 8) ? v[t] : v[t + 8], kp = (li & 8) ? v[t + 8] : v[t]; w8[t] = kp + __shfl_xor(snd, 8); }
#pragma unroll
        for (int t = 0; t < 4; ++t) { const float snd = (li & 4) ? w8[t] : w8[t + 4], kp = (li & 4) ? w8[t + 4] : w8[t]; w4[t] = kp + __shfl_xor(snd, 4); }
#pragma unroll
        for (int t = 0; t < 2; ++t) { const float snd = (li & 2) ? w4[t] : w4[t + 2], kp = (li & 2) ? w4[t + 2] : w4[t]; w2[t] = kp + __shfl_xor(snd, 2); }
        { const float snd = (li & 1) ? w2[0] : w2[1], kp = (li & 1) ? w2[1] : w2[0]; sc[h] = kp + __shfl_xor(snd, 1); }
        __builtin_amdgcn_sched_barrier(0);
    }
    const bool valid = (4 * li + gq) >= kmin;
#pragma unroll
    for (int h = 0; h < 4; ++h) {
        const float sv = valid ? sc[h] : NEGBIG;
        const float mnew = fmaxf(m[h], wave_max(sv));
        const float alpha = __builtin_amdgcn_exp2f(m[h] - mnew), p = __builtin_amdgcn_exp2f(sv - mnew);
        l[h] = l[h] * alpha + wave_sum(p); o4[h] *= alpha; m[h] = mnew; pout[h] = p;
    }
    const int src0 = lane & 48;
#pragma unroll
    for (int i = 0; i < 16; ++i) {
#pragma unroll
        for (int h = 0; h < 4; ++h) o4[h] += vreg[i] * __shfl(pout[h], src0 + i);
    }
    __builtin_amdgcn_sched_barrier(0);
}
__device__ __forceinline__ void skey(const float* kb, const float* vb, const f32x4 (&q4)[4], float (&m)[4], float (&l)[4], f32x4 (&o4)[4], int lane) {
    const int li = lane & 15, gq = lane >> 4;
    const f32x4 kd = *(const f32x4*)(kb + 4 * li), vd = *(const f32x4*)(vb + 4 * li);
#pragma unroll
    for (int h = 0; h < 4; ++h) {
        float sv = (kd[0] * q4[h][0] + kd[1] * q4[h][1]) + (kd[2] * q4[h][2] + kd[3] * q4[h][3]);
        sv += __shfl_xor(sv, 1); sv += __shfl_xor(sv, 2); sv += __shfl_xor(sv, 4); sv += __shfl_xor(sv, 8);
        const float mnew = fmaxf(m[h], sv), alpha = __builtin_amdgcn_exp2f(m[h] - mnew), p = __builtin_amdgcn_exp2f(sv - mnew);
        l[h] = l[h] * alpha + p; o4[h] *= alpha; if (gq == 0) o4[h] += vd * p; m[h] = mnew;
    }
}

constexpr int S_ST = 0, S_MISC = 8 * 3 * 4 * 66 * 4;
__device__ __forceinline__ void sample_unit(const Params& P, LAS unsigned char* lds, int sb, int g, int tid, int lane, int wave) {
    const bf16_t* ACT = (const bf16_t*)(P.ws + WS_ACT); bf16_t* AB = (bf16_t*)(P.ws + WS_AB);
    LAS float* ST = (LAS float*)(lds + S_ST); LAS float* MISC = (LAS float*)(lds + S_MISC);
    const size_t row = (size_t)MP + sb;
    const int* ptab = (const int*)P.in[8] + sb * 16;
    const int li = lane & 15;
    __syncthreads();
    f32x4 q4[4];
#pragma unroll
    for (int h = 0; h < 4; ++h) { float t4[4]; unpack4(*(const u32x2*)(ACT + row * NIN + LQ + 64 * (4 * g + h) + 4 * li), t4); q4[h] = (f32x4){t4[0], t4[1], t4[2], t4[3]}; }
    float ms[4], ls[4]; f32x4 os[4];
#define S_RESET() do { _Pragma("unroll") for (int h = 0; h < 4; ++h) { ms[h] = MINIT; ls[h] = 0.f; os[h] = (f32x4){0.f, 0.f, 0.f, 0.f}; } } while (0)
#define S_PUBLISH(b2, doit) do { _Pragma("unroll") for (int h = 0; h < 4; ++h) { f32x4 v = os[h]; \
        _Pragma("unroll") for (int e = 0; e < 4; ++e) { float x = v[e]; x += __shfl_xor(x, 16); x += __shfl_xor(x, 32); v[e] = x; } \
        if (doit) { LAS float* st = ST + ((wave * 3 + (b2)) * 4 + h) * 66; if (lane < 16) *(LAS f32x4*)(st + 4 * lane) = v; if (lane == 0) { st[64] = ms[h]; st[65] = ls[h]; } } } } while (0)
    float pdummy[4], pc[4];
    S_RESET();
    { const size_t off = (((size_t)sb * 512 + 64 * wave) * 2 + g) * 64; stile(P.in[6] + off, P.in[7] + off, 128, (wave == 0) ? 1 : 0, q4, ms, ls, os, pdummy, lane); }
    if (wave == 0) { const size_t off = ((size_t)(sb * 512 + 511) * 2 + g) * 64; skey(P.out + O_SKW + off, P.out + O_SVW + off, q4, ms, ls, os, lane); }
    S_PUBLISH(1, true);
    S_RESET();
    stile((const float*)(P.ws + WS_KCS) + (size_t)(sb * 2 + g) * 4096, (const float*)(P.ws + WS_VCS) + (size_t)(sb * 2 + g) * 4096, 64, 0, q4, ms, ls, os, pc, lane);
    float imp = 0.f;
#pragma unroll
    for (int h = 0; h < 4; ++h) { const float pn = pc[h] / ls[h]; imp += pn + __shfl_down(pn, 16); }
    S_PUBLISH(2, wave == 0);
    const int jblk = 2 * li + (lane >> 5);
    const bool cand = ((lane >> 4) & 1) == 0 && jblk >= 1;
    unsigned key = cand ? ((__builtin_bit_cast(unsigned, imp) & 0xffffffe0u) | (unsigned)(31 - jblk)) : 0u;
    unsigned long long selpack = 0ull;
#pragma unroll
    for (int pick = 0; pick < 6; ++pick) {
        unsigned best = key;
#pragma unroll
        for (int o2 = 1; o2 < 64; o2 <<= 1) { const unsigned other = (unsigned)__shfl_xor((int)best, o2); best = other > best ? other : best; }
        const int bj = 31 - (int)(best & 31u);
        selpack |= (unsigned long long)bj << (5 * (pick + 1));
        if (cand && jblk == bj) key = 0u;
    }
    S_RESET();
    if (wave < 7) { const int blk = (int)((selpack >> (5 * wave)) & 31ull); const int page = __builtin_amdgcn_readfirstlane(ptab[blk >> 1]); const size_t off = (((size_t)page * 128 + (blk & 1) * 64) * 2 + g) * 64;
        stile(P.in[4] + off, P.in[5] + off, 128, 0, q4, ms, ls, os, pdummy, lane); }
    else skey(P.out + O_SKS + (size_t)sb * 128 + g * 64, P.out + O_SVS + (size_t)sb * 128 + g * 64, q4, ms, ls, os, lane);
    S_PUBLISH(0, true);
#undef S_RESET
#undef S_PUBLISH
    if (wave == 7) {
        const u32x4 raw = *(const u32x4*)(ACT + row * NIN + LVB + 8 * lane);
        float f[8]; f[0] = bf2f(raw.x); f[1] = bf2f(raw.x >> 16); f[2] = bf2f(raw.y); f[3] = bf2f(raw.y >> 16); f[4] = bf2f(raw.z); f[5] = bf2f(raw.z >> 16); f[6] = bf2f(raw.w); f[7] = bf2f(raw.w >> 16);
        float sm = 0.f;
#pragma unroll
        for (int i = 0; i < 8; ++i) sm += f[i];
        const float mean = wave_sum(sm) * (1.0f / 512.0f); float sq = 0.f;
#pragma unroll
        for (int i = 0; i < 8; ++i) { const float d = f[i] - mean; sq += d * d; }
        const float rstd = rsqrtf(wave_sum(sq) * (1.0f / 512.0f) + 1e-6f);
        if (lane == 0) { MISC[0] = mean; MISC[1] = rstd; }
    }
    __syncthreads();
    if (wave < 4) {
        const int h = wave, head = 4 * g + h;
        const LAS float* stc = ST + ((0 * 3 + 2) * 4 + h) * 66;
        float oa = bf2f(ACT[row * NIN + LNSA + 3 * head + 0]) * stc[lane] / stc[65];
#pragma unroll
        for (int b2 = 0; b2 < 2; ++b2) {
            float M = MINIT;
#pragma unroll
            for (int w = 0; w < 8; ++w) M = fmaxf(M, ST[((w * 3 + b2) * 4 + h) * 66 + 64]);
            float L = 0.f, O = 0.f;
#pragma unroll
            for (int w = 0; w < 8; ++w) { const LAS float* st = ST + ((w * 3 + b2) * 4 + h) * 66; const float f = __builtin_amdgcn_exp2f(st[64] - M); L += st[65] * f; O += st[lane] * f; }
            oa += bf2f(ACT[row * NIN + LNSA + 3 * head + 1 + b2]) * O / L;
        }
        const int col = 64 * head + lane;
        AB[row * DM + col] = (bf16_t)f2bf(oa * bf2f(ACT[row * NIN + LZA + col]));
    }
    if (tid < 256) {
        const int d = 256 * g + tid, gm = d >> 7;
        const float vn = (bf2f(ACT[row * NIN + LVB + d]) - MISC[0]) * MISC[1] * P.in[21][d] + P.in[22][d];
        P.out[O_SVCH + (size_t)sb * 512 + d] = vn;
        const float sv = P.in[23][(size_t)gm * 128 * 128] * vn + P.in[24][gm * 128];
        AB[row * DM + 512 + d] = (bf16_t)f2bf(bf2f(ACT[row * NIN + LU + d]) * sv * bf2f(ACT[row * NIN + LZB + d]));
    }
}

template <int MODE>
__device__ __forceinline__ void small_gemm(const Params& P, int c, int G, int wave, int lane) {
    const int lr = lane & 15, grp = lane >> 4;
    for (int t = c + G * wave; t < 512; t += G * 8) {
        const int rt = t & 7, ct = t >> 3;
        const size_t row = (size_t)MP + 16 * rt + lr;
        const bf16_t* A = (const bf16_t*)(P.ws + (MODE == 0 ? WS_AB : WS_H)) + row * DM + 8 * grp;
        const int wrow = (MODE == 0) ? (256 * (ct >> 4) + 128 * ((ct >> 1) & 1) + 32 * ((ct >> 2) & 3) + 16 * (ct & 1) + lr) : (16 * ct + lr);
        const bf16_t* W = (const bf16_t*)(P.ws + (MODE == 0 ? WS_WTBR : WS_WTOUT)) + (size_t)wrow * DM + 8 * grp;
        f32x4 acc0 = (f32x4){0.f, 0.f, 0.f, 0.f}, acc1 = (f32x4){0.f, 0.f, 0.f, 0.f};
#pragma unroll 8
        for (int ks = 0; ks < 16; ++ks) acc0 = __builtin_amdgcn_mfma_f32_16x16x32_bf16(*(const bf16x8*)(W + 32 * ks), *(const bf16x8*)(A + 32 * ks), acc0, 0, 0, 0);
#pragma unroll 8
        for (int ks = 16; ks < 32; ++ks) acc1 = __builtin_amdgcn_mfma_f32_16x16x32_bf16(*(const bf16x8*)(W + 32 * ks), *(const bf16x8*)(A + 32 * ks), acc1, 0, 0, 0);
        const int col = 16 * ct + 4 * grp;
        if (MODE == 0) {
            const int i = 16 * rt + lr, cc = col & 255;
            const size_t go = ((size_t)(((64 * 8 + (col >> 8)) * 8 + (i >> 6) * 4 + (cc >> 6)) * 32 + ((((i >> 4) & 3) * 2 + ((cc >> 5) & 1)) * 2 + ((cc >> 4) & 1))) * 64 + ((cc >> 2) & 3) * 16 + (i & 15)) * 4;
            const bf16_t* GB = (const bf16_t*)(P.ws + WS_GBUF);
            float sa[4], sb[4]; unpack4(*(const u32x2*)(GB + go), sa); unpack4(*(const u32x2*)(GB + go + (size_t)4 * 8 * 32 * 256), sb);
            u32x2 w; w.x = cvt_pk_bf16(sa[0] * acc0[0] + sb[0] * acc1[0], sa[1] * acc0[1] + sb[1] * acc1[1]); w.y = cvt_pk_bf16(sa[2] * acc0[2] + sb[2] * acc1[2], sa[3] * acc0[3] + sb[3] * acc1[3]);
            *(u32x2*)((bf16_t*)(P.ws + WS_H) + row * DM + col) = w;
        } else {
            const int sbi = 16 * rt + lr;
            const f32x4 xv = *(const f32x4*)(P.in[1] + (size_t)sbi * DM + col), gv = *(const f32x4*)((const float*)(P.ws + WS_MOD) + (size_t)(8 + sbi) * 3072 + 2048 + col);
            *(f32x4*)(P.out + O_YS + (size_t)sbi * DM + col) = xv + gv * (acc0 + acc1);
        }
    }
}

#define XB_TMO      128
#define XB_XCNT(j)  (256  + 64 * (j))
#define XB_XSUB(j)  (1280 + 64 * (j))
#define XB_XGEN(j)  (2304 + 64 * (j))
#define XB_TOP      3328
#define XB_TOPGEN   3392
#define XCD_BAR_WORDS 3456
#define XB_SPIN_CAP (1u << 18)
__device__ __forceinline__ unsigned xb_ld(unsigned* p)              { return __hip_atomic_load(p, __ATOMIC_RELAXED, __HIP_MEMORY_SCOPE_AGENT); }
__device__ __forceinline__ unsigned xb_add(unsigned* p, unsigned v) { return __hip_atomic_fetch_add(p, v, __ATOMIC_RELAXED, __HIP_MEMORY_SCOPE_AGENT); }
__device__ __forceinline__ unsigned xb_xcc_id() { return (unsigned)__builtin_amdgcn_s_getreg((3 << 11) | 20) & 0xFu; }
#define XB_SPIN(cond, bar) do { unsigned _sp = 0; while (cond) { __builtin_amdgcn_s_sleep(1); \
    if ((++_sp & 255u) == 0u) { if (xb_ld(&(bar)[XB_TMO])) break; if (_sp > XB_SPIN_CAP) { atomicAdd(&(bar)[XB_TMO], 1u); break; } } } } while (0)
struct XcdBarrier { unsigned* bar; unsigned x; volatile LAS unsigned* st; };
__device__ __forceinline__ XcdBarrier xcd_barrier_post(unsigned* bar, volatile LAS unsigned* st) {
    XcdBarrier b; b.bar = bar; b.x = xb_xcc_id(); b.st = st;
    if (threadIdx.x == 0) (void)xb_add(&bar[XB_XCNT(b.x)], 1u);
    return b;
}
__device__ __forceinline__ void xcd_barrier_complete(unsigned* bar, unsigned x, unsigned& nloc, unsigned& nx) {
    const unsigned G = gridDim.x * gridDim.y * gridDim.z;
    unsigned sum, cnt, mine, sp = 0u;
    for (;;) {
        sum = 0u; cnt = 0u; mine = 0u;
#pragma unroll
        for (unsigned j = 0; j < 16; ++j) { const unsigned c = xb_ld(&bar[XB_XCNT(j)]); sum += c; cnt += (c > 0u) ? 1u : 0u; mine = (j == x) ? c : mine; }
        if (sum == G) break;
        __builtin_amdgcn_s_sleep(1);
        if ((++sp & 255u) == 0u) { if (xb_ld(&bar[XB_TMO])) break; if (sp > XB_SPIN_CAP) { atomicAdd(&bar[XB_TMO], 1u); break; } }
    }
    nloc = mine > 0u ? mine : 1u; nx = cnt > 0u ? cnt : 1u;
}
__device__ __forceinline__ void xcd_barrier(const XcdBarrier& b) {
    asm volatile("s_waitcnt vmcnt(0)" ::: "memory");
    __syncthreads();
    if (threadIdx.x == 0) {
        unsigned* bar = b.bar;
        __builtin_amdgcn_s_waitcnt(0);
        unsigned nloc = b.st[0], nx = b.st[1];
        if (nloc == 0u) { xcd_barrier_complete(bar, b.x, nloc, nx); b.st[0] = nloc; b.st[1] = nx; }
        const unsigned old = xb_add(&bar[XB_XSUB(b.x)], 1u);
        const unsigned gen = old / nloc;
        if (old + 1u == (gen + 1u) * nloc) {
            __builtin_amdgcn_fence(__ATOMIC_RELEASE, "agent");
            asm volatile("s_waitcnt vmcnt(0)" ::: "memory");
            const unsigned og = xb_add(&bar[XB_TOP], 1u);
            const unsigned tg = og / nx;
            if (og + 1u == (tg + 1u) * nx) xb_add(&bar[XB_TOPGEN], 1u);
            else XB_SPIN(xb_ld(&bar[XB_TOPGEN]) == tg, bar);
            __builtin_amdgcn_fence(__ATOMIC_ACQUIRE, "agent");
            xb_add(&bar[XB_XGEN(b.x)], 1u);
            asm volatile("s_waitcnt vmcnt(0)" ::: "memory");
        } else {
            XB_SPIN(xb_ld(&bar[XB_XGEN(b.x)]) == gen, bar);
            __builtin_amdgcn_fence(__ATOMIC_ACQUIRE, "agent");
            asm volatile("s_waitcnt vmcnt(0)" ::: "memory");
        }
    }
    __syncthreads();
}

__global__ void __launch_bounds__(512, 2) mk_fwd(Params P) {
    extern __shared__ __attribute__((aligned(16))) unsigned char lds_raw[];
    LAS unsigned char* lds = (LAS unsigned char*)lds_raw;
    const int tid = threadIdx.x, lane = tid & 63, wave = __builtin_amdgcn_readfirstlane(tid >> 6);
    const int G = gridDim.x, c = blockIdx.x, gw = c * 8 + wave, NGW = G * 8, gtid = c * 512 + tid, NT = G * 512;
    cg::grid_group grid = cg::this_grid();
    const int lo = P.ph_lo, hi = P.ph_hi;
    if (tid < 16) ((LAS unsigned*)(lds + LDS_XB))[tid] = 0u;
    __syncthreads();
    const XcdBarrier bar = xcd_barrier_post((unsigned*)(P.ws + WS_CTL), (volatile LAS unsigned*)(lds + LDS_XB));
    if (hi < 0) grid.sync();
#define IN(k) (lo <= (k) && (k) < hi)
#define SEAM(k) do { if (IN(k) && IN((k) + 1)) xcd_barrier(bar); } while (0)
    unsigned char* ws = P.ws;
    if (IN(0)) for (int rep = 0; rep < MK_REP0; ++rep) { p0_prologue(P, lds, gw, NGW, lane, wave, gtid, NT); }
    SEAM(0);
    if (IN(1)) for (int rep = 0; rep < MK_REP1; ++rep) { p1_hrows(P, gw, NGW, lane); }
    SEAM(1);
    if (IN(2)) for (int rep = 0; rep < MK_REP2; ++rep) {
        pg8::Gemm gm{(const bf16_t*)(ws + WS_H), (const bf16_t*)(ws + WS_WTIN), DM, DM, DM};
        pg8::StaticOrder S; S.init(MPAD / 256, NIN / 256, G, c);
        EpiInProj E{(bf16_t*)(ws + WS_ACT), (bf16_t*)(ws + WS_VT), (bf16_t*)(ws + WS_GBUF), P.out, P.in[15], P.in[16], (const float*)(ws + WS_ROPE), lds + LDS_EPI};
        pg8::gemm_phase<EpiInProj, pg8::StaticOrder>(lds, gm, S, E);
    }
    SEAM(2);
    if (IN(3)) for (int rep = 0; rep < MK_REP3; ++rep) { p3_compress(P, lds, gw, NGW, lane, wave); }
    SEAM(3);
    if (IN(4)) for (int rep = 0; rep < MK_REP4; ++rep) {
        asm volatile("" ::: "memory");
        for (int i = 0;; ++i) { const int a = (i & 1) ? (i + 1) * G - 1 - c : i * G + c; if (a >= 512 || a < 0) break; attn_unit(P, lds, a & 7, 63 - (a >> 3), tid, lane, wave); }
        {
            unsigned* qctr = (unsigned*)(ws + WS_CTL) + 3584;
            LAS unsigned* qsl = (LAS unsigned*)(lds + LDS_XB + 32);
            for (;;) {
                __syncthreads();
                if (tid == 0) *qsl = __hip_atomic_fetch_add(qctr, 1u, __ATOMIC_RELAXED, __HIP_MEMORY_SCOPE_AGENT);
                __syncthreads();
                const int u = (int)*qsl;
                if (u >= 512) break;
                if (u < 256) gmlp_unit(P, lds, u >> 5, (u >> 1) & 15, u & 1, tid, lane, wave);
                else { const int su = u - 256; sample_unit(P, lds, su >> 1, su & 1, tid, lane, wave); }
            }
        }
        __syncthreads();
    }
    SEAM(4);
    if (IN(5)) for (int rep = 0; rep < MK_REP5; ++rep) {
        pg8::Gemm gm{(const bf16_t*)(ws + WS_AB), (const bf16_t*)(ws + WS_WTBR), DM, DM, 512};
        small_gemm<0>(P, c, G, wave, lane);
        pg8::PairOrder S; S.S.init(MP / 256, DM / 256, G, c);
        EpiMix E{(const bf16_t*)(ws + WS_GBUF), (bf16_t*)(ws + WS_H)};
        pg8::gemm_phase<EpiMix, pg8::PairOrder>(lds, gm, S, E);
    }
    SEAM(5);
    if (IN(6)) for (int rep = 0; rep < MK_REP6; ++rep) {
        pg8::Gemm gm{(const bf16_t*)(ws + WS_H), (const bf16_t*)(ws + WS_WTOUT), DM, DM, DM};
        small_gemm<1>(P, c, G, wave, lane);
        pg8::StaticOrder S; S.init(MP / 256, DM / 256, G, c);
        EpiOut E{P.in[0], P.in[1], (const float*)(ws + WS_MOD), P.out};
        pg8::gemm_phase<EpiOut, pg8::StaticOrder>(lds, gm, S, E);
    }
#undef IN
#undef SEAM
}

extern "C" void kernel_launch(void* const* d_in, const int* in_sizes, int n_in, void* d_out, int out_size, void* d_ws, size_t ws_size, hipStream_t stream) {
    static int grid = 0;
    if (grid == 0) {
        if (n_in != 28 || out_size != (int)O_END || ws_size < WS_END) { fprintf(stderr, "kernel_launch: unexpected shapes (n_in %d, out %d, ws %zu); nothing launched\n", n_in, out_size, ws_size); grid = -1; return; }
        int dev = 0, cus = 0, per_cu = 0;
        if (hipGetDevice(&dev) != hipSuccess || hipDeviceGetAttribute(&cus, hipDeviceAttributeMultiprocessorCount, dev) != hipSuccess) { grid = -1; return; }
        if (hipFuncSetAttribute((const void*)mk_fwd, hipFuncAttributeMaxDynamicSharedMemorySize, LDS_BYTES) != hipSuccess) { fprintf(stderr, "kernel_launch: hipFuncSetAttribute failed\n"); grid = -1; return; }
        if (hipOccupancyMaxActiveBlocksPerMultiprocessor(&per_cu, (const void*)mk_fwd, 512, LDS_BYTES) != hipSuccess || per_cu < 1) { fprintf(stderr, "kernel_launch: occupancy query failed (%d)\n", per_cu); (void)hipGetLastError(); per_cu = 1; }
        if (per_cu > 1) per_cu = 1;
        grid = cus * per_cu;
    }
    if (grid < 0) return;
    if (hipMemsetAsync((char*)d_ws + WS_CTL, 0, CTL_BYTES, stream) != hipSuccess) { fprintf(stderr, "kernel_launch: hipMemsetAsync failed\n"); return; }
    Params p{};
    for (int i = 0; i < 28; ++i) p.in[i] = (const float*)d_in[i];
    p.out = (float*)d_out; p.ws = (unsigned char*)d_ws;
#if MK_N_LAUNCHES == 1
    p.ph_lo = 0; p.ph_hi = 7;
    void* args[] = {&p};
    hipError_t e = hipLaunchCooperativeKernel((const void*)mk_fwd, dim3(grid), dim3(512), args, LDS_BYTES, stream);
    if (e != hipSuccess) fprintf(stderr, "kernel_launch: cooperative launch failed: %s (grid %d)\n", hipGetErrorString(e), grid);
#else
    for (int ph = 0; ph < 7; ++ph) {
        p.ph_lo = ph; p.ph_hi = ph + 1;
        void* args[] = {&p};
        hipError_t e = hipLaunchCooperativeKernel((const void*)mk_fwd, dim3(grid), dim3(512), args, LDS_BYTES, stream);
        if (e != hipSuccess) { fprintf(stderr, "kernel_launch: launch %d failed: %s (grid %d)\n", ph, hipGetErrorString(e), grid); break; }
    }
#endif
}
```

```cpp
#include <hip/hip_runtime.h>
#include <hip/hip_cooperative_groups.h>
#include <cstdio>
#include <cstdint>
namespace cg = cooperative_groups;

#ifndef MK_N_LAUNCHES
#define MK_N_LAUNCHES 1
#endif
#define MK_REP0 1
#define MK_REP1 1
#define MK_REP2 1
#define MK_REP3 1
#define MK_REP4 1
#define MK_REP5 1
#define MK_REP6 1

#define LAS __attribute__((address_space(3)))
typedef unsigned short bf16_t;
typedef short bf16x8 __attribute__((ext_vector_type(8)));
typedef short bf16x4 __attribute__((ext_vector_type(4)));
typedef float f32x4 __attribute__((ext_vector_type(4)));
typedef float f32x2 __attribute__((ext_vector_type(2)));
typedef unsigned u32x4 __attribute__((ext_vector_type(4)));
typedef unsigned u32x2 __attribute__((ext_vector_type(2)));

constexpr int DM = 1024, SEQ = 2048, NBATCH = 8, MP = NBATCH * SEQ, NSB = 128, MTOT = MP + NSB, MPAD = 16640;
constexpr int NIN = 5632;
constexpr int LQ = 0, LK = 512, LV = 896, LZA = 1280, LU = 1792, LVB = 2304, LZB = 2816, LGA = 3328, LGB = 4352, LNSA = 5376;
constexpr float C2Q = 0.125f * 1.4426950408889634f;
constexpr float NEGBIG = -1e30f, MINIT = -1e29f;
constexpr size_t O_YP = 0, O_YS = 16777216, O_PKC = 16908288, O_PVC = 19005440, O_PKS = 21102592, O_PVS = 23199744, O_PKW = 25296896, O_PVW = 25821184,
                 O_SKC = 26345472, O_SVC = 26361856, O_SKS = 26378240, O_SVS = 26394624, O_SKW = 26411008, O_SVW = 34799616, O_SVCH = 43188224, O_END = 43253760;
constexpr size_t MiB = 1u << 20;
constexpr size_t WS_ROPE = 0, WS_MOD = 1 * MiB, WS_WTIN = 3 * MiB, WS_WTBR = 14 * MiB, WS_WTOUT = 16 * MiB, WS_TRIL = 18 * MiB, WS_KC = 18 * MiB + 512 * 1024, WS_VCT = WS_KC + 128 * 1024,
                 WS_KCS = 19 * MiB, WS_VCS = 23 * MiB, WS_VT = 27 * MiB, WS_H = 40 * MiB, WS_AB = 73 * MiB, WS_ACT = 106 * MiB, WS_GBUF = 285 * MiB, WS_END = 355 * MiB;
constexpr size_t WS_CTL = 768 * 1024, CTL_BYTES = 16384;
constexpr int LDS_BYTES = 151552, LDS_XB = LDS_BYTES - 64;
constexpr int LDS_EPI = 131072, EPI_PITCH = 144, EPI_WAVE = 16 * EPI_PITCH;
static_assert(LDS_EPI + 8 * EPI_WAVE <= LDS_XB - 64, "epilogue staging");

struct Params { const float* in[28]; float* out; unsigned char* ws; int ph_lo, ph_hi; };

__device__ __forceinline__ unsigned f2bf(float f) { unsigned u = __builtin_bit_cast(unsigned, f); return (u + 0x7fffu + ((u >> 16) & 1u)) >> 16; }
__device__ __forceinline__ unsigned cvt_pk_bf16(float lo, float hi);
__device__ __forceinline__ unsigned pk2(float lo, float hi) { return cvt_pk_bf16(lo, hi); }
__device__ __forceinline__ float bf2f(unsigned b) { return __builtin_bit_cast(float, (b & 0xffffu) << 16); }
typedef __bf16 bf16x2_t __attribute__((ext_vector_type(2)));
__device__ __forceinline__ unsigned cvt_pk_bf16(float lo, float hi) { const f32x2 v = {lo, hi}; const bf16x2_t b = __builtin_convertvector(v, bf16x2_t); return __builtin_bit_cast(unsigned, b); }
__device__ __forceinline__ void stage_store_rows(LAS unsigned char* sw, int lane, int fr, int fq, const u32x2 (&w)[2][2], bf16_t* dst0, size_t pitch, int nrows) {
#pragma unroll
    for (int bj = 0; bj < 2; ++bj)
#pragma unroll
        for (int n = 0; n < 2; ++n) *(LAS u32x2*)(sw + fr * EPI_PITCH + (32 * bj + 16 * n + 4 * fq) * 2) = w[bj][n];
    const int r = lane >> 3, ch = lane & 7;
    const u32x4 v0 = *(const LAS u32x4*)(sw + r * EPI_PITCH + ch * 16), v1 = *(const LAS u32x4*)(sw + (r + 8) * EPI_PITCH + ch * 16);
    if (r < nrows) *(u32x4*)(dst0 + (size_t)r * pitch + ch * 8) = v0;
    if (r + 8 < nrows) *(u32x4*)(dst0 + (size_t)(r + 8) * pitch + ch * 8) = v1;
}
__device__ __forceinline__ float sigmoidf_(float x) { return __builtin_amdgcn_rcpf(1.0f + __builtin_amdgcn_exp2f(x * -1.4426950408889634f)); }
__device__ __forceinline__ float wave_sum(float v) {
#pragma unroll
    for (int o = 1; o < 64; o <<= 1) v += __shfl_xor(v, o);
    return v;
}
__device__ __forceinline__ float wave_max(float v) {
#pragma unroll
    for (int o = 1; o < 64; o <<= 1) v = fmaxf(v, __shfl_xor(v, o));
    return v;
}
__device__ __forceinline__ void unpack4(u32x2 w, float (&f)[4]) { f[0] = bf2f(w.x); f[1] = bf2f(w.x >> 16); f[2] = bf2f(w.y); f[3] = bf2f(w.y >> 16); }

namespace pg8 {
constexpr int BM = 256, BK = 64, HALF = 128, HTB = HALF * BK * 2, STAGE_BYTES = 8 * HTB, NXCD = 8, WGM = 8;
__host__ __device__ __forceinline__ int lds_byte(int r, int c) { const int st = (r >> 4) * 2 + (c >> 5), rr = r & 15, cc = c & 31, ob = rr * 64 + cc * 2; return st * 1024 + (ob ^ (((ob >> 9) & 1) << 5)); }
__host__ __device__ __forceinline__ void stage_rc(int b, int& R, int& C) { const int st = b / 1024, sb = b % 1024, swz = sb ^ (((sb >> 9) & 1) << 5); R = (st >> 1) * 16 + swz / 64; C = (st & 1) * 32 + (swz % 64) / 2; }

struct Unit { int pm, pn, kofs, keep; };
struct Gemm { const bf16_t* A; const bf16_t* Bt; int lda, ldb, K; };

struct StaticOrder {
    int nM, nN, nwg, G, c;
    __device__ void init(int nM_, int nN_, int G_, int c_) { nM = nM_; nN = nN_; nwg = nM * nN; G = G_; c = c_; }
    __device__ bool tile(int i, int& pm, int& pn) const {
        const long L = (long)i * G + c; if (L >= nwg) return false;
        int wgid = (int)L; { const int q = nwg / NXCD, r = nwg % NXCD, xcd = wgid % NXCD, off = wgid / NXCD; wgid = (xcd < r ? xcd * (q + 1) : r * (q + 1) + (xcd - r) * q) + off; }
        const int nig = WGM * nN, gid = wgid / nig, fm = gid * WGM, gsz = (nM - fm) < WGM ? (nM - fm) : WGM;
        pm = fm + ((wgid % nig) % gsz); pn = (wgid % nig) / gsz; return true;
    }
    __device__ bool next(int i, Unit& u) const { u.kofs = 0; u.keep = 0; return tile(i, u.pm, u.pn); }
};
struct PairOrder {
    StaticOrder S;
    __device__ bool next(int i, Unit& u) const { u.kofs = (i & 1) * 512; u.keep = (i & 1) ? 0 : 1; return S.tile(i >> 1, u.pm, u.pn); }
};

template <class Epi, class Sched>
__device__ __forceinline__ void gemm_phase(LAS unsigned char* lds, const Gemm g, const Sched& S, const Epi& E) {
    const int tid = threadIdx.x, wid = __builtin_amdgcn_readfirstlane(tid >> 6), lane = tid & 63, wr = wid >> 2, wc = wid & 3, fr = lane & 15, fq = lane >> 4;
    const int nt = g.K / BK;
    unsigned voffA[2], voffB[2];
#pragma unroll
    for (int i = 0; i < 2; ++i) { int R, C; stage_rc(tid * 16 + i * 8192, R, C); voffA[i] = (unsigned)(R * g.lda + C) * 2u; voffB[i] = (unsigned)(R * g.ldb + C) * 2u; }
    const size_t kstep = (size_t)(BK * 2);
    const size_t hstepA = (size_t)HALF * g.lda * 2, hstepB = (size_t)HALF * g.ldb * 2, tstepA = 2 * hstepA, tstepB = 2 * hstepB;
    const unsigned ldsw = (unsigned)wid * 1024u;
    const int aoff = lds_byte(wr * 64 + fr, fq * 8), boff = lds_byte(wc * 32 + fr, fq * 8);
#define PG8_SA(b, h) (((b) * 2 + (h)) * HTB)
#define PG8_SB(b, h) ((4 + (b) * 2 + (h)) * HTB)
#define PG8_STAGE(bufoff, gbase, voff) do { _Pragma("unroll") for (int _i = 0; _i < 2; ++_i) \
        __builtin_amdgcn_global_load_lds((const unsigned*)((const char*)(gbase) + (voff)[_i]), (LAS unsigned*)(lds + (bufoff) + ldsw + _i * 8192), 16, 0, 0); } while (0)
#define PG8_LDA(dst, b, h) do { _Pragma("unroll") for (int m = 0; m < 4; ++m) _Pragma("unroll") for (int k = 0; k < 2; ++k) dst[m][k] = *(const LAS bf16x8*)(lds + PG8_SA(b, h) + aoff + m * 2048 + k * 1024); } while (0)
#define PG8_LDB(dst, b, h) do { _Pragma("unroll") for (int n = 0; n < 2; ++n) _Pragma("unroll") for (int k = 0; k < 2; ++k) dst[n][k] = *(const LAS bf16x8*)(lds + PG8_SB(b, h) + boff + n * 2048 + k * 1024); } while (0)
#define PG8_MMA(ai, bj, At, Bt) do { __builtin_amdgcn_s_setprio(1); _Pragma("unroll") for (int m = 0; m < 4; ++m) _Pragma("unroll") for (int n = 0; n < 2; ++n) _Pragma("unroll") for (int k = 0; k < 2; ++k) \
        acc[ai][bj][m][n] = __builtin_amdgcn_mfma_f32_16x16x32_bf16(Bt[n][k], At[m][k], acc[ai][bj][m][n], 0, 0, 0); __builtin_amdgcn_s_setprio(0); } while (0)
#define PG8_WAIT_V(n) asm volatile("s_waitcnt vmcnt(" #n ")" ::: "memory")
#define PG8_WAIT_L(n) asm volatile("s_waitcnt lgkmcnt(" #n ")" ::: "memory")
#define PG8_BAR __builtin_amdgcn_s_barrier()
#define PG8_SCHED __builtin_amdgcn_sched_barrier(0)
    Unit cur, nxt; int ui = 0;
    if (!S.next(0, cur)) return;
    f32x4 acc[2][2][4][2];
#pragma unroll
    for (int a = 0; a < 2; ++a)
#pragma unroll
        for (int b = 0; b < 2; ++b)
#pragma unroll
            for (int m = 0; m < 4; ++m)
#pragma unroll
                for (int n = 0; n < 2; ++n) acc[a][b][m][n] = (f32x4){0.f, 0.f, 0.f, 0.f};
    bf16x8 At[4][2], B0[2][2], B1[2][2];
    const char* cA = (const char*)g.A + (size_t)cur.pm * tstepA + (size_t)cur.kofs * 2; const char* cB = (const char*)g.Bt + (size_t)cur.pn * tstepB + (size_t)cur.kofs * 2;
    PG8_STAGE(PG8_SB(0, 0), cB, voffB); PG8_STAGE(PG8_SB(0, 1), cB + hstepB, voffB); PG8_STAGE(PG8_SA(0, 0), cA, voffA); PG8_STAGE(PG8_SA(0, 1), cA + hstepA, voffA);
    if (wr == 1) PG8_BAR;
    PG8_WAIT_V(2); PG8_BAR;
    PG8_STAGE(PG8_SB(1, 0), cB + kstep, voffB); PG8_STAGE(PG8_SA(1, 0), cA + kstep, voffA); PG8_STAGE(PG8_SB(1, 1), cB + hstepB + kstep, voffB);
    PG8_WAIT_V(6); PG8_BAR;
    for (;;) {
        const bool has_next = S.next(ui + 1, nxt);
        const char* nA = has_next ? (const char*)g.A + (size_t)nxt.pm * tstepA + (size_t)nxt.kofs * 2 : cA; const char* nB = has_next ? (const char*)g.Bt + (size_t)nxt.pn * tstepB + (size_t)nxt.kofs * 2 : cB;
        for (int t = 0; t < nt; t += 2) {
            const bool last = (t == nt - 2);
            const char* a1 = cA + (size_t)(t + 1) * kstep;
            const char* a2 = last ? nA : cA + (size_t)(t + 2) * kstep; const char* b2 = last ? nB : cB + (size_t)(t + 2) * kstep;
            const char* a3 = a2 + kstep; const char* b3 = b2 + kstep;
            PG8_LDB(B0, 0, 0); PG8_LDB(B1, 0, 1); PG8_SCHED; PG8_LDA(At, 0, 0); PG8_STAGE(PG8_SA(1, 1), a1 + hstepA, voffA);
            PG8_WAIT_V(8); PG8_WAIT_L(0); PG8_BAR; PG8_MMA(0, 0, At, B0); PG8_MMA(0, 1, At, B1); PG8_BAR; PG8_SCHED;
            PG8_LDA(At, 0, 1); PG8_STAGE(PG8_SB(0, 0), b2, voffB); PG8_STAGE(PG8_SB(0, 1), b2 + hstepB, voffB); PG8_STAGE(PG8_SA(0, 0), a2, voffA);
            PG8_WAIT_V(8); PG8_WAIT_L(0); PG8_BAR; PG8_MMA(1, 0, At, B0); PG8_MMA(1, 1, At, B1); PG8_BAR; PG8_SCHED;
            PG8_LDB(B0, 1, 0); PG8_LDB(B1, 1, 1); PG8_SCHED; PG8_LDA(At, 1, 0); PG8_STAGE(PG8_SA(0, 1), a2 + hstepA, voffA);
            PG8_WAIT_V(8); PG8_WAIT_L(0); PG8_BAR; PG8_MMA(0, 0, At, B0); PG8_MMA(0, 1, At, B1); PG8_BAR; PG8_SCHED;
            PG8_LDA(At, 1, 1); PG8_STAGE(PG8_SB(1, 0), b3, voffB); PG8_STAGE(PG8_SB(1, 1), b3 + hstepB, voffB); PG8_STAGE(PG8_SA(1, 0), a3, voffA);
            PG8_WAIT_V(8); PG8_WAIT_L(0); PG8_BAR; PG8_MMA(1, 0, At, B0); PG8_MMA(1, 1, At, B1); PG8_BAR; PG8_SCHED;
        }
        if (wr == 0) PG8_BAR;
        E(acc, cur, wr, wc, fr, fq);
        if (!has_next) break;
        if (!cur.keep) {
#pragma unroll
            for (int a = 0; a < 2; ++a)
#pragma unroll
                for (int b = 0; b < 2; ++b)
#pragma unroll
                    for (int m = 0; m < 4; ++m)
#pragma unroll
                        for (int n = 0; n < 2; ++n) acc[a][b][m][n] = (f32x4){0.f, 0.f, 0.f, 0.f};
        }
        cur = nxt; cA = nA; cB = nB; ++ui;
        if (wr == 1) PG8_BAR;
    }
    PG8_WAIT_V(0);
    PG8_BAR;
#undef PG8_SA
#undef PG8_SB
#undef PG8_STAGE
#undef PG8_LDA
#undef PG8_LDB
#undef PG8_MMA
#undef PG8_WAIT_V
#undef PG8_WAIT_L
#undef PG8_BAR
#undef PG8_SCHED
}
}

struct EpiInProj {
    bf16_t* ACT; bf16_t* VT; bf16_t* GB; float* out; const float* qng; const float* kng; const float* rope; LAS unsigned char* stg;
    __device__ __forceinline__ void operator()(f32x4 (&acc)[2][2][4][2], const pg8::Unit& u, int wr, int wc, int fr, int fq) const {
        const int pn = u.pn;
        int type = 0, slot = 0;
        if (pn < 2) { type = 1; slot = 4 * pn + wc; }
        else if (pn == 2 || (pn == 3 && wc < 2)) { type = 2; slot = 4 * (pn - 2) + wc; }
        else if (pn == 3 || pn == 4) { type = 3; slot = 4 * (pn - 3) + wc - 2; }
        const int rbase = u.pm * 256 + wr * 64 + fr;
        if (type == 1 || type == 2) {
            const float* gn = (type == 1) ? qng : kng;
            f32x4 g4[2][2];
#pragma unroll
            for (int bj = 0; bj < 2; ++bj)
#pragma unroll
                for (int n = 0; n < 2; ++n) g4[bj][n] = *(const f32x4*)(gn + 32 * bj + 16 * n + 4 * fq);
            const int br = slot >> 1, kvh = slot & 1;
#pragma unroll
            for (int ai = 0; ai < 2; ++ai)
#pragma unroll
                for (int m = 0; m < 4; ++m) {
                    const int row = rbase + ai * 128 + m * 16;
                    float ss = 0.f;
#pragma unroll
                    for (int bj = 0; bj < 2; ++bj)
#pragma unroll
                        for (int n = 0; n < 2; ++n) { const f32x4 v = acc[ai][bj][m][n]; ss += (v[0] * v[0] + v[1] * v[1]) + (v[2] * v[2] + v[3] * v[3]); }
                    ss += __shfl_xor(ss, 16); ss += __shfl_xor(ss, 32);
                    const float rinv = __builtin_amdgcn_rsqf(ss * (1.0f / 64.0f) + 1e-6f);
                    const int pos = (row < MP) ? (row & (SEQ - 1)) : SEQ;
                    const bool live = row < MTOT;
                    long obase = -1;
                    if (type == 2 && live) {
                        if (row < MP) {
                            const int t = row & (SEQ - 1), b = row >> 11;
                            if (br == 0) obase = (long)O_PKC + (long)row * 128 + kvh * 64;
                            else if (br == 1) obase = (long)O_PKS + (long)row * 128 + kvh * 64;
                            else if (t >= 1536) obase = (long)O_PKW + ((long)(b * 512 + t - 1536) * 2 + kvh) * 64;
                        } else {
                            const int sb = row - MP;
                            if (br == 0) obase = (long)O_SKC + sb * 128 + kvh * 64;
                            else if (br == 1) obase = (long)O_SKS + sb * 128 + kvh * 64;
                            else obase = (long)O_SKW + ((long)(sb * 512 + 511) * 2 + kvh) * 64;
                        }
                    }
                    u32x2 wst[2][2];
#pragma unroll
                    for (int n = 0; n < 2; ++n) {
                        const f32x4 cs0 = *(const f32x4*)(rope + ((size_t)pos * 32 + 16 * n + 4 * fq) * 2);
                        const f32x4 cs1 = *(const f32x4*)(rope + ((size_t)pos * 32 + 16 * n + 4 * fq) * 2 + 4);
                        const float cc[4] = {cs0[0], cs0[2], cs1[0], cs1[2]}, sn[4] = {cs0[1], cs0[3], cs1[1], cs1[3]};
                        f32x4 o0, o1;
#pragma unroll
                        for (int j = 0; j < 4; ++j) {
                            const float y0 = acc[ai][0][m][n][j] * rinv * g4[0][n][j], y1 = acc[ai][1][m][n][j] * rinv * g4[1][n][j];
                            o0[j] = y0 * cc[j] - y1 * sn[j]; o1[j] = y1 * cc[j] + y0 * sn[j];
                        }
                        const float qs = (type == 1) ? C2Q : 1.0f;
                        wst[0][n].x = cvt_pk_bf16(o0[0] * qs, o0[1] * qs); wst[0][n].y = cvt_pk_bf16(o0[2] * qs, o0[3] * qs); wst[1][n].x = cvt_pk_bf16(o1[0] * qs, o1[1] * qs); wst[1][n].y = cvt_pk_bf16(o1[2] * qs, o1[3] * qs);
                        if (type == 2 && obase >= 0) { const int dcol = 16 * n + 4 * fq; *(f32x4*)(out + obase + dcol) = o0; *(f32x4*)(out + obase + 32 + dcol) = o1; }
                    }
                    { const int row0 = row - fr; stage_store_rows(stg + (wr * 4 + wc) * EPI_WAVE, fq * 16 + fr, fr, fq, wst, ACT + (size_t)row0 * NIN + ((type == 1) ? LQ : LK) + 64 * slot, NIN, MTOT - row0); }
                }
        } else if (type == 3) {
            const int br = slot >> 1, kvh = slot & 1;
#pragma unroll
            for (int ai = 0; ai < 2; ++ai)
#pragma unroll
                for (int m = 0; m < 4; ++m) {
                    const int row = rbase + ai * 128 + m * 16;
                    if (row < MTOT) {
                        long obase = -1;
                        if (row < MP) {
                            const int t = row & (SEQ - 1), b = row >> 11;
                            if (br == 0) obase = (long)O_PVC + (long)row * 128 + kvh * 64;
                            else if (br == 1) obase = (long)O_PVS + (long)row * 128 + kvh * 64;
                            else if (t >= 1536) obase = (long)O_PVW + ((long)(b * 512 + t - 1536) * 2 + kvh) * 64;
                            bf16_t* vt = VT + ((size_t)(b * 6 + slot) * 64) * SEQ + t;
#pragma unroll
                            for (int bj = 0; bj < 2; ++bj)
#pragma unroll
                                for (int n = 0; n < 2; ++n)
#pragma unroll
                                    for (int j = 0; j < 4; ++j) vt[(size_t)(32 * bj + 16 * n + 4 * fq + j) * SEQ] = (bf16_t)f2bf(acc[ai][bj][m][n][j]);
                        } else {
                            const int sb = row - MP;
                            if (br == 0) obase = (long)O_SVC + sb * 128 + kvh * 64;
                            else if (br == 1) obase = (long)O_SVS + sb * 128 + kvh * 64;
                            else obase = (long)O_SVW + ((long)(sb * 512 + 511) * 2 + kvh) * 64;
                        }
                        if (obase >= 0) {
#pragma unroll
                            for (int bj = 0; bj < 2; ++bj)
#pragma unroll
                                for (int n = 0; n < 2; ++n) *(f32x4*)(out + obase + 32 * bj + 16 * n + 4 * fq) = acc[ai][bj][m][n];
                        }
                    }
                }
        } else if (pn >= 13 && pn <= 20) {
            bf16_t* gp = GB + ((size_t)((u.pm * 8 + (pn - 13)) * 8 + wr * 4 + wc) * 32) * 256 + (size_t)(fq * 16 + fr) * 4;
#pragma unroll
            for (int ai = 0; ai < 2; ++ai)
#pragma unroll
                for (int m = 0; m < 4; ++m)
#pragma unroll
                    for (int bj = 0; bj < 2; ++bj)
#pragma unroll
                        for (int n = 0; n < 2; ++n) {
                            const f32x4 v = acc[ai][bj][m][n];
                            u32x2 w; w.x = cvt_pk_bf16(sigmoidf_(v[0]), sigmoidf_(v[1])); w.y = cvt_pk_bf16(sigmoidf_(v[2]), sigmoidf_(v[3]));
                            *(u32x2*)(gp + (size_t)(((ai * 4 + m) * 2 + bj) * 2 + n) * 256) = w;
                        }
        } else {
            const int mode = (pn <= 6) ? 1 : (pn <= 10) ? 0 : (pn <= 12) ? 1 : 2;
            LAS unsigned char* sw = stg + (wr * 4 + wc) * EPI_WAVE; const int lane = fq * 16 + fr;
#pragma unroll
            for (int ai = 0; ai < 2; ++ai)
#pragma unroll
                for (int m = 0; m < 4; ++m) {
                    const int row0 = u.pm * 256 + wr * 64 + ai * 128 + m * 16;
                    u32x2 w[2][2];
#pragma unroll
                    for (int bj = 0; bj < 2; ++bj)
#pragma unroll
                        for (int n = 0; n < 2; ++n) {
                            f32x4 v = acc[ai][bj][m][n];
#pragma unroll
                            for (int j = 0; j < 4; ++j) { const float sg = sigmoidf_(v[j]); v[j] = (mode == 0) ? v[j] : (mode == 1) ? v[j] * sg : sg; }
                            w[bj][n].x = cvt_pk_bf16(v[0], v[1]); w[bj][n].y = cvt_pk_bf16(v[2], v[3]);
                        }
                    stage_store_rows(sw, lane, fr, fq, w, ACT + (size_t)row0 * NIN + 256 * pn + 64 * wc, NIN, MTOT - row0);
                }
        }
    }
};

struct EpiMix {
    const bf16_t* GB; bf16_t* M;
    __device__ __forceinline__ void operator()(f32x4 (&acc)[2][2][4][2], const pg8::Unit& u, int wr, int wc, int fr, int fq) const {
        const int rbase = u.pm * 256 + wr * 64 + fr, cbase = u.pn * 256 + 64 * wc + 4 * fq;
        const bf16_t* ga = GB + ((size_t)((u.pm * 8 + u.pn) * 8 + wr * 4 + wc) * 32) * 256 + (size_t)(fq * 16 + fr) * 4;
        const bf16_t* gb = ga + (size_t)4 * 8 * 32 * 256;
#pragma unroll
        for (int ai = 0; ai < 2; ++ai) {
            u32x2 gsb[16], gsa[16];
#pragma unroll
            for (int f = 0; f < 16; ++f) { gsb[f] = *(const u32x2*)(gb + (ai * 16 + f) * 256); if (u.keep) gsa[f] = *(const u32x2*)(ga + (ai * 16 + f) * 256); }
#pragma unroll
            for (int m = 0; m < 4; ++m) {
                const int row = rbase + ai * 128 + m * 16;
#pragma unroll
                for (int bj = 0; bj < 2; ++bj)
#pragma unroll
                    for (int n = 0; n < 2; ++n) {
                        const int f = (m * 2 + bj) * 2 + n;
                        float sb[4]; unpack4(gsb[f], sb);
                        if (u.keep) {
                            float sa[4]; unpack4(gsa[f], sa);
#pragma unroll
                            for (int j = 0; j < 4; ++j) acc[ai][bj][m][n][j] *= sa[j] * __builtin_amdgcn_rcpf(sb[j]);
                        } else if (row < MP) {
                            const f32x4 v = acc[ai][bj][m][n];
                            u32x2 w; w.x = cvt_pk_bf16(v[0] * sb[0], v[1] * sb[1]); w.y = cvt_pk_bf16(v[2] * sb[2], v[3] * sb[3]);
                            *(u32x2*)(M + (size_t)row * DM + cbase + 32 * bj + 16 * n) = w;
                        }
                    }
            }
        }
    }
};

struct EpiOut {
    const float* xp; const float* xs; const float* MOD; float* out;
    __device__ __forceinline__ void operator()(f32x4 (&acc)[2][2][4][2], const pg8::Unit& u, int wr, int wc, int fr, int fq) const {
        const int rbase = u.pm * 256 + wr * 64 + fr, cbase = u.pn * 256 + wc * 32 + 4 * fq;
        const float* gr = MOD + (size_t)(rbase >> 11) * 3072 + 2048;
        f32x4 gv[2][2];
#pragma unroll
        for (int bj = 0; bj < 2; ++bj)
#pragma unroll
            for (int n = 0; n < 2; ++n) gv[bj][n] = *(const f32x4*)(gr + cbase + 128 * bj + 16 * n);
#pragma unroll
        for (int ai = 0; ai < 2; ++ai) {
            f32x4 xv[4][2][2];
#pragma unroll
            for (int m = 0; m < 4; ++m)
#pragma unroll
                for (int bj = 0; bj < 2; ++bj)
#pragma unroll
                    for (int n = 0; n < 2; ++n) xv[m][bj][n] = __builtin_nontemporal_load((const f32x4*)(xp + (size_t)(rbase + ai * 128 + m * 16) * DM + cbase + 128 * bj + 16 * n));
#pragma unroll
            for (int m = 0; m < 4; ++m)
#pragma unroll
                for (int bj = 0; bj < 2; ++bj)
#pragma unroll
                    for (int n = 0; n < 2; ++n)
                        __builtin_nontemporal_store(xv[m][bj][n] + gv[bj][n] * acc[ai][bj][m][n], (f32x4*)(out + O_YP + (size_t)(rbase + ai * 128 + m * 16) * DM + cbase + 128 * bj + 16 * n));
        }
    }
};

__device__ __forceinline__ void transpose_item(const float* src, int src_ld, int nvalid, bf16_t* dst, int dst_ld, LAS float* scr, int lane) {
    float tv[64];
    const int cc = lane & 31, ccl = cc < nvalid ? cc : 0;
#pragma unroll
    for (int i = 0; i < 64; ++i) tv[i] = src[(size_t)(2 * i + (lane >> 5)) * src_ld + ccl];
#pragma unroll
    for (int hf = 0; hf < 2; ++hf) {
#pragma unroll
        for (int i = 0; i < 32; ++i) scr[(2 * i + (lane >> 5)) * 33 + cc] = (cc < nvalid) ? tv[32 * hf + i] : 0.f;
        asm volatile("s_waitcnt lgkmcnt(0)" ::: "memory");
        const int c = lane & 7;
#pragma unroll
        for (int j = 0; j < 4; ++j) { const int n = (lane >> 3) + 8 * j; const LAS float* sp = scr + (8 * c) * 33 + n;
            u32x4 o; o.x = pk2(sp[0 * 33], sp[1 * 33]); o.y = pk2(sp[2 * 33], sp[3 * 33]); o.z = pk2(sp[4 * 33], sp[5 * 33]); o.w = pk2(sp[6 * 33], sp[7 * 33]);
            *(u32x4*)(dst + (size_t)n * dst_ld + 64 * hf + 8 * c) = o; }
        asm volatile("s_waitcnt lgkmcnt(0)" ::: "memory");
    }
}

__device__ __forceinline__ void p0_prologue(const Params& P, LAS unsigned char* lds, int gw, int NGW, int lane_p, int wave, int gtid, int NT) {
    unsigned char* ws = P.ws;
    LAS float* scr = (LAS float*)(lds + wave * 16384);
    constexpr int I_MOD = 9 * 48, I_WIN = 8 * 176, I_WBR = 8 * 32, I_WOUT = 8 * 32, I_POOL = NSB * 16 * 2;
    constexpr int I_TOTAL = I_MOD + I_WIN + I_WBR + I_WOUT + I_POOL;
    constexpr int I_TR = I_WIN + I_WBR + I_WOUT;
    const bool modw = gw < I_MOD; const int NO = NGW - I_MOD, io = gw - I_MOD;
    static_assert(I_TR == 1920 && I_POOL == 4096 && I_MOD == 432, "the deal below is written for these counts and a 2048-wave grid");
    for (int stp = 0;; ++stp) {
        int it;
        if (NGW != 2048) { it = gw + stp * NGW; if (it >= I_TOTAL) break; }
        else if (modw) { if (stp == 0) it = gw; else if (stp == 1) it = I_MOD + I_TR + gw; else break; }
        else {
            const int j = io - 432;
            const int nT = (j < 0) ? 0 : (j < 736 ? 2 : 1);
            if (stp < nT) it = I_MOD + (stp == 0 ? j : 1184 + j);
            else { const int q = stp - nT; if (q == 0) it = I_MOD + I_TR + 432 + io; else if (q == 1) it = I_MOD + I_TR + 432 + 1616 + io; else if (q == 2 && io < 432) it = I_MOD + I_TR + 3664 + io; else break; }
        }
        int lane = lane_p; asm volatile("" : "+v"(lane));
        if (it < I_MOD) {
            const int mt = it / 48, ng = it % 48, lr = lane & 15, kq = lane >> 4;
            int arow_i = 16 * mt + lr; if (arow_i > 135) arow_i = 135;
            const float* arow = ((arow_i < 8) ? P.in[9] + (size_t)arow_i * DM : P.in[10] + (size_t)(arow_i - 8) * DM) + 4 * kq;
            const float* bp = P.in[11] + (size_t)(4 * kq) * 3072 + 64 * ng + 4 * lr;
            f32x4 macc[4];
#pragma unroll
            for (int nt = 0; nt < 4; ++nt) macc[nt] = (f32x4){0.f, 0.f, 0.f, 0.f};
            f32x4 a0[4], b0[16], a1[4], b1[16];
#define MOD_LOAD(A_, B_, k0) do { _Pragma("unroll") for (int j = 0; j < 4; ++j) { A_[j] = *(const f32x4*)(arow + (k0) + 16 * j); \
                _Pragma("unroll") for (int e = 0; e < 4; ++e) B_[4 * j + e] = *(const f32x4*)(bp + (size_t)((k0) + 16 * j + e) * 3072); } } while (0)
#define MOD_MMA(A_, B_) do { _Pragma("unroll") for (int j = 0; j < 4; ++j) _Pragma("unroll") for (int e = 0; e < 4; ++e) _Pragma("unroll") for (int nt = 0; nt < 4; ++nt) \
                macc[nt] = __builtin_amdgcn_mfma_f32_16x16x4f32(A_[j][e], B_[4 * j + e][nt], macc[nt], 0, 0, 0); } while (0)
            MOD_LOAD(a0, b0, 0);
            for (int k0 = 0; k0 < DM; k0 += 128) {
                MOD_LOAD(a1, b1, k0 + 64);
                __builtin_amdgcn_sched_barrier(0);
                MOD_MMA(a0, b0);
                __builtin_amdgcn_sched_barrier(0);
                if (k0 + 128 < DM) MOD_LOAD(a0, b0, k0 + 128);
                __builtin_amdgcn_sched_barrier(0);
                MOD_MMA(a1, b1);
                __builtin_amdgcn_sched_barrier(0);
            }
#undef MOD_LOAD
#undef MOD_MMA
            float* MOD = (float*)(ws + WS_MOD);
            const f32x4 bb = *(const f32x4*)(P.in[12] + 64 * ng + 4 * lr);
#pragma unroll
            for (int r = 0; r < 4; ++r) { const int row = 16 * mt + 4 * kq + r;
                if (row < 136) *(f32x4*)(MOD + (size_t)row * 3072 + 64 * ng + 4 * lr) = (f32x4){macc[0][r] + bb[0], macc[1][r] + bb[1], macc[2][r] + bb[2], macc[3][r] + bb[3]}; }
            continue;
        }
        it -= I_MOD;
        if (it < I_WIN) {
            const int kb = it / 176, nb = it % 176;
            const int pn = nb >> 3, bj = (nb >> 2) & 1, wc = nb & 3;
            const int L0 = 256 * pn + 64 * wc + 32 * bj;
            int srcc, nvalid;
            if (L0 < 1280) { srcc = L0; nvalid = 32; } else if (L0 < LNSA) { srcc = L0 + 24; nvalid = 32; } else if (L0 == LNSA) { srcc = 1280; nvalid = 24; } else { srcc = 0; nvalid = 0; }
            transpose_item(P.in[14] + (size_t)(128 * kb) * 5400 + srcc, 5400, nvalid, (bf16_t*)(ws + WS_WTIN) + (size_t)(32 * nb) * DM + 128 * kb, DM, scr, lane);
            continue;
        }
        it -= I_WIN;
        if (it < I_WBR) {
            const int kb = it / 32, nb = it % 32;
            const float* src = (kb < 4) ? P.in[25] + (size_t)(128 * kb) * DM : P.in[26] + (size_t)(128 * (kb - 4)) * DM;
            const int L0 = 256 * (nb >> 3) + 64 * (nb & 3) + 32 * ((nb >> 2) & 1);
            transpose_item(src + L0, DM, 32, (bf16_t*)(ws + WS_WTBR) + (size_t)(32 * nb) * DM + 128 * kb, DM, scr, lane);
            continue;
        }
        it -= I_WBR;
        if (it < I_WOUT) {
            const int kb = it / 32, nb = it % 32;
            transpose_item(P.in[27] + (size_t)(128 * kb) * DM + 32 * nb, DM, 32, (bf16_t*)(ws + WS_WTOUT) + (size_t)(32 * nb) * DM + 128 * kb, DM, scr, lane);
            continue;
        }
        it -= I_WOUT;
        {
            const int sb = it >> 5, pg = (it >> 1) & 15, which = it & 1;
            const int page = ((const int*)P.in[8])[sb * 16 + pg];
            const float* src = P.in[2 + which] + (size_t)page * 128 * 128;
            const float* pe = P.in[17 + which]; const float* w = P.in[19 + which];
            const int d0 = (2 * lane) & 63;
            float p0 = 0.f, p1 = 0.f;
#pragma unroll 8
            for (int r = 0; r < 32; ++r) { const f32x2 v = *(const f32x2*)(pe + r * 64 + d0); p0 += v[0]; p1 += v[1]; }
#pragma unroll
            for (int cb = 0; cb < 4; ++cb) {
                f32x2 v[32];
#pragma unroll
                for (int r = 0; r < 32; ++r) v[r] = __builtin_nontemporal_load((const f32x2*)(src + (size_t)(cb * 32 + r) * 128 + 2 * lane));
                float s0 = 0.f, s1 = 0.f;
#pragma unroll
                for (int r = 0; r < 32; ++r) { s0 += v[r][0]; s1 += v[r][1]; }
                scr[d0 * 8 + cb * 2 + (lane >> 5)] = (s0 + p0) * (1.0f / 32.0f); scr[(d0 + 1) * 8 + cb * 2 + (lane >> 5)] = (s1 + p1) * (1.0f / 32.0f);
            }
            asm volatile("s_waitcnt lgkmcnt(0)" ::: "memory");
            float a[8];
#pragma unroll
            for (int q = 0; q < 8; ++q) a[q] = 0.f;
#pragma unroll 8
            for (int d = 0; d < 64; ++d) { const float wv = w[d * 64 + lane]; const f32x4 pa = *(const LAS f32x4*)(scr + d * 8), pb = *(const LAS f32x4*)(scr + d * 8 + 4);
                a[0] += pa[0] * wv; a[1] += pa[1] * wv; a[2] += pa[2] * wv; a[3] += pa[3] * wv; a[4] += pb[0] * wv; a[5] += pb[1] * wv; a[6] += pb[2] * wv; a[7] += pb[3] * wv; }
            float* dst = (float*)(ws + (which ? WS_VCS : WS_KCS));
#pragma unroll
            for (int q = 0; q < 8; ++q) dst[((size_t)(sb * 2 + (q & 1)) * 64 + 4 * pg + (q >> 1)) * 64 + lane] = a[q];
            asm volatile("s_waitcnt lgkmcnt(0)" ::: "memory");
        }
    }
    float* rope = (float*)(ws + WS_ROPE);
    for (int i = gtid; i < 2049 * 32; i += NT) {
        const int pos = i >> 5, k = i & 31;
        double invd = 1.0;
        for (int q = 0; q < k; ++q) invd *= 0.7498942093324559;
        const float ang = (float)pos * (float)invd;
        const double rev = (double)ang * 0.15915494309189535;
        const float fr = (float)(rev - __builtin_rint(rev));
        rope[2 * i] = __builtin_amdgcn_cosf(fr); rope[2 * i + 1] = __builtin_amdgcn_sinf(fr);
    }
    bf16_t* tril = (bf16_t*)(ws + WS_TRIL);
    for (int i = gtid; i < 4 * 128 * 128; i += NT) { const int r = (i >> 7) & 127, cidx = i & 127; tril[i] = (cidx <= r) ? (bf16_t)f2bf(P.in[23][i]) : (bf16_t)0; }
    for (int tk = blockIdx.x; tk < 2 * NSB * 2; tk += gridDim.x) {
        const int w2 = tk >> 8, sb = (tk >> 1) & 127, half = tk & 1;
        const f32x4* src = (const f32x4*)P.in[6 + w2] + (size_t)sb * 512 * 32 + 32 + half * 8176; f32x4* dst = (f32x4*)(P.out + (w2 ? O_SVW : O_SKW)) + (size_t)sb * 512 * 32 + half * 8176;
        f32x4 cv[16];
#pragma unroll
        for (int u = 0; u < 16; ++u) { const int i = threadIdx.x + 512 * u; if (i < 8176) cv[u] = __builtin_nontemporal_load(src + i); }
#pragma unroll
        for (int u = 0; u < 16; ++u) { const int i = threadIdx.x + 512 * u; if (i < 8176) __builtin_nontemporal_store(cv[u], dst + i); }
    }
}

__device__ __forceinline__ void p1_hrows(const Params& P, int gw, int NGW, int lane) {
    const float* MOD = (const float*)(P.ws + WS_MOD); bf16_t* H = (bf16_t*)(P.ws + WS_H); const float* ng = P.in[13];
    for (int row0 = gw; row0 < MPAD; row0 += 4 * NGW) {
        f32x4 v[4][4];
#pragma unroll
        for (int q = 0; q < 4; ++q) { const int row = row0 + q * NGW; const int rr = row < MTOT ? row : 0;
            const float* xr = (rr < MP) ? P.in[0] + (size_t)rr * DM : P.in[1] + (size_t)(rr - MP) * DM;
#pragma unroll
            for (int j = 0; j < 4; ++j) v[q][j] = __builtin_nontemporal_load((const f32x4*)xr + lane + 64 * j); }
#pragma unroll
        for (int q = 0; q < 4; ++q) {
            const int row = row0 + q * NGW;
            if (row >= MPAD) break;
            unsigned long long* o8 = (unsigned long long*)(H + (size_t)row * DM) + lane;
            if (row >= MTOT) {
#pragma unroll
                for (int j = 0; j < 4; ++j) o8[64 * j] = 0ull;
                continue; }
            const float* md = (row < MP) ? MOD + (size_t)(row >> 11) * 3072 : MOD + (size_t)(8 + row - MP) * 3072;
            float s = 0.f;
#pragma unroll
            for (int j = 0; j < 4; ++j) s += (v[q][j][0] * v[q][j][0] + v[q][j][1] * v[q][j][1]) + (v[q][j][2] * v[q][j][2] + v[q][j][3] * v[q][j][3]);
            const float rstd = rsqrtf(wave_sum(s) * (1.0f / DM) + 1e-6f);
#pragma unroll
            for (int j = 0; j < 4; ++j) {
                const int col = 4 * lane + 256 * j;
                const f32x4 g = *(const f32x4*)(ng + col), sh = *(const f32x4*)(md + col), sc = *(const f32x4*)(md + 1024 + col);
                const f32x4 h = (v[q][j] * rstd) * g * (sc + 1.0f) + sh;
                o8[64 * j] = (unsigned long long)pk2(h[0], h[1]) | ((unsigned long long)pk2(h[2], h[3]) << 32);
            }
        }
    }
}

__device__ __forceinline__ void p3_compress(const Params& P, LAS unsigned char* lds, int gw, int NGW, int lane, int wave) {
    LAS float* scr = (LAS float*)(lds + wave * 1024);
    for (int it = gw; it < NBATCH * 64 * 2 * 2; it += NGW) {
        const int b = it >> 8, c = (it >> 2) & 63, kvh = (it >> 1) & 1, which = it & 1;
        const float* src = P.out + (which ? O_PVC : O_PKC) + ((size_t)(b * SEQ + 32 * c) * 2 + kvh) * 64;
        const float* pe = P.in[17 + which]; const float* w = P.in[19 + which];
        float s = 0.f;
#pragma unroll
        for (int r = 0; r < 32; ++r) s += src[(size_t)r * 128 + lane] + pe[r * 64 + lane];
        scr[lane] = s * (1.0f / 32.0f);
        asm volatile("s_waitcnt lgkmcnt(0)" ::: "memory");
        float a = 0.f;
#pragma unroll 8
        for (int d = 0; d < 64; ++d) a += scr[d] * w[d * 64 + lane];
        if (which == 0) ((bf16_t*)(P.ws + WS_KC))[((size_t)(b * 64 + c) * 2 + kvh) * 64 + lane] = (bf16_t)f2bf(a);
        else ((bf16_t*)(P.ws + WS_VCT))[((size_t)(b * 2 + kvh) * 64 + lane) * 64 + c] = (bf16_t)f2bf(a);
        asm volatile("s_waitcnt lgkmcnt(0)" ::: "memory");
    }
}

constexpr int A_TILE = 32768, A_IMP = 3 * A_TILE, A_IMPS = A_IMP + 8 * 32 * 33 * 4, A_SEL = A_IMPS + 2 * 32 * 33 * 4;
static_assert(A_SEL + 256 <= LDS_XB, "attention LDS map");
#define ATT_BAR() do { asm volatile("s_waitcnt lgkmcnt(0)" ::: "memory"); __builtin_amdgcn_s_barrier(); asm volatile("" ::: "memory"); } while (0)

struct TileSrc { const bf16_t* kb; const bf16_t* v0; const bf16_t* v1; unsigned kpitch, vpitch; };
__device__ __forceinline__ TileSrc attn_tile_src(const Params& P, int b, int T, int n_slc, int lo) {
    TileSrc s;
    if (T == 0) { s.kb = (const bf16_t*)(P.ws + WS_KC) + (size_t)b * 64 * 128; s.v0 = (const bf16_t*)(P.ws + WS_VCT) + (size_t)(b * 2) * 4096; s.v1 = s.v0 + 4096; s.kpitch = 128; s.vpitch = 64; }
    else {
        const bool slc = T <= n_slc; const int j = slc ? T - 1 : lo + (T - 1 - n_slc), br = slc ? 1 : 2;
        s.kb = (const bf16_t*)(P.ws + WS_ACT) + ((size_t)b * SEQ + 64 * j) * NIN + LK + 128 * br;
        s.v0 = (const bf16_t*)(P.ws + WS_VT) + ((size_t)(b * 6 + 2 * br) * 64) * SEQ + 64 * j; s.v1 = s.v0 + (size_t)64 * SEQ; s.kpitch = NIN; s.vpitch = SEQ;
    }
    return s;
}
__device__ __forceinline__ void attn_dma(LAS unsigned char* buf, const TileSrc& s, int wave, int lane_in) {
    int lane = lane_in; asm volatile("" : "+v"(lane));
    const int r = 8 * wave + (lane >> 3), ch = (lane & 7) ^ (lane >> 3);
#pragma unroll
    for (int i = 0; i < 2; ++i) {
        __builtin_amdgcn_global_load_lds((const unsigned*)(s.kb + (size_t)r * s.kpitch + i * 64 + ch * 8), (LAS unsigned*)(buf + (wave + 8 * i) * 1024), 16, 0, 0);
        __builtin_amdgcn_global_load_lds((const unsigned*)((i ? s.v1 : s.v0) + (size_t)r * s.vpitch + ch * 8), (LAS unsigned*)(buf + 16384 + (wave + 8 * i) * 1024), 16, 0, 0);
    }
}

constexpr float ATT_M0 = -30.f, ATT_THR = 12.f;
template <int MODE>
__device__ __forceinline__ void attn_tile(const LAS unsigned char* Kg, const LAS unsigned char* Vg, const bf16x8 (&qf)[2][2], f32x4 (&O)[4][2], float (&mrun)[2], float (&lrun)[2], f32x4 (&s)[2][4],
                                          int lane_in, int kbase, const int (&qpos)[2], const float (&cinit)[2], bool emask) {
    int lane = lane_in; asm volatile("" : "+v"(lane));
    const int lr = lane & 15, grp = lane >> 4, sw = lr & 7;
    const float c0[2] = {cinit[0] - mrun[0], cinit[1] - mrun[1]};
#pragma unroll
    for (int kt = 0; kt < 4; ++kt) {
        const bf16x8 k0 = *(const LAS bf16x8*)(Kg + (16 * kt + lr) * 128 + ((grp ^ sw) << 4));
        const bf16x8 k1 = *(const LAS bf16x8*)(Kg + (16 * kt + lr) * 128 + (((4 + grp) ^ sw) << 4));
#pragma unroll
        for (int qt = 0; qt < 2; ++qt) {
            const f32x4 a = __builtin_amdgcn_mfma_f32_16x16x32_bf16(k0, qf[qt][0], (f32x4){c0[qt], c0[qt], c0[qt], c0[qt]}, 0, 0, 0);
            s[qt][kt] = __builtin_amdgcn_mfma_f32_16x16x32_bf16(k1, qf[qt][1], a, 0, 0, 0);
        }
    }
    bf16x8 vf[2][4];
#pragma unroll
    for (int c2 = 0; c2 < 2; ++c2)
#pragma unroll
        for (int dt = 0; dt < 4; ++dt) {
            const LAS unsigned char* vr = Vg + (16 * dt + lr) * 128 + 8 * (grp & 1);
            const u32x2 lo = *(const LAS u32x2*)(vr + (((4 * c2 + (grp >> 1)) ^ sw) << 4));
            const u32x2 hi = *(const LAS u32x2*)(vr + (((4 * c2 + 2 + (grp >> 1)) ^ sw) << 4));
            const u32x4 vv = {lo.x, lo.y, hi.x, hi.y};
            vf[c2][dt] = __builtin_bit_cast(bf16x8, vv);
        }
    if (emask) {
#pragma unroll
        for (int qt = 0; qt < 2; ++qt)
#pragma unroll
            for (int kt = 0; kt < 4; ++kt)
#pragma unroll
                for (int r = 0; r < 4; ++r) {
                    const int key = 16 * kt + 4 * grp + r;
                    bool valid;
                    if (MODE == 0) valid = key < ((qpos[qt] + 1) >> 5);
                    else if (MODE == 1) valid = (kbase + key <= qpos[qt]);
                    else { const int kp = kbase + key; valid = (kp <= qpos[qt]) && (kp > qpos[qt] - 512); }
                    s[qt][kt][r] = valid ? s[qt][kt][r] : NEGBIG;
                }
    }
    float mx[2];
#pragma unroll
    for (int qt = 0; qt < 2; ++qt) {
        float m0 = fmaxf(fmaxf(s[qt][0][0], s[qt][0][1]), fmaxf(s[qt][0][2], s[qt][0][3]));
#pragma unroll
        for (int kt = 1; kt < 4; ++kt) m0 = fmaxf(m0, fmaxf(fmaxf(s[qt][kt][0], s[qt][kt][1]), fmaxf(s[qt][kt][2], s[qt][kt][3])));
        m0 = fmaxf(m0, __shfl_xor(m0, 16)); mx[qt] = fmaxf(m0, __shfl_xor(m0, 32));
    }
    if (__any((int)(fmaxf(mx[0], mx[1]) > ATT_THR))) {
#pragma unroll
        for (int qt = 0; qt < 2; ++qt) {
            const float delta = fmaxf(mx[qt], 0.f), f = __builtin_amdgcn_exp2f(-delta);
            mrun[qt] += delta; lrun[qt] *= f;
#pragma unroll
            for (int dt = 0; dt < 4; ++dt) O[dt][qt] *= f;
#pragma unroll
            for (int kt = 0; kt < 4; ++kt) s[qt][kt] -= delta;
        }
    }
#pragma unroll
    for (int qt = 0; qt < 2; ++qt) {
        float ls = 0.f;
#pragma unroll
        for (int kt = 0; kt < 4; ++kt)
#pragma unroll
            for (int r = 0; r < 4; ++r) { const float p = __builtin_amdgcn_exp2f(s[qt][kt][r]); s[qt][kt][r] = p; ls += p; }
        lrun[qt] += ls;
#pragma unroll
        for (int c2 = 0; c2 < 2; ++c2) {
            u32x4 w; w.x = cvt_pk_bf16(s[qt][2 * c2][0], s[qt][2 * c2][1]); w.y = cvt_pk_bf16(s[qt][2 * c2][2], s[qt][2 * c2][3]);
            w.z = cvt_pk_bf16(s[qt][2 * c2 + 1][0], s[qt][2 * c2 + 1][1]); w.w = cvt_pk_bf16(s[qt][2 * c2 + 1][2], s[qt][2 * c2 + 1][3]);
            const bf16x8 pf = __builtin_bit_cast(bf16x8, w);
#pragma unroll
            for (int dt = 0; dt < 4; ++dt) O[dt][qt] = __builtin_amdgcn_mfma_f32_16x16x32_bf16(vf[c2][dt], pf, O[dt][qt], 0, 0, 0);
        }
    }
}

__device__ __forceinline__ void attn_unit(const Params& P, LAS unsigned char* lds, int b, int qb32, int tid, int lane, int wave) {
    asm volatile("" : "+v"(tid), "+v"(lane));
    const bf16_t* ACT = (const bf16_t*)(P.ws + WS_ACT); bf16_t* AB = (bf16_t*)(P.ws + WS_AB);
    const int lr = lane & 15, grp = lane >> 4, g = wave >> 2;
    const int t0 = 32 * qb32, qblk = t0 >> 6; const size_t row0 = (size_t)b * SEQ + t0;
    const int n_slc = qblk + 1, lo = (t0 - 511 > 0) ? ((t0 - 511) >> 6) : 0, NT = 1 + n_slc + (qblk - lo + 1);
    LAS float* IMP = (LAS float*)(lds + A_IMP); LAS float* IMPS = (LAS float*)(lds + A_IMPS); LAS unsigned* SEL = (LAS unsigned*)(lds + A_SEL);
    bf16x8 qf[2][2]; int qpos[2]; float gate[2][3];
#pragma unroll
    for (int qt = 0; qt < 2; ++qt) {
        const size_t row = row0 + 16 * qt + lr; qpos[qt] = t0 + 16 * qt + lr;
#pragma unroll
        for (int ks = 0; ks < 2; ++ks) qf[qt][ks] = *(const bf16x8*)(ACT + row * NIN + LQ + 64 * wave + 32 * ks + 8 * grp);
#pragma unroll
        for (int br = 0; br < 3; ++br) gate[qt][br] = bf2f(ACT[row * NIN + LNSA + 3 * wave + br]);
    }
    f32x4 O[4][2], OA[4][2], s[2][4]; float mrun[2], lrun[2]; unsigned selm[2] = {0u, 0u};
#pragma unroll
    for (int dt = 0; dt < 4; ++dt)
#pragma unroll
        for (int qt = 0; qt < 2; ++qt) { O[dt][qt] = (f32x4){0.f, 0.f, 0.f, 0.f}; OA[dt][qt] = (f32x4){0.f, 0.f, 0.f, 0.f}; }
    mrun[0] = mrun[1] = ATT_M0; lrun[0] = lrun[1] = 0.f;
#define ATT_FINISH(br) do { _Pragma("unroll") for (int qt = 0; qt < 2; ++qt) { float lt = lrun[qt]; lt += __shfl_xor(lt, 16); lt += __shfl_xor(lt, 32); \
        const float f = (lt > 0.f) ? gate[qt][br] / lt : 0.f; _Pragma("unroll") for (int dt = 0; dt < 4; ++dt) { OA[dt][qt] += O[dt][qt] * f; O[dt][qt] = (f32x4){0.f, 0.f, 0.f, 0.f}; } \
        mrun[qt] = ATT_M0; lrun[qt] = 0.f; } } while (0)
    const float czero[2] = {0.f, 0.f};
    ATT_BAR();
    { const TileSrc s0 = attn_tile_src(P, b, 0, n_slc, lo); attn_dma(lds, s0, wave, lane); }
    { const TileSrc s1 = attn_tile_src(P, b, 1, n_slc, lo); attn_dma(lds + A_TILE, s1, wave, lane); }
    asm volatile("s_waitcnt vmcnt(4)" ::: "memory");
    ATT_BAR();
    { const TileSrc s2 = attn_tile_src(P, b, 2, n_slc, lo); attn_dma(lds + 2 * A_TILE, s2, wave, lane); }
    {
        attn_tile<0>(lds + g * 8192, lds + 16384 + g * 8192, qf, O, mrun, lrun, s, lane, 0, qpos, czero, true);
#pragma unroll
        for (int qt = 0; qt < 2; ++qt) {
            float lt = lrun[qt]; lt += __shfl_xor(lt, 16); lt += __shfl_xor(lt, 32);
            const float inv = (lt > 0.f) ? 1.0f / lt : 0.f;
#pragma unroll
            for (int kt = 0; kt < 4; ++kt)
#pragma unroll
                for (int rr = 0; rr < 2; ++rr) IMP[(wave * 32 + 16 * qt + lr) * 33 + 8 * kt + 2 * grp + rr] = (s[qt][kt][2 * rr] + s[qt][kt][2 * rr + 1]) * inv;
        }
        ATT_FINISH(0);
        ATT_BAR();
        for (int i = tid; i < 2 * 32 * 32; i += 512) { const int gg = i >> 10, q = (i >> 5) & 31, j = i & 31;
            IMPS[(gg * 32 + q) * 33 + j] = (IMP[((4 * gg + 0) * 32 + q) * 33 + j] + IMP[((4 * gg + 1) * 32 + q) * 33 + j]) + (IMP[((4 * gg + 2) * 32 + q) * 33 + j] + IMP[((4 * gg + 3) * 32 + q) * 33 + j]); }
        ATT_BAR();
        if (tid < 64) {
            const int gg = tid >> 5, q = tid & 31;
            unsigned mask = 1u | (1u << qblk);
            if (qblk - 1 <= 6) mask = (qblk >= 31) ? 0xffffffffu : ((2u << qblk) - 1u);
            else {
                const LAS float* v = IMPS + (gg * 32 + q) * 33;
                for (int pick = 0; pick < 6; ++pick) { float best = -1.f; int bi = 1;
                    for (int j = 1; j < qblk; ++j) { const float x = v[j]; if (!((mask >> j) & 1u) && x > best) { best = x; bi = j; } }
                    mask |= 1u << bi; }
            }
            SEL[gg * 32 + q] = mask;
        }
        asm volatile("s_waitcnt vmcnt(4)" ::: "memory");
        ATT_BAR();
        selm[0] = SEL[g * 32 + lr]; selm[1] = SEL[g * 32 + 16 + lr];
    }
    int cur = 1, nxt = 0;
    for (int T = 1; T < NT; ++T) {
        const bool more = T + 2 < NT;
        if (more) { const TileSrc sn = attn_tile_src(P, b, T + 2, n_slc, lo); attn_dma(lds + nxt * A_TILE, sn, wave, lane); }
        const LAS unsigned char* Kg = lds + cur * A_TILE + g * 8192; const LAS unsigned char* Vg = Kg + 16384;
        if (T <= n_slc) {
            const int jb = T - 1;
            const float cin[2] = {((selm[0] >> jb) & 1u) ? 0.f : NEGBIG, ((selm[1] >> jb) & 1u) ? 0.f : NEGBIG};
            if (__any((int)(((selm[0] | selm[1]) >> jb) & 1u))) attn_tile<1>(Kg, Vg, qf, O, mrun, lrun, s, lane, 64 * jb, qpos, cin, jb == qblk);
            if (T == n_slc) ATT_FINISH(1);
        } else {
            const int jt = lo + (T - 1 - n_slc);
            const bool em = (64 * jt + 63 > t0) || (64 * jt <= t0 + 31 - 512);
            attn_tile<2>(Kg, Vg, qf, O, mrun, lrun, s, lane, 64 * jt, qpos, czero, em);
            if (T == NT - 1) ATT_FINISH(2);
        }
        if (more) asm volatile("s_waitcnt vmcnt(4)" ::: "memory"); else asm volatile("s_waitcnt vmcnt(0)" ::: "memory");
        ATT_BAR();
        cur = (cur == 2) ? 0 : cur + 1; nxt = (nxt == 2) ? 0 : nxt + 1;
    }
#undef ATT_FINISH
#pragma unroll
    for (int qt = 0; qt < 2; ++qt) {
        const size_t row = row0 + 16 * qt + lr;
#pragma unroll
        for (int dt = 0; dt < 4; ++dt) {
            const int col = 64 * wave + 16 * dt + 4 * grp;
            float za[4]; unpack4(*(const u32x2*)(ACT + row * NIN + LZA + col), za);
            u32x2 w; w.x = cvt_pk_bf16(OA[dt][qt][0] * za[0], OA[dt][qt][1] * za[1]); w.y = cvt_pk_bf16(OA[dt][qt][2] * za[2], OA[dt][qt][3] * za[3]);
            *(u32x2*)(AB + row * DM + col) = w;
        }
    }
}

constexpr int G_ST = 0, G_VNT = 1024, VPITCH = 136;
__device__ __forceinline__ void gmlp_unit(const Params& P, LAS unsigned char* lds, int b, int ch, int gp, int tid, int lane, int wave) {
    asm volatile("" : "+v"(tid), "+v"(lane));
    const bf16_t* ACT = (const bf16_t*)(P.ws + WS_ACT); bf16_t* AB = (bf16_t*)(P.ws + WS_AB);
    LAS f32x2* ST = (LAS f32x2*)(lds + G_ST); LAS bf16_t* Vnt = (LAS bf16_t*)(lds + G_VNT);
    const size_t R0 = (size_t)b * SEQ + 128 * ch;
    __syncthreads();
    {
        u32x4 raw[16];
#pragma unroll
        for (int i = 0; i < 16; ++i) raw[i] = *(const u32x4*)(ACT + (R0 + wave + 8 * i) * NIN + LVB + 8 * lane);
#pragma unroll
        for (int i = 0; i < 16; ++i) {
            float f[8]; f[0] = bf2f(raw[i].x); f[1] = bf2f(raw[i].x >> 16); f[2] = bf2f(raw[i].y); f[3] = bf2f(raw[i].y >> 16); f[4] = bf2f(raw[i].z); f[5] = bf2f(raw[i].z >> 16); f[6] = bf2f(raw[i].w); f[7] = bf2f(raw[i].w >> 16);
            float sm = 0.f, sq = 0.f;
#pragma unroll
            for (int e = 0; e < 8; ++e) { sm += f[e]; sq += f[e] * f[e]; }
#pragma unroll
            for (int o = 1; o < 64; o <<= 1) { sm += __shfl_xor(sm, o); sq += __shfl_xor(sq, o); }
            const float mean = sm * (1.0f / 512.0f), var = fmaxf(sq * (1.0f / 512.0f) - mean * mean, 0.f);
            if (lane == 0) ST[wave + 8 * i] = (f32x2){mean, rsqrtf(var + 1e-6f)};
        }
    }
    __syncthreads();
    {
        const float* vg = P.in[21] + 256 * gp; const float* vb = P.in[22] + 256 * gp;
        u32x4 raw[4][2];
#pragma unroll
        for (int i = 0; i < 4; ++i) { const int idx = tid + 512 * i, j2 = idx & 63, chn = idx >> 6;
#pragma unroll
            for (int h2 = 0; h2 < 2; ++h2) raw[i][h2] = *(const u32x4*)(ACT + (R0 + 2 * j2 + h2) * NIN + LVB + 256 * gp + 8 * chn); }
#pragma unroll
        for (int i = 0; i < 4; ++i) {
            const int idx = tid + 512 * i, j2 = idx & 63, chn = idx >> 6;
            const f32x2 st0 = ST[2 * j2], st1 = ST[2 * j2 + 1];
            const unsigned w0[4] = {raw[i][0].x, raw[i][0].y, raw[i][0].z, raw[i][0].w}, w1[4] = {raw[i][1].x, raw[i][1].y, raw[i][1].z, raw[i][1].w};
#pragma unroll
            for (int e = 0; e < 8; ++e) { const int d = 8 * chn + e;
                const float a = bf2f(w0[e >> 1] >> (16 * (e & 1))), b2 = bf2f(w1[e >> 1] >> (16 * (e & 1)));
                *(LAS unsigned*)(Vnt + d * VPITCH + 2 * j2) = cvt_pk_bf16((a - st0[0]) * st0[1] * vg[d] + vb[d], (b2 - st1[0]) * st1[1] * vg[d] + vb[d]); }
        }
    }
    __syncthreads();
    const int lr = lane & 15, grp = lane >> 4, g = 2 * gp + (wave >> 2);
    const bf16_t* tril = (const bf16_t*)(P.ws + WS_TRIL) + (size_t)g * 128 * 128;
    f32x4 acc[2][8];
#pragma unroll
    for (int t2 = 0; t2 < 2; ++t2)
#pragma unroll
        for (int it = 0; it < 8; ++it) acc[t2][it] = (f32x4){0.f, 0.f, 0.f, 0.f};
#pragma unroll
    for (int ks = 0; ks < 4; ++ks) {
        const bf16x8 af0 = *(const LAS bf16x8*)(Vnt + (32 * wave + lr) * VPITCH + 32 * ks + 8 * grp);
        const bf16x8 af1 = *(const LAS bf16x8*)(Vnt + (32 * wave + 16 + lr) * VPITCH + 32 * ks + 8 * grp);
#pragma unroll
        for (int it = 0; it < 8; ++it) {
            if ((it >> 1) >= ks) { const bf16x8 bfr = *(const bf16x8*)(tril + (size_t)(16 * it + lr) * 128 + 32 * ks + 8 * grp);
                acc[0][it] = __builtin_amdgcn_mfma_f32_16x16x32_bf16(af0, bfr, acc[0][it], 0, 0, 0); acc[1][it] = __builtin_amdgcn_mfma_f32_16x16x32_bf16(af1, bfr, acc[1][it], 0, 0, 0); }
        }
    }
    const float* bs = P.in[24] + 128 * g;
#pragma unroll
    for (int it = 0; it < 8; ++it) {
        const int i = 16 * it + lr; const size_t row = R0 + i;
        const float bsi = bs[i];
#pragma unroll
        for (int t2 = 0; t2 < 2; ++t2) {
            const int d0 = 256 * gp + 32 * wave + 16 * t2 + 4 * grp;
            float uu[4], zb[4]; unpack4(*(const u32x2*)(ACT + row * NIN + LU + d0), uu); unpack4(*(const u32x2*)(ACT + row * NIN + LZB + d0), zb);
            u32x2 w; w.x = cvt_pk_bf16(uu[0] * (acc[t2][it][0] + bsi) * zb[0], uu[1] * (acc[t2][it][1] + bsi) * zb[1]); w.y = cvt_pk_bf16(uu[2] * (acc[t2][it][2] + bsi) * zb[2], uu[3] * (acc[t2][it][3] + bsi) * zb[3]);
            *(u32x2*)(AB + row * DM + 512 + d0) = w;
        }
    }
}

__device__ __forceinline__ void stile(const float* kb, const float* vb, int stride, int kmin, const f32x4 (&q4)[4], float (&m)[4], float (&l)[4], f32x4 (&o4)[4], float (&pout)[4], int lane_in) {
    int lane = lane_in; asm volatile("" : "+v"(lane));
    const int li = lane & 15, gq = lane >> 4;
    __builtin_amdgcn_sched_barrier(0);
    const float* kl = kb + (size_t)(gq * stride + 4 * li); const float* vl = vb + (size_t)(gq * stride + 4 * li);
    f32x4 kreg[16], vreg[16];
#pragma unroll
    for (int i = 0; i < 16; ++i) kreg[i] = __builtin_nontemporal_load((const f32x4*)(kl + (size_t)(4 * i) * stride));
#pragma unroll
    for (int i = 0; i < 16; ++i) vreg[i] = __builtin_nontemporal_load((const f32x4*)(vl + (size_t)(4 * i) * stride));
    float sc[4];
#pragma unroll
    for (int h = 0; h < 4; ++h) {
        float v[16], w8[8], w4[4], w2[2];
#pragma unroll
        for (int i = 0; i < 16; ++i) v[i] = (kreg[i][0] * q4[h][0] + kreg[i][1] * q4[h][1]) + (kreg[i][2] * q4[h][2] + kreg[i][3] * q4[h][3]);
#pragma unroll
        for (int t = 0; t < 8; ++t) { const float snd = (li & 8) ? v[t] : v[t + 8], kp = (li & 8) ? v[t + 8] : v[t]; w8[t] = kp + __shfl_xor(snd, 8); }
#pragma unroll
        for (int t = 0; t < 4; ++t) { const float snd = (li & 4) ? w8[t] : w8[t + 4], kp = (li & 4) ? w8[t + 4] : w8[t]; w4[t] = kp + __shfl_xor(snd, 4); }
#pragma unroll
        for (int t = 0; t < 2; ++t) { const float snd = (li & 2) ? w4[t] : w4[t + 2], kp = (li & 2) ? w4[t + 2] : w4[t]; w2[t] = kp + __shfl_xor(snd, 2); }
        { const float snd = (li & 1) ? w2[0] : w2[1], kp = (li & 1) ? w2[1] : w2[0]; sc[h] = kp + __shfl_xor(snd, 1); }
        __builtin_amdgcn_sched_barrier(0);
    }
    const bool valid = (4 * li + gq) >= kmin;
#pragma unroll
    for (int h = 0; h < 4; ++h) {
        const float sv = valid ? sc[h] : NEGBIG;
        const float mnew = fmaxf(m[h], wave_max(sv));
        const float alpha = __builtin_amdgcn_exp2f(m[h] - mnew), p = __builtin_amdgcn_exp2f(sv - mnew);
        l[h] = l[h] * alpha + wave_sum(p); o4[h] *= alpha; m[h] = mnew; pout[h] = p;
    }
    const int src0 = lane & 48;
#pragma unroll
    for (int i = 0; i < 16; ++i) {
#pragma unroll
        for (int h = 0; h < 4; ++h) o4[h] += vreg[i] * __shfl(pout[h], src0 + i);
    }
    __builtin_amdgcn_sched_barrier(0);
}
__device__ __forceinline__ void skey(const float* kb, const float* vb, const f32x4 (&q4)[4], float (&m)[4], float (&l)[4], f32x4 (&o4)[4], int lane) {
    const int li = lane & 15, gq = lane >> 4;
    const f32x4 kd = *(const f32x4*)(kb + 4 * li), vd = *(const f32x4*)(vb + 4 * li);
#pragma unroll
    for (int h = 0; h < 4; ++h) {
        float sv = (kd[0] * q4[h][0] + kd[1] * q4[h][1]) + (kd[2] * q4[h][2] + kd[3] * q4[h][3]);
        sv += __shfl_xor(sv, 1); sv += __shfl_xor(sv, 2); sv += __shfl_xor(sv, 4); sv += __shfl_xor(sv, 8);
        const float mnew = fmaxf(m[h], sv), alpha = __builtin_amdgcn_exp2f(m[h] - mnew), p = __builtin_amdgcn_exp2f(sv - mnew);
        l[h] = l[h] * alpha + p; o4[h] *= alpha; if (gq == 0) o4[h] += vd * p; m[h] = mnew;
    }
}

constexpr int S_ST = 0, S_MISC = 8 * 3 * 4 * 66 * 4;
__device__ __forceinline__ void sample_unit(const Params& P, LAS unsigned char* lds, int sb, int g, int tid, int lane, int wave) {
    const bf16_t* ACT = (const bf16_t*)(P.ws + WS_ACT); bf16_t* AB = (bf16_t*)(P.ws + WS_AB);
    LAS float* ST = (LAS float*)(lds + S_ST); LAS float* MISC = (LAS float*)(lds + S_MISC);
    const size_t row = (size_t)MP + sb;
    const int* ptab = (const int*)P.in[8] + sb * 16;
    const int li = lane & 15;
    __syncthreads();
    f32x4 q4[4];
#pragma unroll
    for (int h = 0; h < 4; ++h) { float t4[4]; unpack4(*(const u32x2*)(ACT + row * NIN + LQ + 64 * (4 * g + h) + 4 * li), t4); q4[h] = (f32x4){t4[0], t4[1], t4[2], t4[3]}; }
    float ms[4], ls[4]; f32x4 os[4];
#define S_RESET() do { _Pragma("unroll") for (int h = 0; h < 4; ++h) { ms[h] = MINIT; ls[h] = 0.f; os[h] = (f32x4){0.f, 0.f, 0.f, 0.f}; } } while (0)
#define S_PUBLISH(b2, doit) do { _Pragma("unroll") for (int h = 0; h < 4; ++h) { f32x4 v = os[h]; \
        _Pragma("unroll") for (int e = 0; e < 4; ++e) { float x = v[e]; x += __shfl_xor(x, 16); x += __shfl_xor(x, 32); v[e] = x; } \
        if (doit) { LAS float* st = ST + ((wave * 3 + (b2)) * 4 + h) * 66; if (lane < 16) *(LAS f32x4*)(st + 4 * lane) = v; if (lane == 0) { st[64] = ms[h]; st[65] = ls[h]; } } } } while (0)
    float pdummy[4], pc[4];
    S_RESET();
    { const size_t off = (((size_t)sb * 512 + 64 * wave) * 2 + g) * 64; stile(P.in[6] + off, P.in[7] + off, 128, (wave == 0) ? 1 : 0, q4, ms, ls, os, pdummy, lane); }
    if (wave == 0) { const size_t off = ((size_t)(sb * 512 + 511) * 2 + g) * 64; skey(P.out + O_SKW + off, P.out + O_SVW + off, q4, ms, ls, os, lane); }
    S_PUBLISH(1, true);
    S_RESET();
    stile((const float*)(P.ws + WS_KCS) + (size_t)(sb * 2 + g) * 4096, (const float*)(P.ws + WS_VCS) + (size_t)(sb * 2 + g) * 4096, 64, 0, q4, ms, ls, os, pc, lane);
    float imp = 0.f;
#pragma unroll
    for (int h = 0; h < 4; ++h) { const float pn = pc[h] / ls[h]; imp += pn + __shfl_down(pn, 16); }
    S_PUBLISH(2, wave == 0);
    const int jblk = 2 * li + (lane >> 5);
    const bool cand = ((lane >> 4) & 1) == 0 && jblk >= 1;
    unsigned key = cand ? ((__builtin_bit_cast(unsigned, imp) & 0xffffffe0u) | (unsigned)(31 - jblk)) : 0u;
    unsigned long long selpack = 0ull;
#pragma unroll
    for (int pick = 0; pick < 6; ++pick) {
        unsigned best = key;
#pragma unroll
        for (int o2 = 1; o2 < 64; o2 <<= 1) { const unsigned other = (unsigned)__shfl_xor((int)best, o2); best = other > best ? other : best; }
        const int bj = 31 - (int)(best & 31u);
        selpack |= (unsigned long long)bj << (5 * (pick + 1));
        if (cand && jblk == bj) key = 0u;
    }
    S_RESET();
    if (wave < 7) { const int blk = (int)((selpack >> (5 * wave)) & 31ull); const int page = __builtin_amdgcn_readfirstlane(ptab[blk >> 1]); const size_t off = (((size_t)page * 128 + (blk & 1) * 64) * 2 + g) * 64;
        stile(P.in[4] + off, P.in[5] + off, 128, 0, q4, ms, ls, os, pdummy, lane); }
    else skey(P.out + O_SKS + (size_t)sb * 128 + g * 64, P.out + O_SVS + (size_t)sb * 128 + g * 64, q4, ms, ls, os, lane);
    S_PUBLISH(0, true);
#undef S_RESET
#undef S_PUBLISH
    if (wave == 7) {
        const u32x4 raw = *(const u32x4*)(ACT + row * NIN + LVB + 8 * lane);
        float f[8]; f[0] = bf2f(raw.x); f[1] = bf2f(raw.x >> 16); f[2] = bf2f(raw.y); f[3] = bf2f(raw.y >> 16); f[4] = bf2f(raw.z); f[5] = bf2f(raw.z >> 16); f[6] = bf2f(raw.w); f[7] = bf2f(raw.w >> 16);
        float sm = 0.f;
#pragma unroll
        for (int i = 0; i < 8; ++i) sm += f[i];
        const float mean = wave_sum(sm) * (1.0f / 512.0f); float sq = 0.f;
#pragma unroll
        for (int i = 0; i < 8; ++i) { const float d = f[i] - mean; sq += d * d; }
        const float rstd = rsqrtf(wave_sum(sq) * (1.0f / 512.0f) + 1e-6f);
        if (lane == 0) { MISC[0] = mean; MISC[1] = rstd; }
    }
    __syncthreads();
    if (wave < 4) {
        const int h = wave, head = 4 * g + h;
        const LAS float* stc = ST + ((0 * 3 + 2) * 4 + h) * 66;
        float oa = bf2f(ACT[row * NIN + LNSA + 3 * head + 0]) * stc[lane] / stc[65];
#pragma unroll
        for (int b2 = 0; b2 < 2; ++b2) {
            float M = MINIT;
#pragma unroll
            for (int w = 0; w < 8; ++w) M = fmaxf(M, ST[((w * 3 + b2) * 4 + h) * 66 + 64]);
            float L = 0.f, O = 0.f;
#pragma unroll
            for (int w = 0; w < 8; ++w) { const LAS float* st = ST + ((w * 3 + b2) * 4 + h) * 66; const float f = __builtin_amdgcn_exp2f(st[64] - M); L += st[65] * f; O += st[lane] * f; }
            oa += bf2f(ACT[row * NIN + LNSA + 3 * head + 1 + b2]) * O / L;
        }
        const int col = 64 * head + lane;
        AB[row * DM + col] = (bf16_t)f2bf(oa * bf2f(ACT[row * NIN + LZA + col]));
    }
    if (tid < 256) {
        const int d = 256 * g + tid, gm = d >> 7;
        const float vn = (bf2f(ACT[row * NIN + LVB + d]) - MISC[0]) * MISC[1] * P.in[21][d] + P.in[22][d];
        P.out[O_SVCH + (size_t)sb * 512 + d] = vn;
        const float sv = P.in[23][(size_t)gm * 128 * 128] * vn + P.in[24][gm * 128];
        AB[row * DM + 512 + d] = (bf16_t)f2bf(bf2f(ACT[row * NIN + LU + d]) * sv * bf2f(ACT[row * NIN + LZB + d]));
    }
}

template <int MODE>
__device__ __forceinline__ void small_gemm(const Params& P, int c, int G, int wave, int lane) {
    const int lr = lane & 15, grp = lane >> 4;
    for (int t = c + G * wave; t < 512; t += G * 8) {
        const int rt = t & 7, ct = t >> 3;
        const size_t row = (size_t)MP + 16 * rt + lr;
        const bf16_t* A = (const bf16_t*)(P.ws + (MODE == 0 ? WS_AB : WS_H)) + row * DM + 8 * grp;
        const int wrow = (MODE == 0) ? (256 * (ct >> 4) + 128 * ((ct >> 1) & 1) + 32 * ((ct >> 2) & 3) + 16 * (ct & 1) + lr) : (16 * ct + lr);
        const bf16_t* W = (const bf16_t*)(P.ws + (MODE == 0 ? WS_WTBR : WS_WTOUT)) + (size_t)wrow * DM + 8 * grp;
        f32x4 acc0 = (f32x4){0.f, 0.f, 0.f, 0.f}, acc1 = (f32x4){0.f, 0.f, 0.f, 0.f};
#pragma unroll
        for (int ks = 0; ks < 16; ++ks) acc0 = __builtin_amdgcn_mfma_f32_16x16x32_bf16(*(const bf16x8*)(W + 32 * ks), *(const bf16x8*)(A + 32 * ks), acc0, 0, 0, 0);
#pragma unroll
        for (int ks = 16; ks < 32; ++ks) acc1 = __builtin_amdgcn_mfma_f32_16x16x32_bf16(*(const bf16x8*)(W + 32 * ks), *(const bf16x8*)(A + 32 * ks), acc1, 0, 0, 0);
        const int col = 16 * ct + 4 * grp;
        if (MODE == 0) {
            const int i = 16 * rt + lr, cc = col & 255;
            const size_t go = ((size_t)(((64 * 8 + (col >> 8)) * 8 + (i >> 6) * 4 + (cc >> 6)) * 32 + ((((i >> 4) & 3) * 2 + ((cc >> 5) & 1)) * 2 + ((cc >> 4) & 1))) * 64 + ((cc >> 2) & 3) * 16 + (i & 15)) * 4;
            const bf16_t* GB = (const bf16_t*)(P.ws + WS_GBUF);
            float sa[4], sb[4]; unpack4(*(const u32x2*)(GB + go), sa); unpack4(*(const u32x2*)(GB + go + (size_t)4 * 8 * 32 * 256), sb);
            u32x2 w; w.x = cvt_pk_bf16(sa[0] * acc0[0] + sb[0] * acc1[0], sa[1] * acc0[1] + sb[1] * acc1[1]); w.y = cvt_pk_bf16(sa[2] * acc0[2] + sb[2] * acc1[2], sa[3] * acc0[3] + sb[3] * acc1[3]);
            *(u32x2*)((bf16_t*)(P.ws + WS_H) + row * DM + col) = w;
        } else {
            const int sbi = 16 * rt + lr;
            const f32x4 xv = *(const f32x4*)(P.in[1] + (size_t)sbi * DM + col), gv = *(const f32x4*)((const float*)(P.ws + WS_MOD) + (size_t)(8 + sbi) * 3072 + 2048 + col);
            *(f32x4*)(P.out + O_YS + (size_t)sbi * DM + col) = xv + gv * (acc0 + acc1);
        }
    }
}

#define XB_TMO      128
#define XB_XCNT(j)  (256  + 64 * (j))
#define XB_XSUB(j)  (1280 + 64 * (j))
#define XB_XGEN(j)  (2304 + 64 * (j))
#define XB_TOP      3328
#define XB_TOPGEN   3392
#define XCD_BAR_WORDS 3456
#define XB_SPIN_CAP (1u << 18)
__device__ __forceinline__ unsigned xb_ld(unsigned* p)              { return __hip_atomic_load(p, __ATOMIC_RELAXED, __HIP_MEMORY_SCOPE_AGENT); }
__device__ __forceinline__ unsigned xb_add(unsigned* p, unsigned v) { return __hip_atomic_fetch_add(p, v, __ATOMIC_RELAXED, __HIP_MEMORY_SCOPE_AGENT); }
__device__ __forceinline__ unsigned xb_xcc_id() { return (unsigned)__builtin_amdgcn_s_getreg((3 << 11) | 20) & 0xFu; }
#define XB_SPIN(cond, bar) do { unsigned _sp = 0; while (cond) { __builtin_amdgcn_s_sleep(1); \
    if ((++_sp & 255u) == 0u) { if (xb_ld(&(bar)[XB_TMO])) break; if (_sp > XB_SPIN_CAP) { atomicAdd(&(bar)[XB_TMO], 1u); break; } } } } while (0)
struct XcdBarrier { unsigned* bar; unsigned x; volatile LAS unsigned* st; };
__device__ __forceinline__ XcdBarrier xcd_barrier_post(unsigned* bar, volatile LAS unsigned* st) {
    XcdBarrier b; b.bar = bar; b.x = xb_xcc_id(); b.st = st;
    if (threadIdx.x == 0) (void)xb_add(&bar[XB_XCNT(b.x)], 1u);
    return b;
}
__device__ __forceinline__ void xcd_barrier_complete(unsigned* bar, unsigned x, unsigned& nloc, unsigned& nx) {
    const unsigned G = gridDim.x * gridDim.y * gridDim.z;
    unsigned sum, cnt, mine, sp = 0u;
    for (;;) {
        sum = 0u; cnt = 0u; mine = 0u;
#pragma unroll
        for (unsigned j = 0; j < 16; ++j) { const unsigned c = xb_ld(&bar[XB_XCNT(j)]); sum += c; cnt += (c > 0u) ? 1u : 0u; mine = (j == x) ? c : mine; }
        if (sum == G) break;
        __builtin_amdgcn_s_sleep(1);
        if ((++sp & 255u) == 0u) { if (xb_ld(&bar[XB_TMO])) break; if (sp > XB_SPIN_CAP) { atomicAdd(&bar[XB_TMO], 1u); break; } }
    }
    nloc = mine > 0u ? mine : 1u; nx = cnt > 0u ? cnt : 1u;
}
__device__ __forceinline__ void xcd_barrier(const XcdBarrier& b) {
    asm volatile("s_waitcnt vmcnt(0)" ::: "memory");
    __syncthreads();
    if (threadIdx.x == 0) {
        unsigned* bar = b.bar;
        __builtin_amdgcn_s_waitcnt(0);
        unsigned nloc = b.st[0], nx = b.st[1];
        if (nloc == 0u) { xcd_barrier_complete(bar, b.x, nloc, nx); b.st[0] = nloc; b.st[1] = nx; }
        const unsigned old = xb_add(&bar[XB_XSUB(b.x)], 1u);
        const unsigned gen = old / nloc;
        if (old + 1u == (gen + 1u) * nloc) {
            __builtin_amdgcn_fence(__ATOMIC_RELEASE, "agent");
            asm volatile("s_waitcnt vmcnt(0)" ::: "memory");
            const unsigned og = xb_add(&bar[XB_TOP], 1u);
            const unsigned tg = og / nx;
            if (og + 1u == (tg + 1u) * nx) xb_add(&bar[XB_TOPGEN], 1u);
            else XB_SPIN(xb_ld(&bar[XB_TOPGEN]) == tg, bar);
            __builtin_amdgcn_fence(__ATOMIC_ACQUIRE, "agent");
            xb_add(&bar[XB_XGEN(b.x)], 1u);
            asm volatile("s_waitcnt vmcnt(0)" ::: "memory");
        } else {
            XB_SPIN(xb_ld(&bar[XB_XGEN(b.x)]) == gen, bar);
            __builtin_amdgcn_fence(__ATOMIC_ACQUIRE, "agent");
            asm volatile("s_waitcnt vmcnt(0)" ::: "memory");
        }
    }
    __syncthreads();
}

__global__ void __launch_bounds__(512, 2) mk_fwd(Params P) {
    extern __shared__ __attribute__((aligned(16))) unsigned char lds_raw[];
    LAS unsigned char* lds = (LAS unsigned char*)lds_raw;
    const int tid = threadIdx.x, lane = tid & 63, wave = __builtin_amdgcn_readfirstlane(tid >> 6);
    const int G = gridDim.x, c = blockIdx.x, gw = c * 8 + wave, NGW = G * 8, gtid = c * 512 + tid, NT = G * 512;
    cg::grid_group grid = cg::this_grid();
    const int lo = P.ph_lo, hi = P.ph_hi;
    if (tid < 16) ((LAS unsigned*)(lds + LDS_XB))[tid] = 0u;
    __syncthreads();
    const XcdBarrier bar = xcd_barrier_post((unsigned*)(P.ws + WS_CTL), (volatile LAS unsigned*)(lds + LDS_XB));
    if (hi < 0) grid.sync();
#define IN(k) (lo <= (k) && (k) < hi)
#define SEAM(k) do { if (IN(k) && IN((k) + 1)) xcd_barrier(bar); } while (0)
    unsigned char* ws = P.ws;
    if (IN(0)) for (int rep = 0; rep < MK_REP0; ++rep) { p0_prologue(P, lds, gw, NGW, lane, wave, gtid, NT); }
    SEAM(0);
    if (IN(1)) for (int rep = 0; rep < MK_REP1; ++rep) { p1_hrows(P, gw, NGW, lane); }
    SEAM(1);
    if (IN(2)) for (int rep = 0; rep < MK_REP2; ++rep) {
        pg8::Gemm gm{(const bf16_t*)(ws + WS_H), (const bf16_t*)(ws + WS_WTIN), DM, DM, DM};
        pg8::StaticOrder S; S.init(MPAD / 256, NIN / 256, G, c);
        EpiInProj E{(bf16_t*)(ws + WS_ACT), (bf16_t*)(ws + WS_VT), (bf16_t*)(ws + WS_GBUF), P.out, P.in[15], P.in[16], (const float*)(ws + WS_ROPE), lds + LDS_EPI};
        pg8::gemm_phase<EpiInProj, pg8::StaticOrder>(lds, gm, S, E);
    }
    SEAM(2);
    if (IN(3)) for (int rep = 0; rep < MK_REP3; ++rep) { p3_compress(P, lds, gw, NGW, lane, wave); }
    SEAM(3);
    if (IN(4)) for (int rep = 0; rep < MK_REP4; ++rep) {
        asm volatile("" ::: "memory");
        for (int i = 0;; ++i) { const int a = (i & 1) ? (i + 1) * G - 1 - c : i * G + c; if (a >= 512 || a < 0) break; attn_unit(P, lds, a & 7, 63 - (a >> 3), tid, lane, wave); }
        {
            unsigned* qctr = (unsigned*)(ws + WS_CTL) + 3584;
            LAS unsigned* qsl = (LAS unsigned*)(lds + LDS_XB + 32);
            for (;;) {
                __syncthreads();
                if (tid == 0) *qsl = __hip_atomic_fetch_add(qctr, 1u, __ATOMIC_RELAXED, __HIP_MEMORY_SCOPE_AGENT);
                __syncthreads();
                const int u = (int)*qsl;
                if (u >= 512) break;
                if (u < 256) gmlp_unit(P, lds, u >> 5, (u >> 1) & 15, u & 1, tid, lane, wave);
                else { const int su = u - 256; sample_unit(P, lds, su >> 1, su & 1, tid, lane, wave); }
            }
        }
        __syncthreads();
    }
    SEAM(4);
    if (IN(5)) for (int rep = 0; rep < MK_REP5; ++rep) {
        pg8::Gemm gm{(const bf16_t*)(ws + WS_AB), (const bf16_t*)(ws + WS_WTBR), DM, DM, 512};
        small_gemm<0>(P, c, G, wave, lane);
        pg8::PairOrder S; S.S.init(MP / 256, DM / 256, G, c);
        EpiMix E{(const bf16_t*)(ws + WS_GBUF), (bf16_t*)(ws + WS_H)};
        pg8::gemm_phase<EpiMix, pg8::PairOrder>(lds, gm, S, E);
    }
    SEAM(5);
    if (IN(6)) for (int rep = 0; rep < MK_REP6; ++rep) {
        pg8::Gemm gm{(const bf16_t*)(ws + WS_H), (const bf16_t*)(ws + WS_WTOUT), DM, DM, DM};
        small_gemm<1>(P, c, G, wave, lane);
        pg8::StaticOrder S; S.init(MP / 256, DM / 256, G, c);
        EpiOut E{P.in[0], P.in[1], (const float*)(ws + WS_MOD), P.out};
        pg8::gemm_phase<EpiOut, pg8::StaticOrder>(lds, gm, S, E);
    }
#undef IN
#undef SEAM
}

extern "C" void kernel_launch(void* const* d_in, const int* in_sizes, int n_in, void* d_out, int out_size, void* d_ws, size_t ws_size, hipStream_t stream) {
    static int grid = 0;
    if (grid == 0) {
        if (n_in != 28 || out_size != (int)O_END || ws_size < WS_END) { fprintf(stderr, "kernel_launch: unexpected shapes (n_in %d, out %d, ws %zu); nothing launched\n", n_in, out_size, ws_size); grid = -1; return; }
        int dev = 0, cus = 0, per_cu = 0;
        if (hipGetDevice(&dev) != hipSuccess || hipDeviceGetAttribute(&cus, hipDeviceAttributeMultiprocessorCount, dev) != hipSuccess) { grid = -1; return; }
        if (hipFuncSetAttribute((const void*)mk_fwd, hipFuncAttributeMaxDynamicSharedMemorySize, LDS_BYTES) != hipSuccess) { fprintf(stderr, "kernel_launch: hipFuncSetAttribute failed\n"); grid = -1; return; }
        if (hipOccupancyMaxActiveBlocksPerMultiprocessor(&per_cu, (const void*)mk_fwd, 512, LDS_BYTES) != hipSuccess || per_cu < 1) { fprintf(stderr, "kernel_launch: occupancy query failed (%d)\n", per_cu); (void)hipGetLastError(); per_cu = 1; }
        if (per_cu > 1) per_cu = 1;
        grid = cus * per_cu;
    }
    if (grid < 0) return;
    if (hipMemsetAsync((char*)d_ws + WS_CTL, 0, CTL_BYTES, stream) != hipSuccess) { fprintf(stderr, "kernel_launch: hipMemsetAsync failed\n"); return; }
    Params p{};
    for (int i = 0; i < 28; ++i) p.in[i] = (const float*)d_in[i];
    p.out = (float*)d_out; p.ws = (unsigned char*)d_ws;
#if MK_N_LAUNCHES == 1
    p.ph_lo = 0; p.ph_hi = 7;
    void* args[] = {&p};
    hipError_t e = hipLaunchCooperativeKernel((const void*)mk_fwd, dim3(grid), dim3(512), args, LDS_BYTES, stream);
    if (e != hipSuccess) fprintf(stderr, "kernel_launch: cooperative launch failed: %s (grid %d)\n", hipGetErrorString(e), grid);
#else
    for (int ph = 0; ph < 7; ++ph) {
        p.ph_lo = ph; p.ph_hi = ph + 1;
        void* args[] = {&p};
        hipError_t e = hipLaunchCooperativeKernel((const void*)mk_fwd, dim3(grid), dim3(512), args, LDS_BYTES, stream);
        if (e != hipSuccess) { fprintf(stderr, "kernel_launch: launch %d failed: %s (grid %d)\n", ph, hipGetErrorString(e), grid); break; }
    }
#endif
}
```

```cpp
#include <hip/hip_runtime.h>
#include <hip/hip_cooperative_groups.h>
#include <cstdio>
#include <cstdint>
namespace cg = cooperative_groups;

#ifndef MK_N_LAUNCHES
#define MK_N_LAUNCHES 1
#endif
#define MK_REP0 1
#define MK_REP1 1
#define MK_REP2 1
#define MK_REP3 1
#define MK_REP4 1
#define MK_REP5 1
#define MK_REP6 1

#define LAS __attribute__((address_space(3)))
typedef unsigned short bf16_t;
typedef short bf16x8 __attribute__((ext_vector_type(8)));
typedef short bf16x4 __attribute__((ext_vector_type(4)));
typedef float f32x4 __attribute__((ext_vector_type(4)));
typedef float f32x2 __attribute__((ext_vector_type(2)));
typedef unsigned u32x4 __attribute__((ext_vector_type(4)));
typedef unsigned u32x2 __attribute__((ext_vector_type(2)));

constexpr int DM = 1024, SEQ = 2048, NBATCH = 8, MP = NBATCH * SEQ, NSB = 128, MTOT = MP + NSB, MPAD = 16640;
constexpr int NIN = 5632;
constexpr int LQ = 0, LK = 512, LV = 896, LZA = 1280, LU = 1792, LVB = 2304, LZB = 2816, LGA = 3328, LGB = 4352, LNSA = 5376;
constexpr float C2Q = 0.125f * 1.4426950408889634f;
constexpr float NEGBIG = -1e30f, MINIT = -1e29f;
constexpr size_t O_YP = 0, O_YS = 16777216, O_PKC = 16908288, O_PVC = 19005440, O_PKS = 21102592, O_PVS = 23199744, O_PKW = 25296896, O_PVW = 25821184,
                 O_SKC = 26345472, O_SVC = 26361856, O_SKS = 26378240, O_SVS = 26394624, O_SKW = 26411008, O_SVW = 34799616, O_SVCH = 43188224, O_END = 43253760;
constexpr size_t MiB = 1u << 20;
constexpr size_t WS_ROPE = 0, WS_MOD = 1 * MiB, WS_WTIN = 3 * MiB, WS_WTBR = 14 * MiB, WS_WTOUT = 16 * MiB, WS_TRIL = 18 * MiB, WS_KC = 18 * MiB + 512 * 1024, WS_VCT = WS_KC + 128 * 1024,
                 WS_KCS = 19 * MiB, WS_VCS = 23 * MiB, WS_VT = 27 * MiB, WS_H = 40 * MiB, WS_AB = 73 * MiB, WS_ACT = 106 * MiB, WS_GBUF = 285 * MiB, WS_END = 355 * MiB;
constexpr size_t WS_CTL = 768 * 1024, CTL_BYTES = 16384;
constexpr int LDS_BYTES = 151552, LDS_XB = LDS_BYTES - 64;
constexpr int LDS_EPI = 131072, EPI_PITCH = 144, EPI_WAVE = 16 * EPI_PITCH;
static_assert(LDS_EPI + 8 * EPI_WAVE <= LDS_XB - 64, "epilogue staging");

struct Params { const float* in[28]; float* out; unsigned char* ws; int ph_lo, ph_hi; };

__device__ __forceinline__ unsigned f2bf(float f) { unsigned u = __builtin_bit_cast(unsigned, f); return (u + 0x7fffu + ((u >> 16) & 1u)) >> 16; }
__device__ __forceinline__ unsigned cvt_pk_bf16(float lo, float hi);
__device__ __forceinline__ unsigned pk2(float lo, float hi) { return cvt_pk_bf16(lo, hi); }
__device__ __forceinline__ float bf2f(unsigned b) { return __builtin_bit_cast(float, (b & 0xffffu) << 16); }
typedef __bf16 bf16x2_t __attribute__((ext_vector_type(2)));
__device__ __forceinline__ unsigned cvt_pk_bf16(float lo, float hi) { const f32x2 v = {lo, hi}; const bf16x2_t b = __builtin_convertvector(v, bf16x2_t); return __builtin_bit_cast(unsigned, b); }
__device__ __forceinline__ void stage_store_rows(LAS unsigned char* sw, int lane, int fr, int fq, const u32x2 (&w)[2][2], bf16_t* dst0, size_t pitch, int nrows) {
#pragma unroll
    for (int bj = 0; bj < 2; ++bj)
#pragma unroll
        for (int n = 0; n < 2; ++n) *(LAS u32x2*)(sw + fr * EPI_PITCH + (32 * bj + 16 * n + 4 * fq) * 2) = w[bj][n];
    const int r = lane >> 3, ch = lane & 7;
    const u32x4 v0 = *(const LAS u32x4*)(sw + r * EPI_PITCH + ch * 16), v1 = *(const LAS u32x4*)(sw + (r + 8) * EPI_PITCH + ch * 16);
    if (r < nrows) *(u32x4*)(dst0 + (size_t)r * pitch + ch * 8) = v0;
    if (r + 8 < nrows) *(u32x4*)(dst0 + (size_t)(r + 8) * pitch + ch * 8) = v1;
}
__device__ __forceinline__ float sigmoidf_(float x) { return __builtin_amdgcn_rcpf(1.0f + __builtin_amdgcn_exp2f(x * -1.4426950408889634f)); }
__device__ __forceinline__ float wave_sum(float v) {
#pragma unroll
    for (int o = 1; o < 64; o <<= 1) v += __shfl_xor(v, o);
    return v;
}
__device__ __forceinline__ float wave_max(float v) {
#pragma unroll
    for (int o = 1; o < 64; o <<= 1) v = fmaxf(v, __shfl_xor(v, o));
    return v;
}
__device__ __forceinline__ void unpack4(u32x2 w, float (&f)[4]) { f[0] = bf2f(w.x); f[1] = bf2f(w.x >> 16); f[2] = bf2f(w.y); f[3] = bf2f(w.y >> 16); }

namespace pg8 {
constexpr int BM = 256, BK = 64, HALF = 128, HTB = HALF * BK * 2, STAGE_BYTES = 8 * HTB, NXCD = 8, WGM = 8;
__host__ __device__ __forceinline__ int lds_byte(int r, int c) { const int st = (r >> 4) * 2 + (c >> 5), rr = r & 15, cc = c & 31, ob = rr * 64 + cc * 2; return st * 1024 + (ob ^ (((ob >> 9) & 1) << 5)); }
__host__ __device__ __forceinline__ void stage_rc(int b, int& R, int& C) { const int st = b / 1024, sb = b % 1024, swz = sb ^ (((sb >> 9) & 1) << 5); R = (st >> 1) * 16 + swz / 64; C = (st & 1) * 32 + (swz % 64) / 2; }

struct Unit { int pm, pn, kofs, keep; };
struct Gemm { const bf16_t* A; const bf16_t* Bt; int lda, ldb, K; };

struct StaticOrder {
    int nM, nN, nwg, G, c;
    __device__ void init(int nM_, int nN_, int G_, int c_) { nM = nM_; nN = nN_; nwg = nM * nN; G = G_; c = c_; }
    __device__ bool tile(int i, int& pm, int& pn) const {
        const long L = (long)i * G + c; if (L >= nwg) return false;
        int wgid = (int)L; { const int q = nwg / NXCD, r = nwg % NXCD, xcd = wgid % NXCD, off = wgid / NXCD; wgid = (xcd < r ? xcd * (q + 1) : r * (q + 1) + (xcd - r) * q) + off; }
        const int nig = WGM * nN, gid = wgid / nig, fm = gid * WGM, gsz = (nM - fm) < WGM ? (nM - fm) : WGM;
        pm = fm + ((wgid % nig) % gsz); pn = (wgid % nig) / gsz; return true;
    }
    __device__ bool next(int i, Unit& u) const { u.kofs = 0; u.keep = 0; return tile(i, u.pm, u.pn); }
};
struct PairOrder {
    StaticOrder S;
    __device__ bool next(int i, Unit& u) const { u.kofs = (i & 1) * 512; u.keep = (i & 1) ? 0 : 1; return S.tile(i >> 1, u.pm, u.pn); }
};

template <class Epi, class Sched>
__device__ __forceinline__ void gemm_phase(LAS unsigned char* lds, const Gemm g, const Sched& S, const Epi& E) {
    const int tid = threadIdx.x, wid = __builtin_amdgcn_readfirstlane(tid >> 6), lane = tid & 63, wr = wid >> 2, wc = wid & 3, fr = lane & 15, fq = lane >> 4;
    const int nt = g.K / BK;
    unsigned voffA[2], voffB[2];
#pragma unroll
    for (int i = 0; i < 2; ++i) { int R, C; stage_rc(tid * 16 + i * 8192, R, C); voffA[i] = (unsigned)(R * g.lda + C) * 2u; voffB[i] = (unsigned)(R * g.ldb + C) * 2u; }
    const size_t kstep = (size_t)(BK * 2);
    const size_t hstepA = (size_t)HALF * g.lda * 2, hstepB = (size_t)HALF * g.ldb * 2, tstepA = 2 * hstepA, tstepB = 2 * hstepB;
    const unsigned ldsw = (unsigned)wid * 1024u;
    const int aoff = lds_byte(wr * 64 + fr, fq * 8), boff = lds_byte(wc * 32 + fr, fq * 8);
#define PG8_SA(b, h) (((b) * 2 + (h)) * HTB)
#define PG8_SB(b, h) ((4 + (b) * 2 + (h)) * HTB)
#define PG8_STAGE(bufoff, gbase, voff) do { _Pragma("unroll") for (int _i = 0; _i < 2; ++_i) \
        __builtin_amdgcn_global_load_lds((const unsigned*)((const char*)(gbase) + (voff)[_i]), (LAS unsigned*)(lds + (bufoff) + ldsw + _i * 8192), 16, 0, 0); } while (0)
#define PG8_LDA(dst, b, h) do { _Pragma("unroll") for (int m = 0; m < 4; ++m) _Pragma("unroll") for (int k = 0; k < 2; ++k) dst[m][k] = *(const LAS bf16x8*)(lds + PG8_SA(b, h) + aoff + m * 2048 + k * 1024); } while (0)
#define PG8_LDB(dst, b, h) do { _Pragma("unroll") for (int n = 0; n < 2; ++n) _Pragma("unroll") for (int k = 0; k < 2; ++k) dst[n][k] = *(const LAS bf16x8*)(lds + PG8_SB(b, h) + boff + n * 2048 + k * 1024); } while (0)
#define PG8_MMA(ai, bj, At, Bt) do { __builtin_amdgcn_s_setprio(1); _Pragma("unroll") for (int m = 0; m < 4; ++m) _Pragma("unroll") for (int n = 0; n < 2; ++n) _Pragma("unroll") for (int k = 0; k < 2; ++k) \
        acc[ai][bj][m][n] = __builtin_amdgcn_mfma_f32_16x16x32_bf16(Bt[n][k], At[m][k], acc[ai][bj][m][n], 0, 0, 0); __builtin_amdgcn_s_setprio(0); } while (0)
#define PG8_WAIT_V(n) asm volatile("s_waitcnt vmcnt(" #n ")" ::: "memory")
#define PG8_WAIT_L(n) asm volatile("s_waitcnt lgkmcnt(" #n ")" ::: "memory")
#define PG8_BAR __builtin_amdgcn_s_barrier()
#define PG8_SCHED __builtin_amdgcn_sched_barrier(0)
    Unit cur, nxt; int ui = 0;
    if (!S.next(0, cur)) return;
    f32x4 acc[2][2][4][2];
#pragma unroll
    for (int a = 0; a < 2; ++a)
#pragma unroll
        for (int b = 0; b < 2; ++b)
#pragma unroll
            for (int m = 0; m < 4; ++m)
#pragma unroll
                for (int n = 0; n < 2; ++n) acc[a][b][m][n] = (f32x4){0.f, 0.f, 0.f, 0.f};
    bf16x8 At[4][2], B0[2][2], B1[2][2];
    const char* cA = (const char*)g.A + (size_t)cur.pm * tstepA + (size_t)cur.kofs * 2; const char* cB = (const char*)g.Bt + (size_t)cur.pn * tstepB + (size_t)cur.kofs * 2;
    PG8_STAGE(PG8_SB(0, 0), cB, voffB); PG8_STAGE(PG8_SB(0, 1), cB + hstepB, voffB); PG8_STAGE(PG8_SA(0, 0), cA, voffA); PG8_STAGE(PG8_SA(0, 1), cA + hstepA, voffA);
    if (wr == 1) PG8_BAR;
    PG8_WAIT_V(2); PG8_BAR;
    PG8_STAGE(PG8_SB(1, 0), cB + kstep, voffB); PG8_STAGE(PG8_SA(1, 0), cA + kstep, voffA); PG8_STAGE(PG8_SB(1, 1), cB + hstepB + kstep, voffB);
    PG8_WAIT_V(6); PG8_BAR;
    for (;;) {
        const bool has_next = S.next(ui + 1, nxt);
        const char* nA = has_next ? (const char*)g.A + (size_t)nxt.pm * tstepA + (size_t)nxt.kofs * 2 : cA; const char* nB = has_next ? (const char*)g.Bt + (size_t)nxt.pn * tstepB + (size_t)nxt.kofs * 2 : cB;
        for (int t = 0; t < nt; t += 2) {
            const bool last = (t == nt - 2);
            const char* a1 = cA + (size_t)(t + 1) * kstep;
            const char* a2 = last ? nA : cA + (size_t)(t + 2) * kstep; const char* b2 = last ? nB : cB + (size_t)(t + 2) * kstep;
            const char* a3 = a2 + kstep; const char* b3 = b2 + kstep;
            PG8_LDB(B0, 0, 0); PG8_LDB(B1, 0, 1); PG8_SCHED; PG8_LDA(At, 0, 0); PG8_STAGE(PG8_SA(1, 1), a1 + hstepA, voffA);
            PG8_WAIT_V(8); PG8_WAIT_L(0); PG8_BAR; PG8_MMA(0, 0, At, B0); PG8_MMA(0, 1, At, B1); PG8_BAR; PG8_SCHED;
            PG8_LDA(At, 0, 1); PG8_STAGE(PG8_SB(0, 0), b2, voffB); PG8_STAGE(PG8_SB(0, 1), b2 + hstepB, voffB); PG8_STAGE(PG8_SA(0, 0), a2, voffA);
            PG8_WAIT_V(8); PG8_WAIT_L(0); PG8_BAR; PG8_MMA(1, 0, At, B0); PG8_MMA(1, 1, At, B1); PG8_BAR; PG8_SCHED;
            PG8_LDB(B0, 1, 0); PG8_LDB(B1, 1, 1); PG8_SCHED; PG8_LDA(At, 1, 0); PG8_STAGE(PG8_SA(0, 1), a2 + hstepA, voffA);
            PG8_WAIT_V(8); PG8_WAIT_L(0); PG8_BAR; PG8_MMA(0, 0, At, B0); PG8_MMA(0, 1, At, B1); PG8_BAR; PG8_SCHED;
            PG8_LDA(At, 1, 1); PG8_STAGE(PG8_SB(1, 0), b3, voffB); PG8_STAGE(PG8_SB(1, 1), b3 + hstepB, voffB); PG8_STAGE(PG8_SA(1, 0), a3, voffA);
            PG8_WAIT_V(8); PG8_WAIT_L(0); PG8_BAR; PG8_MMA(1, 0, At, B0); PG8_MMA(1, 1, At, B1); PG8_BAR; PG8_SCHED;
        }
        if (wr == 0) PG8_BAR;
        E(acc, cur, wr, wc, fr, fq);
        if (!has_next) break;
        if (!cur.keep) {
#pragma unroll
            for (int a = 0; a < 2; ++a)
#pragma unroll
                for (int b = 0; b < 2; ++b)
#pragma unroll
                    for (int m = 0; m < 4; ++m)
#pragma unroll
                        for (int n = 0; n < 2; ++n) acc[a][b][m][n] = (f32x4){0.f, 0.f, 0.f, 0.f};
        }
        cur = nxt; cA = nA; cB = nB; ++ui;
        if (wr == 1) PG8_BAR;
    }
    PG8_WAIT_V(0);
    PG8_BAR;
#undef PG8_SA
#undef PG8_SB
#undef PG8_STAGE
#undef PG8_LDA
#undef PG8_LDB
#undef PG8_MMA
#undef PG8_WAIT_V
#undef PG8_WAIT_L
#undef PG8_BAR
#undef PG8_SCHED
}
}

struct EpiInProj {
    bf16_t* ACT; bf16_t* VT; bf16_t* GB; float* out; const float* qng; const float* kng; const float* rope; LAS unsigned char* stg;
    __device__ __forceinline__ void operator()(f32x4 (&acc)[2][2][4][2], const pg8::Unit& u, int wr, int wc, int fr, int fq) const {
        const int pn = u.pn;
        int type = 0, slot = 0;
        if (pn < 2) { type = 1; slot = 4 * pn + wc; }
        else if (pn == 2 || (pn == 3 && wc < 2)) { type = 2; slot = 4 * (pn - 2) + wc; }
        else if (pn == 3 || pn == 4) { type = 3; slot = 4 * (pn - 3) + wc - 2; }
        const int rbase = u.pm * 256 + wr * 64 + fr;
        if (type == 1 || type == 2) {
            const float* gn = (type == 1) ? qng : kng;
            f32x4 g4[2][2];
#pragma unroll
            for (int bj = 0; bj < 2; ++bj)
#pragma unroll
                for (int n = 0; n < 2; ++n) g4[bj][n] = *(const f32x4*)(gn + 32 * bj + 16 * n + 4 * fq);
            const int br = slot >> 1, kvh = slot & 1;
#pragma unroll
            for (int ai = 0; ai < 2; ++ai)
#pragma unroll
                for (int m = 0; m < 4; ++m) {
                    const int row = rbase + ai * 128 + m * 16;
                    float ss = 0.f;
#pragma unroll
                    for (int bj = 0; bj < 2; ++bj)
#pragma unroll
                        for (int n = 0; n < 2; ++n) { const f32x4 v = acc[ai][bj][m][n]; ss += (v[0] * v[0] + v[1] * v[1]) + (v[2] * v[2] + v[3] * v[3]); }
                    ss += __shfl_xor(ss, 16); ss += __shfl_xor(ss, 32);
                    const float rinv = __builtin_amdgcn_rsqf(ss * (1.0f / 64.0f) + 1e-6f);
                    const int pos = (row < MP) ? (row & (SEQ - 1)) : SEQ;
                    const bool live = row < MTOT;
                    long obase = -1;
                    if (type == 2 && live) {
                        if (row < MP) {
                            const int t = row & (SEQ - 1), b = row >> 11;
                            if (br == 0) obase = (long)O_PKC + (long)row * 128 + kvh * 64;
                            else if (br == 1) obase = (long)O_PKS + (long)row * 128 + kvh * 64;
                            else if (t >= 1536) obase = (long)O_PKW + ((long)(b * 512 + t - 1536) * 2 + kvh) * 64;
                        } else {
                            const int sb = row - MP;
                            if (br == 0) obase = (long)O_SKC + sb * 128 + kvh * 64;
                            else if (br == 1) obase = (long)O_SKS + sb * 128 + kvh * 64;
                            else obase = (long)O_SKW + ((long)(sb * 512 + 511) * 2 + kvh) * 64;
                        }
                    }
                    u32x2 wst[2][2];
#pragma unroll
                    for (int n = 0; n < 2; ++n) {
                        const f32x4 cs0 = *(const f32x4*)(rope + ((size_t)pos * 32 + 16 * n + 4 * fq) * 2);
                        const f32x4 cs1 = *(const f32x4*)(rope + ((size_t)pos * 32 + 16 * n + 4 * fq) * 2 + 4);
                        const float cc[4] = {cs0[0], cs0[2], cs1[0], cs1[2]}, sn[4] = {cs0[1], cs0[3], cs1[1], cs1[3]};
                        f32x4 o0, o1;
#pragma unroll
                        for (int j = 0; j < 4; ++j) {
                            const float y0 = acc[ai][0][m][n][j] * rinv * g4[0][n][j], y1 = acc[ai][1][m][n][j] * rinv * g4[1][n][j];
                            o0[j] = y0 * cc[j] - y1 * sn[j]; o1[j] = y1 * cc[j] + y0 * sn[j];
                        }
                        const float qs = (type == 1) ? C2Q : 1.0f;
                        wst[0][n].x = cvt_pk_bf16(o0[0] * qs, o0[1] * qs); wst[0][n].y = cvt_pk_bf16(o0[2] * qs, o0[3] * qs); wst[1][n].x = cvt_pk_bf16(o1[0] * qs, o1[1] * qs); wst[1][n].y = cvt_pk_bf16(o1[2] * qs, o1[3] * qs);
                        if (type == 2 && obase >= 0) { const int dcol = 16 * n + 4 * fq; *(f32x4*)(out + obase + dcol) = o0; *(f32x4*)(out + obase + 32 + dcol) = o1; }
                    }
                    { const int row0 = row - fr; stage_store_rows(stg + (wr * 4 + wc) * EPI_WAVE, fq * 16 + fr, fr, fq, wst, ACT + (size_t)row0 * NIN + ((type == 1) ? LQ : LK) + 64 * slot, NIN, MTOT - row0); }
                }
        } else if (type == 3) {
            const int br = slot >> 1, kvh = slot & 1;
#pragma unroll
            for (int ai = 0; ai < 2; ++ai)
#pragma unroll
                for (int m = 0; m < 4; ++m) {
                    const int row = rbase + ai * 128 + m * 16;
                    if (row < MTOT) {
                        long obase = -1;
                        if (row < MP) {
                            const int t = row & (SEQ - 1), b = row >> 11;
                            if (br == 0) obase = (long)O_PVC + (long)row * 128 + kvh * 64;
                            else if (br == 1) obase = (long)O_PVS + (long)row * 128 + kvh * 64;
                            else if (t >= 1536) obase = (long)O_PVW + ((long)(b * 512 + t - 1536) * 2 + kvh) * 64;
                            bf16_t* vt = VT + ((size_t)(b * 6 + slot) * 64) * SEQ + t;
#pragma unroll
                            for (int bj = 0; bj < 2; ++bj)
#pragma unroll
                                for (int n = 0; n < 2; ++n)
#pragma unroll
                                    for (int j = 0; j < 4; ++j) vt[(size_t)(32 * bj + 16 * n + 4 * fq + j) * SEQ] = (bf16_t)f2bf(acc[ai][bj][m][n][j]);
                        } else {
                            const int sb = row - MP;
                            if (br == 0) obase = (long)O_SVC + sb * 128 + kvh * 64;
                            else if (br == 1) obase = (long)O_SVS + sb * 128 + kvh * 64;
                            else obase = (long)O_SVW + ((long)(sb * 512 + 511) * 2 + kvh) * 64;
                        }
                        if (obase >= 0) {
#pragma unroll
                            for (int bj = 0; bj < 2; ++bj)
#pragma unroll
                                for (int n = 0; n < 2; ++n) *(f32x4*)(out + obase + 32 * bj + 16 * n + 4 * fq) = acc[ai][bj][m][n];
                        }
                    }
                }
        } else if (pn >= 13 && pn <= 20) {
            bf16_t* gp = GB + ((size_t)((u.pm * 8 + (pn - 13)) * 8 + wr * 4 + wc) * 32) * 256 + (size_t)(fq * 16 + fr) * 4;
#pragma unroll
            for (int ai = 0; ai < 2; ++ai)
#pragma unroll
                for (int m = 0; m < 4; ++m)
#pragma unroll
                    for (int bj = 0; bj < 2; ++bj)
#pragma unroll
                        for (int n = 0; n < 2; ++n) {
                            const f32x4 v = acc[ai][bj][m][n];
                            u32x2 w; w.x = cvt_pk_bf16(sigmoidf_(v[0]), sigmoidf_(v[1])); w.y = cvt_pk_bf16(sigmoidf_(v[2]), sigmoidf_(v[3]));
                            *(u32x2*)(gp + (size_t)(((ai * 4 + m) * 2 + bj) * 2 + n) * 256) = w;
                        }
        } else {
            const int mode = (pn <= 6) ? 1 : (pn <= 10) ? 0 : (pn <= 12) ? 1 : 2;
            LAS unsigned char* sw = stg + (wr * 4 + wc) * EPI_WAVE; const int lane = fq * 16 + fr;
#pragma unroll
            for (int ai = 0; ai < 2; ++ai)
#pragma unroll
                for (int m = 0; m < 4; ++m) {
                    const int row0 = u.pm * 256 + wr * 64 + ai * 128 + m * 16;
                    u32x2 w[2][2];
#pragma unroll
                    for (int bj = 0; bj < 2; ++bj)
#pragma unroll
                        for (int n = 0; n < 2; ++n) {
                            f32x4 v = acc[ai][bj][m][n];
#pragma unroll
                            for (int j = 0; j < 4; ++j) { const float sg = sigmoidf_(v[j]); v[j] = (mode == 0) ? v[j] : (mode == 1) ? v[j] * sg : sg; }
                            w[bj][n].x = cvt_pk_bf16(v[0], v[1]); w[bj][n].y = cvt_pk_bf16(v[2], v[3]);
                        }
                    stage_store_rows(sw, lane, fr, fq, w, ACT + (size_t)row0 * NIN + 256 * pn + 64 * wc, NIN, MTOT - row0);
                }
        }
    }
};

struct EpiMix {
    const bf16_t* GB; bf16_t* M;
    __device__ __forceinline__ void operator()(f32x4 (&acc)[2][2][4][2], const pg8::Unit& u, int wr, int wc, int fr, int fq) const {
        const int rbase = u.pm * 256 + wr * 64 + fr, cbase = u.pn * 256 + 64 * wc + 4 * fq;
        const bf16_t* ga = GB + ((size_t)((u.pm * 8 + u.pn) * 8 + wr * 4 + wc) * 32) * 256 + (size_t)(fq * 16 + fr) * 4;
        const bf16_t* gb = ga + (size_t)4 * 8 * 32 * 256;
#pragma unroll
        for (int ai = 0; ai < 2; ++ai) {
            u32x2 gsb[16], gsa[16];
#pragma unroll
            for (int f = 0; f < 16; ++f) { gsb[f] = *(const u32x2*)(gb + (ai * 16 + f) * 256); if (u.keep) gsa[f] = *(const u32x2*)(ga + (ai * 16 + f) * 256); }
#pragma unroll
            for (int m = 0; m < 4; ++m) {
                const int row = rbase + ai * 128 + m * 16;
#pragma unroll
                for (int bj = 0; bj < 2; ++bj)
#pragma unroll
                    for (int n = 0; n < 2; ++n) {
                        const int f = (m * 2 + bj) * 2 + n;
                        float sb[4]; unpack4(gsb[f], sb);
                        if (u.keep) {
                            float sa[4]; unpack4(gsa[f], sa);
#pragma unroll
                            for (int j = 0; j < 4; ++j) acc[ai][bj][m][n][j] *= sa[j] * __builtin_amdgcn_rcpf(sb[j]);
                        } else if (row < MP) {
                            const f32x4 v = acc[ai][bj][m][n];
                            u32x2 w; w.x = cvt_pk_bf16(v[0] * sb[0], v[1] * sb[1]); w.y = cvt_pk_bf16(v[2] * sb[2], v[3] * sb[3]);
                            *(u32x2*)(M + (size_t)row * DM + cbase + 32 * bj + 16 * n) = w;
                        }
                    }
            }
        }
    }
};

struct EpiOut {
    const float* xp; const float* xs; const float* MOD; float* out;
    __device__ __forceinline__ void operator()(f32x4 (&acc)[2][2][4][2], const pg8::Unit& u, int wr, int wc, int fr, int fq) const {
        const int rbase = u.pm * 256 + wr * 64 + fr, cbase = u.pn * 256 + wc * 32 + 4 * fq;
        const float* gr = MOD + (size_t)(rbase >> 11) * 3072 + 2048;
        f32x4 gv[2][2];
#pragma unroll
        for (int bj = 0; bj < 2; ++bj)
#pragma unroll
            for (int n = 0; n < 2; ++n) gv[bj][n] = *(const f32x4*)(gr + cbase + 128 * bj + 16 * n);
#pragma unroll
        for (int ai = 0; ai < 2; ++ai) {
            f32x4 xv[4][2][2];
#pragma unroll
            for (int m = 0; m < 4; ++m)
#pragma unroll
                for (int bj = 0; bj < 2; ++bj)
#pragma unroll
                    for (int n = 0; n < 2; ++n) xv[m][bj][n] = __builtin_nontemporal_load((const f32x4*)(xp + (size_t)(rbase + ai * 128 + m * 16) * DM + cbase + 128 * bj + 16 * n));
#pragma unroll
            for (int m = 0; m < 4; ++m)
#pragma unroll
                for (int bj = 0; bj < 2; ++bj)
#pragma unroll
                    for (int n = 0; n < 2; ++n)
                        __builtin_nontemporal_store(xv[m][bj][n] + gv[bj][n] * acc[ai][bj][m][n], (f32x4*)(out + O_YP + (size_t)(rbase + ai * 128 + m * 16) * DM + cbase + 128 * bj + 16 * n));
        }
    }
};

__device__ __forceinline__ void transpose_item(const float* src, int src_ld, int nvalid, bf16_t* dst, int dst_ld, LAS float* scr, int lane) {
    float tv[64];
    const int cc = lane & 31, ccl = cc < nvalid ? cc : 0;
#pragma unroll
    for (int i = 0; i < 64; ++i) tv[i] = src[(size_t)(2 * i + (lane >> 5)) * src_ld + ccl];
#pragma unroll
    for (int hf = 0; hf < 2; ++hf) {
#pragma unroll
        for (int i = 0; i < 32; ++i) scr[(2 * i + (lane >> 5)) * 33 + cc] = (cc < nvalid) ? tv[32 * hf + i] : 0.f;
        asm volatile("s_waitcnt lgkmcnt(0)" ::: "memory");
        const int c = lane & 7;
#pragma unroll
        for (int j = 0; j < 4; ++j) { const int n = (lane >> 3) + 8 * j; const LAS float* sp = scr + (8 * c) * 33 + n;
            u32x4 o; o.x = pk2(sp[0 * 33], sp[1 * 33]); o.y = pk2(sp[2 * 33], sp[3 * 33]); o.z = pk2(sp[4 * 33], sp[5 * 33]); o.w = pk2(sp[6 * 33], sp[7 * 33]);
            *(u32x4*)(dst + (size_t)n * dst_ld + 64 * hf + 8 * c) = o; }
        asm volatile("s_waitcnt lgkmcnt(0)" ::: "memory");
    }
}

__device__ __forceinline__ void p0_prologue(const Params& P, LAS unsigned char* lds, int gw, int NGW, int lane_p, int wave, int gtid, int NT) {
    unsigned char* ws = P.ws;
    LAS float* scr = (LAS float*)(lds + wave * 16384);
    constexpr int I_MOD = 9 * 48, I_WIN = 8 * 176, I_WBR = 8 * 32, I_WOUT = 8 * 32, I_POOL = NSB * 16 * 2;
    constexpr int I_TOTAL = I_MOD + I_WIN + I_WBR + I_WOUT + I_POOL;
    constexpr int I_TR = I_WIN + I_WBR + I_WOUT;
    const bool modw = gw < I_MOD; const int NO = NGW - I_MOD, io = gw - I_MOD;
    static_assert(I_TR == 1920 && I_POOL == 4096 && I_MOD == 432, "the deal below is written for these counts and a 2048-wave grid");
    for (int stp = 0;; ++stp) {
        int it;
        if (NGW != 2048) { it = gw + stp * NGW; if (it >= I_TOTAL) break; }
        else if (modw) { if (stp == 0) it = gw; else if (stp == 1) it = I_MOD + I_TR + gw; else break; }
        else {
            const int j = io - 432;
            const int nT = (j < 0) ? 0 : (j < 736 ? 2 : 1);
            if (stp < nT) it = I_MOD + (stp == 0 ? j : 1184 + j);
            else { const int q = stp - nT; if (q == 0) it = I_MOD + I_TR + 432 + io; else if (q == 1) it = I_MOD + I_TR + 432 + 1616 + io; else if (q == 2 && io < 432) it = I_MOD + I_TR + 3664 + io; else break; }
        }
        int lane = lane_p; asm volatile("" : "+v"(lane));
        if (it < I_MOD) {
            const int mt = it / 48, ng = it % 48, lr = lane & 15, kq = lane >> 4;
            int arow_i = 16 * mt + lr; if (arow_i > 135) arow_i = 135;
            const float* arow = ((arow_i < 8) ? P.in[9] + (size_t)arow_i * DM : P.in[10] + (size_t)(arow_i - 8) * DM) + 4 * kq;
            const float* bp = P.in[11] + (size_t)(4 * kq) * 3072 + 64 * ng + 4 * lr;
            f32x4 macc[4];
#pragma unroll
            for (int nt = 0; nt < 4; ++nt) macc[nt] = (f32x4){0.f, 0.f, 0.f, 0.f};
            f32x4 a0[4], b0[16], a1[4], b1[16];
#define MOD_LOAD(A_, B_, k0) do { _Pragma("unroll") for (int j = 0; j < 4; ++j) { A_[j] = *(const f32x4*)(arow + (k0) + 16 * j); \
                _Pragma("unroll") for (int e = 0; e < 4; ++e) B_[4 * j + e] = *(const f32x4*)(bp + (size_t)((k0) + 16 * j + e) * 3072); } } while (0)
#define MOD_MMA(A_, B_) do { _Pragma("unroll") for (int j = 0; j < 4; ++j) _Pragma("unroll") for (int e = 0; e < 4; ++e) _Pragma("unroll") for (int nt = 0; nt < 4; ++nt) \
                macc[nt] = __builtin_amdgcn_mfma_f32_16x16x4f32(A_[j][e], B_[4 * j + e][nt], macc[nt], 0, 0, 0); } while (0)
            MOD_LOAD(a0, b0, 0);
            for (int k0 = 0; k0 < DM; k0 += 128) {
                MOD_LOAD(a1, b1, k0 + 64);
                __builtin_amdgcn_sched_barrier(0);
                MOD_MMA(a0, b0);
                __builtin_amdgcn_sched_barrier(0);
                if (k0 + 128 < DM) MOD_LOAD(a0, b0, k0 + 128);
                __builtin_amdgcn_sched_barrier(0);
                MOD_MMA(a1, b1);
                __builtin_amdgcn_sched_barrier(0);
            }
#undef MOD_LOAD
#undef MOD_MMA
            float* MOD = (float*)(ws + WS_MOD);
            const f32x4 bb = *(const f32x4*)(P.in[12] + 64 * ng + 4 * lr);
#pragma unroll
            for (int r = 0; r < 4; ++r) { const int row = 16 * mt + 4 * kq + r;
                if (row < 136) *(f32x4*)(MOD + (size_t)row * 3072 + 64 * ng + 4 * lr) = (f32x4){macc[0][r] + bb[0], macc[1][r] + bb[1], macc[2][r] + bb[2], macc[3][r] + bb[3]}; }
            continue;
        }
        it -= I_MOD;
        if (it < I_WIN) {
            const int kb = it / 176, nb = it % 176;
            const int pn = nb >> 3, bj = (nb >> 2) & 1, wc = nb & 3;
            const int L0 = 256 * pn + 64 * wc + 32 * bj;
            int srcc, nvalid;
            if (L0 < 1280) { srcc = L0; nvalid = 32; } else if (L0 < LNSA) { srcc = L0 + 24; nvalid = 32; } else if (L0 == LNSA) { srcc = 1280; nvalid = 24; } else { srcc = 0; nvalid = 0; }
            transpose_item(P.in[14] + (size_t)(128 * kb) * 5400 + srcc, 5400, nvalid, (bf16_t*)(ws + WS_WTIN) + (size_t)(32 * nb) * DM + 128 * kb, DM, scr, lane);
            continue;
        }
        it -= I_WIN;
        if (it < I_WBR) {
            const int kb = it / 32, nb = it % 32;
            const float* src = (kb < 4) ? P.in[25] + (size_t)(128 * kb) * DM : P.in[26] + (size_t)(128 * (kb - 4)) * DM;
            const int L0 = 256 * (nb >> 3) + 64 * (nb & 3) + 32 * ((nb >> 2) & 1);
            transpose_item(src + L0, DM, 32, (bf16_t*)(ws + WS_WTBR) + (size_t)(32 * nb) * DM + 128 * kb, DM, scr, lane);
            continue;
        }
        it -= I_WBR;
        if (it < I_WOUT) {
            const int kb = it / 32, nb = it % 32;
            transpose_item(P.in[27] + (size_t)(128 * kb) * DM + 32 * nb, DM, 32, (bf16_t*)(ws + WS_WTOUT) + (size_t)(32 * nb) * DM + 128 * kb, DM, scr, lane);
            continue;
        }
        it -= I_WOUT;
        {
            const int sb = it >> 5, pg = (it >> 1) & 15, which = it & 1;
            const int page = ((const int*)P.in[8])[sb * 16 + pg];
            const float* src = P.in[2 + which] + (size_t)page * 128 * 128;
            const float* pe = P.in[17 + which]; const float* w = P.in[19 + which];
            const int d0 = (2 * lane) & 63;
            float p0 = 0.f, p1 = 0.f;
#pragma unroll 8
            for (int r = 0; r < 32; ++r) { const f32x2 v = *(const f32x2*)(pe + r * 64 + d0); p0 += v[0]; p1 += v[1]; }
#pragma unroll
            for (int cb = 0; cb < 4; ++cb) {
                f32x2 v[32];
#pragma unroll
                for (int r = 0; r < 32; ++r) v[r] = __builtin_nontemporal_load((const f32x2*)(src + (size_t)(cb * 32 + r) * 128 + 2 * lane));
                float s0 = 0.f, s1 = 0.f;
#pragma unroll
                for (int r = 0; r < 32; ++r) { s0 += v[r][0]; s1 += v[r][1]; }
                scr[d0 * 8 + cb * 2 + (lane >> 5)] = (s0 + p0) * (1.0f / 32.0f); scr[(d0 + 1) * 8 + cb * 2 + (lane >> 5)] = (s1 + p1) * (1.0f / 32.0f);
            }
            asm volatile("s_waitcnt lgkmcnt(0)" ::: "memory");
            float a[8];
#pragma unroll
            for (int q = 0; q < 8; ++q) a[q] = 0.f;
#pragma unroll 8
            for (int d = 0; d < 64; ++d) { const float wv = w[d * 64 + lane]; const f32x4 pa = *(const LAS f32x4*)(scr + d * 8), pb = *(const LAS f32x4*)(scr + d * 8 + 4);
                a[0] += pa[0] * wv; a[1] += pa[1] * wv; a[2] += pa[2] * wv; a[3] += pa[3] * wv; a[4] += pb[0] * wv; a[5] += pb[1] * wv; a[6] += pb[2] * wv; a[7] += pb[3] * wv; }
            float* dst = (float*)(ws + (which ? WS_VCS : WS_KCS));
#pragma unroll
            for (int q = 0; q < 8; ++q) dst[((size_t)(sb * 2 + (q & 1)) * 64 + 4 * pg + (q >> 1)) * 64 + lane] = a[q];
            asm volatile("s_waitcnt lgkmcnt(0)" ::: "memory");
        }
    }
    float* rope = (float*)(ws + WS_ROPE);
    for (int i = gtid; i < 2049 * 32; i += NT) {
        const int pos = i >> 5, k = i & 31;
        double invd = 1.0;
        for (int q = 0; q < k; ++q) invd *= 0.7498942093324559;
        const float ang = (float)pos * (float)invd;
        const double rev = (double)ang * 0.15915494309189535;
        const float fr = (float)(rev - __builtin_rint(rev));
        rope[2 * i] = __builtin_amdgcn_cosf(fr); rope[2 * i + 1] = __builtin_amdgcn_sinf(fr);
    }
    bf16_t* tril = (bf16_t*)(ws + WS_TRIL);
    for (int i = gtid; i < 4 * 128 * 128; i += NT) { const int r = (i >> 7) & 127, cidx = i & 127; tril[i] = (cidx <= r) ? (bf16_t)f2bf(P.in[23][i]) : (bf16_t)0; }
    for (int tk = blockIdx.x; tk < 2 * NSB * 2; tk += gridDim.x) {
        const int w2 = tk >> 8, sb = (tk >> 1) & 127, half = tk & 1;
        const f32x4* src = (const f32x4*)P.in[6 + w2] + (size_t)sb * 512 * 32 + 32 + half * 8176; f32x4* dst = (f32x4*)(P.out + (w2 ? O_SVW : O_SKW)) + (size_t)sb * 512 * 32 + half * 8176;
        f32x4 cv[16];
#pragma unroll
        for (int u = 0; u < 16; ++u) { const int i = threadIdx.x + 512 * u; if (i < 8176) cv[u] = __builtin_nontemporal_load(src + i); }
#pragma unroll
        for (int u = 0; u < 16; ++u) { const int i = threadIdx.x + 512 * u; if (i < 8176) __builtin_nontemporal_store(cv[u], dst + i); }
    }
}

__device__ __forceinline__ void p1_hrows(const Params& P, int gw, int NGW, int lane) {
    const float* MOD = (const float*)(P.ws + WS_MOD); bf16_t* H = (bf16_t*)(P.ws + WS_H); const float* ng = P.in[13];
    for (int row0 = gw; row0 < MPAD; row0 += 4 * NGW) {
        f32x4 v[4][4];
#pragma unroll
        for (int q = 0; q < 4; ++q) { const int row = row0 + q * NGW; const int rr = row < MTOT ? row : 0;
            const float* xr = (rr < MP) ? P.in[0] + (size_t)rr * DM : P.in[1] + (size_t)(rr - MP) * DM;
#pragma unroll
            for (int j = 0; j < 4; ++j) v[q][j] = __builtin_nontemporal_load((const f32x4*)xr + lane + 64 * j); }
#pragma unroll
        for (int q = 0; q < 4; ++q) {
            const int row = row0 + q * NGW;
            if (row >= MPAD) break;
            unsigned long long* o8 = (unsigned long long*)(H + (size_t)row * DM) + lane;
            if (row >= MTOT) {
#pragma unroll
                for (int j = 0; j < 4; ++j) o8[64 * j] = 0ull;
                continue; }
            const float* md = (row < MP) ? MOD + (size_t)(row >> 11) * 3072 : MOD + (size_t)(8 + row - MP) * 3072;
            float s = 0.f;
#pragma unroll
            for (int j = 0; j < 4; ++j) s += (v[q][j][0] * v[q][j][0] + v[q][j][1] * v[q][j][1]) + (v[q][j][2] * v[q][j][2] + v[q][j][3] * v[q][j][3]);
            const float rstd = rsqrtf(wave_sum(s) * (1.0f / DM) + 1e-6f);
#pragma unroll
            for (int j = 0; j < 4; ++j) {
                const int col = 4 * lane + 256 * j;
                const f32x4 g = *(const f32x4*)(ng + col), sh = *(const f32x4*)(md + col), sc = *(const f32x4*)(md + 1024 + col);
                const f32x4 h = (v[q][j] * rstd) * g * (sc + 1.0f) + sh;
                o8[64 * j] = (unsigned long long)pk2(h[0], h[1]) | ((unsigned long long)pk2(h[2], h[3]) << 32);
            }
        }
    }
}

__device__ __forceinline__ void p3_compress(const Params& P, LAS unsigned char* lds, int gw, int NGW, int lane, int wave) {
    LAS float* scr = (LAS float*)(lds + wave * 1024);
    for (int it = gw; it < NBATCH * 64 * 2 * 2; it += NGW) {
        const int b = it >> 8, c = (it >> 2) & 63, kvh = (it >> 1) & 1, which = it & 1;
        const float* src = P.out + (which ? O_PVC : O_PKC) + ((size_t)(b * SEQ + 32 * c) * 2 + kvh) * 64;
        const float* pe = P.in[17 + which]; const float* w = P.in[19 + which];
        float s = 0.f;
#pragma unroll
        for (int r = 0; r < 32; ++r) s += src[(size_t)r * 128 + lane] + pe[r * 64 + lane];
        scr[lane] = s * (1.0f / 32.0f);
        asm volatile("s_waitcnt lgkmcnt(0)" ::: "memory");
        float a = 0.f;
#pragma unroll 8
        for (int d = 0; d < 64; ++d) a += scr[d] * w[d * 64 + lane];
        if (which == 0) ((bf16_t*)(P.ws + WS_KC))[((size_t)(b * 64 + c) * 2 + kvh) * 64 + lane] = (bf16_t)f2bf(a);
        else ((bf16_t*)(P.ws + WS_VCT))[((size_t)(b * 2 + kvh) * 64 + lane) * 64 + c] = (bf16_t)f2bf(a);
        asm volatile("s_waitcnt lgkmcnt(0)" ::: "memory");
    }
}

constexpr int A_TILE = 32768, A_IMP = 3 * A_TILE, A_IMPS = A_IMP + 8 * 32 * 33 * 4, A_SEL = A_IMPS + 2 * 32 * 33 * 4;
static_assert(A_SEL + 256 <= LDS_XB, "attention LDS map");
#define ATT_BAR() do { asm volatile("s_waitcnt lgkmcnt(0)" ::: "memory"); __builtin_amdgcn_s_barrier(); asm volatile("" ::: "memory"); } while (0)

struct TileSrc { const bf16_t* kb; const bf16_t* v0; const bf16_t* v1; unsigned kpitch, vpitch; };
__device__ __forceinline__ TileSrc attn_tile_src(const Params& P, int b, int T, int n_slc, int lo) {
    TileSrc s;
    if (T == 0) { s.kb = (const bf16_t*)(P.ws + WS_KC) + (size_t)b * 64 * 128; s.v0 = (const bf16_t*)(P.ws + WS_VCT) + (size_t)(b * 2) * 4096; s.v1 = s.v0 + 4096; s.kpitch = 128; s.vpitch = 64; }
    else {
        const bool slc = T <= n_slc; const int j = slc ? T - 1 : lo + (T - 1 - n_slc), br = slc ? 1 : 2;
        s.kb = (const bf16_t*)(P.ws + WS_ACT) + ((size_t)b * SEQ + 64 * j) * NIN + LK + 128 * br;
        s.v0 = (const bf16_t*)(P.ws + WS_VT) + ((size_t)(b * 6 + 2 * br) * 64) * SEQ + 64 * j; s.v1 = s.v0 + (size_t)64 * SEQ; s.kpitch = NIN; s.vpitch = SEQ;
    }
    return s;
}
__device__ __forceinline__ void attn_dma(LAS unsigned char* buf, const TileSrc& s, int wave, int lane_in) {
    int lane = lane_in; asm volatile("" : "+v"(lane));
    const int r = 8 * wave + (lane >> 3), ch = (lane & 7) ^ (lane >> 3);
#pragma unroll
    for (int i = 0; i < 2; ++i) {
        __builtin_amdgcn_global_load_lds((const unsigned*)(s.kb + (size_t)r * s.kpitch + i * 64 + ch * 8), (LAS unsigned*)(buf + (wave + 8 * i) * 1024), 16, 0, 0);
        __builtin_amdgcn_global_load_lds((const unsigned*)((i ? s.v1 : s.v0) + (size_t)r * s.vpitch + ch * 8), (LAS unsigned*)(buf + 16384 + (wave + 8 * i) * 1024), 16, 0, 0);
    }
}

constexpr float ATT_M0 = -30.f, ATT_THR = 12.f;
template <int MODE>
__device__ __forceinline__ void attn_tile(const LAS unsigned char* Kg, const LAS unsigned char* Vg, const bf16x8 (&qf)[2][2], f32x4 (&O)[4][2], float (&mrun)[2], float (&lrun)[2], f32x4 (&s)[2][4],
                                          int lane_in, int kbase, const int (&qpos)[2], const float (&cinit)[2], bool emask) {
    int lane = lane_in; asm volatile("" : "+v"(lane));
    const int lr = lane & 15, grp = lane >> 4, sw = lr & 7;
    const float c0[2] = {cinit[0] - mrun[0], cinit[1] - mrun[1]};
#pragma unroll
    for (int kt = 0; kt < 4; ++kt) {
        const bf16x8 k0 = *(const LAS bf16x8*)(Kg + (16 * kt + lr) * 128 + ((grp ^ sw) << 4));
        const bf16x8 k1 = *(const LAS bf16x8*)(Kg + (16 * kt + lr) * 128 + (((4 + grp) ^ sw) << 4));
#pragma unroll
        for (int qt = 0; qt < 2; ++qt) {
            const f32x4 a = __builtin_amdgcn_mfma_f32_16x16x32_bf16(k0, qf[qt][0], (f32x4){c0[qt], c0[qt], c0[qt], c0[qt]}, 0, 0, 0);
            s[qt][kt] = __builtin_amdgcn_mfma_f32_16x16x32_bf16(k1, qf[qt][1], a, 0, 0, 0);
        }
    }
    bf16x8 vf[2][4];
#pragma unroll
    for (int c2 = 0; c2 < 2; ++c2)
#pragma unroll
        for (int dt = 0; dt < 4; ++dt) {
            const LAS unsigned char* vr = Vg + (16 * dt + lr) * 128 + 8 * (grp & 1);
            const u32x2 lo = *(const LAS u32x2*)(vr + (((4 * c2 + (grp >> 1)) ^ sw) << 4));
            const u32x2 hi = *(const LAS u32x2*)(vr + (((4 * c2 + 2 + (grp >> 1)) ^ sw) << 4));
            const u32x4 vv = {lo.x, lo.y, hi.x, hi.y};
            vf[c2][dt] = __builtin_bit_cast(bf16x8, vv);
        }
    if (emask) {
#pragma unroll
        for (int qt = 0; qt < 2; ++qt)
#pragma unroll
            for (int kt = 0; kt < 4; ++kt)
#pragma unroll
                for (int r = 0; r < 4; ++r) {
                    const int key = 16 * kt + 4 * grp + r;
                    bool valid;
                    if (MODE == 0) valid = key < ((qpos[qt] + 1) >> 5);
                    else if (MODE == 1) valid = (kbase + key <= qpos[qt]);
                    else { const int kp = kbase + key; valid = (kp <= qpos[qt]) && (kp > qpos[qt] - 512); }
                    s[qt][kt][r] = valid ? s[qt][kt][r] : NEGBIG;
                }
    }
    float mx[2];
#pragma unroll
    for (int qt = 0; qt < 2; ++qt) {
#define FMX(a, b) __builtin_amdgcn_fmed3f((a), (b), __builtin_inff())
        float m0 = FMX(FMX(s[qt][0][0], s[qt][0][1]), FMX(s[qt][0][2], s[qt][0][3]));
#pragma unroll
        for (int kt = 1; kt < 4; ++kt) m0 = FMX(m0, FMX(FMX(s[qt][kt][0], s[qt][kt][1]), FMX(s[qt][kt][2], s[qt][kt][3])));
        m0 = FMX(m0, __shfl_xor(m0, 16)); mx[qt] = FMX(m0, __shfl_xor(m0, 32));
#undef FMX
    }
    if (__any((int)(fmaxf(mx[0], mx[1]) > ATT_THR))) {
#pragma unroll
        for (int qt = 0; qt < 2; ++qt) {
            const float delta = fmaxf(mx[qt], 0.f), f = __builtin_amdgcn_exp2f(-delta);
            mrun[qt] += delta; lrun[qt] *= f;
#pragma unroll
            for (int dt = 0; dt < 4; ++dt) O[dt][qt] *= f;
#pragma unroll
            for (int kt = 0; kt < 4; ++kt) s[qt][kt] -= delta;
        }
    }
#pragma unroll
    for (int qt = 0; qt < 2; ++qt) {
        float ls = 0.f;
#pragma unroll
        for (int kt = 0; kt < 4; ++kt)
#pragma unroll
            for (int r = 0; r < 4; ++r) { const float p = __builtin_amdgcn_exp2f(s[qt][kt][r]); s[qt][kt][r] = p; ls += p; }
        lrun[qt] += ls;
#pragma unroll
        for (int c2 = 0; c2 < 2; ++c2) {
            u32x4 w; w.x = cvt_pk_bf16(s[qt][2 * c2][0], s[qt][2 * c2][1]); w.y = cvt_pk_bf16(s[qt][2 * c2][2], s[qt][2 * c2][3]);
            w.z = cvt_pk_bf16(s[qt][2 * c2 + 1][0], s[qt][2 * c2 + 1][1]); w.w = cvt_pk_bf16(s[qt][2 * c2 + 1][2], s[qt][2 * c2 + 1][3]);
            const bf16x8 pf = __builtin_bit_cast(bf16x8, w);
#pragma unroll
            for (int dt = 0; dt < 4; ++dt) O[dt][qt] = __builtin_amdgcn_mfma_f32_16x16x32_bf16(vf[c2][dt], pf, O[dt][qt], 0, 0, 0);
        }
    }
}

__device__ __forceinline__ void attn_unit(const Params& P, LAS unsigned char* lds, int b, int qb32, int tid, int lane, int wave) {
    asm volatile("" : "+v"(tid), "+v"(lane));
    const bf16_t* ACT = (const bf16_t*)(P.ws + WS_ACT); bf16_t* AB = (bf16_t*)(P.ws + WS_AB);
    const int lr = lane & 15, grp = lane >> 4, g = wave >> 2;
    const int t0 = 32 * qb32, qblk = t0 >> 6; const size_t row0 = (size_t)b * SEQ + t0;
    const int n_slc = qblk + 1, lo = (t0 - 511 > 0) ? ((t0 - 511) >> 6) : 0, NT = 1 + n_slc + (qblk - lo + 1);
    LAS float* IMP = (LAS float*)(lds + A_IMP); LAS float* IMPS = (LAS float*)(lds + A_IMPS); LAS unsigned* SEL = (LAS unsigned*)(lds + A_SEL);
    bf16x8 qf[2][2]; int qpos[2]; float gate[2][3];
#pragma unroll
    for (int qt = 0; qt < 2; ++qt) {
        const size_t row = row0 + 16 * qt + lr; qpos[qt] = t0 + 16 * qt + lr;
#pragma unroll
        for (int ks = 0; ks < 2; ++ks) qf[qt][ks] = *(const bf16x8*)(ACT + row * NIN + LQ + 64 * wave + 32 * ks + 8 * grp);
#pragma unroll
        for (int br = 0; br < 3; ++br) gate[qt][br] = bf2f(ACT[row * NIN + LNSA + 3 * wave + br]);
    }
    f32x4 O[4][2], OA[4][2], s[2][4]; float mrun[2], lrun[2]; unsigned selm[2] = {0u, 0u};
#pragma unroll
    for (int dt = 0; dt < 4; ++dt)
#pragma unroll
        for (int qt = 0; qt < 2; ++qt) { O[dt][qt] = (f32x4){0.f, 0.f, 0.f, 0.f}; OA[dt][qt] = (f32x4){0.f, 0.f, 0.f, 0.f}; }
    mrun[0] = mrun[1] = ATT_M0; lrun[0] = lrun[1] = 0.f;
#define ATT_FINISH(br) do { _Pragma("unroll") for (int qt = 0; qt < 2; ++qt) { float lt = lrun[qt]; lt += __shfl_xor(lt, 16); lt += __shfl_xor(lt, 32); \
        const float f = (lt > 0.f) ? gate[qt][br] / lt : 0.f; _Pragma("unroll") for (int dt = 0; dt < 4; ++dt) { OA[dt][qt] += O[dt][qt] * f; O[dt][qt] = (f32x4){0.f, 0.f, 0.f, 0.f}; } \
        mrun[qt] = ATT_M0; lrun[qt] = 0.f; } } while (0)
    const float czero[2] = {0.f, 0.f};
    ATT_BAR();
    { const TileSrc s0 = attn_tile_src(P, b, 0, n_slc, lo); attn_dma(lds, s0, wave, lane); }
    { const TileSrc s1 = attn_tile_src(P, b, 1, n_slc, lo); attn_dma(lds + A_TILE, s1, wave, lane); }
    asm volatile("s_waitcnt vmcnt(4)" ::: "memory");
    ATT_BAR();
    { const TileSrc s2 = attn_tile_src(P, b, 2, n_slc, lo); attn_dma(lds + 2 * A_TILE, s2, wave, lane); }
    {
        attn_tile<0>(lds + g * 8192, lds + 16384 + g * 8192, qf, O, mrun, lrun, s, lane, 0, qpos, czero, true);
#pragma unroll
        for (int qt = 0; qt < 2; ++qt) {
            float lt = lrun[qt]; lt += __shfl_xor(lt, 16); lt += __shfl_xor(lt, 32);
            const float inv = (lt > 0.f) ? 1.0f / lt : 0.f;
#pragma unroll
            for (int kt = 0; kt < 4; ++kt)
#pragma unroll
                for (int rr = 0; rr < 2; ++rr) IMP[(wave * 32 + 16 * qt + lr) * 33 + 8 * kt + 2 * grp + rr] = (s[qt][kt][2 * rr] + s[qt][kt][2 * rr + 1]) * inv;
        }
        ATT_FINISH(0);
        ATT_BAR();
        for (int i = tid; i < 2 * 32 * 32; i += 512) { const int gg = i >> 10, q = (i >> 5) & 31, j = i & 31;
            IMPS[(gg * 32 + q) * 33 + j] = (IMP[((4 * gg + 0) * 32 + q) * 33 + j] + IMP[((4 * gg + 1) * 32 + q) * 33 + j]) + (IMP[((4 * gg + 2) * 32 + q) * 33 + j] + IMP[((4 * gg + 3) * 32 + q) * 33 + j]); }
        ATT_BAR();
        if (tid < 64) {
            const int gg = tid >> 5, q = tid & 31;
            unsigned mask = 1u | (1u << qblk);
            if (qblk - 1 <= 6) mask = (qblk >= 31) ? 0xffffffffu : ((2u << qblk) - 1u);
            else {
                const LAS float* v = IMPS + (gg * 32 + q) * 33;
                for (int pick = 0; pick < 6; ++pick) { float best = -1.f; int bi = 1;
                    for (int j = 1; j < qblk; ++j) { const float x = v[j]; if (!((mask >> j) & 1u) && x > best) { best = x; bi = j; } }
                    mask |= 1u << bi; }
            }
            SEL[gg * 32 + q] = mask;
        }
        asm volatile("s_waitcnt vmcnt(4)" ::: "memory");
        ATT_BAR();
        selm[0] = SEL[g * 32 + lr]; selm[1] = SEL[g * 32 + 16 + lr];
    }
    int cur = 1, nxt = 0;
    for (int T = 1; T < NT; ++T) {
        const bool more = T + 2 < NT;
        if (more) { const TileSrc sn = attn_tile_src(P, b, T + 2, n_slc, lo); attn_dma(lds + nxt * A_TILE, sn, wave, lane); }
        const LAS unsigned char* Kg = lds + cur * A_TILE + g * 8192; const LAS unsigned char* Vg = Kg + 16384;
        if (T <= n_slc) {
            const int jb = T - 1;
            const float cin[2] = {((selm[0] >> jb) & 1u) ? 0.f : NEGBIG, ((selm[1] >> jb) & 1u) ? 0.f : NEGBIG};
            attn_tile<1>(Kg, Vg, qf, O, mrun, lrun, s, lane, 64 * jb, qpos, cin, jb == qblk);
            if (T == n_slc) ATT_FINISH(1);
        } else {
            const int jt = lo + (T - 1 - n_slc);
            const bool em = (64 * jt + 63 > t0) || (64 * jt <= t0 + 31 - 512);
            attn_tile<2>(Kg, Vg, qf, O, mrun, lrun, s, lane, 64 * jt, qpos, czero, em);
            if (T == NT - 1) ATT_FINISH(2);
        }
        if (more) asm volatile("s_waitcnt vmcnt(4)" ::: "memory"); else asm volatile("s_waitcnt vmcnt(0)" ::: "memory");
        ATT_BAR();
        cur = (cur == 2) ? 0 : cur + 1; nxt = (nxt == 2) ? 0 : nxt + 1;
    }
#undef ATT_FINISH
#pragma unroll
    for (int qt = 0; qt < 2; ++qt) {
        const size_t row = row0 + 16 * qt + lr;
#pragma unroll
        for (int dt = 0; dt < 4; ++dt) {
            const int col = 64 * wave + 16 * dt + 4 * grp;
            float za[4]; unpack4(*(const u32x2*)(ACT + row * NIN + LZA + col), za);
            u32x2 w; w.x = cvt_pk_bf16(OA[dt][qt][0] * za[0], OA[dt][qt][1] * za[1]); w.y = cvt_pk_bf16(OA[dt][qt][2] * za[2], OA[dt][qt][3] * za[3]);
            *(u32x2*)(AB + row * DM + col) = w;
        }
    }
}

constexpr int G_ST = 0, G_VNT = 1024, VPITCH = 136;
__device__ __forceinline__ void gmlp_unit(const Params& P, LAS unsigned char* lds, int b, int ch, int gp, int tid, int lane, int wave) {
    asm volatile("" : "+v"(tid), "+v"(lane));
    const bf16_t* ACT = (const bf16_t*)(P.ws + WS_ACT); bf16_t* AB = (bf16_t*)(P.ws + WS_AB);
    LAS f32x2* ST = (LAS f32x2*)(lds + G_ST); LAS bf16_t* Vnt = (LAS bf16_t*)(lds + G_VNT);
    const size_t R0 = (size_t)b * SEQ + 128 * ch;
    __syncthreads();
    {
        u32x4 raw[16];
#pragma unroll
        for (int i = 0; i < 16; ++i) raw[i] = *(const u32x4*)(ACT + (R0 + wave + 8 * i) * NIN + LVB + 8 * lane);
#pragma unroll
        for (int i = 0; i < 16; ++i) {
            float f[8]; f[0] = bf2f(raw[i].x); f[1] = bf2f(raw[i].x >> 16); f[2] = bf2f(raw[i].y); f[3] = bf2f(raw[i].y >> 16); f[4] = bf2f(raw[i].z); f[5] = bf2f(raw[i].z >> 16); f[6] = bf2f(raw[i].w); f[7] = bf2f(raw[i].w >> 16);
            float sm = 0.f, sq = 0.f;
#pragma unroll
            for (int e = 0; e < 8; ++e) { sm += f[e]; sq += f[e] * f[e]; }
#pragma unroll
            for (int o = 1; o < 64; o <<= 1) { sm += __shfl_xor(sm, o); sq += __shfl_xor(sq, o); }
            const float mean = sm * (1.0f / 512.0f), var = fmaxf(sq * (1.0f / 512.0f) - mean * mean, 0.f);
            if (lane == 0) ST[wave + 8 * i] = (f32x2){mean, rsqrtf(var + 1e-6f)};
        }
    }
    __syncthreads();
    {
        const float* vg = P.in[21] + 256 * gp; const float* vb = P.in[22] + 256 * gp;
        u32x4 raw[4][2];
#pragma unroll
        for (int i = 0; i < 4; ++i) { const int idx = tid + 512 * i, j2 = idx & 63, chn = idx >> 6;
#pragma unroll
            for (int h2 = 0; h2 < 2; ++h2) raw[i][h2] = *(const u32x4*)(ACT + (R0 + 2 * j2 + h2) * NIN + LVB + 256 * gp + 8 * chn); }
#pragma unroll
        for (int i = 0; i < 4; ++i) {
            const int idx = tid + 512 * i, j2 = idx & 63, chn = idx >> 6;
            const f32x2 st0 = ST[2 * j2], st1 = ST[2 * j2 + 1];
            const unsigned w0[4] = {raw[i][0].x, raw[i][0].y, raw[i][0].z, raw[i][0].w}, w1[4] = {raw[i][1].x, raw[i][1].y, raw[i][1].z, raw[i][1].w};
#pragma unroll
            for (int e = 0; e < 8; ++e) { const int d = 8 * chn + e;
                const float a = bf2f(w0[e >> 1] >> (16 * (e & 1))), b2 = bf2f(w1[e >> 1] >> (16 * (e & 1)));
                *(LAS unsigned*)(Vnt + d * VPITCH + 2 * j2) = cvt_pk_bf16((a - st0[0]) * st0[1] * vg[d] + vb[d], (b2 - st1[0]) * st1[1] * vg[d] + vb[d]); }
        }
    }
    __syncthreads();
    const int lr = lane & 15, grp = lane >> 4, g = 2 * gp + (wave >> 2);
    const bf16_t* tril = (const bf16_t*)(P.ws + WS_TRIL) + (size_t)g * 128 * 128;
    f32x4 acc[2][8];
#pragma unroll
    for (int t2 = 0; t2 < 2; ++t2)
#pragma unroll
        for (int it = 0; it < 8; ++it) acc[t2][it] = (f32x4){0.f, 0.f, 0.f, 0.f};
#pragma unroll
    for (int ks = 0; ks < 4; ++ks) {
        const bf16x8 af0 = *(const LAS bf16x8*)(Vnt + (32 * wave + lr) * VPITCH + 32 * ks + 8 * grp);
        const bf16x8 af1 = *(const LAS bf16x8*)(Vnt + (32 * wave + 16 + lr) * VPITCH + 32 * ks + 8 * grp);
#pragma unroll
        for (int it = 0; it < 8; ++it) {
            if ((it >> 1) >= ks) { const bf16x8 bfr = *(const bf16x8*)(tril + (size_t)(16 * it + lr) * 128 + 32 * ks + 8 * grp);
                acc[0][it] = __builtin_amdgcn_mfma_f32_16x16x32_bf16(af0, bfr, acc[0][it], 0, 0, 0); acc[1][it] = __builtin_amdgcn_mfma_f32_16x16x32_bf16(af1, bfr, acc[1][it], 0, 0, 0); }
        }
    }
    const float* bs = P.in[24] + 128 * g;
#pragma unroll
    for (int it = 0; it < 8; ++it) {
        const int i = 16 * it + lr; const size_t row = R0 + i;
        const float bsi = bs[i];
#pragma unroll
        for (int t2 = 0; t2 < 2; ++t2) {
            const int d0 = 256 * gp + 32 * wave + 16 * t2 + 4 * grp;
            float uu[4], zb[4]; unpack4(*(const u32x2*)(ACT + row * NIN + LU + d0), uu); unpack4(*(const u32x2*)(ACT + row * NIN + LZB + d0), zb);
            u32x2 w; w.x = cvt_pk_bf16(uu[0] * (acc[t2][it][0] + bsi) * zb[0], uu[1] * (acc[t2][it][1] + bsi) * zb[1]); w.y = cvt_pk_bf16(uu[2] * (acc[t2][it][2] + bsi) * zb[2], uu[3] * (acc[t2][it][3] + bsi) * zb[3]);
            *(u32x2*)(AB + row * DM + 512 + d0) = w;
        }
    }
}

__device__ __forceinline__ void stile(const float* kb, const float* vb, int stride, int kmin, const f32x4 (&q4)[4], float (&m)[4], float (&l)[4], f32x4 (&o4)[4], float (&pout)[4], int lane_in) {
    int lane = lane_in; asm volatile("" : "+v"(lane));
    const int li = lane & 15, gq = lane >> 4;
    __builtin_amdgcn_sched_barrier(0);
    const float* kl = kb + (size_t)(gq * stride + 4 * li); const float* vl = vb + (size_t)(gq * stride + 4 * li);
    f32x4 kreg[16], vreg[16];
#pragma unroll
    for (int i = 0; i < 16; ++i) kreg[i] = __builtin_nontemporal_load((const f32x4*)(kl + (size_t)(4 * i) * stride));
#pragma unroll
    for (int i = 0; i < 16; ++i) vreg[i] = __builtin_nontemporal_load((const f32x4*)(vl + (size_t)(4 * i) * stride));
    float sc[4];
#pragma unroll
    for (int h = 0; h < 4; ++h) {
        float v[16], w8[8], w4[4], w2[2];
#pragma unroll
        for (int i = 0; i < 16; ++i) v[i] = (kreg[i][0] * q4[h][0] + kreg[i][1] * q4[h][1]) + (kreg[i][2] * q4[h][2] + kreg[i][3] * q4[h][3]);
#pragma unroll
        for (int t = 0; t < 8; ++t) { const float snd = (li & 8) ? v[t] : v[t + 8], kp = (li & 8) ? v[t + 8] : v[t]; w8[t] = kp + __shfl_xor(snd, 8); }
#pragma unroll
        for (int t = 0; t < 4; ++t) { const float snd = (li & 4) ? w8[t] : w8[t + 4], kp = (li & 4) ? w8[t + 4] : w8[t]; w4[t] = kp + __shfl_xor(snd, 4); }
#pragma unroll
        for (int t = 0; t < 2; ++t) { const float snd = (li & 2) ? w4[t] : w4[t + 2], kp = (li & 2) ? w4[t + 2] : w4[t]; w2[t] = kp + __shfl_xor(snd, 2); }
        { const float snd = (li & 1) ? w2[0] : w2[1], kp = (li & 1) ? w2[1] : w2[0]; sc[h] = kp + __shfl_xor(snd, 1); }
        __builtin_amdgcn_sched_barrier(0);
    }
    const bool valid = (4 * li + gq) >= kmin;
#pragma unroll
    for (int h = 0; h < 4; ++h) {
        const float sv = valid ? sc[h] : NEGBIG;
        const float mnew = fmaxf(m[h], wave_max(sv));
        const float alpha = __builtin_amdgcn_exp2f(m[h] - mnew), p = __builtin_amdgcn_exp2f(sv - mnew);
        l[h] = l[h] * alpha + wave_sum(p); o4[h] *= alpha; m[h] = mnew; pout[h] = p;
    }
    const int src0 = lane & 48;
#pragma unroll
    for (int i = 0; i < 16; ++i) {
#pragma unroll
        for (int h = 0; h < 4; ++h) o4[h] += vreg[i] * __shfl(pout[h], src0 + i);
    }
    __builtin_amdgcn_sched_barrier(0);
}
__device__ __forceinline__ void skey(const float* kb, const float* vb, const f32x4 (&q4)[4], float (&m)[4], float (&l)[4], f32x4 (&o4)[4], int lane) {
    const int li = lane & 15, gq = lane >> 4;
    const f32x4 kd = *(const f32x4*)(kb + 4 * li), vd = *(const f32x4*)(vb + 4 * li);
#pragma unroll
    for (int h = 0; h < 4; ++h) {
        float sv = (kd[0] * q4[h][0] + kd[1] * q4[h][1]) + (kd[2] * q4[h][2] + kd[3] * q4[h][3]);
        sv += __shfl_xor(sv, 1); sv += __shfl_xor(sv, 2); sv += __shfl_xor(sv, 4); sv += __shfl_xor(sv, 8);
        const float mnew = fmaxf(m[h], sv), alpha = __builtin_amdgcn_exp2f(m[h] - mnew), p = __builtin_amdgcn_exp2f(sv - mnew);
        l[h] = l[h] * alpha + p; o4[h] *= alpha; if (gq == 0) o4[h] += vd * p; m[h] = mnew;
    }
}

constexpr int S_ST = 0, S_MISC = 8 * 3 * 4 * 66 * 4;
__device__ __forceinline__ void sample_unit(const Params& P, LAS unsigned char* lds, int sb, int g, int tid, int lane, int wave) {
    const bf16_t* ACT = (const bf16_t*)(P.ws + WS_ACT); bf16_t* AB = (bf16_t*)(P.ws + WS_AB);
    LAS float* ST = (LAS float*)(lds + S_ST); LAS float* MISC = (LAS float*)(lds + S_MISC);
    const size_t row = (size_t)MP + sb;
    const int* ptab = (const int*)P.in[8] + sb * 16;
    const int li = lane & 15;
    __syncthreads();
    f32x4 q4[4];
#pragma unroll
    for (int h = 0; h < 4; ++h) { float t4[4]; unpack4(*(const u32x2*)(ACT + row * NIN + LQ + 64 * (4 * g + h) + 4 * li), t4); q4[h] = (f32x4){t4[0], t4[1], t4[2], t4[3]}; }
    float ms[4], ls[4]; f32x4 os[4];
#define S_RESET() do { _Pragma("unroll") for (int h = 0; h < 4; ++h) { ms[h] = MINIT; ls[h] = 0.f; os[h] = (f32x4){0.f, 0.f, 0.f, 0.f}; } } while (0)
#define S_PUBLISH(b2, doit) do { _Pragma("unroll") for (int h = 0; h < 4; ++h) { f32x4 v = os[h]; \
        _Pragma("unroll") for (int e = 0; e < 4; ++e) { float x = v[e]; x += __shfl_xor(x, 16); x += __shfl_xor(x, 32); v[e] = x; } \
        if (doit) { LAS float* st = ST + ((wave * 3 + (b2)) * 4 + h) * 66; if (lane < 16) *(LAS f32x4*)(st + 4 * lane) = v; if (lane == 0) { st[64] = ms[h]; st[65] = ls[h]; } } } } while (0)
    float pdummy[4], pc[4];
    S_RESET();
    { const size_t off = (((size_t)sb * 512 + 64 * wave) * 2 + g) * 64; stile(P.in[6] + off, P.in[7] + off, 128, (wave == 0) ? 1 : 0, q4, ms, ls, os, pdummy, lane); }
    if (wave == 0) { const size_t off = ((size_t)(sb * 512 + 511) * 2 + g) * 64; skey(P.out + O_SKW + off, P.out + O_SVW + off, q4, ms, ls, os, lane); }
    S_PUBLISH(1, true);
    S_RESET();
    stile((const float*)(P.ws + WS_KCS) + (size_t)(sb * 2 + g) * 4096, (const float*)(P.ws + WS_VCS) + (size_t)(sb * 2 + g) * 4096, 64, 0, q4, ms, ls, os, pc, lane);
    float imp = 0.f;
#pragma unroll
    for (int h = 0; h < 4; ++h) { const float pn = pc[h] / ls[h]; imp += pn + __shfl_down(pn, 16); }
    S_PUBLISH(2, wave == 0);
    const int jblk = 2 * li + (lane >> 5);
    const bool cand = ((lane >> 4) & 1) == 0 && jblk >= 1;
    unsigned key = cand ? ((__builtin_bit_cast(unsigned, imp) & 0xffffffe0u) | (unsigned)(31 - jblk)) : 0u;
    unsigned long long selpack = 0ull;
#pragma unroll
    for (int pick = 0; pick < 6; ++pick) {
        unsigned best = key;
#pragma unroll
        for (int o2 = 1; o2 < 64; o2 <<= 1) { const unsigned other = (unsigned)__shfl_xor((int)best, o2); best = other > best ? other : best; }
        const int bj = 31 - (int)(best & 31u);
        selpack |= (unsigned long long)bj << (5 * (pick + 1));
        if (cand && jblk == bj) key = 0u;
    }
    S_RESET();
    if (wave < 7) { const int blk = (int)((selpack >> (5 * wave)) & 31ull); const int page = __builtin_amdgcn_readfirstlane(ptab[blk >> 1]); const size_t off = (((size_t)page * 128 + (blk & 1) * 64) * 2 + g) * 64;
        stile(P.in[4] + off, P.in[5] + off, 128, 0, q4, ms, ls, os, pdummy, lane); }
    else skey(P.out + O_SKS + (size_t)sb * 128 + g * 64, P.out + O_SVS + (size_t)sb * 128 + g * 64, q4, ms, ls, os, lane);
    S_PUBLISH(0, true);
#undef S_RESET
#undef S_PUBLISH
    if (wave == 7) {
        const u32x4 raw = *(const u32x4*)(ACT + row * NIN + LVB + 8 * lane);
        float f[8]; f[0] = bf2f(raw.x); f[1] = bf2f(raw.x >> 16); f[2] = bf2f(raw.y); f[3] = bf2f(raw.y >> 16); f[4] = bf2f(raw.z); f[5] = bf2f(raw.z >> 16); f[6] = bf2f(raw.w); f[7] = bf2f(raw.w >> 16);
        float sm = 0.f;
#pragma unroll
        for (int i = 0; i < 8; ++i) sm += f[i];
        const float mean = wave_sum(sm) * (1.0f / 512.0f); float sq = 0.f;
#pragma unroll
        for (int i = 0; i < 8; ++i) { const float d = f[i] - mean; sq += d * d; }
        const float rstd = rsqrtf(wave_sum(sq) * (1.0f / 512.0f) + 1e-6f);
        if (lane == 0) { MISC[0] = mean; MISC[1] = rstd; }
    }
    __syncthreads();
    if (wave < 4) {
        const int h = wave, head = 4 * g + h;
        const LAS float* stc = ST + ((0 * 3 + 2) * 4 + h) * 66;
        float oa = bf2f(ACT[row * NIN + LNSA + 3 * head + 0]) * stc[lane] / stc[65];
#pragma unroll
        for (int b2 = 0; b2 < 2; ++b2) {
            float M = MINIT;
#pragma unroll
            for (int w = 0; w < 8; ++w) M = fmaxf(M, ST[((w * 3 + b2) * 4 + h) * 66 + 64]);
            float L = 0.f, O = 0.f;
#pragma unroll
            for (int w = 0; w < 8; ++w) { const LAS float* st = ST + ((w * 3 + b2) * 4 + h) * 66; const float f = __builtin_amdgcn_exp2f(st[64] - M); L += st[65] * f; O += st[lane] * f; }
            oa += bf2f(ACT[row * NIN + LNSA + 3 * head + 1 + b2]) * O / L;
        }
        const int col = 64 * head + lane;
        AB[row * DM + col] = (bf16_t)f2bf(oa * bf2f(ACT[row * NIN + LZA + col]));
    }
    if (tid < 256) {
        const int d = 256 * g + tid, gm = d >> 7;
        const float vn = (bf2f(ACT[row * NIN + LVB + d]) - MISC[0]) * MISC[1] * P.in[21][d] + P.in[22][d];
        P.out[O_SVCH + (size_t)sb * 512 + d] = vn;
        const float sv = P.in[23][(size_t)gm * 128 * 128] * vn + P.in[24][gm * 128];
        AB[row * DM + 512 + d] = (bf16_t)f2bf(bf2f(ACT[row * NIN + LU + d]) * sv * bf2f(ACT[row * NIN + LZB + d]));
    }
}

template <int MODE>
__device__ __forceinline__ void small_gemm(const Params& P, int c, int G, int wave, int lane) {
    const int lr = lane & 15, grp = lane >> 4;
    for (int t = c + G * wave; t < 512; t += G * 8) {
        const int rt = t & 7, ct = t >> 3;
        const size_t row = (size_t)MP + 16 * rt + lr;
        const bf16_t* A = (const bf16_t*)(P.ws + (MODE == 0 ? WS_AB : WS_H)) + row * DM + 8 * grp;
        const int wrow = (MODE == 0) ? (256 * (ct >> 4) + 128 * ((ct >> 1) & 1) + 32 * ((ct >> 2) & 3) + 16 * (ct & 1) + lr) : (16 * ct + lr);
        const bf16_t* W = (const bf16_t*)(P.ws + (MODE == 0 ? WS_WTBR : WS_WTOUT)) + (size_t)wrow * DM + 8 * grp;
        f32x4 acc0 = (f32x4){0.f, 0.f, 0.f, 0.f}, acc1 = (f32x4){0.f, 0.f, 0.f, 0.f};
#pragma unroll
        for (int ks = 0; ks < 16; ++ks) acc0 = __builtin_amdgcn_mfma_f32_16x16x32_bf16(*(const bf16x8*)(W + 32 * ks), *(const bf16x8*)(A + 32 * ks), acc0, 0, 0, 0);
#pragma unroll
        for (int ks = 16; ks < 32; ++ks) acc1 = __builtin_amdgcn_mfma_f32_16x16x32_bf16(*(const bf16x8*)(W + 32 * ks), *(const bf16x8*)(A + 32 * ks), acc1, 0, 0, 0);
        const int col = 16 * ct + 4 * grp;
        if (MODE == 0) {
            const int i = 16 * rt + lr, cc = col & 255;
            const size_t go = ((size_t)(((64 * 8 + (col >> 8)) * 8 + (i >> 6) * 4 + (cc >> 6)) * 32 + ((((i >> 4) & 3) * 2 + ((cc >> 5) & 1)) * 2 + ((cc >> 4) & 1))) * 64 + ((cc >> 2) & 3) * 16 + (i & 15)) * 4;
            const bf16_t* GB = (const bf16_t*)(P.ws + WS_GBUF);
            float sa[4], sb[4]; unpack4(*(const u32x2*)(GB + go), sa); unpack4(*(const u32x2*)(GB + go + (size_t)4 * 8 * 32 * 256), sb);
            u32x2 w; w.x = cvt_pk_bf16(sa[0] * acc0[0] + sb[0] * acc1[0], sa[1] * acc0[1] + sb[1] * acc1[1]); w.y = cvt_pk_bf16(sa[2] * acc0[2] + sb[2] * acc1[2], sa[3] * acc0[3] + sb[3] * acc1[3]);
            *(u32x2*)((bf16_t*)(P.ws + WS_H) + row * DM + col) = w;
        } else {
            const int sbi = 16 * rt + lr;
            const f32x4 xv = *(const f32x4*)(P.in[1] + (size_t)sbi * DM + col), gv = *(const f32x4*)((const float*)(P.ws + WS_MOD) + (size_t)(8 + sbi) * 3072 + 2048 + col);
            *(f32x4*)(P.out + O_YS + (size_t)sbi * DM + col) = xv + gv * (acc0 + acc1);
        }
    }
}

#define XB_TMO      128
#define XB_XCNT(j)  (256  + 64 * (j))
#define XB_XSUB(j)  (1280 + 64 * (j))
#define XB_XGEN(j)  (2304 + 64 * (j))
#define XB_TOP      3328
#define XB_TOPGEN   3392
#define XCD_BAR_WORDS 3456
#define XB_SPIN_CAP (1u << 18)
__device__ __forceinline__ unsigned xb_ld(unsigned* p)              { return __hip_atomic_load(p, __ATOMIC_RELAXED, __HIP_MEMORY_SCOPE_AGENT); }
__device__ __forceinline__ unsigned xb_add(unsigned* p, unsigned v) { return __hip_atomic_fetch_add(p, v, __ATOMIC_RELAXED, __HIP_MEMORY_SCOPE_AGENT); }
__device__ __forceinline__ unsigned xb_xcc_id() { return (unsigned)__builtin_amdgcn_s_getreg((3 << 11) | 20) & 0xFu; }
#define XB_SPIN(cond, bar) do { unsigned _sp = 0; while (cond) { __builtin_amdgcn_s_sleep(1); \
    if ((++_sp & 255u) == 0u) { if (xb_ld(&(bar)[XB_TMO])) break; if (_sp > XB_SPIN_CAP) { atomicAdd(&(bar)[XB_TMO], 1u); break; } } } } while (0)
struct XcdBarrier { unsigned* bar; unsigned x; volatile LAS unsigned* st; };
__device__ __forceinline__ XcdBarrier xcd_barrier_post(unsigned* bar, volatile LAS unsigned* st) {
    XcdBarrier b; b.bar = bar; b.x = xb_xcc_id(); b.st = st;
    if (threadIdx.x == 0) (void)xb_add(&bar[XB_XCNT(b.x)], 1u);
    return b;
}
__device__ __forceinline__ void xcd_barrier_complete(unsigned* bar, unsigned x, unsigned& nloc, unsigned& nx) {
    const unsigned G = gridDim.x * gridDim.y * gridDim.z;
    unsigned sum, cnt, mine, sp = 0u;
    for (;;) {
        sum = 0u; cnt = 0u; mine = 0u;
#pragma unroll
        for (unsigned j = 0; j < 16; ++j) { const unsigned c = xb_ld(&bar[XB_XCNT(j)]); sum += c; cnt += (c > 0u) ? 1u : 0u; mine = (j == x) ? c : mine; }
        if (sum == G) break;
        __builtin_amdgcn_s_sleep(1);
        if ((++sp & 255u) == 0u) { if (xb_ld(&bar[XB_TMO])) break; if (sp > XB_SPIN_CAP) { atomicAdd(&bar[XB_TMO], 1u); break; } }
    }
    nloc = mine > 0u ? mine : 1u; nx = cnt > 0u ? cnt : 1u;
}
__device__ __forceinline__ void xcd_barrier(const XcdBarrier& b) {
    asm volatile("s_waitcnt vmcnt(0)" ::: "memory");
    __syncthreads();
    if (threadIdx.x == 0) {
        unsigned* bar = b.bar;
        __builtin_amdgcn_s_waitcnt(0);
        unsigned nloc = b.st[0], nx = b.st[1];
        if (nloc == 0u) { xcd_barrier_complete(bar, b.x, nloc, nx); b.st[0] = nloc; b.st[1] = nx; }
        const unsigned old = xb_add(&bar[XB_XSUB(b.x)], 1u);
        const unsigned gen = old / nloc;
        if (old + 1u == (gen + 1u) * nloc) {
            __builtin_amdgcn_fence(__ATOMIC_RELEASE, "agent");
            asm volatile("s_waitcnt vmcnt(0)" ::: "memory");
            const unsigned og = xb_add(&bar[XB_TOP], 1u);
            const unsigned tg = og / nx;
            if (og + 1u == (tg + 1u) * nx) xb_add(&bar[XB_TOPGEN], 1u);
            else XB_SPIN(xb_ld(&bar[XB_TOPGEN]) == tg, bar);
            __builtin_amdgcn_fence(__ATOMIC_ACQUIRE, "agent");
            xb_add(&bar[XB_XGEN(b.x)], 1u);
            asm volatile("s_waitcnt vmcnt(0)" ::: "memory");
        } else {
            XB_SPIN(xb_ld(&bar[XB_XGEN(b.x)]) == gen, bar);
            __builtin_amdgcn_fence(__ATOMIC_ACQUIRE, "agent");
            asm volatile("s_waitcnt vmcnt(0)" ::: "memory");
        }
    }
    __syncthreads();
}

__global__ void __launch_bounds__(512, 2) mk_fwd(Params P) {
    extern __shared__ __attribute__((aligned(16))) unsigned char lds_raw[];
    LAS unsigned char* lds = (LAS unsigned char*)lds_raw;
    const int tid = threadIdx.x, lane = tid & 63, wave = __builtin_amdgcn_readfirstlane(tid >> 6);
    const int G = gridDim.x, c = blockIdx.x, gw = c * 8 + wave, NGW = G * 8, gtid = c * 512 + tid, NT = G * 512;
    cg::grid_group grid = cg::this_grid();
    const int lo = P.ph_lo, hi = P.ph_hi;
    if (tid < 16) ((LAS unsigned*)(lds + LDS_XB))[tid] = 0u;
    __syncthreads();
    const XcdBarrier bar = xcd_barrier_post((unsigned*)(P.ws + WS_CTL), (volatile LAS unsigned*)(lds + LDS_XB));
    if (hi < 0) grid.sync();
#define IN(k) (lo <= (k) && (k) < hi)
#define SEAM(k) do { if (IN(k) && IN((k) + 1)) xcd_barrier(bar); } while (0)
    unsigned char* ws = P.ws;
    if (IN(0)) for (int rep = 0; rep < MK_REP0; ++rep) { p0_prologue(P, lds, gw, NGW, lane, wave, gtid, NT); }
    SEAM(0);
    if (IN(1)) for (int rep = 0; rep < MK_REP1; ++rep) { p1_hrows(P, gw, NGW, lane); }
    SEAM(1);
    if (IN(2)) for (int rep = 0; rep < MK_REP2; ++rep) {
        pg8::Gemm gm{(const bf16_t*)(ws + WS_H), (const bf16_t*)(ws + WS_WTIN), DM, DM, DM};
        pg8::StaticOrder S; S.init(MPAD / 256, NIN / 256, G, c);
        EpiInProj E{(bf16_t*)(ws + WS_ACT), (bf16_t*)(ws + WS_VT), (bf16_t*)(ws + WS_GBUF), P.out, P.in[15], P.in[16], (const float*)(ws + WS_ROPE), lds + LDS_EPI};
        pg8::gemm_phase<EpiInProj, pg8::StaticOrder>(lds, gm, S, E);
    }
    SEAM(2);
    if (IN(3)) for (int rep = 0; rep < MK_REP3; ++rep) { p3_compress(P, lds, gw, NGW, lane, wave); }
    SEAM(3);
    if (IN(4)) for (int rep = 0; rep < MK_REP4; ++rep) {
        asm volatile("" ::: "memory");
        for (int i = 0;; ++i) { const int a = (i & 1) ? (i + 1) * G - 1 - c : i * G + c; if (a >= 512 || a < 0) break; attn_unit(P, lds, a & 7, 63 - (a >> 3), tid, lane, wave); }
        {
            unsigned* qctr = (unsigned*)(ws + WS_CTL) + 3584;
            LAS unsigned* qsl = (LAS unsigned*)(lds + LDS_XB + 32);
            for (;;) {
                __syncthreads();
                if (tid == 0) *qsl = __hip_atomic_fetch_add(qctr, 1u, __ATOMIC_RELAXED, __HIP_MEMORY_SCOPE_AGENT);
                __syncthreads();
                const int u = (int)*qsl;
                if (u >= 512) break;
                if (u < 256) gmlp_unit(P, lds, u >> 5, (u >> 1) & 15, u & 1, tid, lane, wave);
                else { const int su = u - 256; sample_unit(P, lds, su >> 1, su & 1, tid, lane, wave); }
            }
        }
        __syncthreads();
    }
    SEAM(4);
    if (IN(5)) for (int rep = 0; rep < MK_REP5; ++rep) {
        pg8::Gemm gm{(const bf16_t*)(ws + WS_AB), (const bf16_t*)(ws + WS_WTBR), DM, DM, 512};
        small_gemm<0>(P, c, G, wave, lane);
        pg8::PairOrder S; S.S.init(MP / 256, DM / 256, G, c);
        EpiMix E{(const bf16_t*)(ws + WS_GBUF), (bf16_t*)(ws + WS_H)};
        pg8::gemm_phase<EpiMix, pg8::PairOrder>(lds, gm, S, E);
    }
    SEAM(5);
    if (IN(6)) for (int rep = 0; rep < MK_REP6; ++rep) {
        pg8::Gemm gm{(const bf16_t*)(ws + WS_H), (const bf16_t*)(ws + WS_WTOUT), DM, DM, DM};
        small_gemm<1>(P, c, G, wave, lane);
        pg8::StaticOrder S; S.init(MP / 256, DM / 256, G, c);
        EpiOut E{P.in[0], P.in[1], (const float*)(ws + WS_MOD), P.out};
        pg8::gemm_phase<EpiOut, pg8::StaticOrder>(lds, gm, S, E);
    }
#undef IN
#undef SEAM
}

extern "C" void kernel_launch(void* const* d_in, const int* in_sizes, int n_in, void* d_out, int out_size, void* d_ws, size_t ws_size, hipStream_t stream) {
    static int grid = 0;
    if (grid == 0) {
        if (n_in != 28 || out_size != (int)O_END || ws_size < WS_END) { fprintf(stderr, "kernel_launch: unexpected shapes (n_in %d, out %d, ws %zu); nothing launched\n", n_in, out_size, ws_size); grid = -1; return; }
        int dev = 0, cus = 0, per_cu = 0;
        if (hipGetDevice(&dev) != hipSuccess || hipDeviceGetAttribute(&cus, hipDeviceAttributeMultiprocessorCount, dev) != hipSuccess) { grid = -1; return; }
        if (hipFuncSetAttribute((const void*)mk_fwd, hipFuncAttributeMaxDynamicSharedMemorySize, LDS_BYTES) != hipSuccess) { fprintf(stderr, "kernel_launch: hipFuncSetAttribute failed\n"); grid = -1; return; }
        if (hipOccupancyMaxActiveBlocksPerMultiprocessor(&per_cu, (const void*)mk_fwd, 512, LDS_BYTES) != hipSuccess || per_cu < 1) { fprintf(stderr, "kernel_launch: occupancy query failed (%d)\n", per_cu); (void)hipGetLastError(); per_cu = 1; }
        if (per_cu > 1) per_cu = 1;
        grid = cus * per_cu;
    }
    if (grid < 0) return;
    if (hipMemsetAsync((char*)d_ws + WS_CTL, 0, CTL_BYTES, stream) != hipSuccess) { fprintf(stderr, "kernel_launch: hipMemsetAsync failed\n"); return; }
    Params p{};
    for (int i = 0; i < 28; ++i) p.in[i] = (const float*)d_in[i];
    p.out = (float*)d_out; p.ws = (unsigned char*)d_ws;
#if MK_N_LAUNCHES == 1
    p.ph_lo = 0; p.ph_hi = 7;
    void* args[] = {&p};
    hipError_t e = hipLaunchCooperativeKernel((const void*)mk_fwd, dim3(grid), dim3(512), args, LDS_BYTES, stream);
    if (e != hipSuccess) fprintf(stderr, "kernel_launch: cooperative launch failed: %s (grid %d)\n", hipGetErrorString(e), grid);
#else
    for (int ph = 0; ph < 7; ++ph) {
        p.ph_lo = ph; p.ph_hi = ph + 1;
        void* args[] = {&p};
        hipError_t e = hipLaunchCooperativeKernel((const void*)mk_fwd, dim3(grid), dim3(512), args, LDS_BYTES, stream);
        if (e != hipSuccess) { fprintf(stderr, "kernel_launch: launch %d failed: %s (grid %d)\n", ph, hipGetErrorString(e), grid); break; }
    }
#endif
}
```

```cpp
#include <hip/hip_runtime.h>
#include <hip/hip_cooperative_groups.h>
#include <cstdio>
#include <cstdint>
namespace cg = cooperative_groups;

#ifndef MK_N_LAUNCHES
#define MK_N_LAUNCHES 1
#endif
#define MK_REP0 1
#define MK_REP1 1
#define MK_REP2 1
#define MK_REP3 1
#define MK_REP4 1
#define MK_REP5 1
#define MK_REP6 1

#define LAS __attribute__((address_space(3)))
typedef unsigned short bf16_t;
typedef short bf16x8 __attribute__((ext_vector_type(8)));
typedef short bf16x4 __attribute__((ext_vector_type(4)));
typedef float f32x4 __attribute__((ext_vector_type(4)));
typedef float f32x2 __attribute__((ext_vector_type(2)));
typedef unsigned u32x4 __attribute__((ext_vector_type(4)));
typedef unsigned u32x2 __attribute__((ext_vector_type(2)));

constexpr int DM = 1024, SEQ = 2048, NBATCH = 8, MP = NBATCH * SEQ, NSB = 128, MTOT = MP + NSB, MPAD = 16640;
constexpr int NIN = 5632;
constexpr int LQ = 0, LK = 512, LV = 896, LZA = 1280, LU = 1792, LVB = 2304, LZB = 2816, LGA = 3328, LGB = 4352, LNSA = 5376;
constexpr float C2Q = 0.125f * 1.4426950408889634f;
constexpr float NEGBIG = -1e30f, MINIT = -1e29f;
constexpr size_t O_YP = 0, O_YS = 16777216, O_PKC = 16908288, O_PVC = 19005440, O_PKS = 21102592, O_PVS = 23199744, O_PKW = 25296896, O_PVW = 25821184,
                 O_SKC = 26345472, O_SVC = 26361856, O_SKS = 26378240, O_SVS = 26394624, O_SKW = 26411008, O_SVW = 34799616, O_SVCH = 43188224, O_END = 43253760;
constexpr size_t MiB = 1u << 20;
constexpr size_t WS_ROPE = 0, WS_MOD = 1 * MiB, WS_WTIN = 3 * MiB, WS_WTBR = 14 * MiB, WS_WTOUT = 16 * MiB, WS_TRIL = 18 * MiB, WS_KC = 18 * MiB + 512 * 1024, WS_VCT = WS_KC + 128 * 1024,
                 WS_KCS = 19 * MiB, WS_VCS = 23 * MiB, WS_VT = 27 * MiB, WS_H = 40 * MiB, WS_AB = 73 * MiB, WS_ACT = 106 * MiB, WS_GBUF = 285 * MiB, WS_END = 355 * MiB;
constexpr size_t WS_CTL = 768 * 1024, CTL_BYTES = 16384;
constexpr int LDS_BYTES = 151552, LDS_XB = LDS_BYTES - 64;
constexpr int LDS_EPI = 131072, EPI_PITCH = 144, EPI_WAVE = 16 * EPI_PITCH;
static_assert(LDS_EPI + 8 * EPI_WAVE <= LDS_XB - 64, "epilogue staging");

struct Params { const float* in[28]; float* out; unsigned char* ws; int ph_lo, ph_hi; };

__device__ __forceinline__ unsigned f2bf(float f) { unsigned u = __builtin_bit_cast(unsigned, f); return (u + 0x7fffu + ((u >> 16) & 1u)) >> 16; }
__device__ __forceinline__ unsigned cvt_pk_bf16(float lo, float hi);
__device__ __forceinline__ unsigned pk2(float lo, float hi) { return cvt_pk_bf16(lo, hi); }
__device__ __forceinline__ float bf2f(unsigned b) { return __builtin_bit_cast(float, (b & 0xffffu) << 16); }
typedef __bf16 bf16x2_t __attribute__((ext_vector_type(2)));
__device__ __forceinline__ unsigned cvt_pk_bf16(float lo, float hi) { const f32x2 v = {lo, hi}; const bf16x2_t b = __builtin_convertvector(v, bf16x2_t); return __builtin_bit_cast(unsigned, b); }
__device__ __forceinline__ void stage_store_rows(LAS unsigned char* sw, int lane, int fr, int fq, const u32x2 (&w)[2][2], bf16_t* dst0, size_t pitch, int nrows) {
#pragma unroll
    for (int bj = 0; bj < 2; ++bj)
#pragma unroll
        for (int n = 0; n < 2; ++n) *(LAS u32x2*)(sw + fr * EPI_PITCH + (32 * bj + 16 * n + 4 * fq) * 2) = w[bj][n];
    const int r = lane >> 3, ch = lane & 7;
    const u32x4 v0 = *(const LAS u32x4*)(sw + r * EPI_PITCH + ch * 16), v1 = *(const LAS u32x4*)(sw + (r + 8) * EPI_PITCH + ch * 16);
    if (r < nrows) *(u32x4*)(dst0 + (size_t)r * pitch + ch * 8) = v0;
    if (r + 8 < nrows) *(u32x4*)(dst0 + (size_t)(r + 8) * pitch + ch * 8) = v1;
}
__device__ __forceinline__ float sigmoidf_(float x) { return __builtin_amdgcn_rcpf(1.0f + __builtin_amdgcn_exp2f(x * -1.4426950408889634f)); }
__device__ __forceinline__ float wave_sum(float v) {
#pragma unroll
    for (int o = 1; o < 64; o <<= 1) v += __shfl_xor(v, o);
    return v;
}
__device__ __forceinline__ float wave_max(float v) {
#pragma unroll
    for (int o = 1; o < 64; o <<= 1) v = fmaxf(v, __shfl_xor(v, o));
    return v;
}
__device__ __forceinline__ void unpack4(u32x2 w, float (&f)[4]) { f[0] = bf2f(w.x); f[1] = bf2f(w.x >> 16); f[2] = bf2f(w.y); f[3] = bf2f(w.y >> 16); }

namespace pg8 {
constexpr int BM = 256, BK = 64, HALF = 128, HTB = HALF * BK * 2, STAGE_BYTES = 8 * HTB, NXCD = 8, WGM = 8;
__host__ __device__ __forceinline__ int lds_byte(int r, int c) { const int st = (r >> 4) * 2 + (c >> 5), rr = r & 15, cc = c & 31, ob = rr * 64 + cc * 2; return st * 1024 + (ob ^ (((ob >> 9) & 1) << 5)); }
__host__ __device__ __forceinline__ void stage_rc(int b, int& R, int& C) { const int st = b / 1024, sb = b % 1024, swz = sb ^ (((sb >> 9) & 1) << 5); R = (st >> 1) * 16 + swz / 64; C = (st & 1) * 32 + (swz % 64) / 2; }

struct Unit { int pm, pn, kofs, keep; };
struct Gemm { const bf16_t* A; const bf16_t* Bt; int lda, ldb, K; };

struct StaticOrder {
    int nM, nN, nwg, G, c;
    __device__ void init(int nM_, int nN_, int G_, int c_) { nM = nM_; nN = nN_; nwg = nM * nN; G = G_; c = c_; }
    __device__ bool tile(int i, int& pm, int& pn) const {
        const long L = (long)i * G + c; if (L >= nwg) return false;
        int wgid = (int)L; { const int q = nwg / NXCD, r = nwg % NXCD, xcd = wgid % NXCD, off = wgid / NXCD; wgid = (xcd < r ? xcd * (q + 1) : r * (q + 1) + (xcd - r) * q) + off; }
        const int nig = WGM * nN, gid = wgid / nig, fm = gid * WGM, gsz = (nM - fm) < WGM ? (nM - fm) : WGM;
        pm = fm + ((wgid % nig) % gsz); pn = (wgid % nig) / gsz; return true;
    }
    __device__ bool next(int i, Unit& u) const { u.kofs = 0; u.keep = 0; return tile(i, u.pm, u.pn); }
};
struct PairOrder {
    StaticOrder S;
    __device__ bool next(int i, Unit& u) const { u.kofs = (i & 1) * 512; u.keep = (i & 1) ? 0 : 1; return S.tile(i >> 1, u.pm, u.pn); }
};

template <class Epi, class Sched>
__device__ __forceinline__ void gemm_phase(LAS unsigned char* lds, const Gemm g, const Sched& S, const Epi& E) {
    const int tid = threadIdx.x, wid = __builtin_amdgcn_readfirstlane(tid >> 6), lane = tid & 63, wr = wid >> 2, wc = wid & 3, fr = lane & 15, fq = lane >> 4;
    const int nt = g.K / BK;
    unsigned voffA[2], voffB[2];
#pragma unroll
    for (int i = 0; i < 2; ++i) { int R, C; stage_rc(tid * 16 + i * 8192, R, C); voffA[i] = (unsigned)(R * g.lda + C) * 2u; voffB[i] = (unsigned)(R * g.ldb + C) * 2u; }
    const size_t kstep = (size_t)(BK * 2);
    const size_t hstepA = (size_t)HALF * g.lda * 2, hstepB = (size_t)HALF * g.ldb * 2, tstepA = 2 * hstepA, tstepB = 2 * hstepB;
    const unsigned ldsw = (unsigned)wid * 1024u;
    const int aoff = lds_byte(wr * 64 + fr, fq * 8), boff = lds_byte(wc * 32 + fr, fq * 8);
#define PG8_SA(b, h) (((b) * 2 + (h)) * HTB)
#define PG8_SB(b, h) ((4 + (b) * 2 + (h)) * HTB)
#define PG8_STAGE(bufoff, gbase, voff) do { _Pragma("unroll") for (int _i = 0; _i < 2; ++_i) \
        __builtin_amdgcn_global_load_lds((const unsigned*)((const char*)(gbase) + (voff)[_i]), (LAS unsigned*)(lds + (bufoff) + ldsw + _i * 8192), 16, 0, 0); } while (0)
#define PG8_LDA(dst, b, h) do { _Pragma("unroll") for (int m = 0; m < 4; ++m) _Pragma("unroll") for (int k = 0; k < 2; ++k) dst[m][k] = *(const LAS bf16x8*)(lds + PG8_SA(b, h) + aoff + m * 2048 + k * 1024); } while (0)
#define PG8_LDB(dst, b, h) do { _Pragma("unroll") for (int n = 0; n < 2; ++n) _Pragma("unroll") for (int k = 0; k < 2; ++k) dst[n][k] = *(const LAS bf16x8*)(lds + PG8_SB(b, h) + boff + n * 2048 + k * 1024); } while (0)
#define PG8_MMA(ai, bj, At, Bt) do { __builtin_amdgcn_s_setprio(1); _Pragma("unroll") for (int m = 0; m < 4; ++m) _Pragma("unroll") for (int n = 0; n < 2; ++n) _Pragma("unroll") for (int k = 0; k < 2; ++k) \
        acc[ai][bj][m][n] = __builtin_amdgcn_mfma_f32_16x16x32_bf16(Bt[n][k], At[m][k], acc[ai][bj][m][n], 0, 0, 0); __builtin_amdgcn_s_setprio(0); } while (0)
#define PG8_WAIT_V(n) asm volatile("s_waitcnt vmcnt(" #n ")" ::: "memory")
#define PG8_WAIT_L(n) asm volatile("s_waitcnt lgkmcnt(" #n ")" ::: "memory")
#define PG8_BAR __builtin_amdgcn_s_barrier()
#define PG8_SCHED __builtin_amdgcn_sched_barrier(0)
    Unit cur, nxt; int ui = 0;
    if (!S.next(0, cur)) return;
    f32x4 acc[2][2][4][2];
#pragma unroll
    for (int a = 0; a < 2; ++a)
#pragma unroll
        for (int b = 0; b < 2; ++b)
#pragma unroll
            for (int m = 0; m < 4; ++m)
#pragma unroll
                for (int n = 0; n < 2; ++n) acc[a][b][m][n] = (f32x4){0.f, 0.f, 0.f, 0.f};
    bf16x8 At[4][2], B0[2][2], B1[2][2];
    const char* cA = (const char*)g.A + (size_t)cur.pm * tstepA + (size_t)cur.kofs * 2; const char* cB = (const char*)g.Bt + (size_t)cur.pn * tstepB + (size_t)cur.kofs * 2;
    PG8_STAGE(PG8_SB(0, 0), cB, voffB); PG8_STAGE(PG8_SB(0, 1), cB + hstepB, voffB); PG8_STAGE(PG8_SA(0, 0), cA, voffA); PG8_STAGE(PG8_SA(0, 1), cA + hstepA, voffA);
    if (wr == 1) PG8_BAR;
    PG8_WAIT_V(2); PG8_BAR;
    PG8_STAGE(PG8_SB(1, 0), cB + kstep, voffB); PG8_STAGE(PG8_SA(1, 0), cA + kstep, voffA); PG8_STAGE(PG8_SB(1, 1), cB + hstepB + kstep, voffB);
    PG8_WAIT_V(6); PG8_BAR;
    for (;;) {
        const bool has_next = S.next(ui + 1, nxt);
        const char* nA = has_next ? (const char*)g.A + (size_t)nxt.pm * tstepA + (size_t)nxt.kofs * 2 : cA; const char* nB = has_next ? (const char*)g.Bt + (size_t)nxt.pn * tstepB + (size_t)nxt.kofs * 2 : cB;
        for (int t = 0; t < nt; t += 2) {
            const bool last = (t == nt - 2);
            const char* a1 = cA + (size_t)(t + 1) * kstep;
            const char* a2 = last ? nA : cA + (size_t)(t + 2) * kstep; const char* b2 = last ? nB : cB + (size_t)(t + 2) * kstep;
            const char* a3 = a2 + kstep; const char* b3 = b2 + kstep;
            PG8_LDB(B0, 0, 0); PG8_LDB(B1, 0, 1); PG8_SCHED; PG8_LDA(At, 0, 0); PG8_STAGE(PG8_SA(1, 1), a1 + hstepA, voffA);
            PG8_WAIT_V(8); PG8_WAIT_L(0); PG8_BAR; PG8_MMA(0, 0, At, B0); PG8_MMA(0, 1, At, B1); PG8_BAR; PG8_SCHED;
            PG8_LDA(At, 0, 1); PG8_STAGE(PG8_SB(0, 0), b2, voffB); PG8_STAGE(PG8_SB(0, 1), b2 + hstepB, voffB); PG8_STAGE(PG8_SA(0, 0), a2, voffA);
            PG8_WAIT_V(8); PG8_WAIT_L(0); PG8_BAR; PG8_MMA(1, 0, At, B0); PG8_MMA(1, 1, At, B1); PG8_BAR; PG8_SCHED;
            PG8_LDB(B0, 1, 0); PG8_LDB(B1, 1, 1); PG8_SCHED; PG8_LDA(At, 1, 0); PG8_STAGE(PG8_SA(0, 1), a2 + hstepA, voffA);
            PG8_WAIT_V(8); PG8_WAIT_L(0); PG8_BAR; PG8_MMA(0, 0, At, B0); PG8_MMA(0, 1, At, B1); PG8_BAR; PG8_SCHED;
            PG8_LDA(At, 1, 1); PG8_STAGE(PG8_SB(1, 0), b3, voffB); PG8_STAGE(PG8_SB(1, 1), b3 + hstepB, voffB); PG8_STAGE(PG8_SA(1, 0), a3, voffA);
            PG8_WAIT_V(8); PG8_WAIT_L(0); PG8_BAR; PG8_MMA(1, 0, At, B0); PG8_MMA(1, 1, At, B1); PG8_BAR; PG8_SCHED;
        }
        if (wr == 0) PG8_BAR;
        E(acc, cur, wr, wc, fr, fq);
        if (!has_next) break;
        if (!cur.keep) {
#pragma unroll
            for (int a = 0; a < 2; ++a)
#pragma unroll
                for (int b = 0; b < 2; ++b)
#pragma unroll
                    for (int m = 0; m < 4; ++m)
#pragma unroll
                        for (int n = 0; n < 2; ++n) acc[a][b][m][n] = (f32x4){0.f, 0.f, 0.f, 0.f};
        }
        cur = nxt; cA = nA; cB = nB; ++ui;
        if (wr == 1) PG8_BAR;
    }
    PG8_WAIT_V(0);
    PG8_BAR;
#undef PG8_SA
#undef PG8_SB
#undef PG8_STAGE
#undef PG8_LDA
#undef PG8_LDB
#undef PG8_MMA
#undef PG8_WAIT_V
#undef PG8_WAIT_L
#undef PG8_BAR
#undef PG8_SCHED
}
}

struct EpiInProj {
    bf16_t* ACT; bf16_t* VT; bf16_t* GB; float* out; const float* qng; const float* kng; const float* rope; LAS unsigned char* stg;
    __device__ __forceinline__ void operator()(f32x4 (&acc)[2][2][4][2], const pg8::Unit& u, int wr, int wc, int fr, int fq) const {
        const int pn = u.pn;
        int type = 0, slot = 0;
        if (pn < 2) { type = 1; slot = 4 * pn + wc; }
        else if (pn == 2 || (pn == 3 && wc < 2)) { type = 2; slot = 4 * (pn - 2) + wc; }
        else if (pn == 3 || pn == 4) { type = 3; slot = 4 * (pn - 3) + wc - 2; }
        const int rbase = u.pm * 256 + wr * 64 + fr;
        if (type == 1 || type == 2) {
            const float* gn = (type == 1) ? qng : kng;
            f32x4 g4[2][2];
#pragma unroll
            for (int bj = 0; bj < 2; ++bj)
#pragma unroll
                for (int n = 0; n < 2; ++n) g4[bj][n] = *(const f32x4*)(gn + 32 * bj + 16 * n + 4 * fq);
            const int br = slot >> 1, kvh = slot & 1;
#pragma unroll
            for (int ai = 0; ai < 2; ++ai)
#pragma unroll
                for (int m = 0; m < 4; ++m) {
                    const int row = rbase + ai * 128 + m * 16;
                    float ss = 0.f;
#pragma unroll
                    for (int bj = 0; bj < 2; ++bj)
#pragma unroll
                        for (int n = 0; n < 2; ++n) { const f32x4 v = acc[ai][bj][m][n]; ss += (v[0] * v[0] + v[1] * v[1]) + (v[2] * v[2] + v[3] * v[3]); }
                    ss += __shfl_xor(ss, 16); ss += __shfl_xor(ss, 32);
                    const float rinv = __builtin_amdgcn_rsqf(ss * (1.0f / 64.0f) + 1e-6f);
                    const int pos = (row < MP) ? (row & (SEQ - 1)) : SEQ;
                    const bool live = row < MTOT;
                    long obase = -1;
                    if (type == 2 && live) {
                        if (row < MP) {
                            const int t = row & (SEQ - 1), b = row >> 11;
                            if (br == 0) obase = (long)O_PKC + (long)row * 128 + kvh * 64;
                            else if (br == 1) obase = (long)O_PKS + (long)row * 128 + kvh * 64;
                            else if (t >= 1536) obase = (long)O_PKW + ((long)(b * 512 + t - 1536) * 2 + kvh) * 64;
                        } else {
                            const int sb = row - MP;
                            if (br == 0) obase = (long)O_SKC + sb * 128 + kvh * 64;
                            else if (br == 1) obase = (long)O_SKS + sb * 128 + kvh * 64;
                            else obase = (long)O_SKW + ((long)(sb * 512 + 511) * 2 + kvh) * 64;
                        }
                    }
                    u32x2 wst[2][2];
#pragma unroll
                    for (int n = 0; n < 2; ++n) {
                        const f32x4 cs0 = *(const f32x4*)(rope + ((size_t)pos * 32 + 16 * n + 4 * fq) * 2);
                        const f32x4 cs1 = *(const f32x4*)(rope + ((size_t)pos * 32 + 16 * n + 4 * fq) * 2 + 4);
                        const float cc[4] = {cs0[0], cs0[2], cs1[0], cs1[2]}, sn[4] = {cs0[1], cs0[3], cs1[1], cs1[3]};
                        f32x4 o0, o1;
#pragma unroll
                        for (int j = 0; j < 4; ++j) {
                            const float y0 = acc[ai][0][m][n][j] * rinv * g4[0][n][j], y1 = acc[ai][1][m][n][j] * rinv * g4[1][n][j];
                            o0[j] = y0 * cc[j] - y1 * sn[j]; o1[j] = y1 * cc[j] + y0 * sn[j];
                        }
                        const float qs = (type == 1) ? C2Q : 1.0f;
                        wst[0][n].x = cvt_pk_bf16(o0[0] * qs, o0[1] * qs); wst[0][n].y = cvt_pk_bf16(o0[2] * qs, o0[3] * qs); wst[1][n].x = cvt_pk_bf16(o1[0] * qs, o1[1] * qs); wst[1][n].y = cvt_pk_bf16(o1[2] * qs, o1[3] * qs);
                        if (type == 2 && obase >= 0) { const int dcol = 16 * n + 4 * fq; *(f32x4*)(out + obase + dcol) = o0; *(f32x4*)(out + obase + 32 + dcol) = o1; }
                    }
                    { const int row0 = row - fr; stage_store_rows(stg + (wr * 4 + wc) * EPI_WAVE, fq * 16 + fr, fr, fq, wst, ACT + (size_t)row0 * NIN + ((type == 1) ? LQ : LK) + 64 * slot, NIN, MTOT - row0); }
                }
        } else if (type == 3) {
            const int br = slot >> 1, kvh = slot & 1;
#pragma unroll
            for (int ai = 0; ai < 2; ++ai)
#pragma unroll
                for (int m = 0; m < 4; ++m) {
                    const int row = rbase + ai * 128 + m * 16;
                    if (row < MTOT) {
                        long obase = -1;
                        if (row < MP) {
                            const int t = row & (SEQ - 1), b = row >> 11;
                            if (br == 0) obase = (long)O_PVC + (long)row * 128 + kvh * 64;
                            else if (br == 1) obase = (long)O_PVS + (long)row * 128 + kvh * 64;
                            else if (t >= 1536) obase = (long)O_PVW + ((long)(b * 512 + t - 1536) * 2 + kvh) * 64;
                            bf16_t* vt = VT + ((size_t)(b * 6 + slot) * 64) * SEQ + t;
#pragma unroll
                            for (int bj = 0; bj < 2; ++bj)
#pragma unroll
                                for (int n = 0; n < 2; ++n)
#pragma unroll
                                    for (int j = 0; j < 4; ++j) vt[(size_t)(32 * bj + 16 * n + 4 * fq + j) * SEQ] = (bf16_t)f2bf(acc[ai][bj][m][n][j]);
                        } else {
                            const int sb = row - MP;
                            if (br == 0) obase = (long)O_SVC + sb * 128 + kvh * 64;
                            else if (br == 1) obase = (long)O_SVS + sb * 128 + kvh * 64;
                            else obase = (long)O_SVW + ((long)(sb * 512 + 511) * 2 + kvh) * 64;
                        }
                        if (obase >= 0) {
#pragma unroll
                            for (int bj = 0; bj < 2; ++bj)
#pragma unroll
                                for (int n = 0; n < 2; ++n) *(f32x4*)(out + obase + 32 * bj + 16 * n + 4 * fq) = acc[ai][bj][m][n];
                        }
                    }
                }
        } else if (pn >= 13 && pn <= 20) {
            bf16_t* gp = GB + ((size_t)((u.pm * 8 + (pn - 13)) * 8 + wr * 4 + wc) * 32) * 256 + (size_t)(fq * 16 + fr) * 4;
#pragma unroll
            for (int ai = 0; ai < 2; ++ai)
#pragma unroll
                for (int m = 0; m < 4; ++m)
#pragma unroll
                    for (int bj = 0; bj < 2; ++bj)
#pragma unroll
                        for (int n = 0; n < 2; ++n) {
                            const f32x4 v = acc[ai][bj][m][n];
                            u32x2 w; w.x = cvt_pk_bf16(sigmoidf_(v[0]), sigmoidf_(v[1])); w.y = cvt_pk_bf16(sigmoidf_(v[2]), sigmoidf_(v[3]));
                            *(u32x2*)(gp + (size_t)(((ai * 4 + m) * 2 + bj) * 2 + n) * 256) = w;
                        }
        } else {
            const int mode = (pn <= 6) ? 1 : (pn <= 10) ? 0 : (pn <= 12) ? 1 : 2;
            LAS unsigned char* sw = stg + (wr * 4 + wc) * EPI_WAVE; const int lane = fq * 16 + fr;
#pragma unroll
            for (int ai = 0; ai < 2; ++ai)
#pragma unroll
                for (int m = 0; m < 4; ++m) {
                    const int row0 = u.pm * 256 + wr * 64 + ai * 128 + m * 16;
                    u32x2 w[2][2];
#pragma unroll
                    for (int bj = 0; bj < 2; ++bj)
#pragma unroll
                        for (int n = 0; n < 2; ++n) {
                            f32x4 v = acc[ai][bj][m][n];
#pragma unroll
                            for (int j = 0; j < 4; ++j) { const float sg = sigmoidf_(v[j]); v[j] = (mode == 0) ? v[j] : (mode == 1) ? v[j] * sg : sg; }
                            w[bj][n].x = cvt_pk_bf16(v[0], v[1]); w[bj][n].y = cvt_pk_bf16(v[2], v[3]);
                        }
                    stage_store_rows(sw, lane, fr, fq, w, ACT + (size_t)row0 * NIN + 256 * pn + 64 * wc, NIN, MTOT - row0);
                }
        }
    }
};

struct EpiMix {
    const bf16_t* GB; bf16_t* M;
    __device__ __forceinline__ void operator()(f32x4 (&acc)[2][2][4][2], const pg8::Unit& u, int wr, int wc, int fr, int fq) const {
        const int rbase = u.pm * 256 + wr * 64 + fr, cbase = u.pn * 256 + 64 * wc + 4 * fq;
        const bf16_t* ga = GB + ((size_t)((u.pm * 8 + u.pn) * 8 + wr * 4 + wc) * 32) * 256 + (size_t)(fq * 16 + fr) * 4;
        const bf16_t* gb = ga + (size_t)4 * 8 * 32 * 256;
#pragma unroll
        for (int ai = 0; ai < 2; ++ai) {
            u32x2 gsb[16], gsa[16];
#pragma unroll
            for (int f = 0; f < 16; ++f) { gsb[f] = *(const u32x2*)(gb + (ai * 16 + f) * 256); if (u.keep) gsa[f] = *(const u32x2*)(ga + (ai * 16 + f) * 256); }
#pragma unroll
            for (int m = 0; m < 4; ++m) {
                const int row = rbase + ai * 128 + m * 16;
#pragma unroll
                for (int bj = 0; bj < 2; ++bj)
#pragma unroll
                    for (int n = 0; n < 2; ++n) {
                        const int f = (m * 2 + bj) * 2 + n;
                        float sb[4]; unpack4(gsb[f], sb);
                        if (u.keep) {
                            float sa[4]; unpack4(gsa[f], sa);
#pragma unroll
                            for (int j = 0; j < 4; ++j) acc[ai][bj][m][n][j] *= sa[j] * __builtin_amdgcn_rcpf(sb[j]);
                        } else if (row < MP) {
                            const f32x4 v = acc[ai][bj][m][n];
                            u32x2 w; w.x = cvt_pk_bf16(v[0] * sb[0], v[1] * sb[1]); w.y = cvt_pk_bf16(v[2] * sb[2], v[3] * sb[3]);
                            *(u32x2*)(M + (size_t)row * DM + cbase + 32 * bj + 16 * n) = w;
                        }
                    }
            }
        }
    }
};

struct EpiOut {
    const float* xp; const float* xs; const float* MOD; float* out;
    __device__ __forceinline__ void operator()(f32x4 (&acc)[2][2][4][2], const pg8::Unit& u, int wr, int wc, int fr, int fq) const {
        const int rbase = u.pm * 256 + wr * 64 + fr, cbase = u.pn * 256 + wc * 32 + 4 * fq;
        const float* gr = MOD + (size_t)(rbase >> 11) * 3072 + 2048;
        f32x4 gv[2][2];
#pragma unroll
        for (int bj = 0; bj < 2; ++bj)
#pragma unroll
            for (int n = 0; n < 2; ++n) gv[bj][n] = *(const f32x4*)(gr + cbase + 128 * bj + 16 * n);
#pragma unroll
        for (int ai = 0; ai < 2; ++ai) {
            f32x4 xv[4][2][2];
#pragma unroll
            for (int m = 0; m < 4; ++m)
#pragma unroll
                for (int bj = 0; bj < 2; ++bj)
#pragma unroll
                    for (int n = 0; n < 2; ++n) xv[m][bj][n] = __builtin_nontemporal_load((const f32x4*)(xp + (size_t)(rbase + ai * 128 + m * 16) * DM + cbase + 128 * bj + 16 * n));
#pragma unroll
            for (int m = 0; m < 4; ++m)
#pragma unroll
                for (int bj = 0; bj < 2; ++bj)
#pragma unroll
                    for (int n = 0; n < 2; ++n)
                        __builtin_nontemporal_store(xv[m][bj][n] + gv[bj][n] * acc[ai][bj][m][n], (f32x4*)(out + O_YP + (size_t)(rbase + ai * 128 + m * 16) * DM + cbase + 128 * bj + 16 * n));
        }
    }
};

__device__ __forceinline__ void transpose_item(const float* src, int src_ld, int nvalid, bf16_t* dst, int dst_ld, LAS float* scr, int lane) {
    float tv[64];
    const int cc = lane & 31, ccl = cc < nvalid ? cc : 0;
#pragma unroll
    for (int i = 0; i < 64; ++i) tv[i] = src[(size_t)(2 * i + (lane >> 5)) * src_ld + ccl];
#pragma unroll
    for (int hf = 0; hf < 2; ++hf) {
#pragma unroll
        for (int i = 0; i < 32; ++i) scr[(2 * i + (lane >> 5)) * 33 + cc] = (cc < nvalid) ? tv[32 * hf + i] : 0.f;
        asm volatile("s_waitcnt lgkmcnt(0)" ::: "memory");
        const int c = lane & 7;
#pragma unroll
        for (int j = 0; j < 4; ++j) { const int n = (lane >> 3) + 8 * j; const LAS float* sp = scr + (8 * c) * 33 + n;
            u32x4 o; o.x = pk2(sp[0 * 33], sp[1 * 33]); o.y = pk2(sp[2 * 33], sp[3 * 33]); o.z = pk2(sp[4 * 33], sp[5 * 33]); o.w = pk2(sp[6 * 33], sp[7 * 33]);
            *(u32x4*)(dst + (size_t)n * dst_ld + 64 * hf + 8 * c) = o; }
        asm volatile("s_waitcnt lgkmcnt(0)" ::: "memory");
    }
}

__device__ __forceinline__ void pool_item(const Params& P, LAS float* scr, int it, int lane_in) {
    int lane = lane_in; asm volatile("" : "+v"(lane));
    unsigned char* ws = P.ws;
    const int sb = it >> 5, pg = (it >> 1) & 15, which = it & 1;
    const int page = ((const int*)P.in[8])[sb * 16 + pg];
    const float* src = P.in[2 + which] + (size_t)page * 128 * 128;
    const float* pe = P.in[17 + which]; const float* w = P.in[19 + which];
    const int d0 = (2 * lane) & 63;
    float p0 = 0.f, p1 = 0.f;
#pragma unroll 8
    for (int r = 0; r < 32; ++r) { const f32x2 v = *(const f32x2*)(pe + r * 64 + d0); p0 += v[0]; p1 += v[1]; }
#pragma unroll
    for (int cb = 0; cb < 4; ++cb) {
        f32x2 v[32];
#pragma unroll
        for (int r = 0; r < 32; ++r) v[r] = __builtin_nontemporal_load((const f32x2*)(src + (size_t)(cb * 32 + r) * 128 + 2 * lane));
        float s0 = 0.f, s1 = 0.f;
#pragma unroll
        for (int r = 0; r < 32; ++r) { s0 += v[r][0]; s1 += v[r][1]; }
        scr[d0 * 8 + cb * 2 + (lane >> 5)] = (s0 + p0) * (1.0f / 32.0f); scr[(d0 + 1) * 8 + cb * 2 + (lane >> 5)] = (s1 + p1) * (1.0f / 32.0f);
    }
    asm volatile("s_waitcnt lgkmcnt(0)" ::: "memory");
    float a[8];
#pragma unroll
    for (int q = 0; q < 8; ++q) a[q] = 0.f;
#pragma unroll 8
    for (int d = 0; d < 64; ++d) { const float wv = w[d * 64 + lane]; const f32x4 pa = *(const LAS f32x4*)(scr + d * 8), pb = *(const LAS f32x4*)(scr + d * 8 + 4);
        a[0] += pa[0] * wv; a[1] += pa[1] * wv; a[2] += pa[2] * wv; a[3] += pa[3] * wv; a[4] += pb[0] * wv; a[5] += pb[1] * wv; a[6] += pb[2] * wv; a[7] += pb[3] * wv; }
    float* dst = (float*)(ws + (which ? WS_VCS : WS_KCS));
#pragma unroll
    for (int q = 0; q < 8; ++q) dst[((size_t)(sb * 2 + (q & 1)) * 64 + 4 * pg + (q >> 1)) * 64 + lane] = a[q];
    asm volatile("s_waitcnt lgkmcnt(0)" ::: "memory");

}

__device__ __forceinline__ void p0_prologue(const Params& P, LAS unsigned char* lds, int gw, int NGW, int lane_p, int wave, int gtid, int NT) {
    unsigned char* ws = P.ws;
    LAS float* scr = (LAS float*)(lds + wave * 16384);
    constexpr int I_MOD = 9 * 48, I_WIN = 8 * 176, I_WBR = 8 * 32, I_WOUT = 8 * 32, I_POOL = NSB * 16 * 2;
    constexpr int POOL_P0 = 1616 + 776;
    constexpr int I_TOTAL = I_MOD + I_WIN + I_WBR + I_WOUT + I_POOL;
    constexpr int I_TR = I_WIN + I_WBR + I_WOUT;
    const bool modw = gw < I_MOD; const int io = gw - I_MOD;
    static_assert(I_TR == 1920 && I_POOL == 4096 && I_MOD == 432 && POOL_P0 == 1616 + 776, "the deal below is written for these counts and a 2048-wave grid");
    for (int stp = 0;; ++stp) {
        int it;
        if (NGW != 2048) { it = gw + stp * NGW; if (it >= I_MOD + I_TR + POOL_P0) break; }
        else if (modw) { if (stp == 0) it = gw; else break; }
        else {
            const int j = io - 776;
            const int nT = (io < 776) ? 1 : (j < 304 ? 2 : 1), nP = (io < 776) ? 2 : 1;
            if (stp >= nT + nP) break;
            if (stp < nT) it = I_MOD + ((io < 776) ? io : (stp == 0 ? 776 + j : 1616 + j));
            else it = I_MOD + I_TR + (stp - nT == 0 ? io : 1616 + io);
        }
        int lane = lane_p; asm volatile("" : "+v"(lane));
        if (it < I_MOD) {
            const int mt = it / 48, ng = it % 48, lr = lane & 15, kq = lane >> 4;
            int arow_i = 16 * mt + lr; if (arow_i > 135) arow_i = 135;
            const float* arow = ((arow_i < 8) ? P.in[9] + (size_t)arow_i * DM : P.in[10] + (size_t)(arow_i - 8) * DM) + 4 * kq;
            const float* bp = P.in[11] + (size_t)(4 * kq) * 3072 + 64 * ng + 4 * lr;
            f32x4 macc[4];
#pragma unroll
            for (int nt = 0; nt < 4; ++nt) macc[nt] = (f32x4){0.f, 0.f, 0.f, 0.f};
            f32x4 a0[4], b0[16], a1[4], b1[16];
#define MOD_LOAD(A_, B_, k0) do { _Pragma("unroll") for (int j = 0; j < 4; ++j) { A_[j] = *(const f32x4*)(arow + (k0) + 16 * j); \
                _Pragma("unroll") for (int e = 0; e < 4; ++e) B_[4 * j + e] = *(const f32x4*)(bp + (size_t)((k0) + 16 * j + e) * 3072); } } while (0)
#define MOD_MMA(A_, B_) do { _Pragma("unroll") for (int j = 0; j < 4; ++j) _Pragma("unroll") for (int e = 0; e < 4; ++e) _Pragma("unroll") for (int nt = 0; nt < 4; ++nt) \
                macc[nt] = __builtin_amdgcn_mfma_f32_16x16x4f32(A_[j][e], B_[4 * j + e][nt], macc[nt], 0, 0, 0); } while (0)
            MOD_LOAD(a0, b0, 0);
            for (int k0 = 0; k0 < DM; k0 += 128) {
                MOD_LOAD(a1, b1, k0 + 64);
                __builtin_amdgcn_sched_barrier(0);
                MOD_MMA(a0, b0);
                __builtin_amdgcn_sched_barrier(0);
                if (k0 + 128 < DM) MOD_LOAD(a0, b0, k0 + 128);
                __builtin_amdgcn_sched_barrier(0);
                MOD_MMA(a1, b1);
                __builtin_amdgcn_sched_barrier(0);
            }
#undef MOD_LOAD
#undef MOD_MMA
            float* MOD = (float*)(ws + WS_MOD);
            const f32x4 bb = *(const f32x4*)(P.in[12] + 64 * ng + 4 * lr);
#pragma unroll
            for (int r = 0; r < 4; ++r) { const int row = 16 * mt + 4 * kq + r;
                if (row < 136) *(f32x4*)(MOD + (size_t)row * 3072 + 64 * ng + 4 * lr) = (f32x4){macc[0][r] + bb[0], macc[1][r] + bb[1], macc[2][r] + bb[2], macc[3][r] + bb[3]}; }
            continue;
        }
        it -= I_MOD;
        if (it < I_WIN) {
            const int kb = it / 176, nb = it % 176;
            const int pn = nb >> 3, bj = (nb >> 2) & 1, wc = nb & 3;
            const int L0 = 256 * pn + 64 * wc + 32 * bj;
            int srcc, nvalid;
            if (L0 < 1280) { srcc = L0; nvalid = 32; } else if (L0 < LNSA) { srcc = L0 + 24; nvalid = 32; } else if (L0 == LNSA) { srcc = 1280; nvalid = 24; } else { srcc = 0; nvalid = 0; }
            transpose_item(P.in[14] + (size_t)(128 * kb) * 5400 + srcc, 5400, nvalid, (bf16_t*)(ws + WS_WTIN) + (size_t)(32 * nb) * DM + 128 * kb, DM, scr, lane);
            continue;
        }
        it -= I_WIN;
        if (it < I_WBR) {
            const int kb = it / 32, nb = it % 32;
            const float* src = (kb < 4) ? P.in[25] + (size_t)(128 * kb) * DM : P.in[26] + (size_t)(128 * (kb - 4)) * DM;
            const int L0 = 256 * (nb >> 3) + 64 * (nb & 3) + 32 * ((nb >> 2) & 1);
            transpose_item(src + L0, DM, 32, (bf16_t*)(ws + WS_WTBR) + (size_t)(32 * nb) * DM + 128 * kb, DM, scr, lane);
            continue;
        }
        it -= I_WBR;
        if (it < I_WOUT) {
            const int kb = it / 32, nb = it % 32;
            transpose_item(P.in[27] + (size_t)(128 * kb) * DM + 32 * nb, DM, 32, (bf16_t*)(ws + WS_WTOUT) + (size_t)(32 * nb) * DM + 128 * kb, DM, scr, lane);
            continue;
        }
        it -= I_WOUT;
        pool_item(P, scr, it, lane);
    }
    float* rope = (float*)(ws + WS_ROPE);
    for (int i = gtid; i < 2049 * 32; i += NT) {
        const int pos = i >> 5, k = i & 31;
        double invd = 1.0;
        for (int q = 0; q < k; ++q) invd *= 0.7498942093324559;
        const float ang = (float)pos * (float)invd;
        const double rev = (double)ang * 0.15915494309189535;
        const float fr = (float)(rev - __builtin_rint(rev));
        rope[2 * i] = __builtin_amdgcn_cosf(fr); rope[2 * i + 1] = __builtin_amdgcn_sinf(fr);
    }
    bf16_t* tril = (bf16_t*)(ws + WS_TRIL);
    for (int i = gtid; i < 4 * 128 * 128; i += NT) { const int r = (i >> 7) & 127, cidx = i & 127; tril[i] = (cidx <= r) ? (bf16_t)f2bf(P.in[23][i]) : (bf16_t)0; }
    for (int tk = blockIdx.x; tk < 2 * NSB * 2; tk += gridDim.x) {
        const int w2 = tk >> 8, sb = (tk >> 1) & 127, half = tk & 1;
        const f32x4* src = (const f32x4*)P.in[6 + w2] + (size_t)sb * 512 * 32 + 32 + half * 8176; f32x4* dst = (f32x4*)(P.out + (w2 ? O_SVW : O_SKW)) + (size_t)sb * 512 * 32 + half * 8176;
        f32x4 cv[16];
#pragma unroll
        for (int u = 0; u < 16; ++u) { const int i = threadIdx.x + 512 * u; if (i < 8176) cv[u] = __builtin_nontemporal_load(src + i); }
#pragma unroll
        for (int u = 0; u < 16; ++u) { const int i = threadIdx.x + 512 * u; if (i < 8176) __builtin_nontemporal_store(cv[u], dst + i); }
    }
}

__device__ __forceinline__ void p1_hrows(const Params& P, int gw, int NGW, int lane) {
    const float* MOD = (const float*)(P.ws + WS_MOD); bf16_t* H = (bf16_t*)(P.ws + WS_H); const float* ng = P.in[13];
    for (int row0 = gw; row0 < MPAD; row0 += 4 * NGW) {
        f32x4 v[4][4];
#pragma unroll
        for (int q = 0; q < 4; ++q) { const int row = row0 + q * NGW; const int rr = row < MTOT ? row : 0;
            const float* xr = (rr < MP) ? P.in[0] + (size_t)rr * DM : P.in[1] + (size_t)(rr - MP) * DM;
#pragma unroll
            for (int j = 0; j < 4; ++j) v[q][j] = __builtin_nontemporal_load((const f32x4*)xr + lane + 64 * j); }
#pragma unroll
        for (int q = 0; q < 4; ++q) {
            const int row = row0 + q * NGW;
            if (row >= MPAD) break;
            unsigned long long* o8 = (unsigned long long*)(H + (size_t)row * DM) + lane;
            if (row >= MTOT) {
#pragma unroll
                for (int j = 0; j < 4; ++j) o8[64 * j] = 0ull;
                continue; }
            const float* md = (row < MP) ? MOD + (size_t)(row >> 11) * 3072 : MOD + (size_t)(8 + row - MP) * 3072;
            float s = 0.f;
#pragma unroll
            for (int j = 0; j < 4; ++j) s += (v[q][j][0] * v[q][j][0] + v[q][j][1] * v[q][j][1]) + (v[q][j][2] * v[q][j][2] + v[q][j][3] * v[q][j][3]);
            const float rstd = rsqrtf(wave_sum(s) * (1.0f / DM) + 1e-6f);
#pragma unroll
            for (int j = 0; j < 4; ++j) {
                const int col = 4 * lane + 256 * j;
                const f32x4 g = *(const f32x4*)(ng + col), sh = *(const f32x4*)(md + col), sc = *(const f32x4*)(md + 1024 + col);
                const f32x4 h = (v[q][j] * rstd) * g * (sc + 1.0f) + sh;
                o8[64 * j] = (unsigned long long)pk2(h[0], h[1]) | ((unsigned long long)pk2(h[2], h[3]) << 32);
            }
        }
    }
}

__device__ __forceinline__ void p3_compress(const Params& P, LAS unsigned char* lds, int gw, int NGW, int lane, int wave) {
    LAS float* scr = (LAS float*)(lds + wave * 1024);
    for (int it = gw; it < NBATCH * 64 * 2 * 2; it += NGW) {
        const int b = it >> 8, c = (it >> 2) & 63, kvh = (it >> 1) & 1, which = it & 1;
        const float* src = P.out + (which ? O_PVC : O_PKC) + ((size_t)(b * SEQ + 32 * c) * 2 + kvh) * 64;
        const float* pe = P.in[17 + which]; const float* w = P.in[19 + which];
        float s = 0.f;
#pragma unroll
        for (int r = 0; r < 32; ++r) s += src[(size_t)r * 128 + lane] + pe[r * 64 + lane];
        scr[lane] = s * (1.0f / 32.0f);
        asm volatile("s_waitcnt lgkmcnt(0)" ::: "memory");
        float a = 0.f;
#pragma unroll 8
        for (int d = 0; d < 64; ++d) a += scr[d] * w[d * 64 + lane];
        if (which == 0) ((bf16_t*)(P.ws + WS_KC))[((size_t)(b * 64 + c) * 2 + kvh) * 64 + lane] = (bf16_t)f2bf(a);
        else ((bf16_t*)(P.ws + WS_VCT))[((size_t)(b * 2 + kvh) * 64 + lane) * 64 + c] = (bf16_t)f2bf(a);
        asm volatile("s_waitcnt lgkmcnt(0)" ::: "memory");
    }
}

constexpr int A_TILE = 32768, A_IMP = 3 * A_TILE, A_IMPS = A_IMP + 8 * 32 * 33 * 4, A_SEL = A_IMPS + 2 * 32 * 33 * 4;
static_assert(A_SEL + 256 <= LDS_XB, "attention LDS map");
#define ATT_BAR() do { asm volatile("s_waitcnt lgkmcnt(0)" ::: "memory"); __builtin_amdgcn_s_barrier(); asm volatile("" ::: "memory"); } while (0)

struct TileSrc { const bf16_t* kb; const bf16_t* v0; const bf16_t* v1; unsigned kpitch, vpitch; };
__device__ __forceinline__ TileSrc attn_tile_src(const Params& P, int b, int T, int n_slc, int lo) {
    TileSrc s;
    if (T == 0) { s.kb = (const bf16_t*)(P.ws + WS_KC) + (size_t)b * 64 * 128; s.v0 = (const bf16_t*)(P.ws + WS_VCT) + (size_t)(b * 2) * 4096; s.v1 = s.v0 + 4096; s.kpitch = 128; s.vpitch = 64; }
    else {
        const bool slc = T <= n_slc; const int j = slc ? T - 1 : lo + (T - 1 - n_slc), br = slc ? 1 : 2;
        s.kb = (const bf16_t*)(P.ws + WS_ACT) + ((size_t)b * SEQ + 64 * j) * NIN + LK + 128 * br;
        s.v0 = (const bf16_t*)(P.ws + WS_VT) + ((size_t)(b * 6 + 2 * br) * 64) * SEQ + 64 * j; s.v1 = s.v0 + (size_t)64 * SEQ; s.kpitch = NIN; s.vpitch = SEQ;
    }
    return s;
}
__device__ __forceinline__ void attn_dma(LAS unsigned char* buf, const TileSrc& s, int wave, int lane_in) {
    int lane = lane_in; asm volatile("" : "+v"(lane));
    const int r = 8 * wave + (lane >> 3), ch = (lane & 7) ^ (lane >> 3);
#pragma unroll
    for (int i = 0; i < 2; ++i) {
        __builtin_amdgcn_global_load_lds((const unsigned*)(s.kb + (size_t)r * s.kpitch + i * 64 + ch * 8), (LAS unsigned*)(buf + (wave + 8 * i) * 1024), 16, 0, 0);
        __builtin_amdgcn_global_load_lds((const unsigned*)((i ? s.v1 : s.v0) + (size_t)r * s.vpitch + ch * 8), (LAS unsigned*)(buf + 16384 + (wave + 8 * i) * 1024), 16, 0, 0);
    }
}

constexpr float ATT_M0 = -30.f, ATT_THR = 12.f;
template <int MODE>
__device__ __forceinline__ void attn_tile(const LAS unsigned char* Kg, const LAS unsigned char* Vg, const bf16x8 (&qf)[2][2], f32x4 (&O)[4][2], float (&mrun)[2], float (&lrun)[2], f32x4 (&s)[2][4],
                                          int lane_in, int kbase, const int (&qpos)[2], const float (&cinit)[2], bool emask) {
    int lane = lane_in; asm volatile("" : "+v"(lane));
    const int lr = lane & 15, grp = lane >> 4, sw = lr & 7;
    const float c0[2] = {cinit[0] - mrun[0], cinit[1] - mrun[1]};
#pragma unroll
    for (int kt = 0; kt < 4; ++kt) {
        const bf16x8 k0 = *(const LAS bf16x8*)(Kg + (16 * kt + lr) * 128 + ((grp ^ sw) << 4));
        const bf16x8 k1 = *(const LAS bf16x8*)(Kg + (16 * kt + lr) * 128 + (((4 + grp) ^ sw) << 4));
#pragma unroll
        for (int qt = 0; qt < 2; ++qt) {
            const f32x4 a = __builtin_amdgcn_mfma_f32_16x16x32_bf16(k0, qf[qt][0], (f32x4){c0[qt], c0[qt], c0[qt], c0[qt]}, 0, 0, 0);
            s[qt][kt] = __builtin_amdgcn_mfma_f32_16x16x32_bf16(k1, qf[qt][1], a, 0, 0, 0);
        }
    }
    bf16x8 vf[2][4];
#pragma unroll
    for (int c2 = 0; c2 < 2; ++c2)
#pragma unroll
        for (int dt = 0; dt < 4; ++dt) {
            const LAS unsigned char* vr = Vg + (16 * dt + lr) * 128 + 8 * (grp & 1);
            const u32x2 lo = *(const LAS u32x2*)(vr + (((4 * c2 + (grp >> 1)) ^ sw) << 4));
            const u32x2 hi = *(const LAS u32x2*)(vr + (((4 * c2 + 2 + (grp >> 1)) ^ sw) << 4));
            const u32x4 vv = {lo.x, lo.y, hi.x, hi.y};
            vf[c2][dt] = __builtin_bit_cast(bf16x8, vv);
        }
    if (emask) {
#pragma unroll
        for (int qt = 0; qt < 2; ++qt)
#pragma unroll
            for (int kt = 0; kt < 4; ++kt)
#pragma unroll
                for (int r = 0; r < 4; ++r) {
                    const int key = 16 * kt + 4 * grp + r;
                    bool valid;
                    if (MODE == 0) valid = key < ((qpos[qt] + 1) >> 5);
                    else if (MODE == 1) valid = (kbase + key <= qpos[qt]);
                    else { const int kp = kbase + key; valid = (kp <= qpos[qt]) && (kp > qpos[qt] - 512); }
                    s[qt][kt][r] = valid ? s[qt][kt][r] : NEGBIG;
                }
    }
    float mx[2];
#pragma unroll
    for (int qt = 0; qt < 2; ++qt) {
#define FMX(a, b) __builtin_amdgcn_fmed3f((a), (b), __builtin_inff())
        float m0 = FMX(FMX(s[qt][0][0], s[qt][0][1]), FMX(s[qt][0][2], s[qt][0][3]));
#pragma unroll
        for (int kt = 1; kt < 4; ++kt) m0 = FMX(m0, FMX(FMX(s[qt][kt][0], s[qt][kt][1]), FMX(s[qt][kt][2], s[qt][kt][3])));
        m0 = FMX(m0, __shfl_xor(m0, 16)); mx[qt] = FMX(m0, __shfl_xor(m0, 32));
#undef FMX
    }
    if (__any((int)(fmaxf(mx[0], mx[1]) > ATT_THR))) {
#pragma unroll
        for (int qt = 0; qt < 2; ++qt) {
            const float delta = fmaxf(mx[qt], 0.f), f = __builtin_amdgcn_exp2f(-delta);
            mrun[qt] += delta; lrun[qt] *= f;
#pragma unroll
            for (int dt = 0; dt < 4; ++dt) O[dt][qt] *= f;
#pragma unroll
            for (int kt = 0; kt < 4; ++kt) s[qt][kt] -= delta;
        }
    }
#pragma unroll
    for (int qt = 0; qt < 2; ++qt) {
        float ls = 0.f;
#pragma unroll
        for (int kt = 0; kt < 4; ++kt)
#pragma unroll
            for (int r = 0; r < 4; ++r) { const float p = __builtin_amdgcn_exp2f(s[qt][kt][r]); s[qt][kt][r] = p; ls += p; }
        lrun[qt] += ls;
#pragma unroll
        for (int c2 = 0; c2 < 2; ++c2) {
            u32x4 w; w.x = cvt_pk_bf16(s[qt][2 * c2][0], s[qt][2 * c2][1]); w.y = cvt_pk_bf16(s[qt][2 * c2][2], s[qt][2 * c2][3]);
            w.z = cvt_pk_bf16(s[qt][2 * c2 + 1][0], s[qt][2 * c2 + 1][1]); w.w = cvt_pk_bf16(s[qt][2 * c2 + 1][2], s[qt][2 * c2 + 1][3]);
            const bf16x8 pf = __builtin_bit_cast(bf16x8, w);
#pragma unroll
            for (int dt = 0; dt < 4; ++dt) O[dt][qt] = __builtin_amdgcn_mfma_f32_16x16x32_bf16(vf[c2][dt], pf, O[dt][qt], 0, 0, 0);
        }
    }
}

__device__ __forceinline__ void attn_unit(const Params& P, LAS unsigned char* lds, int b, int qb32, int tid, int lane, int wave) {
    asm volatile("" : "+v"(tid), "+v"(lane));
    const bf16_t* ACT = (const bf16_t*)(P.ws + WS_ACT); bf16_t* AB = (bf16_t*)(P.ws + WS_AB);
    const int lr = lane & 15, grp = lane >> 4, g = wave >> 2;
    const int t0 = 32 * qb32, qblk = t0 >> 6; const size_t row0 = (size_t)b * SEQ + t0;
    const int n_slc = qblk + 1, lo = (t0 - 511 > 0) ? ((t0 - 511) >> 6) : 0, NT = 1 + n_slc + (qblk - lo + 1);
    LAS float* IMP = (LAS float*)(lds + A_IMP); LAS float* IMPS = (LAS float*)(lds + A_IMPS); LAS unsigned* SEL = (LAS unsigned*)(lds + A_SEL);
    bf16x8 qf[2][2]; int qpos[2]; float gate[2][3];
#pragma unroll
    for (int qt = 0; qt < 2; ++qt) {
        const size_t row = row0 + 16 * qt + lr; qpos[qt] = t0 + 16 * qt + lr;
#pragma unroll
        for (int ks = 0; ks < 2; ++ks) qf[qt][ks] = *(const bf16x8*)(ACT + row * NIN + LQ + 64 * wave + 32 * ks + 8 * grp);
#pragma unroll
        for (int br = 0; br < 3; ++br) gate[qt][br] = bf2f(ACT[row * NIN + LNSA + 3 * wave + br]);
    }
    f32x4 O[4][2], OA[4][2], s[2][4]; float mrun[2], lrun[2]; unsigned selm[2] = {0u, 0u};
#pragma unroll
    for (int dt = 0; dt < 4; ++dt)
#pragma unroll
        for (int qt = 0; qt < 2; ++qt) { O[dt][qt] = (f32x4){0.f, 0.f, 0.f, 0.f}; OA[dt][qt] = (f32x4){0.f, 0.f, 0.f, 0.f}; }
    mrun[0] = mrun[1] = ATT_M0; lrun[0] = lrun[1] = 0.f;
#define ATT_FINISH(br) do { _Pragma("unroll") for (int qt = 0; qt < 2; ++qt) { float lt = lrun[qt]; lt += __shfl_xor(lt, 16); lt += __shfl_xor(lt, 32); \
        const float f = (lt > 0.f) ? gate[qt][br] / lt : 0.f; _Pragma("unroll") for (int dt = 0; dt < 4; ++dt) { OA[dt][qt] += O[dt][qt] * f; O[dt][qt] = (f32x4){0.f, 0.f, 0.f, 0.f}; } \
        mrun[qt] = ATT_M0; lrun[qt] = 0.f; } } while (0)
    const float czero[2] = {0.f, 0.f};
    ATT_BAR();
    { const TileSrc s0 = attn_tile_src(P, b, 0, n_slc, lo); attn_dma(lds, s0, wave, lane); }
    { const TileSrc s1 = attn_tile_src(P, b, 1, n_slc, lo); attn_dma(lds + A_TILE, s1, wave, lane); }
    asm volatile("s_waitcnt vmcnt(4)" ::: "memory");
    ATT_BAR();
    { const TileSrc s2 = attn_tile_src(P, b, 2, n_slc, lo); attn_dma(lds + 2 * A_TILE, s2, wave, lane); }
    {
        attn_tile<0>(lds + g * 8192, lds + 16384 + g * 8192, qf, O, mrun, lrun, s, lane, 0, qpos, czero, true);
#pragma unroll
        for (int qt = 0; qt < 2; ++qt) {
            float lt = lrun[qt]; lt += __shfl_xor(lt, 16); lt += __shfl_xor(lt, 32);
            const float inv = (lt > 0.f) ? 1.0f / lt : 0.f;
#pragma unroll
            for (int kt = 0; kt < 4; ++kt)
#pragma unroll
                for (int rr = 0; rr < 2; ++rr) IMP[(wave * 32 + 16 * qt + lr) * 33 + 8 * kt + 2 * grp + rr] = (s[qt][kt][2 * rr] + s[qt][kt][2 * rr + 1]) * inv;
        }
        ATT_FINISH(0);
        ATT_BAR();
        for (int i = tid; i < 2 * 32 * 32; i += 512) { const int gg = i >> 10, q = (i >> 5) & 31, j = i & 31;
            IMPS[(gg * 32 + q) * 33 + j] = (IMP[((4 * gg + 0) * 32 + q) * 33 + j] + IMP[((4 * gg + 1) * 32 + q) * 33 + j]) + (IMP[((4 * gg + 2) * 32 + q) * 33 + j] + IMP[((4 * gg + 3) * 32 + q) * 33 + j]); }
        ATT_BAR();
        if (tid < 64) {
            const int gg = tid >> 5, q = tid & 31;
            unsigned mask = 1u | (1u << qblk);
            if (qblk - 1 <= 6) mask = (qblk >= 31) ? 0xffffffffu : ((2u << qblk) - 1u);
            else {
                const LAS float* v = IMPS + (gg * 32 + q) * 33;
                for (int pick = 0; pick < 6; ++pick) { float best = -1.f; int bi = 1;
                    for (int j = 1; j < qblk; ++j) { const float x = v[j]; if (!((mask >> j) & 1u) && x > best) { best = x; bi = j; } }
                    mask |= 1u << bi; }
            }
            SEL[gg * 32 + q] = mask;
        }
        asm volatile("s_waitcnt vmcnt(4)" ::: "memory");
        ATT_BAR();
        selm[0] = SEL[g * 32 + lr]; selm[1] = SEL[g * 32 + 16 + lr];
    }
    int cur = 1, nxt = 0;
    for (int T = 1; T < NT; ++T) {
        const bool more = T + 2 < NT;
        if (more) { const TileSrc sn = attn_tile_src(P, b, T + 2, n_slc, lo); attn_dma(lds + nxt * A_TILE, sn, wave, lane); }
        const LAS unsigned char* Kg = lds + cur * A_TILE + g * 8192; const LAS unsigned char* Vg = Kg + 16384;
        if (T <= n_slc) {
            const int jb = T - 1;
            const float cin[2] = {((selm[0] >> jb) & 1u) ? 0.f : NEGBIG, ((selm[1] >> jb) & 1u) ? 0.f : NEGBIG};
            attn_tile<1>(Kg, Vg, qf, O, mrun, lrun, s, lane, 64 * jb, qpos, cin, jb == qblk);
            if (T == n_slc) ATT_FINISH(1);
        } else {
            const int jt = lo + (T - 1 - n_slc);
            const bool em = (64 * jt + 63 > t0) || (64 * jt <= t0 + 31 - 512);
            attn_tile<2>(Kg, Vg, qf, O, mrun, lrun, s, lane, 64 * jt, qpos, czero, em);
            if (T == NT - 1) ATT_FINISH(2);
        }
        if (more) asm volatile("s_waitcnt vmcnt(4)" ::: "memory"); else asm volatile("s_waitcnt vmcnt(0)" ::: "memory");
        ATT_BAR();
        cur = (cur == 2) ? 0 : cur + 1; nxt = (nxt == 2) ? 0 : nxt + 1;
    }
#undef ATT_FINISH
#pragma unroll
    for (int qt = 0; qt < 2; ++qt) {
        const size_t row = row0 + 16 * qt + lr;
#pragma unroll
        for (int dt = 0; dt < 4; ++dt) {
            const int col = 64 * wave + 16 * dt + 4 * grp;
            float za[4]; unpack4(*(const u32x2*)(ACT + row * NIN + LZA + col), za);
            u32x2 w; w.x = cvt_pk_bf16(OA[dt][qt][0] * za[0], OA[dt][qt][1] * za[1]); w.y = cvt_pk_bf16(OA[dt][qt][2] * za[2], OA[dt][qt][3] * za[3]);
            *(u32x2*)(AB + row * DM + col) = w;
        }
    }
}

constexpr int G_ST = 0, G_VNT = 1024, VPITCH = 136;
__device__ __forceinline__ void gmlp_unit(const Params& P, LAS unsigned char* lds, int b, int ch, int gp, int tid, int lane, int wave) {
    asm volatile("" : "+v"(tid), "+v"(lane));
    const bf16_t* ACT = (const bf16_t*)(P.ws + WS_ACT); bf16_t* AB = (bf16_t*)(P.ws + WS_AB);
    LAS f32x2* ST = (LAS f32x2*)(lds + G_ST); LAS bf16_t* Vnt = (LAS bf16_t*)(lds + G_VNT);
    const size_t R0 = (size_t)b * SEQ + 128 * ch;
    __syncthreads();
    {
        u32x4 raw[16];
#pragma unroll
        for (int i = 0; i < 16; ++i) raw[i] = *(const u32x4*)(ACT + (R0 + wave + 8 * i) * NIN + LVB + 8 * lane);
#pragma unroll
        for (int i = 0; i < 16; ++i) {
            float f[8]; f[0] = bf2f(raw[i].x); f[1] = bf2f(raw[i].x >> 16); f[2] = bf2f(raw[i].y); f[3] = bf2f(raw[i].y >> 16); f[4] = bf2f(raw[i].z); f[5] = bf2f(raw[i].z >> 16); f[6] = bf2f(raw[i].w); f[7] = bf2f(raw[i].w >> 16);
            float sm = 0.f, sq = 0.f;
#pragma unroll
            for (int e = 0; e < 8; ++e) { sm += f[e]; sq += f[e] * f[e]; }
#pragma unroll
            for (int o = 1; o < 64; o <<= 1) { sm += __shfl_xor(sm, o); sq += __shfl_xor(sq, o); }
            const float mean = sm * (1.0f / 512.0f), var = fmaxf(sq * (1.0f / 512.0f) - mean * mean, 0.f);
            if (lane == 0) ST[wave + 8 * i] = (f32x2){mean, rsqrtf(var + 1e-6f)};
        }
    }
    __syncthreads();
    {
        const float* vg = P.in[21] + 256 * gp; const float* vb = P.in[22] + 256 * gp;
        u32x4 raw[4][2];
#pragma unroll
        for (int i = 0; i < 4; ++i) { const int idx = tid + 512 * i, j2 = idx & 63, chn = idx >> 6;
#pragma unroll
            for (int h2 = 0; h2 < 2; ++h2) raw[i][h2] = *(const u32x4*)(ACT + (R0 + 2 * j2 + h2) * NIN + LVB + 256 * gp + 8 * chn); }
#pragma unroll
        for (int i = 0; i < 4; ++i) {
            const int idx = tid + 512 * i, j2 = idx & 63, chn = idx >> 6;
            const f32x2 st0 = ST[2 * j2], st1 = ST[2 * j2 + 1];
            const unsigned w0[4] = {raw[i][0].x, raw[i][0].y, raw[i][0].z, raw[i][0].w}, w1[4] = {raw[i][1].x, raw[i][1].y, raw[i][1].z, raw[i][1].w};
#pragma unroll
            for (int e = 0; e < 8; ++e) { const int d = 8 * chn + e;
                const float a = bf2f(w0[e >> 1] >> (16 * (e & 1))), b2 = bf2f(w1[e >> 1] >> (16 * (e & 1)));
                *(LAS unsigned*)(Vnt + d * VPITCH + 2 * j2) = cvt_pk_bf16((a - st0[0]) * st0[1] * vg[d] + vb[d], (b2 - st1[0]) * st1[1] * vg[d] + vb[d]); }
        }
    }
    __syncthreads();
    const int lr = lane & 15, grp = lane >> 4, g = 2 * gp + (wave >> 2);
    const bf16_t* tril = (const bf16_t*)(P.ws + WS_TRIL) + (size_t)g * 128 * 128;
    f32x4 acc[2][8];
#pragma unroll
    for (int t2 = 0; t2 < 2; ++t2)
#pragma unroll
        for (int it = 0; it < 8; ++it) acc[t2][it] = (f32x4){0.f, 0.f, 0.f, 0.f};
#pragma unroll
    for (int ks = 0; ks < 4; ++ks) {
        const bf16x8 af0 = *(const LAS bf16x8*)(Vnt + (32 * wave + lr) * VPITCH + 32 * ks + 8 * grp);
        const bf16x8 af1 = *(const LAS bf16x8*)(Vnt + (32 * wave + 16 + lr) * VPITCH + 32 * ks + 8 * grp);
#pragma unroll
        for (int it = 0; it < 8; ++it) {
            if ((it >> 1) >= ks) { const bf16x8 bfr = *(const bf16x8*)(tril + (size_t)(16 * it + lr) * 128 + 32 * ks + 8 * grp);
                acc[0][it] = __builtin_amdgcn_mfma_f32_16x16x32_bf16(af0, bfr, acc[0][it], 0, 0, 0); acc[1][it] = __builtin_amdgcn_mfma_f32_16x16x32_bf16(af1, bfr, acc[1][it], 0, 0, 0); }
        }
    }
    const float* bs = P.in[24] + 128 * g;
#pragma unroll
    for (int it = 0; it < 8; ++it) {
        const int i = 16 * it + lr; const size_t row = R0 + i;
        const float bsi = bs[i];
#pragma unroll
        for (int t2 = 0; t2 < 2; ++t2) {
            const int d0 = 256 * gp + 32 * wave + 16 * t2 + 4 * grp;
            float uu[4], zb[4]; unpack4(*(const u32x2*)(ACT + row * NIN + LU + d0), uu); unpack4(*(const u32x2*)(ACT + row * NIN + LZB + d0), zb);
            u32x2 w; w.x = cvt_pk_bf16(uu[0] * (acc[t2][it][0] + bsi) * zb[0], uu[1] * (acc[t2][it][1] + bsi) * zb[1]); w.y = cvt_pk_bf16(uu[2] * (acc[t2][it][2] + bsi) * zb[2], uu[3] * (acc[t2][it][3] + bsi) * zb[3]);
            *(u32x2*)(AB + row * DM + 512 + d0) = w;
        }
    }
}

__device__ __forceinline__ void stile(const float* kb, const float* vb, int stride, int kmin, const f32x4 (&q4)[4], float (&m)[4], float (&l)[4], f32x4 (&o4)[4], float (&pout)[4], int lane_in) {
    int lane = lane_in; asm volatile("" : "+v"(lane));
    const int li = lane & 15, gq = lane >> 4;
    __builtin_amdgcn_sched_barrier(0);
    const float* kl = kb + (size_t)(gq * stride + 4 * li); const float* vl = vb + (size_t)(gq * stride + 4 * li);
    f32x4 kreg[16], vreg[16];
#pragma unroll
    for (int i = 0; i < 16; ++i) kreg[i] = __builtin_nontemporal_load((const f32x4*)(kl + (size_t)(4 * i) * stride));
#pragma unroll
    for (int i = 0; i < 16; ++i) vreg[i] = __builtin_nontemporal_load((const f32x4*)(vl + (size_t)(4 * i) * stride));
    float sc[4];
#pragma unroll
    for (int h = 0; h < 4; ++h) {
        float v[16], w8[8], w4[4], w2[2];
#pragma unroll
        for (int i = 0; i < 16; ++i) v[i] = (kreg[i][0] * q4[h][0] + kreg[i][1] * q4[h][1]) + (kreg[i][2] * q4[h][2] + kreg[i][3] * q4[h][3]);
#pragma unroll
        for (int t = 0; t < 8; ++t) { const float snd = (li & 8) ? v[t] : v[t + 8], kp = (li & 8) ? v[t + 8] : v[t]; w8[t] = kp + __shfl_xor(snd, 8); }
#pragma unroll
        for (int t = 0; t < 4; ++t) { const float snd = (li & 4) ? w8[t] : w8[t + 4], kp = (li & 4) ? w8[t + 4] : w8[t]; w4[t] = kp + __shfl_xor(snd, 4); }
#pragma unroll
        for (int t = 0; t < 2; ++t) { const float snd = (li & 2) ? w4[t] : w4[t + 2], kp = (li & 2) ? w4[t + 2] : w4[t]; w2[t] = kp + __shfl_xor(snd, 2); }
        { const float snd = (li & 1) ? w2[0] : w2[1], kp = (li & 1) ? w2[1] : w2[0]; sc[h] = kp + __shfl_xor(snd, 1); }
        __builtin_amdgcn_sched_barrier(0);
    }
    const bool valid = (4 * li + gq) >= kmin;
#pragma unroll
    for (int h = 0; h < 4; ++h) {
        const float sv = valid ? sc[h] : NEGBIG;
        const float mnew = fmaxf(m[h], wave_max(sv));
        const float alpha = __builtin_amdgcn_exp2f(m[h] - mnew), p = __builtin_amdgcn_exp2f(sv - mnew);
        l[h] = l[h] * alpha + wave_sum(p); o4[h] *= alpha; m[h] = mnew; pout[h] = p;
    }
    const int src0 = lane & 48;
#pragma unroll
    for (int i = 0; i < 16; ++i) {
#pragma unroll
        for (int h = 0; h < 4; ++h) o4[h] += vreg[i] * __shfl(pout[h], src0 + i);
    }
    __builtin_amdgcn_sched_barrier(0);
}
__device__ __forceinline__ void skey(const float* kb, const float* vb, const f32x4 (&q4)[4], float (&m)[4], float (&l)[4], f32x4 (&o4)[4], int lane) {
    const int li = lane & 15, gq = lane >> 4;
    const f32x4 kd = *(const f32x4*)(kb + 4 * li), vd = *(const f32x4*)(vb + 4 * li);
#pragma unroll
    for (int h = 0; h < 4; ++h) {
        float sv = (kd[0] * q4[h][0] + kd[1] * q4[h][1]) + (kd[2] * q4[h][2] + kd[3] * q4[h][3]);
        sv += __shfl_xor(sv, 1); sv += __shfl_xor(sv, 2); sv += __shfl_xor(sv, 4); sv += __shfl_xor(sv, 8);
        const float mnew = fmaxf(m[h], sv), alpha = __builtin_amdgcn_exp2f(m[h] - mnew), p = __builtin_amdgcn_exp2f(sv - mnew);
        l[h] = l[h] * alpha + p; o4[h] *= alpha; if (gq == 0) o4[h] += vd * p; m[h] = mnew;
    }
}

constexpr int S_ST = 0, S_MISC = 8 * 3 * 4 * 66 * 4;
__device__ __forceinline__ void sample_unit(const Params& P, LAS unsigned char* lds, int sb, int g, int tid, int lane, int wave) {
    const bf16_t* ACT = (const bf16_t*)(P.ws + WS_ACT); bf16_t* AB = (bf16_t*)(P.ws + WS_AB);
    LAS float* ST = (LAS float*)(lds + S_ST); LAS float* MISC = (LAS float*)(lds + S_MISC);
    const size_t row = (size_t)MP + sb;
    const int* ptab = (const int*)P.in[8] + sb * 16;
    const int li = lane & 15;
    __syncthreads();
    f32x4 q4[4];
#pragma unroll
    for (int h = 0; h < 4; ++h) { float t4[4]; unpack4(*(const u32x2*)(ACT + row * NIN + LQ + 64 * (4 * g + h) + 4 * li), t4); q4[h] = (f32x4){t4[0], t4[1], t4[2], t4[3]}; }
    float ms[4], ls[4]; f32x4 os[4];
#define S_RESET() do { _Pragma("unroll") for (int h = 0; h < 4; ++h) { ms[h] = MINIT; ls[h] = 0.f; os[h] = (f32x4){0.f, 0.f, 0.f, 0.f}; } } while (0)
#define S_PUBLISH(b2, doit) do { _Pragma("unroll") for (int h = 0; h < 4; ++h) { f32x4 v = os[h]; \
        _Pragma("unroll") for (int e = 0; e < 4; ++e) { float x = v[e]; x += __shfl_xor(x, 16); x += __shfl_xor(x, 32); v[e] = x; } \
        if (doit) { LAS float* st = ST + ((wave * 3 + (b2)) * 4 + h) * 66; if (lane < 16) *(LAS f32x4*)(st + 4 * lane) = v; if (lane == 0) { st[64] = ms[h]; st[65] = ls[h]; } } } } while (0)
    float pdummy[4], pc[4];
    S_RESET();
    { const size_t off = (((size_t)sb * 512 + 64 * wave) * 2 + g) * 64; stile(P.in[6] + off, P.in[7] + off, 128, (wave == 0) ? 1 : 0, q4, ms, ls, os, pdummy, lane); }
    if (wave == 0) { const size_t off = ((size_t)(sb * 512 + 511) * 2 + g) * 64; skey(P.out + O_SKW + off, P.out + O_SVW + off, q4, ms, ls, os, lane); }
    S_PUBLISH(1, true);
    S_RESET();
    stile((const float*)(P.ws + WS_KCS) + (size_t)(sb * 2 + g) * 4096, (const float*)(P.ws + WS_VCS) + (size_t)(sb * 2 + g) * 4096, 64, 0, q4, ms, ls, os, pc, lane);
    float imp = 0.f;
#pragma unroll
    for (int h = 0; h < 4; ++h) { const float pn = pc[h] / ls[h]; imp += pn + __shfl_down(pn, 16); }
    S_PUBLISH(2, wave == 0);
    const int jblk = 2 * li + (lane >> 5);
    const bool cand = ((lane >> 4) & 1) == 0 && jblk >= 1;
    unsigned key = cand ? ((__builtin_bit_cast(unsigned, imp) & 0xffffffe0u) | (unsigned)(31 - jblk)) : 0u;
    unsigned long long selpack = 0ull;
#pragma unroll
    for (int pick = 0; pick < 6; ++pick) {
        unsigned best = key;
#pragma unroll
        for (int o2 = 1; o2 < 64; o2 <<= 1) { const unsigned other = (unsigned)__shfl_xor((int)best, o2); best = other > best ? other : best; }
        const int bj = 31 - (int)(best & 31u);
        selpack |= (unsigned long long)bj << (5 * (pick + 1));
        if (cand && jblk == bj) key = 0u;
    }
    S_RESET();
    if (wave < 7) { const int blk = (int)((selpack >> (5 * wave)) & 31ull); const int page = __builtin_amdgcn_readfirstlane(ptab[blk >> 1]); const size_t off = (((size_t)page * 128 + (blk & 1) * 64) * 2 + g) * 64;
        stile(P.in[4] + off, P.in[5] + off, 128, 0, q4, ms, ls, os, pdummy, lane); }
    else skey(P.out + O_SKS + (size_t)sb * 128 + g * 64, P.out + O_SVS + (size_t)sb * 128 + g * 64, q4, ms, ls, os, lane);
    S_PUBLISH(0, true);
#undef S_RESET
#undef S_PUBLISH
    if (wave == 7) {
        const u32x4 raw = *(const u32x4*)(ACT + row * NIN + LVB + 8 * lane);
        float f[8]; f[0] = bf2f(raw.x); f[1] = bf2f(raw.x >> 16); f[2] = bf2f(raw.y); f[3] = bf2f(raw.y >> 16); f[4] = bf2f(raw.z); f[5] = bf2f(raw.z >> 16); f[6] = bf2f(raw.w); f[7] = bf2f(raw.w >> 16);
        float sm = 0.f;
#pragma unroll
        for (int i = 0; i < 8; ++i) sm += f[i];
        const float mean = wave_sum(sm) * (1.0f / 512.0f); float sq = 0.f;
#pragma unroll
        for (int i = 0; i < 8; ++i) { const float d = f[i] - mean; sq += d * d; }
        const float rstd = rsqrtf(wave_sum(sq) * (1.0f / 512.0f) + 1e-6f);
        if (lane == 0) { MISC[0] = mean; MISC[1] = rstd; }
    }
    __syncthreads();
    if (wave < 4) {
        const int h = wave, head = 4 * g + h;
        const LAS float* stc = ST + ((0 * 3 + 2) * 4 + h) * 66;
        float oa = bf2f(ACT[row * NIN + LNSA + 3 * head + 0]) * stc[lane] / stc[65];
#pragma unroll
        for (int b2 = 0; b2 < 2; ++b2) {
            float M = MINIT;
#pragma unroll
            for (int w = 0; w < 8; ++w) M = fmaxf(M, ST[((w * 3 + b2) * 4 + h) * 66 + 64]);
            float L = 0.f, O = 0.f;
#pragma unroll
            for (int w = 0; w < 8; ++w) { const LAS float* st = ST + ((w * 3 + b2) * 4 + h) * 66; const float f = __builtin_amdgcn_exp2f(st[64] - M); L += st[65] * f; O += st[lane] * f; }
            oa += bf2f(ACT[row * NIN + LNSA + 3 * head + 1 + b2]) * O / L;
        }
        const int col = 64 * head + lane;
        AB[row * DM + col] = (bf16_t)f2bf(oa * bf2f(ACT[row * NIN + LZA + col]));
    }
    if (tid < 256) {
        const int d = 256 * g + tid, gm = d >> 7;
        const float vn = (bf2f(ACT[row * NIN + LVB + d]) - MISC[0]) * MISC[1] * P.in[21][d] + P.in[22][d];
        P.out[O_SVCH + (size_t)sb * 512 + d] = vn;
        const float sv = P.in[23][(size_t)gm * 128 * 128] * vn + P.in[24][gm * 128];
        AB[row * DM + 512 + d] = (bf16_t)f2bf(bf2f(ACT[row * NIN + LU + d]) * sv * bf2f(ACT[row * NIN + LZB + d]));
    }
}

template <int MODE>
__device__ __forceinline__ void small_gemm(const Params& P, int c, int G, int wave, int lane) {
    const int lr = lane & 15, grp = lane >> 4;
    for (int t = c + G * wave; t < 512; t += G * 8) {
        const int rt = t & 7, ct = t >> 3;
        const size_t row = (size_t)MP + 16 * rt + lr;
        const bf16_t* A = (const bf16_t*)(P.ws + (MODE == 0 ? WS_AB : WS_H)) + row * DM + 8 * grp;
        const int wrow = (MODE == 0) ? (256 * (ct >> 4) + 128 * ((ct >> 1) & 1) + 32 * ((ct >> 2) & 3) + 16 * (ct & 1) + lr) : (16 * ct + lr);
        const bf16_t* W = (const bf16_t*)(P.ws + (MODE == 0 ? WS_WTBR : WS_WTOUT)) + (size_t)wrow * DM + 8 * grp;
        f32x4 acc0 = (f32x4){0.f, 0.f, 0.f, 0.f}, acc1 = (f32x4){0.f, 0.f, 0.f, 0.f};
#pragma unroll
        for (int ks = 0; ks < 16; ++ks) acc0 = __builtin_amdgcn_mfma_f32_16x16x32_bf16(*(const bf16x8*)(W + 32 * ks), *(const bf16x8*)(A + 32 * ks), acc0, 0, 0, 0);
#pragma unroll
        for (int ks = 16; ks < 32; ++ks) acc1 = __builtin_amdgcn_mfma_f32_16x16x32_bf16(*(const bf16x8*)(W + 32 * ks), *(const bf16x8*)(A + 32 * ks), acc1, 0, 0, 0);
        const int col = 16 * ct + 4 * grp;
        if (MODE == 0) {
            const int i = 16 * rt + lr, cc = col & 255;
            const size_t go = ((size_t)(((64 * 8 + (col >> 8)) * 8 + (i >> 6) * 4 + (cc >> 6)) * 32 + ((((i >> 4) & 3) * 2 + ((cc >> 5) & 1)) * 2 + ((cc >> 4) & 1))) * 64 + ((cc >> 2) & 3) * 16 + (i & 15)) * 4;
            const bf16_t* GB = (const bf16_t*)(P.ws + WS_GBUF);
            float sa[4], sb[4]; unpack4(*(const u32x2*)(GB + go), sa); unpack4(*(const u32x2*)(GB + go + (size_t)4 * 8 * 32 * 256), sb);
            u32x2 w; w.x = cvt_pk_bf16(sa[0] * acc0[0] + sb[0] * acc1[0], sa[1] * acc0[1] + sb[1] * acc1[1]); w.y = cvt_pk_bf16(sa[2] * acc0[2] + sb[2] * acc1[2], sa[3] * acc0[3] + sb[3] * acc1[3]);
            *(u32x2*)((bf16_t*)(P.ws + WS_H) + row * DM + col) = w;
        } else {
            const int sbi = 16 * rt + lr;
            const f32x4 xv = *(const f32x4*)(P.in[1] + (size_t)sbi * DM + col), gv = *(const f32x4*)((const float*)(P.ws + WS_MOD) + (size_t)(8 + sbi) * 3072 + 2048 + col);
            *(f32x4*)(P.out + O_YS + (size_t)sbi * DM + col) = xv + gv * (acc0 + acc1);
        }
    }
}

#define XB_TMO      128
#define XB_XCNT(j)  (256  + 64 * (j))
#define XB_XSUB(j)  (1280 + 64 * (j))
#define XB_XGEN(j)  (2304 + 64 * (j))
#define XB_TOP      3328
#define XB_TOPGEN   3392
#define XCD_BAR_WORDS 3456
#define XB_SPIN_CAP (1u << 18)
__device__ __forceinline__ unsigned xb_ld(unsigned* p)              { return __hip_atomic_load(p, __ATOMIC_RELAXED, __HIP_MEMORY_SCOPE_AGENT); }
__device__ __forceinline__ unsigned xb_add(unsigned* p, unsigned v) { return __hip_atomic_fetch_add(p, v, __ATOMIC_RELAXED, __HIP_MEMORY_SCOPE_AGENT); }
__device__ __forceinline__ unsigned xb_xcc_id() { return (unsigned)__builtin_amdgcn_s_getreg((3 << 11) | 20) & 0xFu; }
#define XB_SPIN(cond, bar) do { unsigned _sp = 0; while (cond) { __builtin_amdgcn_s_sleep(1); \
    if ((++_sp & 255u) == 0u) { if (xb_ld(&(bar)[XB_TMO])) break; if (_sp > XB_SPIN_CAP) { atomicAdd(&(bar)[XB_TMO], 1u); break; } } } } while (0)
struct XcdBarrier { unsigned* bar; unsigned x; volatile LAS unsigned* st; };
__device__ __forceinline__ XcdBarrier xcd_barrier_post(unsigned* bar, volatile LAS unsigned* st) {
    XcdBarrier b; b.bar = bar; b.x = xb_xcc_id(); b.st = st;
    if (threadIdx.x == 0) (void)xb_add(&bar[XB_XCNT(b.x)], 1u);
    return b;
}
__device__ __forceinline__ void xcd_barrier_complete(unsigned* bar, unsigned x, unsigned& nloc, unsigned& nx) {
    const unsigned G = gridDim.x * gridDim.y * gridDim.z;
    unsigned sum, cnt, mine, sp = 0u;
    for (;;) {
        sum = 0u; cnt = 0u; mine = 0u;
#pragma unroll
        for (unsigned j = 0; j < 16; ++j) { const unsigned c = xb_ld(&bar[XB_XCNT(j)]); sum += c; cnt += (c > 0u) ? 1u : 0u; mine = (j == x) ? c : mine; }
        if (sum == G) break;
        __builtin_amdgcn_s_sleep(1);
        if ((++sp & 255u) == 0u) { if (xb_ld(&bar[XB_TMO])) break; if (sp > XB_SPIN_CAP) { atomicAdd(&bar[XB_TMO], 1u); break; } }
    }
    nloc = mine > 0u ? mine : 1u; nx = cnt > 0u ? cnt : 1u;
}
__device__ __forceinline__ void xcd_barrier(const XcdBarrier& b) {
    asm volatile("s_waitcnt vmcnt(0)" ::: "memory");
    __syncthreads();
    if (threadIdx.x == 0) {
        unsigned* bar = b.bar;
        __builtin_amdgcn_s_waitcnt(0);
        unsigned nloc = b.st[0], nx = b.st[1];
        if (nloc == 0u) { xcd_barrier_complete(bar, b.x, nloc, nx); b.st[0] = nloc; b.st[1] = nx; }
        const unsigned old = xb_add(&bar[XB_XSUB(b.x)], 1u);
        const unsigned gen = old / nloc;
        if (old + 1u == (gen + 1u) * nloc) {
            __builtin_amdgcn_fence(__ATOMIC_RELEASE, "agent");
            asm volatile("s_waitcnt vmcnt(0)" ::: "memory");
            const unsigned og = xb_add(&bar[XB_TOP], 1u);
            const unsigned tg = og / nx;
            if (og + 1u == (tg + 1u) * nx) xb_add(&bar[XB_TOPGEN], 1u);
            else XB_SPIN(xb_ld(&bar[XB_TOPGEN]) == tg, bar);
            __builtin_amdgcn_fence(__ATOMIC_ACQUIRE, "agent");
            xb_add(&bar[XB_XGEN(b.x)], 1u);
            asm volatile("s_waitcnt vmcnt(0)" ::: "memory");
        } else {
            XB_SPIN(xb_ld(&bar[XB_XGEN(b.x)]) == gen, bar);
            __builtin_amdgcn_fence(__ATOMIC_ACQUIRE, "agent");
            asm volatile("s_waitcnt vmcnt(0)" ::: "memory");
        }
    }
    __syncthreads();
}

__global__ void __launch_bounds__(512, 2) mk_fwd(Params P) {
    extern __shared__ __attribute__((aligned(16))) unsigned char lds_raw[];
    LAS unsigned char* lds = (LAS unsigned char*)lds_raw;
    const int tid = threadIdx.x, lane = tid & 63, wave = __builtin_amdgcn_readfirstlane(tid >> 6);
    const int G = gridDim.x, c = blockIdx.x, gw = c * 8 + wave, NGW = G * 8, gtid = c * 512 + tid, NT = G * 512;
    cg::grid_group grid = cg::this_grid();
    const int lo = P.ph_lo, hi = P.ph_hi;
    if (tid < 16) ((LAS unsigned*)(lds + LDS_XB))[tid] = 0u;
    __syncthreads();
    const XcdBarrier bar = xcd_barrier_post((unsigned*)(P.ws + WS_CTL), (volatile LAS unsigned*)(lds + LDS_XB));
    if (hi < 0) grid.sync();
#define IN(k) (lo <= (k) && (k) < hi)
#define SEAM(k) do { if (IN(k) && IN((k) + 1)) xcd_barrier(bar); } while (0)
    unsigned char* ws = P.ws;
    if (IN(0)) for (int rep = 0; rep < MK_REP0; ++rep) { p0_prologue(P, lds, gw, NGW, lane, wave, gtid, NT); }
    SEAM(0);
    if (IN(1)) for (int rep = 0; rep < MK_REP1; ++rep) { p1_hrows(P, gw, NGW, lane); }
    SEAM(1);
    if (IN(2)) for (int rep = 0; rep < MK_REP2; ++rep) {
        pg8::Gemm gm{(const bf16_t*)(ws + WS_H), (const bf16_t*)(ws + WS_WTIN), DM, DM, DM};
        pg8::StaticOrder S; S.init(MPAD / 256, NIN / 256, G, c);
        EpiInProj E{(bf16_t*)(ws + WS_ACT), (bf16_t*)(ws + WS_VT), (bf16_t*)(ws + WS_GBUF), P.out, P.in[15], P.in[16], (const float*)(ws + WS_ROPE), lds + LDS_EPI};
        pg8::gemm_phase<EpiInProj, pg8::StaticOrder>(lds, gm, S, E);
        { const int nwg = (MPAD / 256) * (NIN / 256), nlast = nwg % G;
          if (nlast != 0 && c >= nlast) { const int nidle = (G - nlast) * 8, iw = (c - nlast) * 8 + wave;
              for (int u = (1616 + 776) + iw; u < 4096; u += nidle) pool_item(P, (LAS float*)(lds + wave * 16384), u, lane); }
          else if (nlast == 0) { for (int u = (1616 + 776) + gw; u < 4096; u += NGW) pool_item(P, (LAS float*)(lds + wave * 16384), u, lane); } }
    }
    SEAM(2);
    if (IN(3)) for (int rep = 0; rep < MK_REP3; ++rep) { p3_compress(P, lds, gw, NGW, lane, wave); }
    SEAM(3);
    if (IN(4)) for (int rep = 0; rep < MK_REP4; ++rep) {
        asm volatile("" ::: "memory");
        for (int i = 0;; ++i) { const int a = (i & 1) ? (i + 1) * G - 1 - c : i * G + c; if (a >= 512 || a < 0) break; attn_unit(P, lds, a & 7, 63 - (a >> 3), tid, lane, wave); }
        {
            unsigned* qctr = (unsigned*)(ws + WS_CTL) + 3584;
            LAS unsigned* qsl = (LAS unsigned*)(lds + LDS_XB + 32);
            for (;;) {
                __syncthreads();
                if (tid == 0) *qsl = __hip_atomic_fetch_add(qctr, 1u, __ATOMIC_RELAXED, __HIP_MEMORY_SCOPE_AGENT);
                __syncthreads();
                const int u = (int)*qsl;
                if (u >= 512) break;
                if (u < 256) gmlp_unit(P, lds, u >> 5, (u >> 1) & 15, u & 1, tid, lane, wave);
                else { const int su = u - 256; sample_unit(P, lds, su >> 1, su & 1, tid, lane, wave); }
            }
        }
        __syncthreads();
    }
    SEAM(4);
    if (IN(5)) for (int rep = 0; rep < MK_REP5; ++rep) {
        pg8::Gemm gm{(const bf16_t*)(ws + WS_AB), (const bf16_t*)(ws + WS_WTBR), DM, DM, 512};
        small_gemm<0>(P, c, G, wave, lane);
        pg8::PairOrder S; S.S.init(MP / 256, DM / 256, G, c);
        EpiMix E{(const bf16_t*)(ws + WS_GBUF), (bf16_t*)(ws + WS_H)};
        pg8::gemm_phase<EpiMix, pg8::PairOrder>(lds, gm, S, E);
    }
    SEAM(5);
    if (IN(6)) for (int rep = 0; rep < MK_REP6; ++rep) {
        pg8::Gemm gm{(const bf16_t*)(ws + WS_H), (const bf16_t*)(ws + WS_WTOUT), DM, DM, DM};
        small_gemm<1>(P, c, G, wave, lane);
        pg8::StaticOrder S; S.init(MP / 256, DM / 256, G, c);
        EpiOut E{P.in[0], P.in[1], (const float*)(ws + WS_MOD), P.out};
        pg8::gemm_phase<EpiOut, pg8::StaticOrder>(lds, gm, S, E);
    }
#undef IN
#undef SEAM
}

extern "C" void kernel_launch(void* const* d_in, const int* in_sizes, int n_in, void* d_out, int out_size, void* d_ws, size_t ws_size, hipStream_t stream) {
    static int grid = 0;
    if (grid == 0) {
        if (n_in != 28 || out_size != (int)O_END || ws_size < WS_END) { fprintf(stderr, "kernel_launch: unexpected shapes (n_in %d, out %d, ws %zu); nothing launched\n", n_in, out_size, ws_size); grid = -1; return; }
        int dev = 0, cus = 0, per_cu = 0;
        if (hipGetDevice(&dev) != hipSuccess || hipDeviceGetAttribute(&cus, hipDeviceAttributeMultiprocessorCount, dev) != hipSuccess) { grid = -1; return; }
        if (hipFuncSetAttribute((const void*)mk_fwd, hipFuncAttributeMaxDynamicSharedMemorySize, LDS_BYTES) != hipSuccess) { fprintf(stderr, "kernel_launch: hipFuncSetAttribute failed\n"); grid = -1; return; }
        if (hipOccupancyMaxActiveBlocksPerMultiprocessor(&per_cu, (const void*)mk_fwd, 512, LDS_BYTES) != hipSuccess || per_cu < 1) { fprintf(stderr, "kernel_launch: occupancy query failed (%d)\n", per_cu); (void)hipGetLastError(); per_cu = 1; }
        if (per_cu > 1) per_cu = 1;
        grid = cus * per_cu;
    }
    if (grid < 0) return;
    if (hipMemsetAsync((char*)d_ws + WS_CTL, 0, CTL_BYTES, stream) != hipSuccess) { fprintf(stderr, "kernel_launch: hipMemsetAsync failed\n"); return; }
    Params p{};
    for (int i = 0; i < 28; ++i) p.in[i] = (const float*)d_in[i];
    p.out = (float*)d_out; p.ws = (unsigned char*)d_ws;
#if MK_N_LAUNCHES == 1
    p.ph_lo = 0; p.ph_hi = 7;
    void* args[] = {&p};
    hipError_t e = hipLaunchCooperativeKernel((const void*)mk_fwd, dim3(grid), dim3(512), args, LDS_BYTES, stream);
    if (e != hipSuccess) fprintf(stderr, "kernel_launch: cooperative launch failed: %s (grid %d)\n", hipGetErrorString(e), grid);
#else
    for (int ph = 0; ph < 7; ++ph) {
        p.ph_lo = ph; p.ph_hi = ph + 1;
        void* args[] = {&p};
        hipError_t e = hipLaunchCooperativeKernel((const void*)mk_fwd, dim3(grid), dim3(512), args, LDS_BYTES, stream);
        if (e != hipSuccess) { fprintf(stderr, "kernel_launch: launch %d failed: %s (grid %d)\n", ph, hipGetErrorString(e), grid); break; }
    }
#endif
}
```

```cpp
#include <hip/hip_runtime.h>
#include <hip/hip_cooperative_groups.h>
#include <cstdio>
#include <cstdint>
namespace cg = cooperative_groups;

#ifndef MK_N_LAUNCHES
#define MK_N_LAUNCHES 1
#endif
#define MK_REP0 1
#define MK_REP1 1
#define MK_REP2 1
#define MK_REP3 1
#define MK_REP4 1
#define MK_REP5 1
#define MK_REP6 1

#define LAS __attribute__((address_space(3)))
typedef unsigned short bf16_t;
typedef short bf16x8 __attribute__((ext_vector_type(8)));
typedef short bf16x4 __attribute__((ext_vector_type(4)));
typedef float f32x4 __attribute__((ext_vector_type(4)));
typedef float f32x2 __attribute__((ext_vector_type(2)));
typedef unsigned u32x4 __attribute__((ext_vector_type(4)));
typedef unsigned u32x2 __attribute__((ext_vector_type(2)));

constexpr int DM = 1024, SEQ = 2048, NBATCH = 8, MP = NBATCH * SEQ, NSB = 128, MTOT = MP + NSB, MPAD = 16640;
constexpr int NIN = 5632;
constexpr int LQ = 0, LK = 512, LV = 896, LZA = 1280, LU = 1792, LVB = 2304, LZB = 2816, LGA = 3328, LGB = 4352, LNSA = 5376;
constexpr float C2Q = 0.125f * 1.4426950408889634f;
constexpr float NEGBIG = -1e30f, MINIT = -1e29f;
constexpr size_t O_YP = 0, O_YS = 16777216, O_PKC = 16908288, O_PVC = 19005440, O_PKS = 21102592, O_PVS = 23199744, O_PKW = 25296896, O_PVW = 25821184,
                 O_SKC = 26345472, O_SVC = 26361856, O_SKS = 26378240, O_SVS = 26394624, O_SKW = 26411008, O_SVW = 34799616, O_SVCH = 43188224, O_END = 43253760;
constexpr size_t MiB = 1u << 20;
constexpr size_t WS_ROPE = 0, WS_MOD = 1 * MiB, WS_WTIN = 3 * MiB, WS_WTBR = 14 * MiB, WS_WTOUT = 16 * MiB, WS_TRIL = 18 * MiB, WS_KC = 18 * MiB + 512 * 1024, WS_VCT = WS_KC + 128 * 1024,
                 WS_KCS = 19 * MiB, WS_VCS = 23 * MiB, WS_VT = 27 * MiB, WS_H = 40 * MiB, WS_AB = 73 * MiB, WS_ACT = 106 * MiB, WS_GBUF = 285 * MiB, WS_END = 355 * MiB;
constexpr size_t WS_CTL = 768 * 1024, CTL_BYTES = 16384;
constexpr int LDS_BYTES = 151552, LDS_XB = LDS_BYTES - 64;
constexpr int LDS_EPI = 131072, EPI_PITCH = 144, EPI_WAVE = 16 * EPI_PITCH;
static_assert(LDS_EPI + 8 * EPI_WAVE <= LDS_XB - 64, "epilogue staging");

struct Params { const float* in[28]; float* out; unsigned char* ws; int ph_lo, ph_hi; };

__device__ __forceinline__ unsigned f2bf(float f) { unsigned u = __builtin_bit_cast(unsigned, f); return (u + 0x7fffu + ((u >> 16) & 1u)) >> 16; }
__device__ __forceinline__ unsigned cvt_pk_bf16(float lo, float hi);
__device__ __forceinline__ unsigned pk2(float lo, float hi) { return cvt_pk_bf16(lo, hi); }
__device__ __forceinline__ float bf2f(unsigned b) { return __builtin_bit_cast(float, (b & 0xffffu) << 16); }
typedef __bf16 bf16x2_t __attribute__((ext_vector_type(2)));
__device__ __forceinline__ unsigned cvt_pk_bf16(float lo, float hi) { const f32x2 v = {lo, hi}; const bf16x2_t b = __builtin_convertvector(v, bf16x2_t); return __builtin_bit_cast(unsigned, b); }
__device__ __forceinline__ void stage_store_rows(LAS unsigned char* sw, int lane, int fr, int fq, const u32x2 (&w)[2][2], bf16_t* dst0, size_t pitch, int nrows) {
#pragma unroll
    for (int bj = 0; bj < 2; ++bj)
#pragma unroll
        for (int n = 0; n < 2; ++n) *(LAS u32x2*)(sw + fr * EPI_PITCH + (32 * bj + 16 * n + 4 * fq) * 2) = w[bj][n];
    const int r = lane >> 3, ch = lane & 7;
    const u32x4 v0 = *(const LAS u32x4*)(sw + r * EPI_PITCH + ch * 16), v1 = *(const LAS u32x4*)(sw + (r + 8) * EPI_PITCH + ch * 16);
    if (r < nrows) *(u32x4*)(dst0 + (size_t)r * pitch + ch * 8) = v0;
    if (r + 8 < nrows) *(u32x4*)(dst0 + (size_t)(r + 8) * pitch + ch * 8) = v1;
}
__device__ __forceinline__ float sigmoidf_(float x) { return __builtin_amdgcn_rcpf(1.0f + __builtin_amdgcn_exp2f(x * -1.4426950408889634f)); }
__device__ __forceinline__ float wave_sum(float v) {
#pragma unroll
    for (int o = 1; o < 64; o <<= 1) v += __shfl_xor(v, o);
    return v;
}
__device__ __forceinline__ float wave_max(float v) {
#pragma unroll
    for (int o = 1; o < 64; o <<= 1) v = fmaxf(v, __shfl_xor(v, o));
    return v;
}
__device__ __forceinline__ float row0_bcast(float m) {
    const unsigned u = __builtin_bit_cast(unsigned, m);
    const unsigned a = __builtin_amdgcn_permlane16_swap(u, u, false, false)[0];
    return __builtin_bit_cast(float, __builtin_amdgcn_permlane32_swap(a, a, false, false)[0]);
}
__device__ __forceinline__ void unpack4(u32x2 w, float (&f)[4]) { f[0] = bf2f(w.x); f[1] = bf2f(w.x >> 16); f[2] = bf2f(w.y); f[3] = bf2f(w.y >> 16); }

namespace pg8 {
constexpr int BM = 256, BK = 64, HALF = 128, HTB = HALF * BK * 2, STAGE_BYTES = 8 * HTB, NXCD = 8, WGM = 8;
__host__ __device__ __forceinline__ int lds_byte(int r, int c) { const int st = (r >> 4) * 2 + (c >> 5), rr = r & 15, cc = c & 31, ob = rr * 64 + cc * 2; return st * 1024 + (ob ^ (((ob >> 9) & 1) << 5)); }
__host__ __device__ __forceinline__ void stage_rc(int b, int& R, int& C) { const int st = b / 1024, sb = b % 1024, swz = sb ^ (((sb >> 9) & 1) << 5); R = (st >> 1) * 16 + swz / 64; C = (st & 1) * 32 + (swz % 64) / 2; }

struct Unit { int pm, pn, kofs, keep; };
struct Gemm { const bf16_t* A; const bf16_t* Bt; int lda, ldb, K; };

struct StaticOrder {
    int nM, nN, nwg, G, c;
    __device__ void init(int nM_, int nN_, int G_, int c_) { nM = nM_; nN = nN_; nwg = nM * nN; G = G_; c = c_; }
    __device__ bool tile(int i, int& pm, int& pn) const {
        const long L = (long)i * G + c; if (L >= nwg) return false;
        int wgid = (int)L; { const int q = nwg / NXCD, r = nwg % NXCD, xcd = wgid % NXCD, off = wgid / NXCD; wgid = (xcd < r ? xcd * (q + 1) : r * (q + 1) + (xcd - r) * q) + off; }
        const int nig = WGM * nN, gid = wgid / nig, fm = gid * WGM, gsz = (nM - fm) < WGM ? (nM - fm) : WGM;
        pm = fm + ((wgid % nig) % gsz); pn = (wgid % nig) / gsz; return true;
    }
    __device__ bool next(int i, Unit& u) const { u.kofs = 0; u.keep = 0; return tile(i, u.pm, u.pn); }
};
struct PairOrder {
    StaticOrder S;
    __device__ bool next(int i, Unit& u) const { u.kofs = (i & 1) * 512; u.keep = (i & 1) ? 0 : 1; return S.tile(i >> 1, u.pm, u.pn); }
};

template <class Epi, class Sched>
__device__ __forceinline__ void gemm_phase(LAS unsigned char* lds, const Gemm g, const Sched& S, const Epi& E) {
    const int tid = threadIdx.x, wid = __builtin_amdgcn_readfirstlane(tid >> 6), lane = tid & 63, wr = wid >> 2, wc = wid & 3, fr = lane & 15, fq = lane >> 4;
    const int nt = g.K / BK;
    unsigned voffA[2], voffB[2];
#pragma unroll
    for (int i = 0; i < 2; ++i) { int R, C; stage_rc(tid * 16 + i * 8192, R, C); voffA[i] = (unsigned)(R * g.lda + C) * 2u; voffB[i] = (unsigned)(R * g.ldb + C) * 2u; }
    const size_t kstep = (size_t)(BK * 2);
    const size_t hstepA = (size_t)HALF * g.lda * 2, hstepB = (size_t)HALF * g.ldb * 2, tstepA = 2 * hstepA, tstepB = 2 * hstepB;
    const unsigned ldsw = (unsigned)wid * 1024u;
    const int aoff = lds_byte(wr * 64 + fr, fq * 8), boff = lds_byte(wc * 32 + fr, fq * 8);
#define PG8_SA(b, h) (((b) * 2 + (h)) * HTB)
#define PG8_SB(b, h) ((4 + (b) * 2 + (h)) * HTB)
#define PG8_STAGE(bufoff, gbase, voff) do { _Pragma("unroll") for (int _i = 0; _i < 2; ++_i) \
        __builtin_amdgcn_global_load_lds((const unsigned*)((const char*)(gbase) + (voff)[_i]), (LAS unsigned*)(lds + (bufoff) + ldsw + _i * 8192), 16, 0, 0); } while (0)
#define PG8_LDA(dst, b, h) do { _Pragma("unroll") for (int m = 0; m < 4; ++m) _Pragma("unroll") for (int k = 0; k < 2; ++k) dst[m][k] = *(const LAS bf16x8*)(lds + PG8_SA(b, h) + aoff + m * 2048 + k * 1024); } while (0)
#define PG8_LDB(dst, b, h) do { _Pragma("unroll") for (int n = 0; n < 2; ++n) _Pragma("unroll") for (int k = 0; k < 2; ++k) dst[n][k] = *(const LAS bf16x8*)(lds + PG8_SB(b, h) + boff + n * 2048 + k * 1024); } while (0)
#define PG8_MMA(ai, bj, At, Bt) do { __builtin_amdgcn_s_setprio(1); _Pragma("unroll") for (int m = 0; m < 4; ++m) _Pragma("unroll") for (int n = 0; n < 2; ++n) _Pragma("unroll") for (int k = 0; k < 2; ++k) \
        acc[ai][bj][m][n] = __builtin_amdgcn_mfma_f32_16x16x32_bf16(Bt[n][k], At[m][k], acc[ai][bj][m][n], 0, 0, 0); __builtin_amdgcn_s_setprio(0); } while (0)
#define PG8_WAIT_V(n) asm volatile("s_waitcnt vmcnt(" #n ")" ::: "memory")
#define PG8_WAIT_L(n) asm volatile("s_waitcnt lgkmcnt(" #n ")" ::: "memory")
#define PG8_BAR __builtin_amdgcn_s_barrier()
#define PG8_SCHED __builtin_amdgcn_sched_barrier(0)
    Unit cur, nxt; int ui = 0;
    if (!S.next(0, cur)) return;
    f32x4 acc[2][2][4][2];
#pragma unroll
    for (int a = 0; a < 2; ++a)
#pragma unroll
        for (int b = 0; b < 2; ++b)
#pragma unroll
            for (int m = 0; m < 4; ++m)
#pragma unroll
                for (int n = 0; n < 2; ++n) acc[a][b][m][n] = (f32x4){0.f, 0.f, 0.f, 0.f};
    bf16x8 At[4][2], B0[2][2], B1[2][2];
    const char* cA = (const char*)g.A + (size_t)cur.pm * tstepA + (size_t)cur.kofs * 2; const char* cB = (const char*)g.Bt + (size_t)cur.pn * tstepB + (size_t)cur.kofs * 2;
    PG8_STAGE(PG8_SB(0, 0), cB, voffB); PG8_STAGE(PG8_SB(0, 1), cB + hstepB, voffB); PG8_STAGE(PG8_SA(0, 0), cA, voffA); PG8_STAGE(PG8_SA(0, 1), cA + hstepA, voffA);
    if (wr == 1) PG8_BAR;
    PG8_WAIT_V(2); PG8_BAR;
    PG8_STAGE(PG8_SB(1, 0), cB + kstep, voffB); PG8_STAGE(PG8_SA(1, 0), cA + kstep, voffA); PG8_STAGE(PG8_SB(1, 1), cB + hstepB + kstep, voffB);
    PG8_WAIT_V(6); PG8_BAR;
    for (;;) {
        const bool has_next = S.next(ui + 1, nxt);
        const char* nA = has_next ? (const char*)g.A + (size_t)nxt.pm * tstepA + (size_t)nxt.kofs * 2 : cA; const char* nB = has_next ? (const char*)g.Bt + (size_t)nxt.pn * tstepB + (size_t)nxt.kofs * 2 : cB;
        for (int t = 0; t < nt; t += 2) {
            const bool last = (t == nt - 2);
            const char* a1 = cA + (size_t)(t + 1) * kstep;
            const char* a2 = last ? nA : cA + (size_t)(t + 2) * kstep; const char* b2 = last ? nB : cB + (size_t)(t + 2) * kstep;
            const char* a3 = a2 + kstep; const char* b3 = b2 + kstep;
            PG8_LDB(B0, 0, 0); PG8_LDB(B1, 0, 1); PG8_SCHED; PG8_LDA(At, 0, 0); PG8_STAGE(PG8_SA(1, 1), a1 + hstepA, voffA);
            PG8_WAIT_V(8); PG8_WAIT_L(0); PG8_BAR; PG8_MMA(0, 0, At, B0); PG8_MMA(0, 1, At, B1); PG8_BAR; PG8_SCHED;
            PG8_LDA(At, 0, 1); PG8_STAGE(PG8_SB(0, 0), b2, voffB); PG8_STAGE(PG8_SB(0, 1), b2 + hstepB, voffB); PG8_STAGE(PG8_SA(0, 0), a2, voffA);
            PG8_WAIT_V(8); PG8_WAIT_L(0); PG8_BAR; PG8_MMA(1, 0, At, B0); PG8_MMA(1, 1, At, B1); PG8_BAR; PG8_SCHED;
            PG8_LDB(B0, 1, 0); PG8_LDB(B1, 1, 1); PG8_SCHED; PG8_LDA(At, 1, 0); PG8_STAGE(PG8_SA(0, 1), a2 + hstepA, voffA);
            PG8_WAIT_V(8); PG8_WAIT_L(0); PG8_BAR; PG8_MMA(0, 0, At, B0); PG8_MMA(0, 1, At, B1); PG8_BAR; PG8_SCHED;
            PG8_LDA(At, 1, 1); PG8_STAGE(PG8_SB(1, 0), b3, voffB); PG8_STAGE(PG8_SB(1, 1), b3 + hstepB, voffB); PG8_STAGE(PG8_SA(1, 0), a3, voffA);
            PG8_WAIT_V(8); PG8_WAIT_L(0); PG8_BAR; PG8_MMA(1, 0, At, B0); PG8_MMA(1, 1, At, B1); PG8_BAR; PG8_SCHED;
        }
        if (wr == 0) PG8_BAR;
        E(acc, cur, wr, wc, fr, fq);
        if (!has_next) break;
        if (!cur.keep) {
#pragma unroll
            for (int a = 0; a < 2; ++a)
#pragma unroll
                for (int b = 0; b < 2; ++b)
#pragma unroll
                    for (int m = 0; m < 4; ++m)
#pragma unroll
                        for (int n = 0; n < 2; ++n) acc[a][b][m][n] = (f32x4){0.f, 0.f, 0.f, 0.f};
        }
        cur = nxt; cA = nA; cB = nB; ++ui;
        if (wr == 1) PG8_BAR;
    }
    PG8_WAIT_V(0);
    PG8_BAR;
#undef PG8_SA
#undef PG8_SB
#undef PG8_STAGE
#undef PG8_LDA
#undef PG8_LDB
#undef PG8_MMA
#undef PG8_WAIT_V
#undef PG8_WAIT_L
#undef PG8_BAR
#undef PG8_SCHED
}
}

struct EpiInProj {
    bf16_t* ACT; bf16_t* VT; bf16_t* GB; float* out; const float* qng; const float* kng; const float* rope; LAS unsigned char* stg;
    __device__ __forceinline__ void operator()(f32x4 (&acc)[2][2][4][2], const pg8::Unit& u, int wr, int wc, int fr, int fq) const {
        const int pn = u.pn;
        int type = 0, slot = 0;
        if (pn < 2) { type = 1; slot = 4 * pn + wc; }
        else if (pn == 2 || (pn == 3 && wc < 2)) { type = 2; slot = 4 * (pn - 2) + wc; }
        else if (pn == 3 || pn == 4) { type = 3; slot = 4 * (pn - 3) + wc - 2; }
        const int rbase = u.pm * 256 + wr * 64 + fr;
        if (type == 1 || type == 2) {
            const float* gn = (type == 1) ? qng : kng;
            f32x4 g4[2][2];
#pragma unroll
            for (int bj = 0; bj < 2; ++bj)
#pragma unroll
                for (int n = 0; n < 2; ++n) g4[bj][n] = *(const f32x4*)(gn + 32 * bj + 16 * n + 4 * fq);
            const int br = slot >> 1, kvh = slot & 1;
#pragma unroll
            for (int ai = 0; ai < 2; ++ai)
#pragma unroll
                for (int m = 0; m < 4; ++m) {
                    const int row = rbase + ai * 128 + m * 16;
                    float ss = 0.f;
#pragma unroll
                    for (int bj = 0; bj < 2; ++bj)
#pragma unroll
                        for (int n = 0; n < 2; ++n) { const f32x4 v = acc[ai][bj][m][n]; ss += (v[0] * v[0] + v[1] * v[1]) + (v[2] * v[2] + v[3] * v[3]); }
                    ss += __shfl_xor(ss, 16); ss += __shfl_xor(ss, 32);
                    const float rinv = __builtin_amdgcn_rsqf(ss * (1.0f / 64.0f) + 1e-6f);
                    const int pos = (row < MP) ? (row & (SEQ - 1)) : SEQ;
                    const bool live = row < MTOT;
                    long obase = -1;
                    if (type == 2 && live) {
                        if (row < MP) {
                            const int t = row & (SEQ - 1), b = row >> 11;
                            if (br == 0) obase = (long)O_PKC + (long)row * 128 + kvh * 64;
                            else if (br == 1) obase = (long)O_PKS + (long)row * 128 + kvh * 64;
                            else if (t >= 1536) obase = (long)O_PKW + ((long)(b * 512 + t - 1536) * 2 + kvh) * 64;
                        } else {
                            const int sb = row - MP;
                            if (br == 0) obase = (long)O_SKC + sb * 128 + kvh * 64;
                            else if (br == 1) obase = (long)O_SKS + sb * 128 + kvh * 64;
                            else obase = (long)O_SKW + ((long)(sb * 512 + 511) * 2 + kvh) * 64;
                        }
                    }
                    u32x2 wst[2][2];
#pragma unroll
                    for (int n = 0; n < 2; ++n) {
                        const f32x4 cs0 = *(const f32x4*)(rope + ((size_t)pos * 32 + 16 * n + 4 * fq) * 2);
                        const f32x4 cs1 = *(const f32x4*)(rope + ((size_t)pos * 32 + 16 * n + 4 * fq) * 2 + 4);
                        const float cc[4] = {cs0[0], cs0[2], cs1[0], cs1[2]}, sn[4] = {cs0[1], cs0[3], cs1[1], cs1[3]};
                        f32x4 o0, o1;
#pragma unroll
                        for (int j = 0; j < 4; ++j) {
                            const float y0 = acc[ai][0][m][n][j] * rinv * g4[0][n][j], y1 = acc[ai][1][m][n][j] * rinv * g4[1][n][j];
                            o0[j] = y0 * cc[j] - y1 * sn[j]; o1[j] = y1 * cc[j] + y0 * sn[j];
                        }
                        const float qs = (type == 1) ? C2Q : 1.0f;
                        wst[0][n].x = cvt_pk_bf16(o0[0] * qs, o0[1] * qs); wst[0][n].y = cvt_pk_bf16(o0[2] * qs, o0[3] * qs); wst[1][n].x = cvt_pk_bf16(o1[0] * qs, o1[1] * qs); wst[1][n].y = cvt_pk_bf16(o1[2] * qs, o1[3] * qs);
                        if (type == 2 && obase >= 0) { const int dcol = 16 * n + 4 * fq; *(f32x4*)(out + obase + dcol) = o0; *(f32x4*)(out + obase + 32 + dcol) = o1; }
                    }
                    { const int row0 = row - fr; stage_store_rows(stg + (wr * 4 + wc) * EPI_WAVE, fq * 16 + fr, fr, fq, wst, ACT + (size_t)row0 * NIN + ((type == 1) ? LQ : LK) + 64 * slot, NIN, MTOT - row0); }
                }
        } else if (type == 3) {
            const int br = slot >> 1, kvh = slot & 1;
#pragma unroll
            for (int ai = 0; ai < 2; ++ai)
#pragma unroll
                for (int m = 0; m < 4; ++m) {
                    const int row = rbase + ai * 128 + m * 16;
                    if (row < MTOT) {
                        long obase = -1;
                        if (row < MP) {
                            const int t = row & (SEQ - 1), b = row >> 11;
                            if (br == 0) obase = (long)O_PVC + (long)row * 128 + kvh * 64;
                            else if (br == 1) obase = (long)O_PVS + (long)row * 128 + kvh * 64;
                            else if (t >= 1536) obase = (long)O_PVW + ((long)(b * 512 + t - 1536) * 2 + kvh) * 64;
                            bf16_t* vt = VT + ((size_t)(b * 6 + slot) * 64) * SEQ + t;
#pragma unroll
                            for (int bj = 0; bj < 2; ++bj)
#pragma unroll
                                for (int n = 0; n < 2; ++n)
#pragma unroll
                                    for (int j = 0; j < 4; ++j) vt[(size_t)(32 * bj + 16 * n + 4 * fq + j) * SEQ] = (bf16_t)f2bf(acc[ai][bj][m][n][j]);
                        } else {
                            const int sb = row - MP;
                            if (br == 0) obase = (long)O_SVC + sb * 128 + kvh * 64;
                            else if (br == 1) obase = (long)O_SVS + sb * 128 + kvh * 64;
                            else obase = (long)O_SVW + ((long)(sb * 512 + 511) * 2 + kvh) * 64;
                        }
                        if (obase >= 0) {
#pragma unroll
                            for (int bj = 0; bj < 2; ++bj)
#pragma unroll
                                for (int n = 0; n < 2; ++n) *(f32x4*)(out + obase + 32 * bj + 16 * n + 4 * fq) = acc[ai][bj][m][n];
                        }
                    }
                }
        } else if (pn >= 13 && pn <= 20) {
            bf16_t* gp = GB + ((size_t)((u.pm * 8 + (pn - 13)) * 8 + wr * 4 + wc) * 32) * 256 + (size_t)(fq * 16 + fr) * 4;
#pragma unroll
            for (int ai = 0; ai < 2; ++ai)
#pragma unroll
                for (int m = 0; m < 4; ++m)
#pragma unroll
                    for (int bj = 0; bj < 2; ++bj)
#pragma unroll
                        for (int n = 0; n < 2; ++n) {
                            const f32x4 v = acc[ai][bj][m][n];
                            u32x2 w; w.x = cvt_pk_bf16(sigmoidf_(v[0]), sigmoidf_(v[1])); w.y = cvt_pk_bf16(sigmoidf_(v[2]), sigmoidf_(v[3]));
                            *(u32x2*)(gp + (size_t)(((ai * 4 + m) * 2 + bj) * 2 + n) * 256) = w;
                        }
        } else {
            const int mode = (pn <= 6) ? 1 : (pn <= 10) ? 0 : (pn <= 12) ? 1 : 2;
            LAS unsigned char* sw = stg + (wr * 4 + wc) * EPI_WAVE; const int lane = fq * 16 + fr;
#pragma unroll
            for (int ai = 0; ai < 2; ++ai)
#pragma unroll
                for (int m = 0; m < 4; ++m) {
                    const int row0 = u.pm * 256 + wr * 64 + ai * 128 + m * 16;
                    u32x2 w[2][2];
#pragma unroll
                    for (int bj = 0; bj < 2; ++bj)
#pragma unroll
                        for (int n = 0; n < 2; ++n) {
                            f32x4 v = acc[ai][bj][m][n];
#pragma unroll
                            for (int j = 0; j < 4; ++j) { const float sg = sigmoidf_(v[j]); v[j] = (mode == 0) ? v[j] : (mode == 1) ? v[j] * sg : sg; }
                            w[bj][n].x = cvt_pk_bf16(v[0], v[1]); w[bj][n].y = cvt_pk_bf16(v[2], v[3]);
                        }
                    stage_store_rows(sw, lane, fr, fq, w, ACT + (size_t)row0 * NIN + 256 * pn + 64 * wc, NIN, MTOT - row0);
                }
        }
    }
};

struct EpiMix {
    const bf16_t* GB; bf16_t* M;
    __device__ __forceinline__ void operator()(f32x4 (&acc)[2][2][4][2], const pg8::Unit& u, int wr, int wc, int fr, int fq) const {
        const int rbase = u.pm * 256 + wr * 64 + fr, cbase = u.pn * 256 + 64 * wc + 4 * fq;
        const bf16_t* ga = GB + ((size_t)((u.pm * 8 + u.pn) * 8 + wr * 4 + wc) * 32) * 256 + (size_t)(fq * 16 + fr) * 4;
        const bf16_t* gb = ga + (size_t)4 * 8 * 32 * 256;
#pragma unroll
        for (int ai = 0; ai < 2; ++ai) {
            u32x2 gsb[16], gsa[16];
#pragma unroll
            for (int f = 0; f < 16; ++f) { gsb[f] = *(const u32x2*)(gb + (ai * 16 + f) * 256); if (u.keep) gsa[f] = *(const u32x2*)(ga + (ai * 16 + f) * 256); }
#pragma unroll
            for (int m = 0; m < 4; ++m) {
                const int row = rbase + ai * 128 + m * 16;
#pragma unroll
                for (int bj = 0; bj < 2; ++bj)
#pragma unroll
                    for (int n = 0; n < 2; ++n) {
                        const int f = (m * 2 + bj) * 2 + n;
                        float sb[4]; unpack4(gsb[f], sb);
                        if (u.keep) {
                            float sa[4]; unpack4(gsa[f], sa);
#pragma unroll
                            for (int j = 0; j < 4; ++j) acc[ai][bj][m][n][j] *= sa[j] * __builtin_amdgcn_rcpf(sb[j]);
                        } else if (row < MP) {
                            const f32x4 v = acc[ai][bj][m][n];
                            u32x2 w; w.x = cvt_pk_bf16(v[0] * sb[0], v[1] * sb[1]); w.y = cvt_pk_bf16(v[2] * sb[2], v[3] * sb[3]);
                            *(u32x2*)(M + (size_t)row * DM + cbase + 32 * bj + 16 * n) = w;
                        }
                    }
            }
        }
    }
};

struct EpiOut {
    const float* xp; const float* xs; const float* MOD; float* out;
    __device__ __forceinline__ void operator()(f32x4 (&acc)[2][2][4][2], const pg8::Unit& u, int wr, int wc, int fr, int fq) const {
        const int rbase = u.pm * 256 + wr * 64 + fr, cbase = u.pn * 256 + wc * 32 + 4 * fq;
        const float* gr = MOD + (size_t)(rbase >> 11) * 3072 + 2048;
        f32x4 gv[2][2];
#pragma unroll
        for (int bj = 0; bj < 2; ++bj)
#pragma unroll
            for (int n = 0; n < 2; ++n) gv[bj][n] = *(const f32x4*)(gr + cbase + 128 * bj + 16 * n);
#pragma unroll
        for (int ai = 0; ai < 2; ++ai) {
            f32x4 xv[4][2][2];
#pragma unroll
            for (int m = 0; m < 4; ++m)
#pragma unroll
                for (int bj = 0; bj < 2; ++bj)
#pragma unroll
                    for (int n = 0; n < 2; ++n) xv[m][bj][n] = __builtin_nontemporal_load((const f32x4*)(xp + (size_t)(rbase + ai * 128 + m * 16) * DM + cbase + 128 * bj + 16 * n));
#pragma unroll
            for (int m = 0; m < 4; ++m)
#pragma unroll
                for (int bj = 0; bj < 2; ++bj)
#pragma unroll
                    for (int n = 0; n < 2; ++n)
                        __builtin_nontemporal_store(xv[m][bj][n] + gv[bj][n] * acc[ai][bj][m][n], (f32x4*)(out + O_YP + (size_t)(rbase + ai * 128 + m * 16) * DM + cbase + 128 * bj + 16 * n));
        }
    }
};

__device__ __forceinline__ void transpose_item(const float* src, int src_ld, int nvalid, bf16_t* dst, int dst_ld, LAS float* scr, int lane) {
    float tv[64];
    const int cc = lane & 31, ccl = cc < nvalid ? cc : 0;
#pragma unroll
    for (int i = 0; i < 64; ++i) tv[i] = src[(size_t)(2 * i + (lane >> 5)) * src_ld + ccl];
#pragma unroll
    for (int hf = 0; hf < 2; ++hf) {
#pragma unroll
        for (int i = 0; i < 32; ++i) scr[(2 * i + (lane >> 5)) * 33 + cc] = (cc < nvalid) ? tv[32 * hf + i] : 0.f;
        asm volatile("s_waitcnt lgkmcnt(0)" ::: "memory");
        const int c = lane & 7;
#pragma unroll
        for (int j = 0; j < 4; ++j) { const int n = (lane >> 3) + 8 * j; const LAS float* sp = scr + (8 * c) * 33 + n;
            u32x4 o; o.x = pk2(sp[0 * 33], sp[1 * 33]); o.y = pk2(sp[2 * 33], sp[3 * 33]); o.z = pk2(sp[4 * 33], sp[5 * 33]); o.w = pk2(sp[6 * 33], sp[7 * 33]);
            *(u32x4*)(dst + (size_t)n * dst_ld + 64 * hf + 8 * c) = o; }
        asm volatile("s_waitcnt lgkmcnt(0)" ::: "memory");
    }
}

__device__ __forceinline__ void pool_item(const Params& P, LAS float* scr, int it, int lane_in) {
    int lane = lane_in; asm volatile("" : "+v"(lane));
    unsigned char* ws = P.ws;
    const int sb = it >> 5, pg = (it >> 1) & 15, which = it & 1;
    const int page = ((const int*)P.in[8])[sb * 16 + pg];
    const float* src = P.in[2 + which] + (size_t)page * 128 * 128;
    const float* pe = P.in[17 + which]; const float* w = P.in[19 + which];
    const int d0 = (2 * lane) & 63;
    float p0 = 0.f, p1 = 0.f;
#pragma unroll 8
    for (int r = 0; r < 32; ++r) { const f32x2 v = *(const f32x2*)(pe + r * 64 + d0); p0 += v[0]; p1 += v[1]; }
#pragma unroll
    for (int cb = 0; cb < 4; ++cb) {
        f32x2 v[32];
#pragma unroll
        for (int r = 0; r < 32; ++r) v[r] = __builtin_nontemporal_load((const f32x2*)(src + (size_t)(cb * 32 + r) * 128 + 2 * lane));
        float s0 = 0.f, s1 = 0.f;
#pragma unroll
        for (int r = 0; r < 32; ++r) { s0 += v[r][0]; s1 += v[r][1]; }
        scr[d0 * 8 + cb * 2 + (lane >> 5)] = (s0 + p0) * (1.0f / 32.0f); scr[(d0 + 1) * 8 + cb * 2 + (lane >> 5)] = (s1 + p1) * (1.0f / 32.0f);
    }
    asm volatile("s_waitcnt lgkmcnt(0)" ::: "memory");
    float a[8];
#pragma unroll
    for (int q = 0; q < 8; ++q) a[q] = 0.f;
#pragma unroll 8
    for (int d = 0; d < 64; ++d) { const float wv = w[d * 64 + lane]; const f32x4 pa = *(const LAS f32x4*)(scr + d * 8), pb = *(const LAS f32x4*)(scr + d * 8 + 4);
        a[0] += pa[0] * wv; a[1] += pa[1] * wv; a[2] += pa[2] * wv; a[3] += pa[3] * wv; a[4] += pb[0] * wv; a[5] += pb[1] * wv; a[6] += pb[2] * wv; a[7] += pb[3] * wv; }
    float* dst = (float*)(ws + (which ? WS_VCS : WS_KCS));
#pragma unroll
    for (int q = 0; q < 8; ++q) dst[((size_t)(sb * 2 + (q & 1)) * 64 + 4 * pg + (q >> 1)) * 64 + lane] = a[q];
    asm volatile("s_waitcnt lgkmcnt(0)" ::: "memory");

}

__device__ __forceinline__ void p0_prologue(const Params& P, LAS unsigned char* lds, int gw, int NGW, int lane_p, int wave, int gtid, int NT) {
    unsigned char* ws = P.ws;
    LAS float* scr = (LAS float*)(lds + wave * 16384);
    constexpr int I_MOD = 9 * 48, I_WIN = 8 * 176, I_WBR = 8 * 32, I_WOUT = 8 * 32, I_POOL = NSB * 16 * 2;
    constexpr int POOL_P0 = 1616 + 776;
    constexpr int I_TOTAL = I_MOD + I_WIN + I_WBR + I_WOUT + I_POOL;
    constexpr int I_TR = I_WIN + I_WBR + I_WOUT;
    const bool modw = gw < I_MOD; const int io = gw - I_MOD;
    static_assert(I_TR == 1920 && I_POOL == 4096 && I_MOD == 432 && POOL_P0 == 1616 + 776, "the deal below is written for these counts and a 2048-wave grid");
    for (int stp = 0;; ++stp) {
        int it;
        if (NGW != 2048) { it = gw + stp * NGW; if (it >= I_MOD + I_TR + POOL_P0) break; }
        else if (modw) { if (stp == 0) it = gw; else break; }
        else {
            const int j = io - 776;
            const int nT = (io < 776) ? 1 : (j < 304 ? 2 : 1), nP = (io < 776) ? 2 : 1;
            if (stp >= nT + nP) break;
            if (stp < nT) it = I_MOD + ((io < 776) ? io : (stp == 0 ? 776 + j : 1616 + j));
            else it = I_MOD + I_TR + (stp - nT == 0 ? io : 1616 + io);
        }
        int lane = lane_p; asm volatile("" : "+v"(lane));
        if (it < I_MOD) {
            const int mt = it / 48, ng = it % 48, lr = lane & 15, kq = lane >> 4;
            int arow_i = 16 * mt + lr; if (arow_i > 135) arow_i = 135;
            const float* arow = ((arow_i < 8) ? P.in[9] + (size_t)arow_i * DM : P.in[10] + (size_t)(arow_i - 8) * DM) + 4 * kq;
            const float* bp = P.in[11] + (size_t)(4 * kq) * 3072 + 64 * ng + 4 * lr;
            f32x4 macc[4];
#pragma unroll
            for (int nt = 0; nt < 4; ++nt) macc[nt] = (f32x4){0.f, 0.f, 0.f, 0.f};
            f32x4 a0[4], b0[16], a1[4], b1[16];
#define MOD_LOAD(A_, B_, k0) do { _Pragma("unroll") for (int j = 0; j < 4; ++j) { A_[j] = *(const f32x4*)(arow + (k0) + 16 * j); \
                _Pragma("unroll") for (int e = 0; e < 4; ++e) B_[4 * j + e] = *(const f32x4*)(bp + (size_t)((k0) + 16 * j + e) * 3072); } } while (0)
#define MOD_MMA(A_, B_) do { _Pragma("unroll") for (int j = 0; j < 4; ++j) _Pragma("unroll") for (int e = 0; e < 4; ++e) _Pragma("unroll") for (int nt = 0; nt < 4; ++nt) \
                macc[nt] = __builtin_amdgcn_mfma_f32_16x16x4f32(A_[j][e], B_[4 * j + e][nt], macc[nt], 0, 0, 0); } while (0)
            MOD_LOAD(a0, b0, 0);
            for (int k0 = 0; k0 < DM; k0 += 128) {
                MOD_LOAD(a1, b1, k0 + 64);
                __builtin_amdgcn_sched_barrier(0);
                MOD_MMA(a0, b0);
                __builtin_amdgcn_sched_barrier(0);
                if (k0 + 128 < DM) MOD_LOAD(a0, b0, k0 + 128);
                __builtin_amdgcn_sched_barrier(0);
                MOD_MMA(a1, b1);
                __builtin_amdgcn_sched_barrier(0);
            }
#undef MOD_LOAD
#undef MOD_MMA
            float* MOD = (float*)(ws + WS_MOD);
            const f32x4 bb = *(const f32x4*)(P.in[12] + 64 * ng + 4 * lr);
#pragma unroll
            for (int r = 0; r < 4; ++r) { const int row = 16 * mt + 4 * kq + r;
                if (row < 136) *(f32x4*)(MOD + (size_t)row * 3072 + 64 * ng + 4 * lr) = (f32x4){macc[0][r] + bb[0], macc[1][r] + bb[1], macc[2][r] + bb[2], macc[3][r] + bb[3]}; }
            continue;
        }
        it -= I_MOD;
        if (it < I_WIN) {
            const int kb = it / 176, nb = it % 176;
            const int pn = nb >> 3, bj = (nb >> 2) & 1, wc = nb & 3;
            const int L0 = 256 * pn + 64 * wc + 32 * bj;
            int srcc, nvalid;
            if (L0 < 1280) { srcc = L0; nvalid = 32; } else if (L0 < LNSA) { srcc = L0 + 24; nvalid = 32; } else if (L0 == LNSA) { srcc = 1280; nvalid = 24; } else { srcc = 0; nvalid = 0; }
            transpose_item(P.in[14] + (size_t)(128 * kb) * 5400 + srcc, 5400, nvalid, (bf16_t*)(ws + WS_WTIN) + (size_t)(32 * nb) * DM + 128 * kb, DM, scr, lane);
            continue;
        }
        it -= I_WIN;
        if (it < I_WBR) {
            const int kb = it / 32, nb = it % 32;
            const float* src = (kb < 4) ? P.in[25] + (size_t)(128 * kb) * DM : P.in[26] + (size_t)(128 * (kb - 4)) * DM;
            const int L0 = 256 * (nb >> 3) + 64 * (nb & 3) + 32 * ((nb >> 2) & 1);
            transpose_item(src + L0, DM, 32, (bf16_t*)(ws + WS_WTBR) + (size_t)(32 * nb) * DM + 128 * kb, DM, scr, lane);
            continue;
        }
        it -= I_WBR;
        if (it < I_WOUT) {
            const int kb = it / 32, nb = it % 32;
            transpose_item(P.in[27] + (size_t)(128 * kb) * DM + 32 * nb, DM, 32, (bf16_t*)(ws + WS_WTOUT) + (size_t)(32 * nb) * DM + 128 * kb, DM, scr, lane);
            continue;
        }
        it -= I_WOUT;
        pool_item(P, scr, it, lane);
    }
    float* rope = (float*)(ws + WS_ROPE);
    for (int i = gtid; i < 2049 * 32; i += NT) {
        const int pos = i >> 5, k = i & 31;
        double invd = 1.0;
        for (int q = 0; q < k; ++q) invd *= 0.7498942093324559;
        const float ang = (float)pos * (float)invd;
        const double rev = (double)ang * 0.15915494309189535;
        const float fr = (float)(rev - __builtin_rint(rev));
        rope[2 * i] = __builtin_amdgcn_cosf(fr); rope[2 * i + 1] = __builtin_amdgcn_sinf(fr);
    }
    bf16_t* tril = (bf16_t*)(ws + WS_TRIL);
    for (int i = gtid; i < 4 * 128 * 128; i += NT) { const int r = (i >> 7) & 127, cidx = i & 127; tril[i] = (cidx <= r) ? (bf16_t)f2bf(P.in[23][i]) : (bf16_t)0; }
    for (int tk = blockIdx.x; tk < 2 * NSB * 2; tk += gridDim.x) {
        const int w2 = tk >> 8, sb = (tk >> 1) & 127, half = tk & 1;
        const f32x4* src = (const f32x4*)P.in[6 + w2] + (size_t)sb * 512 * 32 + 32 + half * 8176; f32x4* dst = (f32x4*)(P.out + (w2 ? O_SVW : O_SKW)) + (size_t)sb * 512 * 32 + half * 8176;
        f32x4 cv[16];
#pragma unroll
        for (int u = 0; u < 16; ++u) { const int i = threadIdx.x + 512 * u; if (i < 8176) cv[u] = __builtin_nontemporal_load(src + i); }
#pragma unroll
        for (int u = 0; u < 16; ++u) { const int i = threadIdx.x + 512 * u; if (i < 8176) __builtin_nontemporal_store(cv[u], dst + i); }
    }
}

__device__ __forceinline__ void p1_hrows(const Params& P, int gw, int NGW, int lane) {
    const float* MOD = (const float*)(P.ws + WS_MOD); bf16_t* H = (bf16_t*)(P.ws + WS_H); const float* ng = P.in[13];
    for (int row0 = gw; row0 < MPAD; row0 += 4 * NGW) {
        f32x4 v[4][4];
#pragma unroll
        for (int q = 0; q < 4; ++q) { const int row = row0 + q * NGW; const int rr = row < MTOT ? row : 0;
            const float* xr = (rr < MP) ? P.in[0] + (size_t)rr * DM : P.in[1] + (size_t)(rr - MP) * DM;
#pragma unroll
            for (int j = 0; j < 4; ++j) v[q][j] = __builtin_nontemporal_load((const f32x4*)xr + lane + 64 * j); }
#pragma unroll
        for (int q = 0; q < 4; ++q) {
            const int row = row0 + q * NGW;
            if (row >= MPAD) break;
            unsigned long long* o8 = (unsigned long long*)(H + (size_t)row * DM) + lane;
            if (row >= MTOT) {
#pragma unroll
                for (int j = 0; j < 4; ++j) o8[64 * j] = 0ull;
                continue; }
            const float* md = (row < MP) ? MOD + (size_t)(row >> 11) * 3072 : MOD + (size_t)(8 + row - MP) * 3072;
            float s = 0.f;
#pragma unroll
            for (int j = 0; j < 4; ++j) s += (v[q][j][0] * v[q][j][0] + v[q][j][1] * v[q][j][1]) + (v[q][j][2] * v[q][j][2] + v[q][j][3] * v[q][j][3]);
            const float rstd = rsqrtf(wave_sum(s) * (1.0f / DM) + 1e-6f);
#pragma unroll
            for (int j = 0; j < 4; ++j) {
                const int col = 4 * lane + 256 * j;
                const f32x4 g = *(const f32x4*)(ng + col), sh = *(const f32x4*)(md + col), sc = *(const f32x4*)(md + 1024 + col);
                const f32x4 h = (v[q][j] * rstd) * g * (sc + 1.0f) + sh;
                o8[64 * j] = (unsigned long long)pk2(h[0], h[1]) | ((unsigned long long)pk2(h[2], h[3]) << 32);
            }
        }
    }
}

__device__ __forceinline__ void p3_compress(const Params& P, LAS unsigned char* lds, int gw, int NGW, int lane, int wave) {
    LAS float* scr = (LAS float*)(lds + wave * 1024);
    for (int it = gw; it < NBATCH * 64 * 2 * 2; it += NGW) {
        const int b = it >> 8, c = (it >> 2) & 63, kvh = (it >> 1) & 1, which = it & 1;
        const float* src = P.out + (which ? O_PVC : O_PKC) + ((size_t)(b * SEQ + 32 * c) * 2 + kvh) * 64;
        const float* pe = P.in[17 + which]; const float* w = P.in[19 + which];
        float s = 0.f;
#pragma unroll
        for (int r = 0; r < 32; ++r) s += src[(size_t)r * 128 + lane] + pe[r * 64 + lane];
        scr[lane] = s * (1.0f / 32.0f);
        asm volatile("s_waitcnt lgkmcnt(0)" ::: "memory");
        float a = 0.f;
#pragma unroll 8
        for (int d = 0; d < 64; ++d) a += scr[d] * w[d * 64 + lane];
        if (which == 0) ((bf16_t*)(P.ws + WS_KC))[((size_t)(b * 64 + c) * 2 + kvh) * 64 + lane] = (bf16_t)f2bf(a);
        else ((bf16_t*)(P.ws + WS_VCT))[((size_t)(b * 2 + kvh) * 64 + lane) * 64 + c] = (bf16_t)f2bf(a);
        asm volatile("s_waitcnt lgkmcnt(0)" ::: "memory");
    }
}

constexpr int A_TILE = 32768, A_IMP = 3 * A_TILE, A_IMPS = A_IMP + 8 * 32 * 33 * 4, A_SEL = A_IMPS + 2 * 32 * 33 * 4;
static_assert(A_SEL + 256 <= LDS_XB, "attention LDS map");
#define ATT_BAR() do { asm volatile("s_waitcnt lgkmcnt(0)" ::: "memory"); __builtin_amdgcn_s_barrier(); asm volatile("" ::: "memory"); } while (0)

struct TileSrc { const bf16_t* kb; const bf16_t* v0; const bf16_t* v1; unsigned kpitch, vpitch; };
__device__ __forceinline__ TileSrc attn_tile_src(const Params& P, int b, int T, int n_slc, int lo) {
    TileSrc s;
    if (T == 0) { s.kb = (const bf16_t*)(P.ws + WS_KC) + (size_t)b * 64 * 128; s.v0 = (const bf16_t*)(P.ws + WS_VCT) + (size_t)(b * 2) * 4096; s.v1 = s.v0 + 4096; s.kpitch = 128; s.vpitch = 64; }
    else {
        const bool slc = T <= n_slc; const int j = slc ? T - 1 : lo + (T - 1 - n_slc), br = slc ? 1 : 2;
        s.kb = (const bf16_t*)(P.ws + WS_ACT) + ((size_t)b * SEQ + 64 * j) * NIN + LK + 128 * br;
        s.v0 = (const bf16_t*)(P.ws + WS_VT) + ((size_t)(b * 6 + 2 * br) * 64) * SEQ + 64 * j; s.v1 = s.v0 + (size_t)64 * SEQ; s.kpitch = NIN; s.vpitch = SEQ;
    }
    return s;
}
__device__ __forceinline__ void attn_dma(LAS unsigned char* buf, const TileSrc& s, int wave, int lane_in) {
    int lane = lane_in; asm volatile("" : "+v"(lane));
    const int r = 8 * wave + (lane >> 3), ch = (lane & 7) ^ (lane >> 3);
#pragma unroll
    for (int i = 0; i < 2; ++i) {
        __builtin_amdgcn_global_load_lds((const unsigned*)(s.kb + (size_t)r * s.kpitch + i * 64 + ch * 8), (LAS unsigned*)(buf + (wave + 8 * i) * 1024), 16, 0, 0);
        __builtin_amdgcn_global_load_lds((const unsigned*)((i ? s.v1 : s.v0) + (size_t)r * s.vpitch + ch * 8), (LAS unsigned*)(buf + 16384 + (wave + 8 * i) * 1024), 16, 0, 0);
    }
}

constexpr float ATT_M0 = -30.f, ATT_THR = 12.f;
template <int MODE>
__device__ __forceinline__ void attn_tile(const LAS unsigned char* Kg, const LAS unsigned char* Vg, const bf16x8 (&qf)[2][2], f32x4 (&O)[4][2], float (&mrun)[2], float (&lrun)[2], f32x4 (&s)[2][4],
                                          int lane_in, int kbase, const int (&qpos)[2], const float (&cinit)[2], bool emask) {
    int lane = lane_in; asm volatile("" : "+v"(lane));
    const int lr = lane & 15, grp = lane >> 4, sw = lr & 7;
    const float c0[2] = {cinit[0] - mrun[0], cinit[1] - mrun[1]};
#pragma unroll
    for (int kt = 0; kt < 4; ++kt) {
        const bf16x8 k0 = *(const LAS bf16x8*)(Kg + (16 * kt + lr) * 128 + ((grp ^ sw) << 4));
        const bf16x8 k1 = *(const LAS bf16x8*)(Kg + (16 * kt + lr) * 128 + (((4 + grp) ^ sw) << 4));
#pragma unroll
        for (int qt = 0; qt < 2; ++qt) {
            const f32x4 a = __builtin_amdgcn_mfma_f32_16x16x32_bf16(k0, qf[qt][0], (f32x4){c0[qt], c0[qt], c0[qt], c0[qt]}, 0, 0, 0);
            s[qt][kt] = __builtin_amdgcn_mfma_f32_16x16x32_bf16(k1, qf[qt][1], a, 0, 0, 0);
        }
    }
    bf16x8 vf[2][4];
#pragma unroll
    for (int c2 = 0; c2 < 2; ++c2)
#pragma unroll
        for (int dt = 0; dt < 4; ++dt) {
            const LAS unsigned char* vr = Vg + (16 * dt + lr) * 128 + 8 * (grp & 1);
            const u32x2 lo = *(const LAS u32x2*)(vr + (((4 * c2 + (grp >> 1)) ^ sw) << 4));
            const u32x2 hi = *(const LAS u32x2*)(vr + (((4 * c2 + 2 + (grp >> 1)) ^ sw) << 4));
            const u32x4 vv = {lo.x, lo.y, hi.x, hi.y};
            vf[c2][dt] = __builtin_bit_cast(bf16x8, vv);
        }
    if (emask) {
#pragma unroll
        for (int qt = 0; qt < 2; ++qt)
#pragma unroll
            for (int kt = 0; kt < 4; ++kt)
#pragma unroll
                for (int r = 0; r < 4; ++r) {
                    const int key = 16 * kt + 4 * grp + r;
                    bool valid;
                    if (MODE == 0) valid = key < ((qpos[qt] + 1) >> 5);
                    else if (MODE == 1) valid = (kbase + key <= qpos[qt]);
                    else { const int kp = kbase + key; valid = (kp <= qpos[qt]) && (kp > qpos[qt] - 512); }
                    s[qt][kt][r] = valid ? s[qt][kt][r] : NEGBIG;
                }
    }
    float mx[2];
#pragma unroll
    for (int qt = 0; qt < 2; ++qt) {
#define FMX(a, b) __builtin_amdgcn_fmed3f((a), (b), __builtin_inff())
        float m0 = FMX(FMX(s[qt][0][0], s[qt][0][1]), FMX(s[qt][0][2], s[qt][0][3]));
#pragma unroll
        for (int kt = 1; kt < 4; ++kt) m0 = FMX(m0, FMX(FMX(s[qt][kt][0], s[qt][kt][1]), FMX(s[qt][kt][2], s[qt][kt][3])));
        mx[qt] = row0_bcast(m0);
#undef FMX
    }
    if (__any((int)(fmaxf(mx[0], mx[1]) > ATT_THR))) {
#pragma unroll
        for (int qt = 0; qt < 2; ++qt) {
            const float delta = fmaxf(mx[qt], 0.f), f = __builtin_amdgcn_exp2f(-delta);
            mrun[qt] += delta; lrun[qt] *= f;
#pragma unroll
            for (int dt = 0; dt < 4; ++dt) O[dt][qt] *= f;
#pragma unroll
            for (int kt = 0; kt < 4; ++kt) s[qt][kt] -= delta;
        }
    }
#pragma unroll
    for (int qt = 0; qt < 2; ++qt) {
        float ls = 0.f;
#pragma unroll
        for (int kt = 0; kt < 4; ++kt)
#pragma unroll
            for (int r = 0; r < 4; ++r) { const float p = __builtin_amdgcn_exp2f(s[qt][kt][r]); s[qt][kt][r] = p; ls += p; }
        lrun[qt] += ls;
#pragma unroll
        for (int c2 = 0; c2 < 2; ++c2) {
            u32x4 w; w.x = cvt_pk_bf16(s[qt][2 * c2][0], s[qt][2 * c2][1]); w.y = cvt_pk_bf16(s[qt][2 * c2][2], s[qt][2 * c2][3]);
            w.z = cvt_pk_bf16(s[qt][2 * c2 + 1][0], s[qt][2 * c2 + 1][1]); w.w = cvt_pk_bf16(s[qt][2 * c2 + 1][2], s[qt][2 * c2 + 1][3]);
            const bf16x8 pf = __builtin_bit_cast(bf16x8, w);
#pragma unroll
            for (int dt = 0; dt < 4; ++dt) O[dt][qt] = __builtin_amdgcn_mfma_f32_16x16x32_bf16(vf[c2][dt], pf, O[dt][qt], 0, 0, 0);
        }
    }
}

__device__ __forceinline__ void attn_unit(const Params& P, LAS unsigned char* lds, int b, int qb32, int tid, int lane, int wave) {
    asm volatile("" : "+v"(tid), "+v"(lane));
    const bf16_t* ACT = (const bf16_t*)(P.ws + WS_ACT); bf16_t* AB = (bf16_t*)(P.ws + WS_AB);
    const int lr = lane & 15, grp = lane >> 4, g = wave >> 2;
    const int t0 = 32 * qb32, qblk = t0 >> 6; const size_t row0 = (size_t)b * SEQ + t0;
    const int n_slc = qblk + 1, lo = (t0 - 511 > 0) ? ((t0 - 511) >> 6) : 0, NT = 1 + n_slc + (qblk - lo + 1);
    LAS float* IMP = (LAS float*)(lds + A_IMP); LAS float* IMPS = (LAS float*)(lds + A_IMPS); LAS unsigned* SEL = (LAS unsigned*)(lds + A_SEL);
    bf16x8 qf[2][2]; int qpos[2]; float gate[2][3];
#pragma unroll
    for (int qt = 0; qt < 2; ++qt) {
        const size_t row = row0 + 16 * qt + lr; qpos[qt] = t0 + 16 * qt + lr;
#pragma unroll
        for (int ks = 0; ks < 2; ++ks) qf[qt][ks] = *(const bf16x8*)(ACT + row * NIN + LQ + 64 * wave + 32 * ks + 8 * grp);
#pragma unroll
        for (int br = 0; br < 3; ++br) gate[qt][br] = bf2f(ACT[row * NIN + LNSA + 3 * wave + br]);
    }
    f32x4 O[4][2], OA[4][2], s[2][4]; float mrun[2], lrun[2]; unsigned selm[2] = {0u, 0u};
#pragma unroll
    for (int dt = 0; dt < 4; ++dt)
#pragma unroll
        for (int qt = 0; qt < 2; ++qt) { O[dt][qt] = (f32x4){0.f, 0.f, 0.f, 0.f}; OA[dt][qt] = (f32x4){0.f, 0.f, 0.f, 0.f}; }
    mrun[0] = mrun[1] = ATT_M0; lrun[0] = lrun[1] = 0.f;
#define ATT_FINISH(br) do { _Pragma("unroll") for (int qt = 0; qt < 2; ++qt) { float lt = lrun[qt]; lt += __shfl_xor(lt, 16); lt += __shfl_xor(lt, 32); \
        const float f = (lt > 0.f) ? gate[qt][br] / lt : 0.f; _Pragma("unroll") for (int dt = 0; dt < 4; ++dt) { OA[dt][qt] += O[dt][qt] * f; O[dt][qt] = (f32x4){0.f, 0.f, 0.f, 0.f}; } \
        mrun[qt] = ATT_M0; lrun[qt] = 0.f; } } while (0)
    const float czero[2] = {0.f, 0.f};
    ATT_BAR();
    { const TileSrc s0 = attn_tile_src(P, b, 0, n_slc, lo); attn_dma(lds, s0, wave, lane); }
    { const TileSrc s1 = attn_tile_src(P, b, 1, n_slc, lo); attn_dma(lds + A_TILE, s1, wave, lane); }
    asm volatile("s_waitcnt vmcnt(4)" ::: "memory");
    ATT_BAR();
    { const TileSrc s2 = attn_tile_src(P, b, 2, n_slc, lo); attn_dma(lds + 2 * A_TILE, s2, wave, lane); }
    {
        attn_tile<0>(lds + g * 8192, lds + 16384 + g * 8192, qf, O, mrun, lrun, s, lane, 0, qpos, czero, true);
#pragma unroll
        for (int qt = 0; qt < 2; ++qt) {
            float lt = lrun[qt]; lt += __shfl_xor(lt, 16); lt += __shfl_xor(lt, 32);
            const float inv = (lt > 0.f) ? 1.0f / lt : 0.f;
#pragma unroll
            for (int kt = 0; kt < 4; ++kt)
#pragma unroll
                for (int rr = 0; rr < 2; ++rr) IMP[(wave * 32 + 16 * qt + lr) * 33 + 8 * kt + 2 * grp + rr] = (s[qt][kt][2 * rr] + s[qt][kt][2 * rr + 1]) * inv;
        }
        ATT_FINISH(0);
        ATT_BAR();
        for (int i = tid; i < 2 * 32 * 32; i += 512) { const int gg = i >> 10, q = (i >> 5) & 31, j = i & 31;
            IMPS[(gg * 32 + q) * 33 + j] = (IMP[((4 * gg + 0) * 32 + q) * 33 + j] + IMP[((4 * gg + 1) * 32 + q) * 33 + j]) + (IMP[((4 * gg + 2) * 32 + q) * 33 + j] + IMP[((4 * gg + 3) * 32 + q) * 33 + j]); }
        ATT_BAR();
        if (tid < 64) {
            const int gg = tid >> 5, q = tid & 31;
            unsigned mask = 1u | (1u << qblk);
            if (qblk - 1 <= 6) mask = (qblk >= 31) ? 0xffffffffu : ((2u << qblk) - 1u);
            else {
                const LAS float* v = IMPS + (gg * 32 + q) * 33;
                for (int pick = 0; pick < 6; ++pick) { float best = -1.f; int bi = 1;
                    for (int j = 1; j < qblk; ++j) { const float x = v[j]; if (!((mask >> j) & 1u) && x > best) { best = x; bi = j; } }
                    mask |= 1u << bi; }
            }
            SEL[gg * 32 + q] = mask;
        }
        asm volatile("s_waitcnt vmcnt(4)" ::: "memory");
        ATT_BAR();
        selm[0] = SEL[g * 32 + lr]; selm[1] = SEL[g * 32 + 16 + lr];
    }
    int cur = 1, nxt = 0;
    for (int T = 1; T < NT; ++T) {
        const bool more = T + 2 < NT;
        if (more) { const TileSrc sn = attn_tile_src(P, b, T + 2, n_slc, lo); attn_dma(lds + nxt * A_TILE, sn, wave, lane); }
        const LAS unsigned char* Kg = lds + cur * A_TILE + g * 8192; const LAS unsigned char* Vg = Kg + 16384;
        if (T <= n_slc) {
            const int jb = T - 1;
            const float cin[2] = {((selm[0] >> jb) & 1u) ? 0.f : NEGBIG, ((selm[1] >> jb) & 1u) ? 0.f : NEGBIG};
            attn_tile<1>(Kg, Vg, qf, O, mrun, lrun, s, lane, 64 * jb, qpos, cin, jb == qblk);
            if (T == n_slc) ATT_FINISH(1);
        } else {
            const int jt = lo + (T - 1 - n_slc);
            const bool em = (64 * jt + 63 > t0) || (64 * jt <= t0 + 31 - 512);
            attn_tile<2>(Kg, Vg, qf, O, mrun, lrun, s, lane, 64 * jt, qpos, czero, em);
            if (T == NT - 1) ATT_FINISH(2);
        }
        if (more) asm volatile("s_waitcnt vmcnt(4)" ::: "memory"); else asm volatile("s_waitcnt vmcnt(0)" ::: "memory");
        ATT_BAR();
        cur = (cur == 2) ? 0 : cur + 1; nxt = (nxt == 2) ? 0 : nxt + 1;
    }
#undef ATT_FINISH
#pragma unroll
    for (int qt = 0; qt < 2; ++qt) {
        const size_t row = row0 + 16 * qt + lr;
#pragma unroll
        for (int dt = 0; dt < 4; ++dt) {
            const int col = 64 * wave + 16 * dt + 4 * grp;
            float za[4]; unpack4(*(const u32x2*)(ACT + row * NIN + LZA + col), za);
            u32x2 w; w.x = cvt_pk_bf16(OA[dt][qt][0] * za[0], OA[dt][qt][1] * za[1]); w.y = cvt_pk_bf16(OA[dt][qt][2] * za[2], OA[dt][qt][3] * za[3]);
            *(u32x2*)(AB + row * DM + col) = w;
        }
    }
}

constexpr int G_ST = 0, G_VNT = 1024, VPITCH = 136;
__device__ __forceinline__ void gmlp_unit(const Params& P, LAS unsigned char* lds, int b, int ch, int gp, int tid, int lane, int wave) {
    asm volatile("" : "+v"(tid), "+v"(lane));
    const bf16_t* ACT = (const bf16_t*)(P.ws + WS_ACT); bf16_t* AB = (bf16_t*)(P.ws + WS_AB);
    LAS f32x2* ST = (LAS f32x2*)(lds + G_ST); LAS bf16_t* Vnt = (LAS bf16_t*)(lds + G_VNT);
    const size_t R0 = (size_t)b * SEQ + 128 * ch;
    __syncthreads();
    {
        u32x4 raw[16];
#pragma unroll
        for (int i = 0; i < 16; ++i) raw[i] = *(const u32x4*)(ACT + (R0 + wave + 8 * i) * NIN + LVB + 8 * lane);
#pragma unroll
        for (int i = 0; i < 16; ++i) {
            float f[8]; f[0] = bf2f(raw[i].x); f[1] = bf2f(raw[i].x >> 16); f[2] = bf2f(raw[i].y); f[3] = bf2f(raw[i].y >> 16); f[4] = bf2f(raw[i].z); f[5] = bf2f(raw[i].z >> 16); f[6] = bf2f(raw[i].w); f[7] = bf2f(raw[i].w >> 16);
            float sm = 0.f, sq = 0.f;
#pragma unroll
            for (int e = 0; e < 8; ++e) { sm += f[e]; sq += f[e] * f[e]; }
#pragma unroll
            for (int o = 1; o < 64; o <<= 1) { sm += __shfl_xor(sm, o); sq += __shfl_xor(sq, o); }
            const float mean = sm * (1.0f / 512.0f), var = fmaxf(sq * (1.0f / 512.0f) - mean * mean, 0.f);
            if (lane == 0) ST[wave + 8 * i] = (f32x2){mean, rsqrtf(var + 1e-6f)};
        }
    }
    __syncthreads();
    {
        const float* vg = P.in[21] + 256 * gp; const float* vb = P.in[22] + 256 * gp;
        u32x4 raw[4][2];
#pragma unroll
        for (int i = 0; i < 4; ++i) { const int idx = tid + 512 * i, j2 = idx & 63, chn = idx >> 6;
#pragma unroll
            for (int h2 = 0; h2 < 2; ++h2) raw[i][h2] = *(const u32x4*)(ACT + (R0 + 2 * j2 + h2) * NIN + LVB + 256 * gp + 8 * chn); }
#pragma unroll
        for (int i = 0; i < 4; ++i) {
            const int idx = tid + 512 * i, j2 = idx & 63, chn = idx >> 6;
            const f32x2 st0 = ST[2 * j2], st1 = ST[2 * j2 + 1];
            const unsigned w0[4] = {raw[i][0].x, raw[i][0].y, raw[i][0].z, raw[i][0].w}, w1[4] = {raw[i][1].x, raw[i][1].y, raw[i][1].z, raw[i][1].w};
#pragma unroll
            for (int e = 0; e < 8; ++e) { const int d = 8 * chn + e;
                const float a = bf2f(w0[e >> 1] >> (16 * (e & 1))), b2 = bf2f(w1[e >> 1] >> (16 * (e & 1)));
                *(LAS unsigned*)(Vnt + d * VPITCH + 2 * j2) = cvt_pk_bf16((a - st0[0]) * st0[1] * vg[d] + vb[d], (b2 - st1[0]) * st1[1] * vg[d] + vb[d]); }
        }
    }
    __syncthreads();
    const int lr = lane & 15, grp = lane >> 4, g = 2 * gp + (wave >> 2);
    const bf16_t* tril = (const bf16_t*)(P.ws + WS_TRIL) + (size_t)g * 128 * 128;
    f32x4 acc[2][8];
#pragma unroll
    for (int t2 = 0; t2 < 2; ++t2)
#pragma unroll
        for (int it = 0; it < 8; ++it) acc[t2][it] = (f32x4){0.f, 0.f, 0.f, 0.f};
#pragma unroll
    for (int ks = 0; ks < 4; ++ks) {
        const bf16x8 af0 = *(const LAS bf16x8*)(Vnt + (32 * wave + lr) * VPITCH + 32 * ks + 8 * grp);
        const bf16x8 af1 = *(const LAS bf16x8*)(Vnt + (32 * wave + 16 + lr) * VPITCH + 32 * ks + 8 * grp);
#pragma unroll
        for (int it = 0; it < 8; ++it) {
            if ((it >> 1) >= ks) { const bf16x8 bfr = *(const bf16x8*)(tril + (size_t)(16 * it + lr) * 128 + 32 * ks + 8 * grp);
                acc[0][it] = __builtin_amdgcn_mfma_f32_16x16x32_bf16(af0, bfr, acc[0][it], 0, 0, 0); acc[1][it] = __builtin_amdgcn_mfma_f32_16x16x32_bf16(af1, bfr, acc[1][it], 0, 0, 0); }
        }
    }
    const float* bs = P.in[24] + 128 * g;
#pragma unroll
    for (int it = 0; it < 8; ++it) {
        const int i = 16 * it + lr; const size_t row = R0 + i;
        const float bsi = bs[i];
#pragma unroll
        for (int t2 = 0; t2 < 2; ++t2) {
            const int d0 = 256 * gp + 32 * wave + 16 * t2 + 4 * grp;
            float uu[4], zb[4]; unpack4(*(const u32x2*)(ACT + row * NIN + LU + d0), uu); unpack4(*(const u32x2*)(ACT + row * NIN + LZB + d0), zb);
            u32x2 w; w.x = cvt_pk_bf16(uu[0] * (acc[t2][it][0] + bsi) * zb[0], uu[1] * (acc[t2][it][1] + bsi) * zb[1]); w.y = cvt_pk_bf16(uu[2] * (acc[t2][it][2] + bsi) * zb[2], uu[3] * (acc[t2][it][3] + bsi) * zb[3]);
            *(u32x2*)(AB + row * DM + 512 + d0) = w;
        }
    }
}

__device__ __forceinline__ void stile(const float* kb, const float* vb, int stride, int kmin, const f32x4 (&q4)[4], float (&m)[4], float (&l)[4], f32x4 (&o4)[4], float (&pout)[4], int lane_in) {
    int lane = lane_in; asm volatile("" : "+v"(lane));
    const int li = lane & 15, gq = lane >> 4;
    __builtin_amdgcn_sched_barrier(0);
    const float* kl = kb + (size_t)(gq * stride + 4 * li); const float* vl = vb + (size_t)(gq * stride + 4 * li);
    f32x4 kreg[16], vreg[16];
#pragma unroll
    for (int i = 0; i < 16; ++i) kreg[i] = __builtin_nontemporal_load((const f32x4*)(kl + (size_t)(4 * i) * stride));
#pragma unroll
    for (int i = 0; i < 16; ++i) vreg[i] = __builtin_nontemporal_load((const f32x4*)(vl + (size_t)(4 * i) * stride));
    float sc[4];
#pragma unroll
    for (int h = 0; h < 4; ++h) {
        float v[16], w8[8], w4[4], w2[2];
#pragma unroll
        for (int i = 0; i < 16; ++i) v[i] = (kreg[i][0] * q4[h][0] + kreg[i][1] * q4[h][1]) + (kreg[i][2] * q4[h][2] + kreg[i][3] * q4[h][3]);
#pragma unroll
        for (int t = 0; t < 8; ++t) { const float snd = (li & 8) ? v[t] : v[t + 8], kp = (li & 8) ? v[t + 8] : v[t]; w8[t] = kp + __shfl_xor(snd, 8); }
#pragma unroll
        for (int t = 0; t < 4; ++t) { const float snd = (li & 4) ? w8[t] : w8[t + 4], kp = (li & 4) ? w8[t + 4] : w8[t]; w4[t] = kp + __shfl_xor(snd, 4); }
#pragma unroll
        for (int t = 0; t < 2; ++t) { const float snd = (li & 2) ? w4[t] : w4[t + 2], kp = (li & 2) ? w4[t + 2] : w4[t]; w2[t] = kp + __shfl_xor(snd, 2); }
        { const float snd = (li & 1) ? w2[0] : w2[1], kp = (li & 1) ? w2[1] : w2[0]; sc[h] = kp + __shfl_xor(snd, 1); }
        __builtin_amdgcn_sched_barrier(0);
    }
    const bool valid = (4 * li + gq) >= kmin;
#pragma unroll
    for (int h = 0; h < 4; ++h) {
        const float sv = valid ? sc[h] : NEGBIG;
        const float mnew = fmaxf(m[h], wave_max(sv));
        const float alpha = __builtin_amdgcn_exp2f(m[h] - mnew), p = __builtin_amdgcn_exp2f(sv - mnew);
        l[h] = l[h] * alpha + wave_sum(p); o4[h] *= alpha; m[h] = mnew; pout[h] = p;
    }
    const int src0 = lane & 48;
#pragma unroll
    for (int i = 0; i < 16; ++i) {
#pragma unroll
        for (int h = 0; h < 4; ++h) o4[h] += vreg[i] * __shfl(pout[h], src0 + i);
    }
    __builtin_amdgcn_sched_barrier(0);
}
__device__ __forceinline__ void skey(const float* kb, const float* vb, const f32x4 (&q4)[4], float (&m)[4], float (&l)[4], f32x4 (&o4)[4], int lane) {
    const int li = lane & 15, gq = lane >> 4;
    const f32x4 kd = *(const f32x4*)(kb + 4 * li), vd = *(const f32x4*)(vb + 4 * li);
#pragma unroll
    for (int h = 0; h < 4; ++h) {
        float sv = (kd[0] * q4[h][0] + kd[1] * q4[h][1]) + (kd[2] * q4[h][2] + kd[3] * q4[h][3]);
        sv += __shfl_xor(sv, 1); sv += __shfl_xor(sv, 2); sv += __shfl_xor(sv, 4); sv += __shfl_xor(sv, 8);
        const float mnew = fmaxf(m[h], sv), alpha = __builtin_amdgcn_exp2f(m[h] - mnew), p = __builtin_amdgcn_exp2f(sv - mnew);
        l[h] = l[h] * alpha + p; o4[h] *= alpha; if (gq == 0) o4[h] += vd * p; m[h] = mnew;
    }
}

constexpr int S_ST = 0, S_MISC = 8 * 3 * 4 * 66 * 4;
__device__ __forceinline__ void sample_unit(const Params& P, LAS unsigned char* lds, int sb, int g, int tid, int lane, int wave) {
    const bf16_t* ACT = (const bf16_t*)(P.ws + WS_ACT); bf16_t* AB = (bf16_t*)(P.ws + WS_AB);
    LAS float* ST = (LAS float*)(lds + S_ST); LAS float* MISC = (LAS float*)(lds + S_MISC);
    const size_t row = (size_t)MP + sb;
    const int* ptab = (const int*)P.in[8] + sb * 16;
    const int li = lane & 15;
    __syncthreads();
    f32x4 q4[4];
#pragma unroll
    for (int h = 0; h < 4; ++h) { float t4[4]; unpack4(*(const u32x2*)(ACT + row * NIN + LQ + 64 * (4 * g + h) + 4 * li), t4); q4[h] = (f32x4){t4[0], t4[1], t4[2], t4[3]}; }
    float ms[4], ls[4]; f32x4 os[4];
#define S_RESET() do { _Pragma("unroll") for (int h = 0; h < 4; ++h) { ms[h] = MINIT; ls[h] = 0.f; os[h] = (f32x4){0.f, 0.f, 0.f, 0.f}; } } while (0)
#define S_PUBLISH(b2, doit) do { _Pragma("unroll") for (int h = 0; h < 4; ++h) { f32x4 v = os[h]; \
        _Pragma("unroll") for (int e = 0; e < 4; ++e) { float x = v[e]; x += __shfl_xor(x, 16); x += __shfl_xor(x, 32); v[e] = x; } \
        if (doit) { LAS float* st = ST + ((wave * 3 + (b2)) * 4 + h) * 66; if (lane < 16) *(LAS f32x4*)(st + 4 * lane) = v; if (lane == 0) { st[64] = ms[h]; st[65] = ls[h]; } } } } while (0)
    float pdummy[4], pc[4];
    S_RESET();
    { const size_t off = (((size_t)sb * 512 + 64 * wave) * 2 + g) * 64; stile(P.in[6] + off, P.in[7] + off, 128, (wave == 0) ? 1 : 0, q4, ms, ls, os, pdummy, lane); }
    if (wave == 0) { const size_t off = ((size_t)(sb * 512 + 511) * 2 + g) * 64; skey(P.out + O_SKW + off, P.out + O_SVW + off, q4, ms, ls, os, lane); }
    S_PUBLISH(1, true);
    S_RESET();
    stile((const float*)(P.ws + WS_KCS) + (size_t)(sb * 2 + g) * 4096, (const float*)(P.ws + WS_VCS) + (size_t)(sb * 2 + g) * 4096, 64, 0, q4, ms, ls, os, pc, lane);
    float imp = 0.f;
#pragma unroll
    for (int h = 0; h < 4; ++h) { const float pn = pc[h] / ls[h]; imp += pn + __shfl_down(pn, 16); }
    S_PUBLISH(2, wave == 0);
    const int jblk = 2 * li + (lane >> 5);
    const bool cand = ((lane >> 4) & 1) == 0 && jblk >= 1;
    unsigned key = cand ? ((__builtin_bit_cast(unsigned, imp) & 0xffffffe0u) | (unsigned)(31 - jblk)) : 0u;
    unsigned long long selpack = 0ull;
#pragma unroll
    for (int pick = 0; pick < 6; ++pick) {
        unsigned best = key;
#pragma unroll
        for (int o2 = 1; o2 < 64; o2 <<= 1) { const unsigned other = (unsigned)__shfl_xor((int)best, o2); best = other > best ? other : best; }
        const int bj = 31 - (int)(best & 31u);
        selpack |= (unsigned long long)bj << (5 * (pick + 1));
        if (cand && jblk == bj) key = 0u;
    }
    S_RESET();
    if (wave < 7) { const int blk = (int)((selpack >> (5 * wave)) & 31ull); const int page = __builtin_amdgcn_readfirstlane(ptab[blk >> 1]); const size_t off = (((size_t)page * 128 + (blk & 1) * 64) * 2 + g) * 64;
        stile(P.in[4] + off, P.in[5] + off, 128, 0, q4, ms, ls, os, pdummy, lane); }
    else skey(P.out + O_SKS + (size_t)sb * 128 + g * 64, P.out + O_SVS + (size_t)sb * 128 + g * 64, q4, ms, ls, os, lane);
    S_PUBLISH(0, true);
#undef S_RESET
#undef S_PUBLISH
    if (wave == 7) {
        const u32x4 raw = *(const u32x4*)(ACT + row * NIN + LVB + 8 * lane);
        float f[8]; f[0] = bf2f(raw.x); f[1] = bf2f(raw.x >> 16); f[2] = bf2f(raw.y); f[3] = bf2f(raw.y >> 16); f[4] = bf2f(raw.z); f[5] = bf2f(raw.z >> 16); f[6] = bf2f(raw.w); f[7] = bf2f(raw.w >> 16);
        float sm = 0.f;
#pragma unroll
        for (int i = 0; i < 8; ++i) sm += f[i];
        const float mean = wave_sum(sm) * (1.0f / 512.0f); float sq = 0.f;
#pragma unroll
        for (int i = 0; i < 8; ++i) { const float d = f[i] - mean; sq += d * d; }
        const float rstd = rsqrtf(wave_sum(sq) * (1.0f / 512.0f) + 1e-6f);
        if (lane == 0) { MISC[0] = mean; MISC[1] = rstd; }
    }
    __syncthreads();
    if (wave < 4) {
        const int h = wave, head = 4 * g + h;
        const LAS float* stc = ST + ((0 * 3 + 2) * 4 + h) * 66;
        float oa = bf2f(ACT[row * NIN + LNSA + 3 * head + 0]) * stc[lane] / stc[65];
#pragma unroll
        for (int b2 = 0; b2 < 2; ++b2) {
            float M = MINIT;
#pragma unroll
            for (int w = 0; w < 8; ++w) M = fmaxf(M, ST[((w * 3 + b2) * 4 + h) * 66 + 64]);
            float L = 0.f, O = 0.f;
#pragma unroll
            for (int w = 0; w < 8; ++w) { const LAS float* st = ST + ((w * 3 + b2) * 4 + h) * 66; const float f = __builtin_amdgcn_exp2f(st[64] - M); L += st[65] * f; O += st[lane] * f; }
            oa += bf2f(ACT[row * NIN + LNSA + 3 * head + 1 + b2]) * O / L;
        }
        const int col = 64 * head + lane;
        AB[row * DM + col] = (bf16_t)f2bf(oa * bf2f(ACT[row * NIN + LZA + col]));
    }
    if (tid < 256) {
        const int d = 256 * g + tid, gm = d >> 7;
        const float vn = (bf2f(ACT[row * NIN + LVB + d]) - MISC[0]) * MISC[1] * P.in[21][d] + P.in[22][d];
        P.out[O_SVCH + (size_t)sb * 512 + d] = vn;
        const float sv = P.in[23][(size_t)gm * 128 * 128] * vn + P.in[24][gm * 128];
        AB[row * DM + 512 + d] = (bf16_t)f2bf(bf2f(ACT[row * NIN + LU + d]) * sv * bf2f(ACT[row * NIN + LZB + d]));
    }
}

template <int MODE>
__device__ __forceinline__ void small_gemm(const Params& P, int c, int G, int wave, int lane) {
    const int lr = lane & 15, grp = lane >> 4;
    for (int t = c + G * wave; t < 512; t += G * 8) {
        const int rt = t & 7, ct = t >> 3;
        const size_t row = (size_t)MP + 16 * rt + lr;
        const bf16_t* A = (const bf16_t*)(P.ws + (MODE == 0 ? WS_AB : WS_H)) + row * DM + 8 * grp;
        const int wrow = (MODE == 0) ? (256 * (ct >> 4) + 128 * ((ct >> 1) & 1) + 32 * ((ct >> 2) & 3) + 16 * (ct & 1) + lr) : (16 * ct + lr);
        const bf16_t* W = (const bf16_t*)(P.ws + (MODE == 0 ? WS_WTBR : WS_WTOUT)) + (size_t)wrow * DM + 8 * grp;
        f32x4 acc0 = (f32x4){0.f, 0.f, 0.f, 0.f}, acc1 = (f32x4){0.f, 0.f, 0.f, 0.f};
#pragma unroll
        for (int ks = 0; ks < 16; ++ks) acc0 = __builtin_amdgcn_mfma_f32_16x16x32_bf16(*(const bf16x8*)(W + 32 * ks), *(const bf16x8*)(A + 32 * ks), acc0, 0, 0, 0);
#pragma unroll
        for (int ks = 16; ks < 32; ++ks) acc1 = __builtin_amdgcn_mfma_f32_16x16x32_bf16(*(const bf16x8*)(W + 32 * ks), *(const bf16x8*)(A + 32 * ks), acc1, 0, 0, 0);
        const int col = 16 * ct + 4 * grp;
        if (MODE == 0) {
            const int i = 16 * rt + lr, cc = col & 255;
            const size_t go = ((size_t)(((64 * 8 + (col >> 8)) * 8 + (i >> 6) * 4 + (cc >> 6)) * 32 + ((((i >> 4) & 3) * 2 + ((cc >> 5) & 1)) * 2 + ((cc >> 4) & 1))) * 64 + ((cc >> 2) & 3) * 16 + (i & 15)) * 4;
            const bf16_t* GB = (const bf16_t*)(P.ws + WS_GBUF);
            float sa[4], sb[4]; unpack4(*(const u32x2*)(GB + go), sa); unpack4(*(const u32x2*)(GB + go + (size_t)4 * 8 * 32 * 256), sb);
            u32x2 w; w.x = cvt_pk_bf16(sa[0] * acc0[0] + sb[0] * acc1[0], sa[1] * acc0[1] + sb[1] * acc1[1]); w.y = cvt_pk_bf16(sa[2] * acc0[2] + sb[2] * acc1[2], sa[3] * acc0[3] + sb[3] * acc1[3]);
            *(u32x2*)((bf16_t*)(P.ws + WS_H) + row * DM + col) = w;
        } else {
            const int sbi = 16 * rt + lr;
            const f32x4 xv = *(const f32x4*)(P.in[1] + (size_t)sbi * DM + col), gv = *(const f32x4*)((const float*)(P.ws + WS_MOD) + (size_t)(8 + sbi) * 3072 + 2048 + col);
            *(f32x4*)(P.out + O_YS + (size_t)sbi * DM + col) = xv + gv * (acc0 + acc1);
        }
    }
}

#define XB_TMO      128
#define XB_XCNT(j)  (256  + 64 * (j))
#define XB_XSUB(j)  (1280 + 64 * (j))
#define XB_XGEN(j)  (2304 + 64 * (j))
#define XB_TOP      3328
#define XB_TOPGEN   3392
#define XCD_BAR_WORDS 3456
#define XB_SPIN_CAP (1u << 18)
__device__ __forceinline__ unsigned xb_ld(unsigned* p)              { return __hip_atomic_load(p, __ATOMIC_RELAXED, __HIP_MEMORY_SCOPE_AGENT); }
__device__ __forceinline__ unsigned xb_add(unsigned* p, unsigned v) { return __hip_atomic_fetch_add(p, v, __ATOMIC_RELAXED, __HIP_MEMORY_SCOPE_AGENT); }
__device__ __forceinline__ unsigned xb_xcc_id() { return (unsigned)__builtin_amdgcn_s_getreg((3 << 11) | 20) & 0xFu; }
#define XB_SPIN(cond, bar) do { unsigned _sp = 0; while (cond) { __builtin_amdgcn_s_sleep(1); \
    if ((++_sp & 255u) == 0u) { if (xb_ld(&(bar)[XB_TMO])) break; if (_sp > XB_SPIN_CAP) { atomicAdd(&(bar)[XB_TMO], 1u); break; } } } } while (0)
struct XcdBarrier { unsigned* bar; unsigned x; volatile LAS unsigned* st; };
__device__ __forceinline__ XcdBarrier xcd_barrier_post(unsigned* bar, volatile LAS unsigned* st) {
    XcdBarrier b; b.bar = bar; b.x = xb_xcc_id(); b.st = st;
    if (threadIdx.x == 0) (void)xb_add(&bar[XB_XCNT(b.x)], 1u);
    return b;
}
__device__ __forceinline__ void xcd_barrier_complete(unsigned* bar, unsigned x, unsigned& nloc, unsigned& nx) {
    const unsigned G = gridDim.x * gridDim.y * gridDim.z;
    unsigned sum, cnt, mine, sp = 0u;
    for (;;) {
        sum = 0u; cnt = 0u; mine = 0u;
#pragma unroll
        for (unsigned j = 0; j < 16; ++j) { const unsigned c = xb_ld(&bar[XB_XCNT(j)]); sum += c; cnt += (c > 0u) ? 1u : 0u; mine = (j == x) ? c : mine; }
        if (sum == G) break;
        __builtin_amdgcn_s_sleep(1);
        if ((++sp & 255u) == 0u) { if (xb_ld(&bar[XB_TMO])) break; if (sp > XB_SPIN_CAP) { atomicAdd(&bar[XB_TMO], 1u); break; } }
    }
    nloc = mine > 0u ? mine : 1u; nx = cnt > 0u ? cnt : 1u;
}
__device__ __forceinline__ void xcd_barrier(const XcdBarrier& b) {
    asm volatile("s_waitcnt vmcnt(0)" ::: "memory");
    __syncthreads();
    if (threadIdx.x == 0) {
        unsigned* bar = b.bar;
        __builtin_amdgcn_s_waitcnt(0);
        unsigned nloc = b.st[0], nx = b.st[1];
        if (nloc == 0u) { xcd_barrier_complete(bar, b.x, nloc, nx); b.st[0] = nloc; b.st[1] = nx; }
        const unsigned old = xb_add(&bar[XB_XSUB(b.x)], 1u);
        const unsigned gen = old / nloc;
        if (old + 1u == (gen + 1u) * nloc) {
            __builtin_amdgcn_fence(__ATOMIC_RELEASE, "agent");
            asm volatile("s_waitcnt vmcnt(0)" ::: "memory");
            const unsigned og = xb_add(&bar[XB_TOP], 1u);
            const unsigned tg = og / nx;
            if (og + 1u == (tg + 1u) * nx) xb_add(&bar[XB_TOPGEN], 1u);
            else XB_SPIN(xb_ld(&bar[XB_TOPGEN]) == tg, bar);
            __builtin_amdgcn_fence(__ATOMIC_ACQUIRE, "agent");
            xb_add(&bar[XB_XGEN(b.x)], 1u);
            asm volatile("s_waitcnt vmcnt(0)" ::: "memory");
        } else {
            XB_SPIN(xb_ld(&bar[XB_XGEN(b.x)]) == gen, bar);
            __builtin_amdgcn_fence(__ATOMIC_ACQUIRE, "agent");
            asm volatile("s_waitcnt vmcnt(0)" ::: "memory");
        }
    }
    __syncthreads();
}

__global__ void __launch_bounds__(512, 2) mk_fwd(Params P) {
    extern __shared__ __attribute__((aligned(16))) unsigned char lds_raw[];
    LAS unsigned char* lds = (LAS unsigned char*)lds_raw;
    const int tid = threadIdx.x, lane = tid & 63, wave = __builtin_amdgcn_readfirstlane(tid >> 6);
    const int G = gridDim.x, c = blockIdx.x, gw = c * 8 + wave, NGW = G * 8, gtid = c * 512 + tid, NT = G * 512;
    cg::grid_group grid = cg::this_grid();
    const int lo = P.ph_lo, hi = P.ph_hi;
    if (tid < 16) ((LAS unsigned*)(lds + LDS_XB))[tid] = 0u;
    __syncthreads();
    const XcdBarrier bar = xcd_barrier_post((unsigned*)(P.ws + WS_CTL), (volatile LAS unsigned*)(lds + LDS_XB));
    if (hi < 0) grid.sync();
#define IN(k) (lo <= (k) && (k) < hi)
#define SEAM(k) do { if (IN(k) && IN((k) + 1)) xcd_barrier(bar); } while (0)
    unsigned char* ws = P.ws;
    if (IN(0)) for (int rep = 0; rep < MK_REP0; ++rep) { p0_prologue(P, lds, gw, NGW, lane, wave, gtid, NT); }
    SEAM(0);
    if (IN(1)) for (int rep = 0; rep < MK_REP1; ++rep) { p1_hrows(P, gw, NGW, lane); }
    SEAM(1);
    if (IN(2)) for (int rep = 0; rep < MK_REP2; ++rep) {
        pg8::Gemm gm{(const bf16_t*)(ws + WS_H), (const bf16_t*)(ws + WS_WTIN), DM, DM, DM};
        pg8::StaticOrder S; S.init(MPAD / 256, NIN / 256, G, c);
        EpiInProj E{(bf16_t*)(ws + WS_ACT), (bf16_t*)(ws + WS_VT), (bf16_t*)(ws + WS_GBUF), P.out, P.in[15], P.in[16], (const float*)(ws + WS_ROPE), lds + LDS_EPI};
        pg8::gemm_phase<EpiInProj, pg8::StaticOrder>(lds, gm, S, E);
        { const int nwg = (MPAD / 256) * (NIN / 256), nlast = nwg % G;
          if (nlast != 0 && c >= nlast) { const int nidle = (G - nlast) * 8, iw = (c - nlast) * 8 + wave;
              for (int u = (1616 + 776) + iw; u < 4096; u += nidle) pool_item(P, (LAS float*)(lds + wave * 16384), u, lane); }
          else if (nlast == 0) { for (int u = (1616 + 776) + gw; u < 4096; u += NGW) pool_item(P, (LAS float*)(lds + wave * 16384), u, lane); } }
    }
    SEAM(2);
    if (IN(3)) for (int rep = 0; rep < MK_REP3; ++rep) { p3_compress(P, lds, gw, NGW, lane, wave); }
    SEAM(3);
    if (IN(4)) for (int rep = 0; rep < MK_REP4; ++rep) {
        asm volatile("" ::: "memory");
        for (int i = 0;; ++i) { const int a = (i & 1) ? (i + 1) * G - 1 - c : i * G + c; if (a >= 512 || a < 0) break; attn_unit(P, lds, a & 7, 63 - (a >> 3), tid, lane, wave); }
        {
            unsigned* qctr = (unsigned*)(ws + WS_CTL) + 3584;
            LAS unsigned* qsl = (LAS unsigned*)(lds + LDS_XB + 32);
            for (;;) {
                __syncthreads();
                if (tid == 0) *qsl = __hip_atomic_fetch_add(qctr, 1u, __ATOMIC_RELAXED, __HIP_MEMORY_SCOPE_AGENT);
                __syncthreads();
                const int u = (int)*qsl;
                if (u >= 512) break;
                if (u < 256) gmlp_unit(P, lds, u >> 5, (u >> 1) & 15, u & 1, tid, lane, wave);
                else { const int su = u - 256; sample_unit(P, lds, su >> 1, su & 1, tid, lane, wave); }
            }
        }
        __syncthreads();
    }
    SEAM(4);
    if (IN(5)) for (int rep = 0; rep < MK_REP5; ++rep) {
        pg8::Gemm gm{(const bf16_t*)(ws + WS_AB), (const bf16_t*)(ws + WS_WTBR), DM, DM, 512};
        small_gemm<0>(P, c, G, wave, lane);
        pg8::PairOrder S; S.S.init(MP / 256, DM / 256, G, c);
        EpiMix E{(const bf16_t*)(ws + WS_GBUF), (bf16_t*)(ws + WS_H)};
        pg8::gemm_phase<EpiMix, pg8::PairOrder>(lds, gm, S, E);
    }
    SEAM(5);
    if (IN(6)) for (int rep = 0; rep < MK_REP6; ++rep) {
        pg8::Gemm gm{(const bf16_t*)(ws + WS_H), (const bf16_t*)(ws + WS_WTOUT), DM, DM, DM};
        small_gemm<1>(P, c, G, wave, lane);
        pg8::StaticOrder S; S.init(MP / 256, DM / 256, G, c);
        EpiOut E{P.in[0], P.in[1], (const float*)(ws + WS_MOD), P.out};
        pg8::gemm_phase<EpiOut, pg8::StaticOrder>(lds, gm, S, E);
    }
#undef IN
#undef SEAM
}

extern "C" void kernel_launch(void* const* d_in, const int* in_sizes, int n_in, void* d_out, int out_size, void* d_ws, size_t ws_size, hipStream_t stream) {
    static int grid = 0;
    if (grid == 0) {
        if (n_in != 28 || out_size != (int)O_END || ws_size < WS_END) { fprintf(stderr, "kernel_launch: unexpected shapes (n_in %d, out %d, ws %zu); nothing launched\n", n_in, out_size, ws_size); grid = -1; return; }
        int dev = 0, cus = 0, per_cu = 0;
        if (hipGetDevice(&dev) != hipSuccess || hipDeviceGetAttribute(&cus, hipDeviceAttributeMultiprocessorCount, dev) != hipSuccess) { grid = -1; return; }
        if (hipFuncSetAttribute((const void*)mk_fwd, hipFuncAttributeMaxDynamicSharedMemorySize, LDS_BYTES) != hipSuccess) { fprintf(stderr, "kernel_launch: hipFuncSetAttribute failed\n"); grid = -1; return; }
        if (hipOccupancyMaxActiveBlocksPerMultiprocessor(&per_cu, (const void*)mk_fwd, 512, LDS_BYTES) != hipSuccess || per_cu < 1) { fprintf(stderr, "kernel_launch: occupancy query failed (%d)\n", per_cu); (void)hipGetLastError(); per_cu = 1; }
        if (per_cu > 1) per_cu = 1;
        grid = cus * per_cu;
    }
    if (grid < 0) return;
    if (hipMemsetAsync((char*)d_ws + WS_CTL, 0, CTL_BYTES, stream) != hipSuccess) { fprintf(stderr, "kernel_launch: hipMemsetAsync failed\n"); return; }
    Params p{};
    for (int i = 0; i < 28; ++i) p.in[i] = (const float*)d_in[i];
    p.out = (float*)d_out; p.ws = (unsigned char*)d_ws;
#if MK_N_LAUNCHES == 1
    p.ph_lo = 0; p.ph_hi = 7;
    void* args[] = {&p};
    hipError_t e = hipLaunchCooperativeKernel((const void*)mk_fwd, dim3(grid), dim3(512), args, LDS_BYTES, stream);
    if (e != hipSuccess) fprintf(stderr, "kernel_launch: cooperative launch failed: %s (grid %d)\n", hipGetErrorString(e), grid);
#else
    for (int ph = 0; ph < 7; ++ph) {
        p.ph_lo = ph; p.ph_hi = ph + 1;
        void* args[] = {&p};
        hipError_t e = hipLaunchCooperativeKernel((const void*)mk_fwd, dim3(grid), dim3(512), args, LDS_BYTES, stream);
        if (e != hipSuccess) { fprintf(stderr, "kernel_launch: launch %d failed: %s (grid %d)\n", ph, hipGetErrorString(e), grid); break; }
    }
#endif
}
```

```cpp
#include <hip/hip_runtime.h>
#include <hip/hip_cooperative_groups.h>
#include <cstdio>
#include <cstdint>
namespace cg = cooperative_groups;

#ifndef MK_N_LAUNCHES
#define MK_N_LAUNCHES 1
#endif
#define MK_REP0 1
#define MK_REP1 1
#define MK_REP2 1
#define MK_REP3 1
#define MK_REP4 1
#define MK_REP5 1
#define MK_REP6 1

#define LAS __attribute__((address_space(3)))
typedef unsigned short bf16_t;
typedef short bf16x8 __attribute__((ext_vector_type(8)));
typedef short bf16x4 __attribute__((ext_vector_type(4)));
typedef float f32x4 __attribute__((ext_vector_type(4)));
typedef float f32x2 __attribute__((ext_vector_type(2)));
typedef unsigned u32x4 __attribute__((ext_vector_type(4)));
typedef unsigned u32x2 __attribute__((ext_vector_type(2)));

constexpr int DM = 1024, SEQ = 2048, NBATCH = 8, MP = NBATCH * SEQ, NSB = 128, MTOT = MP + NSB, MPAD = 16640;
constexpr int NIN = 5632;
constexpr int LQ = 0, LK = 512, LV = 896, LZA = 1280, LU = 1792, LVB = 2304, LZB = 2816, LGA = 3328, LGB = 4352, LNSA = 5376;
constexpr float C2Q = 0.125f * 1.4426950408889634f;
constexpr float NEGBIG = -1e30f, MINIT = -1e29f;
#define VPERM32(k) (8 * (((k) >> 2) & 3) + 4 * (((k) >> 4) & 1) + ((k) & 3))
constexpr size_t O_YP = 0, O_YS = 16777216, O_PKC = 16908288, O_PVC = 19005440, O_PKS = 21102592, O_PVS = 23199744, O_PKW = 25296896, O_PVW = 25821184,
                 O_SKC = 26345472, O_SVC = 26361856, O_SKS = 26378240, O_SVS = 26394624, O_SKW = 26411008, O_SVW = 34799616, O_SVCH = 43188224, O_END = 43253760;
constexpr size_t MiB = 1u << 20;
constexpr size_t WS_ROPE = 0, WS_MOD = 1 * MiB, WS_WTIN = 3 * MiB, WS_WTBR = 14 * MiB, WS_WTOUT = 16 * MiB, WS_TRIL = 18 * MiB, WS_KC = 18 * MiB + 512 * 1024, WS_VCT = WS_KC + 128 * 1024,
                 WS_KCS = 19 * MiB, WS_VCS = 23 * MiB, WS_VT = 27 * MiB, WS_H = 40 * MiB, WS_AB = 73 * MiB, WS_ACT = 106 * MiB, WS_GBUF = 285 * MiB, WS_END = 355 * MiB;
constexpr size_t WS_CTL = 768 * 1024, CTL_BYTES = 16384;
constexpr int LDS_BYTES = 151552, LDS_XB = LDS_BYTES - 64;
constexpr int LDS_EPI = 131072, EPI_PITCH = 144, EPI_WAVE = 16 * EPI_PITCH;
static_assert(LDS_EPI + 8 * EPI_WAVE <= LDS_XB - 64, "epilogue staging");

struct Params { const float* in[28]; float* out; unsigned char* ws; int ph_lo, ph_hi; };

__device__ __forceinline__ unsigned f2bf(float f) { unsigned u = __builtin_bit_cast(unsigned, f); return (u + 0x7fffu + ((u >> 16) & 1u)) >> 16; }
__device__ __forceinline__ unsigned cvt_pk_bf16(float lo, float hi);
__device__ __forceinline__ unsigned pk2(float lo, float hi) { return cvt_pk_bf16(lo, hi); }
__device__ __forceinline__ float bf2f(unsigned b) { return __builtin_bit_cast(float, (b & 0xffffu) << 16); }
typedef __bf16 bf16x2_t __attribute__((ext_vector_type(2)));
__device__ __forceinline__ unsigned cvt_pk_bf16(float lo, float hi) { const f32x2 v = {lo, hi}; const bf16x2_t b = __builtin_convertvector(v, bf16x2_t); return __builtin_bit_cast(unsigned, b); }
__device__ __forceinline__ void stage_store_rows(LAS unsigned char* sw, int lane, int fr, int fq, const u32x2 (&w)[2][2], bf16_t* dst0, size_t pitch, int nrows) {
#pragma unroll
    for (int bj = 0; bj < 2; ++bj)
#pragma unroll
        for (int n = 0; n < 2; ++n) *(LAS u32x2*)(sw + fr * EPI_PITCH + (32 * bj + 16 * n + 4 * fq) * 2) = w[bj][n];
    const int r = lane >> 3, ch = lane & 7;
    const u32x4 v0 = *(const LAS u32x4*)(sw + r * EPI_PITCH + ch * 16), v1 = *(const LAS u32x4*)(sw + (r + 8) * EPI_PITCH + ch * 16);
    if (r < nrows) *(u32x4*)(dst0 + (size_t)r * pitch + ch * 8) = v0;
    if (r + 8 < nrows) *(u32x4*)(dst0 + (size_t)(r + 8) * pitch + ch * 8) = v1;
}
__device__ __forceinline__ float sigmoidf_(float x) { return __builtin_amdgcn_rcpf(1.0f + __builtin_amdgcn_exp2f(x * -1.4426950408889634f)); }
template <int CTRL, int BANK_MASK>
__device__ __forceinline__ float dpp_mov(float old, float x) { return __builtin_bit_cast(float, __builtin_amdgcn_update_dpp(__builtin_bit_cast(int, old), __builtin_bit_cast(int, x), CTRL, 0xF, BANK_MASK, false)); }
template <int M>
__device__ __forceinline__ float xs(float x) {
    if (M == 1) return dpp_mov<0xB1, 0xF>(x, x);
    if (M == 2) return dpp_mov<0x4E, 0xF>(x, x);
    if (M == 8) return dpp_mov<0x128, 0xF>(x, x);
    const float r = dpp_mov<0x104, 0x5>(x, x);
    return dpp_mov<0x114, 0xA>(r, x);
}
__device__ __forceinline__ float rl(float x, int l) { return __builtin_bit_cast(float, __builtin_amdgcn_readlane(__builtin_bit_cast(int, x), l)); }
__device__ __forceinline__ float wave_sum(float v) {
    v += xs<1>(v); v += xs<2>(v); v += dpp_mov<0x124, 0xF>(v, v); v += xs<8>(v);
    return (rl(v, 0) + rl(v, 16)) + (rl(v, 32) + rl(v, 48));
}
__device__ __forceinline__ float wave_max(float v) {
    v = fmaxf(v, xs<1>(v)); v = fmaxf(v, xs<2>(v)); v = fmaxf(v, dpp_mov<0x124, 0xF>(v, v)); v = fmaxf(v, xs<8>(v));
    return fmaxf(fmaxf(rl(v, 0), rl(v, 16)), fmaxf(rl(v, 32), rl(v, 48)));
}
__device__ __forceinline__ unsigned wave_max_u(unsigned u) {
    auto mv = [](unsigned a, float moved) { const unsigned b = __builtin_bit_cast(unsigned, moved); return b > a ? b : a; };
    float f = __builtin_bit_cast(float, u);
    u = mv(u, xs<1>(f)); f = __builtin_bit_cast(float, u); u = mv(u, xs<2>(f)); f = __builtin_bit_cast(float, u); u = mv(u, dpp_mov<0x124, 0xF>(f, f)); f = __builtin_bit_cast(float, u); u = mv(u, xs<8>(f));
    const unsigned a = (unsigned)__builtin_amdgcn_readlane((int)u, 0), b = (unsigned)__builtin_amdgcn_readlane((int)u, 16), c = (unsigned)__builtin_amdgcn_readlane((int)u, 32), d = (unsigned)__builtin_amdgcn_readlane((int)u, 48);
    const unsigned ab = a > b ? a : b, cd = c > d ? c : d; return ab > cd ? ab : cd;
}
__device__ __forceinline__ float row0_bcast(float m) {
    const unsigned u = __builtin_bit_cast(unsigned, m);
    const unsigned a = __builtin_amdgcn_permlane16_swap(u, u, false, false)[0];
    return __builtin_bit_cast(float, __builtin_amdgcn_permlane32_swap(a, a, false, false)[0]);
}
__device__ __forceinline__ void unpack4(u32x2 w, float (&f)[4]) { f[0] = bf2f(w.x); f[1] = bf2f(w.x >> 16); f[2] = bf2f(w.y); f[3] = bf2f(w.y >> 16); }

namespace pg8 {
constexpr int BM = 256, BK = 64, HALF = 128, HTB = HALF * BK * 2, STAGE_BYTES = 8 * HTB, NXCD = 8, WGM = 8;
__host__ __device__ __forceinline__ int lds_byte(int r, int c) { const int st = (r >> 4) * 2 + (c >> 5), rr = r & 15, cc = c & 31, ob = rr * 64 + cc * 2; return st * 1024 + (ob ^ (((ob >> 9) & 1) << 5)); }
__host__ __device__ __forceinline__ void stage_rc(int b, int& R, int& C) { const int st = b / 1024, sb = b % 1024, swz = sb ^ (((sb >> 9) & 1) << 5); R = (st >> 1) * 16 + swz / 64; C = (st & 1) * 32 + (swz % 64) / 2; }

struct Unit { int pm, pn, kofs, keep; };
struct Gemm { const bf16_t* A; const bf16_t* Bt; int lda, ldb, K; };

struct StaticOrder {
    int nM, nN, nwg, G, c;
    __device__ void init(int nM_, int nN_, int G_, int c_) { nM = nM_; nN = nN_; nwg = nM * nN; G = G_; c = c_; }
    __device__ bool tile(int i, int& pm, int& pn) const {
        const long L = (long)i * G + c; if (L >= nwg) return false;
        int wgid = (int)L; { const int q = nwg / NXCD, r = nwg % NXCD, xcd = wgid % NXCD, off = wgid / NXCD; wgid = (xcd < r ? xcd * (q + 1) : r * (q + 1) + (xcd - r) * q) + off; }
        const int nig = WGM * nN, gid = wgid / nig, fm = gid * WGM, gsz = (nM - fm) < WGM ? (nM - fm) : WGM;
        pm = fm + ((wgid % nig) % gsz); pn = (wgid % nig) / gsz; return true;
    }
    __device__ bool next(int i, Unit& u) const { u.kofs = 0; u.keep = 0; return tile(i, u.pm, u.pn); }
};
struct PairOrder {
    StaticOrder S;
    __device__ bool next(int i, Unit& u) const { u.kofs = (i & 1) * 512; u.keep = (i & 1) ? 0 : 1; return S.tile(i >> 1, u.pm, u.pn); }
};

template <class Epi, class Sched>
__device__ __forceinline__ void gemm_phase(LAS unsigned char* lds, const Gemm g, const Sched& S, const Epi& E) {
    const int tid = threadIdx.x, wid = __builtin_amdgcn_readfirstlane(tid >> 6), lane = tid & 63, wr = wid >> 2, wc = wid & 3, fr = lane & 15, fq = lane >> 4;
    const int nt = g.K / BK;
    unsigned voffA[2], voffB[2];
#pragma unroll
    for (int i = 0; i < 2; ++i) { int R, C; stage_rc(tid * 16 + i * 8192, R, C); voffA[i] = (unsigned)(R * g.lda + C) * 2u; voffB[i] = (unsigned)(R * g.ldb + C) * 2u; }
    const size_t kstep = (size_t)(BK * 2);
    const size_t hstepA = (size_t)HALF * g.lda * 2, hstepB = (size_t)HALF * g.ldb * 2, tstepA = 2 * hstepA, tstepB = 2 * hstepB;
    const unsigned ldsw = (unsigned)wid * 1024u;
    const int aoff = lds_byte(wr * 64 + fr, fq * 8), boff = lds_byte(wc * 32 + fr, fq * 8);
#define PG8_SA(b, h) (((b) * 2 + (h)) * HTB)
#define PG8_SB(b, h) ((4 + (b) * 2 + (h)) * HTB)
#define PG8_STAGE(bufoff, gbase, voff) do { _Pragma("unroll") for (int _i = 0; _i < 2; ++_i) \
        __builtin_amdgcn_global_load_lds((const unsigned*)((const char*)(gbase) + (voff)[_i]), (LAS unsigned*)(lds + (bufoff) + ldsw + _i * 8192), 16, 0, 0); } while (0)
#define PG8_LDA(dst, b, h) do { _Pragma("unroll") for (int m = 0; m < 4; ++m) _Pragma("unroll") for (int k = 0; k < 2; ++k) dst[m][k] = *(const LAS bf16x8*)(lds + PG8_SA(b, h) + aoff + m * 2048 + k * 1024); } while (0)
#define PG8_LDB(dst, b, h) do { _Pragma("unroll") for (int n = 0; n < 2; ++n) _Pragma("unroll") for (int k = 0; k < 2; ++k) dst[n][k] = *(const LAS bf16x8*)(lds + PG8_SB(b, h) + boff + n * 2048 + k * 1024); } while (0)
#define PG8_MMA(ai, bj, At, Bt) do { __builtin_amdgcn_s_setprio(1); _Pragma("unroll") for (int m = 0; m < 4; ++m) _Pragma("unroll") for (int n = 0; n < 2; ++n) _Pragma("unroll") for (int k = 0; k < 2; ++k) \
        acc[ai][bj][m][n] = __builtin_amdgcn_mfma_f32_16x16x32_bf16(Bt[n][k], At[m][k], acc[ai][bj][m][n], 0, 0, 0); __builtin_amdgcn_s_setprio(0); } while (0)
#define PG8_WAIT_V(n) asm volatile("s_waitcnt vmcnt(" #n ")" ::: "memory")
#define PG8_WAIT_L(n) asm volatile("s_waitcnt lgkmcnt(" #n ")" ::: "memory")
#define PG8_BAR __builtin_amdgcn_s_barrier()
#define PG8_SCHED __builtin_amdgcn_sched_barrier(0)
    Unit cur, nxt; int ui = 0;
    if (!S.next(0, cur)) return;
    f32x4 acc[2][2][4][2];
#pragma unroll
    for (int a = 0; a < 2; ++a)
#pragma unroll
        for (int b = 0; b < 2; ++b)
#pragma unroll
            for (int m = 0; m < 4; ++m)
#pragma unroll
                for (int n = 0; n < 2; ++n) acc[a][b][m][n] = (f32x4){0.f, 0.f, 0.f, 0.f};
    bf16x8 At[4][2], B0[2][2], B1[2][2];
    const char* cA = (const char*)g.A + (size_t)cur.pm * tstepA + (size_t)cur.kofs * 2; const char* cB = (const char*)g.Bt + (size_t)cur.pn * tstepB + (size_t)cur.kofs * 2;
    PG8_STAGE(PG8_SB(0, 0), cB, voffB); PG8_STAGE(PG8_SB(0, 1), cB + hstepB, voffB); PG8_STAGE(PG8_SA(0, 0), cA, voffA); PG8_STAGE(PG8_SA(0, 1), cA + hstepA, voffA);
    if (wr == 1) PG8_BAR;
    PG8_WAIT_V(2); PG8_BAR;
    PG8_STAGE(PG8_SB(1, 0), cB + kstep, voffB); PG8_STAGE(PG8_SA(1, 0), cA + kstep, voffA); PG8_STAGE(PG8_SB(1, 1), cB + hstepB + kstep, voffB);
    PG8_WAIT_V(6); PG8_BAR;
    for (;;) {
        const bool has_next = S.next(ui + 1, nxt);
        const char* nA = has_next ? (const char*)g.A + (size_t)nxt.pm * tstepA + (size_t)nxt.kofs * 2 : cA; const char* nB = has_next ? (const char*)g.Bt + (size_t)nxt.pn * tstepB + (size_t)nxt.kofs * 2 : cB;
        for (int t = 0; t < nt; t += 2) {
            const bool last = (t == nt - 2);
            const char* a1 = cA + (size_t)(t + 1) * kstep;
            const char* a2 = last ? nA : cA + (size_t)(t + 2) * kstep; const char* b2 = last ? nB : cB + (size_t)(t + 2) * kstep;
            const char* a3 = a2 + kstep; const char* b3 = b2 + kstep;
            PG8_LDB(B0, 0, 0); PG8_LDB(B1, 0, 1); PG8_SCHED; PG8_LDA(At, 0, 0); PG8_STAGE(PG8_SA(1, 1), a1 + hstepA, voffA);
            PG8_WAIT_V(8); PG8_WAIT_L(0); PG8_BAR; PG8_MMA(0, 0, At, B0); PG8_MMA(0, 1, At, B1); PG8_BAR; PG8_SCHED;
            PG8_LDA(At, 0, 1); PG8_STAGE(PG8_SB(0, 0), b2, voffB); PG8_STAGE(PG8_SB(0, 1), b2 + hstepB, voffB); PG8_STAGE(PG8_SA(0, 0), a2, voffA);
            PG8_WAIT_V(8); PG8_WAIT_L(0); PG8_BAR; PG8_MMA(1, 0, At, B0); PG8_MMA(1, 1, At, B1); PG8_BAR; PG8_SCHED;
            PG8_LDB(B0, 1, 0); PG8_LDB(B1, 1, 1); PG8_SCHED; PG8_LDA(At, 1, 0); PG8_STAGE(PG8_SA(0, 1), a2 + hstepA, voffA);
            PG8_WAIT_V(8); PG8_WAIT_L(0); PG8_BAR; PG8_MMA(0, 0, At, B0); PG8_MMA(0, 1, At, B1); PG8_BAR; PG8_SCHED;
            PG8_LDA(At, 1, 1); PG8_STAGE(PG8_SB(1, 0), b3, voffB); PG8_STAGE(PG8_SB(1, 1), b3 + hstepB, voffB); PG8_STAGE(PG8_SA(1, 0), a3, voffA);
            PG8_WAIT_V(8); PG8_WAIT_L(0); PG8_BAR; PG8_MMA(1, 0, At, B0); PG8_MMA(1, 1, At, B1); PG8_BAR; PG8_SCHED;
        }
        if (wr == 0) PG8_BAR;
        E(acc, cur, wr, wc, fr, fq);
        if (!has_next) break;
        if (!cur.keep) {
#pragma unroll
            for (int a = 0; a < 2; ++a)
#pragma unroll
                for (int b = 0; b < 2; ++b)
#pragma unroll
                    for (int m = 0; m < 4; ++m)
#pragma unroll
                        for (int n = 0; n < 2; ++n) acc[a][b][m][n] = (f32x4){0.f, 0.f, 0.f, 0.f};
        }
        cur = nxt; cA = nA; cB = nB; ++ui;
        if (wr == 1) PG8_BAR;
    }
    PG8_WAIT_V(0);
    PG8_BAR;
#undef PG8_SA
#undef PG8_SB
#undef PG8_STAGE
#undef PG8_LDA
#undef PG8_LDB
#undef PG8_MMA
#undef PG8_WAIT_V
#undef PG8_WAIT_L
#undef PG8_BAR
#undef PG8_SCHED
}
}

__device__ __forceinline__ float tred16(const float (&v)[16], int li) {
    float w8[8], w4[4], w2[2];
#pragma unroll
    for (int t = 0; t < 8; ++t) { const float snd = (li & 8) ? v[t] : v[t + 8], kp = (li & 8) ? v[t + 8] : v[t]; w8[t] = kp + xs<8>(snd); }
#pragma unroll
    for (int t = 0; t < 4; ++t) { const float snd = (li & 4) ? w8[t] : w8[t + 4], kp = (li & 4) ? w8[t + 4] : w8[t]; w4[t] = kp + xs<4>(snd); }
#pragma unroll
    for (int t = 0; t < 2; ++t) { const float snd = (li & 2) ? w4[t] : w4[t + 2], kp = (li & 2) ? w4[t + 2] : w4[t]; w2[t] = kp + xs<2>(snd); }
    const float snd = (li & 1) ? w2[0] : w2[1], kp = (li & 1) ? w2[1] : w2[0];
    return kp + xs<1>(snd);
}
__device__ __forceinline__ void cmp_finish(const float (&red)[4], bf16_t* ACT, int which, int b, int kvh, int c0, LAS unsigned char* sw, int fr, int fq) {
    typedef const float* cfp;
    const __attribute__((address_space(4))) cfp* kin = (const __attribute__((address_space(4))) cfp*)__builtin_amdgcn_kernarg_segment_ptr();
    const float* pe = kin[17 + which]; const float* w = kin[19 + which];
    bf16_t* KC = (bf16_t*)((unsigned char*)ACT - WS_ACT + WS_KC); bf16_t* VCT = (bf16_t*)((unsigned char*)ACT - WS_ACT + WS_VCT);
    const int d = 32 * (fr >> 3) + 16 * ((fr >> 2) & 1) + 4 * fq + (fr & 3), lane = fq * 16 + fr;
    __builtin_amdgcn_sched_barrier(0);
    float ps = 0.f;
#pragma unroll 16
    for (int r = 0; r < 32; ++r) ps += pe[r * 64 + d];
    LAS f32x4* scr = (LAS f32x4*)sw;
    scr[d] = (f32x4){(red[0] + ps) * (1.0f / 32.0f), (red[1] + ps) * (1.0f / 32.0f), (red[2] + ps) * (1.0f / 32.0f), (red[3] + ps) * (1.0f / 32.0f)};
    asm volatile("s_waitcnt lgkmcnt(0)" ::: "memory");
    float a[4] = {0.f, 0.f, 0.f, 0.f};
#pragma unroll 32
    for (int dd = 0; dd < 64; ++dd) { const float wv = w[dd * 64 + lane]; const f32x4 p = scr[dd]; a[0] += p[0] * wv; a[1] += p[1] * wv; a[2] += p[2] * wv; a[3] += p[3] * wv; }
#pragma unroll
    for (int i = 0; i < 4; ++i) {
        const int c = c0 + 4 * (i >> 1) + (i & 1);
        if (which == 0) KC[((size_t)(b * 64 + c) * 2 + kvh) * 64 + lane] = (bf16_t)f2bf(a[i]);
        else VCT[((size_t)(b * 2 + kvh) * 64 + lane) * 64 + ((c & ~31) | VPERM32(c & 31))] = (bf16_t)f2bf(a[i]);
    }
    asm volatile("s_waitcnt lgkmcnt(0)" ::: "memory");
}
struct EpiInProj {
    bf16_t* ACT; bf16_t* VT; bf16_t* GB; float* out; const float* qng; const float* kng; const float* rope; LAS unsigned char* stg;
    __device__ __forceinline__ void operator()(f32x4 (&acc)[2][2][4][2], const pg8::Unit& u, int wr, int wc, int fr, int fq) const {
        asm volatile("" : "+v"(fr), "+v"(fq));
        const int pn = u.pn;
        int type = 0, slot = 0;
        if (pn < 2) { type = 1; slot = 4 * pn + wc; }
        else if (pn == 2 || (pn == 3 && wc < 2)) { type = 2; slot = 4 * (pn - 2) + wc; }
        else if (pn == 3 || pn == 4) { type = 3; slot = 4 * (pn - 3) + wc - 2; }
        const int rbase = u.pm * 256 + wr * 64 + fr;
        if (type == 1 || type == 2) {
            const float* gn = (type == 1) ? qng : kng;
            f32x4 g4[2][2];
#pragma unroll
            for (int bj = 0; bj < 2; ++bj)
#pragma unroll
                for (int n = 0; n < 2; ++n) g4[bj][n] = *(const f32x4*)(gn + 32 * bj + 16 * n + 4 * fq);
            const int br = slot >> 1, kvh = slot & 1;
            const bool docmp = (type == 2) && br == 0 && u.pm < MP / 256;
#pragma unroll
            for (int ai = 0; ai < 2; ++ai)
#pragma unroll
                for (int m = 0; m < 4; ++m) {
                    const int row = rbase + ai * 128 + m * 16;
                    float ss = 0.f;
#pragma unroll
                    for (int bj = 0; bj < 2; ++bj)
#pragma unroll
                        for (int n = 0; n < 2; ++n) { const f32x4 v = acc[ai][bj][m][n]; ss += (v[0] * v[0] + v[1] * v[1]) + (v[2] * v[2] + v[3] * v[3]); }
                    ss += __shfl_xor(ss, 16); ss += __shfl_xor(ss, 32);
                    const float rinv = __builtin_amdgcn_rsqf(ss * (1.0f / 64.0f) + 1e-6f);
                    const int pos = (row < MP) ? (row & (SEQ - 1)) : SEQ;
                    const bool live = row < MTOT;
                    long obase = -1;
                    if (type == 2 && live) {
                        if (row < MP) {
                            const int t = row & (SEQ - 1), b = row >> 11;
                            if (br == 0) obase = (long)O_PKC + (long)row * 128 + kvh * 64;
                            else if (br == 1) obase = (long)O_PKS + (long)row * 128 + kvh * 64;
                            else if (t >= 1536) obase = (long)O_PKW + ((long)(b * 512 + t - 1536) * 2 + kvh) * 64;
                        } else {
                            const int sb = row - MP;
                            if (br == 0) obase = (long)O_SKC + sb * 128 + kvh * 64;
                            else if (br == 1) obase = (long)O_SKS + sb * 128 + kvh * 64;
                            else obase = (long)O_SKW + ((long)(sb * 512 + 511) * 2 + kvh) * 64;
                        }
                    }
                    u32x2 wst[2][2];
#pragma unroll
                    for (int n = 0; n < 2; ++n) {
                        const f32x4 cs0 = *(const f32x4*)(rope + ((size_t)pos * 32 + 16 * n + 4 * fq) * 2);
                        const f32x4 cs1 = *(const f32x4*)(rope + ((size_t)pos * 32 + 16 * n + 4 * fq) * 2 + 4);
                        const float cc[4] = {cs0[0], cs0[2], cs1[0], cs1[2]}, sn[4] = {cs0[1], cs0[3], cs1[1], cs1[3]};
                        f32x4 o0, o1;
#pragma unroll
                        for (int j = 0; j < 4; ++j) {
                            const float y0 = acc[ai][0][m][n][j] * rinv * g4[0][n][j], y1 = acc[ai][1][m][n][j] * rinv * g4[1][n][j];
                            o0[j] = y0 * cc[j] - y1 * sn[j]; o1[j] = y1 * cc[j] + y0 * sn[j];
                        }
                        const float qs = (type == 1) ? C2Q : 1.0f;
                        wst[0][n].x = cvt_pk_bf16(o0[0] * qs, o0[1] * qs); wst[0][n].y = cvt_pk_bf16(o0[2] * qs, o0[3] * qs); wst[1][n].x = cvt_pk_bf16(o1[0] * qs, o1[1] * qs); wst[1][n].y = cvt_pk_bf16(o1[2] * qs, o1[3] * qs);
                        if (type == 2 && obase >= 0) { const int dcol = 16 * n + 4 * fq; *(f32x4*)(out + obase + dcol) = o0; *(f32x4*)(out + obase + 32 + dcol) = o1; }
                    }
                    { const int row0 = row - fr; stage_store_rows(stg + (wr * 4 + wc) * EPI_WAVE, fq * 16 + fr, fr, fq, wst, ACT + (size_t)row0 * NIN + ((type == 1) ? LQ : LK) + 64 * slot, NIN, MTOT - row0); }
                }
            if (docmp) {
                int fqo = fq; asm volatile("" : "+v"(fqo));
                float red[4];
#pragma unroll
                for (int ai = 0; ai < 2; ++ai)
#pragma unroll
                    for (int mp = 0; mp < 2; ++mp) {
                        float cs[16];
#pragma unroll
                        for (int mm = 0; mm < 2; ++mm) {
                            const float* p = out + (size_t)O_PKC + (size_t)(rbase + ai * 128 + (2 * mp + mm) * 16) * 128 + kvh * 64 + 4 * fqo;
#pragma unroll
                            for (int n = 0; n < 2; ++n) { const f32x4 a = *(const f32x4*)(p + 16 * n), b2 = *(const f32x4*)(p + 32 + 16 * n);
#pragma unroll
                                for (int j = 0; j < 4; ++j) { if (mm) { cs[4 * n + j] += a[j]; cs[8 + 4 * n + j] += b2[j]; } else { cs[4 * n + j] = a[j]; cs[8 + 4 * n + j] = b2[j]; } } }
                        }
                        red[ai * 2 + mp] = tred16(cs, fr);
                        __builtin_amdgcn_sched_barrier(0);
                    }
                cmp_finish(red, ACT, 0, u.pm >> 3, kvh, (u.pm & 7) * 8 + 2 * wr, stg + (wr * 4 + wc) * EPI_WAVE, fr, fq);
            }
        } else if (type == 3) {
            const int br = slot >> 1, kvh = slot & 1;
            const bool docmp = br == 0 && u.pm < MP / 256;
#pragma unroll
            for (int ai = 0; ai < 2; ++ai)
#pragma unroll
                for (int m = 0; m < 4; ++m) {
                    const int row = rbase + ai * 128 + m * 16;
                    if (row < MTOT) {
                        long obase = -1;
                        if (row < MP) {
                            const int t = row & (SEQ - 1), b = row >> 11;
                            if (br == 0) obase = (long)O_PVC + (long)row * 128 + kvh * 64;
                            else if (br == 1) obase = (long)O_PVS + (long)row * 128 + kvh * 64;
                            else if (t >= 1536) obase = (long)O_PVW + ((long)(b * 512 + t - 1536) * 2 + kvh) * 64;
                            bf16_t* vt = VT + ((size_t)(b * 6 + slot) * 64) * SEQ + ((t & ~31) | VPERM32(t & 31));
#pragma unroll
                            for (int bj = 0; bj < 2; ++bj)
#pragma unroll
                                for (int n = 0; n < 2; ++n)
#pragma unroll
                                    for (int j = 0; j < 4; ++j) vt[(size_t)(32 * bj + 16 * n + 4 * fq + j) * SEQ] = (bf16_t)f2bf(acc[ai][bj][m][n][j]);
                        } else {
                            const int sb = row - MP;
                            if (br == 0) obase = (long)O_SVC + sb * 128 + kvh * 64;
                            else if (br == 1) obase = (long)O_SVS + sb * 128 + kvh * 64;
                            else obase = (long)O_SVW + ((long)(sb * 512 + 511) * 2 + kvh) * 64;
                        }
                        if (obase >= 0) {
#pragma unroll
                            for (int bj = 0; bj < 2; ++bj)
#pragma unroll
                                for (int n = 0; n < 2; ++n) *(f32x4*)(out + obase + 32 * bj + 16 * n + 4 * fq) = acc[ai][bj][m][n];
                        }
                    }
                }
            if (docmp) {
                float red[4];
#pragma unroll
                for (int ai = 0; ai < 2; ++ai)
#pragma unroll
                    for (int mp = 0; mp < 2; ++mp) {
                        float cs[16];
#pragma unroll
                        for (int bj = 0; bj < 2; ++bj)
#pragma unroll
                            for (int n = 0; n < 2; ++n)
#pragma unroll
                                for (int j = 0; j < 4; ++j) cs[8 * bj + 4 * n + j] = acc[ai][bj][2 * mp][n][j] + acc[ai][bj][2 * mp + 1][n][j];
                        red[ai * 2 + mp] = tred16(cs, fr);
                    }
                cmp_finish(red, ACT, 1, u.pm >> 3, kvh, (u.pm & 7) * 8 + 2 * wr, stg + (wr * 4 + wc) * EPI_WAVE, fr, fq);
            }
        } else if (pn >= 13 && pn <= 20) {
            bf16_t* gp = GB + ((size_t)((u.pm * 8 + (pn - 13)) * 8 + wr * 4 + wc) * 32) * 256 + (size_t)(fq * 16 + fr) * 4;
#pragma unroll
            for (int ai = 0; ai < 2; ++ai)
#pragma unroll
                for (int m = 0; m < 4; ++m)
#pragma unroll
                    for (int bj = 0; bj < 2; ++bj)
#pragma unroll
                        for (int n = 0; n < 2; ++n) {
                            const f32x4 v = acc[ai][bj][m][n];
                            u32x2 w; w.x = cvt_pk_bf16(sigmoidf_(v[0]), sigmoidf_(v[1])); w.y = cvt_pk_bf16(sigmoidf_(v[2]), sigmoidf_(v[3]));
                            *(u32x2*)(gp + (size_t)(((ai * 4 + m) * 2 + bj) * 2 + n) * 256) = w;
                        }
        } else {
            const int mode = (pn <= 6) ? 1 : (pn <= 10) ? 0 : (pn <= 12) ? 1 : 2;
            LAS unsigned char* sw = stg + (wr * 4 + wc) * EPI_WAVE; const int lane = fq * 16 + fr;
#pragma unroll
            for (int ai = 0; ai < 2; ++ai)
#pragma unroll
                for (int m = 0; m < 4; ++m) {
                    const int row0 = u.pm * 256 + wr * 64 + ai * 128 + m * 16;
                    u32x2 w[2][2];
#pragma unroll
                    for (int bj = 0; bj < 2; ++bj)
#pragma unroll
                        for (int n = 0; n < 2; ++n) {
                            f32x4 v = acc[ai][bj][m][n];
#pragma unroll
                            for (int j = 0; j < 4; ++j) { const float sg = sigmoidf_(v[j]); v[j] = (mode == 0) ? v[j] : (mode == 1) ? v[j] * sg : sg; }
                            w[bj][n].x = cvt_pk_bf16(v[0], v[1]); w[bj][n].y = cvt_pk_bf16(v[2], v[3]);
                        }
                    stage_store_rows(sw, lane, fr, fq, w, ACT + (size_t)row0 * NIN + 256 * pn + 64 * wc, NIN, MTOT - row0);
                }
        }
    }
};

struct EpiMix {
    const bf16_t* GB; bf16_t* M;
    __device__ __forceinline__ void operator()(f32x4 (&acc)[2][2][4][2], const pg8::Unit& u, int wr, int wc, int fr, int fq) const {
        const int rbase = u.pm * 256 + wr * 64 + fr, cbase = u.pn * 256 + 64 * wc + 4 * fq;
        const bf16_t* ga = GB + ((size_t)((u.pm * 8 + u.pn) * 8 + wr * 4 + wc) * 32) * 256 + (size_t)(fq * 16 + fr) * 4;
        const bf16_t* gb = ga + (size_t)4 * 8 * 32 * 256;
#pragma unroll
        for (int ai = 0; ai < 2; ++ai) {
            u32x2 gsb[16], gsa[16];
#pragma unroll
            for (int f = 0; f < 16; ++f) { gsb[f] = *(const u32x2*)(gb + (ai * 16 + f) * 256); if (u.keep) gsa[f] = *(const u32x2*)(ga + (ai * 16 + f) * 256); }
#pragma unroll
            for (int m = 0; m < 4; ++m) {
                const int row = rbase + ai * 128 + m * 16;
#pragma unroll
                for (int bj = 0; bj < 2; ++bj)
#pragma unroll
                    for (int n = 0; n < 2; ++n) {
                        const int f = (m * 2 + bj) * 2 + n;
                        float sb[4]; unpack4(gsb[f], sb);
                        if (u.keep) {
                            float sa[4]; unpack4(gsa[f], sa);
#pragma unroll
                            for (int j = 0; j < 4; ++j) acc[ai][bj][m][n][j] *= sa[j] * __builtin_amdgcn_rcpf(sb[j]);
                        } else if (row < MP) {
                            const f32x4 v = acc[ai][bj][m][n];
                            u32x2 w; w.x = cvt_pk_bf16(v[0] * sb[0], v[1] * sb[1]); w.y = cvt_pk_bf16(v[2] * sb[2], v[3] * sb[3]);
                            *(u32x2*)(M + (size_t)row * DM + cbase + 32 * bj + 16 * n) = w;
                        }
                    }
            }
        }
    }
};

struct EpiOut {
    const float* xp; const float* xs; const float* MOD; float* out;
    __device__ __forceinline__ void operator()(f32x4 (&acc)[2][2][4][2], const pg8::Unit& u, int wr, int wc, int fr, int fq) const {
        const int rbase = u.pm * 256 + wr * 64 + fr, cbase = u.pn * 256 + wc * 32 + 4 * fq;
        const float* gr = MOD + (size_t)(rbase >> 11) * 3072 + 2048;
        f32x4 gv[2][2];
#pragma unroll
        for (int bj = 0; bj < 2; ++bj)
#pragma unroll
            for (int n = 0; n < 2; ++n) gv[bj][n] = *(const f32x4*)(gr + cbase + 128 * bj + 16 * n);
#pragma unroll
        for (int ai = 0; ai < 2; ++ai) {
            f32x4 xv[4][2][2];
#pragma unroll
            for (int m = 0; m < 4; ++m)
#pragma unroll
                for (int bj = 0; bj < 2; ++bj)
#pragma unroll
                    for (int n = 0; n < 2; ++n) xv[m][bj][n] = __builtin_nontemporal_load((const f32x4*)(xp + (size_t)(rbase + ai * 128 + m * 16) * DM + cbase + 128 * bj + 16 * n));
#pragma unroll
            for (int m = 0; m < 4; ++m)
#pragma unroll
                for (int bj = 0; bj < 2; ++bj)
#pragma unroll
                    for (int n = 0; n < 2; ++n)
                        __builtin_nontemporal_store(xv[m][bj][n] + gv[bj][n] * acc[ai][bj][m][n], (f32x4*)(out + O_YP + (size_t)(rbase + ai * 128 + m * 16) * DM + cbase + 128 * bj + 16 * n));
        }
    }
};

__device__ __forceinline__ void transpose_item(const float* src, int src_ld, int nvalid, bf16_t* dst, int dst_ld, LAS float* scr, int lane) {
    float tv[64];
    const int cc = lane & 31, ccl = cc < nvalid ? cc : 0;
#pragma unroll
    for (int i = 0; i < 64; ++i) tv[i] = src[(size_t)(2 * i + (lane >> 5)) * src_ld + ccl];
#pragma unroll
    for (int hf = 0; hf < 2; ++hf) {
#pragma unroll
        for (int i = 0; i < 32; ++i) scr[(2 * i + (lane >> 5)) * 33 + cc] = (cc < nvalid) ? tv[32 * hf + i] : 0.f;
        asm volatile("s_waitcnt lgkmcnt(0)" ::: "memory");
        const int c = lane & 7;
#pragma unroll
        for (int j = 0; j < 4; ++j) { const int n = (lane >> 3) + 8 * j; const LAS float* sp = scr + (8 * c) * 33 + n;
            u32x4 o; o.x = pk2(sp[0 * 33], sp[1 * 33]); o.y = pk2(sp[2 * 33], sp[3 * 33]); o.z = pk2(sp[4 * 33], sp[5 * 33]); o.w = pk2(sp[6 * 33], sp[7 * 33]);
            *(u32x4*)(dst + (size_t)n * dst_ld + 64 * hf + 8 * c) = o; }
        asm volatile("s_waitcnt lgkmcnt(0)" ::: "memory");
    }
}

__device__ __forceinline__ void pool_pe_sums(const Params& P, int lane, float (&pes)[2][2]) {
    const int d0 = (2 * lane) & 63;
#pragma unroll
    for (int which = 0; which < 2; ++which) {
        const float* pe = P.in[17 + which];
        float p0 = 0.f, p1 = 0.f;
#pragma unroll
        for (int r = 0; r < 32; ++r) { const f32x2 v = *(const f32x2*)(pe + r * 64 + d0); p0 += v[0]; p1 += v[1]; }
        pes[which][0] = p0; pes[which][1] = p1;
    }
}
__device__ __forceinline__ void pool_item(const Params& P, LAS float* scr, int it, int lane_in, const float (&pes)[2][2]) {
    int lane = lane_in; asm volatile("" : "+v"(lane));
    unsigned char* ws = P.ws;
    const int sb = it >> 5, pg = (it >> 1) & 15, which = it & 1;
    const int page = ((const int*)P.in[8])[sb * 16 + pg];
    const float* src = P.in[2 + which] + (size_t)page * 128 * 128;
    const float* w = P.in[19 + which];
    const int d0 = (2 * lane) & 63;
    const float p0 = which ? pes[1][0] : pes[0][0], p1 = which ? pes[1][1] : pes[0][1];
    float wv[64];
#pragma unroll
    for (int d = 0; d < 64; ++d) wv[d] = w[d * 64 + lane];
    __builtin_amdgcn_sched_barrier(0);
#pragma unroll
    for (int cb = 0; cb < 4; ++cb) {
        f32x2 v[32];
#pragma unroll
        for (int r = 0; r < 32; ++r) v[r] = __builtin_nontemporal_load((const f32x2*)(src + (size_t)(cb * 32 + r) * 128 + 2 * lane));
        float s0 = 0.f, s1 = 0.f;
#pragma unroll
        for (int r = 0; r < 32; ++r) { s0 += v[r][0]; s1 += v[r][1]; }
        scr[d0 * 8 + cb * 2 + (lane >> 5)] = (s0 + p0) * (1.0f / 32.0f); scr[(d0 + 1) * 8 + cb * 2 + (lane >> 5)] = (s1 + p1) * (1.0f / 32.0f);
    }
    asm volatile("s_waitcnt lgkmcnt(0)" ::: "memory");
    float a[8];
#pragma unroll
    for (int q = 0; q < 8; ++q) a[q] = 0.f;
#pragma unroll
    for (int d8 = 0; d8 < 64; d8 += 8) {
        f32x4 pa[8], pb[8];
#pragma unroll
        for (int e = 0; e < 8; ++e) { pa[e] = *(const LAS f32x4*)(scr + (d8 + e) * 8); pb[e] = *(const LAS f32x4*)(scr + (d8 + e) * 8 + 4); }
        __builtin_amdgcn_sched_barrier(0);
#pragma unroll
        for (int e = 0; e < 8; ++e) { const float wd = wv[d8 + e];
            a[0] += pa[e][0] * wd; a[1] += pa[e][1] * wd; a[2] += pa[e][2] * wd; a[3] += pa[e][3] * wd; a[4] += pb[e][0] * wd; a[5] += pb[e][1] * wd; a[6] += pb[e][2] * wd; a[7] += pb[e][3] * wd; }
        __builtin_amdgcn_sched_barrier(0);
    }
    float* dst = (float*)(ws + (which ? WS_VCS : WS_KCS));
#pragma unroll
    for (int q = 0; q < 8; ++q) dst[((size_t)(sb * 2 + (q & 1)) * 64 + 4 * pg + (q >> 1)) * 64 + lane] = a[q];
    asm volatile("s_waitcnt lgkmcnt(0)" ::: "memory");

}

__device__ __forceinline__ void p0_prologue(const Params& P, LAS unsigned char* lds, int gw, int NGW, int lane_p, int wave, int gtid, int NT) {
    unsigned char* ws = P.ws;
    LAS float* scr = (LAS float*)(lds + wave * 16384);
    constexpr int I_MOD = 9 * 96, I_WIN = 8 * 176, I_WBR = 8 * 32, I_WOUT = 8 * 32, I_POOL = NSB * 16 * 2;
    constexpr int POOL_P0 = 1616 + 776;
    constexpr int I_TOTAL = I_MOD + I_WIN + I_WBR + I_WOUT + I_POOL;
    constexpr int I_TR = I_WIN + I_WBR + I_WOUT;
    const bool modw = gw < I_MOD; const int io = gw - I_MOD;
    float pes[2][2] = {{0.f, 0.f}, {0.f, 0.f}};
    if (!modw || NGW != 2048) pool_pe_sums(P, lane_p, pes);
    static_assert(I_TR == 1920 && I_POOL == 4096 && I_MOD == 864 && POOL_P0 == 1616 + 776, "the deal below is written for these counts and a 2048-wave grid");
    for (int stp = 0;; ++stp) {
        int it;
        if (NGW != 2048) { it = gw + stp * NGW; if (it >= I_MOD + I_TR + POOL_P0) break; }
        else if (modw) { if (stp == 0) it = gw; else if (stp == 1) it = I_MOD + gw; else break; }
        else {
            const int nT = (io < 1056) ? 1 : 0, nP = (io >= 1056 && io < 1080) ? 3 : 2;
            if (stp >= nT + nP) break;
            if (stp < nT) it = I_MOD + 864 + io;
            else { const int pp = stp - nT; it = I_MOD + I_TR + (pp == 0 ? io : pp == 1 ? 1184 + io : 2368 + (io - 1056)); }
        }
        int lane = lane_p; asm volatile("" : "+v"(lane));
        if (it < I_MOD) {
            const int mt = it / 96, ng = it % 96, lr = lane & 15, kq = lane >> 4;
            int arow_i = 16 * mt + lr; if (arow_i > 135) arow_i = 135;
            const float* arow = ((arow_i < 8) ? P.in[9] + (size_t)arow_i * DM : P.in[10] + (size_t)(arow_i - 8) * DM) + 4 * kq;
            const float* bp = P.in[11] + (size_t)(4 * kq) * 3072 + 32 * ng + 2 * lr;
            f32x4 macc[2];
#pragma unroll
            for (int nt = 0; nt < 2; ++nt) macc[nt] = (f32x4){0.f, 0.f, 0.f, 0.f};
            f32x4 a0[4], a1[4], a2[4]; f32x2 b0[16], b1[16], b2[16];
#define MOD_LOAD(A_, B_, k0) do { _Pragma("unroll") for (int j = 0; j < 4; ++j) { A_[j] = *(const f32x4*)(arow + (k0) + 16 * j); \
                _Pragma("unroll") for (int e = 0; e < 4; ++e) B_[4 * j + e] = *(const f32x2*)(bp + (size_t)((k0) + 16 * j + e) * 3072); } } while (0)
#define MOD_MMA(A_, B_) do { _Pragma("unroll") for (int j = 0; j < 4; ++j) _Pragma("unroll") for (int e = 0; e < 4; ++e) _Pragma("unroll") for (int nt = 0; nt < 2; ++nt) \
                macc[nt] = __builtin_amdgcn_mfma_f32_16x16x4f32(A_[j][e], B_[4 * j + e][nt], macc[nt], 0, 0, 0); } while (0)
            MOD_LOAD(a0, b0, 0); MOD_LOAD(a1, b1, 64);
            for (int k0 = 0; k0 < DM; k0 += 192) {
                if (k0 + 128 < DM) MOD_LOAD(a2, b2, k0 + 128);
                __builtin_amdgcn_sched_barrier(0);
                MOD_MMA(a0, b0);
                __builtin_amdgcn_sched_barrier(0);
                if (k0 + 192 < DM) MOD_LOAD(a0, b0, k0 + 192);
                __builtin_amdgcn_sched_barrier(0);
                if (k0 + 64 < DM) MOD_MMA(a1, b1);
                __builtin_amdgcn_sched_barrier(0);
                if (k0 + 256 < DM) MOD_LOAD(a1, b1, k0 + 256);
                __builtin_amdgcn_sched_barrier(0);
                if (k0 + 128 < DM) MOD_MMA(a2, b2);
                __builtin_amdgcn_sched_barrier(0);
            }
#undef MOD_LOAD
#undef MOD_MMA
            float* MOD = (float*)(ws + WS_MOD);
            const f32x2 bb = *(const f32x2*)(P.in[12] + 32 * ng + 2 * lr);
#pragma unroll
            for (int r = 0; r < 4; ++r) { const int row = 16 * mt + 4 * kq + r;
                if (row < 136) *(f32x2*)(MOD + (size_t)row * 3072 + 32 * ng + 2 * lr) = (f32x2){macc[0][r] + bb[0], macc[1][r] + bb[1]}; }
            continue;
        }
        it -= I_MOD;
        if (it < I_WIN) {
            const int kb = it / 176, nb = it % 176;
            const int pn = nb >> 3, bj = (nb >> 2) & 1, wc = nb & 3;
            const int L0 = 256 * pn + 64 * wc + 32 * bj;
            int srcc, nvalid;
            if (L0 < 1280) { srcc = L0; nvalid = 32; } else if (L0 < LNSA) { srcc = L0 + 24; nvalid = 32; } else if (L0 == LNSA) { srcc = 1280; nvalid = 24; } else { srcc = 0; nvalid = 0; }
            transpose_item(P.in[14] + (size_t)(128 * kb) * 5400 + srcc, 5400, nvalid, (bf16_t*)(ws + WS_WTIN) + (size_t)(32 * nb) * DM + 128 * kb, DM, scr, lane);
            continue;
        }
        it -= I_WIN;
        if (it < I_WBR) {
            const int kb = it / 32, nb = it % 32;
            const float* src = (kb < 4) ? P.in[25] + (size_t)(128 * kb) * DM : P.in[26] + (size_t)(128 * (kb - 4)) * DM;
            const int L0 = 256 * (nb >> 3) + 64 * (nb & 3) + 32 * ((nb >> 2) & 1);
            transpose_item(src + L0, DM, 32, (bf16_t*)(ws + WS_WTBR) + (size_t)(32 * nb) * DM + 128 * kb, DM, scr, lane);
            continue;
        }
        it -= I_WBR;
        if (it < I_WOUT) {
            const int kb = it / 32, nb = it % 32;
            transpose_item(P.in[27] + (size_t)(128 * kb) * DM + 32 * nb, DM, 32, (bf16_t*)(ws + WS_WTOUT) + (size_t)(32 * nb) * DM + 128 * kb, DM, scr, lane);
            continue;
        }
        it -= I_WOUT;
        pool_item(P, scr, it, lane, pes);
    }
    float* rope = (float*)(ws + WS_ROPE);
    for (int i = gtid; i < 2049 * 32; i += NT) {
        const int pos = i >> 5, k = i & 31;
        double invd = 1.0;
        for (int q = 0; q < k; ++q) invd *= 0.7498942093324559;
        const float ang = (float)pos * (float)invd;
        const double rev = (double)ang * 0.15915494309189535;
        const float fr = (float)(rev - __builtin_rint(rev));
        rope[2 * i] = __builtin_amdgcn_cosf(fr); rope[2 * i + 1] = __builtin_amdgcn_sinf(fr);
    }
    bf16_t* tril = (bf16_t*)(ws + WS_TRIL);
    for (int i = gtid; i < 4 * 128 * 128; i += NT) { const int r = (i >> 7) & 127, cidx = i & 127; tril[i] = (cidx <= r) ? (bf16_t)f2bf(P.in[23][i]) : (bf16_t)0; }
}

__device__ __forceinline__ void p1_row(const Params& P, int row, const f32x4 (&v)[4], int lane) {
    const float* MOD = (const float*)(P.ws + WS_MOD); bf16_t* H = (bf16_t*)(P.ws + WS_H); const float* ng = P.in[13];
    unsigned long long* o8 = (unsigned long long*)(H + (size_t)row * DM) + lane;
    if (row >= MTOT) {
#pragma unroll
        for (int j = 0; j < 4; ++j) o8[64 * j] = 0ull;
        return; }
    const float* md = (row < MP) ? MOD + (size_t)(row >> 11) * 3072 : MOD + (size_t)(8 + row - MP) * 3072;
    float s = 0.f;
#pragma unroll
    for (int j = 0; j < 4; ++j) s += (v[j][0] * v[j][0] + v[j][1] * v[j][1]) + (v[j][2] * v[j][2] + v[j][3] * v[j][3]);
    const float rstd = rsqrtf(wave_sum(s) * (1.0f / DM) + 1e-6f);
#pragma unroll
    for (int j = 0; j < 4; ++j) {
        const int col = 4 * lane + 256 * j;
        const f32x4 g = *(const f32x4*)(ng + col), sh = *(const f32x4*)(md + col), sc = *(const f32x4*)(md + 1024 + col);
        const f32x4 h = (v[j] * rstd) * g * (sc + 1.0f) + sh;
        o8[64 * j] = (unsigned long long)pk2(h[0], h[1]) | ((unsigned long long)pk2(h[2], h[3]) << 32);
    }
}
__device__ __forceinline__ void p1_hrows(const Params& P, int gw, int NGW, int lane) {
    int trip = 0;
    for (int row0 = gw; row0 < MP; row0 += 4 * NGW, ++trip) {
        const int xrow = MP + (gw >> 3); const bool extra = (trip == 1) && (gw & 7) == 0 && xrow < MPAD && NGW == 2048;
        f32x4 v[5][4];
#pragma unroll
        for (int q = 0; q < 4; ++q) { const int row = row0 + q * NGW; const int rr = row < MP ? row : 0;
#pragma unroll
            for (int j = 0; j < 4; ++j) v[q][j] = __builtin_nontemporal_load((const f32x4*)(P.in[0] + (size_t)rr * DM) + lane + 64 * j); }
        if (extra) { const int rr = (xrow < MTOT) ? xrow - MP : 0;
#pragma unroll
          for (int j = 0; j < 4; ++j) v[4][j] = __builtin_nontemporal_load((const f32x4*)(P.in[1] + (size_t)rr * DM) + lane + 64 * j); }
#pragma unroll
        for (int q = 0; q < 4; ++q) { const int row = row0 + q * NGW; if (row < MP) p1_row(P, row, v[q], lane); }
        if (extra) p1_row(P, xrow, v[4], lane);
    }
    if (NGW != 2048) for (int row = MP + gw; row < MPAD; row += NGW) {
        f32x4 v[4]; const int rr = row < MTOT ? row : MP;
#pragma unroll
        for (int j = 0; j < 4; ++j) v[j] = __builtin_nontemporal_load((const f32x4*)(P.in[1] + (size_t)(rr - MP) * DM) + lane + 64 * j);
        p1_row(P, row, v, lane);
    }
}

constexpr int A_TILE = 32768, A_IMP = 3 * A_TILE, A_IMPS = A_IMP + 8 * 32 * 33 * 4, A_SEL = A_IMPS + 2 * 32 * 33 * 4;
constexpr int A_CPY = 141312;
static_assert(A_SEL + 256 <= A_CPY && A_CPY + 8192 <= LDS_XB, "attention LDS map");
#define ATT_BAR() do { asm volatile("s_waitcnt lgkmcnt(0)" ::: "memory"); __builtin_amdgcn_s_barrier(); asm volatile("" ::: "memory"); } while (0)

struct TileSrc { const bf16_t* kb; const bf16_t* v0; const bf16_t* v1; unsigned kpitch, vpitch; };
__device__ __forceinline__ TileSrc attn_tile_src(const Params& P, int b, int T, int n_slc, int lo) {
    TileSrc s;
    if (T == 0) { s.kb = (const bf16_t*)(P.ws + WS_KC) + (size_t)b * 64 * 128; s.v0 = (const bf16_t*)(P.ws + WS_VCT) + (size_t)(b * 2) * 4096; s.v1 = s.v0 + 4096; s.kpitch = 128; s.vpitch = 64; }
    else {
        const bool slc = T <= n_slc; const int j = slc ? T - 1 : lo + (T - 1 - n_slc), br = slc ? 1 : 2;
        s.kb = (const bf16_t*)(P.ws + WS_ACT) + ((size_t)b * SEQ + 64 * j) * NIN + LK + 128 * br;
        s.v0 = (const bf16_t*)(P.ws + WS_VT) + ((size_t)(b * 6 + 2 * br) * 64) * SEQ + 64 * j; s.v1 = s.v0 + (size_t)64 * SEQ; s.kpitch = NIN; s.vpitch = SEQ;
    }
    return s;
}
__device__ __forceinline__ void attn_dma(LAS unsigned char* buf, const TileSrc& s, int wave, int lane_in) {
    int lane = lane_in; asm volatile("" : "+v"(lane));
    const int r = 8 * wave + (lane >> 3), ch = (lane & 7) ^ (lane >> 3);
#pragma unroll
    for (int i = 0; i < 2; ++i) {
        __builtin_amdgcn_global_load_lds((const unsigned*)(s.kb + (size_t)r * s.kpitch + i * 64 + ch * 8), (LAS unsigned*)(buf + (wave + 8 * i) * 1024), 16, 0, 0);
        __builtin_amdgcn_global_load_lds((const unsigned*)((i ? s.v1 : s.v0) + (size_t)r * s.vpitch + ch * 8), (LAS unsigned*)(buf + 16384 + (wave + 8 * i) * 1024), 16, 0, 0);
    }
}

constexpr float ATT_M0 = -30.f, ATT_THR = 12.f, ATT_SBOUND = 40.f;
template <int MODE, bool STAT>
__device__ __forceinline__ void attn_tile(const LAS unsigned char* Kg, const LAS unsigned char* Vg, const bf16x8 (&qf)[2][2], f32x4 (&O)[4][2], float (&mrun)[2], float (&lrun)[2], f32x4 (&s)[2][4],
                                          int lane_in, int kbase, const int (&qpos)[2], const float (&cinit)[2], bool emask) {
    int lane = lane_in; asm volatile("" : "+v"(lane));
    const int lr = lane & 15, grp = lane >> 4, sw = lr & 7;
    const float c0[2] = {STAT ? cinit[0] : cinit[0] - mrun[0], STAT ? cinit[1] : cinit[1] - mrun[1]};
#pragma unroll
    for (int kt = 0; kt < 4; ++kt) {
        const bf16x8 k0 = *(const LAS bf16x8*)(Kg + (16 * kt + lr) * 128 + ((grp ^ sw) << 4));
        const bf16x8 k1 = *(const LAS bf16x8*)(Kg + (16 * kt + lr) * 128 + (((4 + grp) ^ sw) << 4));
#pragma unroll
        for (int qt = 0; qt < 2; ++qt) {
            const f32x4 a = __builtin_amdgcn_mfma_f32_16x16x32_bf16(k0, qf[qt][0], (f32x4){c0[qt], c0[qt], c0[qt], c0[qt]}, 0, 0, 0);
            s[qt][kt] = __builtin_amdgcn_mfma_f32_16x16x32_bf16(k1, qf[qt][1], a, 0, 0, 0);
        }
    }
    bf16x8 vf[2][4];
#pragma unroll
    for (int c2 = 0; c2 < 2; ++c2)
#pragma unroll
        for (int dt = 0; dt < 4; ++dt) {
            vf[c2][dt] = *(const LAS bf16x8*)(Vg + (16 * dt + lr) * 128 + (((4 * c2 + grp) ^ sw) << 4));
        }
    if (emask) {
#pragma unroll
        for (int qt = 0; qt < 2; ++qt)
#pragma unroll
            for (int kt = 0; kt < 4; ++kt)
#pragma unroll
                for (int r = 0; r < 4; ++r) {
                    const int key = 16 * kt + 4 * grp + r;
                    bool valid;
                    if (MODE == 0) valid = key < ((qpos[qt] + 1) >> 5);
                    else if (MODE == 1) valid = (kbase + key <= qpos[qt]);
                    else { const int kp = kbase + key; valid = (kp <= qpos[qt]) && (kp > qpos[qt] - 512); }
                    s[qt][kt][r] = valid ? s[qt][kt][r] : NEGBIG;
                }
    }
    if (!STAT) {
    float mx[2];
#pragma unroll
    for (int qt = 0; qt < 2; ++qt) {
#define FMX(a, b) __builtin_amdgcn_fmed3f((a), (b), __builtin_inff())
        float m0 = FMX(FMX(s[qt][0][0], s[qt][0][1]), FMX(s[qt][0][2], s[qt][0][3]));
#pragma unroll
        for (int kt = 1; kt < 4; ++kt) m0 = FMX(m0, FMX(FMX(s[qt][kt][0], s[qt][kt][1]), FMX(s[qt][kt][2], s[qt][kt][3])));
        mx[qt] = row0_bcast(m0);
#undef FMX
    }
    if (__any((int)(fmaxf(mx[0], mx[1]) > ATT_THR))) {
#pragma unroll
        for (int qt = 0; qt < 2; ++qt) {
            const float delta = fmaxf(mx[qt], 0.f), f = __builtin_amdgcn_exp2f(-delta);
            mrun[qt] += delta; lrun[qt] *= f;
#pragma unroll
            for (int dt = 0; dt < 4; ++dt) O[dt][qt] *= f;
#pragma unroll
            for (int kt = 0; kt < 4; ++kt) s[qt][kt] -= delta;
        }
    }
    }
#pragma unroll
    for (int qt = 0; qt < 2; ++qt) {
        float ls = 0.f;
#pragma unroll
        for (int kt = 0; kt < 4; ++kt)
#pragma unroll
            for (int r = 0; r < 4; ++r) { const float p = __builtin_amdgcn_exp2f(s[qt][kt][r]); s[qt][kt][r] = p; ls += p; }
        lrun[qt] += ls;
#pragma unroll
        for (int c2 = 0; c2 < 2; ++c2) {
            u32x4 w; w.x = cvt_pk_bf16(s[qt][2 * c2][0], s[qt][2 * c2][1]); w.y = cvt_pk_bf16(s[qt][2 * c2][2], s[qt][2 * c2][3]);
            w.z = cvt_pk_bf16(s[qt][2 * c2 + 1][0], s[qt][2 * c2 + 1][1]); w.w = cvt_pk_bf16(s[qt][2 * c2 + 1][2], s[qt][2 * c2 + 1][3]);
            const bf16x8 pf = __builtin_bit_cast(bf16x8, w);
#pragma unroll
            for (int dt = 0; dt < 4; ++dt) O[dt][qt] = __builtin_amdgcn_mfma_f32_16x16x32_bf16(vf[c2][dt], pf, O[dt][qt], 0, 0, 0);
        }
    }
}

struct WinCopy { int tk, i, G; };
__device__ __forceinline__ void wincopy_addr(const Params& P, const WinCopy& cs, int tid, const f32x4*& src, f32x4*& dst) {
    const int w2 = cs.tk >> 8, sb = (cs.tk >> 1) & 127, half = cs.tk & 1;
    int idx = cs.i + tid; idx = idx < 8176 ? idx : 8175;
    src = (const f32x4*)P.in[6 + w2] + (size_t)sb * 512 * 32 + 32 + half * 8176 + idx; dst = (f32x4*)(P.out + (w2 ? O_SVW : O_SKW)) + (size_t)sb * 512 * 32 + half * 8176 + idx;
}
__device__ __forceinline__ void wincopy_next(WinCopy& cs) { cs.i += 512; if (cs.i >= 8176) { cs.i = 0; cs.tk += cs.G; } }
template <bool STAT>
__device__ __forceinline__ void attn_unit(const Params& P, LAS unsigned char* lds, int b, int qb32, int tid, int lane, int wave, WinCopy& cs) {
    asm volatile("" : "+v"(tid), "+v"(lane));
    const bf16_t* ACT = (const bf16_t*)(P.ws + WS_ACT); bf16_t* AB = (bf16_t*)(P.ws + WS_AB);
    const int lr = lane & 15, grp = lane >> 4, g = wave >> 2;
    const int t0 = 32 * qb32, qblk = t0 >> 6; const size_t row0 = (size_t)b * SEQ + t0;
    const int n_slc = qblk + 1, lo = (t0 - 511 > 0) ? ((t0 - 511) >> 6) : 0, NT = 1 + n_slc + (qblk - lo + 1);
    LAS float* IMP = (LAS float*)(lds + A_IMP); LAS float* IMPS = (LAS float*)(lds + A_IMPS); LAS unsigned* SEL = (LAS unsigned*)(lds + A_SEL);
    bf16x8 qf[2][2]; int qpos[2]; float gate[2][3];
#pragma unroll
    for (int qt = 0; qt < 2; ++qt) {
        const size_t row = row0 + 16 * qt + lr; qpos[qt] = t0 + 16 * qt + lr;
#pragma unroll
        for (int ks = 0; ks < 2; ++ks) qf[qt][ks] = *(const bf16x8*)(ACT + row * NIN + LQ + 64 * wave + 32 * ks + 8 * grp);
#pragma unroll
        for (int br = 0; br < 3; ++br) gate[qt][br] = bf2f(ACT[row * NIN + LNSA + 3 * wave + br]);
    }
    f32x4 O[4][2], OA[4][2], s[2][4]; float mrun[2], lrun[2]; unsigned selm[2] = {0u, 0u};
#pragma unroll
    for (int dt = 0; dt < 4; ++dt)
#pragma unroll
        for (int qt = 0; qt < 2; ++qt) { O[dt][qt] = (f32x4){0.f, 0.f, 0.f, 0.f}; OA[dt][qt] = (f32x4){0.f, 0.f, 0.f, 0.f}; }
    mrun[0] = mrun[1] = ATT_M0; lrun[0] = lrun[1] = 0.f;
#define ATT_FINISH(br) do { _Pragma("unroll") for (int qt = 0; qt < 2; ++qt) { float lt = lrun[qt]; lt += __shfl_xor(lt, 16); lt += __shfl_xor(lt, 32); \
        const float f = (lt > 0.f) ? gate[qt][br] / lt : 0.f; _Pragma("unroll") for (int dt = 0; dt < 4; ++dt) { OA[dt][qt] += O[dt][qt] * f; O[dt][qt] = (f32x4){0.f, 0.f, 0.f, 0.f}; } \
        mrun[qt] = ATT_M0; lrun[qt] = 0.f; } } while (0)
    const float czero[2] = {0.f, 0.f};
    ATT_BAR();
    { const TileSrc s0 = attn_tile_src(P, b, 0, n_slc, lo); attn_dma(lds, s0, wave, lane); }
    { const TileSrc s1 = attn_tile_src(P, b, 1, n_slc, lo); attn_dma(lds + A_TILE, s1, wave, lane); }
    asm volatile("s_waitcnt vmcnt(4)" ::: "memory");
    ATT_BAR();
    { const TileSrc s2 = attn_tile_src(P, b, 2, n_slc, lo); attn_dma(lds + 2 * A_TILE, s2, wave, lane); }
    {
        attn_tile<0, false>(lds + g * 8192, lds + 16384 + g * 8192, qf, O, mrun, lrun, s, lane, 0, qpos, czero, true);
#pragma unroll
        for (int qt = 0; qt < 2; ++qt) {
            float lt = lrun[qt]; lt += __shfl_xor(lt, 16); lt += __shfl_xor(lt, 32);
            const float inv = (lt > 0.f) ? 1.0f / lt : 0.f;
#pragma unroll
            for (int kt = 0; kt < 4; ++kt)
#pragma unroll
                for (int rr = 0; rr < 2; ++rr) IMP[(wave * 32 + 16 * qt + lr) * 33 + 8 * kt + 2 * grp + rr] = (s[qt][kt][2 * rr] + s[qt][kt][2 * rr + 1]) * inv;
        }
        ATT_FINISH(0);
        ATT_BAR();
        for (int i = tid; i < 2 * 32 * 32; i += 512) { const int gg = i >> 10, q = (i >> 5) & 31, j = i & 31;
            IMPS[(gg * 32 + q) * 33 + j] = (IMP[((4 * gg + 0) * 32 + q) * 33 + j] + IMP[((4 * gg + 1) * 32 + q) * 33 + j]) + (IMP[((4 * gg + 2) * 32 + q) * 33 + j] + IMP[((4 * gg + 3) * 32 + q) * 33 + j]); }
        ATT_BAR();
        {
            const int pr = tid >> 3, sub = tid & 7;
            unsigned mask = 1u | (1u << qblk);
            if (qblk - 1 <= 6) mask = (qblk >= 31) ? 0xffffffffu : ((2u << qblk) - 1u);
            else {
                const LAS float* v = IMPS + pr * 33;
                float x[4];
#pragma unroll
                for (int jj = 0; jj < 4; ++jj) { const int j = sub + 8 * jj; x[jj] = (j >= 1 && j < qblk) ? v[j] : -1.f; }
#pragma unroll
                for (int pick = 0; pick < 6; ++pick) {
                    float best = x[0]; int bi = sub;
#pragma unroll
                    for (int jj = 1; jj < 4; ++jj) if (x[jj] > best) { best = x[jj]; bi = sub + 8 * jj; }
#pragma unroll
                    for (int o = 1; o < 8; o <<= 1) { const float ob = __shfl_xor(best, o); const int oi = __shfl_xor(bi, o); if (ob > best || (ob == best && oi < bi)) { best = ob; bi = oi; } }
                    mask |= 1u << bi;
#pragma unroll
                    for (int jj = 0; jj < 4; ++jj) if (sub + 8 * jj == bi) x[jj] = -1.f;
                }
            }
            if (sub == 0) SEL[pr] = mask;
        }
        asm volatile("s_waitcnt vmcnt(4)" ::: "memory");
        ATT_BAR();
        selm[0] = SEL[g * 32 + lr]; selm[1] = SEL[g * 32 + 16 + lr];
    }
    int cur = 1, nxt = 0;
#define ATT_STEP_HEAD() const bool more = T + 2 < NT; \
        const bool cp = cs.tk < 512; f32x4* cpd = nullptr; \
        if (cp) { const f32x4* cps; wincopy_addr(P, cs, tid, cps, cpd); __builtin_amdgcn_global_load_lds((const unsigned*)cps, (LAS unsigned*)(lds + A_CPY + wave * 1024), 16, 0, 0); }     \
        { const TileSrc sn = attn_tile_src(P, b, more ? T + 2 : NT - 1, n_slc, lo); attn_dma(lds + nxt * A_TILE, sn, wave, lane); }     \
        const LAS unsigned char* Kg = lds + cur * A_TILE + g * 8192; const LAS unsigned char* Vg = Kg + 16384
#define ATT_STEP_TAIL() asm volatile("s_waitcnt vmcnt(4)" ::: "memory"); \
        if (cp) { const f32x4 cpv = *(const LAS f32x4*)(lds + A_CPY + wave * 1024 + lane * 16); __builtin_nontemporal_store(cpv, cpd); wincopy_next(cs); }     \
        ATT_BAR(); \
        cur = (cur == 2) ? 0 : cur + 1; nxt = (nxt == 2) ? 0 : nxt + 1
    for (int T = 1; T <= n_slc; ++T) {
        ATT_STEP_HEAD();
        const int jb = T - 1;
        const float cin[2] = {((selm[0] >> jb) & 1u) ? 0.f : NEGBIG, ((selm[1] >> jb) & 1u) ? 0.f : NEGBIG};
        attn_tile<1, STAT>(Kg, Vg, qf, O, mrun, lrun, s, lane, 64 * jb, qpos, cin, jb == qblk);
        ATT_STEP_TAIL();
    }
    ATT_FINISH(1);
    for (int T = n_slc + 1; T < NT; ++T) {
        ATT_STEP_HEAD();
        const int jt = lo + (T - 1 - n_slc);
        const bool em = (64 * jt + 63 > t0) || (64 * jt <= t0 + 31 - 512);
        attn_tile<2, STAT>(Kg, Vg, qf, O, mrun, lrun, s, lane, 64 * jt, qpos, czero, em);
        ATT_STEP_TAIL();
    }
    ATT_FINISH(2);
    asm volatile("s_waitcnt vmcnt(0)" ::: "memory");
#undef ATT_STEP_HEAD
#undef ATT_STEP_TAIL
#undef ATT_FINISH
#pragma unroll
    for (int qt = 0; qt < 2; ++qt) {
        const size_t row = row0 + 16 * qt + lr;
#pragma unroll
        for (int dt = 0; dt < 4; ++dt) {
            const int col = 64 * wave + 16 * dt + 4 * grp;
            float za[4]; unpack4(*(const u32x2*)(ACT + row * NIN + LZA + col), za);
            u32x2 w; w.x = cvt_pk_bf16(OA[dt][qt][0] * za[0], OA[dt][qt][1] * za[1]); w.y = cvt_pk_bf16(OA[dt][qt][2] * za[2], OA[dt][qt][3] * za[3]);
            *(u32x2*)(AB + row * DM + col) = w;
        }
    }
}

constexpr int G_ST = 0, G_VNT = 1024, VPITCH = 136;
__device__ __forceinline__ void gmlp_unit(const Params& P, LAS unsigned char* lds, int b, int ch, int gp, int tid, int lane, int wave) {
    asm volatile("" : "+v"(tid), "+v"(lane));
    const bf16_t* ACT = (const bf16_t*)(P.ws + WS_ACT); bf16_t* AB = (bf16_t*)(P.ws + WS_AB);
    LAS f32x2* ST = (LAS f32x2*)(lds + G_ST); LAS bf16_t* Vnt = (LAS bf16_t*)(lds + G_VNT);
    const size_t R0 = (size_t)b * SEQ + 128 * ch;
    __syncthreads();
    u32x4 vraw[4][2];
    {
        u32x4 raw[16];
#pragma unroll
        for (int i = 0; i < 16; ++i) raw[i] = *(const u32x4*)(ACT + (R0 + wave + 8 * i) * NIN + LVB + 8 * lane);
#pragma unroll
        for (int i = 0; i < 4; ++i) { const int idx = tid + 512 * i, j2 = idx & 63, chn = idx >> 6;
#pragma unroll
            for (int h2 = 0; h2 < 2; ++h2) vraw[i][h2] = *(const u32x4*)(ACT + (R0 + 2 * j2 + h2) * NIN + LVB + 256 * gp + 8 * chn); }
        __builtin_amdgcn_sched_barrier(0);
#pragma unroll
        for (int i = 0; i < 16; ++i) {
            float f[8]; f[0] = bf2f(raw[i].x); f[1] = bf2f(raw[i].x >> 16); f[2] = bf2f(raw[i].y); f[3] = bf2f(raw[i].y >> 16); f[4] = bf2f(raw[i].z); f[5] = bf2f(raw[i].z >> 16); f[6] = bf2f(raw[i].w); f[7] = bf2f(raw[i].w >> 16);
            float sm = 0.f, sq = 0.f;
#pragma unroll
            for (int e = 0; e < 8; ++e) { sm += f[e]; sq += f[e] * f[e]; }
            sm = wave_sum(sm); sq = wave_sum(sq);
            const float mean = sm * (1.0f / 512.0f), var = fmaxf(sq * (1.0f / 512.0f) - mean * mean, 0.f);
            if (lane == 0) ST[wave + 8 * i] = (f32x2){mean, rsqrtf(var + 1e-6f)};
        }
    }
    __syncthreads();
    {
        const float* vg = P.in[21] + 256 * gp; const float* vb = P.in[22] + 256 * gp;
#pragma unroll
        for (int i = 0; i < 4; ++i) {
            const int idx = tid + 512 * i, j2 = idx & 63, chn = idx >> 6;
            const f32x2 st0 = ST[2 * j2], st1 = ST[2 * j2 + 1];
            const f32x4 g0 = *(const f32x4*)(vg + 8 * chn), g1 = *(const f32x4*)(vg + 8 * chn + 4), b0 = *(const f32x4*)(vb + 8 * chn), b1 = *(const f32x4*)(vb + 8 * chn + 4);
            const float gv[8] = {g0[0], g0[1], g0[2], g0[3], g1[0], g1[1], g1[2], g1[3]}, bv[8] = {b0[0], b0[1], b0[2], b0[3], b1[0], b1[1], b1[2], b1[3]};
            const unsigned w0[4] = {vraw[i][0].x, vraw[i][0].y, vraw[i][0].z, vraw[i][0].w}, w1[4] = {vraw[i][1].x, vraw[i][1].y, vraw[i][1].z, vraw[i][1].w};
#pragma unroll
            for (int e = 0; e < 8; ++e) { const int d = 8 * chn + e;
                const float a = bf2f(w0[e >> 1] >> (16 * (e & 1))), b2 = bf2f(w1[e >> 1] >> (16 * (e & 1)));
                *(LAS unsigned*)(Vnt + d * VPITCH + 2 * j2) = cvt_pk_bf16((a - st0[0]) * st0[1] * gv[e] + bv[e], (b2 - st1[0]) * st1[1] * gv[e] + bv[e]); }
        }
    }
    __syncthreads();
    const int lr = lane & 15, grp = lane >> 4, g = 2 * gp + (wave >> 2);
    const bf16_t* tril = (const bf16_t*)(P.ws + WS_TRIL) + (size_t)g * 128 * 128;
    u32x2 upre[8][2], zpre[8][2];
#pragma unroll
    for (int it = 0; it < 8; ++it)
#pragma unroll
        for (int t2 = 0; t2 < 2; ++t2) { const size_t row = R0 + 16 * it + lr; const int d0 = 256 * gp + 32 * wave + 16 * t2 + 4 * grp;
            upre[it][t2] = *(const u32x2*)(ACT + row * NIN + LU + d0); zpre[it][t2] = *(const u32x2*)(ACT + row * NIN + LZB + d0); }
    __builtin_amdgcn_sched_barrier(0);
    f32x4 acc[2][8];
#pragma unroll
    for (int t2 = 0; t2 < 2; ++t2)
#pragma unroll
        for (int it = 0; it < 8; ++it) acc[t2][it] = (f32x4){0.f, 0.f, 0.f, 0.f};
    bf16x8 bfr[4][8];
#pragma unroll
    for (int ks = 0; ks < 4; ++ks)
#pragma unroll
        for (int it = 0; it < 8; ++it) if ((it >> 1) >= ks) bfr[ks][it] = *(const bf16x8*)(tril + (size_t)(16 * it + lr) * 128 + 32 * ks + 8 * grp);
    __builtin_amdgcn_sched_barrier(0);
#pragma unroll
    for (int ks = 0; ks < 4; ++ks) {
        const bf16x8 af0 = *(const LAS bf16x8*)(Vnt + (32 * wave + lr) * VPITCH + 32 * ks + 8 * grp);
        const bf16x8 af1 = *(const LAS bf16x8*)(Vnt + (32 * wave + 16 + lr) * VPITCH + 32 * ks + 8 * grp);
#pragma unroll
        for (int it = 0; it < 8; ++it) {
            if ((it >> 1) >= ks) { acc[0][it] = __builtin_amdgcn_mfma_f32_16x16x32_bf16(af0, bfr[ks][it], acc[0][it], 0, 0, 0); acc[1][it] = __builtin_amdgcn_mfma_f32_16x16x32_bf16(af1, bfr[ks][it], acc[1][it], 0, 0, 0); }
        }
    }
    const float* bs = P.in[24] + 128 * g;
#pragma unroll
    for (int it = 0; it < 8; ++it) {
        const int i = 16 * it + lr; const size_t row = R0 + i;
        const float bsi = bs[i];
#pragma unroll
        for (int t2 = 0; t2 < 2; ++t2) {
            const int d0 = 256 * gp + 32 * wave + 16 * t2 + 4 * grp;
            float uu[4], zb[4]; unpack4(upre[it][t2], uu); unpack4(zpre[it][t2], zb);
            u32x2 w; w.x = cvt_pk_bf16(uu[0] * (acc[t2][it][0] + bsi) * zb[0], uu[1] * (acc[t2][it][1] + bsi) * zb[1]); w.y = cvt_pk_bf16(uu[2] * (acc[t2][it][2] + bsi) * zb[2], uu[3] * (acc[t2][it][3] + bsi) * zb[3]);
            *(u32x2*)(AB + row * DM + 512 + d0) = w;
        }
    }
}

__device__ __forceinline__ void stile(const float* kb, const float* vb, int stride, int kmin, const f32x4 (&q4)[4], float (&m)[4], float (&l)[4], f32x4 (&o4)[4], float (&pout)[4], int lane_in, LAS f32x4* pb) {
    int lane = lane_in; asm volatile("" : "+v"(lane));
    const int li = lane & 15, gq = lane >> 4;
    __builtin_amdgcn_sched_barrier(0);
    const float* kl = kb + (size_t)(gq * stride + 4 * li); const float* vl = vb + (size_t)(gq * stride + 4 * li);
    f32x4 kreg[16], vreg[16];
#pragma unroll
    for (int i = 0; i < 16; ++i) kreg[i] = __builtin_nontemporal_load((const f32x4*)(kl + (size_t)(4 * i) * stride));
#pragma unroll
    for (int i = 0; i < 16; ++i) vreg[i] = __builtin_nontemporal_load((const f32x4*)(vl + (size_t)(4 * i) * stride));
    float sc[4];
#pragma unroll
    for (int h = 0; h < 4; ++h) {
        float v[16];
#pragma unroll
        for (int i = 0; i < 16; ++i) v[i] = (kreg[i][0] * q4[h][0] + kreg[i][1] * q4[h][1]) + (kreg[i][2] * q4[h][2] + kreg[i][3] * q4[h][3]);
        sc[h] = tred16(v, li);
    }
    const bool valid = (4 * li + gq) >= kmin;
#pragma unroll
    for (int h = 0; h < 4; ++h) {
        const float sv = valid ? sc[h] : NEGBIG;
        const float mnew = fmaxf(m[h], wave_max(sv));
        const float alpha = __builtin_amdgcn_exp2f(m[h] - mnew), p = __builtin_amdgcn_exp2f(sv - mnew);
        l[h] = l[h] * alpha + wave_sum(p); o4[h] *= alpha; m[h] = mnew; pout[h] = p;
    }
    pb[4 * li + gq] = (f32x4){pout[0], pout[1], pout[2], pout[3]};
    asm volatile("s_waitcnt lgkmcnt(0)" ::: "memory");
#pragma unroll
    for (int i = 0; i < 16; ++i) {
        const f32x4 pk = pb[4 * i + gq];
#pragma unroll
        for (int h = 0; h < 4; ++h) o4[h] += vreg[i] * pk[h];
    }
    asm volatile("s_waitcnt lgkmcnt(0)" ::: "memory");
    __builtin_amdgcn_sched_barrier(0);
}
__device__ __forceinline__ void skey(const float* kb, const float* vb, const f32x4 (&q4)[4], float (&m)[4], float (&l)[4], f32x4 (&o4)[4], int lane) {
    const int li = lane & 15, gq = lane >> 4;
    const f32x4 kd = *(const f32x4*)(kb + 4 * li), vd = *(const f32x4*)(vb + 4 * li);
#pragma unroll
    for (int h = 0; h < 4; ++h) {
        float sv = (kd[0] * q4[h][0] + kd[1] * q4[h][1]) + (kd[2] * q4[h][2] + kd[3] * q4[h][3]);
        sv += xs<1>(sv); sv += xs<2>(sv); sv += xs<4>(sv); sv += xs<8>(sv);
        const float mnew = fmaxf(m[h], sv), alpha = __builtin_amdgcn_exp2f(m[h] - mnew), p = __builtin_amdgcn_exp2f(sv - mnew);
        l[h] = l[h] * alpha + p; o4[h] *= alpha; if (gq == 0) o4[h] += vd * p; m[h] = mnew;
    }
}

constexpr int S_ST = 0, S_MISC = 8 * 3 * 4 * 66 * 4, S_PB = 26624;
static_assert(S_MISC + 64 <= S_PB, "decode unit LDS");
constexpr int S_ST_ = 0;
__device__ __forceinline__ void sample_unit(const Params& P, LAS unsigned char* lds, int sb, int g, int tid, int lane, int wave) {
    const bf16_t* ACT = (const bf16_t*)(P.ws + WS_ACT); bf16_t* AB = (bf16_t*)(P.ws + WS_AB);
    LAS float* ST = (LAS float*)(lds + S_ST); LAS float* MISC = (LAS float*)(lds + S_MISC);
    const size_t row = (size_t)MP + sb;
    const int* ptab = (const int*)P.in[8] + sb * 16;
    const int li = lane & 15;
    __syncthreads();
    f32x4 q4[4];
#pragma unroll
    for (int h = 0; h < 4; ++h) { float t4[4]; unpack4(*(const u32x2*)(ACT + row * NIN + LQ + 64 * (4 * g + h) + 4 * li), t4); q4[h] = (f32x4){t4[0], t4[1], t4[2], t4[3]}; }
    float ms[4], ls[4]; f32x4 os[4];
#define S_RESET() do { _Pragma("unroll") for (int h = 0; h < 4; ++h) { ms[h] = MINIT; ls[h] = 0.f; os[h] = (f32x4){0.f, 0.f, 0.f, 0.f}; } } while (0)
#define S_PUBLISH(b2, doit) do { _Pragma("unroll") for (int h = 0; h < 4; ++h) { f32x4 v = os[h]; \
        _Pragma("unroll") for (int e = 0; e < 4; ++e) { float x = v[e]; x += __shfl_xor(x, 16); x += __shfl_xor(x, 32); v[e] = x; } \
        if (doit) { LAS float* st = ST + ((wave * 3 + (b2)) * 4 + h) * 66; if (lane < 16) *(LAS f32x4*)(st + 4 * lane) = v; if (lane == 0) { st[64] = ms[h]; st[65] = ls[h]; } } } } while (0)
    float pdummy[4], pc[4];
    LAS f32x4* pb = (LAS f32x4*)(lds + S_PB + wave * 1024);
    S_RESET();
    { const size_t off = (((size_t)sb * 512 + 64 * wave) * 2 + g) * 64; stile(P.in[6] + off, P.in[7] + off, 128, (wave == 0) ? 1 : 0, q4, ms, ls, os, pdummy, lane, pb); }
    if (wave == 0) { const size_t off = ((size_t)(sb * 512 + 511) * 2 + g) * 64; skey(P.out + O_SKW + off, P.out + O_SVW + off, q4, ms, ls, os, lane); }
    S_PUBLISH(1, true);
    S_RESET();
    stile((const float*)(P.ws + WS_KCS) + (size_t)(sb * 2 + g) * 4096, (const float*)(P.ws + WS_VCS) + (size_t)(sb * 2 + g) * 4096, 64, 0, q4, ms, ls, os, pc, lane, pb);
    float imp = 0.f;
#pragma unroll
    for (int h = 0; h < 4; ++h) { const float pn = pc[h] / ls[h]; imp += pn + __shfl_down(pn, 16); }
    S_PUBLISH(2, wave == 0);
    const int jblk = 2 * li + (lane >> 5);
    const bool cand = ((lane >> 4) & 1) == 0 && jblk >= 1;
    unsigned key = cand ? ((__builtin_bit_cast(unsigned, imp) & 0xffffffe0u) | (unsigned)(31 - jblk)) : 0u;
    unsigned long long selpack = 0ull;
#pragma unroll
    for (int pick = 0; pick < 6; ++pick) {
        const unsigned best = wave_max_u(key);
        const int bj = 31 - (int)(best & 31u);
        selpack |= (unsigned long long)bj << (5 * (pick + 1));
        if (cand && jblk == bj) key = 0u;
    }
    S_RESET();
    if (wave < 7) { const int blk = (int)((selpack >> (5 * wave)) & 31ull); const int page = __builtin_amdgcn_readfirstlane(ptab[blk >> 1]); const size_t off = (((size_t)page * 128 + (blk & 1) * 64) * 2 + g) * 64;
        stile(P.in[4] + off, P.in[5] + off, 128, 0, q4, ms, ls, os, pdummy, lane, pb); }
    else skey(P.out + O_SKS + (size_t)sb * 128 + g * 64, P.out + O_SVS + (size_t)sb * 128 + g * 64, q4, ms, ls, os, lane);
    S_PUBLISH(0, true);
#undef S_RESET
#undef S_PUBLISH
    if (wave == 7) {
        const u32x4 raw = *(const u32x4*)(ACT + row * NIN + LVB + 8 * lane);
        float f[8]; f[0] = bf2f(raw.x); f[1] = bf2f(raw.x >> 16); f[2] = bf2f(raw.y); f[3] = bf2f(raw.y >> 16); f[4] = bf2f(raw.z); f[5] = bf2f(raw.z >> 16); f[6] = bf2f(raw.w); f[7] = bf2f(raw.w >> 16);
        float sm = 0.f;
#pragma unroll
        for (int i = 0; i < 8; ++i) sm += f[i];
        const float mean = wave_sum(sm) * (1.0f / 512.0f); float sq = 0.f;
#pragma unroll
        for (int i = 0; i < 8; ++i) { const float d = f[i] - mean; sq += d * d; }
        const float rstd = rsqrtf(wave_sum(sq) * (1.0f / 512.0f) + 1e-6f);
        if (lane == 0) { MISC[0] = mean; MISC[1] = rstd; }
    }
    __syncthreads();
    if (wave < 4) {
        const int h = wave, head = 4 * g + h;
        const LAS float* stc = ST + ((0 * 3 + 2) * 4 + h) * 66;
        float oa = bf2f(ACT[row * NIN + LNSA + 3 * head + 0]) * stc[lane] / stc[65];
#pragma unroll
        for (int b2 = 0; b2 < 2; ++b2) {
            float M = MINIT;
#pragma unroll
            for (int w = 0; w < 8; ++w) M = fmaxf(M, ST[((w * 3 + b2) * 4 + h) * 66 + 64]);
            float L = 0.f, O = 0.f;
#pragma unroll
            for (int w = 0; w < 8; ++w) { const LAS float* st = ST + ((w * 3 + b2) * 4 + h) * 66; const float f = __builtin_amdgcn_exp2f(st[64] - M); L += st[65] * f; O += st[lane] * f; }
            oa += bf2f(ACT[row * NIN + LNSA + 3 * head + 1 + b2]) * O / L;
        }
        const int col = 64 * head + lane;
        AB[row * DM + col] = (bf16_t)f2bf(oa * bf2f(ACT[row * NIN + LZA + col]));
    }
    if (tid < 256) {
        const int d = 256 * g + tid, gm = d >> 7;
        const float vn = (bf2f(ACT[row * NIN + LVB + d]) - MISC[0]) * MISC[1] * P.in[21][d] + P.in[22][d];
        P.out[O_SVCH + (size_t)sb * 512 + d] = vn;
        const float sv = P.in[23][(size_t)gm * 128 * 128] * vn + P.in[24][gm * 128];
        AB[row * DM + 512 + d] = (bf16_t)f2bf(bf2f(ACT[row * NIN + LU + d]) * sv * bf2f(ACT[row * NIN + LZB + d]));
    }
}

template <int MODE>
__device__ __forceinline__ void small_gemm(const Params& P, int c, int G, int wave, int lane) {
    const int lr = lane & 15, grp = lane >> 4;
    for (int t = c + G * wave; t < 512; t += G * 8) {
        const int rt = t & 7, ct = t >> 3;
        const size_t row = (size_t)MP + 16 * rt + lr;
        const bf16_t* A = (const bf16_t*)(P.ws + (MODE == 0 ? WS_AB : WS_H)) + row * DM + 8 * grp;
        const int wrow = (MODE == 0) ? (256 * (ct >> 4) + 128 * ((ct >> 1) & 1) + 32 * ((ct >> 2) & 3) + 16 * (ct & 1) + lr) : (16 * ct + lr);
        const bf16_t* W = (const bf16_t*)(P.ws + (MODE == 0 ? WS_WTBR : WS_WTOUT)) + (size_t)wrow * DM + 8 * grp;
        f32x4 acc0 = (f32x4){0.f, 0.f, 0.f, 0.f}, acc1 = (f32x4){0.f, 0.f, 0.f, 0.f};
#pragma unroll
        for (int ks = 0; ks < 16; ++ks) acc0 = __builtin_amdgcn_mfma_f32_16x16x32_bf16(*(const bf16x8*)(W + 32 * ks), *(const bf16x8*)(A + 32 * ks), acc0, 0, 0, 0);
#pragma unroll
        for (int ks = 16; ks < 32; ++ks) acc1 = __builtin_amdgcn_mfma_f32_16x16x32_bf16(*(const bf16x8*)(W + 32 * ks), *(const bf16x8*)(A + 32 * ks), acc1, 0, 0, 0);
        const int col = 16 * ct + 4 * grp;
        if (MODE == 0) {
            const int i = 16 * rt + lr, cc = col & 255;
            const size_t go = ((size_t)(((64 * 8 + (col >> 8)) * 8 + (i >> 6) * 4 + (cc >> 6)) * 32 + ((((i >> 4) & 3) * 2 + ((cc >> 5) & 1)) * 2 + ((cc >> 4) & 1))) * 64 + ((cc >> 2) & 3) * 16 + (i & 15)) * 4;
            const bf16_t* GB = (const bf16_t*)(P.ws + WS_GBUF);
            float sa[4], sb[4]; unpack4(*(const u32x2*)(GB + go), sa); unpack4(*(const u32x2*)(GB + go + (size_t)4 * 8 * 32 * 256), sb);
            u32x2 w; w.x = cvt_pk_bf16(sa[0] * acc0[0] + sb[0] * acc1[0], sa[1] * acc0[1] + sb[1] * acc1[1]); w.y = cvt_pk_bf16(sa[2] * acc0[2] + sb[2] * acc1[2], sa[3] * acc0[3] + sb[3] * acc1[3]);
            *(u32x2*)((bf16_t*)(P.ws + WS_H) + row * DM + col) = w;
        } else {
            const int sbi = 16 * rt + lr;
            const f32x4 xv = *(const f32x4*)(P.in[1] + (size_t)sbi * DM + col), gv = *(const f32x4*)((const float*)(P.ws + WS_MOD) + (size_t)(8 + sbi) * 3072 + 2048 + col);
            *(f32x4*)(P.out + O_YS + (size_t)sbi * DM + col) = xv + gv * (acc0 + acc1);
        }
    }
}

#define XB_TMO      128
#define XB_XCNT(j)  (256  + 64 * (j))
#define XB_XSUB(j)  (1280 + 64 * (j))
#define XB_XGEN(j)  (2304 + 64 * (j))
#define XB_TOP      3328
#define XB_TOPGEN   3392
#define XCD_BAR_WORDS 3456
#define XB_SPIN_CAP (1u << 18)
__device__ __forceinline__ unsigned xb_ld(unsigned* p)              { return __hip_atomic_load(p, __ATOMIC_RELAXED, __HIP_MEMORY_SCOPE_AGENT); }
__device__ __forceinline__ unsigned xb_add(unsigned* p, unsigned v) { return __hip_atomic_fetch_add(p, v, __ATOMIC_RELAXED, __HIP_MEMORY_SCOPE_AGENT); }
__device__ __forceinline__ unsigned xb_xcc_id() { return (unsigned)__builtin_amdgcn_s_getreg((3 << 11) | 20) & 0xFu; }
#define XB_SPIN(cond, bar) do { unsigned _sp = 0; while (cond) { __builtin_amdgcn_s_sleep(1); \
    if ((++_sp & 255u) == 0u) { if (xb_ld(&(bar)[XB_TMO])) break; if (_sp > XB_SPIN_CAP) { atomicAdd(&(bar)[XB_TMO], 1u); break; } } } } while (0)
struct XcdBarrier { unsigned* bar; unsigned x; volatile LAS unsigned* st; };
__device__ __forceinline__ XcdBarrier xcd_barrier_post(unsigned* bar, volatile LAS unsigned* st) {
    XcdBarrier b; b.bar = bar; b.x = xb_xcc_id(); b.st = st;
    if (threadIdx.x == 0) (void)xb_add(&bar[XB_XCNT(b.x)], 1u);
    return b;
}
__device__ __forceinline__ void xcd_barrier_complete(unsigned* bar, unsigned x, unsigned& nloc, unsigned& nx) {
    const unsigned G = gridDim.x * gridDim.y * gridDim.z;
    unsigned sum, cnt, mine, sp = 0u;
    for (;;) {
        sum = 0u; cnt = 0u; mine = 0u;
#pragma unroll
        for (unsigned j = 0; j < 16; ++j) { const unsigned c = xb_ld(&bar[XB_XCNT(j)]); sum += c; cnt += (c > 0u) ? 1u : 0u; mine = (j == x) ? c : mine; }
        if (sum == G) break;
        __builtin_amdgcn_s_sleep(1);
        if ((++sp & 255u) == 0u) { if (xb_ld(&bar[XB_TMO])) break; if (sp > XB_SPIN_CAP) { atomicAdd(&bar[XB_TMO], 1u); break; } }
    }
    nloc = mine > 0u ? mine : 1u; nx = cnt > 0u ? cnt : 1u;
}
__device__ __forceinline__ void xcd_barrier(const XcdBarrier& b) {
    asm volatile("s_waitcnt vmcnt(0)" ::: "memory");
    __syncthreads();
    if (threadIdx.x == 0) {
        unsigned* bar = b.bar;
        __builtin_amdgcn_s_waitcnt(0);
        unsigned nloc = b.st[0], nx = b.st[1];
        if (nloc == 0u) { xcd_barrier_complete(bar, b.x, nloc, nx); b.st[0] = nloc; b.st[1] = nx; }
        const unsigned old = xb_add(&bar[XB_XSUB(b.x)], 1u);
        const unsigned gen = old / nloc;
        if (old + 1u == (gen + 1u) * nloc) {
            __builtin_amdgcn_fence(__ATOMIC_RELEASE, "agent");
            asm volatile("s_waitcnt vmcnt(0)" ::: "memory");
            const unsigned og = xb_add(&bar[XB_TOP], 1u);
            const unsigned tg = og / nx;
            if (og + 1u == (tg + 1u) * nx) xb_add(&bar[XB_TOPGEN], 1u);
            else XB_SPIN(xb_ld(&bar[XB_TOPGEN]) == tg, bar);
            __builtin_amdgcn_fence(__ATOMIC_ACQUIRE, "agent");
            xb_add(&bar[XB_XGEN(b.x)], 1u);
            asm volatile("s_waitcnt vmcnt(0)" ::: "memory");
        } else {
            XB_SPIN(xb_ld(&bar[XB_XGEN(b.x)]) == gen, bar);
            __builtin_amdgcn_fence(__ATOMIC_ACQUIRE, "agent");
            asm volatile("s_waitcnt vmcnt(0)" ::: "memory");
        }
    }
    __syncthreads();
}

__global__ void __launch_bounds__(512, 2) mk_fwd(Params P) {
    extern __shared__ __attribute__((aligned(16))) unsigned char lds_raw[];
    LAS unsigned char* lds = (LAS unsigned char*)lds_raw;
    const int tid = threadIdx.x, lane = tid & 63, wave = __builtin_amdgcn_readfirstlane(tid >> 6);
    const int G = gridDim.x, c = blockIdx.x, gw = c * 8 + wave, NGW = G * 8, gtid = c * 512 + tid, NT = G * 512;
    cg::grid_group grid = cg::this_grid();
    const int lo = P.ph_lo, hi = P.ph_hi;
    if (tid < 16) ((LAS unsigned*)(lds + LDS_XB))[tid] = 0u;
    __syncthreads();
    const XcdBarrier bar = xcd_barrier_post((unsigned*)(P.ws + WS_CTL), (volatile LAS unsigned*)(lds + LDS_XB));
    if (hi < 0) grid.sync();
#define IN(k) (lo <= (k) && (k) < hi)
#define SEAM(k) do { if ((k) != 3 && IN(k) && IN((k) + 1)) xcd_barrier(bar); } while (0)
    unsigned char* ws = P.ws;
    if (IN(0)) for (int rep = 0; rep < MK_REP0; ++rep) { p0_prologue(P, lds, gw, NGW, lane, wave, gtid, NT); }
    SEAM(0);
    if (IN(1)) for (int rep = 0; rep < MK_REP1; ++rep) { p1_hrows(P, gw, NGW, lane); }
    SEAM(1);
    if (IN(2)) for (int rep = 0; rep < MK_REP2; ++rep) {
        pg8::Gemm gm{(const bf16_t*)(ws + WS_H), (const bf16_t*)(ws + WS_WTIN), DM, DM, DM};
        pg8::StaticOrder S; S.init(MPAD / 256, NIN / 256, G, c);
        EpiInProj E{(bf16_t*)(ws + WS_ACT), (bf16_t*)(ws + WS_VT), (bf16_t*)(ws + WS_GBUF), P.out, P.in[15], P.in[16], (const float*)(ws + WS_ROPE), lds + LDS_EPI};
        pg8::gemm_phase<EpiInProj, pg8::StaticOrder>(lds, gm, S, E);
        { const int nwg = (MPAD / 256) * (NIN / 256), nlast = nwg % G;
          if (nlast != 0 && c >= nlast) { const int nidle = (G - nlast) * 8, iw = (c - nlast) * 8 + wave; float pes[2][2]; pool_pe_sums(P, lane, pes);
              for (int u = (1616 + 776) + iw; u < 4096; u += nidle) pool_item(P, (LAS float*)(lds + wave * 16384), u, lane, pes); }
          else if (nlast == 0) { float pes[2][2]; pool_pe_sums(P, lane, pes); for (int u = (1616 + 776) + gw; u < 4096; u += NGW) pool_item(P, (LAS float*)(lds + wave * 16384), u, lane, pes); } }
    }
    SEAM(2);
    SEAM(3);
    if (IN(4)) for (int rep = 0; rep < MK_REP4; ++rep) {
        asm volatile("" ::: "memory");
        bool stat;
        { const float gq = fabsf(P.in[15][lane]), gk = fabsf(P.in[16][lane]); stat = 64.0f * C2Q * wave_max(gq) * wave_max(gk) <= ATT_SBOUND; }
        WinCopy cs{c, 0, G};
        for (int i = 0;; ++i) { const int a = (i & 1) ? (i + 1) * G - 1 - c : i * G + c; if (a >= 512 || a < 0) break;
            if (stat) attn_unit<true>(P, lds, a & 7, 63 - (a >> 3), tid, lane, wave, cs); else attn_unit<false>(P, lds, a & 7, 63 - (a >> 3), tid, lane, wave, cs); }
        while (cs.tk < 512) { const f32x4* cps; f32x4* cpd; wincopy_addr(P, cs, tid, cps, cpd); __builtin_nontemporal_store(__builtin_nontemporal_load(cps), cpd); wincopy_next(cs); }
        {
            unsigned* qctr = (unsigned*)(ws + WS_CTL) + 3584;
            LAS unsigned* qsl = (LAS unsigned*)(lds + LDS_XB + 32);
            for (;;) {
                __syncthreads();
                if (tid == 0) *qsl = __hip_atomic_fetch_add(qctr, 1u, __ATOMIC_RELAXED, __HIP_MEMORY_SCOPE_AGENT);
                __syncthreads();
                const int u = (int)*qsl;
                if (u >= 512) break;
                if (u < 256) gmlp_unit(P, lds, u >> 5, (u >> 1) & 15, u & 1, tid, lane, wave);
                else { const int su = u - 256; sample_unit(P, lds, su >> 1, su & 1, tid, lane, wave); }
            }
        }
        __syncthreads();
    }
    SEAM(4);
    if (IN(5)) for (int rep = 0; rep < MK_REP5; ++rep) {
        pg8::Gemm gm{(const bf16_t*)(ws + WS_AB), (const bf16_t*)(ws + WS_WTBR), DM, DM, 512};
        small_gemm<0>(P, c, G, wave, lane);
        pg8::PairOrder S; S.S.init(MP / 256, DM / 256, G, c);
        EpiMix E{(const bf16_t*)(ws + WS_GBUF), (bf16_t*)(ws + WS_H)};
        pg8::gemm_phase<EpiMix, pg8::PairOrder>(lds, gm, S, E);
    }
    SEAM(5);
    if (IN(6)) for (int rep = 0; rep < MK_REP6; ++rep) {
        pg8::Gemm gm{(const bf16_t*)(ws + WS_H), (const bf16_t*)(ws + WS_WTOUT), DM, DM, DM};
        small_gemm<1>(P, c, G, wave, lane);
        pg8::StaticOrder S; S.init(MP / 256, DM / 256, G, c);
        EpiOut E{P.in[0], P.in[1], (const float*)(ws + WS_MOD), P.out};
        pg8::gemm_phase<EpiOut, pg8::StaticOrder>(lds, gm, S, E);
    }
#undef IN
#undef SEAM
}

extern "C" void kernel_launch(void* const* d_in, const int* in_sizes, int n_in, void* d_out, int out_size, void* d_ws, size_t ws_size, hipStream_t stream) {
    static int grid = 0;
    if (grid == 0) {
        if (n_in != 28 || out_size != (int)O_END || ws_size < WS_END) { fprintf(stderr, "kernel_launch: unexpected shapes (n_in %d, out %d, ws %zu); nothing launched\n", n_in, out_size, ws_size); grid = -1; return; }
        int dev = 0, cus = 0, per_cu = 0;
        if (hipGetDevice(&dev) != hipSuccess || hipDeviceGetAttribute(&cus, hipDeviceAttributeMultiprocessorCount, dev) != hipSuccess) { grid = -1; return; }
        if (hipFuncSetAttribute((const void*)mk_fwd, hipFuncAttributeMaxDynamicSharedMemorySize, LDS_BYTES) != hipSuccess) { fprintf(stderr, "kernel_launch: hipFuncSetAttribute failed\n"); grid = -1; return; }
        if (hipOccupancyMaxActiveBlocksPerMultiprocessor(&per_cu, (const void*)mk_fwd, 512, LDS_BYTES) != hipSuccess || per_cu < 1) { fprintf(stderr, "kernel_launch: occupancy query failed (%d)\n", per_cu); (void)hipGetLastError(); per_cu = 1; }
        if (per_cu > 1) per_cu = 1;
        grid = cus * per_cu;
    }
    if (grid < 0) return;
    if (hipMemsetAsync((char*)d_ws + WS_CTL, 0, CTL_BYTES, stream) != hipSuccess) { fprintf(stderr, "kernel_launch: hipMemsetAsync failed\n"); return; }
    Params p{};
    for (int i = 0; i < 28; ++i) p.in[i] = (const float*)d_in[i];
    p.out = (float*)d_out; p.ws = (unsigned char*)d_ws;
#if MK_N_LAUNCHES == 1
    p.ph_lo = 0; p.ph_hi = 7;
    void* args[] = {&p};
    hipError_t e = hipLaunchCooperativeKernel((const void*)mk_fwd, dim3(grid), dim3(512), args, LDS_BYTES, stream);
    if (e != hipSuccess) fprintf(stderr, "kernel_launch: cooperative launch failed: %s (grid %d)\n", hipGetErrorString(e), grid);
#else
    for (int ph = 0; ph < 7; ++ph) {
        p.ph_lo = ph; p.ph_hi = ph + 1;
        void* args[] = {&p};
        hipError_t e = hipLaunchCooperativeKernel((const void*)mk_fwd, dim3(grid), dim3(512), args, LDS_BYTES, stream);
        if (e != hipSuccess) { fprintf(stderr, "kernel_launch: launch %d failed: %s (grid %d)\n", ph, hipGetErrorString(e), grid); break; }
    }
#endif
}
```
